# Optimizing an MI355X kernel written in HIP

```python
import math
import jax
import jax.numpy as jnp
from jax import lax
import numpy as np

D_MODEL = 2048
BATCH = 8
SEQ = 2048
DEPTH = 2

GRID_W = 64
CTX_LEN = 256
HEAD_DIM = 64
ROPE_THETA = 10000.0
NORM_EPS = 1e-6
N_MIXERS = 4
GROUP_W = D_MODEL // N_MIXERS

GLA_DV = 64
GLA_DK = GLA_DV // 2
GLA_HEADS = GROUP_W // GLA_DV
GLA_GATE_RANK = 16
GLA_GATE_TEMP = 16.0
GLA_CHUNK = 16
SWA_HEADS = GROUP_W // HEAD_DIM
SWA_KV_HEADS = SWA_HEADS // 4
SWA_WINDOW = 128
SWA_BLOCK = 128
HYENA_CH = GROUP_W
HYENA_ORDER = 2
HYENA_BANDS = 16
HYENA_EMB = 1 + 2 * HYENA_BANDS
HYENA_HIDDEN = 64
HYENA_TARGET = 1e-2
HYENA_MIN_DECAY = math.log(1.0 / HYENA_TARGET) / 1.5
HYENA_MAX_DECAY = math.log(1.0 / HYENA_TARGET) / 0.3
DIFF_QK_DIM = HEAD_DIM
DIFF_V_DIM = 2 * HEAD_DIM
DIFF_HEADS = GROUP_W // DIFF_V_DIM
DIFF_BLOCK = 128
N_EXPERTS = 16
N_GROUPS = 4
EXPERTS_PER_GROUP = N_EXPERTS // N_GROUPS
TOP_K = 2
D_EXPERT = 1024

COL_SIZES = (GLA_HEADS * GLA_DK, GLA_HEADS * GLA_DK, GLA_HEADS * GLA_DV, GLA_HEADS * GLA_DV, 2 * GLA_GATE_RANK,
             SWA_HEADS * HEAD_DIM, SWA_KV_HEADS * HEAD_DIM, SWA_KV_HEADS * HEAD_DIM,
             (HYENA_ORDER + 1) * HYENA_CH,
             DIFF_HEADS * 2 * DIFF_QK_DIM, DIFF_HEADS * 2 * DIFF_QK_DIM, DIFF_HEADS * DIFF_V_DIM)
D_IN = sum(COL_SIZES)
COL_OFFSETS = tuple(int(o) for o in np.cumsum(COL_SIZES)[:-1])
D_MIX = GLA_HEADS * GLA_DV + SWA_HEADS * HEAD_DIM + HYENA_CH + DIFF_HEADS * DIFF_V_DIM

kernel_name = "hybrid_parallel_heads_moe_dit"

F32 = jnp.float32


def rmsnorm(x, w):
    xf = x.astype(F32)
    y = xf * lax.rsqrt(jnp.mean(xf * xf, axis=-1, keepdims=True) + NORM_EPS)
    return (y * w.astype(F32)).astype(x.dtype)


def rope_tables(row_ids, col_ids):
    n = HEAD_DIM // 4
    inv = ROPE_THETA ** (-jnp.arange(n, dtype=F32) / n)
    ar = row_ids[:, None] * inv
    ac = col_ids[:, None] * inv
    return (jnp.cos(ar), jnp.sin(ar), jnp.cos(ac), jnp.sin(ac))


def rope_2d(x, rope):
    cos_r, sin_r, cos_c, sin_c = rope
    shp = (1, x.shape[1]) + (1,) * (x.ndim - 3) + (cos_r.shape[-1],)

    def rot(xh, cos, sin):
        cos = cos.reshape(shp).astype(xh.dtype)
        sin = sin.reshape(shp).astype(xh.dtype)
        x1, x2 = jnp.split(xh, 2, axis=-1)
        return jnp.concatenate([x1 * cos - x2 * sin, x2 * cos + x1 * sin], axis=-1)

    xr, xcol = jnp.split(x, 2, axis=-1)
    return jnp.concatenate([rot(xr, cos_r, sin_r), rot(xcol, cos_c, sin_c)], axis=-1)


def gla_scan(q, k, v, log_a, s0, with_output):
    B, L, H, dk = k.shape
    dv = v.shape[-1]
    C = GLA_CHUNK
    n = L // C
    r = lambda t: t.reshape(B, n, C, H, t.shape[-1]).astype(F32)
    q, k, v, log_a = r(q), r(k), r(v), r(log_a)
    b = jnp.cumsum(log_a, axis=2)
    b_last = b[:, :, -1]
    chunk_kv = jnp.einsum('bnchd,bnchv->bnhdv', k * jnp.exp(b_last[:, :, None] - b), v)
    chunk_decay = jnp.exp(b_last)

    def step(s, inp):
        dec, kv = inp
        return dec[..., None] * s + kv, s

    s_final, s_start = lax.scan(step, s0, (jnp.moveaxis(chunk_decay, 1, 0), jnp.moveaxis(chunk_kv, 1, 0)))
    if not with_output:
        return None, s_final
    s_start = jnp.moveaxis(s_start, 0, 1)
    o_inter = jnp.einsum('bnchd,bnhdv->bnchv', q * jnp.exp(b), s_start)
    tri = jnp.tril(jnp.ones((C, C), dtype=bool))
    diff = b[:, :, :, None] - b[:, :, None, :]
    decay = jnp.exp(jnp.where(tri[None, None, :, :, None, None], diff, -jnp.inf))
    attn = jnp.einsum('bnthd,bnshd,bntshd->bnhts', q, k, decay)
    o_intra = jnp.einsum('bnhts,bnshv->bnthv', attn, v)
    return (o_inter + o_intra).reshape(B, L, H, dv), s_final


def gla_mixer(cols_c, cols_l, p, update_ctx):
    def prep(cols):
        q, k, v, g, a = cols
        B, L, _ = q.shape
        q = q.reshape(B, L, GLA_HEADS, GLA_DK) * (GLA_DK ** -0.5)
        k = k.reshape(B, L, GLA_HEADS, GLA_DK)
        v = v.reshape(B, L, GLA_HEADS, GLA_DV)
        z = jnp.einsum('bldr,drk->bldk', a.reshape(B, L, 2, GLA_GATE_RANK), p['gla_gate_w']) + p['gla_gate_b']
        la = (jax.nn.log_sigmoid(z.astype(F32)) / GLA_GATE_TEMP).reshape(B, L, 2, GLA_HEADS, GLA_DK)
        return q, k, v, g, la[:, :, 0], la[:, :, 1]

    qc, kc, vc, gc, lfc, lbc = prep(cols_c)
    ql, kl, vl, gl, lfl, lbl = prep(cols_l)
    B = ql.shape[0]
    s0 = jnp.zeros((B, GLA_HEADS, GLA_DK, GLA_DV), F32)
    fl = lambda t: jnp.flip(t, axis=1)
    oc_f, s_f = gla_scan(qc, kc, vc, lfc, s0, update_ctx)
    oc_b, s_b = gla_scan(fl(qc), fl(kc), fl(vc), fl(lbc), s0, update_ctx)
    ol_f, _ = gla_scan(ql, kl, vl, lfl, s_f, True)
    ol_b, _ = gla_scan(fl(ql), fl(kl), fl(vl), fl(lbl), s_b, True)

    def finish(o, g):
        o = rmsnorm(o.astype(g.dtype), p['gla_norm_w'])
        return o.reshape(g.shape) * jax.nn.silu(g)

    out_l = finish(ol_f + fl(ol_b), gl)
    out_c = finish(oc_f + fl(oc_b), gc) if update_ctx else None
    return out_c, out_l


def swa_latent(q, k, v, kc, vc, sink):
    B, S, Hq, hd = q.shape
    Hkv = k.shape[2]
    G = Hq // Hkv
    W = SWA_BLOCK
    nb = S // W
    Lc = kc.shape[1]
    scale = hd ** -0.5
    qb = q.reshape(B, nb, W, Hkv, G, hd)

    def band(t):
        tp = jnp.pad(t, ((0, 0), (W, W), (0, 0), (0, 0))).reshape(B, nb + 2, W, Hkv, hd)
        return jnp.concatenate([tp[:, :-2], tp[:, 1:-1], tp[:, 2:]], axis=2)

    kb, vb = band(k), band(v)
    s_loc = jnp.einsum('bnqhgd,bnkhd->bnhgqk', qb, kb).astype(F32) * scale
    blk = jnp.arange(nb)[:, None] * W
    qpos = blk + jnp.arange(W)[None, :]
    kpos = blk - W + jnp.arange(3 * W)[None, :]
    valid = ((jnp.abs(qpos[:, :, None] - kpos[:, None, :]) <= SWA_WINDOW)
             & (kpos >= 0)[:, None, :] & (kpos < S)[:, None, :])
    s_loc = jnp.where(valid[None, :, None, None], s_loc, -jnp.inf)
    s_ctx = jnp.einsum('bnqhgd,bkhd->bnhgqk', qb, kc).astype(F32) * scale
    s_sink = jnp.broadcast_to(sink.astype(F32).reshape(1, 1, Hkv, G, 1, 1), s_ctx.shape[:-1] + (1,))
    prob = jax.nn.softmax(jnp.concatenate([s_sink, s_ctx, s_loc], axis=-1), axis=-1).astype(v.dtype)
    o = (jnp.einsum('bnhgqk,bkhd->bnqhgd', prob[..., 1:1 + Lc], vc)
         + jnp.einsum('bnhgqk,bnkhd->bnqhgd', prob[..., 1 + Lc:], vb))
    return o.reshape(B, S, Hq * hd)


def swa_context(q, k, v, sink):
    B, L, Hq, hd = q.shape
    Hkv = k.shape[2]
    G = Hq // Hkv
    s = jnp.einsum('bqhgd,bkhd->bhgqk', q.reshape(B, L, Hkv, G, hd), k).astype(F32) * (hd ** -0.5)
    s_sink = jnp.broadcast_to(sink.astype(F32).reshape(1, Hkv, G, 1, 1), s.shape[:-1] + (1,))
    prob = jax.nn.softmax(jnp.concatenate([s_sink, s], axis=-1), axis=-1)[..., 1:].astype(v.dtype)
    return jnp.einsum('bhgqk,bkhd->bqhgd', prob, v).reshape(B, L, Hq * hd)


def swa_mixer(cols_c, cols_l, p, rope, update_ctx):
    qc, kc, vc = cols_c
    ql, kl, vl = cols_l
    heads = lambda t, n: t.reshape(t.shape[0], t.shape[1], n, HEAD_DIM)
    qn = lambda t: rmsnorm(heads(t, SWA_HEADS), p['swa_q_norm_w'])
    kn = lambda t: rmsnorm(heads(t, SWA_KV_HEADS), p['swa_k_norm_w'])
    kc_, vc_ = kn(kc), heads(vc, SWA_KV_HEADS)
    out_l = swa_latent(rope_2d(qn(ql), rope), rope_2d(kn(kl), rope), heads(vl, SWA_KV_HEADS),
                       kc_, vc_, p['swa_sink'])
    out_c = swa_context(qn(qc), kc_, vc_, p['swa_sink']) if update_ctx else None
    return out_c, out_l


def short_conv(u, w, b):
    up = jnp.pad(u, ((0, 0), (1, 1), (0, 0)))
    return up[:, :-2] * w[0] + up[:, 1:-1] * w[1] + up[:, 2:] * w[2] + b


def hyena_filter_spectrum(L, p):
    t = jnp.linspace(0.0, 1.0, L, dtype=F32)[:, None]
    w = (2.0 * math.pi / L) * jnp.arange(L, dtype=F32)[:, None]
    bands = jnp.linspace(1e-4, HYENA_BANDS - 1, HYENA_BANDS, dtype=F32)
    z = jnp.concatenate([t, jnp.cos(w * bands), -jnp.sin(w * bands)], axis=-1)
    fr = p['hyena_ffn_freq'].astype(F32)
    h = jnp.sin(fr[0] * (z @ p['hyena_ffn_w1'].astype(F32) + p['hyena_ffn_b1'].astype(F32)))
    h = jnp.sin(fr[1] * (h @ p['hyena_ffn_w2'].astype(F32) + p['hyena_ffn_b2'].astype(F32)))
    h = (h @ p['hyena_ffn_w3'].astype(F32)).reshape(L, HYENA_ORDER, 2, HYENA_CH)
    deltas = jnp.linspace(HYENA_MIN_DECAY, HYENA_MAX_DECAY, HYENA_CH, dtype=F32)
    h = h * jnp.exp(-t * deltas)[:, None, None, :]
    h = h / jnp.sum(jnp.abs(h), axis=(0, 2), keepdims=True)
    full = jnp.concatenate([h[:, :, 0], jnp.zeros((1, HYENA_ORDER, HYENA_CH), F32),
                            jnp.flip(h[1:, :, 1], axis=0)], axis=0)
    return jnp.fft.rfft(full, axis=0)


def fft_conv(u, spec):
    L = u.shape[1]
    U = jnp.fft.rfft(u.astype(F32), n=2 * L, axis=1)
    return jnp.fft.irfft(U * spec[None], n=2 * L, axis=1)[:, :L].astype(u.dtype)


def hyena_mixer(u_c, u_l, p, update_ctx):
    def run(u):
        z = short_conv(u, p['hyena_conv_w'], p['hyena_conv_b'])
        x1, x2, y = jnp.split(z, 3, axis=-1)
        spec = hyena_filter_spectrum(u.shape[1], p)
        for o, gate in enumerate((x1, x2)):
            y = gate * (fft_conv(y, spec[:, o]) + y * p['hyena_bias'][o])
        return y

    out_l = run(u_l)
    out_c = run(u_c) if update_ctx else None
    return out_c, out_l


def diff_attend(q, k, v, lam):
    s = jnp.einsum('bqhmd,bkhmd->bhmqk', q, k).astype(F32) * (q.shape[-1] ** -0.5)
    prob = jax.nn.softmax(s, axis=-1)
    wgt = prob[:, :, 0] - lam * prob[:, :, 1]
    return jnp.einsum('bhqk,bkhe->bqhe', wgt.astype(v.dtype), v)


def diff_attend_blocks(q, k, v, lam):
    B, S, H, M, d = q.shape
    nb = S // DIFF_BLOCK
    qb = jnp.moveaxis(q.reshape(B, nb, DIFF_BLOCK, H, M, d), 1, 0)
    o = lax.map(lambda qq: diff_attend(qq, k, v, lam), qb)
    return jnp.moveaxis(o, 0, 1).reshape(B, S, H, -1)


def diff_mixer(cols_c, cols_l, p, rope, lam_init, update_ctx):
    dl = p['diff_lambda'].astype(F32)
    lam = jnp.exp(jnp.sum(dl[0] * dl[1])) - jnp.exp(jnp.sum(dl[2] * dl[3])) + lam_init
    qk = lambda t: t.reshape(t.shape[0], t.shape[1], DIFF_HEADS, 2, DIFF_QK_DIM)
    vh = lambda t: t.reshape(t.shape[0], t.shape[1], DIFF_HEADS, DIFF_V_DIM)
    qn = lambda t: rmsnorm(qk(t), p['diff_q_norm_w'])
    kn = lambda t: rmsnorm(qk(t), p['diff_k_norm_w'])
    qc, kc, vc = cols_c
    ql, kl, vl = cols_l
    kc_, vc_ = kn(kc), vh(vc)
    k_all = jnp.concatenate([kc_, rope_2d(kn(kl), rope)], axis=1)
    v_all = jnp.concatenate([vc_, vh(vl)], axis=1)

    def post(o):
        o = rmsnorm(o, p['diff_subln_w']) * (1.0 - lam_init)
        return o.reshape(o.shape[0], o.shape[1], DIFF_HEADS * DIFF_V_DIM)

    out_l = post(diff_attend_blocks(rope_2d(qn(ql), rope), k_all, v_all, lam))
    out_c = post(diff_attend(qn(qc), kc_, vc_, lam)) if update_ctx else None
    return out_c, out_l


def moe(h, router_w, router_bias, w_gate, w_up, w_down):
    Bh, Lh, D = h.shape
    t = h.reshape(-1, D)
    probs = jax.nn.softmax((t @ router_w).astype(F32), axis=-1)
    sel = (probs + router_bias.astype(F32)).reshape(-1, N_GROUPS, EXPERTS_PER_GROUP)
    group = jnp.argmax(jnp.max(sel, axis=-1), axis=-1)
    sel_g = jnp.take_along_axis(sel, group[:, None, None], axis=1)[:, 0]
    _, idx = lax.top_k(sel_g, TOP_K)
    expert = group[:, None] * EXPERTS_PER_GROUP + idx
    wts = jnp.take_along_axis(probs, expert, axis=-1)
    wts = wts / jnp.sum(wts, axis=-1, keepdims=True)
    comb = jnp.sum(jax.nn.one_hot(expert, N_EXPERTS, dtype=F32) * wts[..., None], axis=1).astype(t.dtype)
    y = jnp.zeros_like(t)
    for e in range(N_EXPERTS):
        he = jax.nn.silu(t @ w_gate[e]) * (t @ w_up[e])
        y = y + comb[:, e:e + 1] * (he @ w_down[e])
    return y.reshape(Bh, Lh, D)


def hybrid_layer(x, xc, c, c_ctx, p, router_w, router_bias, rope, lam_init, update_ctx):
    Lc = xc.shape[1]
    mod_l = jnp.split(jax.nn.silu(c) @ p['ada_w'] + p['ada_b'], 6, axis=-1)
    mod_c = jnp.split(jax.nn.silu(c_ctx) @ p['ada_w'] + p['ada_b'], 6, axis=-1)
    sh_l, sc_l, ga_l, shf_l, scf_l, gf_l = [m[:, None, :] for m in mod_l]
    sh_c, sc_c, ga_c, shf_c, scf_c, gf_c = mod_c

    h_l = rmsnorm(x, p['norm1_w']) * (1.0 + sc_l) + sh_l
    h_c = rmsnorm(xc, p['norm1_w']) * (1.0 + sc_c) + sh_c
    u = jnp.concatenate([h_c, h_l], axis=1) @ p['w_in']
    cols_c = jnp.split(u[:, :Lc], COL_OFFSETS, axis=-1)
    cols_l = jnp.split(u[:, Lc:], COL_OFFSETS, axis=-1)

    a_c, a_l = gla_mixer(cols_c[0:5], cols_l[0:5], p, update_ctx)
    b_c, b_l = swa_mixer(cols_c[5:8], cols_l[5:8], p, rope, update_ctx)
    y_c, y_l = hyena_mixer(cols_c[8], cols_l[8], p, update_ctx)
    d_c, d_l = diff_mixer(cols_c[9:12], cols_l[9:12], p, rope, lam_init, update_ctx)

    x = x + ga_l * (jnp.concatenate([a_l, b_l, y_l, d_l], axis=-1) @ p['w_out'])
    f_l = rmsnorm(x, p['norm2_w']) * (1.0 + scf_l) + shf_l
    if update_ctx:
        xc = xc + ga_c * (jnp.concatenate([a_c, b_c, y_c, d_c], axis=-1) @ p['w_out'])
        f_c = rmsnorm(xc, p['norm2_w']) * (1.0 + scf_c) + shf_c
        f = moe(jnp.concatenate([f_c, f_l], axis=1), router_w, router_bias,
                p['expert_w_gate'], p['expert_w_up'], p['expert_w_down'])
        xc = xc + gf_c * f[:, :Lc]
        x = x + gf_l * f[:, Lc:]
    else:
        x = x + gf_l * moe(f_l, router_w, router_bias, p['expert_w_gate'], p['expert_w_up'], p['expert_w_down'])
    return x, xc


def setup_inputs(seed: int = 0) -> dict:
    key = jax.random.key(seed)
    ks = iter(jax.random.split(key, 48))
    nrm = lambda shape, scale: jax.random.normal(next(ks), shape, F32) * scale
    gain = lambda shape: 1.0 + nrm(shape, 0.02)
    D = D_MODEL
    return {
        "x": nrm((BATCH, SEQ, D), 1.0),
        "c": nrm((BATCH, D), 1.0),
        "ctx": nrm((BATCH, CTX_LEN, D), 1.0),
        "c_ctx": nrm((D,), 1.0),
        "norm1_w": gain((DEPTH, D)),
        "norm2_w": gain((DEPTH, D)),
        "ada_w": nrm((DEPTH, D, 6 * D), 0.5 * D ** -0.5),
        "ada_b": nrm((DEPTH, 6 * D), 0.01),
        "w_in": nrm((DEPTH, D, D_IN), D ** -0.5),
        "w_out": nrm((DEPTH, D_MIX, D), D_MIX ** -0.5),
        "gla_gate_w": nrm((DEPTH, 2, GLA_GATE_RANK, GLA_HEADS * GLA_DK), GLA_GATE_RANK ** -0.5),
        "gla_gate_b": nrm((DEPTH, 2, GLA_HEADS * GLA_DK), 0.1),
        "gla_norm_w": gain((DEPTH, GLA_DV)),
        "swa_q_norm_w": gain((DEPTH, HEAD_DIM)),
        "swa_k_norm_w": gain((DEPTH, HEAD_DIM)),
        "swa_sink": nrm((DEPTH, SWA_HEADS), 0.5),
        "hyena_conv_w": nrm((DEPTH, 3, (HYENA_ORDER + 1) * HYENA_CH), 3 ** -0.5),
        "hyena_conv_b": nrm((DEPTH, (HYENA_ORDER + 1) * HYENA_CH), 0.01),
        "hyena_ffn_w1": nrm((DEPTH, HYENA_EMB, HYENA_HIDDEN), HYENA_EMB ** -0.5),
        "hyena_ffn_b1": nrm((DEPTH, HYENA_HIDDEN), 0.1),
        "hyena_ffn_w2": nrm((DEPTH, HYENA_HIDDEN, HYENA_HIDDEN), HYENA_HIDDEN ** -0.5),
        "hyena_ffn_b2": nrm((DEPTH, HYENA_HIDDEN), 0.1),
        "hyena_ffn_w3": nrm((DEPTH, HYENA_HIDDEN, HYENA_ORDER * 2 * HYENA_CH), HYENA_HIDDEN ** -0.5),
        "hyena_ffn_freq": 1.0 + nrm((DEPTH, 2, HYENA_HIDDEN), 0.1),
        "hyena_bias": nrm((DEPTH, HYENA_ORDER, HYENA_CH), 1.0),
        "diff_q_norm_w": gain((DEPTH, DIFF_QK_DIM)),
        "diff_k_norm_w": gain((DEPTH, DIFF_QK_DIM)),
        "diff_lambda": nrm((DEPTH, 4, DIFF_QK_DIM), 0.1),
        "diff_subln_w": gain((DEPTH, DIFF_V_DIM)),
        "router_w": nrm((D, N_EXPERTS), D ** -0.5),
        "router_bias": nrm((N_EXPERTS,), 0.01),
        "expert_w_gate": nrm((DEPTH, N_EXPERTS, D, D_EXPERT), D ** -0.5),
        "expert_w_up": nrm((DEPTH, N_EXPERTS, D, D_EXPERT), D ** -0.5),
        "expert_w_down": nrm((DEPTH, N_EXPERTS, D_EXPERT, D), D_EXPERT ** -0.5),
    }


def reference(x, c, ctx, c_ctx, norm1_w, norm2_w, ada_w, ada_b, w_in, w_out, gla_gate_w, gla_gate_b, gla_norm_w,
              swa_q_norm_w, swa_k_norm_w, swa_sink, hyena_conv_w, hyena_conv_b, hyena_ffn_w1, hyena_ffn_b1,
              hyena_ffn_w2, hyena_ffn_b2, hyena_ffn_w3, hyena_ffn_freq, hyena_bias, diff_q_norm_w, diff_k_norm_w,
              diff_lambda, diff_subln_w, router_w, router_bias, expert_w_gate, expert_w_up, expert_w_down):
    S = x.shape[1]
    rows = S // GRID_W
    row_ids = jnp.repeat(jnp.arange(rows), GRID_W).astype(F32)
    col_ids = jnp.tile(jnp.arange(GRID_W), rows).astype(F32)
    rope = rope_tables(row_ids, col_ids)
    xc = ctx
    for l in range(DEPTH):
        p = dict(norm1_w=norm1_w[l], norm2_w=norm2_w[l], ada_w=ada_w[l], ada_b=ada_b[l], w_in=w_in[l],
                 w_out=w_out[l], gla_gate_w=gla_gate_w[l], gla_gate_b=gla_gate_b[l], gla_norm_w=gla_norm_w[l],
                 swa_q_norm_w=swa_q_norm_w[l], swa_k_norm_w=swa_k_norm_w[l], swa_sink=swa_sink[l],
                 hyena_conv_w=hyena_conv_w[l], hyena_conv_b=hyena_conv_b[l], hyena_ffn_w1=hyena_ffn_w1[l],
                 hyena_ffn_b1=hyena_ffn_b1[l], hyena_ffn_w2=hyena_ffn_w2[l], hyena_ffn_b2=hyena_ffn_b2[l],
                 hyena_ffn_w3=hyena_ffn_w3[l], hyena_ffn_freq=hyena_ffn_freq[l], hyena_bias=hyena_bias[l],
                 diff_q_norm_w=diff_q_norm_w[l], diff_k_norm_w=diff_k_norm_w[l], diff_lambda=diff_lambda[l],
                 diff_subln_w=diff_subln_w[l], expert_w_gate=expert_w_gate[l], expert_w_up=expert_w_up[l],
                 expert_w_down=expert_w_down[l])
        lam_init = 0.8 - 0.6 * math.exp(-0.3 * l)
        x, xc = hybrid_layer(x, xc, c, c_ctx, p, router_w, router_bias, rope, lam_init, l < DEPTH - 1)
    return x
```

```cpp
#include <hip/hip_runtime.h>
#include <cstdio>
#include <cstdint>

#define LAS __attribute__((address_space(3)))
#define GAS __attribute__((address_space(1)))
typedef unsigned short bf16_t;
typedef short bf16x8 __attribute__((ext_vector_type(8)));
typedef float f32x2 __attribute__((ext_vector_type(2)));
typedef float f32x4 __attribute__((ext_vector_type(4)));
typedef float f32x16 __attribute__((ext_vector_type(16)));
typedef unsigned u32x2 __attribute__((ext_vector_type(2)));
typedef unsigned u32x4 __attribute__((ext_vector_type(4)));
typedef int i32x4 __attribute__((ext_vector_type(4)));
typedef int i32x8 __attribute__((ext_vector_type(8)));

constexpr int D = 2048, NB = 8, SEQ = 2048, LC = 256, DEPTH = 2;
constexpr int TL = NB * SEQ, TCX = NB * LC, TT = TL + TCX;
constexpr int DIN = 5408, NU = 5376, NE = 16, DE = 1024;
constexpr int KEYS = LC + SEQ;
constexpr int UC_GQ = 0, UC_GK = 256, UC_GV = 512, UC_GG = 1024, UC_SQ = 1536, UC_SK = 2048, UC_SV = 2176, UC_HY = 2304, UC_DQ = 3840, UC_DK = 4352, UC_DV = 4864;
constexpr int MOE_ROWS = 2 * TT + NE * 256;
constexpr int MOE_PANELS = MOE_ROWS / 256;
constexpr int GCH = 64, NCH = KEYS / GCH;
constexpr float NORM_EPS = 1e-6f;
constexpr float LOG2E = 1.4426950408889634f;

constexpr size_t MiB = 1u << 20;
constexpr size_t WS_CTL = 0, CTL_BYTES = 1 * MiB;
constexpr size_t WS_MOD = 1 * MiB;
constexpr size_t WS_ROPE = 2 * MiB;
constexpr size_t WS_HYH2 = 3 * MiB;
constexpr size_t WS_WA = 5 * MiB;
constexpr size_t WS_RT = 6 * MiB;
constexpr size_t WS_AG = 7 * MiB;
constexpr size_t WS_HYF = 10 * MiB;
constexpr size_t WS_WIN = 28 * MiB;
constexpr size_t WS_WOUT = 70 * MiB;
constexpr size_t WS_WGU = 86 * MiB;
constexpr size_t WS_WD = 342 * MiB;
constexpr size_t WS_X = 470 * MiB;
constexpr size_t WS_H = 614 * MiB;
constexpr size_t WS_U = 686 * MiB;
constexpr size_t WS_B = 875 * MiB;
constexpr size_t WS_VTD = WS_B;
constexpr size_t WS_VTS = WS_B + 18 * MiB;
constexpr size_t WS_ZT = WS_B + 23 * MiB;
constexpr size_t WS_OT = WS_B + 77 * MiB;
constexpr size_t WS_GSL = WS_B + 95 * MiB;
constexpr size_t WS_GSS = WS_B + 131 * MiB;
constexpr size_t WS_GAE = WS_B + 167 * MiB;
constexpr size_t WS_Y2 = WS_B;
constexpr size_t WS_HB = 1043 * MiB;
constexpr size_t WS_END = 1115 * MiB;
constexpr int WIN_F8_MASK = 2;
#define WIN_F8_L(l) (((WIN_F8_MASK) >> (l)) & 1)
constexpr bool WOUT_F8 = true;
constexpr int MIXB = WOUT_F8 ? 1 : 2;
constexpr size_t RT_E = 0;
constexpr size_t RT_W = 128 * 1024;
constexpr size_t RT_ROWTOK = 320 * 1024;
constexpr size_t RT_ROWW = 512 * 1024;
constexpr int CW_BAR = 4096;
constexpr int CW_CNT = 16384;
constexpr int CW_CUR = 16384 + 256;
constexpr int CW_HYC = 16384 + 512, CW_ADAC = 16384 + 576;
constexpr int CW_Q = 16384 + 1024;

constexpr int LDS_BYTES = 155648;
constexpr int LDS_MISC = LDS_BYTES - 512;
constexpr int NWAVES = 8, NTHR = 512;

__device__ __forceinline__ unsigned f2bf(float f) { unsigned u = __builtin_bit_cast(unsigned, f); return (u + 0x7fffu + ((u >> 16) & 1u)) >> 16; }
#ifndef EMU8
#define EMU8 0
#endif
__device__ __forceinline__ float q8(float f) { unsigned u = __builtin_bit_cast(unsigned, f); u = (u + 0x7ffffu + ((u >> 20) & 1u)) & 0xfff00000u; return __builtin_bit_cast(float, u); }
__device__ __forceinline__ unsigned pk2(float lo, float hi) { return f2bf(lo) | (f2bf(hi) << 16); }
__device__ __forceinline__ unsigned pk2q(float lo, float hi) { return f2bf(q8(lo)) | (f2bf(q8(hi)) << 16); }
__device__ __forceinline__ unsigned pk4_f8(float a, float b, float c, float d) {
    a = fminf(fmaxf(a, -448.f), 448.f); b = fminf(fmaxf(b, -448.f), 448.f); c = fminf(fmaxf(c, -448.f), 448.f); d = fminf(fmaxf(d, -448.f), 448.f);
    int r = 0; r = __builtin_amdgcn_cvt_pk_fp8_f32(a, b, r, false); r = __builtin_amdgcn_cvt_pk_fp8_f32(c, d, r, true); return (unsigned)r; }
__device__ __forceinline__ unsigned char f8_1(float a) { a = fminf(fmaxf(a, -448.f), 448.f); return (unsigned char)(__builtin_amdgcn_cvt_pk_fp8_f32(a, a, 0, false) & 0xff); }
__device__ __forceinline__ float bf2f(unsigned short b) { return __builtin_bit_cast(float, ((unsigned)b) << 16); }
__device__ __forceinline__ float bflo(unsigned w) { return __builtin_bit_cast(float, w << 16); }
__device__ __forceinline__ float bfhi(unsigned w) { return __builtin_bit_cast(float, w & 0xffff0000u); }
__device__ __forceinline__ float wave_sum(float v) {
#pragma unroll
    for (int o = 1; o < 64; o <<= 1) v += __shfl_xor(v, o);
    return v;
}
__device__ __forceinline__ float silu_f(float x) { return x / (1.f + __expf(-x)); }
#define LDS_WAIT() asm volatile("s_waitcnt lgkmcnt(0)" ::: "memory")
#define VM_WAIT() asm volatile("s_waitcnt vmcnt(0)" ::: "memory")

#define XB_TMO      128
#define XB_XCNT(j)  (256  + 64 * (j))
#define XB_XSUB(j)  (1280 + 64 * (j))
#define XB_XGEN(j)  (2304 + 64 * (j))
#define XB_TOP      3328
#define XB_TOPGEN   3392
#define XCD_BAR_WORDS 3456
#define XB_SPIN_CAP (1u << 18)
__device__ __forceinline__ unsigned xb_ld(unsigned* p)              { return __hip_atomic_load(p, __ATOMIC_RELAXED, __HIP_MEMORY_SCOPE_AGENT); }
__device__ __forceinline__ unsigned xb_add(unsigned* p, unsigned v) { return __hip_atomic_fetch_add(p, v, __ATOMIC_RELAXED, __HIP_MEMORY_SCOPE_AGENT); }
__device__ __forceinline__ unsigned xb_xcc_id() { return (unsigned)__builtin_amdgcn_s_getreg((3 << 11) | 20) & 0xFu; }
#define XB_SPIN(cond, bar) do { unsigned _sp = 0; while (cond) { __builtin_amdgcn_s_sleep(1); \
    if ((++_sp & 255u) == 0u) { if (xb_ld(&(bar)[XB_TMO])) break; if (_sp > XB_SPIN_CAP) { atomicAdd(&(bar)[XB_TMO], 1u); break; } } } } while (0)
struct XcdBarrier { unsigned* bar; unsigned x; volatile LAS unsigned* st; };
__device__ __forceinline__ XcdBarrier xcd_barrier_post(unsigned* bar, volatile LAS unsigned* st, int tid) {
    XcdBarrier b; b.bar = bar; b.x = xb_xcc_id(); b.st = st;
    if (tid == 0) (void)xb_add(&bar[XB_XCNT(b.x)], 1u);
    return b;
}
__device__ __forceinline__ void xcd_barrier_complete(unsigned* bar, unsigned x, unsigned& nloc, unsigned& nx) {
    const unsigned G = gridDim.x * gridDim.y * gridDim.z;
    unsigned sum, cnt, mine, sp = 0u;
    for (;;) {
        sum = 0u; cnt = 0u; mine = 0u;
#pragma unroll
        for (unsigned j = 0; j < 16; ++j) { const unsigned c = xb_ld(&bar[XB_XCNT(j)]); sum += c; cnt += (c > 0u) ? 1u : 0u; mine = (j == x) ? c : mine; }
        if (sum == G) break;
        __builtin_amdgcn_s_sleep(1);
        if ((++sp & 255u) == 0u) { if (xb_ld(&bar[XB_TMO])) break; if (sp > XB_SPIN_CAP) { atomicAdd(&bar[XB_TMO], 1u); break; } }
    }
    nloc = mine > 0u ? mine : 1u; nx = cnt > 0u ? cnt : 1u;
}
__device__ __forceinline__ void xcd_barrier(const XcdBarrier& b, int tid) {
    asm volatile("s_waitcnt vmcnt(0)" ::: "memory");
    __syncthreads();
    if (tid == 0) {
        unsigned* bar = b.bar;
        __builtin_amdgcn_s_waitcnt(0);
        unsigned nloc = b.st[0], nx = b.st[1];
        if (nloc == 0u) { xcd_barrier_complete(bar, b.x, nloc, nx); b.st[0] = nloc; b.st[1] = nx; }
        const unsigned old = xb_add(&bar[XB_XSUB(b.x)], 1u);
        const unsigned gen = old / nloc;
        if (old + 1u == (gen + 1u) * nloc) {
            __builtin_amdgcn_fence(__ATOMIC_RELEASE, "agent");
            asm volatile("s_waitcnt vmcnt(0)" ::: "memory");
            const unsigned og = xb_add(&bar[XB_TOP], 1u);
            const unsigned tg = og / nx;
            if (og + 1u == (tg + 1u) * nx) xb_add(&bar[XB_TOPGEN], 1u);
            else XB_SPIN(xb_ld(&bar[XB_TOPGEN]) == tg, bar);
            __builtin_amdgcn_fence(__ATOMIC_ACQUIRE, "agent");
            xb_add(&bar[XB_XGEN(b.x)], 1u);
            asm volatile("s_waitcnt vmcnt(0)" ::: "memory");
        } else {
            XB_SPIN(xb_ld(&bar[XB_XGEN(b.x)]) == gen, bar);
            __builtin_amdgcn_fence(__ATOMIC_ACQUIRE, "agent");
            asm volatile("s_waitcnt vmcnt(0)" ::: "memory");
        }
    }
    __syncthreads();
}

namespace pg8 {
constexpr int BM = 256, BK = 64, HALF = 128, HTB = HALF * BK * 2, STAGE_BYTES = 8 * HTB;
__host__ __device__ __forceinline__ int lds_byte(int r, int c) { const int st = (r >> 4) * 2 + (c >> 5), rr = r & 15, cc = c & 31, ob = rr * 64 + cc * 2; return st * 1024 + (ob ^ (((ob >> 9) & 1) << 5)); }
__host__ __device__ __forceinline__ void stage_rc(int b, int& R, int& C) { const int st = b / 1024, sb = b % 1024, swz = sb ^ (((sb >> 9) & 1) << 5); R = (st >> 1) * 16 + swz / 64; C = (st & 1) * 32 + (swz % 64) / 2; }
__host__ __device__ __forceinline__ int lds_byte8(int r, int cb) { const int st = (r >> 4) * 2 + (cb >> 6), rr = r & 15, ob = rr * 64 + (cb & 63); return st * 1024 + (ob ^ (((ob >> 9) & 1) << 4)); }
__host__ __device__ __forceinline__ void stage_rc8(int b, int& R, int& Cb) { const int st = b / 1024, sb = b % 1024, swz = sb ^ (((sb >> 9) & 1) << 4); R = (st >> 1) * 16 + swz / 64; Cb = (st & 1) * 64 + (swz % 64); }
__host__ __device__ __forceinline__ int perm32(int rho) { const int n = rho >> 4, i = rho & 15; return 8 * (i >> 2) + 4 * n + (i & 3); }
struct Unit { int pm, pn; };
struct Gemm { const bf16_t* A; const bf16_t* Bt; int K; const int* rowtab; };
__device__ __forceinline__ unsigned cvt_pk_bf16(float lo, float hi) { unsigned r; asm volatile("v_cvt_pk_bf16_f32 %0, %1, %2" : "=v"(r) : "v"(lo), "v"(hi)); return r; }

template <class Epi, class Sched, bool GATHER, bool F8 = false>
__device__ __forceinline__ void gemm_phase(LAS unsigned char* lds, const Gemm g, const Sched& S, const Epi& E, const int tid) {
    const int wid = __builtin_amdgcn_readfirstlane(tid >> 6), lane = tid & 63, wr = wid >> 2, wc = wid & 3, fr = lane & 15, fq = lane >> 4;
    const int K = g.K, RB = F8 ? K : 2 * K, nt = RB / 128;
    unsigned voffB[2], voffA[2];
#pragma unroll
    for (int i = 0; i < 2; ++i) { int R, Cb; if constexpr (F8) stage_rc8(tid * 16 + i * 8192, R, Cb); else { int C; stage_rc(tid * 16 + i * 8192, R, C); Cb = 2 * C; }
        const int Rb = Epi::PERM ? ((R & ~31) + perm32(R & 31)) : R;
        voffA[i] = (unsigned)(R * RB + Cb); voffB[i] = (unsigned)(Rb * RB + Cb); }
    const size_t kstep = 128;
    const size_t hstep = (size_t)HALF * RB;
    const size_t tstep = 2 * hstep;
    const unsigned ldsw = (unsigned)wid * 1024u;
    const int aoff = F8 ? lds_byte8(wr * 64 + fr, 32 * fq) : lds_byte(wr * 64 + fr, fq * 8), boff = F8 ? lds_byte8(wc * 32 + fr, 32 * fq) : lds_byte(wc * 32 + fr, fq * 8);
    const int aoff2 = aoff ^ 16, boff2 = boff ^ 16;
#define PG8_SA(b, h) (((b) * 2 + (h)) * HTB)
#define PG8_SB(b, h) ((4 + (b) * 2 + (h)) * HTB)
#define PG8_STAGE(bufoff, gbase, voff) do { _Pragma("unroll") for (int _i = 0; _i < 2; ++_i) \
        __builtin_amdgcn_global_load_lds((const unsigned*)((const char*)(gbase) + (voff)[_i]), (LAS unsigned*)(lds + (bufoff) + ldsw + _i * 8192), 16, 0, 0); } while (0)
#define PG8_LDA(dst, b, h) do { if constexpr (F8) { _Pragma("unroll") for (int m = 0; m < 4; ++m) { const i32x4 _lo = *(const LAS i32x4*)(lds + PG8_SA(b, h) + aoff + m * 2048), _hi = *(const LAS i32x4*)(lds + PG8_SA(b, h) + aoff2 + m * 2048); dst##8[m] = __builtin_shufflevector(_lo, _hi, 0, 1, 2, 3, 4, 5, 6, 7); } } \
        else { _Pragma("unroll") for (int m = 0; m < 4; ++m) _Pragma("unroll") for (int k = 0; k < 2; ++k) dst[m][k] = *(const LAS bf16x8*)(lds + PG8_SA(b, h) + aoff + m * 2048 + k * 1024); } } while (0)
#define PG8_LDB(dst, b, h) do { if constexpr (F8) { _Pragma("unroll") for (int n = 0; n < 2; ++n) { const i32x4 _lo = *(const LAS i32x4*)(lds + PG8_SB(b, h) + boff + n * 2048), _hi = *(const LAS i32x4*)(lds + PG8_SB(b, h) + boff2 + n * 2048); dst##8[n] = __builtin_shufflevector(_lo, _hi, 0, 1, 2, 3, 4, 5, 6, 7); } } \
        else { _Pragma("unroll") for (int n = 0; n < 2; ++n) _Pragma("unroll") for (int k = 0; k < 2; ++k) dst[n][k] = *(const LAS bf16x8*)(lds + PG8_SB(b, h) + boff + n * 2048 + k * 1024); } } while (0)
#define PG8_CAT(x) __builtin_shufflevector(x[0], x[1], 0, 1, 2, 3, 4, 5, 6, 7)
#define PG8_MMA(ai, bj, At, Bt) do { __builtin_amdgcn_s_setprio(1); if constexpr (F8) { _Pragma("unroll") for (int m = 0; m < 4; ++m) _Pragma("unroll") for (int n = 0; n < 2; ++n) \
            asm volatile("v_mfma_scale_f32_16x16x128_f8f6f4 %0, %1, %2, %0, %3, %3 op_sel_hi:[0,0,0]" : "+v"(acc[ai][bj][m][n]) : "v"(Bt##8[n]), "v"(At##8[m]), "v"(f8scale)); } \
        else { _Pragma("unroll") for (int m = 0; m < 4; ++m) _Pragma("unroll") for (int n = 0; n < 2; ++n) _Pragma("unroll") for (int k = 0; k < 2; ++k) \
            acc[ai][bj][m][n] = __builtin_amdgcn_mfma_f32_16x16x32_bf16(Bt[n][k], At[m][k], acc[ai][bj][m][n], 0, 0, 0); } __builtin_amdgcn_s_setprio(0); } while (0)
#define PG8_WAIT_V(n) asm volatile("s_waitcnt vmcnt(" #n ")" ::: "memory")
#define PG8_WAIT_L(n) asm volatile("s_waitcnt lgkmcnt(" #n ")" ::: "memory")
#define PG8_BAR __builtin_amdgcn_s_barrier()
#define PG8_SCHED __builtin_amdgcn_sched_barrier(0)
#define PG8_AOFF(o, u) do { int _t2 = tid; asm volatile("" : "+v"(_t2)); _Pragma("unroll") for (int _i = 0; _i < 2; ++_i) { int _R, _Cb; if constexpr (F8) stage_rc8(_t2 * 16 + _i * 8192, _R, _Cb); else { int _C; stage_rc(_t2 * 16 + _i * 8192, _R, _C); _Cb = 2 * _C; } \
        _Pragma("unroll") for (int _h = 0; _h < 2; ++_h) { int _r = (u).pm * BM + _h * HALF + _R; \
        { const int _t = g.rowtab[_r]; _r = _t < 0 ? 0 : (_t & 0x3fffffff); } o[_h][_i] = (unsigned)(_r * RB + _Cb); } } } while (0)
    Unit cur, nxt; int ui = 0;
    if (!S.next(0, cur)) return;
    f32x4 acc[2][2][4][2];
#pragma unroll
    for (int a = 0; a < 2; ++a)
#pragma unroll
        for (int b = 0; b < 2; ++b)
#pragma unroll
            for (int m = 0; m < 4; ++m)
#pragma unroll
                for (int n = 0; n < 2; ++n) acc[a][b][m][n] = (f32x4){0.f, 0.f, 0.f, 0.f};
    bf16x8 At[4][2], B0[2][2], B1[2][2];
    i32x8 At8[4], B08[2], B18[2];
    int f8scale = 0x7f7f7f7f; asm volatile("" : "+v"(f8scale));
    unsigned oc[2][2], on[2][2];
    const char* gA = (const char*)g.A;
    const char* cA = gA; const char* cB = (const char*)g.Bt + (size_t)cur.pn * tstep;
    if constexpr (GATHER) { PG8_AOFF(oc, cur); } else { cA = gA + (size_t)cur.pm * tstep; }
#define PG8_STA_CUR(buf, kb, h) do { if constexpr (GATHER) { PG8_STAGE(buf, gA + (kb), oc[h]); } else { PG8_STAGE(buf, cA + (kb) + (h) * hstep, voffA); } } while (0)
#define PG8_STA_SEL(buf, kb, h) do { if constexpr (GATHER) { if (last) { PG8_STAGE(buf, gA + (kb), on[h]); } else { PG8_STAGE(buf, gA + (kb), oc[h]); } } else { PG8_STAGE(buf, a2p + (kb) + (h) * hstep, voffA); } } while (0)
    PG8_STAGE(PG8_SB(0, 0), cB, voffB); PG8_STAGE(PG8_SB(0, 1), cB + hstep, voffB); PG8_STA_CUR(PG8_SA(0, 0), 0, 0); PG8_STA_CUR(PG8_SA(0, 1), 0, 1);
    if (wr == 1) PG8_BAR;
    PG8_WAIT_V(2); PG8_BAR;
    PG8_STAGE(PG8_SB(1, 0), cB + kstep, voffB); PG8_STA_CUR(PG8_SA(1, 0), kstep, 0); PG8_STAGE(PG8_SB(1, 1), cB + hstep + kstep, voffB);
    PG8_WAIT_V(6); PG8_BAR;
    for (;;) {
        const bool has_next = S.next(ui + 1, nxt);
        const char* nA = cA;
        if constexpr (!GATHER) { if (has_next) nA = gA + (size_t)nxt.pm * tstep; }
        const char* nB = has_next ? (const char*)g.Bt + (size_t)nxt.pn * tstep : cB;
#pragma unroll 1
        for (int t = 0; t < nt; t += 2) {
            const bool last = (t == nt - 2);
            int to = t; asm volatile("" : "+s"(to));
            const size_t k1 = (size_t)(to + 1) * kstep, k2 = last ? 0 : (size_t)(to + 2) * kstep, k3 = k2 + kstep;
            const char* b2 = last ? nB : cB + (size_t)(to + 2) * kstep; const char* b3 = b2 + kstep;
            const char* a2p = last ? nA : cA;
            if constexpr (GATHER) { if (last) { if (has_next) { PG8_AOFF(on, nxt); } else {
#pragma unroll
                for (int h = 0; h < 2; ++h)
#pragma unroll
                    for (int i = 0; i < 2; ++i) on[h][i] = oc[h][i]; } } }
            PG8_LDB(B0, 0, 0); PG8_LDB(B1, 0, 1); PG8_SCHED; PG8_LDA(At, 0, 0); PG8_STA_CUR(PG8_SA(1, 1), k1, 1);
            PG8_WAIT_V(8); PG8_WAIT_L(0); PG8_BAR; PG8_MMA(0, 0, At, B0); PG8_MMA(0, 1, At, B1); PG8_BAR; PG8_SCHED;
            PG8_LDA(At, 0, 1); PG8_STAGE(PG8_SB(0, 0), b2, voffB); PG8_STAGE(PG8_SB(0, 1), b2 + hstep, voffB); PG8_STA_SEL(PG8_SA(0, 0), k2, 0);
            PG8_WAIT_V(8); PG8_WAIT_L(0); PG8_BAR; PG8_MMA(1, 0, At, B0); PG8_MMA(1, 1, At, B1); PG8_BAR; PG8_SCHED;
            PG8_LDB(B0, 1, 0); PG8_LDB(B1, 1, 1); PG8_SCHED; PG8_LDA(At, 1, 0); PG8_STA_SEL(PG8_SA(0, 1), k2, 1);
            PG8_WAIT_V(8); PG8_WAIT_L(0); PG8_BAR; PG8_MMA(0, 0, At, B0); PG8_MMA(0, 1, At, B1); PG8_BAR; PG8_SCHED;
            PG8_LDA(At, 1, 1); PG8_STAGE(PG8_SB(1, 0), b3, voffB); PG8_STAGE(PG8_SB(1, 1), b3 + hstep, voffB); PG8_STA_SEL(PG8_SA(1, 0), k3, 0);
            PG8_WAIT_V(8); PG8_WAIT_L(0); PG8_BAR; PG8_MMA(1, 0, At, B0); PG8_MMA(1, 1, At, B1); PG8_BAR; PG8_SCHED;
        }
        if (wr == 0) PG8_BAR;
        if constexpr (F8) asm volatile("s_nop 15\n\ts_nop 15" : "+v"(acc[1][1][0][0]), "+v"(acc[1][1][0][1]), "+v"(acc[1][1][1][0]), "+v"(acc[1][1][1][1]), "+v"(acc[1][1][2][0]), "+v"(acc[1][1][2][1]), "+v"(acc[1][1][3][0]), "+v"(acc[1][1][3][1]) :: "memory");
        E(acc, cur, wr, wc, fr, fq);
        if (!has_next) break;
#pragma unroll
        for (int a = 0; a < 2; ++a)
#pragma unroll
            for (int b = 0; b < 2; ++b)
#pragma unroll
                for (int m = 0; m < 4; ++m)
#pragma unroll
                    for (int n = 0; n < 2; ++n) acc[a][b][m][n] = (f32x4){0.f, 0.f, 0.f, 0.f};
        cur = nxt; cB = nB; cA = nA; ++ui;
        if constexpr (GATHER) {
#pragma unroll
            for (int h = 0; h < 2; ++h)
#pragma unroll
                for (int i = 0; i < 2; ++i) oc[h][i] = on[h][i]; }
        if (wr == 1) PG8_BAR;
    }
#undef PG8_STA_CUR
#undef PG8_STA_SEL
    PG8_WAIT_V(0);
    PG8_BAR;
#undef PG8_SA
#undef PG8_SB
#undef PG8_STAGE
#undef PG8_LDA
#undef PG8_LDB
#undef PG8_CAT
#undef PG8_MMA
#undef PG8_WAIT_V
#undef PG8_WAIT_L
#undef PG8_BAR
#undef PG8_SCHED
#undef PG8_AOFF
}
}

struct Params { const float* in[34]; float* out; unsigned char* ws; int ph_lo, ph_hi; };
typedef const __attribute__((address_space(4))) Params* KP;
__device__ __forceinline__ KP kp_opaque(KP p) { asm volatile("" : "+s"(p)); return p; }
enum { I_X = 0, I_C, I_CTX, I_CCTX, I_N1W, I_N2W, I_ADAW, I_ADAB, I_WIN, I_WOUT, I_GGW, I_GGB, I_GNW, I_SQN, I_SKN, I_SINK, I_HCW, I_HCB, I_HW1, I_HB1, I_HW2, I_HB2, I_HW3, I_HFR, I_HBIAS,
       I_DQN, I_DKN, I_DLAM, I_DSUB, I_RW, I_RB, I_EG, I_EU, I_ED };
struct Frame {
    LAS unsigned char* lds; volatile LAS unsigned* MISC; unsigned* ctl;
    int tid, lane, wave, vcu, G;
    unsigned char* ws;
};
__device__ __forceinline__ int modrow_of(int row) { return row < TL ? (row >> 11) : 8; }
__device__ __forceinline__ int keyrow(int b, int kidx) { return kidx < LC ? TL + b * LC + kidx : b * SEQ + (kidx - LC); }
__device__ __forceinline__ int wg_grab(Frame& F, int q) {
    __syncthreads();
    if (F.tid == 0) F.MISC[0] = __hip_atomic_fetch_add(F.ctl + CW_Q + 64 * q, 1u, __ATOMIC_RELAXED, __HIP_MEMORY_SCOPE_AGENT);
    __syncthreads();
    { int t_; asm volatile("v_mbcnt_lo_u32_b32 %0, -1, 0\n\tv_mbcnt_hi_u32_b32 %0, -1, %0" : "=v"(t_)); F.lane = t_; F.tid = F.wave * 64 + t_; }
    return (int)F.MISC[0];
}

namespace pg8 {
constexpr int NXCD = 8, WGM = 8;
struct RectOrder {
    int nM, nN, nwg, G, c, nextra, xpm0; unsigned long long xt;
    __device__ void init(int nM_, int nN_, int G_, int c_, int nextra_, int xpm0_, unsigned long long xt_) { nM = nM_; nN = nN_; nwg = nM * nN; G = G_; c = c_; nextra = nextra_; xpm0 = xpm0_; xt = xt_; }
    __device__ bool next(int i, Unit& u) const {
        const int L = i * G + c; if (L >= nwg + nextra) return false;
        if (L >= nwg) { const int e = L - nwg; u.pm = xpm0 + (e >> 3); u.pn = (int)((xt >> (8 * (e & 7))) & 0xffull); return true; }
        int wgid = L; { const int q = nwg / NXCD, r = nwg % NXCD, xcd = wgid % NXCD, off = wgid / NXCD; wgid = (xcd < r ? xcd * (q + 1) : r * (q + 1) + (xcd - r) * q) + off; }
        const int nig = WGM * nN, gid = wgid / nig, fm = gid * WGM, gsz = (nM - fm) < WGM ? (nM - fm) : WGM;
        u.pm = fm + ((wgid % nig) % gsz); u.pn = (wgid % nig) / gsz; return true;
    }
};
struct MoeOrder {
    int npanels, G, vcu; const volatile LAS unsigned char* pexp;
    __device__ bool next(int i, Unit& u) const {
        const int L = i * G + vcu; if (L >= npanels * 8) return false;
        const int p = L >> 3; u.pm = p; u.pn = (int)pexp[p] * 8 + (L & 7); return true;
    }
};
struct EpiU {
    static constexpr bool PERM = true;
    bf16_t* O; float scale;
    __device__ __forceinline__ void operator()(const f32x4 (&acc)[2][2][4][2], const Unit& u, int wr, int wc, int fr, int fq) const {
        const int row0 = u.pm * BM + wr * 64 + fr, col0 = u.pn * BM + wc * 32 + 8 * fq;
#pragma unroll
        for (int ai = 0; ai < 2; ++ai)
#pragma unroll
            for (int m = 0; m < 4; ++m) { bf16_t* rowp = O + (size_t)(row0 + ai * HALF + m * 16) * NU + col0;
#pragma unroll
                for (int bj = 0; bj < 2; ++bj) { const f32x4 v0 = acc[ai][bj][m][0] * scale, v1 = acc[ai][bj][m][1] * scale;
                    u32x4 w; w.x = cvt_pk_bf16(v0[0], v0[1]); w.y = cvt_pk_bf16(v0[2], v0[3]); w.z = cvt_pk_bf16(v1[0], v1[1]); w.w = cvt_pk_bf16(v1[2], v1[3]);
                    *(u32x4*)(rowp + bj * HALF) = w; } }
    }
};
struct EpiWout {
    static constexpr bool PERM = true;
    const float* res_lat; const float* res_ctx; const bf16_t* resb; bf16_t* X; const float* mod;
    __device__ __forceinline__ void operator()(const f32x4 (&acc)[2][2][4][2], const Unit& u, int wr, int wc, int fr, int fq) const {
        const int row0 = u.pm * BM + wr * 64 + fr, col0 = u.pn * BM + wc * 32 + 8 * fq;
        const float* ga = mod + (size_t)modrow_of(u.pm * BM) * 12288 + 2 * D;
        constexpr float sc = WOUT_F8 ? 1.f / 32.f : 1.f;
        f32x4 gv[2][2];
#pragma unroll
        for (int bj = 0; bj < 2; ++bj)
#pragma unroll
            for (int n = 0; n < 2; ++n) gv[bj][n] = *(const f32x4*)(ga + col0 + bj * HALF + n * 4) * sc;
        if (resb) {
#pragma unroll
            for (int ai = 0; ai < 2; ++ai)
#pragma unroll
                for (int m = 0; m < 4; ++m) { const int row = row0 + ai * HALF + m * 16; const bf16_t* rp = resb + (size_t)row * D + col0; bf16_t* xp = X + (size_t)row * D + col0;
#pragma unroll
                    for (int bj = 0; bj < 2; ++bj) { const u32x4 r = *(const u32x4*)(rp + bj * HALF);
                        const f32x4 v0 = (f32x4){bflo(r.x), bfhi(r.x), bflo(r.y), bfhi(r.y)} + gv[bj][0] * acc[ai][bj][m][0], v1 = (f32x4){bflo(r.z), bfhi(r.z), bflo(r.w), bfhi(r.w)} + gv[bj][1] * acc[ai][bj][m][1];
                        u32x4 o; o.x = cvt_pk_bf16(v0[0], v0[1]); o.y = cvt_pk_bf16(v0[2], v0[3]); o.z = cvt_pk_bf16(v1[0], v1[1]); o.w = cvt_pk_bf16(v1[2], v1[3]);
                        *(u32x4*)(xp + bj * HALF) = o; } }
        } else {
#pragma unroll
            for (int ai = 0; ai < 2; ++ai)
#pragma unroll
                for (int m = 0; m < 4; ++m) { const int row = row0 + ai * HALF + m * 16;
                    const float* rp = (row < TL ? res_lat + (size_t)row * D : res_ctx + (size_t)(row - TL) * D) + col0; bf16_t* xp = X + (size_t)row * D + col0;
#pragma unroll
                    for (int bj = 0; bj < 2; ++bj) { const f32x4 r0 = *(const f32x4*)(rp + bj * HALF), r1 = *(const f32x4*)(rp + bj * HALF + 4);
                        const f32x4 v0 = r0 + gv[bj][0] * acc[ai][bj][m][0], v1 = r1 + gv[bj][1] * acc[ai][bj][m][1];
                        u32x4 o; o.x = cvt_pk_bf16(v0[0], v0[1]); o.y = cvt_pk_bf16(v0[2], v0[3]); o.z = cvt_pk_bf16(v1[0], v1[1]); o.w = cvt_pk_bf16(v1[2], v1[3]);
                        *(u32x4*)(xp + bj * HALF) = o; } }
        }
    }
};
struct EpiMoe1 {
    static constexpr bool PERM = true;
    unsigned char* O;
    __device__ __forceinline__ void operator()(const f32x4 (&acc)[2][2][4][2], const Unit& u, int wr, int wc, int fr, int fq) const {
        const int row0 = u.pm * BM + wr * 64 + fr, col0 = (u.pn & 7) * HALF + wc * 32 + 8 * fq;
#pragma unroll
        for (int ai = 0; ai < 2; ++ai)
#pragma unroll
            for (int m = 0; m < 4; ++m) { unsigned char* rowp = O + (size_t)(row0 + ai * HALF + m * 16) * DE + col0; float h[8];
#pragma unroll
                for (int n = 0; n < 2; ++n)
#pragma unroll
                    for (int j = 0; j < 4; ++j) { const float gt = acc[ai][0][m][n][j] * (1.f / 32.f), up = acc[ai][1][m][n][j] * (1.f / 32.f); h[4 * n + j] = gt * __builtin_amdgcn_rcpf(1.f + __expf(-gt)) * up; }
                u32x2 w; w.x = pk4_f8(h[0], h[1], h[2], h[3]); w.y = pk4_f8(h[4], h[5], h[6], h[7]);
                *(u32x2*)rowp = w; }
    }
};
struct EpiMoe2 {
    static constexpr bool PERM = true;
    unsigned char* Y2; const int* rowtok; const float* roww;
    __device__ __forceinline__ void operator()(const f32x4 (&acc)[2][2][4][2], const Unit& u, int wr, int wc, int fr, int fq) const {
        const int row0 = u.pm * BM + wr * 64 + fr, col0 = (u.pn & 7) * BM + wc * 32 + 8 * fq;
#pragma unroll
        for (int ai = 0; ai < 2; ++ai)
#pragma unroll
            for (int m = 0; m < 4; ++m) { asm volatile("" ::: "memory"); const int row = row0 + ai * HALF + m * 16; const int tk = rowtok[row]; const float w = roww[row];
                if (tk >= 0) { unsigned char* rowp = Y2 + ((size_t)(tk >> 30) * TT + (size_t)(tk & 0x3fffffff)) * D + col0;
#pragma unroll
                    for (int bj = 0; bj < 2; ++bj) { const f32x4 v0 = acc[ai][bj][m][0] * w, v1 = acc[ai][bj][m][1] * w;
                        u32x2 o; o.x = pk4_f8(v0[0], v0[1], v0[2], v0[3]); o.y = pk4_f8(v1[0], v1[1], v1[2], v1[3]);
                        *(u32x2*)(rowp + bj * HALF) = o; } } }
    }
};
}

__device__ __forceinline__ void p0_transpose_item(const float* W, int ldw, int srccol0, int k0, bf16_t* dst, int K, LAS float* scr, int lane, bool q = false) {
    { f32x4 v[8];
#pragma unroll
      for (int i = 0; i < 8; ++i) v[i] = *(const f32x4*)(W + (size_t)(k0 + 8 * i + (lane >> 3)) * ldw + srccol0 + 4 * (lane & 7));
#pragma unroll
      for (int i = 0; i < 8; ++i) { LAS float* p = scr + (8 * i + (lane >> 3)) * 33 + 4 * (lane & 7); p[0] = v[i][0]; p[1] = v[i][1]; p[2] = v[i][2]; p[3] = v[i][3]; } }
    LDS_WAIT(); asm volatile("" ::: "memory");
    const int c = lane & 7;
#pragma unroll
    for (int j = 0; j < 4; ++j) { const int n = (lane >> 3) + 8 * j; const LAS float* s = scr + (8 * c) * 33 + n;
        u32x4 o; if (q) { o.x = pk2q(s[0 * 33], s[1 * 33]); o.y = pk2q(s[2 * 33], s[3 * 33]); o.z = pk2q(s[4 * 33], s[5 * 33]); o.w = pk2q(s[6 * 33], s[7 * 33]); }
        else { o.x = pk2(s[0 * 33], s[1 * 33]); o.y = pk2(s[2 * 33], s[3 * 33]); o.z = pk2(s[4 * 33], s[5 * 33]); o.w = pk2(s[6 * 33], s[7 * 33]); }
        *(u32x4*)(dst + (size_t)n * K + k0 + 8 * c) = o; }
    LDS_WAIT(); asm volatile("" ::: "memory");
}
__device__ __forceinline__ void p0_transpose_item8(const float* W, int ldw, int srccol0, int k0, unsigned char* dst, int K, LAS float* scr, int lane) {
    { f32x4 v[8];
#pragma unroll
      for (int i = 0; i < 8; ++i) v[i] = *(const f32x4*)(W + (size_t)(k0 + 8 * i + (lane >> 3)) * ldw + srccol0 + 4 * (lane & 7));
#pragma unroll
      for (int i = 0; i < 8; ++i) { LAS float* p = scr + (8 * i + (lane >> 3)) * 33 + 4 * (lane & 7); p[0] = v[i][0]; p[1] = v[i][1]; p[2] = v[i][2]; p[3] = v[i][3]; } }
    LDS_WAIT(); asm volatile("" ::: "memory");
    const int c = lane & 7;
#pragma unroll
    for (int j = 0; j < 4; ++j) { const int n = (lane >> 3) + 8 * j; const LAS float* s = scr + (8 * c) * 33 + n;
        u32x2 o; o.x = pk4_f8(s[0 * 33] * 32.f, s[1 * 33] * 32.f, s[2 * 33] * 32.f, s[3 * 33] * 32.f); o.y = pk4_f8(s[4 * 33] * 32.f, s[5 * 33] * 32.f, s[6 * 33] * 32.f, s[7 * 33] * 32.f);
        *(u32x2*)(dst + (size_t)n * K + k0 + 8 * c) = o; }
    LDS_WAIT(); asm volatile("" ::: "memory");
}
constexpr int TI_WIN = 32 * 168, TI_WA = 32, TI_WOUT = 32 * 64, TI_GU = 32 * 64, TI_DN = 16 * 64;
constexpr int TI_L = TI_WIN + TI_WA + TI_WOUT;
constexpr int TI_TOTAL = 2 * TI_L + 32 * TI_GU + 32 * TI_DN;
__device__ __forceinline__ void p0_item(KP Pk, Frame& F, int it, LAS float* scr) {
    unsigned char* ws = F.ws;
    if (it < 2 * TI_L) { const int l = it / TI_L; int r = it % TI_L;
        if (r < TI_WIN) { const int kb = r / 168, nb = r % 168, n0 = 32 * nb;
            if (WIN_F8_L(l)) p0_transpose_item8(Pk->in[I_WIN] + (size_t)l * D * DIN, DIN, n0 < 1536 ? n0 : n0 + 32, 64 * kb, ws + WS_WIN + (size_t)l * NU * D * 2 + (size_t)n0 * D, D, scr, F.lane);
            else p0_transpose_item(Pk->in[I_WIN] + (size_t)l * D * DIN, DIN, n0 < 1536 ? n0 : n0 + 32, 64 * kb, (bf16_t*)(ws + WS_WIN) + ((size_t)l * NU + n0) * D, D, scr, F.lane); return; }
        r -= TI_WIN;
        if (r < TI_WA) { if (WIN_F8_L(l)) p0_transpose_item8(Pk->in[I_WIN] + (size_t)l * D * DIN, DIN, 1536, 64 * r, ws + WS_WA + (size_t)l * 32 * D * 2, D, scr, F.lane);
            else p0_transpose_item(Pk->in[I_WIN] + (size_t)l * D * DIN, DIN, 1536, 64 * r, (bf16_t*)(ws + WS_WA) + (size_t)l * 32 * D, D, scr, F.lane); return; }
        r -= TI_WA;
        { const int kb = r / 64, nb = r % 64;
          if (WOUT_F8) p0_transpose_item8(Pk->in[I_WOUT] + (size_t)l * D * D, D, 32 * nb, 64 * kb, ws + WS_WOUT + ((size_t)l * D + 32 * nb) * D, D, scr, F.lane);
          else p0_transpose_item(Pk->in[I_WOUT] + (size_t)l * D * D, D, 32 * nb, 64 * kb, (bf16_t*)(ws + WS_WOUT) + ((size_t)l * D + 32 * nb) * D, D, scr, F.lane); return; }
    }
    it -= 2 * TI_L;
    if (it < 32 * TI_GU) { const int le = it / TI_GU, r = it % TI_GU, kb = r / 64, nb = r % 64, n0 = 32 * nb, j = n0 >> 8, half = (n0 >> 7) & 1, c0 = 128 * j + (n0 & 127);
        p0_transpose_item8((half ? Pk->in[I_EU] : Pk->in[I_EG]) + (size_t)le * D * DE, DE, c0, 64 * kb, ws + WS_WGU + ((size_t)le * 2048 + n0) * D, D, scr, F.lane); return; }
    it -= 32 * TI_GU;
    { const int le = it / TI_DN, r = it % TI_DN, kb = r / 64, nb = r % 64;
        p0_transpose_item8(Pk->in[I_ED] + (size_t)le * DE * D, D, 32 * nb, 64 * kb, ws + WS_WD + ((size_t)le * D + 32 * nb) * DE, DE, scr, F.lane); }
}
__device__ __forceinline__ void ada_unit(KP Pk, Frame& F, int u) {
    unsigned char* ws = F.ws;
    __syncthreads();
        LAS float* sc = (LAS float*)F.lds;
        LAS float* red = (LAS float*)(F.lds + 9 * 2048 * 4);
        for (int i = F.tid; i < 9 * 2048; i += NTHR) { const int r = i >> 11, k = i & 2047; const float v = r < 8 ? Pk->in[I_C][r * 2048 + k] : Pk->in[I_CCTX][k]; sc[i] = silu_f(v); }
        __syncthreads();
        const int l = u / 192, cb = u % 192, col = cb * 64 + (F.tid & 63), kp = F.wave;
        const float* W = Pk->in[I_ADAW] + (size_t)l * D * 12288 + col;
        float a[9];
#pragma unroll
        for (int r = 0; r < 9; ++r) a[r] = 0.f;
        for (int k = kp * 256; k < kp * 256 + 256; k += 64) {
            float w[64];
#pragma unroll
            for (int q = 0; q < 64; ++q) w[q] = W[(size_t)(k + q) * 12288];
#pragma unroll
            for (int q = 0; q < 64; ++q) {
#pragma unroll
                for (int r = 0; r < 9; ++r) a[r] += sc[r * 2048 + k + q] * w[q];
                if ((q & 3) == 3) __builtin_amdgcn_sched_barrier(0); }
        }
#pragma unroll
        for (int r = 0; r < 9; ++r) red[(kp * 9 + r) * 64 + (F.tid & 63)] = a[r];
        __syncthreads();
        for (int i = F.tid; i < 9 * 64; i += NTHR) { const int r = i >> 6, c = i & 63; float s = 0.f;
#pragma unroll
            for (int w = 0; w < 8; ++w) s += red[(w * 9 + r) * 64 + c];
            ((float*)(ws + WS_MOD))[((size_t)l * 9 + r) * 12288 + cb * 64 + c] = s + Pk->in[I_ADAB][l * 12288 + cb * 64 + c]; }
        VM_WAIT();
        __syncthreads();
        if (l == 0 && F.tid == 0) { __builtin_amdgcn_fence(__ATOMIC_RELEASE, "agent"); __hip_atomic_fetch_add(F.ctl + CW_ADAC, 1u, __ATOMIC_RELAXED, __HIP_MEMORY_SCOPE_AGENT); }
}
__device__ __forceinline__ void wait_ctr(Frame& F, int word, unsigned target) {
    if (F.tid == 0) { while (__hip_atomic_load(F.ctl + word, __ATOMIC_RELAXED, __HIP_MEMORY_SCOPE_AGENT) < target) __builtin_amdgcn_s_sleep(2); }
    __syncthreads();
    __builtin_amdgcn_fence(__ATOMIC_ACQUIRE, "agent");
}
__device__ __forceinline__ void ph_norm1_rows(KP Pk, Frame& F, int l, int first, int count, int stride);
__device__ __forceinline__ void ph_hyena_filters(KP Pk, Frame& F, int u);
constexpr int P0_NCV = (TI_WIN + TI_WA + 31) / 32, P0_U_ADA = 128, P0_U_CV = P0_U_ADA + 192, P0_U_N1 = P0_U_CV + P0_NCV, P0_UNITS = P0_U_N1 + 256;
__device__ __forceinline__ void p0_prologue(KP Pk, Frame& F, int rep) {
    unsigned char* ws = F.ws;
    const int gw = F.vcu * NWAVES + F.wave, NGW = F.G * NWAVES;
    for (int it = gw; it < 2 * 2304; it += NGW) { const int l = it / 2304, tt = it % 2304, L = tt < 2048 ? 2048 : 256, t = tt < 2048 ? tt : tt - 2048;
        const float tn = (float)t / (float)(L - 1), wv = (6.283185307179586f / (float)L) * (float)t;
        const float* w1 = Pk->in[I_HW1] + l * 33 * 64; const float* w2 = Pk->in[I_HW2] + l * 64 * 64;
        float zv = 0.f;
        if (F.lane == 0) zv = tn; else if (F.lane < 33) { const int bi = (F.lane - 1) & 15; const float band = 1e-4f + (float)bi * ((15.f - 1e-4f) / 15.f); zv = F.lane < 17 ? cosf(wv * band) : -sinf(wv * band); }
        float s = Pk->in[I_HB1][l * 64 + F.lane];
#pragma unroll
        for (int i = 0; i < 33; ++i) s += __shfl(zv, i) * w1[i * 64 + F.lane];
        const float h1 = sinf(Pk->in[I_HFR][(l * 2 + 0) * 64 + F.lane] * s);
        float s2 = Pk->in[I_HB2][l * 64 + F.lane];
#pragma unroll 16
        for (int i = 0; i < 64; ++i) s2 += __shfl(h1, i) * w2[i * 64 + F.lane];
        ((float*)(ws + WS_HYH2))[(size_t)it * 64 + F.lane] = sinf(Pk->in[I_HFR][(l * 2 + 1) * 64 + F.lane] * s2);
    }
    VM_WAIT();
    __syncthreads();
    if (F.tid == 0) { __builtin_amdgcn_fence(__ATOMIC_RELEASE, "agent"); __hip_atomic_fetch_add(F.ctl + CW_HYC, 1u, __ATOMIC_RELAXED, __HIP_MEMORY_SCOPE_AGENT); }
    for (int i = blockIdx.x * NTHR + F.tid; i < SEQ * 64; i += F.G * NTHR) { const int t = i >> 6, j = i & 63, q = j >> 4, f = j & 15;
        const float inv = exp2f(-(float)f * (13.287712379549449f / 16.f)); const float pos = (float)(q < 2 ? (t >> 6) : (t & 63)); const float ang = pos * inv;
        ((float*)(ws + WS_ROPE))[i] = (q & 1) ? sinf(ang) : cosf(ang); }
    for (;;) {
        const int u = wg_grab(F, rep ? 5 : 0); if (u >= P0_UNITS) break;
        if (u < P0_U_ADA) { wait_ctr(F, CW_HYC, (unsigned)F.G); ph_hyena_filters(Pk, F, u); }
        else if (u < P0_U_CV) ada_unit(Pk, F, u - P0_U_ADA);
        else if (u < P0_U_N1) { LAS float* scr = (LAS float*)(F.lds + F.wave * 8704);
            for (int j = 0; j < 4; ++j) { const int it = (u - P0_U_CV) * 32 + F.wave * 4 + j; if (it < TI_WIN + TI_WA) p0_item(Pk, F, it, scr); } }
        else { wait_ctr(F, CW_ADAC, 192u); ph_norm1_rows(Pk, F, 0, (u - P0_U_N1) * 72 + F.wave * 9, 9, 1); }
    }
}

#define MFMA16(a, b, c) __builtin_amdgcn_mfma_f32_16x16x32_bf16((a), (b), (c), 0, 0, 0)
#define MFMA32(a, b, c) __builtin_amdgcn_mfma_f32_32x32x16_bf16((a), (b), (c), 0, 0, 0)
__device__ __forceinline__ void load_row(const float* p, int lane, f32x4 (&v)[8]) {
#pragma unroll
    for (int j = 0; j < 8; ++j) v[j] = ((const f32x4*)p)[lane + 64 * j];
}
__device__ __forceinline__ void load_row_bf16(const bf16_t* p, int lane, f32x4 (&v)[8]) {
#pragma unroll
    for (int j = 0; j < 8; ++j) { const u32x2 a = ((const u32x2*)p)[lane + 64 * j]; v[j] = (f32x4){bflo(a.x), bfhi(a.x), bflo(a.y), bfhi(a.y)}; }
}
__device__ __forceinline__ void add_y2(const unsigned char* y0, const unsigned char* y1, const float* gf, int lane, f32x4 (&v)[8]) {
#pragma unroll
    for (int j = 0; j < 8; ++j) { const unsigned a = ((const unsigned*)y0)[lane + 64 * j], b = ((const unsigned*)y1)[lane + 64 * j]; const f32x4 g = ((const f32x4*)gf)[lane + 64 * j] * (1.f / 32.f);
        const f32x2 a0 = __builtin_amdgcn_cvt_pk_f32_fp8(a, false), a1 = __builtin_amdgcn_cvt_pk_f32_fp8(a, true), b0 = __builtin_amdgcn_cvt_pk_f32_fp8(b, false), b1 = __builtin_amdgcn_cvt_pk_f32_fp8(b, true);
        v[j][0] += g[0] * (a0[0] + b0[0]); v[j][1] += g[1] * (a0[1] + b0[1]); v[j][2] += g[2] * (a1[0] + b1[0]); v[j][3] += g[3] * (a1[1] + b1[1]); }
}
__device__ __forceinline__ float row_rstd(const f32x4 (&v)[8]) {
    float s = 0.f;
#pragma unroll
    for (int j = 0; j < 8; ++j) s += (v[j][0] * v[j][0] + v[j][1] * v[j][1]) + (v[j][2] * v[j][2] + v[j][3] * v[j][3]);
    return rsqrtf(wave_sum(s) * (1.f / D) + NORM_EPS);
}
__device__ __forceinline__ void modulate(f32x4 (&v)[8], float rstd, const float* nw, const float* sh, const float* sc, int lane) {
#pragma unroll
    for (int j = 0; j < 8; ++j) { const f32x4 w = ((const f32x4*)nw)[lane + 64 * j], a = ((const f32x4*)sc)[lane + 64 * j], b = ((const f32x4*)sh)[lane + 64 * j];
        v[j] = v[j] * rstd * w * (a + 1.f) + b; }
}
__device__ __forceinline__ void store_row_bf16(bf16_t* o, int lane, const f32x4 (&v)[8], bool q = false) {
#pragma unroll
    for (int j = 0; j < 8; ++j) { u32x2 w; if (q) { w.x = pk2q(v[j][0], v[j][1]); w.y = pk2q(v[j][2], v[j][3]); } else { w.x = pk2(v[j][0], v[j][1]); w.y = pk2(v[j][2], v[j][3]); } ((u32x2*)o)[lane + 64 * j] = w; }
}
__device__ __forceinline__ void store_row_f8(unsigned char* o, int lane, const f32x4 (&v)[8]) {
#pragma unroll
    for (int j = 0; j < 8; ++j) ((unsigned*)o)[lane + 64 * j] = pk4_f8(v[j][0], v[j][1], v[j][2], v[j][3]);
}
__device__ __forceinline__ void ph_norm1_rows(KP Pk, Frame& F, int l, int first, int count, int stride) {
    unsigned char* ws = F.ws;
    const float* mod = (const float*)(ws + WS_MOD) + (size_t)l * 9 * 12288;
    bf16_t* X = (bf16_t*)(ws + WS_X); bf16_t* H = (bf16_t*)(ws + WS_H); const unsigned char* Y2 = ws + WS_Y2;
    for (int i_ = 0; i_ < count; ++i_) { const int row = first + i_ * stride;
        const int r = modrow_of(row); f32x4 v[8];
        if (l == 0) load_row(row < TL ? Pk->in[I_X] + (size_t)row * D : Pk->in[I_CTX] + (size_t)(row - TL) * D, F.lane, v);
        else { load_row_bf16(X + (size_t)row * D, F.lane, v);
            add_y2(Y2 + (size_t)row * D, Y2 + ((size_t)TT + row) * D, (const float*)(ws + WS_MOD) + (size_t)r * 12288 + 5 * D, F.lane, v);
            if (row < TL) store_row_bf16(X + (size_t)row * D, F.lane, v); }
        const float rstd = row_rstd(v);
        modulate(v, rstd, Pk->in[I_N1W] + l * D, mod + (size_t)r * 12288, mod + (size_t)r * 12288 + D, F.lane);
        if (WIN_F8_L(l)) store_row_f8(ws + WS_H + (size_t)row * D, F.lane, v); else store_row_bf16(H + (size_t)row * D, F.lane, v);
    }
}
__device__ __forceinline__ void ph_hyena_filters(KP Pk, Frame& F, int u) {
    unsigned char* ws = F.ws;
    constexpr int HRS = 2052;
    LAS float* HR = (LAS float*)F.lds; LAS float* red = (LAS float*)(F.lds + 16 * HRS * 4);
    const int r16 = F.lane & 15, kg = F.lane >> 4;
    {
        const int lf = u >> 7, cg = u & 127, chl = r16 & 3, od = r16 >> 2, ch = cg * 4 + chl;
        const float* w3 = Pk->in[I_HW3] + (size_t)lf * 64 * 2048 + (od >> 1) * 1024 + (od & 1) * 512 + ch;
        bf16x8 wb[2];
#pragma unroll
        for (int ks = 0; ks < 2; ++ks) { float w[8];
#pragma unroll
            for (int j = 0; j < 8; ++j) w[j] = w3[(size_t)(32 * ks + 8 * kg + j) * 2048];
            u32x4 p; p.x = pk2(w[0], w[1]); p.y = pk2(w[2], w[3]); p.z = pk2(w[4], w[5]); p.w = pk2(w[6], w[7]); wb[ks] = __builtin_bit_cast(bf16x8, p); }
        const float dmin = 3.0701134573253940f, dmax = 15.350567286626972f, delta = dmin + (float)ch * ((dmax - dmin) / 511.f);
#pragma unroll 1
        for (int sel = 0; sel < 2; ++sel) {
            const int L = sel == 0 ? 2048 : 256; const float* h2 = (const float*)(ws + WS_HYH2) + ((size_t)lf * 2304 + (sel == 0 ? 0 : 2048)) * 64; const float rl = 1.f / (float)(L - 1);
            __syncthreads();
            float s = 0.f;
#pragma unroll 2
            for (int tile = F.wave; tile < L / 16; tile += NWAVES) {
                const f32x4* hp = (const f32x4*)(h2 + (size_t)(16 * tile + r16) * 64 + 8 * kg);
                const f32x4 a0 = hp[0], a1 = hp[1], a2 = hp[8], a3 = hp[9];
                u32x4 p0, p1; p0.x = pk2(a0[0], a0[1]); p0.y = pk2(a0[2], a0[3]); p0.z = pk2(a1[0], a1[1]); p0.w = pk2(a1[2], a1[3]); p1.x = pk2(a2[0], a2[1]); p1.y = pk2(a2[2], a2[3]); p1.z = pk2(a3[0], a3[1]); p1.w = pk2(a3[2], a3[3]);
                f32x4 d = MFMA16(__builtin_bit_cast(bf16x8, p0), wb[0], ((f32x4){0.f, 0.f, 0.f, 0.f})); d = MFMA16(__builtin_bit_cast(bf16x8, p1), wb[1], d);
                const int t0 = 16 * tile + 4 * kg;
#pragma unroll
                for (int i = 0; i < 4; ++i) { d[i] *= expf(-(float)(t0 + i) * rl * delta); s += fabsf(d[i]); }
                *(LAS f32x4*)(HR + r16 * HRS + t0) = d; }
            s += __shfl_xor(s, 16); s += __shfl_xor(s, 32);
            if (F.lane < 16) red[F.wave * 16 + F.lane] = s;
            __syncthreads();
            for (int e = F.tid; e < 16 * L; e += NTHR) { const int col = e / L, t = e % L, dir = (col >> 2) & 1, o = col >> 3, c = cg * 4 + (col & 3);
                float tot = 0.f;
#pragma unroll
                for (int w = 0; w < 8; ++w) tot += red[w * 16 + (col & ~4)] + red[w * 16 + (col | 4)];
                float hv = HR[col * HRS + t] / tot; int idx = dir == 0 ? L - t : L + t;
                if (dir == 1 && t == 0) { idx = 0; hv = 0.f; }
                ((bf16_t*)(ws + WS_HYF) + ((size_t)lf * 1024 + o * 512 + c) * 4608)[(sel == 0 ? 0 : 4096) + idx] = (bf16_t)f2bf(hv); }
        }
    }
}
__device__ __forceinline__ void ph_norm2_router(KP Pk, Frame& F, int l, int rep) {
    unsigned char* ws = F.ws;
    const int gw = F.vcu * NWAVES + F.wave, NGW = F.G * NWAVES, nrows = l == 0 ? TT : TL;
    const float* mod = (const float*)(ws + WS_MOD) + (size_t)l * 9 * 12288;
    const bf16_t* X = (const bf16_t*)(ws + WS_X); unsigned char* Fo = ws + WS_H;
    LAS float* rw = (LAS float*)F.lds;
    volatile LAS unsigned* lcnt = F.MISC + 16;
    if (F.tid < 16) lcnt[F.tid] = 0u;
    for (int i = F.tid; i < 2048 * 4; i += NTHR) { const f32x4 w = ((const f32x4*)Pk->in[I_RW])[i]; const int k = i >> 2, e0 = (i & 3) * 4;
        rw[(e0 + 0) * 2048 + k] = w[0]; rw[(e0 + 1) * 2048 + k] = w[1]; rw[(e0 + 2) * 2048 + k] = w[2]; rw[(e0 + 3) * 2048 + k] = w[3]; }
    __syncthreads();
    float rb[16];
#pragma unroll
    for (int e = 0; e < 16; ++e) rb[e] = Pk->in[I_RB][e];
    for (int rowA = gw; rowA < nrows; rowA += 2 * NGW) {
        const bool hasB = rowA + NGW < nrows; const int rowB = hasB ? rowA + NGW : rowA;
        f32x4 va[8], vb[8];
        load_row_bf16(X + (size_t)rowA * D, F.lane, va); load_row_bf16(X + (size_t)rowB * D, F.lane, vb);
        { const int r = modrow_of(rowA); const float rstd = row_rstd(va); modulate(va, rstd, Pk->in[I_N2W] + l * D, mod + (size_t)r * 12288 + 3 * D, mod + (size_t)r * 12288 + 4 * D, F.lane); store_row_f8(Fo + (size_t)rowA * D, F.lane, va); }
        { const int r = modrow_of(rowB); const float rstd = row_rstd(vb); modulate(vb, rstd, Pk->in[I_N2W] + l * D, mod + (size_t)r * 12288 + 3 * D, mod + (size_t)r * 12288 + 4 * D, F.lane); if (hasB) store_row_f8(Fo + (size_t)rowB * D, F.lane, vb); }
        float pa[32];
#pragma unroll
        for (int e = 0; e < 16; ++e) { float a = 0.f, b = 0.f;
#pragma unroll
            for (int j = 0; j < 8; ++j) { const f32x4 w = ((const LAS f32x4*)(rw + e * 2048))[F.lane + 64 * j];
                a += (va[j][0] * w[0] + va[j][1] * w[1]) + (va[j][2] * w[2] + va[j][3] * w[3]); b += (vb[j][0] * w[0] + vb[j][1] * w[1]) + (vb[j][2] * w[2] + vb[j][3] * w[3]); }
            pa[e] = a; pa[16 + e] = b; }
#define RB_STEP(N, BIT) { const bool up = (F.lane & (BIT)) != 0; _Pragma("unroll") for (int k = 0; k < (N); ++k) { const float keep = up ? pa[(N) + k] : pa[k], send = up ? pa[k] : pa[(N) + k]; pa[k] = keep + __shfl_xor(send, (BIT)); } }
        RB_STEP(16, 32) RB_STEP(8, 16) RB_STEP(4, 8) RB_STEP(2, 4) RB_STEP(1, 2)
#undef RB_STEP
        const float red = pa[0] + __shfl_xor(pa[0], 1);
        float lg[16];
#pragma unroll
        for (int e = 0; e < 16; ++e) lg[e] = __shfl(red, (F.lane & 32) + 2 * e);
        float mx = lg[0];
#pragma unroll
        for (int e = 1; e < 16; ++e) mx = fmaxf(mx, lg[e]);
        float sum = 0.f;
#pragma unroll
        for (int e = 0; e < 16; ++e) { lg[e] = expf(lg[e] - mx); sum += lg[e]; }
        const float rs = 1.f / sum; float sel[16];
#pragma unroll
        for (int e = 0; e < 16; ++e) { lg[e] *= rs; sel[e] = lg[e] + rb[e]; }
        int grp = 0; float gbest = fmaxf(fmaxf(sel[0], sel[1]), fmaxf(sel[2], sel[3]));
#pragma unroll
        for (int g = 1; g < 4; ++g) { const float gm = fmaxf(fmaxf(sel[4 * g], sel[4 * g + 1]), fmaxf(sel[4 * g + 2], sel[4 * g + 3])); if (gm > gbest) { gbest = gm; grp = g; } }
        float s4[4], p4[4];
#pragma unroll
        for (int i = 0; i < 4; ++i) { s4[i] = grp == 0 ? sel[i] : grp == 1 ? sel[4 + i] : grp == 2 ? sel[8 + i] : sel[12 + i]; p4[i] = grp == 0 ? lg[i] : grp == 1 ? lg[4 + i] : grp == 2 ? lg[8 + i] : lg[12 + i]; }
        int i0 = 0; float b0 = s4[0];
#pragma unroll
        for (int i = 1; i < 4; ++i) if (s4[i] > b0) { b0 = s4[i]; i0 = i; }
        int i1 = -1; float b1 = 0.f;
#pragma unroll
        for (int i = 0; i < 4; ++i) if (i != i0 && (i1 < 0 || s4[i] > b1)) { b1 = s4[i]; i1 = i; }
        const float p0 = i0 == 0 ? p4[0] : i0 == 1 ? p4[1] : i0 == 2 ? p4[2] : p4[3], p1 = i1 == 0 ? p4[0] : i1 == 1 ? p4[1] : i1 == 2 ? p4[2] : p4[3];
        const int e0 = grp * 4 + i0, e1 = grp * 4 + i1; const float ws_ = 1.f / (p0 + p1);
        if (F.lane == 0 || (F.lane == 32 && hasB)) { const int row = F.lane == 0 ? rowA : rowB;
            ((int*)(ws + WS_RT + RT_E))[row] = e0 | (e1 << 8); ((f32x2*)(ws + WS_RT + RT_W))[row] = (f32x2){p0 * ws_, p1 * ws_};
            __hip_atomic_fetch_add((LAS unsigned*)&lcnt[e0], 1u, __ATOMIC_RELAXED, __HIP_MEMORY_SCOPE_WORKGROUP); __hip_atomic_fetch_add((LAS unsigned*)&lcnt[e1], 1u, __ATOMIC_RELAXED, __HIP_MEMORY_SCOPE_WORKGROUP); }
    }
    __syncthreads();
    { int t_; asm volatile("v_mbcnt_lo_u32_b32 %0, -1, 0\n\tv_mbcnt_hi_u32_b32 %0, -1, %0" : "=v"(t_)); t_ += F.wave * 64;
      if (t_ < 16 && lcnt[t_]) __hip_atomic_fetch_add(F.ctl + CW_CNT + 64 * (l + 2 * rep) + t_, lcnt[t_], __ATOMIC_RELAXED, __HIP_MEMORY_SCOPE_AGENT); }
}
__device__ __forceinline__ int moe_table(Frame& F, int l) {
    volatile LAS unsigned char* pexp = (volatile LAS unsigned char*)(F.MISC + 64);
    __syncthreads();
    if (F.tid < 64) {
        const int e = F.lane & 15; const int c = (int)__hip_atomic_load(F.ctl + CW_CNT + 64 * l + e, __ATOMIC_RELAXED, __HIP_MEMORY_SCOPE_AGENT);
        const int np = (c + 255) >> 8; int p0 = np;
#pragma unroll
        for (int d = 1; d < 16; d <<= 1) { const int y = __shfl(p0, F.lane - d); if (e >= d) p0 += y; }
        const int tot = __shfl(p0, 15); p0 -= np;
        if (F.lane < 16) { F.MISC[32 + e] = (unsigned)(p0 * 256); for (int j = 0; j < np; ++j) pexp[p0 + j] = (unsigned char)e; if (e == 0) F.MISC[2] = (unsigned)tot; }
    }
    __syncthreads();
    return (int)F.MISC[2];
}
__device__ __forceinline__ void ph_slots(KP Pk, Frame& F, int l) {
    unsigned char* ws = F.ws;
    const int nrows = l == 0 ? TT : TL, per = (nrows + F.G - 1) / F.G, t0 = blockIdx.x * per, t1 = min(nrows, t0 + per);
    (void)moe_table(F, l);
    volatile LAS unsigned* lcnt = F.MISC + 16; volatile LAS unsigned* lbase = F.MISC + 48;
    if (F.tid < 16) lcnt[F.tid] = 0u;
    __syncthreads();
    const int* RE = (const int*)(ws + WS_RT + RT_E); const f32x2* RW = (const f32x2*)(ws + WS_RT + RT_W);
    int* ROWTOK = (int*)(ws + WS_RT + RT_ROWTOK); float* ROWW = (float*)(ws + WS_RT + RT_ROWW);
    const int tok = t0 + F.tid; int e0 = 0, e1 = 0; unsigned q0 = 0, q1 = 0;
    if (tok < t1) { const int ee = RE[tok]; e0 = ee & 255; e1 = ee >> 8;
        q0 = __hip_atomic_fetch_add((LAS unsigned*)&lcnt[e0], 1u, __ATOMIC_RELAXED, __HIP_MEMORY_SCOPE_WORKGROUP); q1 = __hip_atomic_fetch_add((LAS unsigned*)&lcnt[e1], 1u, __ATOMIC_RELAXED, __HIP_MEMORY_SCOPE_WORKGROUP); }
    __syncthreads();
    if (F.tid < 16) lbase[F.tid] = lcnt[F.tid] ? __hip_atomic_fetch_add(F.ctl + CW_CUR + 64 * l + F.tid, lcnt[F.tid], __ATOMIC_RELAXED, __HIP_MEMORY_SCOPE_AGENT) : 0u;
    __syncthreads();
    if (tok < t1) { const f32x2 w = RW[tok]; const int r0 = (int)(F.MISC[32 + e0] + lbase[e0] + q0), r1 = (int)(F.MISC[32 + e1] + lbase[e1] + q1);
        ROWTOK[r0] = tok; ROWW[r0] = w.x; ROWTOK[r1] = tok | (1 << 30); ROWW[r1] = w.y; }
    if (blockIdx.x < NE) { const int e = blockIdx.x, c = (int)__hip_atomic_load(F.ctl + CW_CNT + 64 * l + e, __ATOMIC_RELAXED, __HIP_MEMORY_SCOPE_AGENT), base = (int)F.MISC[32 + e];
        for (int i = c + F.tid; i < ((c + 255) & ~255); i += NTHR) { ROWTOK[base + i] = -1; ROWW[base + i] = 0.f; } }
}
__device__ __forceinline__ void ph_final(KP Pk, Frame& F) {
    unsigned char* ws = F.ws;
    const int gw = F.vcu * NWAVES + F.wave, NGW = F.G * NWAVES;
    const bf16_t* X = (const bf16_t*)(ws + WS_X); const unsigned char* Y2 = ws + WS_Y2;
    for (int row = gw; row < TL; row += NGW) { f32x4 v[8];
        load_row_bf16(X + (size_t)row * D, F.lane, v);
        add_y2(Y2 + (size_t)row * D, Y2 + ((size_t)TT + row) * D, (const float*)(ws + WS_MOD) + ((size_t)9 + (row >> 11)) * 12288 + 5 * D, F.lane, v);
#pragma unroll
        for (int j = 0; j < 8; ++j) ((f32x4*)(Pk->out + (size_t)row * D))[F.lane + 64 * j] = v[j]; }
}

__device__ __forceinline__ void ph_gate_cols(Frame& F, int l) {
    unsigned char* ws = F.ws;
    const int r32 = F.lane & 31, hi = F.lane >> 5;
    const bf16_t* H = (const bf16_t*)(ws + WS_H); const bf16_t* Wa = (const bf16_t*)(ws + WS_WA) + (size_t)l * 32 * D; float* AG = (float*)(ws + WS_AG);
    LAS unsigned char* tile = F.lds + F.wave * 16896;
    LAS float* red = (LAS float*)F.lds;
    for (int it = blockIdx.x; it < TT / 32; it += F.G) {
        const int kb = F.wave * 256;
        u32x4 av[16]; bf16x8 bv[16];
#pragma unroll
        for (int i = 0; i < 16; ++i) { const int id = F.lane + 64 * i; av[i] = *(const u32x4*)(H + (size_t)(it * 32 + (id >> 5)) * D + kb + 8 * (id & 31)); }
#pragma unroll
        for (int ks = 0; ks < 16; ++ks) bv[ks] = *(const bf16x8*)(Wa + (size_t)r32 * D + kb + 16 * ks + 8 * hi);
        __syncthreads();
#pragma unroll
        for (int i = 0; i < 16; ++i) { const int id = F.lane + 64 * i; *(LAS u32x4*)(tile + ((id >> 5) * 264 + 8 * (id & 31)) * 2) = av[i]; }
        f32x16 acc = {};
#pragma unroll
        for (int ks = 0; ks < 16; ++ks) { const bf16x8 a = *(const LAS bf16x8*)(tile + (r32 * 264 + 16 * ks + 8 * hi) * 2); acc = MFMA32(a, bv[ks], acc); }
        __syncthreads();
#pragma unroll
        for (int r = 0; r < 16; ++r) red[(F.wave * 16 + r) * 64 + F.lane] = acc[r];
        __syncthreads();
        for (int e = F.tid; e < 1024; e += NTHR) { float sum = 0.f;
#pragma unroll
            for (int w = 0; w < 8; ++w) sum += red[w * 1024 + e];
            const int r = e >> 6, ln = e & 63; AG[(size_t)(it * 32 + (r & 3) + 8 * (r >> 2) + 4 * (ln >> 5)) * 32 + (ln & 31)] = sum; }
    }
}

__device__ __forceinline__ void ph_gate_cols8(Frame& F, int l) {
    unsigned char* ws = F.ws;
    const int fr = F.lane & 15, fq = F.lane >> 4, kb = F.wave * 256;
    const unsigned char* H8 = ws + WS_H; const unsigned char* Wa8 = ws + WS_WA + (size_t)l * 32 * D * 2; float* AG = (float*)(ws + WS_AG);
    LAS f32x4* red = (LAS f32x4*)F.lds;
    int f8scale = 0x7f7f7f7f; asm volatile("" : "+v"(f8scale));
    i32x8 b[2][2], a[2][2];
#pragma unroll
    for (int ch = 0; ch < 2; ++ch)
#pragma unroll
        for (int ks = 0; ks < 2; ++ks) b[ch][ks] = *(const i32x8*)(Wa8 + (size_t)(16 * ch + fr) * D + kb + 128 * ks + 32 * fq);
    int it = blockIdx.x;
    if (it < TT / 32) {
#pragma unroll
        for (int rh = 0; rh < 2; ++rh)
#pragma unroll
            for (int ks = 0; ks < 2; ++ks) a[rh][ks] = *(const i32x8*)(H8 + (size_t)(it * 32 + 16 * rh + fr) * D + kb + 128 * ks + 32 * fq); }
    for (; it < TT / 32; it += F.G) {
        f32x4 acc[2][2];
#pragma unroll
        for (int rh = 0; rh < 2; ++rh)
#pragma unroll
            for (int ch = 0; ch < 2; ++ch) acc[rh][ch] = (f32x4){0.f, 0.f, 0.f, 0.f};
#pragma unroll
        for (int ks = 0; ks < 2; ++ks)
#pragma unroll
            for (int rh = 0; rh < 2; ++rh)
#pragma unroll
                for (int ch = 0; ch < 2; ++ch)
                    asm volatile("v_mfma_scale_f32_16x16x128_f8f6f4 %0, %1, %2, %0, %3, %3 op_sel_hi:[0,0,0]" : "+v"(acc[rh][ch]) : "v"(b[ch][ks]), "v"(a[rh][ks]), "v"(f8scale));
        asm volatile("s_nop 15\n\ts_nop 15" : "+v"(acc[0][0]), "+v"(acc[0][1]), "+v"(acc[1][0]), "+v"(acc[1][1]) :: "memory");
        const int nx = it + F.G;
        if (nx < TT / 32) {
#pragma unroll
            for (int rh = 0; rh < 2; ++rh)
#pragma unroll
                for (int ks = 0; ks < 2; ++ks) a[rh][ks] = *(const i32x8*)(H8 + (size_t)(nx * 32 + 16 * rh + fr) * D + kb + 128 * ks + 32 * fq); }
        __syncthreads();
#pragma unroll
        for (int rh = 0; rh < 2; ++rh)
#pragma unroll
            for (int ch = 0; ch < 2; ++ch) red[(F.wave * 4 + rh * 2 + ch) * 64 + F.lane] = acc[rh][ch];
        __syncthreads();
        for (int e = F.tid; e < 1024; e += NTHR) { float sum = 0.f;
#pragma unroll
            for (int w = 0; w < 8; ++w) sum += ((const LAS float*)red)[w * 1024 + e];
            const int blk = e >> 8, ln = (e >> 2) & 63, k = e & 3;
            AG[(size_t)(it * 32 + 16 * (blk >> 1) + (ln & 15)) * 32 + 16 * (blk & 1) + 4 * (ln >> 4) + k] = sum * (1.f / 32.f); }
    }
}

constexpr int WAVE_LDS = 17408;
__device__ __forceinline__ int perm16(int k) { return (k & 3) + 4 * ((k >> 3) & 1) + 8 * ((k >> 2) & 1); }
__device__ __forceinline__ int gla_kidx(int dir, int s) { return dir == 0 ? s : (s < LC ? LC - 1 - s : LC + (SEQ - 1 - (s - LC))); }
constexpr int GL_QT = 0, GL_KT = 1280, GL_KHT = 2560, GL_VT = 4096, GL_PT = 7168, GL_ST = 7936, GL_G = 13056, GL_GW = 13312, GL_GB = 15360;
__device__ __forceinline__ void gla_load_gates(KP Pk, Frame& F, int l, int h, int dir, LAS unsigned char* wl) {
    LAS float* gw = (LAS float*)(wl + GL_GW); LAS float* gb = (LAS float*)(wl + GL_GB);
    const float* src = Pk->in[I_GGW] + ((size_t)(l * 2 + dir) * 16) * 256 + h * 32;
#pragma unroll
    for (int i = 0; i < 8; ++i) { const int e = F.lane + 64 * i; gw[e] = src[(e >> 5) * 256 + (e & 31)]; }
    if (F.lane < 32) gb[F.lane] = Pk->in[I_GGB][(l * 2 + dir) * 256 + h * 32 + F.lane];
}
struct GlaIn { f32x4 ag[4]; u32x4 kv, qv, v0, v1; };
template <bool NEEDQ>
__device__ __forceinline__ void gla_sub_load(Frame& F, int b, int h, int dir, int kidx0, GlaIn& in) {
    unsigned char* ws = F.ws;
    int lane_o = F.lane; asm volatile("" : "+v"(lane_o));
    const int tau = lane_o & 15, dq = lane_o >> 4, row = keyrow(b, kidx0 + tau);
    const f32x4* ag = (const f32x4*)((const float*)(ws + WS_AG) + (size_t)row * 32 + dir * 16);
#pragma unroll
    for (int r4 = 0; r4 < 4; ++r4) in.ag[r4] = ag[r4];
    const bf16_t* U = (const bf16_t*)(ws + WS_U) + (size_t)row * NU;
    in.kv = *(const u32x4*)(U + UC_GK + h * 32 + dq * 8);
    if (NEEDQ) in.qv = *(const u32x4*)(U + UC_GQ + h * 32 + dq * 8);
    in.v0 = *(const u32x4*)(U + UC_GV + h * 64 + dq * 16); in.v1 = *(const u32x4*)(U + UC_GV + h * 64 + dq * 16 + 8);
}
template <bool NEEDQ>
__device__ __forceinline__ void gla_sub_prep(Frame& F, int dir, const GlaIn& in, LAS unsigned char* wl, float (&ltot)[8]) {
    int lane_o = F.lane; asm volatile("" : "+v"(lane_o));
    const int tau = lane_o & 15, dq = lane_o >> 4;
    const LAS float* gw = (const LAS float*)(wl + GL_GW) + dq * 8; const LAS float* gb = (const LAS float*)(wl + GL_GB) + dq * 8;
    const f32x4* ag = in.ag;
    float x[8];
    { const f32x4 b0 = *(const LAS f32x4*)gb, b1 = *(const LAS f32x4*)(gb + 4); x[0] = b0[0]; x[1] = b0[1]; x[2] = b0[2]; x[3] = b0[3]; x[4] = b1[0]; x[5] = b1[1]; x[6] = b1[2]; x[7] = b1[3]; }
#pragma unroll
    for (int r4 = 0; r4 < 4; ++r4) { const f32x4 av = ag[r4];
#pragma unroll
        for (int rr = 0; rr < 4; ++rr) { const f32x4 w0 = *(const LAS f32x4*)(gw + (4 * r4 + rr) * 32), w1 = *(const LAS f32x4*)(gw + (4 * r4 + rr) * 32 + 4);
            x[0] += av[rr] * w0[0]; x[1] += av[rr] * w0[1]; x[2] += av[rr] * w0[2]; x[3] += av[rr] * w0[3]; x[4] += av[rr] * w1[0]; x[5] += av[rr] * w1[1]; x[6] += av[rr] * w1[2]; x[7] += av[rr] * w1[3]; } }
#pragma unroll
    for (int j = 0; j < 8; ++j) x[j] = (fminf(x[j], 0.f) - __logf(1.f + __expf(-fabsf(x[j])))) * (1.f / 16.f);
#pragma unroll
    for (int dl = 1; dl < 16; dl <<= 1) { const int src = dir == 0 ? F.lane - dl : F.lane + dl; const bool ok = dir == 0 ? (tau >= dl) : (tau + dl <= 15);
#pragma unroll
        for (int j = 0; j < 8; ++j) { const float y = __shfl(x[j], src); x[j] += ok ? y : 0.f; } }
    float tot[8];
#pragma unroll
    for (int j = 0; j < 8; ++j) { tot[j] = __shfl(x[j], (lane_o & 48) + (dir == 0 ? 15 : 0)); ltot[j] += tot[j]; }
    const u32x4 kv = in.kv;
    const float kf[8] = {bflo(kv.x), bfhi(kv.x), bflo(kv.y), bfhi(kv.y), bflo(kv.z), bfhi(kv.z), bflo(kv.w), bfhi(kv.w)};
    float kt[8], kh[8];
#pragma unroll
    for (int j = 0; j < 8; ++j) { kt[j] = kf[j] * __expf(-x[j]); kh[j] = kf[j] * __expf(tot[j] - x[j]); }
    { u32x4 w; w.x = pk2(kt[0], kt[1]); w.y = pk2(kt[2], kt[3]); w.z = pk2(kt[4], kt[5]); w.w = pk2(kt[6], kt[7]); *(LAS u32x4*)(wl + GL_KT + (tau * 40 + dq * 8) * 2) = w; }
#pragma unroll
    for (int j = 0; j < 8; ++j) *(LAS unsigned short*)(wl + GL_KHT + ((dq * 8 + j) * 24 + tau) * 2) = (unsigned short)f2bf(kh[j]);
    if (NEEDQ) { const u32x4 qv = in.qv; const float sc = 0.17677669529663687f;
        const float qf[8] = {bflo(qv.x), bfhi(qv.x), bflo(qv.y), bfhi(qv.y), bflo(qv.z), bfhi(qv.z), bflo(qv.w), bfhi(qv.w)}; float qt[8];
#pragma unroll
        for (int j = 0; j < 8; ++j) qt[j] = qf[j] * sc * __expf(x[j]);
        u32x4 w; w.x = pk2(qt[0], qt[1]); w.y = pk2(qt[2], qt[3]); w.z = pk2(qt[4], qt[5]); w.w = pk2(qt[6], qt[7]); *(LAS u32x4*)(wl + GL_QT + (tau * 40 + dq * 8) * 2) = w; }
    if (tau == 0) {
#pragma unroll
        for (int j = 0; j < 8; ++j) ((LAS float*)(wl + GL_G))[dq * 8 + j] = __expf(tot[j]); }
    { const u32x4 v0 = in.v0, v1 = in.v1;
      const unsigned vw[8] = {v0.x, v0.y, v0.z, v0.w, v1.x, v1.y, v1.z, v1.w};
#pragma unroll
      for (int j = 0; j < 8; ++j) { *(LAS unsigned short*)(wl + GL_VT + ((dq * 16 + 2 * j) * 24 + tau) * 2) = (unsigned short)(vw[j] & 0xffffu); *(LAS unsigned short*)(wl + GL_VT + ((dq * 16 + 2 * j + 1) * 24 + tau) * 2) = (unsigned short)(vw[j] >> 16); } }
}
__device__ __forceinline__ void gla_state_update(Frame& F, LAS unsigned char* wl, f32x4 (&Sr)[2][4]) {
    int lane_o = F.lane; asm volatile("" : "+v"(lane_o));
    const int r16 = lane_o & 15, kg = lane_o >> 4; const bf16x8 zf = {0, 0, 0, 0, 0, 0, 0, 0};
    bf16x8 vb[4];
#pragma unroll
    for (int nb = 0; nb < 4; ++nb) { vb[nb] = *(const LAS bf16x8*)(wl + GL_VT + ((16 * nb + r16) * 24 + 8 * (kg & 1)) * 2); if (kg >= 2) vb[nb] = zf; }
#pragma unroll
    for (int db = 0; db < 2; ++db) { const f32x4 gv = *(const LAS f32x4*)(wl + GL_G + (16 * db + 4 * kg) * 4);
        bf16x8 ka = *(const LAS bf16x8*)(wl + GL_KHT + ((16 * db + r16) * 24 + 8 * (kg & 1)) * 2); if (kg >= 2) ka = zf;
#pragma unroll
        for (int nb = 0; nb < 4; ++nb) Sr[db][nb] = MFMA16(ka, vb[nb], Sr[db][nb] * gv); }
}
constexpr int GGRP = 6, NGRP = NCH / GGRP;
constexpr size_t WS_GGS = WS_GSS, WS_GGA = WS_GSS + 8 * MiB;
__device__ __forceinline__ void gla_pass_a(KP Pk, Frame& F, int l, int it, LAS unsigned char* wl) {
    unsigned char* ws = F.ws;
    const int seq = it / NGRP, g = it % NGRP, dir = seq & 1, h = (seq >> 1) & 7, b = seq >> 4, r16 = F.lane & 15, kg = F.lane >> 4;
    gla_load_gates(Pk, F, l, h, dir, wl);
    f32x4 Sr[2][4];
#pragma unroll
    for (int db = 0; db < 2; ++db)
#pragma unroll
        for (int nb = 0; nb < 4; ++nb) Sr[db][nb] = (f32x4){0.f, 0.f, 0.f, 0.f};
    float ltot[8] = {0.f, 0.f, 0.f, 0.f, 0.f, 0.f, 0.f, 0.f};
    GlaIn nin;
    { const int c0 = g * GGRP; gla_sub_load<false>(F, b, h, dir, (dir == 0 ? 64 * c0 : gla_kidx(1, 64 * c0) - 63) + 16 * (dir == 0 ? 0 : 3), nin); }
#pragma unroll 1
    for (int cg = 0; cg <= GGRP; ++cg) {
        const int c = g * GGRP + cg;
        float* sl = cg < GGRP ? (float*)(ws + WS_GSL) + ((size_t)seq * NCH + c) * 2048 : (float*)(ws + WS_GGS) + ((size_t)seq * NGRP + g) * 2048;
        float* al = cg < GGRP ? (float*)(ws + WS_GAE) + ((size_t)seq * NCH + c) * 32 : (float*)(ws + WS_GGA) + ((size_t)seq * NGRP + g) * 32;
#pragma unroll
        for (int db = 0; db < 2; ++db)
#pragma unroll
            for (int nb = 0; nb < 4; ++nb)
#pragma unroll
                for (int i = 0; i < 4; ++i) sl[(16 * db + 4 * kg + i) * 64 + 16 * nb + r16] = Sr[db][nb][i];
        if ((F.lane & 15) == 0) {
#pragma unroll
            for (int j = 0; j < 8; ++j) al[kg * 8 + j] = __expf(ltot[j]); }
        if (cg == GGRP) break;
#pragma unroll 1
        for (int st = 0; st < 4; ++st) {
            const GlaIn cur = nin;
            { const int q2 = cg * 4 + st + 1, c2 = g * GGRP + (q2 >> 2), st2 = q2 & 3, sb2 = dir == 0 ? st2 : 3 - st2;
              if (q2 < 4 * GGRP) gla_sub_load<false>(F, b, h, dir, (dir == 0 ? 64 * c2 : gla_kidx(1, 64 * c2) - 63) + 16 * sb2, nin); }
            gla_sub_prep<false>(F, dir, cur, wl, ltot);
            gla_state_update(F, wl, Sr); }
    }
}
__device__ __forceinline__ void gla_pass_b(KP Pk, Frame& F, int l, int b, int h, int c, LAS unsigned char* wl) {
    unsigned char* ws = F.ws;
    const int r16 = F.lane & 15, kg = F.lane >> 4, seq = (b * 8 + h) * 2; const bf16x8 zf = {0, 0, 0, 0, 0, 0, 0, 0};
    const bf16_t* U = (const bf16_t*)(ws + WS_U); unsigned char* MIX = ws + WS_H;
    u32x2 of[4][4];
#pragma unroll 1
    for (int dir = 0; dir < 2; ++dir) {
        gla_load_gates(Pk, F, l, h, dir, wl);
        const int cc = dir == 0 ? c : (c < 4 ? 3 - c : 39 - c);
        f32x4 Sr[2][4];
#pragma unroll
        for (int db = 0; db < 2; ++db)
#pragma unroll
            for (int nb = 0; nb < 4; ++nb) Sr[db][nb] = (f32x4){0.f, 0.f, 0.f, 0.f};
        { const int gsel = cc / GGRP;
#pragma unroll 1
          for (int gp = 0; gp <= gsel; ++gp) {
            const bool fin = gp == gsel;
            const float* sp = fin ? (const float*)(ws + WS_GSL) + ((size_t)(seq + dir) * NCH + cc) * 2048 : (const float*)(ws + WS_GGS) + ((size_t)(seq + dir) * NGRP + gp) * 2048;
            const float* apx = fin ? (const float*)(ws + WS_GAE) + ((size_t)(seq + dir) * NCH + cc) * 32 : (const float*)(ws + WS_GGA) + ((size_t)(seq + dir) * NGRP + gp) * 32;
#pragma unroll
            for (int db = 0; db < 2; ++db) { const f32x4 av = *(const f32x4*)(apx + 16 * db + 4 * kg);
#pragma unroll
                for (int nb = 0; nb < 4; ++nb)
#pragma unroll
                    for (int i = 0; i < 4; ++i) Sr[db][nb][i] = av[i] * Sr[db][nb][i] + sp[(16 * db + 4 * kg + i) * 64 + 16 * nb + r16]; } } }
        float ltot[8] = {0.f, 0.f, 0.f, 0.f, 0.f, 0.f, 0.f, 0.f};
#pragma unroll 1
        for (int st = 0; st < 4; ++st) { const int sb = dir == 0 ? st : 3 - st;
            int lane_o = F.lane; asm volatile("" : "+v"(lane_o)); const int r16 = lane_o & 15, kg = lane_o >> 4;
#pragma unroll
            for (int db = 0; db < 2; ++db)
#pragma unroll
                for (int nb = 0; nb < 4; ++nb) { u32x2 w; w.x = pk2(Sr[db][nb][0], Sr[db][nb][1]); w.y = pk2(Sr[db][nb][2], Sr[db][nb][3]); *(LAS u32x2*)(wl + GL_ST + ((16 * nb + r16) * 40 + 16 * db + 4 * kg) * 2) = w; }
            { GlaIn in; gla_sub_load<true>(F, b, h, dir, 64 * c + 16 * sb, in); gla_sub_prep<true>(F, dir, in, wl, ltot); }
            const bf16x8 bq = *(const LAS bf16x8*)(wl + GL_QT + (r16 * 40 + 8 * kg) * 2);
            { const bf16x8 ka = *(const LAS bf16x8*)(wl + GL_KT + (r16 * 40 + 8 * kg) * 2);
              f32x4 p = MFMA16(ka, bq, ((f32x4){0.f, 0.f, 0.f, 0.f}));
#pragma unroll
              for (int i = 0; i < 4; ++i) { const int sidx = 4 * kg + i; const bool keep = dir == 0 ? (sidx <= r16) : (sidx >= r16); p[i] = keep ? p[i] : 0.f; }
              u32x2 w; w.x = pk2(p[0], p[1]); w.y = pk2(p[2], p[3]); *(LAS u32x2*)(wl + GL_PT + (r16 * 24 + 4 * kg) * 2) = w; }
            bf16x8 pb = *(const LAS bf16x8*)(wl + GL_PT + (r16 * 24 + 8 * (kg & 1)) * 2); if (kg >= 2) pb = zf;
            f32x4 o[4];
#pragma unroll
            for (int nb = 0; nb < 4; ++nb) { const bf16x8 sa = *(const LAS bf16x8*)(wl + GL_ST + ((16 * nb + r16) * 40 + 8 * kg) * 2);
                bf16x8 va = *(const LAS bf16x8*)(wl + GL_VT + ((16 * nb + r16) * 24 + 8 * (kg & 1)) * 2); if (kg >= 2) va = zf;
                o[nb] = MFMA16(sa, bq, ((f32x4){0.f, 0.f, 0.f, 0.f})); o[nb] = MFMA16(va, pb, o[nb]); }
            if (dir == 0) { u32x2 t[4];
#pragma unroll
                for (int nb = 0; nb < 4; ++nb) { t[nb].x = pk2(o[nb][0], o[nb][1]); t[nb].y = pk2(o[nb][2], o[nb][3]); }
#define OF_PUT(k) { _Pragma("unroll") for (int nb = 0; nb < 4; ++nb) of[k][nb] = t[nb]; }
                if (sb == 0) OF_PUT(0) else if (sb == 1) OF_PUT(1) else if (sb == 2) OF_PUT(2) else OF_PUT(3)
#undef OF_PUT
            }
            else { float ss = 0.f; u32x2 t[4];
#define OF_GET(k) { _Pragma("unroll") for (int nb = 0; nb < 4; ++nb) t[nb] = of[k][nb]; }
                if (sb == 0) OF_GET(0) else if (sb == 1) OF_GET(1) else if (sb == 2) OF_GET(2) else OF_GET(3)
#undef OF_GET
#pragma unroll
                for (int nb = 0; nb < 4; ++nb) { o[nb][0] += bflo(t[nb].x); o[nb][1] += bfhi(t[nb].x); o[nb][2] += bflo(t[nb].y); o[nb][3] += bfhi(t[nb].y); ss += (o[nb][0] * o[nb][0] + o[nb][1] * o[nb][1]) + (o[nb][2] * o[nb][2] + o[nb][3] * o[nb][3]); }
                ss += __shfl_xor(ss, 16); ss += __shfl_xor(ss, 32);
                const float rstd = rsqrtf(ss * (1.f / 64.f) + NORM_EPS); const int row = keyrow(b, 64 * c + 16 * sb + r16);
#pragma unroll
                for (int nb = 0; nb < 4; ++nb) { const int dv0 = 16 * nb + 4 * kg; const u32x2 gg = *(const u32x2*)(U + (size_t)row * NU + UC_GG + h * 64 + dv0); const f32x4 nw = *(const f32x4*)(Pk->in[I_GNW] + l * 64 + dv0);
                    const float y0 = o[nb][0] * rstd * nw[0] * silu_f(bflo(gg.x)), y1 = o[nb][1] * rstd * nw[1] * silu_f(bfhi(gg.x)), y2 = o[nb][2] * rstd * nw[2] * silu_f(bflo(gg.y)), y3 = o[nb][3] * rstd * nw[3] * silu_f(bfhi(gg.y));
                    if (WOUT_F8) *(unsigned*)(MIX + ((size_t)row * D + h * 64 + dv0)) = pk4_f8(y0, y1, y2, y3);
                    else { u32x2 w; w.x = pk2(y0, y1); w.y = pk2(y2, y3); *(u32x2*)(MIX + ((size_t)row * D + h * 64 + dv0) * 2) = w; } } }
            if (st < 3) gla_state_update(F, wl, Sr);
        }
    }
}
__device__ __forceinline__ void prep_qk_row(KP Pk, Frame& F, int l, int row) {
    unsigned char* ws = F.ws;
    bf16_t* U = (bf16_t*)(ws + WS_U) + (size_t)row * NU;
    const bool lat = row < TL; const int t = row & (SEQ - 1), f = F.lane & 15;
    float cs = 1.f, sn = 0.f;
    if (lat) { const float* rp = (const float*)(ws + WS_ROPE) + (size_t)t * 64 + (F.lane < 32 ? 0 : 32); cs = rp[f]; sn = rp[16 + f]; if (!(F.lane & 16)) sn = -sn; }
    const float wsq = Pk->in[I_SQN][l * 64 + F.lane], wsk = Pk->in[I_SKN][l * 64 + F.lane], wdq = Pk->in[I_DQN][l * 64 + F.lane], wdk = Pk->in[I_DKN][l * 64 + F.lane];
    const float qs = 0.125f * LOG2E;
    float xs[26];
#pragma unroll
    for (int v = 0; v < 26; ++v) { const int c0 = v < 8 ? UC_SQ + 64 * v : v < 10 ? UC_SK + 64 * (v - 8) : v < 18 ? UC_DQ + 64 * (v - 10) : UC_DK + 64 * (v - 18); xs[v] = bf2f(U[c0 + F.lane]); }
#pragma unroll
    for (int v = 0; v < 26; ++v) {
        int c0; float w;
        if (v < 8) { c0 = UC_SQ + 64 * v; w = wsq * qs; } else if (v < 10) { c0 = UC_SK + 64 * (v - 8); w = wsk; } else if (v < 18) { c0 = UC_DQ + 64 * (v - 10); w = wdq * qs; } else { c0 = UC_DK + 64 * (v - 18); w = wdk; }
        const float x = xs[v];
        const float y = x * rsqrtf(wave_sum(x * x) * (1.f / 64.f) + NORM_EPS) * w;
        const float yp = __shfl_xor(y, 16);
        U[c0 + F.lane] = (bf16_t)f2bf(y * cs + yp * sn);
    }
}
template <bool PERMK, int NCOLS, class SRC>
__device__ __forceinline__ void tile_transpose(LAS unsigned char* wl, int lane, bf16_t* dst, size_t dst_stride, const SRC& src) {
    LAS unsigned* tl = (LAS unsigned*)wl;
    constexpr int ncols = NCOLS, cpr = NCOLS / 8;
    LDS_WAIT(); asm volatile("" ::: "memory");
#pragma unroll 1
    for (int k0 = 0; k0 < cpr; k0 += 4) { u32x4 v[4];
#pragma unroll
      for (int k = 0; k < 4; ++k) { const int id = lane + 64 * (k0 + k); v[k] = src(id / cpr, id % cpr); }
#pragma unroll
      for (int k = 0; k < 4; ++k) { const int id = lane + 64 * (k0 + k); LAS unsigned* p = tl + (id / cpr) * 65 + (id % cpr) * 4; p[0] = v[k].x; p[1] = v[k].y; p[2] = v[k].z; p[3] = v[k].w; } }
    LDS_WAIT(); asm volatile("" ::: "memory");
    const LAS unsigned short* ts = (const LAS unsigned short*)wl;
    const int cc = lane & 7;
    for (int dv = lane >> 3; dv < ncols; dv += 8) {
        unsigned short e[8];
#pragma unroll
        for (int i = 0; i < 8; ++i) { const int p = 8 * cc + i, srow = PERMK ? ((p & ~15) + perm16(p & 15)) : p; e[i] = ts[srow * 130 + dv]; }
        u32x4 o; o.x = e[0] | ((unsigned)e[1] << 16); o.y = e[2] | ((unsigned)e[3] << 16); o.z = e[4] | ((unsigned)e[5] << 16); o.w = e[6] | ((unsigned)e[7] << 16);
        *(u32x4*)(dst + (size_t)dv * dst_stride + 8 * cc) = o; }
}
__device__ __forceinline__ void ph_prep(KP Pk, Frame& F, int l, int rep) {
    unsigned char* ws = F.ws;
    const int gw = F.vcu * NWAVES + F.wave, NGW = F.G * NWAVES;
    LAS unsigned char* wl = F.lds + F.wave * WAVE_LDS;
    const bf16_t* U = (const bf16_t*)(ws + WS_U);
    const int n_gla = 128 * NGRP, n_hy = NB * (l == 0 ? 36 : 32) * 12, n_vd = NB * 4 * 36, n_vs = NB * 2 * 36, n_rows = rep ? 0 : TT / 4;
    if (gw < n_gla) { gla_pass_a(Pk, F, l, gw, wl); }
    const int total = n_hy + n_vd + n_vs + n_rows, nrest = NGW - n_gla;
    for (int it0 = gw - n_gla; it0 < total && gw >= n_gla; it0 += nrest) {
        int it = it0;
        if (it < n_hy) {
            const int ntile = l == 0 ? 36 : 32, b = it / (ntile * 12), r = it % (ntile * 12), tile = r / 12, cb = r % 12, c0 = cb * 128;
            const bool lat = tile < 32; const int p0 = lat ? 64 * tile : 64 * (tile - 32), Ls = lat ? SEQ : LC, rbase = lat ? b * SEQ : TL + b * LC;
            const float* cw = Pk->in[I_HCW] + (size_t)l * 3 * 1536 + c0 + (F.lane & 15) * 8; const float* cbias = Pk->in[I_HCB] + (size_t)l * 1536 + c0 + (F.lane & 15) * 8;
            float w0[8], w1[8], w2[8], wb[8];
#pragma unroll
            for (int k = 0; k < 8; ++k) { w0[k] = cw[k]; w1[k] = cw[1536 + k]; w2[k] = cw[3072 + k]; wb[k] = cbias[k]; }
            auto src = [&](int i, int ch) -> u32x4 { const int p = p0 + i; const bf16_t* up = U + (size_t)(rbase + p) * NU + UC_HY + c0 + ch * 8;
                const u32x4 m = *(const u32x4*)up; u32x4 a = {0u, 0u, 0u, 0u}, c = {0u, 0u, 0u, 0u};
                if (p > 0) a = *(const u32x4*)(up - NU); if (p + 1 < Ls) c = *(const u32x4*)(up + NU);
                const unsigned av[4] = {a.x, a.y, a.z, a.w}, mv[4] = {m.x, m.y, m.z, m.w}, cv[4] = {c.x, c.y, c.z, c.w}; unsigned o[4];
#pragma unroll
                for (int q = 0; q < 4; ++q) { const int k = 2 * q;
                    const float z0 = bflo(av[q]) * w0[k] + bflo(mv[q]) * w1[k] + bflo(cv[q]) * w2[k] + wb[k];
                    const float z1 = bfhi(av[q]) * w0[k + 1] + bfhi(mv[q]) * w1[k + 1] + bfhi(cv[q]) * w2[k + 1] + wb[k + 1];
                    o[q] = pk2(z0, z1); }
                return (u32x4){o[0], o[1], o[2], o[3]}; };
            tile_transpose<false, 128>(wl, F.lane, (bf16_t*)(ws + WS_ZT) + ((size_t)b * 1536 + c0) * KEYS + (lat ? p0 : SEQ + p0), KEYS, src);
            continue; } it -= n_hy;
        if (it < n_vd) {
            const int b = it / 144, r = it % 144, h = r / 36, tile = r % 36;
            auto src = [&](int i, int ch) -> u32x4 { return *(const u32x4*)(U + (size_t)keyrow(b, 64 * tile + i) * NU + UC_DV + h * 128 + ch * 8); };
            tile_transpose<true, 128>(wl, F.lane, (bf16_t*)(ws + WS_VTD) + ((size_t)(b * 4 + h) * 128) * KEYS + 64 * tile, KEYS, src);
            continue; } it -= n_vd;
        if (it < n_vs) {
            const int b = it / 72, r = it % 72, h = r / 36, tile = r % 36;
            auto src = [&](int i, int ch) -> u32x4 { return *(const u32x4*)(U + (size_t)keyrow(b, 64 * tile + i) * NU + UC_SV + h * 64 + ch * 8); };
            tile_transpose<true, 64>(wl, F.lane, (bf16_t*)(ws + WS_VTS) + ((size_t)(b * 2 + h) * 64) * KEYS + 64 * tile, KEYS, src);
            continue; } it -= n_vs;
        for (int q = 0; q < 4; ++q) prep_qk_row(Pk, F, l, it * 4 + q);
    }
}
__device__ __forceinline__ void ph_gla_scan(Frame& F) {
    unsigned char* ws = F.ws;
    const int gw = F.vcu * NWAVES + F.wave, NGW = F.G * NWAVES;
    for (int it = gw; it < 128 * 32; it += NGW) { const int seq = it >> 5, d = it & 31;
        const float* sl = (const float*)(ws + WS_GSL) + (size_t)seq * NCH * 2048 + d * 64 + F.lane; float* ss = (float*)(ws + WS_GSS) + (size_t)seq * NCH * 2048 + d * 64 + F.lane;
        const float* ae = (const float*)(ws + WS_GAE) + (size_t)seq * NCH * 32 + d;
        float x[NCH], a[NCH];
#pragma unroll
        for (int c = 0; c < NCH; ++c) { x[c] = sl[(size_t)c * 2048]; a[c] = ae[c * 32]; }
        float S = 0.f;
#pragma unroll
        for (int c = 0; c < NCH; ++c) { ss[(size_t)c * 2048] = S; S = a[c] * S + x[c]; }
    }
}

__device__ __forceinline__ int crow(int r, int hi) { return (r & 3) + 8 * (r >> 2) + 4 * hi; }
template <int KW, int DV, bool MASK>
__device__ __forceinline__ void attn_core(Frame& F, const bf16_t* U, int b, int kcol0, const bf16_t* VT, int nctx, int nloc, int loc0,
                                          const bf16x8 (&q)[4], int koff, int qpos0, float sh2, f32x16 (&O)[DV / 32], float& lsum) {
    constexpr int KRB = KW * 2, KB = 64 * KRB, VB = DV * 128, SLOT = KB + VB, NKC = KB / 8192, NVC = VB / 8192, NDMA = NKC + NVC;
    const int r32 = F.lane & 31, hi = F.lane >> 5, nt = nctx + nloc;
#define ATT_DMA(ti) do { const int _k0 = (ti) < nctx ? 64 * (ti) : loc0 + 64 * ((ti) - nctx); LAS unsigned char* _sl = F.lds + ((ti) & 3) * SLOT; \
        _Pragma("unroll") for (int _j = 0; _j < NKC; ++_j) { const int _ch = F.wave + 8 * _j; int _row, _c; \
            if (KW == 128) { _row = 4 * _ch + (F.lane >> 4); _c = (F.lane & 15) ^ (_row & 15); } else { _row = 8 * _ch + (F.lane >> 3); _c = (F.lane & 7) ^ ((_row >> 1) & 7); } \
            __builtin_amdgcn_global_load_lds((const unsigned*)(U + (size_t)keyrow(b, _k0 + _row) * NU + kcol0 + _c * 8), (LAS unsigned*)(_sl + _ch * 1024), 16, 0, 0); } \
        _Pragma("unroll") for (int _j = 0; _j < NVC; ++_j) { const int _ch = F.wave + 8 * _j, _row = 8 * _ch + (F.lane >> 3), _c = (F.lane & 7) ^ ((_row >> 1) & 7); \
            __builtin_amdgcn_global_load_lds((const unsigned*)(VT + (size_t)_row * KEYS + _k0 + _c * 8), (LAS unsigned*)(_sl + KB + _ch * 1024), 16, 0, 0); } } while (0)
    f32x16 s0, s1; bf16x8 pa[4];
#define DSR(dst, addr, off) asm volatile("ds_read_b128 %0, %1 offset:%2" : "=v"(dst) : "v"(addr), "n"(off))
#define LWAIT4(f) asm volatile("s_waitcnt lgkmcnt(0)" : "+v"(f[0]), "+v"(f[1]), "+v"(f[2]), "+v"(f[3]))
    unsigned kad[4], vad[4];
#pragma unroll
    for (int i = 0; i < 4; ++i) { const int c = 2 * i + hi;
        kad[i] = (unsigned)(uintptr_t)F.lds + (KW == 128 ? r32 * 256 + ((((koff >> 3) + c) ^ (r32 & 15)) << 4) : r32 * 128 + ((c ^ ((r32 >> 1) & 7)) << 4));
        vad[i] = (unsigned)(uintptr_t)F.lds + KB + r32 * 128 + ((c ^ ((r32 >> 1) & 7)) << 4); }
    __syncthreads();
    ATT_DMA(0);
    if (nt > 1) ATT_DMA(1);
    if (nt > 2) ATT_DMA(2);
    if (nt > 2) asm volatile("s_waitcnt vmcnt(%0)" :: "n"(NDMA) : "memory"); else asm volatile("s_waitcnt vmcnt(0)" ::: "memory");
    __syncthreads();
#define EXP1(ti, r) do { s0[r] = __builtin_amdgcn_exp2f(s0[r]); s1[r] = __builtin_amdgcn_exp2f(s1[r]); \
        if (MASK && (ti) >= nctx) { const int k0 = loc0 - LC + 64 * ((ti) - nctx) + crow(r, hi), k1 = k0 + 32, d0 = qpos0 + r32 - k0, d1 = d0 - 32; \
            if (k0 < 0 || k0 >= SEQ || d0 > 128 || d0 < -128) s0[r] = 0.f; if (k1 < 0 || k1 >= SEQ || d1 > 128 || d1 < -128) s1[r] = 0.f; } } while (0)
#define RD_K(f, h) do { DSR(f[0], ka[2 * (h)], 0); DSR(f[1], ka[2 * (h)], 32 * KRB); DSR(f[2], ka[2 * (h) + 1], 0); DSR(f[3], ka[2 * (h) + 1], 32 * KRB); } while (0)
#define RD_V(f, nb) do { DSR(f[0], va[0], (nb) * 4096); DSR(f[1], va[1], (nb) * 4096); DSR(f[2], va[2], (nb) * 4096); DSR(f[3], va[3], (nb) * 4096); } while (0)
#define SB() __builtin_amdgcn_sched_barrier(0)
#define PKW(S, B) pg8::cvt_pk_bf16(S[B], S[(B) + 1])
#define PV1(f, nb, kk, ti, R0, NE) do { O[nb] = MFMA32(pa[kk], f[kk], O[nb]); if (more) { _Pragma("unroll") for (int _r = 0; _r < (NE); ++_r) EXP1(ti, (R0) + _r); } SB(); } while (0)
    {
        bf16x8 fa[4], fb[4]; unsigned ka[4];
#pragma unroll
        for (int i = 0; i < 4; ++i) ka[i] = kad[i];
        RD_K(fa, 0); RD_K(fb, 1);
#pragma unroll
        for (int r = 0; r < 16; ++r) { s0[r] = -sh2; s1[r] = -sh2; }
        LWAIT4(fa); LWAIT4(fb);
        s0 = MFMA32(fa[0], q[0], s0); s1 = MFMA32(fa[1], q[0], s1); s0 = MFMA32(fa[2], q[1], s0); s1 = MFMA32(fa[3], q[1], s1);
        s0 = MFMA32(fb[0], q[2], s0); s1 = MFMA32(fb[1], q[2], s1); s0 = MFMA32(fb[2], q[3], s0); s1 = MFMA32(fb[3], q[3], s1);
#pragma unroll
        for (int r = 0; r < 16; ++r) EXP1(0, r);
    }
#define ATT_STEP(MORE) { \
        constexpr bool more = (MORE); \
        if (t + 3 < nt) ATT_DMA(t + 3); \
        unsigned ka[4], va[4]; \
        { int lo_ = F.lane; asm volatile("" : "+v"(lo_)); const int rr = lo_ & 31, hh = lo_ >> 5; \
        _Pragma("unroll") \
          for (int i = 0; i < 4; ++i) { const int c = 2 * i + hh; \
            ka[i] = (unsigned)(uintptr_t)F.lds + ((t + 1) & 3) * SLOT + (KW == 128 ? rr * 256 + ((((koff >> 3) + c) ^ (rr & 15)) << 4) : rr * 128 + ((c ^ ((rr >> 1) & 7)) << 4)); \
            va[i] = (unsigned)(uintptr_t)F.lds + (t & 3) * SLOT + KB + rr * 128 + ((c ^ ((rr >> 1) & 7)) << 4); } } \
        bf16x8 fa[4], fb[4]; \
        if (more) { RD_K(fa, 0); RD_K(fb, 1); } else { RD_V(fa, 0); } \
        SB(); \
 \
        { float ps = 0.f; \
        _Pragma("unroll") \
          for (int r = 0; r < 16; ++r) ps += s0[r] + s1[r]; \
          lsum += ps; \
          u32x4 w; \
          w.x = PKW(s0, 0); w.y = PKW(s0, 2); w.z = PKW(s0, 4); w.w = PKW(s0, 6); pa[0] = __builtin_bit_cast(bf16x8, w); \
          w.x = PKW(s0, 8); w.y = PKW(s0, 10); w.z = PKW(s0, 12); w.w = PKW(s0, 14); pa[1] = __builtin_bit_cast(bf16x8, w); \
          w.x = PKW(s1, 0); w.y = PKW(s1, 2); w.z = PKW(s1, 4); w.w = PKW(s1, 6); pa[2] = __builtin_bit_cast(bf16x8, w); \
          w.x = PKW(s1, 8); w.y = PKW(s1, 10); w.z = PKW(s1, 12); w.w = PKW(s1, 14); pa[3] = __builtin_bit_cast(bf16x8, w); } \
        if (more) { \
        _Pragma("unroll") \
            for (int r = 0; r < 16; ++r) { s0[r] = -sh2; s1[r] = -sh2; } \
        } \
        SB(); \
        if (more) { \
            LWAIT4(fa); LWAIT4(fb); \
            s0 = MFMA32(fa[0], q[0], s0); s1 = MFMA32(fa[1], q[0], s1); s0 = MFMA32(fa[2], q[1], s0); s1 = MFMA32(fa[3], q[1], s1); \
            SB(); RD_V(fa, 0); SB(); \
            s0 = MFMA32(fb[0], q[2], s0); s1 = MFMA32(fb[1], q[2], s1); s0 = MFMA32(fb[2], q[3], s0); s1 = MFMA32(fb[3], q[3], s1); \
            SB(); \
        } \
        LWAIT4(fa); RD_V(fb, 1); SB(); \
        if (DV == 128) { \
            PV1(fa, 0, 0, t + 1, 0, 1); PV1(fa, 0, 1, t + 1, 1, 1); PV1(fa, 0, 2, t + 1, 2, 1); PV1(fa, 0, 3, t + 1, 3, 1); \
            LWAIT4(fb); RD_V(fa, 2); SB(); \
            PV1(fb, 1, 0, t + 1, 4, 1); PV1(fb, 1, 1, t + 1, 5, 1); PV1(fb, 1, 2, t + 1, 6, 1); PV1(fb, 1, 3, t + 1, 7, 1); \
            LWAIT4(fa); RD_V(fb, 3); SB(); \
            PV1(fa, 2, 0, t + 1, 8, 1); PV1(fa, 2, 1, t + 1, 9, 1); PV1(fa, 2, 2, t + 1, 10, 1); PV1(fa, 2, 3, t + 1, 11, 1); \
            LWAIT4(fb); SB(); \
            PV1(fb, 3, 0, t + 1, 12, 1); PV1(fb, 3, 1, t + 1, 13, 1); PV1(fb, 3, 2, t + 1, 14, 1); PV1(fb, 3, 3, t + 1, 15, 1); \
        } else { \
            PV1(fa, 0, 0, t + 1, 0, 2); PV1(fa, 0, 1, t + 1, 2, 2); PV1(fa, 0, 2, t + 1, 4, 2); PV1(fa, 0, 3, t + 1, 6, 2); \
            LWAIT4(fb); SB(); \
            PV1(fb, 1, 0, t + 1, 8, 2); PV1(fb, 1, 1, t + 1, 10, 2); PV1(fb, 1, 2, t + 1, 12, 2); PV1(fb, 1, 3, t + 1, 14, 2); \
        } \
        if (t + 3 < nt) asm volatile("s_waitcnt vmcnt(%0)" :: "n"(NDMA) : "memory"); else asm volatile("s_waitcnt vmcnt(0)" ::: "memory"); \
        __syncthreads(); \
    }
    int t = 0;
#pragma unroll 1
    for (; t + 1 < nt; ++t) ATT_STEP(true)
    ATT_STEP(false)
#undef ATT_STEP
#undef EXP1
#undef SB
#undef PKW
#undef PV1
#undef RD_K
#undef RD_V
#undef DSR
#undef LWAIT4
#undef ATT_DMA
}
__device__ __forceinline__ float score_bound(const float* wq, const float* wk, int lane) {
    float a = fabsf(wq[lane]), c = fabsf(wk[lane]);
#pragma unroll
    for (int o = 1; o < 64; o <<= 1) { a = fmaxf(a, __shfl_xor(a, o)); c = fmaxf(c, __shfl_xor(c, o)); }
    return 64.f * a * c * 0.125f * LOG2E;
}
__device__ __forceinline__ void diff_unit(KP Pk, Frame& F, int l, int b, int h, int qrow0, int nkt) {
    unsigned char* ws = F.ws;
    const bf16_t* U = (const bf16_t*)(ws + WS_U);
    const int m = F.wave & 1, rb = F.wave >> 1;
    const float sh2 = score_bound(Pk->in[I_DQN] + l * 64, Pk->in[I_DKN] + l * 64, F.lane);
    bf16x8 q[4];
    { const bf16_t* qp = U + (size_t)(qrow0 + 32 * rb + (F.lane & 31)) * NU + UC_DQ + h * 128 + m * 64 + 8 * (F.lane >> 5);
#pragma unroll
      for (int ks = 0; ks < 4; ++ks) q[ks] = *(const bf16x8*)(qp + 16 * ks); }
    f32x16 O[4];
#pragma unroll
    for (int nb = 0; nb < 4; ++nb) O[nb] = (f32x16){};
    float lsum = 0.f;
    attn_core<128, 128, false>(F, U, b, UC_DK + h * 128, (const bf16_t*)(ws + WS_VTD) + ((size_t)(b * 4 + h) * 128) * KEYS, nkt, 0, 0, q, 64 * m, 0, sh2, O, lsum);
    int ln_; asm volatile("v_mbcnt_lo_u32_b32 %0, -1, 0\n\tv_mbcnt_hi_u32_b32 %0, -1, %0" : "=v"(ln_));
    const int r32 = ln_ & 31, hi = ln_ >> 5;
    { int lo_ = l; asm volatile("" : "+s"(lo_)); l = lo_; Pk = kp_opaque(Pk); }
    lsum += __shfl_xor(lsum, 32);
    const float rl = 1.f / lsum;
    LAS float* ex = (LAS float*)F.lds + rb * 4096;
    float rlr[16];
#pragma unroll
    for (int r = 0; r < 16; ++r) rlr[r] = __shfl(rl, crow(r, hi));
    if (m == 1) {
#pragma unroll
        for (int nb = 0; nb < 4; ++nb)
#pragma unroll
            for (int r = 0; r < 16; ++r) ex[crow(r, hi) * 128 + nb * 32 + r32] = O[nb][r] * rlr[r];
    }
    __syncthreads();
    if (m == 0) {
        const float* dl = Pk->in[I_DLAM] + l * 256; const float lam_init = __builtin_bit_cast(float, __builtin_amdgcn_readfirstlane(__builtin_bit_cast(int, l == 0 ? 0.2f : (0.8f - 0.6f * 0.74081822068f))));
        const float lam = expf(wave_sum(dl[ln_] * dl[64 + ln_])) - expf(wave_sum(dl[128 + ln_] * dl[192 + ln_])) + lam_init;
        float ssq[16];
#pragma unroll
        for (int r = 0; r < 16; ++r) { float a = 0.f;
#pragma unroll
            for (int nb = 0; nb < 4; ++nb) { const float v = O[nb][r] * rlr[r] - lam * ex[crow(r, hi) * 128 + nb * 32 + r32]; O[nb][r] = v; a += v * v; }
            a += __shfl_xor(a, 1); a += __shfl_xor(a, 2); a += __shfl_xor(a, 4); a += __shfl_xor(a, 8); a += __shfl_xor(a, 16);
            ssq[r] = rsqrtf(a * (1.f / 128.f) + NORM_EPS) * (1.f - lam_init); }
        unsigned char* mix = ws + WS_H + ((size_t)(qrow0 + 32 * rb) * D + 1536 + h * 128) * MIXB;
#pragma unroll
        for (int nb = 0; nb < 4; ++nb) { const float w = Pk->in[I_DSUB][l * 128 + nb * 32 + r32];
#pragma unroll
            for (int r = 0; r < 16; ++r) { const float y = O[nb][r] * ssq[r] * w; const size_t e = (size_t)crow(r, hi) * D + nb * 32 + r32; if (WOUT_F8) mix[e] = f8_1(y); else ((bf16_t*)mix)[e] = (bf16_t)f2bf(y); } }
    }
}
__device__ __forceinline__ void swa_unit(KP Pk, Frame& F, int l, int b, int kvh, int qrow0, int qpos0, bool latent) {
    unsigned char* ws = F.ws;
    const bf16_t* U = (const bf16_t*)(ws + WS_U);
    const int hq = kvh * 4 + (F.wave & 3), rb = F.wave >> 2;
    const float sh2 = score_bound(Pk->in[I_SQN] + l * 64, Pk->in[I_SKN] + l * 64, F.lane);
    bf16x8 q[4];
    { const bf16_t* qp = U + (size_t)(qrow0 + 32 * rb + (F.lane & 31)) * NU + UC_SQ + hq * 64 + 8 * (F.lane >> 5);
#pragma unroll
      for (int ks = 0; ks < 4; ++ks) q[ks] = *(const bf16x8*)(qp + 16 * ks); }
    f32x16 O[2]; O[0] = (f32x16){}; O[1] = (f32x16){};
    float lsum = 0.f;
    int nloc = 0, loc0 = 0;
    if (latent) { int kp0 = qpos0 - 128, kp1 = qpos0 + 64 + 128; if (kp0 < 0) kp0 = 0; if (kp1 > SEQ) kp1 = SEQ; nloc = (kp1 - kp0) / 64; loc0 = LC + kp0; }
    const bf16_t* VT = (const bf16_t*)(ws + WS_VTS) + ((size_t)(b * 2 + kvh) * 64) * KEYS;
    attn_core<64, 64, true>(F, U, b, UC_SK + kvh * 64, VT, 4, nloc, loc0, q, 0, qpos0 + 32 * rb, sh2, O, lsum);
    int ln_; asm volatile("v_mbcnt_lo_u32_b32 %0, -1, 0\n\tv_mbcnt_hi_u32_b32 %0, -1, %0" : "=v"(ln_));
    const int r32 = ln_ & 31, hi = ln_ >> 5;
    { int lo_ = l; asm volatile("" : "+s"(lo_)); l = lo_; Pk = kp_opaque(Pk); }
    lsum += __shfl_xor(lsum, 32);
    const float rl = 1.f / (lsum + exp2f(Pk->in[I_SINK][l * 8 + hq] * LOG2E - sh2));
    unsigned char* mix = ws + WS_H + ((size_t)(qrow0 + 32 * rb) * D + 512 + hq * 64) * MIXB;
#pragma unroll
    for (int r = 0; r < 16; ++r) { const float rr = __shfl(rl, crow(r, hi));
#pragma unroll
        for (int nb = 0; nb < 2; ++nb) { const float y = O[nb][r] * rr; const size_t e = (size_t)crow(r, hi) * D + nb * 32 + r32; if (WOUT_F8) mix[e] = f8_1(y); else ((bf16_t*)mix)[e] = (bf16_t)f2bf(y); } }
}
constexpr int HY_PAD = 224, YSTR = 2504, HY_YB = 8 * YSTR * 2, HY_CST = 8224, HY_COP = 2 * HY_YB;
__device__ __forceinline__ void hyena_unit(KP Pk, Frame& F, int l, int cg) {
    unsigned char* ws = F.ws;
    const int r32 = F.lane & 31, hi = F.lane >> 5, bb = r32 >> 2, ib = r32 & 3;
    const bf16_t* ZT = (const bf16_t*)(ws + WS_ZT); bf16_t* OT = (bf16_t*)(ws + WS_OT);
    LAS unsigned char* cop = F.lds + HY_COP;
    const int nseq = l == 0 ? 2 : 1;
#pragma unroll 1
    for (int cs = 0; cs < 4 * nseq; ++cs) {
        const int ci = cs >> (nseq - 1), st = cs & (nseq - 1), ch = cg * 4 + ci, L = st == 0 ? SEQ : LC, nblk = L / 32, pos0 = st == 0 ? 0 : SEQ;
        __syncthreads();
        for (int id = F.tid; id < 8 * (L / 8 + 56); id += NTHR) { const int b = id / (L / 8 + 56), c = id % (L / 8 + 56);
            if (c < L / 8) *(LAS u32x4*)(F.lds + (b * YSTR + HY_PAD + 8 * c) * 2) = *(const u32x4*)(ZT + ((size_t)b * 1536 + 1024 + ch) * KEYS + pos0 + 8 * c);
            else { const int pc = c - L / 8, off = pc < 28 ? 8 * pc : HY_PAD + L + 8 * (pc - 28); const u32x4 z = {0u, 0u, 0u, 0u};
                *(LAS u32x4*)(F.lds + (b * YSTR + off) * 2) = z; *(LAS u32x4*)(F.lds + HY_YB + (b * YSTR + off) * 2) = z; } }
#pragma unroll 1
        for (int o = 0; o < 2; ++o) {
            const bf16_t* R = (const bf16_t*)(ws + WS_HYF) + ((size_t)l * 1024 + o * 512 + ch) * 4608 + (st == 0 ? 0 : 4096);
            for (int xc = F.tid; xc < 2 * L / 8; xc += NTHR) { const u32x4 lo = *(const u32x4*)(R + 8 * xc); u32x4 hh = {0u, 0u, 0u, 0u}; if (8 * xc + 8 < 2 * L) hh = *(const u32x4*)(R + 8 * xc + 8);
                const unsigned w[9] = {lo.x, lo.y, lo.z, lo.w, hh.x, hh.y, hh.z, hh.w, 0u};
#pragma unroll
                for (int r = 0; r < 8; ++r) { u32x4 ov; unsigned t[4];
#pragma unroll
                    for (int k = 0; k < 4; ++k) t[k] = (r & 1) ? ((w[(r >> 1) + k] >> 16) | (w[(r >> 1) + k + 1] << 16)) : w[(r >> 1) + k];
                    ov.x = t[0]; ov.y = t[1]; ov.z = t[2]; ov.w = t[3]; *(LAS u32x4*)(cop + r * HY_CST + 16 * xc) = ov; } }
            __syncthreads();
            const LAS unsigned char* Yin = F.lds + (o == 0 ? 0 : HY_YB); LAS unsigned char* Yout = F.lds + (o == 0 ? HY_YB : 0);
            const float bias = Pk->in[I_HBIAS][(l * 2 + o) * 512 + ch];
            if (2 * F.wave < nblk / 4) {
                const int g0 = 2 * F.wave, dlo = 4 * g0 - nblk + 1, dhi = min(4 * g0 + 7, nblk - 1), nsteps = dhi - dlo + 1;
                const LAS unsigned char* ap = cop + ((-r32) & 7) * HY_CST + ((L - 32 * dlo - r32 + 8 * hi) & ~7) * 2;
                const LAS unsigned char* bp = Yin + (bb * YSTR + HY_PAD + 32 * (4 * g0 + ib - dlo) + 8 * hi) * 2;
                f32x16 acc0 = {}, acc1 = {};
#define HDSR(dst, addr, off) asm volatile("ds_read_b128 %0, %1 offset:%2" : "=v"(dst) : "v"(addr), "n"(off))
#define HWAIT(a, b, c, d) asm volatile("s_waitcnt lgkmcnt(0)" : "+v"(a), "+v"(b), "+v"(c), "+v"(d))
                bf16x8 R[6][2], A2[2][2];
                const unsigned apa = (unsigned)(uintptr_t)ap, bpa = (unsigned)(uintptr_t)bp;
                HDSR(R[2][0], bpa, 256); HDSR(R[2][1], bpa, 256 + 32); HDSR(R[3][0], bpa, 192); HDSR(R[3][1], bpa, 192 + 32);
                HDSR(R[4][0], bpa, 128); HDSR(R[4][1], bpa, 128 + 32); HDSR(R[5][0], bpa, 64); HDSR(R[5][1], bpa, 64 + 32);
                HDSR(R[0][0], bpa, 0); HDSR(R[0][1], bpa, 32); HDSR(A2[0][0], apa, 0); HDSR(A2[0][1], apa, 32);
                HWAIT(R[2][0], R[2][1], R[3][0], R[3][1]); HWAIT(R[4][0], R[4][1], R[5][0], R[5][1]); HWAIT(R[0][0], R[0][1], A2[0][0], A2[0][1]);
#pragma unroll 1
                for (int s0 = 0; s0 < nsteps; s0 += 6) {
                    const unsigned an = apa - (unsigned)(s0 + 6) * 64u, bn = bpa - (unsigned)(s0 + 6) * 64u;
#pragma unroll
                    for (int j = 0; j < 6; ++j) if (s0 + j < nsteps) {
                        if (s0 + j + 1 < nsteps) { HDSR(A2[(j + 1) & 1][0], an, (5 - j) * 64); HDSR(A2[(j + 1) & 1][1], an, (5 - j) * 64 + 32);
                            HDSR(R[(j + 1) % 6][0], bn, (5 - j) * 64); HDSR(R[(j + 1) % 6][1], bn, (5 - j) * 64 + 32); }
                        acc1 = MFMA32(A2[j & 1][0], R[(j + 2) % 6][0], acc1); acc0 = MFMA32(A2[j & 1][0], R[j][0], acc0);
                        acc1 = MFMA32(A2[j & 1][1], R[(j + 2) % 6][1], acc1); acc0 = MFMA32(A2[j & 1][1], R[j][1], acc0);
                        HWAIT(A2[(j + 1) & 1][0], A2[(j + 1) & 1][1], R[(j + 1) % 6][0], R[(j + 1) % 6][1]); }
                }
#undef HDSR
#undef HWAIT
#pragma unroll
                for (int gg = 0; gg < 2; ++gg) { const f32x16& acc = gg == 0 ? acc0 : acc1;
                    const int t0 = 32 * (4 * (g0 + gg) + ib) + 4 * hi;
                    const bf16_t* gp = ZT + ((size_t)bb * 1536 + o * 512 + ch) * KEYS + pos0 + t0;
#pragma unroll
                    for (int q = 0; q < 4; ++q) { const u32x2 yo = *(const LAS u32x2*)(Yin + (bb * YSTR + HY_PAD + t0 + 8 * q) * 2); const u32x2 gt = *(const u32x2*)(gp + 8 * q);
                        const float v0 = bflo(gt.x) * (acc[4 * q + 0] + bflo(yo.x) * bias), v1 = bfhi(gt.x) * (acc[4 * q + 1] + bfhi(yo.x) * bias);
                        const float v2 = bflo(gt.y) * (acc[4 * q + 2] + bflo(yo.y) * bias), v3 = bfhi(gt.y) * (acc[4 * q + 3] + bfhi(yo.y) * bias);
                        u32x2 ov; ov.x = pk2(v0, v1); ov.y = pk2(v2, v3);
                        if (o == 0) *(LAS u32x2*)(Yout + (bb * YSTR + HY_PAD + t0 + 8 * q) * 2) = ov;
                        else *(u32x2*)(OT + ((size_t)bb * 512 + ch) * KEYS + pos0 + t0 + 8 * q) = ov; } }
            }
            __syncthreads();
        }
    }
    VM_WAIT(); __syncthreads();
    const int npos = l == 0 ? KEYS : SEQ;
    for (int id = F.tid; id < 8 * npos; id += NTHR) { const int b = id / npos, pos = id % npos, row = pos < SEQ ? b * SEQ + pos : TL + b * LC + (pos - SEQ);
        const bf16_t* op = OT + ((size_t)b * 512 + cg * 4) * KEYS + pos;
        if (WOUT_F8) *(unsigned*)(ws + WS_H + (size_t)row * D + 1024 + cg * 4) = pk4_f8(bf2f(op[0]), bf2f(op[KEYS]), bf2f(op[2 * KEYS]), bf2f(op[3 * KEYS]));
        else { u32x2 ov; ov.x = (unsigned)op[0] | ((unsigned)op[KEYS] << 16); ov.y = (unsigned)op[2 * KEYS] | ((unsigned)op[3 * KEYS] << 16); *(u32x2*)((bf16_t*)(ws + WS_H) + (size_t)row * D + 1024 + cg * 4) = ov; } }
}
#ifndef MX_MASK
#define MX_MASK 15
#endif
#ifndef PROBE_MX
#define PROBE_MX 0
#endif
__device__ __forceinline__ void ph_mixers(KP Pk, Frame& F, int l, int qid) {
    const int n_diff = 512, n_hy = 128, n_dctx = l == 0 ? 64 : 0, n_swa = 512, n_sctx = l == 0 ? 64 : 0, gpb = l == 0 ? 5 : 4, n_gla = 64 * gpb;
    constexpr int R0 = 1 + ((PROBE_MX >> 0) & 1), R1 = 1 + ((PROBE_MX >> 1) & 1), R2 = 1 + ((PROBE_MX >> 2) & 1), R3 = 1 + ((PROBE_MX >> 3) & 1);
    const int n_mix = R0 * (n_diff + n_dctx) + R1 * n_hy + R2 * (n_swa + n_sctx) + R3 * n_gla + (l == 0 ? 192 + 128 : 0);
    const int n_titems = 16 * TI_GU + 16 * TI_DN + TI_WOUT + (l == 0 ? TI_WIN + TI_WA : 0), NTU = (n_titems + 127) / 128;
    const int total = n_mix + NTU, tplaced = min(NTU, total / 4);
    for (;;) {
        const int s_ = wg_grab(F, qid); if (s_ >= total) break;
        int u = s_ - min(NTU, s_ / 4), tu = -1;
        if ((s_ & 3) == 3 && (s_ >> 2) < NTU) tu = s_ >> 2; else if (u >= n_mix) tu = tplaced + (u - n_mix);
        if (tu >= 0) { LAS float* scr = (LAS float*)(F.lds + F.wave * 8704);
            for (int j = 0; j < 16; ++j) { int x = tu * 128 + F.wave * 16 + j; if (x >= n_titems) break;
                int it;
                if (x < 16 * TI_GU) it = 2 * TI_L + l * 16 * TI_GU + x;
                else if ((x -= 16 * TI_GU) < 16 * TI_DN) it = 2 * TI_L + 32 * TI_GU + l * 16 * TI_DN + x;
                else if ((x -= 16 * TI_DN) < TI_WOUT) it = l * TI_L + TI_WIN + TI_WA + x;
                else it = TI_L + (x - TI_WOUT);
                p0_item(Pk, F, it, scr); }
            goto mx_next; }
        if (l == 0) { if (u < 192) { ada_unit(Pk, F, 192 + u); goto mx_next; } u -= 192;
                      if (u < 128) { ph_hyena_filters(Pk, F, 128 + u); goto mx_next; } u -= 128; }
        if (u < R1 * n_hy) { u %= n_hy; if (MX_MASK & 2) hyena_unit(Pk, F, l, u); goto mx_next; } u -= R1 * n_hy;
        if (u < R0 * n_diff) { u %= n_diff; const int b = u >> 6, h = (u >> 4) & 3, qb = u & 15; if (MX_MASK & 1) diff_unit(Pk, F, l, b, h, b * SEQ + 128 * qb, 36); goto mx_next; } u -= R0 * n_diff;
        if (u < R0 * n_dctx) { u %= n_dctx; const int b = u >> 3, h = (u >> 1) & 3, qb = u & 1; if (MX_MASK & 1) diff_unit(Pk, F, l, b, h, TL + b * LC + 128 * qb, 4); goto mx_next; } u -= R0 * n_dctx;
        if (u < R2 * n_swa) { u %= n_swa; const int b = u >> 6, kvh = (u >> 5) & 1, qb = u & 31; if (MX_MASK & 4) swa_unit(Pk, F, l, b, kvh, b * SEQ + 64 * qb, 64 * qb, true); goto mx_next; } u -= R2 * n_swa;
        if (u < R2 * n_sctx) { u %= n_sctx; const int b = u >> 3, kvh = (u >> 2) & 1, qb = u & 3; if (MX_MASK & 4) swa_unit(Pk, F, l, b, kvh, TL + b * LC + 64 * qb, 64 * qb, false); goto mx_next; } u -= R2 * n_sctx;
        { u %= n_gla; const int bh = u / gpb, grp = u % gpb, c = (l == 0 ? 0 : 4) + grp * 8 + F.wave;
          __syncthreads();
          if ((MX_MASK & 8) && c < NCH) gla_pass_b(Pk, F, l, bh >> 3, bh & 7, c, F.lds + F.wave * WAVE_LDS);
        }
mx_next: ;
    }
}

constexpr int N_PHASES = 22;
#ifndef PH_MASK
#define PH_MASK 0xfffu
#endif
__global__ void __launch_bounds__(NTHR, 2) fwd_kernel(Params Parg) {
    extern __shared__ __attribute__((aligned(16))) unsigned char lds_raw[];
    const KP P0 = (KP)__builtin_amdgcn_kernarg_segment_ptr();
    Frame F;
    F.lds = (LAS unsigned char*)lds_raw; F.MISC = (volatile LAS unsigned*)(F.lds + LDS_MISC);
    const int wave_s = __builtin_amdgcn_readfirstlane((int)threadIdx.x >> 6);
#define TID_REFRESH() do { int t_; asm volatile("v_mbcnt_lo_u32_b32 %0, -1, 0\n\tv_mbcnt_hi_u32_b32 %0, -1, %0" : "=v"(t_)); F.lane = t_; F.wave = wave_s; F.tid = wave_s * 64 + t_; } while (0)
    TID_REFRESH();
    F.G = gridDim.x; { const int bx = blockIdx.x; F.vcu = (F.G % 8 == 0) ? (bx % 8) * (F.G / 8) + bx / 8 : bx; }
    F.ws = P0->ws; F.ctl = (unsigned*)(P0->ws + WS_CTL);
    for (int u = F.tid; u < 128; u += NTHR) F.MISC[u] = 0u;
    __syncthreads();
    const int lo = P0->ph_lo, hi = P0->ph_hi;
    const bool multi = hi - lo > 1;
    XcdBarrier bar; bar.bar = F.ctl + CW_BAR; bar.x = 0; bar.st = nullptr;
    if (multi) bar = xcd_barrier_post(F.ctl + CW_BAR, F.MISC + 8, F.tid);
#define INR(k) (lo <= (k) && (k) < hi)
#define IN(k, kind) (((PH_MASK >> (kind)) & 1u) && INR(k))
#define SEAM(k) do { if (INR(k) && INR((k) + 1)) { bar.bar = (unsigned*)(kp_opaque(P0)->ws + WS_CTL) + CW_BAR; TID_REFRESH(); xcd_barrier(bar, F.tid); } } while (0)
#ifndef PROBE_MASK
#define PROBE_MASK 0u
#endif
#define REP(kind) for (int rep_ = 0; rep_ < (((PROBE_MASK >> (kind)) & 1u) ? 2 : 1); ++rep_)
#define REP_SYNC(kind) do { if (((PROBE_MASK >> (kind)) & 1u) && rep_ == 0 && multi) { TID_REFRESH(); xcd_barrier(bar, F.tid); } } while (0)
#define PHASE_BEGIN() const KP Pk = kp_opaque(P0); unsigned char* ws = Pk->ws; F.ws = ws; F.ctl = (unsigned*)(ws + WS_CTL); \
    TID_REFRESH()
    if (IN(0, 0)) REP(0) { PHASE_BEGIN(); p0_prologue(Pk, F, rep_); REP_SYNC(0); } SEAM(0);
#pragma unroll 1
    for (int l = 0; l < DEPTH; ++l) {
        const int pb = 1 + 10 * l;
        if (l > 0) { if (IN(pb + 0, 1)) { PHASE_BEGIN(); const int gw = F.vcu * NWAVES + F.wave, NGW = F.G * NWAVES; ph_norm1_rows(Pk, F, l, gw, (TT - gw + NGW - 1) / NGW, NGW); } SEAM(pb + 0); }
        if (IN(pb + 1, 2)) REP(2) { PHASE_BEGIN();
            pg8::Gemm g{(const bf16_t*)(ws + WS_H), (const bf16_t*)(ws + WS_WIN + (size_t)l * NU * D * 2), D, nullptr};
            pg8::RectOrder S; if (l == 0) S.init(72, 21, F.G, (int)blockIdx.x, 0, 0, 0ull); else S.init(64, 21, F.G, (int)blockIdx.x, 64, 64, 0x1413121108030201ull);
            pg8::EpiU E{(bf16_t*)(ws + WS_U), WIN_F8_L(l) ? 1.f / 32.f : 1.f};
            if (WIN_F8_L(l)) pg8::gemm_phase<pg8::EpiU, pg8::RectOrder, false, true>(F.lds, g, S, E, F.tid);
            else pg8::gemm_phase<pg8::EpiU, pg8::RectOrder, false, false>(F.lds, g, S, E, F.tid);
            if (WIN_F8_L(l)) ph_gate_cols8(F, l); else ph_gate_cols(F, l); REP_SYNC(2);
        } SEAM(pb + 1);
        if (IN(pb + 2, 3)) REP(3) { PHASE_BEGIN(); ph_prep(Pk, F, l, rep_); REP_SYNC(3); } SEAM(pb + 2);
        if (IN(pb + 4, 5)) REP(5) { PHASE_BEGIN(); ph_mixers(Pk, F, l, 1 + l + 2 * rep_); REP_SYNC(5); } SEAM(pb + 4);
        if (IN(pb + 5, 6)) REP(6) { if (rep_ && l) break; PHASE_BEGIN();
            pg8::Gemm g{(const bf16_t*)(ws + WS_H), (const bf16_t*)(ws + WS_WOUT + (size_t)l * D * D * MIXB), D, nullptr};
            pg8::RectOrder S; S.init(l == 0 ? 72 : 64, 8, F.G, (int)blockIdx.x, 0, 0, 0ull);
            pg8::EpiWout E{Pk->in[I_X], Pk->in[I_CTX], l == 0 ? (const bf16_t*)nullptr : (const bf16_t*)(ws + WS_X), (bf16_t*)(ws + WS_X), (const float*)(ws + WS_MOD) + (size_t)l * 9 * 12288};
            pg8::gemm_phase<pg8::EpiWout, pg8::RectOrder, false, WOUT_F8>(F.lds, g, S, E, F.tid); REP_SYNC(6);
        } SEAM(pb + 5);
        if (IN(pb + 6, 7)) REP(7) { PHASE_BEGIN(); ph_norm2_router(Pk, F, l, rep_); REP_SYNC(7); } SEAM(pb + 6);
        if (IN(pb + 7, 8)) { PHASE_BEGIN(); ph_slots(Pk, F, l); } SEAM(pb + 7);
        if (IN(pb + 8, 9)) REP(9) { PHASE_BEGIN();
            const int np = moe_table(F, l);
            pg8::Gemm g{(const bf16_t*)(ws + WS_H), (const bf16_t*)(ws + WS_WGU + (size_t)l * NE * 2048 * D), D, (const int*)(ws + WS_RT + RT_ROWTOK)};
            pg8::MoeOrder S{np, F.G, F.vcu, (const volatile LAS unsigned char*)(F.MISC + 64)};
            pg8::EpiMoe1 E{ws + WS_U};
            pg8::gemm_phase<pg8::EpiMoe1, pg8::MoeOrder, true, true>(F.lds, g, S, E, F.tid); REP_SYNC(9);
        } SEAM(pb + 8);
        if (IN(pb + 9, 10)) REP(10) { PHASE_BEGIN();
            const int np = moe_table(F, l);
            pg8::Gemm g{(const bf16_t*)(ws + WS_U), (const bf16_t*)(ws + WS_WD + (size_t)l * NE * D * DE), DE, nullptr};
            pg8::MoeOrder S{np, F.G, F.vcu, (const volatile LAS unsigned char*)(F.MISC + 64)};
            pg8::EpiMoe2 E{ws + WS_Y2, (const int*)(ws + WS_RT + RT_ROWTOK), (const float*)(ws + WS_RT + RT_ROWW)};
            pg8::gemm_phase<pg8::EpiMoe2, pg8::MoeOrder, false, true>(F.lds, g, S, E, F.tid); REP_SYNC(10);
        } SEAM(pb + 9);
    }
    if (IN(21, 11)) REP(11) { PHASE_BEGIN(); ph_final(Pk, F); REP_SYNC(11); }
#undef IN
#undef INR
#undef SEAM
#undef PHASE_BEGIN
#undef REP
#undef REP_SYNC
#undef TID_REFRESH
}

#ifndef MK_PER_PHASE
#define MK_PER_PHASE 0
#endif
extern "C" void kernel_launch(void* const* d_in, const int* in_sizes, int n_in, void* d_out, int out_size, void* d_ws, size_t ws_size, hipStream_t stream) {
    static int grid = 0;
    if (grid == 0) {
        if (n_in != 34 || in_sizes[0] != TL * D || out_size != TL * D || ws_size < WS_END) { fprintf(stderr, "kernel_launch: unexpected shapes (n_in %d, in0 %d, out %d, ws %zu < %zu)\n", n_in, n_in > 0 ? in_sizes[0] : -1, out_size, ws_size, (size_t)WS_END); grid = -1; return; }
        int dev = 0, cus = 0, per_cu = 0;
        if (hipGetDevice(&dev) != hipSuccess || hipDeviceGetAttribute(&cus, hipDeviceAttributeMultiprocessorCount, dev) != hipSuccess) { grid = -1; return; }
        if (hipFuncSetAttribute((const void*)fwd_kernel, hipFuncAttributeMaxDynamicSharedMemorySize, LDS_BYTES) != hipSuccess) { fprintf(stderr, "kernel_launch: hipFuncSetAttribute failed\n"); grid = -1; return; }
        if (hipOccupancyMaxActiveBlocksPerMultiprocessor(&per_cu, (const void*)fwd_kernel, NTHR, LDS_BYTES) != hipSuccess || per_cu < 1) fprintf(stderr, "kernel_launch: occupancy query reports %d\n", per_cu);
        (void)hipGetLastError();
        grid = cus;
    }
    if (grid < 0) return;
    (void)hipMemsetAsync((char*)d_ws + WS_CTL, 0, CTL_BYTES, stream);
    Params p{};
    for (int i = 0; i < 34; ++i) p.in[i] = (const float*)d_in[i];
    p.out = (float*)d_out; p.ws = (unsigned char*)d_ws;
#if MK_PER_PHASE
    for (int k = 0; k < N_PHASES; ++k) { p.ph_lo = k; p.ph_hi = k + 1; hipLaunchKernelGGL(fwd_kernel, dim3(grid), dim3(NTHR), LDS_BYTES, stream, p); }
#else
    p.ph_lo = 0; p.ph_hi = N_PHASES; hipLaunchKernelGGL(fwd_kernel, dim3(grid), dim3(NTHR), LDS_BYTES, stream, p);
#endif
    const hipError_t le = hipPeekAtLastError();
    if (le != hipSuccess) fprintf(stderr, "kernel_launch: launch failed: %s\n", hipGetErrorName(le));
}
```

```cpp
#include <hip/hip_runtime.h>
#include <cstdio>
#include <cstdint>

#define LAS __attribute__((address_space(3)))
#define GAS __attribute__((address_space(1)))
typedef unsigned short bf16_t;
typedef short bf16x8 __attribute__((ext_vector_type(8)));
typedef float f32x2 __attribute__((ext_vector_type(2)));
typedef float f32x4 __attribute__((ext_vector_type(4)));
typedef float f32x16 __attribute__((ext_vector_type(16)));
typedef unsigned u32x2 __attribute__((ext_vector_type(2)));
typedef unsigned u32x4 __attribute__((ext_vector_type(4)));
typedef int i32x4 __attribute__((ext_vector_type(4)));
typedef int i32x8 __attribute__((ext_vector_type(8)));

constexpr int D = 2048, NB = 8, SEQ = 2048, LC = 256, DEPTH = 2;
constexpr int TL = NB * SEQ, TCX = NB * LC, TT = TL + TCX;
constexpr int DIN = 5408, NU = 5376, NE = 16, DE = 1024;
constexpr int KEYS = LC + SEQ;
constexpr int UC_GQ = 0, UC_GK = 256, UC_GV = 512, UC_GG = 1024, UC_SQ = 1536, UC_SK = 2048, UC_SV = 2176, UC_HY = 2304, UC_DQ = 3840, UC_DK = 4352, UC_DV = 4864;
constexpr int MOE_ROWS = 2 * TT + NE * 256;
constexpr int MOE_PANELS = MOE_ROWS / 256;
constexpr int GCH = 64, NCH = KEYS / GCH;
constexpr float NORM_EPS = 1e-6f;
constexpr float LOG2E = 1.4426950408889634f;

constexpr size_t MiB = 1u << 20;
constexpr size_t WS_CTL = 0, CTL_BYTES = 1 * MiB;
constexpr size_t WS_MOD = 1 * MiB;
constexpr size_t WS_ROPE = 2 * MiB;
constexpr size_t WS_HYH2 = 3 * MiB;
constexpr size_t WS_WA = 5 * MiB;
constexpr size_t WS_RT = 6 * MiB;
constexpr size_t WS_AG = 7 * MiB;
constexpr size_t WS_HYF = 10 * MiB;
constexpr size_t WS_WIN = 28 * MiB;
constexpr size_t WS_WOUT = 70 * MiB;
constexpr size_t WS_WGU = 86 * MiB;
constexpr size_t WS_WD = 342 * MiB;
constexpr size_t WS_X = 470 * MiB;
constexpr size_t WS_H = 614 * MiB;
constexpr size_t WS_U = 686 * MiB;
constexpr size_t WS_B = 875 * MiB;
constexpr size_t WS_VTD = WS_B;
constexpr size_t WS_VTS = WS_B + 18 * MiB;
constexpr size_t WS_ZT = WS_B + 23 * MiB;
constexpr size_t WS_OT = WS_B + 77 * MiB;
constexpr size_t WS_GSL = WS_B + 95 * MiB;
constexpr size_t WS_GSS = WS_B + 131 * MiB;
constexpr size_t WS_GAE = WS_B + 167 * MiB;
constexpr size_t WS_Y2 = WS_B;
constexpr size_t WS_HB = 1043 * MiB;
constexpr size_t WS_END = 1115 * MiB;
constexpr int WIN_F8_MASK = 2;
#define WIN_F8_L(l) (((WIN_F8_MASK) >> (l)) & 1)
constexpr bool WOUT_F8 = true;
constexpr int MIXB = WOUT_F8 ? 1 : 2;
constexpr size_t RT_E = 0;
constexpr size_t RT_W = 128 * 1024;
constexpr size_t RT_ROWTOK = 320 * 1024;
constexpr size_t RT_ROWW = 512 * 1024;
constexpr int CW_BAR = 4096;
constexpr int CW_CNT = 16384;
constexpr int CW_CUR = 16384 + 256;
constexpr int CW_Q = 16384 + 1024;

constexpr int LDS_BYTES = 155648;
constexpr int LDS_MISC = LDS_BYTES - 512;
constexpr int NWAVES = 8, NTHR = 512;

__device__ __forceinline__ unsigned f2bf(float f) { unsigned u = __builtin_bit_cast(unsigned, f); return (u + 0x7fffu + ((u >> 16) & 1u)) >> 16; }
#ifndef EMU8
#define EMU8 0
#endif
__device__ __forceinline__ float q8(float f) { unsigned u = __builtin_bit_cast(unsigned, f); u = (u + 0x7ffffu + ((u >> 20) & 1u)) & 0xfff00000u; return __builtin_bit_cast(float, u); }
__device__ __forceinline__ unsigned pk2(float lo, float hi) { return f2bf(lo) | (f2bf(hi) << 16); }
__device__ __forceinline__ unsigned pk2q(float lo, float hi) { return f2bf(q8(lo)) | (f2bf(q8(hi)) << 16); }
__device__ __forceinline__ unsigned pk4_f8(float a, float b, float c, float d) {
    a = fminf(fmaxf(a, -448.f), 448.f); b = fminf(fmaxf(b, -448.f), 448.f); c = fminf(fmaxf(c, -448.f), 448.f); d = fminf(fmaxf(d, -448.f), 448.f);
    int r = 0; r = __builtin_amdgcn_cvt_pk_fp8_f32(a, b, r, false); r = __builtin_amdgcn_cvt_pk_fp8_f32(c, d, r, true); return (unsigned)r; }
__device__ __forceinline__ unsigned char f8_1(float a) { a = fminf(fmaxf(a, -448.f), 448.f); return (unsigned char)(__builtin_amdgcn_cvt_pk_fp8_f32(a, a, 0, false) & 0xff); }
__device__ __forceinline__ float bf2f(unsigned short b) { return __builtin_bit_cast(float, ((unsigned)b) << 16); }
__device__ __forceinline__ float bflo(unsigned w) { return __builtin_bit_cast(float, w << 16); }
__device__ __forceinline__ float bfhi(unsigned w) { return __builtin_bit_cast(float, w & 0xffff0000u); }
__device__ __forceinline__ float wave_sum(float v) {
#pragma unroll
    for (int o = 1; o < 64; o <<= 1) v += __shfl_xor(v, o);
    return v;
}
__device__ __forceinline__ float silu_f(float x) { return x / (1.f + __expf(-x)); }
#define LDS_WAIT() asm volatile("s_waitcnt lgkmcnt(0)" ::: "memory")
#define VM_WAIT() asm volatile("s_waitcnt vmcnt(0)" ::: "memory")

#define XB_TMO      128
#define XB_XCNT(j)  (256  + 64 * (j))
#define XB_XSUB(j)  (1280 + 64 * (j))
#define XB_XGEN(j)  (2304 + 64 * (j))
#define XB_TOP      3328
#define XB_TOPGEN   3392
#define XCD_BAR_WORDS 3456
#define XB_SPIN_CAP (1u << 18)
__device__ __forceinline__ unsigned xb_ld(unsigned* p)              { return __hip_atomic_load(p, __ATOMIC_RELAXED, __HIP_MEMORY_SCOPE_AGENT); }
__device__ __forceinline__ unsigned xb_add(unsigned* p, unsigned v) { return __hip_atomic_fetch_add(p, v, __ATOMIC_RELAXED, __HIP_MEMORY_SCOPE_AGENT); }
__device__ __forceinline__ unsigned xb_xcc_id() { return (unsigned)__builtin_amdgcn_s_getreg((3 << 11) | 20) & 0xFu; }
#define XB_SPIN(cond, bar) do { unsigned _sp = 0; while (cond) { __builtin_amdgcn_s_sleep(1); \
    if ((++_sp & 255u) == 0u) { if (xb_ld(&(bar)[XB_TMO])) break; if (_sp > XB_SPIN_CAP) { atomicAdd(&(bar)[XB_TMO], 1u); break; } } } } while (0)
struct XcdBarrier { unsigned* bar; unsigned x; volatile LAS unsigned* st; };
__device__ __forceinline__ XcdBarrier xcd_barrier_post(unsigned* bar, volatile LAS unsigned* st, int tid) {
    XcdBarrier b; b.bar = bar; b.x = xb_xcc_id(); b.st = st;
    if (tid == 0) (void)xb_add(&bar[XB_XCNT(b.x)], 1u);
    return b;
}
__device__ __forceinline__ void xcd_barrier_complete(unsigned* bar, unsigned x, unsigned& nloc, unsigned& nx) {
    const unsigned G = gridDim.x * gridDim.y * gridDim.z;
    unsigned sum, cnt, mine, sp = 0u;
    for (;;) {
        sum = 0u; cnt = 0u; mine = 0u;
#pragma unroll
        for (unsigned j = 0; j < 16; ++j) { const unsigned c = xb_ld(&bar[XB_XCNT(j)]); sum += c; cnt += (c > 0u) ? 1u : 0u; mine = (j == x) ? c : mine; }
        if (sum == G) break;
        __builtin_amdgcn_s_sleep(1);
        if ((++sp & 255u) == 0u) { if (xb_ld(&bar[XB_TMO])) break; if (sp > XB_SPIN_CAP) { atomicAdd(&bar[XB_TMO], 1u); break; } }
    }
    nloc = mine > 0u ? mine : 1u; nx = cnt > 0u ? cnt : 1u;
}
__device__ __forceinline__ void xcd_barrier(const XcdBarrier& b, int tid) {
    asm volatile("s_waitcnt vmcnt(0)" ::: "memory");
    __syncthreads();
    if (tid == 0) {
        unsigned* bar = b.bar;
        __builtin_amdgcn_s_waitcnt(0);
        unsigned nloc = b.st[0], nx = b.st[1];
        if (nloc == 0u) { xcd_barrier_complete(bar, b.x, nloc, nx); b.st[0] = nloc; b.st[1] = nx; }
        const unsigned old = xb_add(&bar[XB_XSUB(b.x)], 1u);
        const unsigned gen = old / nloc;
        if (old + 1u == (gen + 1u) * nloc) {
            __builtin_amdgcn_fence(__ATOMIC_RELEASE, "agent");
            asm volatile("s_waitcnt vmcnt(0)" ::: "memory");
            const unsigned og = xb_add(&bar[XB_TOP], 1u);
            const unsigned tg = og / nx;
            if (og + 1u == (tg + 1u) * nx) xb_add(&bar[XB_TOPGEN], 1u);
            else XB_SPIN(xb_ld(&bar[XB_TOPGEN]) == tg, bar);
            __builtin_amdgcn_fence(__ATOMIC_ACQUIRE, "agent");
            xb_add(&bar[XB_XGEN(b.x)], 1u);
            asm volatile("s_waitcnt vmcnt(0)" ::: "memory");
        } else {
            XB_SPIN(xb_ld(&bar[XB_XGEN(b.x)]) == gen, bar);
            __builtin_amdgcn_fence(__ATOMIC_ACQUIRE, "agent");
            asm volatile("s_waitcnt vmcnt(0)" ::: "memory");
        }
    }
    __syncthreads();
}

namespace pg8 {
constexpr int BM = 256, BK = 64, HALF = 128, HTB = HALF * BK * 2, STAGE_BYTES = 8 * HTB;
__host__ __device__ __forceinline__ int lds_byte(int r, int c) { const int st = (r >> 4) * 2 + (c >> 5), rr = r & 15, cc = c & 31, ob = rr * 64 + cc * 2; return st * 1024 + (ob ^ (((ob >> 9) & 1) << 5)); }
__host__ __device__ __forceinline__ void stage_rc(int b, int& R, int& C) { const int st = b / 1024, sb = b % 1024, swz = sb ^ (((sb >> 9) & 1) << 5); R = (st >> 1) * 16 + swz / 64; C = (st & 1) * 32 + (swz % 64) / 2; }
__host__ __device__ __forceinline__ int lds_byte8(int r, int cb) { const int st = (r >> 4) * 2 + (cb >> 6), rr = r & 15, ob = rr * 64 + (cb & 63); return st * 1024 + (ob ^ (((ob >> 9) & 1) << 4)); }
__host__ __device__ __forceinline__ void stage_rc8(int b, int& R, int& Cb) { const int st = b / 1024, sb = b % 1024, swz = sb ^ (((sb >> 9) & 1) << 4); R = (st >> 1) * 16 + swz / 64; Cb = (st & 1) * 64 + (swz % 64); }
__host__ __device__ __forceinline__ int perm32(int rho) { const int n = rho >> 4, i = rho & 15; return 8 * (i >> 2) + 4 * n + (i & 3); }
struct Unit { int pm, pn; };
struct Gemm { const bf16_t* A; const bf16_t* Bt; int K; const int* rowtab; };
__device__ __forceinline__ unsigned cvt_pk_bf16(float lo, float hi) { unsigned r; asm volatile("v_cvt_pk_bf16_f32 %0, %1, %2" : "=v"(r) : "v"(lo), "v"(hi)); return r; }

template <class Epi, class Sched, bool GATHER, bool F8 = false>
__device__ __forceinline__ void gemm_phase(LAS unsigned char* lds, const Gemm g, const Sched& S, const Epi& E, const int tid) {
    const int wid = __builtin_amdgcn_readfirstlane(tid >> 6), lane = tid & 63, wr = wid >> 2, wc = wid & 3, fr = lane & 15, fq = lane >> 4;
    const int K = g.K, RB = F8 ? K : 2 * K, nt = RB / 128;
    unsigned voffB[2], voffA[2];
#pragma unroll
    for (int i = 0; i < 2; ++i) { int R, Cb; if constexpr (F8) stage_rc8(tid * 16 + i * 8192, R, Cb); else { int C; stage_rc(tid * 16 + i * 8192, R, C); Cb = 2 * C; }
        const int Rb = Epi::PERM ? ((R & ~31) + perm32(R & 31)) : R;
        voffA[i] = (unsigned)(R * RB + Cb); voffB[i] = (unsigned)(Rb * RB + Cb); }
    const size_t kstep = 128;
    const size_t hstep = (size_t)HALF * RB;
    const size_t tstep = 2 * hstep;
    const unsigned ldsw = (unsigned)wid * 1024u;
    const int aoff = F8 ? lds_byte8(wr * 64 + fr, 32 * fq) : lds_byte(wr * 64 + fr, fq * 8), boff = F8 ? lds_byte8(wc * 32 + fr, 32 * fq) : lds_byte(wc * 32 + fr, fq * 8);
    const int aoff2 = aoff ^ 16, boff2 = boff ^ 16;
#define PG8_SA(b, h) (((b) * 2 + (h)) * HTB)
#define PG8_SB(b, h) ((4 + (b) * 2 + (h)) * HTB)
#define PG8_STAGE(bufoff, gbase, voff) do { _Pragma("unroll") for (int _i = 0; _i < 2; ++_i) \
        __builtin_amdgcn_global_load_lds((const unsigned*)((const char*)(gbase) + (voff)[_i]), (LAS unsigned*)(lds + (bufoff) + ldsw + _i * 8192), 16, 0, 0); } while (0)
#define PG8_LDA(dst, b, h) do { if constexpr (F8) { _Pragma("unroll") for (int m = 0; m < 4; ++m) { const i32x4 _lo = *(const LAS i32x4*)(lds + PG8_SA(b, h) + aoff + m * 2048), _hi = *(const LAS i32x4*)(lds + PG8_SA(b, h) + aoff2 + m * 2048); dst##8[m] = __builtin_shufflevector(_lo, _hi, 0, 1, 2, 3, 4, 5, 6, 7); } } \
        else { _Pragma("unroll") for (int m = 0; m < 4; ++m) _Pragma("unroll") for (int k = 0; k < 2; ++k) dst[m][k] = *(const LAS bf16x8*)(lds + PG8_SA(b, h) + aoff + m * 2048 + k * 1024); } } while (0)
#define PG8_LDB(dst, b, h) do { if constexpr (F8) { _Pragma("unroll") for (int n = 0; n < 2; ++n) { const i32x4 _lo = *(const LAS i32x4*)(lds + PG8_SB(b, h) + boff + n * 2048), _hi = *(const LAS i32x4*)(lds + PG8_SB(b, h) + boff2 + n * 2048); dst##8[n] = __builtin_shufflevector(_lo, _hi, 0, 1, 2, 3, 4, 5, 6, 7); } } \
        else { _Pragma("unroll") for (int n = 0; n < 2; ++n) _Pragma("unroll") for (int k = 0; k < 2; ++k) dst[n][k] = *(const LAS bf16x8*)(lds + PG8_SB(b, h) + boff + n * 2048 + k * 1024); } } while (0)
#define PG8_CAT(x) __builtin_shufflevector(x[0], x[1], 0, 1, 2, 3, 4, 5, 6, 7)
#define PG8_MMA(ai, bj, At, Bt) do { __builtin_amdgcn_s_setprio(1); if constexpr (F8) { _Pragma("unroll") for (int m = 0; m < 4; ++m) _Pragma("unroll") for (int n = 0; n < 2; ++n) \
            asm volatile("v_mfma_scale_f32_16x16x128_f8f6f4 %0, %1, %2, %0, %3, %3 op_sel_hi:[0,0,0]" : "+v"(acc[ai][bj][m][n]) : "v"(Bt##8[n]), "v"(At##8[m]), "v"(f8scale)); } \
        else { _Pragma("unroll") for (int m = 0; m < 4; ++m) _Pragma("unroll") for (int n = 0; n < 2; ++n) _Pragma("unroll") for (int k = 0; k < 2; ++k) \
            acc[ai][bj][m][n] = __builtin_amdgcn_mfma_f32_16x16x32_bf16(Bt[n][k], At[m][k], acc[ai][bj][m][n], 0, 0, 0); } __builtin_amdgcn_s_setprio(0); } while (0)
#define PG8_WAIT_V(n) asm volatile("s_waitcnt vmcnt(" #n ")" ::: "memory")
#define PG8_WAIT_L(n) asm volatile("s_waitcnt lgkmcnt(" #n ")" ::: "memory")
#define PG8_BAR __builtin_amdgcn_s_barrier()
#define PG8_SCHED __builtin_amdgcn_sched_barrier(0)
#define PG8_AOFF(o, u) do { int _t2 = tid; asm volatile("" : "+v"(_t2)); _Pragma("unroll") for (int _i = 0; _i < 2; ++_i) { int _R, _Cb; if constexpr (F8) stage_rc8(_t2 * 16 + _i * 8192, _R, _Cb); else { int _C; stage_rc(_t2 * 16 + _i * 8192, _R, _C); _Cb = 2 * _C; } \
        _Pragma("unroll") for (int _h = 0; _h < 2; ++_h) { int _r = (u).pm * BM + _h * HALF + _R; \
        { const int _t = g.rowtab[_r]; _r = _t < 0 ? 0 : (_t & 0x3fffffff); } o[_h][_i] = (unsigned)(_r * RB + _Cb); } } } while (0)
    Unit cur, nxt; int ui = 0;
    if (!S.next(0, cur)) return;
    f32x4 acc[2][2][4][2];
#pragma unroll
    for (int a = 0; a < 2; ++a)
#pragma unroll
        for (int b = 0; b < 2; ++b)
#pragma unroll
            for (int m = 0; m < 4; ++m)
#pragma unroll
                for (int n = 0; n < 2; ++n) acc[a][b][m][n] = (f32x4){0.f, 0.f, 0.f, 0.f};
    bf16x8 At[4][2], B0[2][2], B1[2][2];
    i32x8 At8[4], B08[2], B18[2];
    int f8scale = 0x7f7f7f7f; asm volatile("" : "+v"(f8scale));
    unsigned oc[2][2], on[2][2];
    const char* gA = (const char*)g.A;
    const char* cA = gA; const char* cB = (const char*)g.Bt + (size_t)cur.pn * tstep;
    if constexpr (GATHER) { PG8_AOFF(oc, cur); } else { cA = gA + (size_t)cur.pm * tstep; }
#define PG8_STA_CUR(buf, kb, h) do { if constexpr (GATHER) { PG8_STAGE(buf, gA + (kb), oc[h]); } else { PG8_STAGE(buf, cA + (kb) + (h) * hstep, voffA); } } while (0)
#define PG8_STA_SEL(buf, kb, h) do { if constexpr (GATHER) { if (last) { PG8_STAGE(buf, gA + (kb), on[h]); } else { PG8_STAGE(buf, gA + (kb), oc[h]); } } else { PG8_STAGE(buf, a2p + (kb) + (h) * hstep, voffA); } } while (0)
    PG8_STAGE(PG8_SB(0, 0), cB, voffB); PG8_STAGE(PG8_SB(0, 1), cB + hstep, voffB); PG8_STA_CUR(PG8_SA(0, 0), 0, 0); PG8_STA_CUR(PG8_SA(0, 1), 0, 1);
    if (wr == 1) PG8_BAR;
    PG8_WAIT_V(2); PG8_BAR;
    PG8_STAGE(PG8_SB(1, 0), cB + kstep, voffB); PG8_STA_CUR(PG8_SA(1, 0), kstep, 0); PG8_STAGE(PG8_SB(1, 1), cB + hstep + kstep, voffB);
    PG8_WAIT_V(6); PG8_BAR;
    for (;;) {
        const bool has_next = S.next(ui + 1, nxt);
        const char* nA = cA;
        if constexpr (!GATHER) { if (has_next) nA = gA + (size_t)nxt.pm * tstep; }
        const char* nB = has_next ? (const char*)g.Bt + (size_t)nxt.pn * tstep : cB;
#pragma unroll 1
        for (int t = 0; t < nt; t += 2) {
            const bool last = (t == nt - 2);
            int to = t; asm volatile("" : "+s"(to));
            const size_t k1 = (size_t)(to + 1) * kstep, k2 = last ? 0 : (size_t)(to + 2) * kstep, k3 = k2 + kstep;
            const char* b2 = last ? nB : cB + (size_t)(to + 2) * kstep; const char* b3 = b2 + kstep;
            const char* a2p = last ? nA : cA;
            if constexpr (GATHER) { if (last) { if (has_next) { PG8_AOFF(on, nxt); } else {
#pragma unroll
                for (int h = 0; h < 2; ++h)
#pragma unroll
                    for (int i = 0; i < 2; ++i) on[h][i] = oc[h][i]; } } }
            PG8_LDB(B0, 0, 0); PG8_LDB(B1, 0, 1); PG8_SCHED; PG8_LDA(At, 0, 0); PG8_STA_CUR(PG8_SA(1, 1), k1, 1);
            PG8_WAIT_V(8); PG8_WAIT_L(0); PG8_BAR; PG8_MMA(0, 0, At, B0); PG8_MMA(0, 1, At, B1); PG8_BAR; PG8_SCHED;
            PG8_LDA(At, 0, 1); PG8_STAGE(PG8_SB(0, 0), b2, voffB); PG8_STAGE(PG8_SB(0, 1), b2 + hstep, voffB); PG8_STA_SEL(PG8_SA(0, 0), k2, 0);
            PG8_WAIT_V(8); PG8_WAIT_L(0); PG8_BAR; PG8_MMA(1, 0, At, B0); PG8_MMA(1, 1, At, B1); PG8_BAR; PG8_SCHED;
            PG8_LDB(B0, 1, 0); PG8_LDB(B1, 1, 1); PG8_SCHED; PG8_LDA(At, 1, 0); PG8_STA_SEL(PG8_SA(0, 1), k2, 1);
            PG8_WAIT_V(8); PG8_WAIT_L(0); PG8_BAR; PG8_MMA(0, 0, At, B0); PG8_MMA(0, 1, At, B1); PG8_BAR; PG8_SCHED;
            PG8_LDA(At, 1, 1); PG8_STAGE(PG8_SB(1, 0), b3, voffB); PG8_STAGE(PG8_SB(1, 1), b3 + hstep, voffB); PG8_STA_SEL(PG8_SA(1, 0), k3, 0);
            PG8_WAIT_V(8); PG8_WAIT_L(0); PG8_BAR; PG8_MMA(1, 0, At, B0); PG8_MMA(1, 1, At, B1); PG8_BAR; PG8_SCHED;
        }
        if (wr == 0) PG8_BAR;
        if constexpr (F8) asm volatile("s_nop 15\n\ts_nop 15" : "+v"(acc[1][1][0][0]), "+v"(acc[1][1][0][1]), "+v"(acc[1][1][1][0]), "+v"(acc[1][1][1][1]), "+v"(acc[1][1][2][0]), "+v"(acc[1][1][2][1]), "+v"(acc[1][1][3][0]), "+v"(acc[1][1][3][1]) :: "memory");
        E(acc, cur, wr, wc, fr, fq);
        if (!has_next) break;
#pragma unroll
        for (int a = 0; a < 2; ++a)
#pragma unroll
            for (int b = 0; b < 2; ++b)
#pragma unroll
                for (int m = 0; m < 4; ++m)
#pragma unroll
                    for (int n = 0; n < 2; ++n) acc[a][b][m][n] = (f32x4){0.f, 0.f, 0.f, 0.f};
        cur = nxt; cB = nB; cA = nA; ++ui;
        if constexpr (GATHER) {
#pragma unroll
            for (int h = 0; h < 2; ++h)
#pragma unroll
                for (int i = 0; i < 2; ++i) oc[h][i] = on[h][i]; }
        if (wr == 1) PG8_BAR;
    }
#undef PG8_STA_CUR
#undef PG8_STA_SEL
    PG8_WAIT_V(0);
    PG8_BAR;
#undef PG8_SA
#undef PG8_SB
#undef PG8_STAGE
#undef PG8_LDA
#undef PG8_LDB
#undef PG8_CAT
#undef PG8_MMA
#undef PG8_WAIT_V
#undef PG8_WAIT_L
#undef PG8_BAR
#undef PG8_SCHED
#undef PG8_AOFF
}
}

struct Params { const float* in[34]; float* out; unsigned char* ws; int ph_lo, ph_hi; };
typedef const __attribute__((address_space(4))) Params* KP;
__device__ __forceinline__ KP kp_opaque(KP p) { asm volatile("" : "+s"(p)); return p; }
enum { I_X = 0, I_C, I_CTX, I_CCTX, I_N1W, I_N2W, I_ADAW, I_ADAB, I_WIN, I_WOUT, I_GGW, I_GGB, I_GNW, I_SQN, I_SKN, I_SINK, I_HCW, I_HCB, I_HW1, I_HB1, I_HW2, I_HB2, I_HW3, I_HFR, I_HBIAS,
       I_DQN, I_DKN, I_DLAM, I_DSUB, I_RW, I_RB, I_EG, I_EU, I_ED };
struct Frame {
    LAS unsigned char* lds; volatile LAS unsigned* MISC; unsigned* ctl;
    int tid, lane, wave, vcu, G;
    unsigned char* ws;
};
__device__ __forceinline__ int modrow_of(int row) { return row < TL ? (row >> 11) : 8; }
__device__ __forceinline__ int keyrow(int b, int kidx) { return kidx < LC ? TL + b * LC + kidx : b * SEQ + (kidx - LC); }
__device__ __forceinline__ int wg_grab(Frame& F, int q) {
    __syncthreads();
    if (F.tid == 0) F.MISC[0] = __hip_atomic_fetch_add(F.ctl + CW_Q + 64 * q, 1u, __ATOMIC_RELAXED, __HIP_MEMORY_SCOPE_AGENT);
    __syncthreads();
    { int t_; asm volatile("v_mbcnt_lo_u32_b32 %0, -1, 0\n\tv_mbcnt_hi_u32_b32 %0, -1, %0" : "=v"(t_)); F.lane = t_; F.tid = F.wave * 64 + t_; }
    return (int)F.MISC[0];
}

namespace pg8 {
constexpr int NXCD = 8, WGM = 8;
struct RectOrder {
    int nM, nN, nwg, G, c, nextra, xpm0; unsigned long long xt;
    __device__ void init(int nM_, int nN_, int G_, int c_, int nextra_, int xpm0_, unsigned long long xt_) { nM = nM_; nN = nN_; nwg = nM * nN; G = G_; c = c_; nextra = nextra_; xpm0 = xpm0_; xt = xt_; }
    __device__ bool next(int i, Unit& u) const {
        const int L = i * G + c; if (L >= nwg + nextra) return false;
        if (L >= nwg) { const int e = L - nwg; u.pm = xpm0 + (e >> 3); u.pn = (int)((xt >> (8 * (e & 7))) & 0xffull); return true; }
        int wgid = L; { const int q = nwg / NXCD, r = nwg % NXCD, xcd = wgid % NXCD, off = wgid / NXCD; wgid = (xcd < r ? xcd * (q + 1) : r * (q + 1) + (xcd - r) * q) + off; }
        const int nig = WGM * nN, gid = wgid / nig, fm = gid * WGM, gsz = (nM - fm) < WGM ? (nM - fm) : WGM;
        u.pm = fm + ((wgid % nig) % gsz); u.pn = (wgid % nig) / gsz; return true;
    }
};
struct MoeOrder {
    int npanels, G, vcu; const volatile LAS unsigned char* pexp;
    __device__ bool next(int i, Unit& u) const {
        const int L = i * G + vcu; if (L >= npanels * 8) return false;
        const int p = L >> 3; u.pm = p; u.pn = (int)pexp[p] * 8 + (L & 7); return true;
    }
};
struct EpiU {
    static constexpr bool PERM = true;
    bf16_t* O; float scale;
    __device__ __forceinline__ void operator()(const f32x4 (&acc)[2][2][4][2], const Unit& u, int wr, int wc, int fr, int fq) const {
        const int row0 = u.pm * BM + wr * 64 + fr, col0 = u.pn * BM + wc * 32 + 8 * fq;
#pragma unroll
        for (int ai = 0; ai < 2; ++ai)
#pragma unroll
            for (int m = 0; m < 4; ++m) { bf16_t* rowp = O + (size_t)(row0 + ai * HALF + m * 16) * NU + col0;
#pragma unroll
                for (int bj = 0; bj < 2; ++bj) { const f32x4 v0 = acc[ai][bj][m][0] * scale, v1 = acc[ai][bj][m][1] * scale;
                    u32x4 w; w.x = cvt_pk_bf16(v0[0], v0[1]); w.y = cvt_pk_bf16(v0[2], v0[3]); w.z = cvt_pk_bf16(v1[0], v1[1]); w.w = cvt_pk_bf16(v1[2], v1[3]);
                    *(u32x4*)(rowp + bj * HALF) = w; } }
    }
};
struct EpiWout {
    static constexpr bool PERM = true;
    const float* res_lat; const float* res_ctx; const bf16_t* resb; bf16_t* X; const float* mod;
    __device__ __forceinline__ void operator()(const f32x4 (&acc)[2][2][4][2], const Unit& u, int wr, int wc, int fr, int fq) const {
        const int row0 = u.pm * BM + wr * 64 + fr, col0 = u.pn * BM + wc * 32 + 8 * fq;
        const float* ga = mod + (size_t)modrow_of(u.pm * BM) * 12288 + 2 * D;
        constexpr float sc = WOUT_F8 ? 1.f / 32.f : 1.f;
        f32x4 gv[2][2];
#pragma unroll
        for (int bj = 0; bj < 2; ++bj)
#pragma unroll
            for (int n = 0; n < 2; ++n) gv[bj][n] = *(const f32x4*)(ga + col0 + bj * HALF + n * 4) * sc;
        if (resb) {
#pragma unroll
            for (int ai = 0; ai < 2; ++ai)
#pragma unroll
                for (int m = 0; m < 4; ++m) { const int row = row0 + ai * HALF + m * 16; const bf16_t* rp = resb + (size_t)row * D + col0; bf16_t* xp = X + (size_t)row * D + col0;
#pragma unroll
                    for (int bj = 0; bj < 2; ++bj) { const u32x4 r = *(const u32x4*)(rp + bj * HALF);
                        const f32x4 v0 = (f32x4){bflo(r.x), bfhi(r.x), bflo(r.y), bfhi(r.y)} + gv[bj][0] * acc[ai][bj][m][0], v1 = (f32x4){bflo(r.z), bfhi(r.z), bflo(r.w), bfhi(r.w)} + gv[bj][1] * acc[ai][bj][m][1];
                        u32x4 o; o.x = cvt_pk_bf16(v0[0], v0[1]); o.y = cvt_pk_bf16(v0[2], v0[3]); o.z = cvt_pk_bf16(v1[0], v1[1]); o.w = cvt_pk_bf16(v1[2], v1[3]);
                        *(u32x4*)(xp + bj * HALF) = o; } }
        } else {
#pragma unroll
            for (int ai = 0; ai < 2; ++ai)
#pragma unroll
                for (int m = 0; m < 4; ++m) { const int row = row0 + ai * HALF + m * 16;
                    const float* rp = (row < TL ? res_lat + (size_t)row * D : res_ctx + (size_t)(row - TL) * D) + col0; bf16_t* xp = X + (size_t)row * D + col0;
#pragma unroll
                    for (int bj = 0; bj < 2; ++bj) { const f32x4 r0 = *(const f32x4*)(rp + bj * HALF), r1 = *(const f32x4*)(rp + bj * HALF + 4);
                        const f32x4 v0 = r0 + gv[bj][0] * acc[ai][bj][m][0], v1 = r1 + gv[bj][1] * acc[ai][bj][m][1];
                        u32x4 o; o.x = cvt_pk_bf16(v0[0], v0[1]); o.y = cvt_pk_bf16(v0[2], v0[3]); o.z = cvt_pk_bf16(v1[0], v1[1]); o.w = cvt_pk_bf16(v1[2], v1[3]);
                        *(u32x4*)(xp + bj * HALF) = o; } }
        }
    }
};
struct EpiMoe1 {
    static constexpr bool PERM = true;
    unsigned char* O;
    __device__ __forceinline__ void operator()(const f32x4 (&acc)[2][2][4][2], const Unit& u, int wr, int wc, int fr, int fq) const {
        const int row0 = u.pm * BM + wr * 64 + fr, col0 = (u.pn & 7) * HALF + wc * 32 + 8 * fq;
#pragma unroll
        for (int ai = 0; ai < 2; ++ai)
#pragma unroll
            for (int m = 0; m < 4; ++m) { unsigned char* rowp = O + (size_t)(row0 + ai * HALF + m * 16) * DE + col0; float h[8];
#pragma unroll
                for (int n = 0; n < 2; ++n)
#pragma unroll
                    for (int j = 0; j < 4; ++j) { const float gt = acc[ai][0][m][n][j] * (1.f / 32.f), up = acc[ai][1][m][n][j] * (1.f / 32.f); h[4 * n + j] = gt * __builtin_amdgcn_rcpf(1.f + __expf(-gt)) * up; }
                u32x2 w; w.x = pk4_f8(h[0], h[1], h[2], h[3]); w.y = pk4_f8(h[4], h[5], h[6], h[7]);
                *(u32x2*)rowp = w; }
    }
};
struct EpiMoe2 {
    static constexpr bool PERM = true;
    unsigned char* Y2; const int* rowtok; const float* roww;
    __device__ __forceinline__ void operator()(const f32x4 (&acc)[2][2][4][2], const Unit& u, int wr, int wc, int fr, int fq) const {
        const int row0 = u.pm * BM + wr * 64 + fr, col0 = (u.pn & 7) * BM + wc * 32 + 8 * fq;
#pragma unroll
        for (int ai = 0; ai < 2; ++ai)
#pragma unroll
            for (int m = 0; m < 4; ++m) { asm volatile("" ::: "memory"); const int row = row0 + ai * HALF + m * 16; const int tk = rowtok[row]; const float w = roww[row];
                if (tk >= 0) { unsigned char* rowp = Y2 + ((size_t)(tk >> 30) * TT + (size_t)(tk & 0x3fffffff)) * D + col0;
#pragma unroll
                    for (int bj = 0; bj < 2; ++bj) { const f32x4 v0 = acc[ai][bj][m][0] * w, v1 = acc[ai][bj][m][1] * w;
                        u32x2 o; o.x = pk4_f8(v0[0], v0[1], v0[2], v0[3]); o.y = pk4_f8(v1[0], v1[1], v1[2], v1[3]);
                        *(u32x2*)(rowp + bj * HALF) = o; } } }
    }
};
}

__device__ __forceinline__ void p0_transpose_item(const float* W, int ldw, int srccol0, int k0, bf16_t* dst, int K, LAS float* scr, int lane, bool q = false) {
    { f32x4 v[8];
#pragma unroll
      for (int i = 0; i < 8; ++i) v[i] = *(const f32x4*)(W + (size_t)(k0 + 8 * i + (lane >> 3)) * ldw + srccol0 + 4 * (lane & 7));
#pragma unroll
      for (int i = 0; i < 8; ++i) { LAS float* p = scr + (8 * i + (lane >> 3)) * 33 + 4 * (lane & 7); p[0] = v[i][0]; p[1] = v[i][1]; p[2] = v[i][2]; p[3] = v[i][3]; } }
    LDS_WAIT(); asm volatile("" ::: "memory");
    const int c = lane & 7;
#pragma unroll
    for (int j = 0; j < 4; ++j) { const int n = (lane >> 3) + 8 * j; const LAS float* s = scr + (8 * c) * 33 + n;
        u32x4 o; if (q) { o.x = pk2q(s[0 * 33], s[1 * 33]); o.y = pk2q(s[2 * 33], s[3 * 33]); o.z = pk2q(s[4 * 33], s[5 * 33]); o.w = pk2q(s[6 * 33], s[7 * 33]); }
        else { o.x = pk2(s[0 * 33], s[1 * 33]); o.y = pk2(s[2 * 33], s[3 * 33]); o.z = pk2(s[4 * 33], s[5 * 33]); o.w = pk2(s[6 * 33], s[7 * 33]); }
        *(u32x4*)(dst + (size_t)n * K + k0 + 8 * c) = o; }
    LDS_WAIT(); asm volatile("" ::: "memory");
}
__device__ __forceinline__ void p0_transpose_item8(const float* W, int ldw, int srccol0, int k0, unsigned char* dst, int K, LAS float* scr, int lane) {
    { f32x4 v[8];
#pragma unroll
      for (int i = 0; i < 8; ++i) v[i] = *(const f32x4*)(W + (size_t)(k0 + 8 * i + (lane >> 3)) * ldw + srccol0 + 4 * (lane & 7));
#pragma unroll
      for (int i = 0; i < 8; ++i) { LAS float* p = scr + (8 * i + (lane >> 3)) * 33 + 4 * (lane & 7); p[0] = v[i][0]; p[1] = v[i][1]; p[2] = v[i][2]; p[3] = v[i][3]; } }
    LDS_WAIT(); asm volatile("" ::: "memory");
    const int c = lane & 7;
#pragma unroll
    for (int j = 0; j < 4; ++j) { const int n = (lane >> 3) + 8 * j; const LAS float* s = scr + (8 * c) * 33 + n;
        u32x2 o; o.x = pk4_f8(s[0 * 33] * 32.f, s[1 * 33] * 32.f, s[2 * 33] * 32.f, s[3 * 33] * 32.f); o.y = pk4_f8(s[4 * 33] * 32.f, s[5 * 33] * 32.f, s[6 * 33] * 32.f, s[7 * 33] * 32.f);
        *(u32x2*)(dst + (size_t)n * K + k0 + 8 * c) = o; }
    LDS_WAIT(); asm volatile("" ::: "memory");
}
constexpr int TI_WIN = 32 * 168, TI_WA = 32, TI_WOUT = 32 * 64, TI_GU = 32 * 64, TI_DN = 16 * 64;
constexpr int TI_L = TI_WIN + TI_WA + TI_WOUT;
constexpr int TI_TOTAL = 2 * TI_L + 32 * TI_GU + 32 * TI_DN;
__device__ __forceinline__ void p0_item(KP Pk, Frame& F, int it, LAS float* scr) {
    unsigned char* ws = F.ws;
    if (it < 2 * TI_L) { const int l = it / TI_L; int r = it % TI_L;
        if (r < TI_WIN) { const int kb = r / 168, nb = r % 168, n0 = 32 * nb;
            if (WIN_F8_L(l)) p0_transpose_item8(Pk->in[I_WIN] + (size_t)l * D * DIN, DIN, n0 < 1536 ? n0 : n0 + 32, 64 * kb, ws + WS_WIN + (size_t)l * NU * D * 2 + (size_t)n0 * D, D, scr, F.lane);
            else p0_transpose_item(Pk->in[I_WIN] + (size_t)l * D * DIN, DIN, n0 < 1536 ? n0 : n0 + 32, 64 * kb, (bf16_t*)(ws + WS_WIN) + ((size_t)l * NU + n0) * D, D, scr, F.lane); return; }
        r -= TI_WIN;
        if (r < TI_WA) { if (WIN_F8_L(l)) p0_transpose_item8(Pk->in[I_WIN] + (size_t)l * D * DIN, DIN, 1536, 64 * r, ws + WS_WA + (size_t)l * 32 * D * 2, D, scr, F.lane);
            else p0_transpose_item(Pk->in[I_WIN] + (size_t)l * D * DIN, DIN, 1536, 64 * r, (bf16_t*)(ws + WS_WA) + (size_t)l * 32 * D, D, scr, F.lane); return; }
        r -= TI_WA;
        { const int kb = r / 64, nb = r % 64;
          if (WOUT_F8) p0_transpose_item8(Pk->in[I_WOUT] + (size_t)l * D * D, D, 32 * nb, 64 * kb, ws + WS_WOUT + ((size_t)l * D + 32 * nb) * D, D, scr, F.lane);
          else p0_transpose_item(Pk->in[I_WOUT] + (size_t)l * D * D, D, 32 * nb, 64 * kb, (bf16_t*)(ws + WS_WOUT) + ((size_t)l * D + 32 * nb) * D, D, scr, F.lane); return; }
    }
    it -= 2 * TI_L;
    if (it < 32 * TI_GU) { const int le = it / TI_GU, r = it % TI_GU, kb = r / 64, nb = r % 64, n0 = 32 * nb, j = n0 >> 8, half = (n0 >> 7) & 1, c0 = 128 * j + (n0 & 127);
        p0_transpose_item8((half ? Pk->in[I_EU] : Pk->in[I_EG]) + (size_t)le * D * DE, DE, c0, 64 * kb, ws + WS_WGU + ((size_t)le * 2048 + n0) * D, D, scr, F.lane); return; }
    it -= 32 * TI_GU;
    { const int le = it / TI_DN, r = it % TI_DN, kb = r / 64, nb = r % 64;
        p0_transpose_item8(Pk->in[I_ED] + (size_t)le * DE * D, D, 32 * nb, 64 * kb, ws + WS_WD + ((size_t)le * D + 32 * nb) * DE, DE, scr, F.lane); }
}
__device__ __forceinline__ void ada_unit(KP Pk, Frame& F, int u) {
    unsigned char* ws = F.ws;
    __syncthreads();
        LAS float* sc = (LAS float*)F.lds;
        LAS float* red = (LAS float*)(F.lds + 9 * 2048 * 4);
        for (int i = F.tid; i < 9 * 2048; i += NTHR) { const int r = i >> 11, k = i & 2047; const float v = r < 8 ? Pk->in[I_C][r * 2048 + k] : Pk->in[I_CCTX][k]; sc[i] = silu_f(v); }
        __syncthreads();
        const int l = u / 96, cb = u % 96, col = cb * 128 + (F.tid & 127), kp = F.tid >> 7;
        const float* W = Pk->in[I_ADAW] + (size_t)l * D * 12288 + col;
        float a[9];
#pragma unroll
        for (int r = 0; r < 9; ++r) a[r] = 0.f;
        for (int k = kp * 512; k < kp * 512 + 512; k += 32) {
            float w[32];
#pragma unroll
            for (int q = 0; q < 32; ++q) w[q] = W[(size_t)(k + q) * 12288];
#pragma unroll
            for (int q = 0; q < 32; ++q) {
#pragma unroll
                for (int r = 0; r < 9; ++r) a[r] += sc[r * 2048 + k + q] * w[q];
                if ((q & 3) == 3) __builtin_amdgcn_sched_barrier(0); }
        }
#pragma unroll
        for (int r = 0; r < 9; ++r) red[(kp * 9 + r) * 128 + (F.tid & 127)] = a[r];
        __syncthreads();
        for (int i = F.tid; i < 9 * 128; i += NTHR) { const int r = i >> 7, c = i & 127;
            const float s = (red[(0 * 9 + r) * 128 + c] + red[(1 * 9 + r) * 128 + c]) + (red[(2 * 9 + r) * 128 + c] + red[(3 * 9 + r) * 128 + c]);
            ((float*)(ws + WS_MOD))[((size_t)l * 9 + r) * 12288 + cb * 128 + c] = s + Pk->in[I_ADAB][l * 12288 + cb * 128 + c]; }
        __syncthreads();
}
__device__ __forceinline__ void p0_prologue(KP Pk, Frame& F, int rep) {
    unsigned char* ws = F.ws;
    const int gw = F.vcu * NWAVES + F.wave, NGW = F.G * NWAVES;
    if (blockIdx.x < 96) ada_unit(Pk, F, (int)blockIdx.x);
    for (int i = blockIdx.x * NTHR + F.tid; i < SEQ * 64; i += F.G * NTHR) { const int t = i >> 6, j = i & 63, q = j >> 4, f = j & 15;
        const float inv = exp2f(-(float)f * (13.287712379549449f / 16.f)); const float pos = (float)(q < 2 ? (t >> 6) : (t & 63)); const float ang = pos * inv;
        ((float*)(ws + WS_ROPE))[i] = (q & 1) ? sinf(ang) : cosf(ang); }
    for (int it = gw; it < 2 * 2304; it += NGW) { const int l = it / 2304, tt = it % 2304, L = tt < 2048 ? 2048 : 256, t = tt < 2048 ? tt : tt - 2048;
        const float tn = (float)t / (float)(L - 1), wv = (6.283185307179586f / (float)L) * (float)t;
        const float* w1 = Pk->in[I_HW1] + l * 33 * 64; const float* w2 = Pk->in[I_HW2] + l * 64 * 64;
        float zv = 0.f;
        if (F.lane == 0) zv = tn; else if (F.lane < 33) { const int bi = (F.lane - 1) & 15; const float band = 1e-4f + (float)bi * ((15.f - 1e-4f) / 15.f); zv = F.lane < 17 ? cosf(wv * band) : -sinf(wv * band); }
        float s = Pk->in[I_HB1][l * 64 + F.lane];
#pragma unroll
        for (int i = 0; i < 33; ++i) s += __shfl(zv, i) * w1[i * 64 + F.lane];
        const float h1 = sinf(Pk->in[I_HFR][(l * 2 + 0) * 64 + F.lane] * s);
        float s2 = Pk->in[I_HB2][l * 64 + F.lane];
#pragma unroll 16
        for (int i = 0; i < 64; ++i) s2 += __shfl(h1, i) * w2[i * 64 + F.lane];
        ((float*)(ws + WS_HYH2))[(size_t)it * 64 + F.lane] = sinf(Pk->in[I_HFR][(l * 2 + 1) * 64 + F.lane] * s2);
    }
    { LAS float* scr = (LAS float*)(F.lds + F.wave * 8704);
      __syncthreads();
      for (;;) { int base = 0; if (F.lane == 0) base = (int)__hip_atomic_fetch_add(F.ctl + CW_Q + 64 * (rep ? 5 : 0), 16u, __ATOMIC_RELAXED, __HIP_MEMORY_SCOPE_AGENT);
          base = __builtin_amdgcn_readfirstlane(base); if (base >= TI_WIN + TI_WA) break;
          for (int it = base; it < base + 16 && it < TI_WIN + TI_WA; ++it) p0_item(Pk, F, it, scr); } }
}

#define MFMA16(a, b, c) __builtin_amdgcn_mfma_f32_16x16x32_bf16((a), (b), (c), 0, 0, 0)
#define MFMA32(a, b, c) __builtin_amdgcn_mfma_f32_32x32x16_bf16((a), (b), (c), 0, 0, 0)
__device__ __forceinline__ void load_row(const float* p, int lane, f32x4 (&v)[8]) {
#pragma unroll
    for (int j = 0; j < 8; ++j) v[j] = ((const f32x4*)p)[lane + 64 * j];
}
__device__ __forceinline__ void load_row_bf16(const bf16_t* p, int lane, f32x4 (&v)[8]) {
#pragma unroll
    for (int j = 0; j < 8; ++j) { const u32x2 a = ((const u32x2*)p)[lane + 64 * j]; v[j] = (f32x4){bflo(a.x), bfhi(a.x), bflo(a.y), bfhi(a.y)}; }
}
__device__ __forceinline__ void add_y2(const unsigned char* y0, const unsigned char* y1, const float* gf, int lane, f32x4 (&v)[8]) {
#pragma unroll
    for (int j = 0; j < 8; ++j) { const unsigned a = ((const unsigned*)y0)[lane + 64 * j], b = ((const unsigned*)y1)[lane + 64 * j]; const f32x4 g = ((const f32x4*)gf)[lane + 64 * j] * (1.f / 32.f);
        const f32x2 a0 = __builtin_amdgcn_cvt_pk_f32_fp8(a, false), a1 = __builtin_amdgcn_cvt_pk_f32_fp8(a, true), b0 = __builtin_amdgcn_cvt_pk_f32_fp8(b, false), b1 = __builtin_amdgcn_cvt_pk_f32_fp8(b, true);
        v[j][0] += g[0] * (a0[0] + b0[0]); v[j][1] += g[1] * (a0[1] + b0[1]); v[j][2] += g[2] * (a1[0] + b1[0]); v[j][3] += g[3] * (a1[1] + b1[1]); }
}
__device__ __forceinline__ float row_rstd(const f32x4 (&v)[8]) {
    float s = 0.f;
#pragma unroll
    for (int j = 0; j < 8; ++j) s += (v[j][0] * v[j][0] + v[j][1] * v[j][1]) + (v[j][2] * v[j][2] + v[j][3] * v[j][3]);
    return rsqrtf(wave_sum(s) * (1.f / D) + NORM_EPS);
}
__device__ __forceinline__ void modulate(f32x4 (&v)[8], float rstd, const float* nw, const float* sh, const float* sc, int lane) {
#pragma unroll
    for (int j = 0; j < 8; ++j) { const f32x4 w = ((const f32x4*)nw)[lane + 64 * j], a = ((const f32x4*)sc)[lane + 64 * j], b = ((const f32x4*)sh)[lane + 64 * j];
        v[j] = v[j] * rstd * w * (a + 1.f) + b; }
}
__device__ __forceinline__ void store_row_bf16(bf16_t* o, int lane, const f32x4 (&v)[8], bool q = false) {
#pragma unroll
    for (int j = 0; j < 8; ++j) { u32x2 w; if (q) { w.x = pk2q(v[j][0], v[j][1]); w.y = pk2q(v[j][2], v[j][3]); } else { w.x = pk2(v[j][0], v[j][1]); w.y = pk2(v[j][2], v[j][3]); } ((u32x2*)o)[lane + 64 * j] = w; }
}
__device__ __forceinline__ void store_row_f8(unsigned char* o, int lane, const f32x4 (&v)[8]) {
#pragma unroll
    for (int j = 0; j < 8; ++j) ((unsigned*)o)[lane + 64 * j] = pk4_f8(v[j][0], v[j][1], v[j][2], v[j][3]);
}
__device__ __forceinline__ void ph_norm1(KP Pk, Frame& F, int l) {
    unsigned char* ws = F.ws;
    const int gw = F.vcu * NWAVES + F.wave, NGW = F.G * NWAVES;
    const float* mod = (const float*)(ws + WS_MOD) + (size_t)l * 9 * 12288;
    bf16_t* X = (bf16_t*)(ws + WS_X); bf16_t* H = (bf16_t*)(ws + WS_H); const unsigned char* Y2 = ws + WS_Y2;
    for (int rowA = gw; rowA < TT; rowA += 2 * NGW) {
        const bool hasB = rowA + NGW < TT; const int rowB = hasB ? rowA + NGW : rowA;
        const int ra = modrow_of(rowA), rb = modrow_of(rowB); f32x4 va[8], vb[8];
        if (l == 0) { load_row(rowA < TL ? Pk->in[I_X] + (size_t)rowA * D : Pk->in[I_CTX] + (size_t)(rowA - TL) * D, F.lane, va);
                      load_row(rowB < TL ? Pk->in[I_X] + (size_t)rowB * D : Pk->in[I_CTX] + (size_t)(rowB - TL) * D, F.lane, vb); }
        else { load_row_bf16(X + (size_t)rowA * D, F.lane, va); load_row_bf16(X + (size_t)rowB * D, F.lane, vb);
            add_y2(Y2 + (size_t)rowA * D, Y2 + ((size_t)TT + rowA) * D, (const float*)(ws + WS_MOD) + (size_t)ra * 12288 + 5 * D, F.lane, va);
            add_y2(Y2 + (size_t)rowB * D, Y2 + ((size_t)TT + rowB) * D, (const float*)(ws + WS_MOD) + (size_t)rb * 12288 + 5 * D, F.lane, vb);
            if (rowA < TL) store_row_bf16(X + (size_t)rowA * D, F.lane, va);
            if (hasB && rowB < TL) store_row_bf16(X + (size_t)rowB * D, F.lane, vb); }
        const float rsa = row_rstd(va), rsb = row_rstd(vb);
        modulate(va, rsa, Pk->in[I_N1W] + l * D, mod + (size_t)ra * 12288, mod + (size_t)ra * 12288 + D, F.lane);
        modulate(vb, rsb, Pk->in[I_N1W] + l * D, mod + (size_t)rb * 12288, mod + (size_t)rb * 12288 + D, F.lane);
        if (WIN_F8_L(l)) { store_row_f8(ws + WS_H + (size_t)rowA * D, F.lane, va); if (hasB) store_row_f8(ws + WS_H + (size_t)rowB * D, F.lane, vb); }
        else { store_row_bf16(H + (size_t)rowA * D, F.lane, va); if (hasB) store_row_bf16(H + (size_t)rowB * D, F.lane, vb); }
    }
}
__device__ __forceinline__ void ph_hyena_filters(KP Pk, Frame& F, int u) {
    unsigned char* ws = F.ws;
    constexpr int HRS = 2052;
    LAS float* HR = (LAS float*)F.lds; LAS float* red = (LAS float*)(F.lds + 16 * HRS * 4);
    const int r16 = F.lane & 15, kg = F.lane >> 4;
    {
        const int lf = u >> 7, cg = u & 127, chl = r16 & 3, od = r16 >> 2, ch = cg * 4 + chl;
        const float* w3 = Pk->in[I_HW3] + (size_t)lf * 64 * 2048 + (od >> 1) * 1024 + (od & 1) * 512 + ch;
        bf16x8 wb[2];
#pragma unroll
        for (int ks = 0; ks < 2; ++ks) { float w[8];
#pragma unroll
            for (int j = 0; j < 8; ++j) w[j] = w3[(size_t)(32 * ks + 8 * kg + j) * 2048];
            u32x4 p; p.x = pk2(w[0], w[1]); p.y = pk2(w[2], w[3]); p.z = pk2(w[4], w[5]); p.w = pk2(w[6], w[7]); wb[ks] = __builtin_bit_cast(bf16x8, p); }
        const float dmin = 3.0701134573253940f, dmax = 15.350567286626972f, delta = dmin + (float)ch * ((dmax - dmin) / 511.f);
#pragma unroll 1
        for (int sel = 0; sel < 2; ++sel) {
            const int L = sel == 0 ? 2048 : 256; const float* h2 = (const float*)(ws + WS_HYH2) + ((size_t)lf * 2304 + (sel == 0 ? 0 : 2048)) * 64; const float rl = 1.f / (float)(L - 1);
            __syncthreads();
            float s = 0.f;
#pragma unroll 2
            for (int tile = F.wave; tile < L / 16; tile += NWAVES) {
                const f32x4* hp = (const f32x4*)(h2 + (size_t)(16 * tile + r16) * 64 + 8 * kg);
                const f32x4 a0 = hp[0], a1 = hp[1], a2 = hp[8], a3 = hp[9];
                u32x4 p0, p1; p0.x = pk2(a0[0], a0[1]); p0.y = pk2(a0[2], a0[3]); p0.z = pk2(a1[0], a1[1]); p0.w = pk2(a1[2], a1[3]); p1.x = pk2(a2[0], a2[1]); p1.y = pk2(a2[2], a2[3]); p1.z = pk2(a3[0], a3[1]); p1.w = pk2(a3[2], a3[3]);
                f32x4 d = MFMA16(__builtin_bit_cast(bf16x8, p0), wb[0], ((f32x4){0.f, 0.f, 0.f, 0.f})); d = MFMA16(__builtin_bit_cast(bf16x8, p1), wb[1], d);
                const int t0 = 16 * tile + 4 * kg;
#pragma unroll
                for (int i = 0; i < 4; ++i) { d[i] *= expf(-(float)(t0 + i) * rl * delta); s += fabsf(d[i]); }
                *(LAS f32x4*)(HR + r16 * HRS + t0) = d; }
            s += __shfl_xor(s, 16); s += __shfl_xor(s, 32);
            if (F.lane < 16) red[F.wave * 16 + F.lane] = s;
            __syncthreads();
            for (int e = F.tid; e < 16 * L; e += NTHR) { const int col = e / L, t = e % L, dir = (col >> 2) & 1, o = col >> 3, c = cg * 4 + (col & 3);
                float tot = 0.f;
#pragma unroll
                for (int w = 0; w < 8; ++w) tot += red[w * 16 + (col & ~4)] + red[w * 16 + (col | 4)];
                float hv = HR[col * HRS + t] / tot; int idx = dir == 0 ? L - t : L + t;
                if (dir == 1 && t == 0) { idx = 0; hv = 0.f; }
                ((bf16_t*)(ws + WS_HYF) + ((size_t)lf * 1024 + o * 512 + c) * 4608)[(sel == 0 ? 0 : 4096) + idx] = (bf16_t)f2bf(hv); }
        }
    }
}
__device__ __forceinline__ void ph_norm2_router(KP Pk, Frame& F, int l, int rep) {
    unsigned char* ws = F.ws;
    const int gw = F.vcu * NWAVES + F.wave, NGW = F.G * NWAVES, nrows = l == 0 ? TT : TL;
    const float* mod = (const float*)(ws + WS_MOD) + (size_t)l * 9 * 12288;
    const bf16_t* X = (const bf16_t*)(ws + WS_X); unsigned char* Fo = ws + WS_H;
    LAS float* rw = (LAS float*)F.lds;
    volatile LAS unsigned* lcnt = F.MISC + 16;
    if (F.tid < 16) lcnt[F.tid] = 0u;
    for (int i = F.tid; i < 2048 * 4; i += NTHR) { const f32x4 w = ((const f32x4*)Pk->in[I_RW])[i]; const int k = i >> 2, e0 = (i & 3) * 4;
        rw[(e0 + 0) * 2048 + k] = w[0]; rw[(e0 + 1) * 2048 + k] = w[1]; rw[(e0 + 2) * 2048 + k] = w[2]; rw[(e0 + 3) * 2048 + k] = w[3]; }
    __syncthreads();
    float rb[16];
#pragma unroll
    for (int e = 0; e < 16; ++e) rb[e] = Pk->in[I_RB][e];
    for (int rowA = gw; rowA < nrows; rowA += 2 * NGW) {
        const bool hasB = rowA + NGW < nrows; const int rowB = hasB ? rowA + NGW : rowA;
        f32x4 va[8], vb[8];
        load_row_bf16(X + (size_t)rowA * D, F.lane, va); load_row_bf16(X + (size_t)rowB * D, F.lane, vb);
        { const int r = modrow_of(rowA); const float rstd = row_rstd(va); modulate(va, rstd, Pk->in[I_N2W] + l * D, mod + (size_t)r * 12288 + 3 * D, mod + (size_t)r * 12288 + 4 * D, F.lane); store_row_f8(Fo + (size_t)rowA * D, F.lane, va); }
        { const int r = modrow_of(rowB); const float rstd = row_rstd(vb); modulate(vb, rstd, Pk->in[I_N2W] + l * D, mod + (size_t)r * 12288 + 3 * D, mod + (size_t)r * 12288 + 4 * D, F.lane); if (hasB) store_row_f8(Fo + (size_t)rowB * D, F.lane, vb); }
        float pa[32];
#pragma unroll
        for (int e = 0; e < 16; ++e) { float a = 0.f, b = 0.f;
#pragma unroll
            for (int j = 0; j < 8; ++j) { const f32x4 w = ((const LAS f32x4*)(rw + e * 2048))[F.lane + 64 * j];
                a += (va[j][0] * w[0] + va[j][1] * w[1]) + (va[j][2] * w[2] + va[j][3] * w[3]); b += (vb[j][0] * w[0] + vb[j][1] * w[1]) + (vb[j][2] * w[2] + vb[j][3] * w[3]); }
            pa[e] = a; pa[16 + e] = b; }
#define RB_STEP(N, BIT) { const bool up = (F.lane & (BIT)) != 0; _Pragma("unroll") for (int k = 0; k < (N); ++k) { const float keep = up ? pa[(N) + k] : pa[k], send = up ? pa[k] : pa[(N) + k]; pa[k] = keep + __shfl_xor(send, (BIT)); } }
        RB_STEP(16, 32) RB_STEP(8, 16) RB_STEP(4, 8) RB_STEP(2, 4) RB_STEP(1, 2)
#undef RB_STEP
        const float red = pa[0] + __shfl_xor(pa[0], 1);
        float lg[16];
#pragma unroll
        for (int e = 0; e < 16; ++e) lg[e] = __shfl(red, (F.lane & 32) + 2 * e);
        float mx = lg[0];
#pragma unroll
        for (int e = 1; e < 16; ++e) mx = fmaxf(mx, lg[e]);
        float sum = 0.f;
#pragma unroll
        for (int e = 0; e < 16; ++e) { lg[e] = expf(lg[e] - mx); sum += lg[e]; }
        const float rs = 1.f / sum; float sel[16];
#pragma unroll
        for (int e = 0; e < 16; ++e) { lg[e] *= rs; sel[e] = lg[e] + rb[e]; }
        int grp = 0; float gbest = fmaxf(fmaxf(sel[0], sel[1]), fmaxf(sel[2], sel[3]));
#pragma unroll
        for (int g = 1; g < 4; ++g) { const float gm = fmaxf(fmaxf(sel[4 * g], sel[4 * g + 1]), fmaxf(sel[4 * g + 2], sel[4 * g + 3])); if (gm > gbest) { gbest = gm; grp = g; } }
        float s4[4], p4[4];
#pragma unroll
        for (int i = 0; i < 4; ++i) { s4[i] = grp == 0 ? sel[i] : grp == 1 ? sel[4 + i] : grp == 2 ? sel[8 + i] : sel[12 + i]; p4[i] = grp == 0 ? lg[i] : grp == 1 ? lg[4 + i] : grp == 2 ? lg[8 + i] : lg[12 + i]; }
        int i0 = 0; float b0 = s4[0];
#pragma unroll
        for (int i = 1; i < 4; ++i) if (s4[i] > b0) { b0 = s4[i]; i0 = i; }
        int i1 = -1; float b1 = 0.f;
#pragma unroll
        for (int i = 0; i < 4; ++i) if (i != i0 && (i1 < 0 || s4[i] > b1)) { b1 = s4[i]; i1 = i; }
        const float p0 = i0 == 0 ? p4[0] : i0 == 1 ? p4[1] : i0 == 2 ? p4[2] : p4[3], p1 = i1 == 0 ? p4[0] : i1 == 1 ? p4[1] : i1 == 2 ? p4[2] : p4[3];
        const int e0 = grp * 4 + i0, e1 = grp * 4 + i1; const float ws_ = 1.f / (p0 + p1);
        if (F.lane == 0 || (F.lane == 32 && hasB)) { const int row = F.lane == 0 ? rowA : rowB;
            ((int*)(ws + WS_RT + RT_E))[row] = e0 | (e1 << 8); ((f32x2*)(ws + WS_RT + RT_W))[row] = (f32x2){p0 * ws_, p1 * ws_};
            __hip_atomic_fetch_add((LAS unsigned*)&lcnt[e0], 1u, __ATOMIC_RELAXED, __HIP_MEMORY_SCOPE_WORKGROUP); __hip_atomic_fetch_add((LAS unsigned*)&lcnt[e1], 1u, __ATOMIC_RELAXED, __HIP_MEMORY_SCOPE_WORKGROUP); }
    }
    __syncthreads();
    { int t_; asm volatile("v_mbcnt_lo_u32_b32 %0, -1, 0\n\tv_mbcnt_hi_u32_b32 %0, -1, %0" : "=v"(t_)); t_ += F.wave * 64;
      if (t_ < 16 && lcnt[t_]) __hip_atomic_fetch_add(F.ctl + CW_CNT + 64 * (l + 2 * rep) + t_, lcnt[t_], __ATOMIC_RELAXED, __HIP_MEMORY_SCOPE_AGENT); }
}
__device__ __forceinline__ int moe_table(Frame& F, int l) {
    volatile LAS unsigned char* pexp = (volatile LAS unsigned char*)(F.MISC + 64);
    __syncthreads();
    if (F.tid < 64) {
        const int e = F.lane & 15; const int c = (int)__hip_atomic_load(F.ctl + CW_CNT + 64 * l + e, __ATOMIC_RELAXED, __HIP_MEMORY_SCOPE_AGENT);
        const int np = (c + 255) >> 8; int p0 = np;
#pragma unroll
        for (int d = 1; d < 16; d <<= 1) { const int y = __shfl(p0, F.lane - d); if (e >= d) p0 += y; }
        const int tot = __shfl(p0, 15); p0 -= np;
        if (F.lane < 16) { F.MISC[32 + e] = (unsigned)(p0 * 256); for (int j = 0; j < np; ++j) pexp[p0 + j] = (unsigned char)e; if (e == 0) F.MISC[2] = (unsigned)tot; }
    }
    __syncthreads();
    return (int)F.MISC[2];
}
__device__ __forceinline__ void ph_slots(KP Pk, Frame& F, int l) {
    unsigned char* ws = F.ws;
    const int nrows = l == 0 ? TT : TL, per = (nrows + F.G - 1) / F.G, t0 = blockIdx.x * per, t1 = min(nrows, t0 + per);
    (void)moe_table(F, l);
    volatile LAS unsigned* lcnt = F.MISC + 16; volatile LAS unsigned* lbase = F.MISC + 48;
    if (F.tid < 16) lcnt[F.tid] = 0u;
    __syncthreads();
    const int* RE = (const int*)(ws + WS_RT + RT_E); const f32x2* RW = (const f32x2*)(ws + WS_RT + RT_W);
    int* ROWTOK = (int*)(ws + WS_RT + RT_ROWTOK); float* ROWW = (float*)(ws + WS_RT + RT_ROWW);
    const int tok = t0 + F.tid; int e0 = 0, e1 = 0; unsigned q0 = 0, q1 = 0;
    if (tok < t1) { const int ee = RE[tok]; e0 = ee & 255; e1 = ee >> 8;
        q0 = __hip_atomic_fetch_add((LAS unsigned*)&lcnt[e0], 1u, __ATOMIC_RELAXED, __HIP_MEMORY_SCOPE_WORKGROUP); q1 = __hip_atomic_fetch_add((LAS unsigned*)&lcnt[e1], 1u, __ATOMIC_RELAXED, __HIP_MEMORY_SCOPE_WORKGROUP); }
    __syncthreads();
    if (F.tid < 16) lbase[F.tid] = lcnt[F.tid] ? __hip_atomic_fetch_add(F.ctl + CW_CUR + 64 * l + F.tid, lcnt[F.tid], __ATOMIC_RELAXED, __HIP_MEMORY_SCOPE_AGENT) : 0u;
    __syncthreads();
    if (tok < t1) { const f32x2 w = RW[tok]; const int r0 = (int)(F.MISC[32 + e0] + lbase[e0] + q0), r1 = (int)(F.MISC[32 + e1] + lbase[e1] + q1);
        ROWTOK[r0] = tok; ROWW[r0] = w.x; ROWTOK[r1] = tok | (1 << 30); ROWW[r1] = w.y; }
    if (blockIdx.x < NE) { const int e = blockIdx.x, c = (int)__hip_atomic_load(F.ctl + CW_CNT + 64 * l + e, __ATOMIC_RELAXED, __HIP_MEMORY_SCOPE_AGENT), base = (int)F.MISC[32 + e];
        for (int i = c + F.tid; i < ((c + 255) & ~255); i += NTHR) { ROWTOK[base + i] = -1; ROWW[base + i] = 0.f; } }
}
__device__ __forceinline__ void ph_final(KP Pk, Frame& F) {
    unsigned char* ws = F.ws;
    const int gw = F.vcu * NWAVES + F.wave, NGW = F.G * NWAVES;
    const bf16_t* X = (const bf16_t*)(ws + WS_X); const unsigned char* Y2 = ws + WS_Y2;
    for (int rowA = gw; rowA < TL; rowA += 2 * NGW) { f32x4 va[8], vb[8];
        const bool hasB = rowA + NGW < TL; const int rowB = hasB ? rowA + NGW : rowA;
        load_row_bf16(X + (size_t)rowA * D, F.lane, va); load_row_bf16(X + (size_t)rowB * D, F.lane, vb);
        add_y2(Y2 + (size_t)rowA * D, Y2 + ((size_t)TT + rowA) * D, (const float*)(ws + WS_MOD) + ((size_t)9 + (rowA >> 11)) * 12288 + 5 * D, F.lane, va);
        add_y2(Y2 + (size_t)rowB * D, Y2 + ((size_t)TT + rowB) * D, (const float*)(ws + WS_MOD) + ((size_t)9 + (rowB >> 11)) * 12288 + 5 * D, F.lane, vb);
#pragma unroll
        for (int j = 0; j < 8; ++j) ((f32x4*)(Pk->out + (size_t)rowA * D))[F.lane + 64 * j] = va[j];
        if (hasB) {
#pragma unroll
            for (int j = 0; j < 8; ++j) ((f32x4*)(Pk->out + (size_t)rowB * D))[F.lane + 64 * j] = vb[j]; } }
}

__device__ __forceinline__ void ph_gate_cols(Frame& F, int l) {
    unsigned char* ws = F.ws;
    const int r32 = F.lane & 31, hi = F.lane >> 5;
    const bf16_t* H = (const bf16_t*)(ws + WS_H); const bf16_t* Wa = (const bf16_t*)(ws + WS_WA) + (size_t)l * 32 * D; float* AG = (float*)(ws + WS_AG);
    LAS unsigned char* tile = F.lds + F.wave * 16896;
    LAS float* red = (LAS float*)F.lds;
    for (int it = blockIdx.x; it < TT / 32; it += F.G) {
        const int kb = F.wave * 256;
        u32x4 av[16]; bf16x8 bv[16];
#pragma unroll
        for (int i = 0; i < 16; ++i) { const int id = F.lane + 64 * i; av[i] = *(const u32x4*)(H + (size_t)(it * 32 + (id >> 5)) * D + kb + 8 * (id & 31)); }
#pragma unroll
        for (int ks = 0; ks < 16; ++ks) bv[ks] = *(const bf16x8*)(Wa + (size_t)r32 * D + kb + 16 * ks + 8 * hi);
        __syncthreads();
#pragma unroll
        for (int i = 0; i < 16; ++i) { const int id = F.lane + 64 * i; *(LAS u32x4*)(tile + ((id >> 5) * 264 + 8 * (id & 31)) * 2) = av[i]; }
        f32x16 acc = {};
#pragma unroll
        for (int ks = 0; ks < 16; ++ks) { const bf16x8 a = *(const LAS bf16x8*)(tile + (r32 * 264 + 16 * ks + 8 * hi) * 2); acc = MFMA32(a, bv[ks], acc); }
        __syncthreads();
#pragma unroll
        for (int r = 0; r < 16; ++r) red[(F.wave * 16 + r) * 64 + F.lane] = acc[r];
        __syncthreads();
        for (int e = F.tid; e < 1024; e += NTHR) { float sum = 0.f;
#pragma unroll
            for (int w = 0; w < 8; ++w) sum += red[w * 1024 + e];
            const int r = e >> 6, ln = e & 63; AG[(size_t)(it * 32 + (r & 3) + 8 * (r >> 2) + 4 * (ln >> 5)) * 32 + (ln & 31)] = sum; }
    }
}

__device__ __forceinline__ void ph_gate_cols8(Frame& F, int l) {
    unsigned char* ws = F.ws;
    const int fr = F.lane & 15, fq = F.lane >> 4, kb = F.wave * 256;
    const unsigned char* H8 = ws + WS_H; const unsigned char* Wa8 = ws + WS_WA + (size_t)l * 32 * D * 2; float* AG = (float*)(ws + WS_AG);
    LAS f32x4* red = (LAS f32x4*)F.lds;
    int f8scale = 0x7f7f7f7f; asm volatile("" : "+v"(f8scale));
    i32x8 b[2][2], a[2][2];
#pragma unroll
    for (int ch = 0; ch < 2; ++ch)
#pragma unroll
        for (int ks = 0; ks < 2; ++ks) b[ch][ks] = *(const i32x8*)(Wa8 + (size_t)(16 * ch + fr) * D + kb + 128 * ks + 32 * fq);
    int it = blockIdx.x;
    if (it < TT / 32) {
#pragma unroll
        for (int rh = 0; rh < 2; ++rh)
#pragma unroll
            for (int ks = 0; ks < 2; ++ks) a[rh][ks] = *(const i32x8*)(H8 + (size_t)(it * 32 + 16 * rh + fr) * D + kb + 128 * ks + 32 * fq); }
    for (; it < TT / 32; it += F.G) {
        f32x4 acc[2][2];
#pragma unroll
        for (int rh = 0; rh < 2; ++rh)
#pragma unroll
            for (int ch = 0; ch < 2; ++ch) acc[rh][ch] = (f32x4){0.f, 0.f, 0.f, 0.f};
#pragma unroll
        for (int ks = 0; ks < 2; ++ks)
#pragma unroll
            for (int rh = 0; rh < 2; ++rh)
#pragma unroll
                for (int ch = 0; ch < 2; ++ch)
                    asm volatile("v_mfma_scale_f32_16x16x128_f8f6f4 %0, %1, %2, %0, %3, %3 op_sel_hi:[0,0,0]" : "+v"(acc[rh][ch]) : "v"(b[ch][ks]), "v"(a[rh][ks]), "v"(f8scale));
        asm volatile("s_nop 15\n\ts_nop 15" : "+v"(acc[0][0]), "+v"(acc[0][1]), "+v"(acc[1][0]), "+v"(acc[1][1]) :: "memory");
        const int nx = it + F.G;
        if (nx < TT / 32) {
#pragma unroll
            for (int rh = 0; rh < 2; ++rh)
#pragma unroll
                for (int ks = 0; ks < 2; ++ks) a[rh][ks] = *(const i32x8*)(H8 + (size_t)(nx * 32 + 16 * rh + fr) * D + kb + 128 * ks + 32 * fq); }
        __syncthreads();
#pragma unroll
        for (int rh = 0; rh < 2; ++rh)
#pragma unroll
            for (int ch = 0; ch < 2; ++ch) red[(F.wave * 4 + rh * 2 + ch) * 64 + F.lane] = acc[rh][ch];
        __syncthreads();
        for (int e = F.tid; e < 1024; e += NTHR) { float sum = 0.f;
#pragma unroll
            for (int w = 0; w < 8; ++w) sum += ((const LAS float*)red)[w * 1024 + e];
            const int blk = e >> 8, ln = (e >> 2) & 63, k = e & 3;
            AG[(size_t)(it * 32 + 16 * (blk >> 1) + (ln & 15)) * 32 + 16 * (blk & 1) + 4 * (ln >> 4) + k] = sum * (1.f / 32.f); }
    }
}

constexpr int WAVE_LDS = 17408;
__device__ __forceinline__ int perm16(int k) { return (k & 3) + 4 * ((k >> 3) & 1) + 8 * ((k >> 2) & 1); }
__device__ __forceinline__ int gla_kidx(int dir, int s) { return dir == 0 ? s : (s < LC ? LC - 1 - s : LC + (SEQ - 1 - (s - LC))); }
constexpr int GL_QT = 0, GL_KT = 1280, GL_KHT = 2560, GL_VT = 4096, GL_PT = 7168, GL_ST = 7936, GL_G = 13056, GL_GW = 13312, GL_GB = 15360;
__device__ __forceinline__ void gla_load_gates(KP Pk, Frame& F, int l, int h, int dir, LAS unsigned char* wl) {
    LAS float* gw = (LAS float*)(wl + GL_GW); LAS float* gb = (LAS float*)(wl + GL_GB);
    const float* src = Pk->in[I_GGW] + ((size_t)(l * 2 + dir) * 16) * 256 + h * 32;
#pragma unroll
    for (int i = 0; i < 8; ++i) { const int e = F.lane + 64 * i; gw[e] = src[(e >> 5) * 256 + (e & 31)]; }
    if (F.lane < 32) gb[F.lane] = Pk->in[I_GGB][(l * 2 + dir) * 256 + h * 32 + F.lane];
}
struct GlaIn { f32x4 ag[4]; u32x4 kv, qv, v0, v1; };
template <bool NEEDQ>
__device__ __forceinline__ void gla_sub_load(Frame& F, int b, int h, int dir, int kidx0, GlaIn& in) {
    unsigned char* ws = F.ws;
    int lane_o = F.lane; asm volatile("" : "+v"(lane_o));
    const int tau = lane_o & 15, dq = lane_o >> 4, row = keyrow(b, kidx0 + tau);
    const f32x4* ag = (const f32x4*)((const float*)(ws + WS_AG) + (size_t)row * 32 + dir * 16);
#pragma unroll
    for (int r4 = 0; r4 < 4; ++r4) in.ag[r4] = ag[r4];
    const bf16_t* U = (const bf16_t*)(ws + WS_U) + (size_t)row * NU;
    in.kv = *(const u32x4*)(U + UC_GK + h * 32 + dq * 8);
    if (NEEDQ) in.qv = *(const u32x4*)(U + UC_GQ + h * 32 + dq * 8);
    in.v0 = *(const u32x4*)(U + UC_GV + h * 64 + dq * 16); in.v1 = *(const u32x4*)(U + UC_GV + h * 64 + dq * 16 + 8);
}
template <bool NEEDQ>
__device__ __forceinline__ void gla_sub_prep(Frame& F, int dir, const GlaIn& in, LAS unsigned char* wl, float (&ltot)[8]) {
    int lane_o = F.lane; asm volatile("" : "+v"(lane_o));
    const int tau = lane_o & 15, dq = lane_o >> 4;
    const LAS float* gw = (const LAS float*)(wl + GL_GW) + dq * 8; const LAS float* gb = (const LAS float*)(wl + GL_GB) + dq * 8;
    const f32x4* ag = in.ag;
    float x[8];
    { const f32x4 b0 = *(const LAS f32x4*)gb, b1 = *(const LAS f32x4*)(gb + 4); x[0] = b0[0]; x[1] = b0[1]; x[2] = b0[2]; x[3] = b0[3]; x[4] = b1[0]; x[5] = b1[1]; x[6] = b1[2]; x[7] = b1[3]; }
#pragma unroll
    for (int r4 = 0; r4 < 4; ++r4) { const f32x4 av = ag[r4];
#pragma unroll
        for (int rr = 0; rr < 4; ++rr) { const f32x4 w0 = *(const LAS f32x4*)(gw + (4 * r4 + rr) * 32), w1 = *(const LAS f32x4*)(gw + (4 * r4 + rr) * 32 + 4);
            x[0] += av[rr] * w0[0]; x[1] += av[rr] * w0[1]; x[2] += av[rr] * w0[2]; x[3] += av[rr] * w0[3]; x[4] += av[rr] * w1[0]; x[5] += av[rr] * w1[1]; x[6] += av[rr] * w1[2]; x[7] += av[rr] * w1[3]; } }
#pragma unroll
    for (int j = 0; j < 8; ++j) x[j] = (fminf(x[j], 0.f) - __logf(1.f + __expf(-fabsf(x[j])))) * (1.f / 16.f);
#pragma unroll
    for (int dl = 1; dl < 16; dl <<= 1) { const int src = dir == 0 ? F.lane - dl : F.lane + dl; const bool ok = dir == 0 ? (tau >= dl) : (tau + dl <= 15);
#pragma unroll
        for (int j = 0; j < 8; ++j) { const float y = __shfl(x[j], src); x[j] += ok ? y : 0.f; } }
    float tot[8];
#pragma unroll
    for (int j = 0; j < 8; ++j) { tot[j] = __shfl(x[j], (lane_o & 48) + (dir == 0 ? 15 : 0)); ltot[j] += tot[j]; }
    const u32x4 kv = in.kv;
    const float kf[8] = {bflo(kv.x), bfhi(kv.x), bflo(kv.y), bfhi(kv.y), bflo(kv.z), bfhi(kv.z), bflo(kv.w), bfhi(kv.w)};
    float kt[8], kh[8];
#pragma unroll
    for (int j = 0; j < 8; ++j) { kt[j] = kf[j] * __expf(-x[j]); kh[j] = kf[j] * __expf(tot[j] - x[j]); }
    { u32x4 w; w.x = pk2(kt[0], kt[1]); w.y = pk2(kt[2], kt[3]); w.z = pk2(kt[4], kt[5]); w.w = pk2(kt[6], kt[7]); *(LAS u32x4*)(wl + GL_KT + (tau * 40 + dq * 8) * 2) = w; }
#pragma unroll
    for (int j = 0; j < 8; ++j) *(LAS unsigned short*)(wl + GL_KHT + ((dq * 8 + j) * 24 + tau) * 2) = (unsigned short)f2bf(kh[j]);
    if (NEEDQ) { const u32x4 qv = in.qv; const float sc = 0.17677669529663687f;
        const float qf[8] = {bflo(qv.x), bfhi(qv.x), bflo(qv.y), bfhi(qv.y), bflo(qv.z), bfhi(qv.z), bflo(qv.w), bfhi(qv.w)}; float qt[8];
#pragma unroll
        for (int j = 0; j < 8; ++j) qt[j] = qf[j] * sc * __expf(x[j]);
        u32x4 w; w.x = pk2(qt[0], qt[1]); w.y = pk2(qt[2], qt[3]); w.z = pk2(qt[4], qt[5]); w.w = pk2(qt[6], qt[7]); *(LAS u32x4*)(wl + GL_QT + (tau * 40 + dq * 8) * 2) = w; }
    if (tau == 0) {
#pragma unroll
        for (int j = 0; j < 8; ++j) ((LAS float*)(wl + GL_G))[dq * 8 + j] = __expf(tot[j]); }
    { const u32x4 v0 = in.v0, v1 = in.v1;
      const unsigned vw[8] = {v0.x, v0.y, v0.z, v0.w, v1.x, v1.y, v1.z, v1.w};
#pragma unroll
      for (int j = 0; j < 8; ++j) { *(LAS unsigned short*)(wl + GL_VT + ((dq * 16 + 2 * j) * 24 + tau) * 2) = (unsigned short)(vw[j] & 0xffffu); *(LAS unsigned short*)(wl + GL_VT + ((dq * 16 + 2 * j + 1) * 24 + tau) * 2) = (unsigned short)(vw[j] >> 16); } }
}
__device__ __forceinline__ void gla_state_update(Frame& F, LAS unsigned char* wl, f32x4 (&Sr)[2][4]) {
    int lane_o = F.lane; asm volatile("" : "+v"(lane_o));
    const int r16 = lane_o & 15, kg = lane_o >> 4; const bf16x8 zf = {0, 0, 0, 0, 0, 0, 0, 0};
    bf16x8 vb[4];
#pragma unroll
    for (int nb = 0; nb < 4; ++nb) { vb[nb] = *(const LAS bf16x8*)(wl + GL_VT + ((16 * nb + r16) * 24 + 8 * (kg & 1)) * 2); if (kg >= 2) vb[nb] = zf; }
#pragma unroll
    for (int db = 0; db < 2; ++db) { const f32x4 gv = *(const LAS f32x4*)(wl + GL_G + (16 * db + 4 * kg) * 4);
        bf16x8 ka = *(const LAS bf16x8*)(wl + GL_KHT + ((16 * db + r16) * 24 + 8 * (kg & 1)) * 2); if (kg >= 2) ka = zf;
#pragma unroll
        for (int nb = 0; nb < 4; ++nb) Sr[db][nb] = MFMA16(ka, vb[nb], Sr[db][nb] * gv); }
}
constexpr int GGRP = 6, NGRP = NCH / GGRP;
constexpr size_t WS_GGS = WS_GSS, WS_GGA = WS_GSS + 8 * MiB;
__device__ __forceinline__ void gla_pass_a(KP Pk, Frame& F, int l, int it, LAS unsigned char* wl) {
    unsigned char* ws = F.ws;
    const int seq = it / NGRP, g = it % NGRP, dir = seq & 1, h = (seq >> 1) & 7, b = seq >> 4, r16 = F.lane & 15, kg = F.lane >> 4;
    gla_load_gates(Pk, F, l, h, dir, wl);
    f32x4 Sr[2][4];
#pragma unroll
    for (int db = 0; db < 2; ++db)
#pragma unroll
        for (int nb = 0; nb < 4; ++nb) Sr[db][nb] = (f32x4){0.f, 0.f, 0.f, 0.f};
    float ltot[8] = {0.f, 0.f, 0.f, 0.f, 0.f, 0.f, 0.f, 0.f};
    GlaIn nin;
    { const int c0 = g * GGRP; gla_sub_load<false>(F, b, h, dir, (dir == 0 ? 64 * c0 : gla_kidx(1, 64 * c0) - 63) + 16 * (dir == 0 ? 0 : 3), nin); }
#pragma unroll 1
    for (int cg = 0; cg <= GGRP; ++cg) {
        const int c = g * GGRP + cg;
        float* sl = cg < GGRP ? (float*)(ws + WS_GSL) + ((size_t)seq * NCH + c) * 2048 : (float*)(ws + WS_GGS) + ((size_t)seq * NGRP + g) * 2048;
        float* al = cg < GGRP ? (float*)(ws + WS_GAE) + ((size_t)seq * NCH + c) * 32 : (float*)(ws + WS_GGA) + ((size_t)seq * NGRP + g) * 32;
#pragma unroll
        for (int db = 0; db < 2; ++db)
#pragma unroll
            for (int nb = 0; nb < 4; ++nb)
#pragma unroll
                for (int i = 0; i < 4; ++i) sl[(16 * db + 4 * kg + i) * 64 + 16 * nb + r16] = Sr[db][nb][i];
        if ((F.lane & 15) == 0) {
#pragma unroll
            for (int j = 0; j < 8; ++j) al[kg * 8 + j] = __expf(ltot[j]); }
        if (cg == GGRP) break;
#pragma unroll 1
        for (int st = 0; st < 4; ++st) {
            const GlaIn cur = nin;
            { const int q2 = cg * 4 + st + 1, c2 = g * GGRP + (q2 >> 2), st2 = q2 & 3, sb2 = dir == 0 ? st2 : 3 - st2;
              if (q2 < 4 * GGRP) gla_sub_load<false>(F, b, h, dir, (dir == 0 ? 64 * c2 : gla_kidx(1, 64 * c2) - 63) + 16 * sb2, nin); }
            gla_sub_prep<false>(F, dir, cur, wl, ltot);
            gla_state_update(F, wl, Sr); }
    }
}
__device__ __forceinline__ void gla_pass_b(KP Pk, Frame& F, int l, int b, int h, int c, LAS unsigned char* wl) {
    unsigned char* ws = F.ws;
    const int r16 = F.lane & 15, kg = F.lane >> 4, seq = (b * 8 + h) * 2; const bf16x8 zf = {0, 0, 0, 0, 0, 0, 0, 0};
    const bf16_t* U = (const bf16_t*)(ws + WS_U); unsigned char* MIX = ws + WS_H;
    u32x2 of[4][4];
#pragma unroll 1
    for (int dir = 0; dir < 2; ++dir) {
        gla_load_gates(Pk, F, l, h, dir, wl);
        const int cc = dir == 0 ? c : (c < 4 ? 3 - c : 39 - c);
        f32x4 Sr[2][4];
#pragma unroll
        for (int db = 0; db < 2; ++db)
#pragma unroll
            for (int nb = 0; nb < 4; ++nb) Sr[db][nb] = (f32x4){0.f, 0.f, 0.f, 0.f};
        { const int gsel = cc / GGRP;
#pragma unroll 1
          for (int gp = 0; gp <= gsel; ++gp) {
            const bool fin = gp == gsel;
            const float* sp = fin ? (const float*)(ws + WS_GSL) + ((size_t)(seq + dir) * NCH + cc) * 2048 : (const float*)(ws + WS_GGS) + ((size_t)(seq + dir) * NGRP + gp) * 2048;
            const float* apx = fin ? (const float*)(ws + WS_GAE) + ((size_t)(seq + dir) * NCH + cc) * 32 : (const float*)(ws + WS_GGA) + ((size_t)(seq + dir) * NGRP + gp) * 32;
#pragma unroll
            for (int db = 0; db < 2; ++db) { const f32x4 av = *(const f32x4*)(apx + 16 * db + 4 * kg);
#pragma unroll
                for (int nb = 0; nb < 4; ++nb)
#pragma unroll
                    for (int i = 0; i < 4; ++i) Sr[db][nb][i] = av[i] * Sr[db][nb][i] + sp[(16 * db + 4 * kg + i) * 64 + 16 * nb + r16]; } } }
        float ltot[8] = {0.f, 0.f, 0.f, 0.f, 0.f, 0.f, 0.f, 0.f};
#pragma unroll 1
        for (int st = 0; st < 4; ++st) { const int sb = dir == 0 ? st : 3 - st;
            int lane_o = F.lane; asm volatile("" : "+v"(lane_o)); const int r16 = lane_o & 15, kg = lane_o >> 4;
#pragma unroll
            for (int db = 0; db < 2; ++db)
#pragma unroll
                for (int nb = 0; nb < 4; ++nb) { u32x2 w; w.x = pk2(Sr[db][nb][0], Sr[db][nb][1]); w.y = pk2(Sr[db][nb][2], Sr[db][nb][3]); *(LAS u32x2*)(wl + GL_ST + ((16 * nb + r16) * 40 + 16 * db + 4 * kg) * 2) = w; }
            { GlaIn in; gla_sub_load<true>(F, b, h, dir, 64 * c + 16 * sb, in); gla_sub_prep<true>(F, dir, in, wl, ltot); }
            const bf16x8 bq = *(const LAS bf16x8*)(wl + GL_QT + (r16 * 40 + 8 * kg) * 2);
            { const bf16x8 ka = *(const LAS bf16x8*)(wl + GL_KT + (r16 * 40 + 8 * kg) * 2);
              f32x4 p = MFMA16(ka, bq, ((f32x4){0.f, 0.f, 0.f, 0.f}));
#pragma unroll
              for (int i = 0; i < 4; ++i) { const int sidx = 4 * kg + i; const bool keep = dir == 0 ? (sidx <= r16) : (sidx >= r16); p[i] = keep ? p[i] : 0.f; }
              u32x2 w; w.x = pk2(p[0], p[1]); w.y = pk2(p[2], p[3]); *(LAS u32x2*)(wl + GL_PT + (r16 * 24 + 4 * kg) * 2) = w; }
            bf16x8 pb = *(const LAS bf16x8*)(wl + GL_PT + (r16 * 24 + 8 * (kg & 1)) * 2); if (kg >= 2) pb = zf;
            f32x4 o[4];
#pragma unroll
            for (int nb = 0; nb < 4; ++nb) { const bf16x8 sa = *(const LAS bf16x8*)(wl + GL_ST + ((16 * nb + r16) * 40 + 8 * kg) * 2);
                bf16x8 va = *(const LAS bf16x8*)(wl + GL_VT + ((16 * nb + r16) * 24 + 8 * (kg & 1)) * 2); if (kg >= 2) va = zf;
                o[nb] = MFMA16(sa, bq, ((f32x4){0.f, 0.f, 0.f, 0.f})); o[nb] = MFMA16(va, pb, o[nb]); }
            if (dir == 0) { u32x2 t[4];
#pragma unroll
                for (int nb = 0; nb < 4; ++nb) { t[nb].x = pk2(o[nb][0], o[nb][1]); t[nb].y = pk2(o[nb][2], o[nb][3]); }
#define OF_PUT(k) { _Pragma("unroll") for (int nb = 0; nb < 4; ++nb) of[k][nb] = t[nb]; }
                if (sb == 0) OF_PUT(0) else if (sb == 1) OF_PUT(1) else if (sb == 2) OF_PUT(2) else OF_PUT(3)
#undef OF_PUT
            }
            else { float ss = 0.f; u32x2 t[4];
#define OF_GET(k) { _Pragma("unroll") for (int nb = 0; nb < 4; ++nb) t[nb] = of[k][nb]; }
                if (sb == 0) OF_GET(0) else if (sb == 1) OF_GET(1) else if (sb == 2) OF_GET(2) else OF_GET(3)
#undef OF_GET
#pragma unroll
                for (int nb = 0; nb < 4; ++nb) { o[nb][0] += bflo(t[nb].x); o[nb][1] += bfhi(t[nb].x); o[nb][2] += bflo(t[nb].y); o[nb][3] += bfhi(t[nb].y); ss += (o[nb][0] * o[nb][0] + o[nb][1] * o[nb][1]) + (o[nb][2] * o[nb][2] + o[nb][3] * o[nb][3]); }
                ss += __shfl_xor(ss, 16); ss += __shfl_xor(ss, 32);
                const float rstd = rsqrtf(ss * (1.f / 64.f) + NORM_EPS); const int row = keyrow(b, 64 * c + 16 * sb + r16);
#pragma unroll
                for (int nb = 0; nb < 4; ++nb) { const int dv0 = 16 * nb + 4 * kg; const u32x2 gg = *(const u32x2*)(U + (size_t)row * NU + UC_GG + h * 64 + dv0); const f32x4 nw = *(const f32x4*)(Pk->in[I_GNW] + l * 64 + dv0);
                    const float y0 = o[nb][0] * rstd * nw[0] * silu_f(bflo(gg.x)), y1 = o[nb][1] * rstd * nw[1] * silu_f(bfhi(gg.x)), y2 = o[nb][2] * rstd * nw[2] * silu_f(bflo(gg.y)), y3 = o[nb][3] * rstd * nw[3] * silu_f(bfhi(gg.y));
                    if (WOUT_F8) *(unsigned*)(MIX + ((size_t)row * D + h * 64 + dv0)) = pk4_f8(y0, y1, y2, y3);
                    else { u32x2 w; w.x = pk2(y0, y1); w.y = pk2(y2, y3); *(u32x2*)(MIX + ((size_t)row * D + h * 64 + dv0) * 2) = w; } } }
            if (st < 3) gla_state_update(F, wl, Sr);
        }
    }
}
__device__ __forceinline__ void prep_qk_row(KP Pk, Frame& F, int l, int row) {
    unsigned char* ws = F.ws;
    bf16_t* U = (bf16_t*)(ws + WS_U) + (size_t)row * NU;
    const bool lat = row < TL; const int t = row & (SEQ - 1), f = F.lane & 15;
    float cs = 1.f, sn = 0.f;
    if (lat) { const float* rp = (const float*)(ws + WS_ROPE) + (size_t)t * 64 + (F.lane < 32 ? 0 : 32); cs = rp[f]; sn = rp[16 + f]; if (!(F.lane & 16)) sn = -sn; }
    const float wsq = Pk->in[I_SQN][l * 64 + F.lane], wsk = Pk->in[I_SKN][l * 64 + F.lane], wdq = Pk->in[I_DQN][l * 64 + F.lane], wdk = Pk->in[I_DKN][l * 64 + F.lane];
    const float qs = 0.125f * LOG2E;
    float xs[26];
#pragma unroll
    for (int v = 0; v < 26; ++v) { const int c0 = v < 8 ? UC_SQ + 64 * v : v < 10 ? UC_SK + 64 * (v - 8) : v < 18 ? UC_DQ + 64 * (v - 10) : UC_DK + 64 * (v - 18); xs[v] = bf2f(U[c0 + F.lane]); }
#pragma unroll
    for (int v = 0; v < 26; ++v) {
        int c0; float w;
        if (v < 8) { c0 = UC_SQ + 64 * v; w = wsq * qs; } else if (v < 10) { c0 = UC_SK + 64 * (v - 8); w = wsk; } else if (v < 18) { c0 = UC_DQ + 64 * (v - 10); w = wdq * qs; } else { c0 = UC_DK + 64 * (v - 18); w = wdk; }
        const float x = xs[v];
        const float y = x * rsqrtf(wave_sum(x * x) * (1.f / 64.f) + NORM_EPS) * w;
        const float yp = __shfl_xor(y, 16);
        U[c0 + F.lane] = (bf16_t)f2bf(y * cs + yp * sn);
    }
}
template <bool PERMK, int NCOLS, class SRC>
__device__ __forceinline__ void tile_transpose(LAS unsigned char* wl, int lane, bf16_t* dst, size_t dst_stride, const SRC& src) {
    LAS unsigned* tl = (LAS unsigned*)wl;
    constexpr int ncols = NCOLS, cpr = NCOLS / 8;
    LDS_WAIT(); asm volatile("" ::: "memory");
#pragma unroll 1
    for (int k0 = 0; k0 < cpr; k0 += 4) { u32x4 v[4];
#pragma unroll
      for (int k = 0; k < 4; ++k) { const int id = lane + 64 * (k0 + k); v[k] = src(id / cpr, id % cpr); }
#pragma unroll
      for (int k = 0; k < 4; ++k) { const int id = lane + 64 * (k0 + k); LAS unsigned* p = tl + (id / cpr) * 65 + (id % cpr) * 4; p[0] = v[k].x; p[1] = v[k].y; p[2] = v[k].z; p[3] = v[k].w; } }
    LDS_WAIT(); asm volatile("" ::: "memory");
    const LAS unsigned short* ts = (const LAS unsigned short*)wl;
    const int cc = lane & 7;
    for (int dv = lane >> 3; dv < ncols; dv += 8) {
        unsigned short e[8];
#pragma unroll
        for (int i = 0; i < 8; ++i) { const int p = 8 * cc + i, srow = PERMK ? ((p & ~15) + perm16(p & 15)) : p; e[i] = ts[srow * 130 + dv]; }
        u32x4 o; o.x = e[0] | ((unsigned)e[1] << 16); o.y = e[2] | ((unsigned)e[3] << 16); o.z = e[4] | ((unsigned)e[5] << 16); o.w = e[6] | ((unsigned)e[7] << 16);
        *(u32x4*)(dst + (size_t)dv * dst_stride + 8 * cc) = o; }
}
__device__ __forceinline__ void ph_prep(KP Pk, Frame& F, int l, int rep) {
    unsigned char* ws = F.ws;
    const int gw = F.vcu * NWAVES + F.wave, NGW = F.G * NWAVES;
    LAS unsigned char* wl = F.lds + F.wave * WAVE_LDS;
    const bf16_t* U = (const bf16_t*)(ws + WS_U);
    const int n_gla = 128 * NGRP, n_hy = NB * (l == 0 ? 36 : 32) * 12, n_vd = NB * 4 * 36, n_vs = NB * 2 * 36, n_rows = rep ? 0 : TT / 4;
    if (gw < n_gla) { gla_pass_a(Pk, F, l, gw, wl); }
    const int total = n_hy + n_vd + n_vs + n_rows, nrest = NGW - n_gla;
    for (int it0 = gw - n_gla; it0 < total && gw >= n_gla; it0 += nrest) {
        int it = it0;
        if (it < n_hy) {
            const int ntile = l == 0 ? 36 : 32, b = it / (ntile * 12), r = it % (ntile * 12), tile = r / 12, cb = r % 12, c0 = cb * 128;
            const bool lat = tile < 32; const int p0 = lat ? 64 * tile : 64 * (tile - 32), Ls = lat ? SEQ : LC, rbase = lat ? b * SEQ : TL + b * LC;
            const float* cw = Pk->in[I_HCW] + (size_t)l * 3 * 1536 + c0 + (F.lane & 15) * 8; const float* cbias = Pk->in[I_HCB] + (size_t)l * 1536 + c0 + (F.lane & 15) * 8;
            float w0[8], w1[8], w2[8], wb[8];
#pragma unroll
            for (int k = 0; k < 8; ++k) { w0[k] = cw[k]; w1[k] = cw[1536 + k]; w2[k] = cw[3072 + k]; wb[k] = cbias[k]; }
            auto src = [&](int i, int ch) -> u32x4 { const int p = p0 + i; const bf16_t* up = U + (size_t)(rbase + p) * NU + UC_HY + c0 + ch * 8;
                const u32x4 m = *(const u32x4*)up; u32x4 a = {0u, 0u, 0u, 0u}, c = {0u, 0u, 0u, 0u};
                if (p > 0) a = *(const u32x4*)(up - NU); if (p + 1 < Ls) c = *(const u32x4*)(up + NU);
                const unsigned av[4] = {a.x, a.y, a.z, a.w}, mv[4] = {m.x, m.y, m.z, m.w}, cv[4] = {c.x, c.y, c.z, c.w}; unsigned o[4];
#pragma unroll
                for (int q = 0; q < 4; ++q) { const int k = 2 * q;
                    const float z0 = bflo(av[q]) * w0[k] + bflo(mv[q]) * w1[k] + bflo(cv[q]) * w2[k] + wb[k];
                    const float z1 = bfhi(av[q]) * w0[k + 1] + bfhi(mv[q]) * w1[k + 1] + bfhi(cv[q]) * w2[k + 1] + wb[k + 1];
                    o[q] = pk2(z0, z1); }
                return (u32x4){o[0], o[1], o[2], o[3]}; };
            tile_transpose<false, 128>(wl, F.lane, (bf16_t*)(ws + WS_ZT) + ((size_t)b * 1536 + c0) * KEYS + (lat ? p0 : SEQ + p0), KEYS, src);
            continue; } it -= n_hy;
        if (it < n_vd) {
            const int b = it / 144, r = it % 144, h = r / 36, tile = r % 36;
            auto src = [&](int i, int ch) -> u32x4 { return *(const u32x4*)(U + (size_t)keyrow(b, 64 * tile + i) * NU + UC_DV + h * 128 + ch * 8); };
            tile_transpose<true, 128>(wl, F.lane, (bf16_t*)(ws + WS_VTD) + ((size_t)(b * 4 + h) * 128) * KEYS + 64 * tile, KEYS, src);
            continue; } it -= n_vd;
        if (it < n_vs) {
            const int b = it / 72, r = it % 72, h = r / 36, tile = r % 36;
            auto src = [&](int i, int ch) -> u32x4 { return *(const u32x4*)(U + (size_t)keyrow(b, 64 * tile + i) * NU + UC_SV + h * 64 + ch * 8); };
            tile_transpose<true, 64>(wl, F.lane, (bf16_t*)(ws + WS_VTS) + ((size_t)(b * 2 + h) * 64) * KEYS + 64 * tile, KEYS, src);
            continue; } it -= n_vs;
        for (int q = 0; q < 4; ++q) prep_qk_row(Pk, F, l, it * 4 + q);
    }
}
__device__ __forceinline__ void ph_gla_scan(Frame& F) {
    unsigned char* ws = F.ws;
    const int gw = F.vcu * NWAVES + F.wave, NGW = F.G * NWAVES;
    for (int it = gw; it < 128 * 32; it += NGW) { const int seq = it >> 5, d = it & 31;
        const float* sl = (const float*)(ws + WS_GSL) + (size_t)seq * NCH * 2048 + d * 64 + F.lane; float* ss = (float*)(ws + WS_GSS) + (size_t)seq * NCH * 2048 + d * 64 + F.lane;
        const float* ae = (const float*)(ws + WS_GAE) + (size_t)seq * NCH * 32 + d;
        float x[NCH], a[NCH];
#pragma unroll
        for (int c = 0; c < NCH; ++c) { x[c] = sl[(size_t)c * 2048]; a[c] = ae[c * 32]; }
        float S = 0.f;
#pragma unroll
        for (int c = 0; c < NCH; ++c) { ss[(size_t)c * 2048] = S; S = a[c] * S + x[c]; }
    }
}

__device__ __forceinline__ int crow(int r, int hi) { return (r & 3) + 8 * (r >> 2) + 4 * hi; }
template <int KW, int DV, bool MASK>
__device__ __forceinline__ void attn_core(Frame& F, const bf16_t* U, int b, int kcol0, const bf16_t* VT, int nctx, int nloc, int loc0,
                                          const bf16x8 (&q)[4], int koff, int qpos0, float sh2, f32x16 (&O)[DV / 32], float& lsum) {
    constexpr int KRB = KW * 2, KB = 64 * KRB, VB = DV * 128, SLOT = KB + VB, NKC = KB / 8192, NVC = VB / 8192, NDMA = NKC + NVC;
    const int r32 = F.lane & 31, hi = F.lane >> 5, nt = nctx + nloc;
#define ATT_DMA(ti) do { const int _k0 = (ti) < nctx ? 64 * (ti) : loc0 + 64 * ((ti) - nctx); LAS unsigned char* _sl = F.lds + ((ti) & 3) * SLOT; \
        _Pragma("unroll") for (int _j = 0; _j < NKC; ++_j) { const int _ch = F.wave + 8 * _j; int _row, _c; \
            if (KW == 128) { _row = 4 * _ch + (F.lane >> 4); _c = (F.lane & 15) ^ (_row & 15); } else { _row = 8 * _ch + (F.lane >> 3); _c = (F.lane & 7) ^ ((_row >> 1) & 7); } \
            __builtin_amdgcn_global_load_lds((const unsigned*)(U + (size_t)keyrow(b, _k0 + _row) * NU + kcol0 + _c * 8), (LAS unsigned*)(_sl + _ch * 1024), 16, 0, 0); } \
        _Pragma("unroll") for (int _j = 0; _j < NVC; ++_j) { const int _ch = F.wave + 8 * _j, _row = 8 * _ch + (F.lane >> 3), _c = (F.lane & 7) ^ ((_row >> 1) & 7); \
            __builtin_amdgcn_global_load_lds((const unsigned*)(VT + (size_t)_row * KEYS + _k0 + _c * 8), (LAS unsigned*)(_sl + KB + _ch * 1024), 16, 0, 0); } } while (0)
    f32x16 s0, s1; bf16x8 pa[4];
#define DSR(dst, addr, off) asm volatile("ds_read_b128 %0, %1 offset:%2" : "=v"(dst) : "v"(addr), "n"(off))
#define LWAIT4(f) asm volatile("s_waitcnt lgkmcnt(0)" : "+v"(f[0]), "+v"(f[1]), "+v"(f[2]), "+v"(f[3]))
    unsigned kad[4], vad[4];
#pragma unroll
    for (int i = 0; i < 4; ++i) { const int c = 2 * i + hi;
        kad[i] = (unsigned)(uintptr_t)F.lds + (KW == 128 ? r32 * 256 + ((((koff >> 3) + c) ^ (r32 & 15)) << 4) : r32 * 128 + ((c ^ ((r32 >> 1) & 7)) << 4));
        vad[i] = (unsigned)(uintptr_t)F.lds + KB + r32 * 128 + ((c ^ ((r32 >> 1) & 7)) << 4); }
    __syncthreads();
    ATT_DMA(0);
    if (nt > 1) ATT_DMA(1);
    if (nt > 2) ATT_DMA(2);
    if (nt > 2) asm volatile("s_waitcnt vmcnt(%0)" :: "n"(NDMA) : "memory"); else asm volatile("s_waitcnt vmcnt(0)" ::: "memory");
    __syncthreads();
#define EXP1(ti, r) do { s0[r] = __builtin_amdgcn_exp2f(s0[r]); s1[r] = __builtin_amdgcn_exp2f(s1[r]); \
        if (MASK && (ti) >= nctx) { const int k0 = loc0 - LC + 64 * ((ti) - nctx) + crow(r, hi), k1 = k0 + 32, d0 = qpos0 + r32 - k0, d1 = d0 - 32; \
            if (k0 < 0 || k0 >= SEQ || d0 > 128 || d0 < -128) s0[r] = 0.f; if (k1 < 0 || k1 >= SEQ || d1 > 128 || d1 < -128) s1[r] = 0.f; } } while (0)
#define RD_K(f, h) do { DSR(f[0], ka[2 * (h)], 0); DSR(f[1], ka[2 * (h)], 32 * KRB); DSR(f[2], ka[2 * (h) + 1], 0); DSR(f[3], ka[2 * (h) + 1], 32 * KRB); } while (0)
#define RD_V(f, nb) do { DSR(f[0], va[0], (nb) * 4096); DSR(f[1], va[1], (nb) * 4096); DSR(f[2], va[2], (nb) * 4096); DSR(f[3], va[3], (nb) * 4096); } while (0)
#define SB() __builtin_amdgcn_sched_barrier(0)
#define PKW(S, B) pg8::cvt_pk_bf16(S[B], S[(B) + 1])
#define PV1(f, nb, kk, ti, R0, NE) do { O[nb] = MFMA32(pa[kk], f[kk], O[nb]); if (more) { _Pragma("unroll") for (int _r = 0; _r < (NE); ++_r) EXP1(ti, (R0) + _r); } SB(); } while (0)
    {
        bf16x8 fa[4], fb[4]; unsigned ka[4];
#pragma unroll
        for (int i = 0; i < 4; ++i) ka[i] = kad[i];
        RD_K(fa, 0); RD_K(fb, 1);
#pragma unroll
        for (int r = 0; r < 16; ++r) { s0[r] = -sh2; s1[r] = -sh2; }
        LWAIT4(fa); LWAIT4(fb);
        s0 = MFMA32(fa[0], q[0], s0); s1 = MFMA32(fa[1], q[0], s1); s0 = MFMA32(fa[2], q[1], s0); s1 = MFMA32(fa[3], q[1], s1);
        s0 = MFMA32(fb[0], q[2], s0); s1 = MFMA32(fb[1], q[2], s1); s0 = MFMA32(fb[2], q[3], s0); s1 = MFMA32(fb[3], q[3], s1);
#pragma unroll
        for (int r = 0; r < 16; ++r) EXP1(0, r);
    }
#define ATT_STEP(MORE) { \
        constexpr bool more = (MORE); \
        if (t + 3 < nt) ATT_DMA(t + 3); \
        unsigned ka[4], va[4]; \
        { int lo_ = F.lane; asm volatile("" : "+v"(lo_)); const int rr = lo_ & 31, hh = lo_ >> 5; \
        _Pragma("unroll") \
          for (int i = 0; i < 4; ++i) { const int c = 2 * i + hh; \
            ka[i] = (unsigned)(uintptr_t)F.lds + ((t + 1) & 3) * SLOT + (KW == 128 ? rr * 256 + ((((koff >> 3) + c) ^ (rr & 15)) << 4) : rr * 128 + ((c ^ ((rr >> 1) & 7)) << 4)); \
            va[i] = (unsigned)(uintptr_t)F.lds + (t & 3) * SLOT + KB + rr * 128 + ((c ^ ((rr >> 1) & 7)) << 4); } } \
        bf16x8 fa[4], fb[4]; \
        if (more) { RD_K(fa, 0); RD_K(fb, 1); } else { RD_V(fa, 0); } \
        SB(); \
 \
        { float ps = 0.f; \
        _Pragma("unroll") \
          for (int r = 0; r < 16; ++r) ps += s0[r] + s1[r]; \
          lsum += ps; \
          u32x4 w; \
          w.x = PKW(s0, 0); w.y = PKW(s0, 2); w.z = PKW(s0, 4); w.w = PKW(s0, 6); pa[0] = __builtin_bit_cast(bf16x8, w); \
          w.x = PKW(s0, 8); w.y = PKW(s0, 10); w.z = PKW(s0, 12); w.w = PKW(s0, 14); pa[1] = __builtin_bit_cast(bf16x8, w); \
          w.x = PKW(s1, 0); w.y = PKW(s1, 2); w.z = PKW(s1, 4); w.w = PKW(s1, 6); pa[2] = __builtin_bit_cast(bf16x8, w); \
          w.x = PKW(s1, 8); w.y = PKW(s1, 10); w.z = PKW(s1, 12); w.w = PKW(s1, 14); pa[3] = __builtin_bit_cast(bf16x8, w); } \
        if (more) { \
        _Pragma("unroll") \
            for (int r = 0; r < 16; ++r) { s0[r] = -sh2; s1[r] = -sh2; } \
        } \
        SB(); \
        if (more) { \
            LWAIT4(fa); LWAIT4(fb); \
            s0 = MFMA32(fa[0], q[0], s0); s1 = MFMA32(fa[1], q[0], s1); s0 = MFMA32(fa[2], q[1], s0); s1 = MFMA32(fa[3], q[1], s1); \
            SB(); RD_V(fa, 0); SB(); \
            s0 = MFMA32(fb[0], q[2], s0); s1 = MFMA32(fb[1], q[2], s1); s0 = MFMA32(fb[2], q[3], s0); s1 = MFMA32(fb[3], q[3], s1); \
            SB(); \
        } \
        LWAIT4(fa); RD_V(fb, 1); SB(); \
        if (DV == 128) { \
            PV1(fa, 0, 0, t + 1, 0, 1); PV1(fa, 0, 1, t + 1, 1, 1); PV1(fa, 0, 2, t + 1, 2, 1); PV1(fa, 0, 3, t + 1, 3, 1); \
            LWAIT4(fb); RD_V(fa, 2); SB(); \
            PV1(fb, 1, 0, t + 1, 4, 1); PV1(fb, 1, 1, t + 1, 5, 1); PV1(fb, 1, 2, t + 1, 6, 1); PV1(fb, 1, 3, t + 1, 7, 1); \
            LWAIT4(fa); RD_V(fb, 3); SB(); \
            PV1(fa, 2, 0, t + 1, 8, 1); PV1(fa, 2, 1, t + 1, 9, 1); PV1(fa, 2, 2, t + 1, 10, 1); PV1(fa, 2, 3, t + 1, 11, 1); \
            LWAIT4(fb); SB(); \
            PV1(fb, 3, 0, t + 1, 12, 1); PV1(fb, 3, 1, t + 1, 13, 1); PV1(fb, 3, 2, t + 1, 14, 1); PV1(fb, 3, 3, t + 1, 15, 1); \
        } else { \
            PV1(fa, 0, 0, t + 1, 0, 2); PV1(fa, 0, 1, t + 1, 2, 2); PV1(fa, 0, 2, t + 1, 4, 2); PV1(fa, 0, 3, t + 1, 6, 2); \
            LWAIT4(fb); SB(); \
            PV1(fb, 1, 0, t + 1, 8, 2); PV1(fb, 1, 1, t + 1, 10, 2); PV1(fb, 1, 2, t + 1, 12, 2); PV1(fb, 1, 3, t + 1, 14, 2); \
        } \
        if (t + 3 < nt) asm volatile("s_waitcnt vmcnt(%0)" :: "n"(NDMA) : "memory"); else asm volatile("s_waitcnt vmcnt(0)" ::: "memory"); \
        __syncthreads(); \
    }
    int t = 0;
#pragma unroll 1
    for (; t + 1 < nt; ++t) ATT_STEP(true)
    ATT_STEP(false)
#undef ATT_STEP
#undef EXP1
#undef SB
#undef PKW
#undef PV1
#undef RD_K
#undef RD_V
#undef DSR
#undef LWAIT4
#undef ATT_DMA
}
__device__ __forceinline__ float score_bound(const float* wq, const float* wk, int lane) {
    float a = fabsf(wq[lane]), c = fabsf(wk[lane]);
#pragma unroll
    for (int o = 1; o < 64; o <<= 1) { a = fmaxf(a, __shfl_xor(a, o)); c = fmaxf(c, __shfl_xor(c, o)); }
    return 64.f * a * c * 0.125f * LOG2E;
}
__device__ __forceinline__ void diff_unit(KP Pk, Frame& F, int l, int b, int h, int qrow0, int nkt) {
    unsigned char* ws = F.ws;
    const bf16_t* U = (const bf16_t*)(ws + WS_U);
    const int m = F.wave & 1, rb = F.wave >> 1;
    const float sh2 = score_bound(Pk->in[I_DQN] + l * 64, Pk->in[I_DKN] + l * 64, F.lane);
    bf16x8 q[4];
    { const bf16_t* qp = U + (size_t)(qrow0 + 32 * rb + (F.lane & 31)) * NU + UC_DQ + h * 128 + m * 64 + 8 * (F.lane >> 5);
#pragma unroll
      for (int ks = 0; ks < 4; ++ks) q[ks] = *(const bf16x8*)(qp + 16 * ks); }
    f32x16 O[4];
#pragma unroll
    for (int nb = 0; nb < 4; ++nb) O[nb] = (f32x16){};
    float lsum = 0.f;
    attn_core<128, 128, false>(F, U, b, UC_DK + h * 128, (const bf16_t*)(ws + WS_VTD) + ((size_t)(b * 4 + h) * 128) * KEYS, nkt, 0, 0, q, 64 * m, 0, sh2, O, lsum);
    int ln_; asm volatile("v_mbcnt_lo_u32_b32 %0, -1, 0\n\tv_mbcnt_hi_u32_b32 %0, -1, %0" : "=v"(ln_));
    const int r32 = ln_ & 31, hi = ln_ >> 5;
    { int lo_ = l; asm volatile("" : "+s"(lo_)); l = lo_; Pk = kp_opaque(Pk); }
    lsum += __shfl_xor(lsum, 32);
    const float rl = 1.f / lsum;
    LAS float* ex = (LAS float*)F.lds + rb * 4096;
    float rlr[16];
#pragma unroll
    for (int r = 0; r < 16; ++r) rlr[r] = __shfl(rl, crow(r, hi));
    if (m == 1) {
#pragma unroll
        for (int nb = 0; nb < 4; ++nb)
#pragma unroll
            for (int r = 0; r < 16; ++r) ex[crow(r, hi) * 128 + nb * 32 + r32] = O[nb][r] * rlr[r];
    }
    __syncthreads();
    if (m == 0) {
        const float* dl = Pk->in[I_DLAM] + l * 256; const float lam_init = __builtin_bit_cast(float, __builtin_amdgcn_readfirstlane(__builtin_bit_cast(int, l == 0 ? 0.2f : (0.8f - 0.6f * 0.74081822068f))));
        const float lam = expf(wave_sum(dl[ln_] * dl[64 + ln_])) - expf(wave_sum(dl[128 + ln_] * dl[192 + ln_])) + lam_init;
        float ssq[16];
#pragma unroll
        for (int r = 0; r < 16; ++r) { float a = 0.f;
#pragma unroll
            for (int nb = 0; nb < 4; ++nb) { const float v = O[nb][r] * rlr[r] - lam * ex[crow(r, hi) * 128 + nb * 32 + r32]; O[nb][r] = v; a += v * v; }
            a += __shfl_xor(a, 1); a += __shfl_xor(a, 2); a += __shfl_xor(a, 4); a += __shfl_xor(a, 8); a += __shfl_xor(a, 16);
            ssq[r] = rsqrtf(a * (1.f / 128.f) + NORM_EPS) * (1.f - lam_init); }
        unsigned char* mix = ws + WS_H + ((size_t)(qrow0 + 32 * rb) * D + 1536 + h * 128) * MIXB;
#pragma unroll
        for (int nb = 0; nb < 4; ++nb) { const float w = Pk->in[I_DSUB][l * 128 + nb * 32 + r32];
#pragma unroll
            for (int r = 0; r < 16; ++r) { const float y = O[nb][r] * ssq[r] * w; const size_t e = (size_t)crow(r, hi) * D + nb * 32 + r32; if (WOUT_F8) mix[e] = f8_1(y); else ((bf16_t*)mix)[e] = (bf16_t)f2bf(y); } }
    }
}
__device__ __forceinline__ void swa_unit(KP Pk, Frame& F, int l, int b, int kvh, int qrow0, int qpos0, bool latent) {
    unsigned char* ws = F.ws;
    const bf16_t* U = (const bf16_t*)(ws + WS_U);
    const int hq = kvh * 4 + (F.wave & 3), rb = F.wave >> 2;
    const float sh2 = score_bound(Pk->in[I_SQN] + l * 64, Pk->in[I_SKN] + l * 64, F.lane);
    bf16x8 q[4];
    { const bf16_t* qp = U + (size_t)(qrow0 + 32 * rb + (F.lane & 31)) * NU + UC_SQ + hq * 64 + 8 * (F.lane >> 5);
#pragma unroll
      for (int ks = 0; ks < 4; ++ks) q[ks] = *(const bf16x8*)(qp + 16 * ks); }
    f32x16 O[2]; O[0] = (f32x16){}; O[1] = (f32x16){};
    float lsum = 0.f;
    int nloc = 0, loc0 = 0;
    if (latent) { int kp0 = qpos0 - 128, kp1 = qpos0 + 64 + 128; if (kp0 < 0) kp0 = 0; if (kp1 > SEQ) kp1 = SEQ; nloc = (kp1 - kp0) / 64; loc0 = LC + kp0; }
    const bf16_t* VT = (const bf16_t*)(ws + WS_VTS) + ((size_t)(b * 2 + kvh) * 64) * KEYS;
    attn_core<64, 64, true>(F, U, b, UC_SK + kvh * 64, VT, 4, nloc, loc0, q, 0, qpos0 + 32 * rb, sh2, O, lsum);
    int ln_; asm volatile("v_mbcnt_lo_u32_b32 %0, -1, 0\n\tv_mbcnt_hi_u32_b32 %0, -1, %0" : "=v"(ln_));
    const int r32 = ln_ & 31, hi = ln_ >> 5;
    { int lo_ = l; asm volatile("" : "+s"(lo_)); l = lo_; Pk = kp_opaque(Pk); }
    lsum += __shfl_xor(lsum, 32);
    const float rl = 1.f / (lsum + exp2f(Pk->in[I_SINK][l * 8 + hq] * LOG2E - sh2));
    unsigned char* mix = ws + WS_H + ((size_t)(qrow0 + 32 * rb) * D + 512 + hq * 64) * MIXB;
#pragma unroll
    for (int r = 0; r < 16; ++r) { const float rr = __shfl(rl, crow(r, hi));
#pragma unroll
        for (int nb = 0; nb < 2; ++nb) { const float y = O[nb][r] * rr; const size_t e = (size_t)crow(r, hi) * D + nb * 32 + r32; if (WOUT_F8) mix[e] = f8_1(y); else ((bf16_t*)mix)[e] = (bf16_t)f2bf(y); } }
}
constexpr int HY_PAD = 224, YSTR = 2504, HY_YB = 8 * YSTR * 2, HY_CST = 8224, HY_COP = 2 * HY_YB;
__device__ __forceinline__ void hyena_unit(KP Pk, Frame& F, int l, int cg) {
    unsigned char* ws = F.ws;
    const int r32 = F.lane & 31, hi = F.lane >> 5, bb = r32 >> 2, ib = r32 & 3;
    const bf16_t* ZT = (const bf16_t*)(ws + WS_ZT); bf16_t* OT = (bf16_t*)(ws + WS_OT);
    LAS unsigned char* cop = F.lds + HY_COP;
    const int nseq = l == 0 ? 2 : 1;
#pragma unroll 1
    for (int cs = 0; cs < 4 * nseq; ++cs) {
        const int ci = cs >> (nseq - 1), st = cs & (nseq - 1), ch = cg * 4 + ci, L = st == 0 ? SEQ : LC, nblk = L / 32, pos0 = st == 0 ? 0 : SEQ;
        __syncthreads();
        for (int id = F.tid; id < 8 * (L / 8 + 56); id += NTHR) { const int b = id / (L / 8 + 56), c = id % (L / 8 + 56);
            if (c < L / 8) *(LAS u32x4*)(F.lds + (b * YSTR + HY_PAD + 8 * c) * 2) = *(const u32x4*)(ZT + ((size_t)b * 1536 + 1024 + ch) * KEYS + pos0 + 8 * c);
            else { const int pc = c - L / 8, off = pc < 28 ? 8 * pc : HY_PAD + L + 8 * (pc - 28); const u32x4 z = {0u, 0u, 0u, 0u};
                *(LAS u32x4*)(F.lds + (b * YSTR + off) * 2) = z; *(LAS u32x4*)(F.lds + HY_YB + (b * YSTR + off) * 2) = z; } }
#pragma unroll 1
        for (int o = 0; o < 2; ++o) {
            const bf16_t* R = (const bf16_t*)(ws + WS_HYF) + ((size_t)l * 1024 + o * 512 + ch) * 4608 + (st == 0 ? 0 : 4096);
            for (int xc = F.tid; xc < 2 * L / 8; xc += NTHR) { const u32x4 lo = *(const u32x4*)(R + 8 * xc); u32x4 hh = {0u, 0u, 0u, 0u}; if (8 * xc + 8 < 2 * L) hh = *(const u32x4*)(R + 8 * xc + 8);
                const unsigned w[9] = {lo.x, lo.y, lo.z, lo.w, hh.x, hh.y, hh.z, hh.w, 0u};
#pragma unroll
                for (int r = 0; r < 8; ++r) { u32x4 ov; unsigned t[4];
#pragma unroll
                    for (int k = 0; k < 4; ++k) t[k] = (r & 1) ? ((w[(r >> 1) + k] >> 16) | (w[(r >> 1) + k + 1] << 16)) : w[(r >> 1) + k];
                    ov.x = t[0]; ov.y = t[1]; ov.z = t[2]; ov.w = t[3]; *(LAS u32x4*)(cop + r * HY_CST + 16 * xc) = ov; } }
            __syncthreads();
            const LAS unsigned char* Yin = F.lds + (o == 0 ? 0 : HY_YB); LAS unsigned char* Yout = F.lds + (o == 0 ? HY_YB : 0);
            const float bias = Pk->in[I_HBIAS][(l * 2 + o) * 512 + ch];
            if (2 * F.wave < nblk / 4) {
                const int g0 = 2 * F.wave, dlo = 4 * g0 - nblk + 1, dhi = min(4 * g0 + 7, nblk - 1), nsteps = dhi - dlo + 1;
                const LAS unsigned char* ap = cop + ((-r32) & 7) * HY_CST + ((L - 32 * dlo - r32 + 8 * hi) & ~7) * 2;
                const LAS unsigned char* bp = Yin + (bb * YSTR + HY_PAD + 32 * (4 * g0 + ib - dlo) + 8 * hi) * 2;
                f32x16 acc0 = {}, acc1 = {};
#define HDSR(dst, addr, off) asm volatile("ds_read_b128 %0, %1 offset:%2" : "=v"(dst) : "v"(addr), "n"(off))
#define HWAIT(a, b, c, d) asm volatile("s_waitcnt lgkmcnt(0)" : "+v"(a), "+v"(b), "+v"(c), "+v"(d))
                bf16x8 R[6][2], A2[2][2];
                const unsigned apa = (unsigned)(uintptr_t)ap, bpa = (unsigned)(uintptr_t)bp;
                HDSR(R[2][0], bpa, 256); HDSR(R[2][1], bpa, 256 + 32); HDSR(R[3][0], bpa, 192); HDSR(R[3][1], bpa, 192 + 32);
                HDSR(R[4][0], bpa, 128); HDSR(R[4][1], bpa, 128 + 32); HDSR(R[5][0], bpa, 64); HDSR(R[5][1], bpa, 64 + 32);
                HDSR(R[0][0], bpa, 0); HDSR(R[0][1], bpa, 32); HDSR(A2[0][0], apa, 0); HDSR(A2[0][1], apa, 32);
                HWAIT(R[2][0], R[2][1], R[3][0], R[3][1]); HWAIT(R[4][0], R[4][1], R[5][0], R[5][1]); HWAIT(R[0][0], R[0][1], A2[0][0], A2[0][1]);
#pragma unroll 1
                for (int s0 = 0; s0 < nsteps; s0 += 6) {
                    const unsigned an = apa - (unsigned)(s0 + 6) * 64u, bn = bpa - (unsigned)(s0 + 6) * 64u;
#pragma unroll
                    for (int j = 0; j < 6; ++j) if (s0 + j < nsteps) {
                        if (s0 + j + 1 < nsteps) { HDSR(A2[(j + 1) & 1][0], an, (5 - j) * 64); HDSR(A2[(j + 1) & 1][1], an, (5 - j) * 64 + 32);
                            HDSR(R[(j + 1) % 6][0], bn, (5 - j) * 64); HDSR(R[(j + 1) % 6][1], bn, (5 - j) * 64 + 32); }
                        acc1 = MFMA32(A2[j & 1][0], R[(j + 2) % 6][0], acc1); acc0 = MFMA32(A2[j & 1][0], R[j][0], acc0);
                        acc1 = MFMA32(A2[j & 1][1], R[(j + 2) % 6][1], acc1); acc0 = MFMA32(A2[j & 1][1], R[j][1], acc0);
                        HWAIT(A2[(j + 1) & 1][0], A2[(j + 1) & 1][1], R[(j + 1) % 6][0], R[(j + 1) % 6][1]); }
                }
#undef HDSR
#undef HWAIT
#pragma unroll
                for (int gg = 0; gg < 2; ++gg) { const f32x16& acc = gg == 0 ? acc0 : acc1;
                    const int t0 = 32 * (4 * (g0 + gg) + ib) + 4 * hi;
                    const bf16_t* gp = ZT + ((size_t)bb * 1536 + o * 512 + ch) * KEYS + pos0 + t0;
#pragma unroll
                    for (int q = 0; q < 4; ++q) { const u32x2 yo = *(const LAS u32x2*)(Yin + (bb * YSTR + HY_PAD + t0 + 8 * q) * 2); const u32x2 gt = *(const u32x2*)(gp + 8 * q);
                        const float v0 = bflo(gt.x) * (acc[4 * q + 0] + bflo(yo.x) * bias), v1 = bfhi(gt.x) * (acc[4 * q + 1] + bfhi(yo.x) * bias);
                        const float v2 = bflo(gt.y) * (acc[4 * q + 2] + bflo(yo.y) * bias), v3 = bfhi(gt.y) * (acc[4 * q + 3] + bfhi(yo.y) * bias);
                        u32x2 ov; ov.x = pk2(v0, v1); ov.y = pk2(v2, v3);
                        if (o == 0) *(LAS u32x2*)(Yout + (bb * YSTR + HY_PAD + t0 + 8 * q) * 2) = ov;
                        else *(u32x2*)(OT + ((size_t)bb * 512 + ch) * KEYS + pos0 + t0 + 8 * q) = ov; } }
            }
            __syncthreads();
        }
    }
    VM_WAIT(); __syncthreads();
    const int npos = l == 0 ? KEYS : SEQ;
    for (int id = F.tid; id < 8 * npos; id += NTHR) { const int b = id / npos, pos = id % npos, row = pos < SEQ ? b * SEQ + pos : TL + b * LC + (pos - SEQ);
        const bf16_t* op = OT + ((size_t)b * 512 + cg * 4) * KEYS + pos;
        if (WOUT_F8) *(unsigned*)(ws + WS_H + (size_t)row * D + 1024 + cg * 4) = pk4_f8(bf2f(op[0]), bf2f(op[KEYS]), bf2f(op[2 * KEYS]), bf2f(op[3 * KEYS]));
        else { u32x2 ov; ov.x = (unsigned)op[0] | ((unsigned)op[KEYS] << 16); ov.y = (unsigned)op[2 * KEYS] | ((unsigned)op[3 * KEYS] << 16); *(u32x2*)((bf16_t*)(ws + WS_H) + (size_t)row * D + 1024 + cg * 4) = ov; } }
}
#ifndef MX_MASK
#define MX_MASK 15
#endif
#ifndef PROBE_MX
#define PROBE_MX 0
#endif
__device__ __forceinline__ void ph_mixers(KP Pk, Frame& F, int l, int qid) {
    const int n_diff = 512, n_hy = 128, n_dctx = l == 0 ? 64 : 0, n_swa = 512, n_sctx = l == 0 ? 64 : 0, gpb = l == 0 ? 5 : 4, n_gla = 64 * gpb;
    constexpr int R0 = 1 + ((PROBE_MX >> 0) & 1), R1 = 1 + ((PROBE_MX >> 1) & 1), R2 = 1 + ((PROBE_MX >> 2) & 1), R3 = 1 + ((PROBE_MX >> 3) & 1);
    const int n_mix = R0 * (n_diff + n_dctx) + R1 * n_hy + R2 * (n_swa + n_sctx) + R3 * n_gla + (l == 0 ? 96 + 128 : 0);
    const int n_titems = 16 * TI_GU + 16 * TI_DN + TI_WOUT + (l == 0 ? TI_WIN + TI_WA : 0), NTU = (n_titems + 127) / 128;
    const int total = n_mix + NTU, tplaced = min(NTU, total / 4);
    for (;;) {
        const int s_ = wg_grab(F, qid); if (s_ >= total) break;
        int u = s_ - min(NTU, s_ / 4), tu = -1;
        if ((s_ & 3) == 3 && (s_ >> 2) < NTU) tu = s_ >> 2; else if (u >= n_mix) tu = tplaced + (u - n_mix);
        if (tu >= 0) { LAS float* scr = (LAS float*)(F.lds + F.wave * 8704);
            for (int j = 0; j < 16; ++j) { int x = tu * 128 + F.wave * 16 + j; if (x >= n_titems) break;
                int it;
                if (x < 16 * TI_GU) it = 2 * TI_L + l * 16 * TI_GU + x;
                else if ((x -= 16 * TI_GU) < 16 * TI_DN) it = 2 * TI_L + 32 * TI_GU + l * 16 * TI_DN + x;
                else if ((x -= 16 * TI_DN) < TI_WOUT) it = l * TI_L + TI_WIN + TI_WA + x;
                else it = TI_L + (x - TI_WOUT);
                p0_item(Pk, F, it, scr); }
            goto mx_next; }
        if (l == 0) { if (u < 96) { ada_unit(Pk, F, 96 + u); goto mx_next; } u -= 96;
                      if (u < 128) { ph_hyena_filters(Pk, F, 128 + u); goto mx_next; } u -= 128; }
        if (u < R1 * n_hy) { u %= n_hy; if (MX_MASK & 2) hyena_unit(Pk, F, l, u); goto mx_next; } u -= R1 * n_hy;
        if (u < R0 * n_diff) { u %= n_diff; const int b = u >> 6, h = (u >> 4) & 3, qb = u & 15; if (MX_MASK & 1) diff_unit(Pk, F, l, b, h, b * SEQ + 128 * qb, 36); goto mx_next; } u -= R0 * n_diff;
        if (u < R0 * n_dctx) { u %= n_dctx; const int b = u >> 3, h = (u >> 1) & 3, qb = u & 1; if (MX_MASK & 1) diff_unit(Pk, F, l, b, h, TL + b * LC + 128 * qb, 4); goto mx_next; } u -= R0 * n_dctx;
        if (u < R2 * n_swa) { u %= n_swa; const int b = u >> 6, kvh = (u >> 5) & 1, qb = u & 31; if (MX_MASK & 4) swa_unit(Pk, F, l, b, kvh, b * SEQ + 64 * qb, 64 * qb, true); goto mx_next; } u -= R2 * n_swa;
        if (u < R2 * n_sctx) { u %= n_sctx; const int b = u >> 3, kvh = (u >> 2) & 1, qb = u & 3; if (MX_MASK & 4) swa_unit(Pk, F, l, b, kvh, TL + b * LC + 64 * qb, 64 * qb, false); goto mx_next; } u -= R2 * n_sctx;
        { u %= n_gla; const int bh = u / gpb, grp = u % gpb, c = (l == 0 ? 0 : 4) + grp * 8 + F.wave;
          __syncthreads();
          if ((MX_MASK & 8) && c < NCH) gla_pass_b(Pk, F, l, bh >> 3, bh & 7, c, F.lds + F.wave * WAVE_LDS);
        }
mx_next: ;
    }
}

constexpr int N_PHASES = 22;
#ifndef PH_MASK
#define PH_MASK 0xfffu
#endif
__global__ void __launch_bounds__(NTHR, 2) fwd_kernel(Params Parg) {
    extern __shared__ __attribute__((aligned(16))) unsigned char lds_raw[];
    const KP P0 = (KP)__builtin_amdgcn_kernarg_segment_ptr();
    Frame F;
    F.lds = (LAS unsigned char*)lds_raw; F.MISC = (volatile LAS unsigned*)(F.lds + LDS_MISC);
    const int wave_s = __builtin_amdgcn_readfirstlane((int)threadIdx.x >> 6);
#define TID_REFRESH() do { int t_; asm volatile("v_mbcnt_lo_u32_b32 %0, -1, 0\n\tv_mbcnt_hi_u32_b32 %0, -1, %0" : "=v"(t_)); F.lane = t_; F.wave = wave_s; F.tid = wave_s * 64 + t_; } while (0)
    TID_REFRESH();
    F.G = gridDim.x; { const int bx = blockIdx.x; F.vcu = (F.G % 8 == 0) ? (bx % 8) * (F.G / 8) + bx / 8 : bx; }
    F.ws = P0->ws; F.ctl = (unsigned*)(P0->ws + WS_CTL);
    for (int u = F.tid; u < 128; u += NTHR) F.MISC[u] = 0u;
    __syncthreads();
    const int lo = P0->ph_lo, hi = P0->ph_hi;
    const bool multi = hi - lo > 1;
    XcdBarrier bar; bar.bar = F.ctl + CW_BAR; bar.x = 0; bar.st = nullptr;
    if (multi) bar = xcd_barrier_post(F.ctl + CW_BAR, F.MISC + 8, F.tid);
#define INR(k) (lo <= (k) && (k) < hi)
#define IN(k, kind) (((PH_MASK >> (kind)) & 1u) && INR(k))
#define SEAM(k) do { if (INR(k) && INR((k) + 1)) { bar.bar = (unsigned*)(kp_opaque(P0)->ws + WS_CTL) + CW_BAR; TID_REFRESH(); xcd_barrier(bar, F.tid); } } while (0)
#ifndef PROBE_MASK
#define PROBE_MASK 0u
#endif
#define REP(kind) for (int rep_ = 0; rep_ < (((PROBE_MASK >> (kind)) & 1u) ? 2 : 1); ++rep_)
#define REP_SYNC(kind) do { if (((PROBE_MASK >> (kind)) & 1u) && rep_ == 0 && multi) { TID_REFRESH(); xcd_barrier(bar, F.tid); } } while (0)
#define PHASE_BEGIN() const KP Pk = kp_opaque(P0); unsigned char* ws = Pk->ws; F.ws = ws; F.ctl = (unsigned*)(ws + WS_CTL); \
    TID_REFRESH()
    if (IN(0, 0)) REP(0) { PHASE_BEGIN(); p0_prologue(Pk, F, rep_); REP_SYNC(0); } SEAM(0);
#pragma unroll 1
    for (int l = 0; l < DEPTH; ++l) {
        const int pb = 1 + 10 * l;
        if (IN(pb + 0, 1)) REP(1) { if (rep_ && l) break; PHASE_BEGIN(); if (l == 0) { for (int u = blockIdx.x; u < 128; u += F.G) ph_hyena_filters(Pk, F, u); } ph_norm1(Pk, F, l); REP_SYNC(1); } SEAM(pb + 0);
        if (IN(pb + 1, 2)) REP(2) { PHASE_BEGIN();
            pg8::Gemm g{(const bf16_t*)(ws + WS_H), (const bf16_t*)(ws + WS_WIN + (size_t)l * NU * D * 2), D, nullptr};
            pg8::RectOrder S; if (l == 0) S.init(72, 21, F.G, (int)blockIdx.x, 0, 0, 0ull); else S.init(64, 21, F.G, (int)blockIdx.x, 64, 64, 0x1413121108030201ull);
            pg8::EpiU E{(bf16_t*)(ws + WS_U), WIN_F8_L(l) ? 1.f / 32.f : 1.f};
            if (WIN_F8_L(l)) pg8::gemm_phase<pg8::EpiU, pg8::RectOrder, false, true>(F.lds, g, S, E, F.tid);
            else pg8::gemm_phase<pg8::EpiU, pg8::RectOrder, false, false>(F.lds, g, S, E, F.tid);
            if (WIN_F8_L(l)) ph_gate_cols8(F, l); else ph_gate_cols(F, l); REP_SYNC(2);
        } SEAM(pb + 1);
        if (IN(pb + 2, 3)) REP(3) { PHASE_BEGIN(); ph_prep(Pk, F, l, rep_); REP_SYNC(3); } SEAM(pb + 2);
        if (IN(pb + 4, 5)) REP(5) { PHASE_BEGIN(); ph_mixers(Pk, F, l, 1 + l + 2 * rep_); REP_SYNC(5); } SEAM(pb + 4);
        if (IN(pb + 5, 6)) REP(6) { if (rep_ && l) break; PHASE_BEGIN();
            pg8::Gemm g{(const bf16_t*)(ws + WS_H), (const bf16_t*)(ws + WS_WOUT + (size_t)l * D * D * MIXB), D, nullptr};
            pg8::RectOrder S; S.init(l == 0 ? 72 : 64, 8, F.G, (int)blockIdx.x, 0, 0, 0ull);
            pg8::EpiWout E{Pk->in[I_X], Pk->in[I_CTX], l == 0 ? (const bf16_t*)nullptr : (const bf16_t*)(ws + WS_X), (bf16_t*)(ws + WS_X), (const float*)(ws + WS_MOD) + (size_t)l * 9 * 12288};
            pg8::gemm_phase<pg8::EpiWout, pg8::RectOrder, false, WOUT_F8>(F.lds, g, S, E, F.tid); REP_SYNC(6);
        } SEAM(pb + 5);
        if (IN(pb + 6, 7)) REP(7) { PHASE_BEGIN(); ph_norm2_router(Pk, F, l, rep_); REP_SYNC(7); } SEAM(pb + 6);
        if (IN(pb + 7, 8)) { PHASE_BEGIN(); ph_slots(Pk, F, l); } SEAM(pb + 7);
        if (IN(pb + 8, 9)) REP(9) { PHASE_BEGIN();
            const int np = moe_table(F, l);
            pg8::Gemm g{(const bf16_t*)(ws + WS_H), (const bf16_t*)(ws + WS_WGU + (size_t)l * NE * 2048 * D), D, (const int*)(ws + WS_RT + RT_ROWTOK)};
            pg8::MoeOrder S{np, F.G, F.vcu, (const volatile LAS unsigned char*)(F.MISC + 64)};
            pg8::EpiMoe1 E{ws + WS_U};
            pg8::gemm_phase<pg8::EpiMoe1, pg8::MoeOrder, true, true>(F.lds, g, S, E, F.tid); REP_SYNC(9);
        } SEAM(pb + 8);
        if (IN(pb + 9, 10)) REP(10) { PHASE_BEGIN();
            const int np = moe_table(F, l);
            pg8::Gemm g{(const bf16_t*)(ws + WS_U), (const bf16_t*)(ws + WS_WD + (size_t)l * NE * D * DE), DE, nullptr};
            pg8::MoeOrder S{np, F.G, F.vcu, (const volatile LAS unsigned char*)(F.MISC + 64)};
            pg8::EpiMoe2 E{ws + WS_Y2, (const int*)(ws + WS_RT + RT_ROWTOK), (const float*)(ws + WS_RT + RT_ROWW)};
            pg8::gemm_phase<pg8::EpiMoe2, pg8::MoeOrder, false, true>(F.lds, g, S, E, F.tid); REP_SYNC(10);
        } SEAM(pb + 9);
    }
    if (IN(21, 11)) REP(11) { PHASE_BEGIN(); ph_final(Pk, F); REP_SYNC(11); }
#undef IN
#undef INR
#undef SEAM
#undef PHASE_BEGIN
#undef REP
#undef REP_SYNC
#undef TID_REFRESH
}

#ifndef MK_PER_PHASE
#define MK_PER_PHASE 0
#endif
extern "C" void kernel_launch(void* const* d_in, const int* in_sizes, int n_in, void* d_out, int out_size, void* d_ws, size_t ws_size, hipStream_t stream) {
    static int grid = 0;
    if (grid == 0) {
        if (n_in != 34 || in_sizes[0] != TL * D || out_size != TL * D || ws_size < WS_END) { fprintf(stderr, "kernel_launch: unexpected shapes (n_in %d, in0 %d, out %d, ws %zu < %zu)\n", n_in, n_in > 0 ? in_sizes[0] : -1, out_size, ws_size, (size_t)WS_END); grid = -1; return; }
        int dev = 0, cus = 0, per_cu = 0;
        if (hipGetDevice(&dev) != hipSuccess || hipDeviceGetAttribute(&cus, hipDeviceAttributeMultiprocessorCount, dev) != hipSuccess) { grid = -1; return; }
        if (hipFuncSetAttribute((const void*)fwd_kernel, hipFuncAttributeMaxDynamicSharedMemorySize, LDS_BYTES) != hipSuccess) { fprintf(stderr, "kernel_launch: hipFuncSetAttribute failed\n"); grid = -1; return; }
        if (hipOccupancyMaxActiveBlocksPerMultiprocessor(&per_cu, (const void*)fwd_kernel, NTHR, LDS_BYTES) != hipSuccess || per_cu < 1) fprintf(stderr, "kernel_launch: occupancy query reports %d\n", per_cu);
        (void)hipGetLastError();
        grid = cus;
    }
    if (grid < 0) return;
    (void)hipMemsetAsync((char*)d_ws + WS_CTL, 0, CTL_BYTES, stream);
    Params p{};
    for (int i = 0; i < 34; ++i) p.in[i] = (const float*)d_in[i];
    p.out = (float*)d_out; p.ws = (unsigned char*)d_ws;
#if MK_PER_PHASE
    for (int k = 0; k < N_PHASES; ++k) { p.ph_lo = k; p.ph_hi = k + 1; hipLaunchKernelGGL(fwd_kernel, dim3(grid), dim3(NTHR), LDS_BYTES, stream, p); }
#else
    p.ph_lo = 0; p.ph_hi = N_PHASES; hipLaunchKernelGGL(fwd_kernel, dim3(grid), dim3(NTHR), LDS_BYTES, stream, p);
#endif
    const hipError_t le = hipPeekAtLastError();
    if (le != hipSuccess) fprintf(stderr, "kernel_launch: launch failed: %s\n", hipGetErrorName(le));
}
```

```cpp
#include <hip/hip_runtime.h>
#include <cstdio>
#include <cstdint>

#define LAS __attribute__((address_space(3)))
#define GAS __attribute__((address_space(1)))
typedef unsigned short bf16_t;
typedef short bf16x8 __attribute__((ext_vector_type(8)));
typedef float f32x2 __attribute__((ext_vector_type(2)));
typedef float f32x4 __attribute__((ext_vector_type(4)));
typedef float f32x16 __attribute__((ext_vector_type(16)));
typedef unsigned u32x2 __attribute__((ext_vector_type(2)));
typedef unsigned u32x4 __attribute__((ext_vector_type(4)));
typedef int i32x4 __attribute__((ext_vector_type(4)));
typedef int i32x8 __attribute__((ext_vector_type(8)));

constexpr int D = 2048, NB = 8, SEQ = 2048, LC = 256, DEPTH = 2;
constexpr int TL = NB * SEQ, TCX = NB * LC, TT = TL + TCX;
constexpr int DIN = 5408, NU = 5376, NE = 16, DE = 1024;
constexpr int KEYS = LC + SEQ;
constexpr int UC_GQ = 0, UC_GK = 256, UC_GV = 512, UC_GG = 1024, UC_SQ = 1536, UC_SK = 2048, UC_SV = 2176, UC_HY = 2304, UC_DQ = 3840, UC_DK = 4352, UC_DV = 4864;
constexpr int MOE_ROWS = 2 * TT + NE * 256;
constexpr int MOE_PANELS = MOE_ROWS / 256;
constexpr int GCH = 64, NCH = KEYS / GCH;
constexpr float NORM_EPS = 1e-6f;
constexpr float LOG2E = 1.4426950408889634f;

constexpr size_t MiB = 1u << 20;
constexpr size_t WS_CTL = 0, CTL_BYTES = 1 * MiB;
constexpr size_t WS_MOD = 1 * MiB;
constexpr size_t WS_ROPE = 2 * MiB;
constexpr size_t WS_HYH2 = 3 * MiB;
constexpr size_t WS_WA = 5 * MiB;
constexpr size_t WS_RT = 6 * MiB;
constexpr size_t WS_AG = 7 * MiB;
constexpr size_t WS_HYF = 10 * MiB;
constexpr size_t WS_WIN = 28 * MiB;
constexpr size_t WS_WOUT = 70 * MiB;
constexpr size_t WS_WGU = 86 * MiB;
constexpr size_t WS_WD = 342 * MiB;
constexpr size_t WS_X = 470 * MiB;
constexpr size_t WS_H = 614 * MiB;
constexpr size_t WS_U = 686 * MiB;
constexpr size_t WS_B = 875 * MiB;
constexpr size_t WS_VTD = WS_B;
constexpr size_t WS_VTS = WS_B + 18 * MiB;
constexpr size_t WS_ZT = WS_B + 23 * MiB;
constexpr size_t WS_OT = WS_B + 77 * MiB;
constexpr size_t WS_GSL = WS_B + 95 * MiB;
constexpr size_t WS_GSS = WS_B + 131 * MiB;
constexpr size_t WS_GAE = WS_B + 167 * MiB;
constexpr size_t WS_Y2 = WS_B;
constexpr size_t WS_HB = 1043 * MiB;
constexpr size_t WS_END = 1115 * MiB;
constexpr int WIN_F8_MASK = 3;
#define WIN_F8_L(l) (((WIN_F8_MASK) >> (l)) & 1)
constexpr bool WOUT_F8 = true;
constexpr int MIXB = WOUT_F8 ? 1 : 2;
constexpr size_t RT_E = 0;
constexpr size_t RT_W = 128 * 1024;
constexpr size_t RT_ROWTOK = 320 * 1024;
constexpr size_t RT_ROWW = 512 * 1024;
constexpr int CW_BAR = 4096;
constexpr int CW_CNT = 16384;
constexpr int CW_CUR = 16384 + 256;
constexpr int CW_Q = 16384 + 1024;

constexpr int LDS_BYTES = 155648;
constexpr int LDS_MISC = LDS_BYTES - 512;
constexpr int NWAVES = 8, NTHR = 512;

__device__ __forceinline__ unsigned f2bf(float f) { unsigned u = __builtin_bit_cast(unsigned, f); return (u + 0x7fffu + ((u >> 16) & 1u)) >> 16; }
#ifndef EMU8
#define EMU8 0
#endif
__device__ __forceinline__ float q8(float f) { unsigned u = __builtin_bit_cast(unsigned, f); u = (u + 0x7ffffu + ((u >> 20) & 1u)) & 0xfff00000u; return __builtin_bit_cast(float, u); }
__device__ __forceinline__ unsigned pk2(float lo, float hi) { return f2bf(lo) | (f2bf(hi) << 16); }
__device__ __forceinline__ unsigned pk2q(float lo, float hi) { return f2bf(q8(lo)) | (f2bf(q8(hi)) << 16); }
__device__ __forceinline__ unsigned pk4_f8(float a, float b, float c, float d) {
    a = fminf(fmaxf(a, -448.f), 448.f); b = fminf(fmaxf(b, -448.f), 448.f); c = fminf(fmaxf(c, -448.f), 448.f); d = fminf(fmaxf(d, -448.f), 448.f);
    int r = 0; r = __builtin_amdgcn_cvt_pk_fp8_f32(a, b, r, false); r = __builtin_amdgcn_cvt_pk_fp8_f32(c, d, r, true); return (unsigned)r; }
__device__ __forceinline__ unsigned char f8_1(float a) { a = fminf(fmaxf(a, -448.f), 448.f); return (unsigned char)(__builtin_amdgcn_cvt_pk_fp8_f32(a, a, 0, false) & 0xff); }
__device__ __forceinline__ float bf2f(unsigned short b) { return __builtin_bit_cast(float, ((unsigned)b) << 16); }
__device__ __forceinline__ float bflo(unsigned w) { return __builtin_bit_cast(float, w << 16); }
__device__ __forceinline__ float bfhi(unsigned w) { return __builtin_bit_cast(float, w & 0xffff0000u); }
__device__ __forceinline__ float wave_sum(float v) {
#pragma unroll
    for (int o = 1; o < 64; o <<= 1) v += __shfl_xor(v, o);
    return v;
}
__device__ __forceinline__ float silu_f(float x) { return x / (1.f + __expf(-x)); }
#define LDS_WAIT() asm volatile("s_waitcnt lgkmcnt(0)" ::: "memory")
#define VM_WAIT() asm volatile("s_waitcnt vmcnt(0)" ::: "memory")

#define XB_TMO      128
#define XB_XCNT(j)  (256  + 64 * (j))
#define XB_XSUB(j)  (1280 + 64 * (j))
#define XB_XGEN(j)  (2304 + 64 * (j))
#define XB_TOP      3328
#define XB_TOPGEN   3392
#define XCD_BAR_WORDS 3456
#define XB_SPIN_CAP (1u << 18)
__device__ __forceinline__ unsigned xb_ld(unsigned* p)              { return __hip_atomic_load(p, __ATOMIC_RELAXED, __HIP_MEMORY_SCOPE_AGENT); }
__device__ __forceinline__ unsigned xb_add(unsigned* p, unsigned v) { return __hip_atomic_fetch_add(p, v, __ATOMIC_RELAXED, __HIP_MEMORY_SCOPE_AGENT); }
__device__ __forceinline__ unsigned xb_xcc_id() { return (unsigned)__builtin_amdgcn_s_getreg((3 << 11) | 20) & 0xFu; }
#define XB_SPIN(cond, bar) do { unsigned _sp = 0; while (cond) { __builtin_amdgcn_s_sleep(1); \
    if ((++_sp & 255u) == 0u) { if (xb_ld(&(bar)[XB_TMO])) break; if (_sp > XB_SPIN_CAP) { atomicAdd(&(bar)[XB_TMO], 1u); break; } } } } while (0)
struct XcdBarrier { unsigned* bar; unsigned x; volatile LAS unsigned* st; };
__device__ __forceinline__ XcdBarrier xcd_barrier_post(unsigned* bar, volatile LAS unsigned* st, int tid) {
    XcdBarrier b; b.bar = bar; b.x = xb_xcc_id(); b.st = st;
    if (tid == 0) (void)xb_add(&bar[XB_XCNT(b.x)], 1u);
    return b;
}
__device__ __forceinline__ void xcd_barrier_complete(unsigned* bar, unsigned x, unsigned& nloc, unsigned& nx) {
    const unsigned G = gridDim.x * gridDim.y * gridDim.z;
    unsigned sum, cnt, mine, sp = 0u;
    for (;;) {
        sum = 0u; cnt = 0u; mine = 0u;
#pragma unroll
        for (unsigned j = 0; j < 16; ++j) { const unsigned c = xb_ld(&bar[XB_XCNT(j)]); sum += c; cnt += (c > 0u) ? 1u : 0u; mine = (j == x) ? c : mine; }
        if (sum == G) break;
        __builtin_amdgcn_s_sleep(1);
        if ((++sp & 255u) == 0u) { if (xb_ld(&bar[XB_TMO])) break; if (sp > XB_SPIN_CAP) { atomicAdd(&bar[XB_TMO], 1u); break; } }
    }
    nloc = mine > 0u ? mine : 1u; nx = cnt > 0u ? cnt : 1u;
}
__device__ __forceinline__ void xcd_barrier(const XcdBarrier& b, int tid) {
    asm volatile("s_waitcnt vmcnt(0)" ::: "memory");
    __syncthreads();
    if (tid == 0) {
        unsigned* bar = b.bar;
        __builtin_amdgcn_s_waitcnt(0);
        unsigned nloc = b.st[0], nx = b.st[1];
        if (nloc == 0u) { xcd_barrier_complete(bar, b.x, nloc, nx); b.st[0] = nloc; b.st[1] = nx; }
        const unsigned old = xb_add(&bar[XB_XSUB(b.x)], 1u);
        const unsigned gen = old / nloc;
        if (old + 1u == (gen + 1u) * nloc) {
            __builtin_amdgcn_fence(__ATOMIC_RELEASE, "agent");
            asm volatile("s_waitcnt vmcnt(0)" ::: "memory");
            const unsigned og = xb_add(&bar[XB_TOP], 1u);
            const unsigned tg = og / nx;
            if (og + 1u == (tg + 1u) * nx) xb_add(&bar[XB_TOPGEN], 1u);
            else XB_SPIN(xb_ld(&bar[XB_TOPGEN]) == tg, bar);
            __builtin_amdgcn_fence(__ATOMIC_ACQUIRE, "agent");
            xb_add(&bar[XB_XGEN(b.x)], 1u);
            asm volatile("s_waitcnt vmcnt(0)" ::: "memory");
        } else {
            XB_SPIN(xb_ld(&bar[XB_XGEN(b.x)]) == gen, bar);
            __builtin_amdgcn_fence(__ATOMIC_ACQUIRE, "agent");
            asm volatile("s_waitcnt vmcnt(0)" ::: "memory");
        }
    }
    __syncthreads();
}

namespace pg8 {
constexpr int BM = 256, BK = 64, HALF = 128, HTB = HALF * BK * 2, STAGE_BYTES = 8 * HTB;
__host__ __device__ __forceinline__ int lds_byte(int r, int c) { const int st = (r >> 4) * 2 + (c >> 5), rr = r & 15, cc = c & 31, ob = rr * 64 + cc * 2; return st * 1024 + (ob ^ (((ob >> 9) & 1) << 5)); }
__host__ __device__ __forceinline__ void stage_rc(int b, int& R, int& C) { const int st = b / 1024, sb = b % 1024, swz = sb ^ (((sb >> 9) & 1) << 5); R = (st >> 1) * 16 + swz / 64; C = (st & 1) * 32 + (swz % 64) / 2; }
__host__ __device__ __forceinline__ int lds_byte8(int r, int cb) { const int st = (r >> 4) * 2 + (cb >> 6), rr = r & 15, ob = rr * 64 + (cb & 63); return st * 1024 + (ob ^ (((ob >> 9) & 1) << 4)); }
__host__ __device__ __forceinline__ void stage_rc8(int b, int& R, int& Cb) { const int st = b / 1024, sb = b % 1024, swz = sb ^ (((sb >> 9) & 1) << 4); R = (st >> 1) * 16 + swz / 64; Cb = (st & 1) * 64 + (swz % 64); }
__host__ __device__ __forceinline__ int perm32(int rho) { const int n = rho >> 4, i = rho & 15; return 8 * (i >> 2) + 4 * n + (i & 3); }
struct Unit { int pm, pn; };
struct Gemm { const bf16_t* A; const bf16_t* Bt; int K; const int* rowtab; };
__device__ __forceinline__ unsigned cvt_pk_bf16(float lo, float hi) { unsigned r; asm volatile("v_cvt_pk_bf16_f32 %0, %1, %2" : "=v"(r) : "v"(lo), "v"(hi)); return r; }

template <class Epi, class Sched, bool GATHER, bool F8 = false>
__device__ __forceinline__ void gemm_phase(LAS unsigned char* lds, const Gemm g, const Sched& S, const Epi& E, const int tid) {
    const int wid = __builtin_amdgcn_readfirstlane(tid >> 6), lane = tid & 63, wr = wid >> 2, wc = wid & 3, fr = lane & 15, fq = lane >> 4;
    const int K = g.K, RB = F8 ? K : 2 * K, nt = RB / 128;
    unsigned voffB[2], voffA[2];
#pragma unroll
    for (int i = 0; i < 2; ++i) { int R, Cb; if constexpr (F8) stage_rc8(tid * 16 + i * 8192, R, Cb); else { int C; stage_rc(tid * 16 + i * 8192, R, C); Cb = 2 * C; }
        const int Rb = Epi::PERM ? ((R & ~31) + perm32(R & 31)) : R;
        voffA[i] = (unsigned)(R * RB + Cb); voffB[i] = (unsigned)(Rb * RB + Cb); }
    const size_t kstep = 128;
    const size_t hstep = (size_t)HALF * RB;
    const size_t tstep = 2 * hstep;
    const unsigned ldsw = (unsigned)wid * 1024u;
    const int aoff = F8 ? lds_byte8(wr * 64 + fr, 32 * fq) : lds_byte(wr * 64 + fr, fq * 8), boff = F8 ? lds_byte8(wc * 32 + fr, 32 * fq) : lds_byte(wc * 32 + fr, fq * 8);
    const int aoff2 = aoff ^ 16, boff2 = boff ^ 16;
#define PG8_SA(b, h) (((b) * 2 + (h)) * HTB)
#define PG8_SB(b, h) ((4 + (b) * 2 + (h)) * HTB)
#define PG8_STAGE(bufoff, gbase, voff) do { _Pragma("unroll") for (int _i = 0; _i < 2; ++_i) \
        __builtin_amdgcn_global_load_lds((const unsigned*)((const char*)(gbase) + (voff)[_i]), (LAS unsigned*)(lds + (bufoff) + ldsw + _i * 8192), 16, 0, 0); } while (0)
#define PG8_LDA(dst, b, h) do { if constexpr (F8) { _Pragma("unroll") for (int m = 0; m < 4; ++m) { const i32x4 _lo = *(const LAS i32x4*)(lds + PG8_SA(b, h) + aoff + m * 2048), _hi = *(const LAS i32x4*)(lds + PG8_SA(b, h) + aoff2 + m * 2048); dst##8[m] = __builtin_shufflevector(_lo, _hi, 0, 1, 2, 3, 4, 5, 6, 7); } } \
        else { _Pragma("unroll") for (int m = 0; m < 4; ++m) _Pragma("unroll") for (int k = 0; k < 2; ++k) dst[m][k] = *(const LAS bf16x8*)(lds + PG8_SA(b, h) + aoff + m * 2048 + k * 1024); } } while (0)
#define PG8_LDB(dst, b, h) do { if constexpr (F8) { _Pragma("unroll") for (int n = 0; n < 2; ++n) { const i32x4 _lo = *(const LAS i32x4*)(lds + PG8_SB(b, h) + boff + n * 2048), _hi = *(const LAS i32x4*)(lds + PG8_SB(b, h) + boff2 + n * 2048); dst##8[n] = __builtin_shufflevector(_lo, _hi, 0, 1, 2, 3, 4, 5, 6, 7); } } \
        else { _Pragma("unroll") for (int n = 0; n < 2; ++n) _Pragma("unroll") for (int k = 0; k < 2; ++k) dst[n][k] = *(const LAS bf16x8*)(lds + PG8_SB(b, h) + boff + n * 2048 + k * 1024); } } while (0)
#define PG8_CAT(x) __builtin_shufflevector(x[0], x[1], 0, 1, 2, 3, 4, 5, 6, 7)
#define PG8_MMA(ai, bj, At, Bt) do { __builtin_amdgcn_s_setprio(1); if constexpr (F8) { _Pragma("unroll") for (int m = 0; m < 4; ++m) _Pragma("unroll") for (int n = 0; n < 2; ++n) \
            asm volatile("v_mfma_scale_f32_16x16x128_f8f6f4 %0, %1, %2, %0, %3, %3 op_sel_hi:[0,0,0]" : "+v"(acc[ai][bj][m][n]) : "v"(Bt##8[n]), "v"(At##8[m]), "v"(f8scale)); } \
        else { _Pragma("unroll") for (int m = 0; m < 4; ++m) _Pragma("unroll") for (int n = 0; n < 2; ++n) _Pragma("unroll") for (int k = 0; k < 2; ++k) \
            acc[ai][bj][m][n] = __builtin_amdgcn_mfma_f32_16x16x32_bf16(Bt[n][k], At[m][k], acc[ai][bj][m][n], 0, 0, 0); } __builtin_amdgcn_s_setprio(0); } while (0)
#define PG8_WAIT_V(n) asm volatile("s_waitcnt vmcnt(" #n ")" ::: "memory")
#define PG8_WAIT_L(n) asm volatile("s_waitcnt lgkmcnt(" #n ")" ::: "memory")
#define PG8_BAR __builtin_amdgcn_s_barrier()
#define PG8_SCHED __builtin_amdgcn_sched_barrier(0)
#define PG8_AOFF(o, u) do { int _t2 = tid; asm volatile("" : "+v"(_t2)); _Pragma("unroll") for (int _i = 0; _i < 2; ++_i) { int _R, _Cb; if constexpr (F8) stage_rc8(_t2 * 16 + _i * 8192, _R, _Cb); else { int _C; stage_rc(_t2 * 16 + _i * 8192, _R, _C); _Cb = 2 * _C; } \
        _Pragma("unroll") for (int _h = 0; _h < 2; ++_h) { int _r = (u).pm * BM + _h * HALF + _R; \
        { const int _t = g.rowtab[_r]; _r = _t < 0 ? 0 : (_t & 0x3fffffff); } o[_h][_i] = (unsigned)(_r * RB + _Cb); } } } while (0)
    Unit cur, nxt; int ui = 0;
    if (!S.next(0, cur)) return;
    f32x4 acc[2][2][4][2];
#pragma unroll
    for (int a = 0; a < 2; ++a)
#pragma unroll
        for (int b = 0; b < 2; ++b)
#pragma unroll
            for (int m = 0; m < 4; ++m)
#pragma unroll
                for (int n = 0; n < 2; ++n) acc[a][b][m][n] = (f32x4){0.f, 0.f, 0.f, 0.f};
    bf16x8 At[4][2], B0[2][2], B1[2][2];
    i32x8 At8[4], B08[2], B18[2];
    int f8scale = 0x7f7f7f7f; asm volatile("" : "+v"(f8scale));
    unsigned oc[2][2], on[2][2];
    const char* gA = (const char*)g.A;
    const char* cA = gA; const char* cB = (const char*)g.Bt + (size_t)cur.pn * tstep;
    if constexpr (GATHER) { PG8_AOFF(oc, cur); } else { cA = gA + (size_t)cur.pm * tstep; }
#define PG8_STA_CUR(buf, kb, h) do { if constexpr (GATHER) { PG8_STAGE(buf, gA + (kb), oc[h]); } else { PG8_STAGE(buf, cA + (kb) + (h) * hstep, voffA); } } while (0)
#define PG8_STA_SEL(buf, kb, h) do { if constexpr (GATHER) { if (last) { PG8_STAGE(buf, gA + (kb), on[h]); } else { PG8_STAGE(buf, gA + (kb), oc[h]); } } else { PG8_STAGE(buf, a2p + (kb) + (h) * hstep, voffA); } } while (0)
    PG8_STAGE(PG8_SB(0, 0), cB, voffB); PG8_STAGE(PG8_SB(0, 1), cB + hstep, voffB); PG8_STA_CUR(PG8_SA(0, 0), 0, 0); PG8_STA_CUR(PG8_SA(0, 1), 0, 1);
    if (wr == 1) PG8_BAR;
    PG8_WAIT_V(2); PG8_BAR;
    PG8_STAGE(PG8_SB(1, 0), cB + kstep, voffB); PG8_STA_CUR(PG8_SA(1, 0), kstep, 0); PG8_STAGE(PG8_SB(1, 1), cB + hstep + kstep, voffB);
    PG8_WAIT_V(6); PG8_BAR;
    for (;;) {
        const bool has_next = S.next(ui + 1, nxt);
        const char* nA = cA;
        if constexpr (!GATHER) { if (has_next) nA = gA + (size_t)nxt.pm * tstep; }
        const char* nB = has_next ? (const char*)g.Bt + (size_t)nxt.pn * tstep : cB;
#pragma unroll 1
        for (int t = 0; t < nt; t += 2) {
            const bool last = (t == nt - 2);
            int to = t; asm volatile("" : "+s"(to));
            const size_t k1 = (size_t)(to + 1) * kstep, k2 = last ? 0 : (size_t)(to + 2) * kstep, k3 = k2 + kstep;
            const char* b2 = last ? nB : cB + (size_t)(to + 2) * kstep; const char* b3 = b2 + kstep;
            const char* a2p = last ? nA : cA;
            if constexpr (GATHER) { if (last) { if (has_next) { PG8_AOFF(on, nxt); } else {
#pragma unroll
                for (int h = 0; h < 2; ++h)
#pragma unroll
                    for (int i = 0; i < 2; ++i) on[h][i] = oc[h][i]; } } }
            PG8_LDB(B0, 0, 0); PG8_LDB(B1, 0, 1); PG8_SCHED; PG8_LDA(At, 0, 0); PG8_STA_CUR(PG8_SA(1, 1), k1, 1);
            PG8_WAIT_V(8); PG8_WAIT_L(0); PG8_BAR; PG8_MMA(0, 0, At, B0); PG8_MMA(0, 1, At, B1); PG8_BAR; PG8_SCHED;
            PG8_LDA(At, 0, 1); PG8_STAGE(PG8_SB(0, 0), b2, voffB); PG8_STAGE(PG8_SB(0, 1), b2 + hstep, voffB); PG8_STA_SEL(PG8_SA(0, 0), k2, 0);
            PG8_WAIT_V(8); PG8_WAIT_L(0); PG8_BAR; PG8_MMA(1, 0, At, B0); PG8_MMA(1, 1, At, B1); PG8_BAR; PG8_SCHED;
            PG8_LDB(B0, 1, 0); PG8_LDB(B1, 1, 1); PG8_SCHED; PG8_LDA(At, 1, 0); PG8_STA_SEL(PG8_SA(0, 1), k2, 1);
            PG8_WAIT_V(8); PG8_WAIT_L(0); PG8_BAR; PG8_MMA(0, 0, At, B0); PG8_MMA(0, 1, At, B1); PG8_BAR; PG8_SCHED;
            PG8_LDA(At, 1, 1); PG8_STAGE(PG8_SB(1, 0), b3, voffB); PG8_STAGE(PG8_SB(1, 1), b3 + hstep, voffB); PG8_STA_SEL(PG8_SA(1, 0), k3, 0);
            PG8_WAIT_V(8); PG8_WAIT_L(0); PG8_BAR; PG8_MMA(1, 0, At, B0); PG8_MMA(1, 1, At, B1); PG8_BAR; PG8_SCHED;
        }
        if (wr == 0) PG8_BAR;
        if constexpr (F8) asm volatile("s_nop 15\n\ts_nop 15" : "+v"(acc[1][1][0][0]), "+v"(acc[1][1][0][1]), "+v"(acc[1][1][1][0]), "+v"(acc[1][1][1][1]), "+v"(acc[1][1][2][0]), "+v"(acc[1][1][2][1]), "+v"(acc[1][1][3][0]), "+v"(acc[1][1][3][1]) :: "memory");
        E(acc, cur, wr, wc, fr, fq);
        if (!has_next) break;
#pragma unroll
        for (int a = 0; a < 2; ++a)
#pragma unroll
            for (int b = 0; b < 2; ++b)
#pragma unroll
                for (int m = 0; m < 4; ++m)
#pragma unroll
                    for (int n = 0; n < 2; ++n) acc[a][b][m][n] = (f32x4){0.f, 0.f, 0.f, 0.f};
        cur = nxt; cB = nB; cA = nA; ++ui;
        if constexpr (GATHER) {
#pragma unroll
            for (int h = 0; h < 2; ++h)
#pragma unroll
                for (int i = 0; i < 2; ++i) oc[h][i] = on[h][i]; }
        if (wr == 1) PG8_BAR;
    }
#undef PG8_STA_CUR
#undef PG8_STA_SEL
    PG8_WAIT_V(0);
    PG8_BAR;
#undef PG8_SA
#undef PG8_SB
#undef PG8_STAGE
#undef PG8_LDA
#undef PG8_LDB
#undef PG8_CAT
#undef PG8_MMA
#undef PG8_WAIT_V
#undef PG8_WAIT_L
#undef PG8_BAR
#undef PG8_SCHED
#undef PG8_AOFF
}
}

struct Params { const float* in[34]; float* out; unsigned char* ws; int ph_lo, ph_hi; };
typedef const __attribute__((address_space(4))) Params* KP;
__device__ __forceinline__ KP kp_opaque(KP p) { asm volatile("" : "+s"(p)); return p; }
enum { I_X = 0, I_C, I_CTX, I_CCTX, I_N1W, I_N2W, I_ADAW, I_ADAB, I_WIN, I_WOUT, I_GGW, I_GGB, I_GNW, I_SQN, I_SKN, I_SINK, I_HCW, I_HCB, I_HW1, I_HB1, I_HW2, I_HB2, I_HW3, I_HFR, I_HBIAS,
       I_DQN, I_DKN, I_DLAM, I_DSUB, I_RW, I_RB, I_EG, I_EU, I_ED };
struct Frame {
    LAS unsigned char* lds; volatile LAS unsigned* MISC; unsigned* ctl;
    int tid, lane, wave, vcu, G;
    unsigned char* ws;
};
__device__ __forceinline__ int modrow_of(int row) { return row < TL ? (row >> 11) : 8; }
__device__ __forceinline__ int keyrow(int b, int kidx) { return kidx < LC ? TL + b * LC + kidx : b * SEQ + (kidx - LC); }
__device__ __forceinline__ int wg_grab(Frame& F, int q) {
    __syncthreads();
    if (F.tid == 0) F.MISC[0] = __hip_atomic_fetch_add(F.ctl + CW_Q + 64 * q, 1u, __ATOMIC_RELAXED, __HIP_MEMORY_SCOPE_AGENT);
    __syncthreads();
    { int t_; asm volatile("v_mbcnt_lo_u32_b32 %0, -1, 0\n\tv_mbcnt_hi_u32_b32 %0, -1, %0" : "=v"(t_)); F.lane = t_; F.tid = F.wave * 64 + t_; }
    return (int)F.MISC[0];
}

namespace pg8 {
constexpr int NXCD = 8, WGM = 8;
struct RectOrder {
    int nM, nN, nwg, G, c, nextra, xpm0; unsigned long long xt;
    __device__ void init(int nM_, int nN_, int G_, int c_, int nextra_, int xpm0_, unsigned long long xt_) { nM = nM_; nN = nN_; nwg = nM * nN; G = G_; c = c_; nextra = nextra_; xpm0 = xpm0_; xt = xt_; }
    __device__ bool next(int i, Unit& u) const {
        const int L = i * G + c; if (L >= nwg + nextra) return false;
        if (L >= nwg) { const int e = L - nwg; u.pm = xpm0 + (e >> 3); u.pn = (int)((xt >> (8 * (e & 7))) & 0xffull); return true; }
        int wgid = L; { const int q = nwg / NXCD, r = nwg % NXCD, xcd = wgid % NXCD, off = wgid / NXCD; wgid = (xcd < r ? xcd * (q + 1) : r * (q + 1) + (xcd - r) * q) + off; }
        const int nig = WGM * nN, gid = wgid / nig, fm = gid * WGM, gsz = (nM - fm) < WGM ? (nM - fm) : WGM;
        u.pm = fm + ((wgid % nig) % gsz); u.pn = (wgid % nig) / gsz; return true;
    }
};
struct MoeOrder {
    int npanels, G, vcu; const volatile LAS unsigned char* pexp;
    __device__ bool next(int i, Unit& u) const {
        const int L = i * G + vcu; if (L >= npanels * 8) return false;
        const int p = L >> 3; u.pm = p; u.pn = (int)pexp[p] * 8 + (L & 7); return true;
    }
};
struct EpiU {
    static constexpr bool PERM = true;
    bf16_t* O; float scale;
    __device__ __forceinline__ void operator()(const f32x4 (&acc)[2][2][4][2], const Unit& u, int wr, int wc, int fr, int fq) const {
        const int row0 = u.pm * BM + wr * 64 + fr, col0 = u.pn * BM + wc * 32 + 8 * fq;
#pragma unroll
        for (int ai = 0; ai < 2; ++ai)
#pragma unroll
            for (int m = 0; m < 4; ++m) { bf16_t* rowp = O + (size_t)(row0 + ai * HALF + m * 16) * NU + col0;
#pragma unroll
                for (int bj = 0; bj < 2; ++bj) { const f32x4 v0 = acc[ai][bj][m][0] * scale, v1 = acc[ai][bj][m][1] * scale;
                    u32x4 w; w.x = cvt_pk_bf16(v0[0], v0[1]); w.y = cvt_pk_bf16(v0[2], v0[3]); w.z = cvt_pk_bf16(v1[0], v1[1]); w.w = cvt_pk_bf16(v1[2], v1[3]);
                    *(u32x4*)(rowp + bj * HALF) = w; } }
    }
};
struct EpiWout {
    static constexpr bool PERM = true;
    const float* res_lat; const float* res_ctx; const bf16_t* resb; bf16_t* X; const float* mod;
    __device__ __forceinline__ void operator()(const f32x4 (&acc)[2][2][4][2], const Unit& u, int wr, int wc, int fr, int fq) const {
        const int row0 = u.pm * BM + wr * 64 + fr, col0 = u.pn * BM + wc * 32 + 8 * fq;
        const float* ga = mod + (size_t)modrow_of(u.pm * BM) * 12288 + 2 * D;
        constexpr float sc = WOUT_F8 ? 1.f / 32.f : 1.f;
        f32x4 gv[2][2];
#pragma unroll
        for (int bj = 0; bj < 2; ++bj)
#pragma unroll
            for (int n = 0; n < 2; ++n) gv[bj][n] = *(const f32x4*)(ga + col0 + bj * HALF + n * 4) * sc;
        if (resb) {
#pragma unroll
            for (int ai = 0; ai < 2; ++ai)
#pragma unroll
                for (int m = 0; m < 4; ++m) { const int row = row0 + ai * HALF + m * 16; const bf16_t* rp = resb + (size_t)row * D + col0; bf16_t* xp = X + (size_t)row * D + col0;
#pragma unroll
                    for (int bj = 0; bj < 2; ++bj) { const u32x4 r = *(const u32x4*)(rp + bj * HALF);
                        const f32x4 v0 = (f32x4){bflo(r.x), bfhi(r.x), bflo(r.y), bfhi(r.y)} + gv[bj][0] * acc[ai][bj][m][0], v1 = (f32x4){bflo(r.z), bfhi(r.z), bflo(r.w), bfhi(r.w)} + gv[bj][1] * acc[ai][bj][m][1];
                        u32x4 o; o.x = cvt_pk_bf16(v0[0], v0[1]); o.y = cvt_pk_bf16(v0[2], v0[3]); o.z = cvt_pk_bf16(v1[0], v1[1]); o.w = cvt_pk_bf16(v1[2], v1[3]);
                        *(u32x4*)(xp + bj * HALF) = o; } }
        } else {
#pragma unroll
            for (int ai = 0; ai < 2; ++ai)
#pragma unroll
                for (int m = 0; m < 4; ++m) { const int row = row0 + ai * HALF + m * 16;
                    const float* rp = (row < TL ? res_lat + (size_t)row * D : res_ctx + (size_t)(row - TL) * D) + col0; bf16_t* xp = X + (size_t)row * D + col0;
#pragma unroll
                    for (int bj = 0; bj < 2; ++bj) { const f32x4 r0 = *(const f32x4*)(rp + bj * HALF), r1 = *(const f32x4*)(rp + bj * HALF + 4);
                        const f32x4 v0 = r0 + gv[bj][0] * acc[ai][bj][m][0], v1 = r1 + gv[bj][1] * acc[ai][bj][m][1];
                        u32x4 o; o.x = cvt_pk_bf16(v0[0], v0[1]); o.y = cvt_pk_bf16(v0[2], v0[3]); o.z = cvt_pk_bf16(v1[0], v1[1]); o.w = cvt_pk_bf16(v1[2], v1[3]);
                        *(u32x4*)(xp + bj * HALF) = o; } }
        }
    }
};
struct EpiMoe1 {
    static constexpr bool PERM = true;
    unsigned char* O;
    __device__ __forceinline__ void operator()(const f32x4 (&acc)[2][2][4][2], const Unit& u, int wr, int wc, int fr, int fq) const {
        const int row0 = u.pm * BM + wr * 64 + fr, col0 = (u.pn & 7) * HALF + wc * 32 + 8 * fq;
#pragma unroll
        for (int ai = 0; ai < 2; ++ai)
#pragma unroll
            for (int m = 0; m < 4; ++m) { unsigned char* rowp = O + (size_t)(row0 + ai * HALF + m * 16) * DE + col0; float h[8];
#pragma unroll
                for (int n = 0; n < 2; ++n)
#pragma unroll
                    for (int j = 0; j < 4; ++j) { const float gt = acc[ai][0][m][n][j] * (1.f / 32.f), up = acc[ai][1][m][n][j] * (1.f / 32.f); h[4 * n + j] = gt * __builtin_amdgcn_rcpf(1.f + __expf(-gt)) * up; }
                u32x2 w; w.x = pk4_f8(h[0], h[1], h[2], h[3]); w.y = pk4_f8(h[4], h[5], h[6], h[7]);
                *(u32x2*)rowp = w; }
    }
};
struct EpiMoe2 {
    static constexpr bool PERM = true;
    unsigned char* Y2; const int* rowtok; const float* roww;
    __device__ __forceinline__ void operator()(const f32x4 (&acc)[2][2][4][2], const Unit& u, int wr, int wc, int fr, int fq) const {
        const int row0 = u.pm * BM + wr * 64 + fr, col0 = (u.pn & 7) * BM + wc * 32 + 8 * fq;
#pragma unroll
        for (int ai = 0; ai < 2; ++ai)
#pragma unroll
            for (int m = 0; m < 4; ++m) { asm volatile("" ::: "memory"); const int row = row0 + ai * HALF + m * 16; const int tk = rowtok[row]; const float w = roww[row];
                if (tk >= 0) { unsigned char* rowp = Y2 + ((size_t)(tk >> 30) * TT + (size_t)(tk & 0x3fffffff)) * D + col0;
#pragma unroll
                    for (int bj = 0; bj < 2; ++bj) { const f32x4 v0 = acc[ai][bj][m][0] * w, v1 = acc[ai][bj][m][1] * w;
                        u32x2 o; o.x = pk4_f8(v0[0], v0[1], v0[2], v0[3]); o.y = pk4_f8(v1[0], v1[1], v1[2], v1[3]);
                        *(u32x2*)(rowp + bj * HALF) = o; } } }
    }
};
}

__device__ __forceinline__ void p0_transpose_item(const float* W, int ldw, int srccol0, int k0, bf16_t* dst, int K, LAS float* scr, int lane, bool q = false) {
    { f32x4 v[8];
#pragma unroll
      for (int i = 0; i < 8; ++i) v[i] = *(const f32x4*)(W + (size_t)(k0 + 8 * i + (lane >> 3)) * ldw + srccol0 + 4 * (lane & 7));
#pragma unroll
      for (int i = 0; i < 8; ++i) { LAS float* p = scr + (8 * i + (lane >> 3)) * 33 + 4 * (lane & 7); p[0] = v[i][0]; p[1] = v[i][1]; p[2] = v[i][2]; p[3] = v[i][3]; } }
    LDS_WAIT(); asm volatile("" ::: "memory");
    const int c = lane & 7;
#pragma unroll
    for (int j = 0; j < 4; ++j) { const int n = (lane >> 3) + 8 * j; const LAS float* s = scr + (8 * c) * 33 + n;
        u32x4 o; if (q) { o.x = pk2q(s[0 * 33], s[1 * 33]); o.y = pk2q(s[2 * 33], s[3 * 33]); o.z = pk2q(s[4 * 33], s[5 * 33]); o.w = pk2q(s[6 * 33], s[7 * 33]); }
        else { o.x = pk2(s[0 * 33], s[1 * 33]); o.y = pk2(s[2 * 33], s[3 * 33]); o.z = pk2(s[4 * 33], s[5 * 33]); o.w = pk2(s[6 * 33], s[7 * 33]); }
        *(u32x4*)(dst + (size_t)n * K + k0 + 8 * c) = o; }
    LDS_WAIT(); asm volatile("" ::: "memory");
}
__device__ __forceinline__ void p0_transpose_item8(const float* W, int ldw, int srccol0, int k0, unsigned char* dst, int K, LAS float* scr, int lane) {
    { f32x4 v[8];
#pragma unroll
      for (int i = 0; i < 8; ++i) v[i] = *(const f32x4*)(W + (size_t)(k0 + 8 * i + (lane >> 3)) * ldw + srccol0 + 4 * (lane & 7));
#pragma unroll
      for (int i = 0; i < 8; ++i) { LAS float* p = scr + (8 * i + (lane >> 3)) * 33 + 4 * (lane & 7); p[0] = v[i][0]; p[1] = v[i][1]; p[2] = v[i][2]; p[3] = v[i][3]; } }
    LDS_WAIT(); asm volatile("" ::: "memory");
    const int c = lane & 7;
#pragma unroll
    for (int j = 0; j < 4; ++j) { const int n = (lane >> 3) + 8 * j; const LAS float* s = scr + (8 * c) * 33 + n;
        u32x2 o; o.x = pk4_f8(s[0 * 33] * 32.f, s[1 * 33] * 32.f, s[2 * 33] * 32.f, s[3 * 33] * 32.f); o.y = pk4_f8(s[4 * 33] * 32.f, s[5 * 33] * 32.f, s[6 * 33] * 32.f, s[7 * 33] * 32.f);
        *(u32x2*)(dst + (size_t)n * K + k0 + 8 * c) = o; }
    LDS_WAIT(); asm volatile("" ::: "memory");
}
constexpr int TI_WIN = 32 * 168, TI_WA = 32, TI_WOUT = 32 * 64, TI_GU = 32 * 64, TI_DN = 16 * 64;
constexpr int TI_L = TI_WIN + TI_WA + TI_WOUT;
constexpr int TI_TOTAL = 2 * TI_L + 32 * TI_GU + 32 * TI_DN;
__device__ __forceinline__ void p0_item(KP Pk, Frame& F, int it, LAS float* scr) {
    unsigned char* ws = F.ws;
    if (it < 2 * TI_L) { const int l = it / TI_L; int r = it % TI_L;
        if (r < TI_WIN) { const int kb = r / 168, nb = r % 168, n0 = 32 * nb;
            if (WIN_F8_L(l)) p0_transpose_item8(Pk->in[I_WIN] + (size_t)l * D * DIN, DIN, n0 < 1536 ? n0 : n0 + 32, 64 * kb, ws + WS_WIN + (size_t)l * NU * D * 2 + (size_t)n0 * D, D, scr, F.lane);
            else p0_transpose_item(Pk->in[I_WIN] + (size_t)l * D * DIN, DIN, n0 < 1536 ? n0 : n0 + 32, 64 * kb, (bf16_t*)(ws + WS_WIN) + ((size_t)l * NU + n0) * D, D, scr, F.lane); return; }
        r -= TI_WIN;
        if (r < TI_WA) { if (WIN_F8_L(l)) p0_transpose_item8(Pk->in[I_WIN] + (size_t)l * D * DIN, DIN, 1536, 64 * r, ws + WS_WA + (size_t)l * 32 * D * 2, D, scr, F.lane);
            else p0_transpose_item(Pk->in[I_WIN] + (size_t)l * D * DIN, DIN, 1536, 64 * r, (bf16_t*)(ws + WS_WA) + (size_t)l * 32 * D, D, scr, F.lane); return; }
        r -= TI_WA;
        { const int kb = r / 64, nb = r % 64;
          if (WOUT_F8) p0_transpose_item8(Pk->in[I_WOUT] + (size_t)l * D * D, D, 32 * nb, 64 * kb, ws + WS_WOUT + ((size_t)l * D + 32 * nb) * D, D, scr, F.lane);
          else p0_transpose_item(Pk->in[I_WOUT] + (size_t)l * D * D, D, 32 * nb, 64 * kb, (bf16_t*)(ws + WS_WOUT) + ((size_t)l * D + 32 * nb) * D, D, scr, F.lane); return; }
    }
    it -= 2 * TI_L;
    if (it < 32 * TI_GU) { const int le = it / TI_GU, r = it % TI_GU, kb = r / 64, nb = r % 64, n0 = 32 * nb, j = n0 >> 8, half = (n0 >> 7) & 1, c0 = 128 * j + (n0 & 127);
        p0_transpose_item8((half ? Pk->in[I_EU] : Pk->in[I_EG]) + (size_t)le * D * DE, DE, c0, 64 * kb, ws + WS_WGU + ((size_t)le * 2048 + n0) * D, D, scr, F.lane); return; }
    it -= 32 * TI_GU;
    { const int le = it / TI_DN, r = it % TI_DN, kb = r / 64, nb = r % 64;
        p0_transpose_item8(Pk->in[I_ED] + (size_t)le * DE * D, D, 32 * nb, 64 * kb, ws + WS_WD + ((size_t)le * D + 32 * nb) * DE, DE, scr, F.lane); }
}
__device__ __forceinline__ void ada_unit(KP Pk, Frame& F, int u) {
    unsigned char* ws = F.ws;
    __syncthreads();
        LAS float* sc = (LAS float*)F.lds;
        LAS float* red = (LAS float*)(F.lds + 9 * 2048 * 4);
        for (int i = F.tid; i < 9 * 2048; i += NTHR) { const int r = i >> 11, k = i & 2047; const float v = r < 8 ? Pk->in[I_C][r * 2048 + k] : Pk->in[I_CCTX][k]; sc[i] = silu_f(v); }
        __syncthreads();
        const int l = u / 96, cb = u % 96, col = cb * 128 + (F.tid & 127), kp = F.tid >> 7;
        const float* W = Pk->in[I_ADAW] + (size_t)l * D * 12288 + col;
        float a[9];
#pragma unroll
        for (int r = 0; r < 9; ++r) a[r] = 0.f;
        for (int k = kp * 512; k < kp * 512 + 512; k += 32) {
            float w[32];
#pragma unroll
            for (int q = 0; q < 32; ++q) w[q] = W[(size_t)(k + q) * 12288];
#pragma unroll
            for (int q = 0; q < 32; ++q) {
#pragma unroll
                for (int r = 0; r < 9; ++r) a[r] += sc[r * 2048 + k + q] * w[q];
                if ((q & 3) == 3) __builtin_amdgcn_sched_barrier(0); }
        }
#pragma unroll
        for (int r = 0; r < 9; ++r) red[(kp * 9 + r) * 128 + (F.tid & 127)] = a[r];
        __syncthreads();
        for (int i = F.tid; i < 9 * 128; i += NTHR) { const int r = i >> 7, c = i & 127;
            const float s = (red[(0 * 9 + r) * 128 + c] + red[(1 * 9 + r) * 128 + c]) + (red[(2 * 9 + r) * 128 + c] + red[(3 * 9 + r) * 128 + c]);
            ((float*)(ws + WS_MOD))[((size_t)l * 9 + r) * 12288 + cb * 128 + c] = s + Pk->in[I_ADAB][l * 12288 + cb * 128 + c]; }
        __syncthreads();
}
__device__ __forceinline__ void p0_prologue(KP Pk, Frame& F, int rep) {
    unsigned char* ws = F.ws;
    const int gw = F.vcu * NWAVES + F.wave, NGW = F.G * NWAVES;
    if (blockIdx.x < 96) ada_unit(Pk, F, (int)blockIdx.x);
    for (int i = blockIdx.x * NTHR + F.tid; i < SEQ * 64; i += F.G * NTHR) { const int t = i >> 6, j = i & 63, q = j >> 4, f = j & 15;
        const float inv = exp2f(-(float)f * (13.287712379549449f / 16.f)); const float pos = (float)(q < 2 ? (t >> 6) : (t & 63)); const float ang = pos * inv;
        ((float*)(ws + WS_ROPE))[i] = (q & 1) ? sinf(ang) : cosf(ang); }
    for (int it = gw; it < 2 * 2304; it += NGW) { const int l = it / 2304, tt = it % 2304, L = tt < 2048 ? 2048 : 256, t = tt < 2048 ? tt : tt - 2048;
        const float tn = (float)t / (float)(L - 1), wv = (6.283185307179586f / (float)L) * (float)t;
        const float* w1 = Pk->in[I_HW1] + l * 33 * 64; const float* w2 = Pk->in[I_HW2] + l * 64 * 64;
        float zv = 0.f;
        if (F.lane == 0) zv = tn; else if (F.lane < 33) { const int bi = (F.lane - 1) & 15; const float band = 1e-4f + (float)bi * ((15.f - 1e-4f) / 15.f); zv = F.lane < 17 ? cosf(wv * band) : -sinf(wv * band); }
        float s = Pk->in[I_HB1][l * 64 + F.lane];
#pragma unroll
        for (int i = 0; i < 33; ++i) s += __shfl(zv, i) * w1[i * 64 + F.lane];
        const float h1 = sinf(Pk->in[I_HFR][(l * 2 + 0) * 64 + F.lane] * s);
        float s2 = Pk->in[I_HB2][l * 64 + F.lane];
#pragma unroll 16
        for (int i = 0; i < 64; ++i) s2 += __shfl(h1, i) * w2[i * 64 + F.lane];
        ((float*)(ws + WS_HYH2))[(size_t)it * 64 + F.lane] = sinf(Pk->in[I_HFR][(l * 2 + 1) * 64 + F.lane] * s2);
    }
    { LAS float* scr = (LAS float*)(F.lds + F.wave * 8704);
      __syncthreads();
      for (;;) { int base = 0; if (F.lane == 0) base = (int)__hip_atomic_fetch_add(F.ctl + CW_Q + 64 * (rep ? 5 : 0), 16u, __ATOMIC_RELAXED, __HIP_MEMORY_SCOPE_AGENT);
          base = __builtin_amdgcn_readfirstlane(base); if (base >= TI_WIN + TI_WA) break;
          for (int it = base; it < base + 16 && it < TI_WIN + TI_WA; ++it) p0_item(Pk, F, it, scr); } }
}

#define MFMA16(a, b, c) __builtin_amdgcn_mfma_f32_16x16x32_bf16((a), (b), (c), 0, 0, 0)
#define MFMA32(a, b, c) __builtin_amdgcn_mfma_f32_32x32x16_bf16((a), (b), (c), 0, 0, 0)
__device__ __forceinline__ void load_row(const float* p, int lane, f32x4 (&v)[8]) {
#pragma unroll
    for (int j = 0; j < 8; ++j) v[j] = ((const f32x4*)p)[lane + 64 * j];
}
__device__ __forceinline__ void load_row_bf16(const bf16_t* p, int lane, f32x4 (&v)[8]) {
#pragma unroll
    for (int j = 0; j < 8; ++j) { const u32x2 a = ((const u32x2*)p)[lane + 64 * j]; v[j] = (f32x4){bflo(a.x), bfhi(a.x), bflo(a.y), bfhi(a.y)}; }
}
__device__ __forceinline__ void add_y2(const unsigned char* y0, const unsigned char* y1, const float* gf, int lane, f32x4 (&v)[8]) {
#pragma unroll
    for (int j = 0; j < 8; ++j) { const unsigned a = ((const unsigned*)y0)[lane + 64 * j], b = ((const unsigned*)y1)[lane + 64 * j]; const f32x4 g = ((const f32x4*)gf)[lane + 64 * j] * (1.f / 32.f);
        const f32x2 a0 = __builtin_amdgcn_cvt_pk_f32_fp8(a, false), a1 = __builtin_amdgcn_cvt_pk_f32_fp8(a, true), b0 = __builtin_amdgcn_cvt_pk_f32_fp8(b, false), b1 = __builtin_amdgcn_cvt_pk_f32_fp8(b, true);
        v[j][0] += g[0] * (a0[0] + b0[0]); v[j][1] += g[1] * (a0[1] + b0[1]); v[j][2] += g[2] * (a1[0] + b1[0]); v[j][3] += g[3] * (a1[1] + b1[1]); }
}
__device__ __forceinline__ float row_rstd(const f32x4 (&v)[8]) {
    float s = 0.f;
#pragma unroll
    for (int j = 0; j < 8; ++j) s += (v[j][0] * v[j][0] + v[j][1] * v[j][1]) + (v[j][2] * v[j][2] + v[j][3] * v[j][3]);
    return rsqrtf(wave_sum(s) * (1.f / D) + NORM_EPS);
}
__device__ __forceinline__ void modulate(f32x4 (&v)[8], float rstd, const float* nw, const float* sh, const float* sc, int lane) {
#pragma unroll
    for (int j = 0; j < 8; ++j) { const f32x4 w = ((const f32x4*)nw)[lane + 64 * j], a = ((const f32x4*)sc)[lane + 64 * j], b = ((const f32x4*)sh)[lane + 64 * j];
        v[j] = v[j] * rstd * w * (a + 1.f) + b; }
}
__device__ __forceinline__ void store_row_bf16(bf16_t* o, int lane, const f32x4 (&v)[8], bool q = false) {
#pragma unroll
    for (int j = 0; j < 8; ++j) { u32x2 w; if (q) { w.x = pk2q(v[j][0], v[j][1]); w.y = pk2q(v[j][2], v[j][3]); } else { w.x = pk2(v[j][0], v[j][1]); w.y = pk2(v[j][2], v[j][3]); } ((u32x2*)o)[lane + 64 * j] = w; }
}
__device__ __forceinline__ void store_row_f8(unsigned char* o, int lane, const f32x4 (&v)[8]) {
#pragma unroll
    for (int j = 0; j < 8; ++j) ((unsigned*)o)[lane + 64 * j] = pk4_f8(v[j][0], v[j][1], v[j][2], v[j][3]);
}
__device__ __forceinline__ void ph_norm1(KP Pk, Frame& F, int l) {
    unsigned char* ws = F.ws;
    const int gw = F.vcu * NWAVES + F.wave, NGW = F.G * NWAVES;
    const float* mod = (const float*)(ws + WS_MOD) + (size_t)l * 9 * 12288;
    bf16_t* X = (bf16_t*)(ws + WS_X); bf16_t* H = (bf16_t*)(ws + WS_H); const unsigned char* Y2 = ws + WS_Y2;
    for (int row = gw; row < TT; row += NGW) {
        const int r = modrow_of(row); f32x4 v[8];
        if (l == 0) load_row(row < TL ? Pk->in[I_X] + (size_t)row * D : Pk->in[I_CTX] + (size_t)(row - TL) * D, F.lane, v);
        else { load_row_bf16(X + (size_t)row * D, F.lane, v);
            add_y2(Y2 + (size_t)row * D, Y2 + ((size_t)TT + row) * D, (const float*)(ws + WS_MOD) + (size_t)r * 12288 + 5 * D, F.lane, v);
            if (row < TL) store_row_bf16(X + (size_t)row * D, F.lane, v); }
        const float rstd = row_rstd(v);
        modulate(v, rstd, Pk->in[I_N1W] + l * D, mod + (size_t)r * 12288, mod + (size_t)r * 12288 + D, F.lane);
        if (WIN_F8_L(l)) store_row_f8(ws + WS_H + (size_t)row * D, F.lane, v); else store_row_bf16(H + (size_t)row * D, F.lane, v);
    }
}
__device__ __forceinline__ void ph_hyena_filters(KP Pk, Frame& F, int u) {
    unsigned char* ws = F.ws;
    constexpr int HRS = 2052;
    LAS float* HR = (LAS float*)F.lds; LAS float* red = (LAS float*)(F.lds + 16 * HRS * 4);
    const int r16 = F.lane & 15, kg = F.lane >> 4;
    {
        const int lf = u >> 7, cg = u & 127, chl = r16 & 3, od = r16 >> 2, ch = cg * 4 + chl;
        const float* w3 = Pk->in[I_HW3] + (size_t)lf * 64 * 2048 + (od >> 1) * 1024 + (od & 1) * 512 + ch;
        bf16x8 wb[2];
#pragma unroll
        for (int ks = 0; ks < 2; ++ks) { float w[8];
#pragma unroll
            for (int j = 0; j < 8; ++j) w[j] = w3[(size_t)(32 * ks + 8 * kg + j) * 2048];
            u32x4 p; p.x = pk2(w[0], w[1]); p.y = pk2(w[2], w[3]); p.z = pk2(w[4], w[5]); p.w = pk2(w[6], w[7]); wb[ks] = __builtin_bit_cast(bf16x8, p); }
        const float dmin = 3.0701134573253940f, dmax = 15.350567286626972f, delta = dmin + (float)ch * ((dmax - dmin) / 511.f);
#pragma unroll 1
        for (int sel = 0; sel < 2; ++sel) {
            const int L = sel == 0 ? 2048 : 256; const float* h2 = (const float*)(ws + WS_HYH2) + ((size_t)lf * 2304 + (sel == 0 ? 0 : 2048)) * 64; const float rl = 1.f / (float)(L - 1);
            __syncthreads();
            float s = 0.f;
#pragma unroll 2
            for (int tile = F.wave; tile < L / 16; tile += NWAVES) {
                const f32x4* hp = (const f32x4*)(h2 + (size_t)(16 * tile + r16) * 64 + 8 * kg);
                const f32x4 a0 = hp[0], a1 = hp[1], a2 = hp[8], a3 = hp[9];
                u32x4 p0, p1; p0.x = pk2(a0[0], a0[1]); p0.y = pk2(a0[2], a0[3]); p0.z = pk2(a1[0], a1[1]); p0.w = pk2(a1[2], a1[3]); p1.x = pk2(a2[0], a2[1]); p1.y = pk2(a2[2], a2[3]); p1.z = pk2(a3[0], a3[1]); p1.w = pk2(a3[2], a3[3]);
                f32x4 d = MFMA16(__builtin_bit_cast(bf16x8, p0), wb[0], ((f32x4){0.f, 0.f, 0.f, 0.f})); d = MFMA16(__builtin_bit_cast(bf16x8, p1), wb[1], d);
                const int t0 = 16 * tile + 4 * kg;
#pragma unroll
                for (int i = 0; i < 4; ++i) { d[i] *= expf(-(float)(t0 + i) * rl * delta); s += fabsf(d[i]); }
                *(LAS f32x4*)(HR + r16 * HRS + t0) = d; }
            s += __shfl_xor(s, 16); s += __shfl_xor(s, 32);
            if (F.lane < 16) red[F.wave * 16 + F.lane] = s;
            __syncthreads();
            for (int e = F.tid; e < 16 * L; e += NTHR) { const int col = e / L, t = e % L, dir = (col >> 2) & 1, o = col >> 3, c = cg * 4 + (col & 3);
                float tot = 0.f;
#pragma unroll
                for (int w = 0; w < 8; ++w) tot += red[w * 16 + (col & ~4)] + red[w * 16 + (col | 4)];
                float hv = HR[col * HRS + t] / tot; int idx = dir == 0 ? L - t : L + t;
                if (dir == 1 && t == 0) { idx = 0; hv = 0.f; }
                ((bf16_t*)(ws + WS_HYF) + ((size_t)lf * 1024 + o * 512 + c) * 4608)[(sel == 0 ? 0 : 4096) + idx] = (bf16_t)f2bf(hv); }
        }
    }
}
__device__ __forceinline__ void ph_norm2_router(KP Pk, Frame& F, int l, int rep) {
    unsigned char* ws = F.ws;
    const int gw = F.vcu * NWAVES + F.wave, NGW = F.G * NWAVES, nrows = l == 0 ? TT : TL;
    const float* mod = (const float*)(ws + WS_MOD) + (size_t)l * 9 * 12288;
    const bf16_t* X = (const bf16_t*)(ws + WS_X); unsigned char* Fo = ws + WS_H;
    LAS float* rw = (LAS float*)F.lds;
    volatile LAS unsigned* lcnt = F.MISC + 16;
    if (F.tid < 16) lcnt[F.tid] = 0u;
    for (int i = F.tid; i < 2048 * 4; i += NTHR) { const f32x4 w = ((const f32x4*)Pk->in[I_RW])[i]; const int k = i >> 2, e0 = (i & 3) * 4;
        rw[(e0 + 0) * 2048 + k] = w[0]; rw[(e0 + 1) * 2048 + k] = w[1]; rw[(e0 + 2) * 2048 + k] = w[2]; rw[(e0 + 3) * 2048 + k] = w[3]; }
    __syncthreads();
    float rb[16];
#pragma unroll
    for (int e = 0; e < 16; ++e) rb[e] = Pk->in[I_RB][e];
    for (int rowA = gw; rowA < nrows; rowA += 2 * NGW) {
        const bool hasB = rowA + NGW < nrows; const int rowB = hasB ? rowA + NGW : rowA;
        f32x4 va[8], vb[8];
        load_row_bf16(X + (size_t)rowA * D, F.lane, va); load_row_bf16(X + (size_t)rowB * D, F.lane, vb);
        { const int r = modrow_of(rowA); const float rstd = row_rstd(va); modulate(va, rstd, Pk->in[I_N2W] + l * D, mod + (size_t)r * 12288 + 3 * D, mod + (size_t)r * 12288 + 4 * D, F.lane); store_row_f8(Fo + (size_t)rowA * D, F.lane, va); }
        { const int r = modrow_of(rowB); const float rstd = row_rstd(vb); modulate(vb, rstd, Pk->in[I_N2W] + l * D, mod + (size_t)r * 12288 + 3 * D, mod + (size_t)r * 12288 + 4 * D, F.lane); if (hasB) store_row_f8(Fo + (size_t)rowB * D, F.lane, vb); }
        float pa[32];
#pragma unroll
        for (int e = 0; e < 16; ++e) { float a = 0.f, b = 0.f;
#pragma unroll
            for (int j = 0; j < 8; ++j) { const f32x4 w = ((const LAS f32x4*)(rw + e * 2048))[F.lane + 64 * j];
                a += (va[j][0] * w[0] + va[j][1] * w[1]) + (va[j][2] * w[2] + va[j][3] * w[3]); b += (vb[j][0] * w[0] + vb[j][1] * w[1]) + (vb[j][2] * w[2] + vb[j][3] * w[3]); }
            pa[e] = a; pa[16 + e] = b; }
#define RB_STEP(N, BIT) { const bool up = (F.lane & (BIT)) != 0; _Pragma("unroll") for (int k = 0; k < (N); ++k) { const float keep = up ? pa[(N) + k] : pa[k], send = up ? pa[k] : pa[(N) + k]; pa[k] = keep + __shfl_xor(send, (BIT)); } }
        RB_STEP(16, 32) RB_STEP(8, 16) RB_STEP(4, 8) RB_STEP(2, 4) RB_STEP(1, 2)
#undef RB_STEP
        const float red = pa[0] + __shfl_xor(pa[0], 1);
        float lg[16];
#pragma unroll
        for (int e = 0; e < 16; ++e) lg[e] = __shfl(red, (F.lane & 32) + 2 * e);
        float mx = lg[0];
#pragma unroll
        for (int e = 1; e < 16; ++e) mx = fmaxf(mx, lg[e]);
        float sum = 0.f;
#pragma unroll
        for (int e = 0; e < 16; ++e) { lg[e] = expf(lg[e] - mx); sum += lg[e]; }
        const float rs = 1.f / sum; float sel[16];
#pragma unroll
        for (int e = 0; e < 16; ++e) { lg[e] *= rs; sel[e] = lg[e] + rb[e]; }
        int grp = 0; float gbest = fmaxf(fmaxf(sel[0], sel[1]), fmaxf(sel[2], sel[3]));
#pragma unroll
        for (int g = 1; g < 4; ++g) { const float gm = fmaxf(fmaxf(sel[4 * g], sel[4 * g + 1]), fmaxf(sel[4 * g + 2], sel[4 * g + 3])); if (gm > gbest) { gbest = gm; grp = g; } }
        float s4[4], p4[4];
#pragma unroll
        for (int i = 0; i < 4; ++i) { s4[i] = grp == 0 ? sel[i] : grp == 1 ? sel[4 + i] : grp == 2 ? sel[8 + i] : sel[12 + i]; p4[i] = grp == 0 ? lg[i] : grp == 1 ? lg[4 + i] : grp == 2 ? lg[8 + i] : lg[12 + i]; }
        int i0 = 0; float b0 = s4[0];
#pragma unroll
        for (int i = 1; i < 4; ++i) if (s4[i] > b0) { b0 = s4[i]; i0 = i; }
        int i1 = -1; float b1 = 0.f;
#pragma unroll
        for (int i = 0; i < 4; ++i) if (i != i0 && (i1 < 0 || s4[i] > b1)) { b1 = s4[i]; i1 = i; }
        const float p0 = i0 == 0 ? p4[0] : i0 == 1 ? p4[1] : i0 == 2 ? p4[2] : p4[3], p1 = i1 == 0 ? p4[0] : i1 == 1 ? p4[1] : i1 == 2 ? p4[2] : p4[3];
        const int e0 = grp * 4 + i0, e1 = grp * 4 + i1; const float ws_ = 1.f / (p0 + p1);
        if (F.lane == 0 || (F.lane == 32 && hasB)) { const int row = F.lane == 0 ? rowA : rowB;
            ((int*)(ws + WS_RT + RT_E))[row] = e0 | (e1 << 8); ((f32x2*)(ws + WS_RT + RT_W))[row] = (f32x2){p0 * ws_, p1 * ws_};
            __hip_atomic_fetch_add((LAS unsigned*)&lcnt[e0], 1u, __ATOMIC_RELAXED, __HIP_MEMORY_SCOPE_WORKGROUP); __hip_atomic_fetch_add((LAS unsigned*)&lcnt[e1], 1u, __ATOMIC_RELAXED, __HIP_MEMORY_SCOPE_WORKGROUP); }
    }
    __syncthreads();
    { int t_; asm volatile("v_mbcnt_lo_u32_b32 %0, -1, 0\n\tv_mbcnt_hi_u32_b32 %0, -1, %0" : "=v"(t_)); t_ += F.wave * 64;
      if (t_ < 16 && lcnt[t_]) __hip_atomic_fetch_add(F.ctl + CW_CNT + 64 * (l + 2 * rep) + t_, lcnt[t_], __ATOMIC_RELAXED, __HIP_MEMORY_SCOPE_AGENT); }
}
__device__ __forceinline__ int moe_table(Frame& F, int l) {
    volatile LAS unsigned char* pexp = (volatile LAS unsigned char*)(F.MISC + 64);
    __syncthreads();
    if (F.tid < 64) {
        const int e = F.lane & 15; const int c = (int)__hip_atomic_load(F.ctl + CW_CNT + 64 * l + e, __ATOMIC_RELAXED, __HIP_MEMORY_SCOPE_AGENT);
        const int np = (c + 255) >> 8; int p0 = np;
#pragma unroll
        for (int d = 1; d < 16; d <<= 1) { const int y = __shfl(p0, F.lane - d); if (e >= d) p0 += y; }
        const int tot = __shfl(p0, 15); p0 -= np;
        if (F.lane < 16) { F.MISC[32 + e] = (unsigned)(p0 * 256); for (int j = 0; j < np; ++j) pexp[p0 + j] = (unsigned char)e; if (e == 0) F.MISC[2] = (unsigned)tot; }
    }
    __syncthreads();
    return (int)F.MISC[2];
}
__device__ __forceinline__ void ph_slots(KP Pk, Frame& F, int l) {
    unsigned char* ws = F.ws;
    const int nrows = l == 0 ? TT : TL, per = (nrows + F.G - 1) / F.G, t0 = blockIdx.x * per, t1 = min(nrows, t0 + per);
    (void)moe_table(F, l);
    volatile LAS unsigned* lcnt = F.MISC + 16; volatile LAS unsigned* lbase = F.MISC + 48;
    if (F.tid < 16) lcnt[F.tid] = 0u;
    __syncthreads();
    const int* RE = (const int*)(ws + WS_RT + RT_E); const f32x2* RW = (const f32x2*)(ws + WS_RT + RT_W);
    int* ROWTOK = (int*)(ws + WS_RT + RT_ROWTOK); float* ROWW = (float*)(ws + WS_RT + RT_ROWW);
    const int tok = t0 + F.tid; int e0 = 0, e1 = 0; unsigned q0 = 0, q1 = 0;
    if (tok < t1) { const int ee = RE[tok]; e0 = ee & 255; e1 = ee >> 8;
        q0 = __hip_atomic_fetch_add((LAS unsigned*)&lcnt[e0], 1u, __ATOMIC_RELAXED, __HIP_MEMORY_SCOPE_WORKGROUP); q1 = __hip_atomic_fetch_add((LAS unsigned*)&lcnt[e1], 1u, __ATOMIC_RELAXED, __HIP_MEMORY_SCOPE_WORKGROUP); }
    __syncthreads();
    if (F.tid < 16) lbase[F.tid] = lcnt[F.tid] ? __hip_atomic_fetch_add(F.ctl + CW_CUR + 64 * l + F.tid, lcnt[F.tid], __ATOMIC_RELAXED, __HIP_MEMORY_SCOPE_AGENT) : 0u;
    __syncthreads();
    if (tok < t1) { const f32x2 w = RW[tok]; const int r0 = (int)(F.MISC[32 + e0] + lbase[e0] + q0), r1 = (int)(F.MISC[32 + e1] + lbase[e1] + q1);
        ROWTOK[r0] = tok; ROWW[r0] = w.x; ROWTOK[r1] = tok | (1 << 30); ROWW[r1] = w.y; }
    if (blockIdx.x < NE) { const int e = blockIdx.x, c = (int)__hip_atomic_load(F.ctl + CW_CNT + 64 * l + e, __ATOMIC_RELAXED, __HIP_MEMORY_SCOPE_AGENT), base = (int)F.MISC[32 + e];
        for (int i = c + F.tid; i < ((c + 255) & ~255); i += NTHR) { ROWTOK[base + i] = -1; ROWW[base + i] = 0.f; } }
}
__device__ __forceinline__ void ph_final(KP Pk, Frame& F) {
    unsigned char* ws = F.ws;
    const int gw = F.vcu * NWAVES + F.wave, NGW = F.G * NWAVES;
    const bf16_t* X = (const bf16_t*)(ws + WS_X); const unsigned char* Y2 = ws + WS_Y2;
    for (int row = gw; row < TL; row += NGW) { f32x4 v[8];
        load_row_bf16(X + (size_t)row * D, F.lane, v);
        add_y2(Y2 + (size_t)row * D, Y2 + ((size_t)TT + row) * D, (const float*)(ws + WS_MOD) + ((size_t)9 + (row >> 11)) * 12288 + 5 * D, F.lane, v);
#pragma unroll
        for (int j = 0; j < 8; ++j) ((f32x4*)(Pk->out + (size_t)row * D))[F.lane + 64 * j] = v[j]; }
}

__device__ __forceinline__ void ph_gate_cols(Frame& F, int l) {
    unsigned char* ws = F.ws;
    const int r32 = F.lane & 31, hi = F.lane >> 5;
    const bf16_t* H = (const bf16_t*)(ws + WS_H); const bf16_t* Wa = (const bf16_t*)(ws + WS_WA) + (size_t)l * 32 * D; float* AG = (float*)(ws + WS_AG);
    LAS unsigned char* tile = F.lds + F.wave * 16896;
    LAS float* red = (LAS float*)F.lds;
    for (int it = blockIdx.x; it < TT / 32; it += F.G) {
        const int kb = F.wave * 256;
        u32x4 av[16]; bf16x8 bv[16];
#pragma unroll
        for (int i = 0; i < 16; ++i) { const int id = F.lane + 64 * i; av[i] = *(const u32x4*)(H + (size_t)(it * 32 + (id >> 5)) * D + kb + 8 * (id & 31)); }
#pragma unroll
        for (int ks = 0; ks < 16; ++ks) bv[ks] = *(const bf16x8*)(Wa + (size_t)r32 * D + kb + 16 * ks + 8 * hi);
        __syncthreads();
#pragma unroll
        for (int i = 0; i < 16; ++i) { const int id = F.lane + 64 * i; *(LAS u32x4*)(tile + ((id >> 5) * 264 + 8 * (id & 31)) * 2) = av[i]; }
        f32x16 acc = {};
#pragma unroll
        for (int ks = 0; ks < 16; ++ks) { const bf16x8 a = *(const LAS bf16x8*)(tile + (r32 * 264 + 16 * ks + 8 * hi) * 2); acc = MFMA32(a, bv[ks], acc); }
        __syncthreads();
#pragma unroll
        for (int r = 0; r < 16; ++r) red[(F.wave * 16 + r) * 64 + F.lane] = acc[r];
        __syncthreads();
        for (int e = F.tid; e < 1024; e += NTHR) { float sum = 0.f;
#pragma unroll
            for (int w = 0; w < 8; ++w) sum += red[w * 1024 + e];
            const int r = e >> 6, ln = e & 63; AG[(size_t)(it * 32 + (r & 3) + 8 * (r >> 2) + 4 * (ln >> 5)) * 32 + (ln & 31)] = sum; }
    }
}

__device__ __forceinline__ void ph_gate_cols8(Frame& F, int l) {
    unsigned char* ws = F.ws;
    const int fr = F.lane & 15, fq = F.lane >> 4, kb = F.wave * 256;
    const unsigned char* H8 = ws + WS_H; const unsigned char* Wa8 = ws + WS_WA + (size_t)l * 32 * D * 2; float* AG = (float*)(ws + WS_AG);
    LAS f32x4* red = (LAS f32x4*)F.lds;
    int f8scale = 0x7f7f7f7f; asm volatile("" : "+v"(f8scale));
    i32x8 b[2][2], a[2][2];
#pragma unroll
    for (int ch = 0; ch < 2; ++ch)
#pragma unroll
        for (int ks = 0; ks < 2; ++ks) b[ch][ks] = *(const i32x8*)(Wa8 + (size_t)(16 * ch + fr) * D + kb + 128 * ks + 32 * fq);
    int it = blockIdx.x;
    if (it < TT / 32) {
#pragma unroll
        for (int rh = 0; rh < 2; ++rh)
#pragma unroll
            for (int ks = 0; ks < 2; ++ks) a[rh][ks] = *(const i32x8*)(H8 + (size_t)(it * 32 + 16 * rh + fr) * D + kb + 128 * ks + 32 * fq); }
    for (; it < TT / 32; it += F.G) {
        f32x4 acc[2][2];
#pragma unroll
        for (int rh = 0; rh < 2; ++rh)
#pragma unroll
            for (int ch = 0; ch < 2; ++ch) acc[rh][ch] = (f32x4){0.f, 0.f, 0.f, 0.f};
#pragma unroll
        for (int ks = 0; ks < 2; ++ks)
#pragma unroll
            for (int rh = 0; rh < 2; ++rh)
#pragma unroll
                for (int ch = 0; ch < 2; ++ch)
                    asm volatile("v_mfma_scale_f32_16x16x128_f8f6f4 %0, %1, %2, %0, %3, %3 op_sel_hi:[0,0,0]" : "+v"(acc[rh][ch]) : "v"(b[ch][ks]), "v"(a[rh][ks]), "v"(f8scale));
        asm volatile("s_nop 15\n\ts_nop 15" : "+v"(acc[0][0]), "+v"(acc[0][1]), "+v"(acc[1][0]), "+v"(acc[1][1]) :: "memory");
        const int nx = it + F.G;
        if (nx < TT / 32) {
#pragma unroll
            for (int rh = 0; rh < 2; ++rh)
#pragma unroll
                for (int ks = 0; ks < 2; ++ks) a[rh][ks] = *(const i32x8*)(H8 + (size_t)(nx * 32 + 16 * rh + fr) * D + kb + 128 * ks + 32 * fq); }
        __syncthreads();
#pragma unroll
        for (int rh = 0; rh < 2; ++rh)
#pragma unroll
            for (int ch = 0; ch < 2; ++ch) red[(F.wave * 4 + rh * 2 + ch) * 64 + F.lane] = acc[rh][ch];
        __syncthreads();
        for (int e = F.tid; e < 1024; e += NTHR) { float sum = 0.f;
#pragma unroll
            for (int w = 0; w < 8; ++w) sum += ((const LAS float*)red)[w * 1024 + e];
            const int blk = e >> 8, ln = (e >> 2) & 63, k = e & 3;
            AG[(size_t)(it * 32 + 16 * (blk >> 1) + (ln & 15)) * 32 + 16 * (blk & 1) + 4 * (ln >> 4) + k] = sum * (1.f / 32.f); }
    }
}

constexpr int WAVE_LDS = 17408;
__device__ __forceinline__ int perm16(int k) { return (k & 3) + 4 * ((k >> 3) & 1) + 8 * ((k >> 2) & 1); }
__device__ __forceinline__ int gla_kidx(int dir, int s) { return dir == 0 ? s : (s < LC ? LC - 1 - s : LC + (SEQ - 1 - (s - LC))); }
constexpr int GL_QT = 0, GL_KT = 1280, GL_KHT = 2560, GL_VT = 4096, GL_PT = 7168, GL_ST = 7936, GL_G = 13056, GL_GW = 13312, GL_GB = 15360;
__device__ __forceinline__ void gla_load_gates(KP Pk, Frame& F, int l, int h, int dir, LAS unsigned char* wl) {
    LAS float* gw = (LAS float*)(wl + GL_GW); LAS float* gb = (LAS float*)(wl + GL_GB);
    const float* src = Pk->in[I_GGW] + ((size_t)(l * 2 + dir) * 16) * 256 + h * 32;
#pragma unroll
    for (int i = 0; i < 8; ++i) { const int e = F.lane + 64 * i; gw[e] = src[(e >> 5) * 256 + (e & 31)]; }
    if (F.lane < 32) gb[F.lane] = Pk->in[I_GGB][(l * 2 + dir) * 256 + h * 32 + F.lane];
}
struct GlaIn { f32x4 ag[4]; u32x4 kv, qv, v0, v1; };
template <bool NEEDQ>
__device__ __forceinline__ void gla_sub_load(Frame& F, int b, int h, int dir, int kidx0, GlaIn& in) {
    unsigned char* ws = F.ws;
    int lane_o = F.lane; asm volatile("" : "+v"(lane_o));
    const int tau = lane_o & 15, dq = lane_o >> 4, row = keyrow(b, kidx0 + tau);
    const f32x4* ag = (const f32x4*)((const float*)(ws + WS_AG) + (size_t)row * 32 + dir * 16);
#pragma unroll
    for (int r4 = 0; r4 < 4; ++r4) in.ag[r4] = ag[r4];
    const bf16_t* U = (const bf16_t*)(ws + WS_U) + (size_t)row * NU;
    in.kv = *(const u32x4*)(U + UC_GK + h * 32 + dq * 8);
    if (NEEDQ) in.qv = *(const u32x4*)(U + UC_GQ + h * 32 + dq * 8);
    in.v0 = *(const u32x4*)(U + UC_GV + h * 64 + dq * 16); in.v1 = *(const u32x4*)(U + UC_GV + h * 64 + dq * 16 + 8);
}
template <bool NEEDQ>
__device__ __forceinline__ void gla_sub_prep(Frame& F, int dir, const GlaIn& in, LAS unsigned char* wl, float (&ltot)[8]) {
    int lane_o = F.lane; asm volatile("" : "+v"(lane_o));
    const int tau = lane_o & 15, dq = lane_o >> 4;
    const LAS float* gw = (const LAS float*)(wl + GL_GW) + dq * 8; const LAS float* gb = (const LAS float*)(wl + GL_GB) + dq * 8;
    const f32x4* ag = in.ag;
    float x[8];
    { const f32x4 b0 = *(const LAS f32x4*)gb, b1 = *(const LAS f32x4*)(gb + 4); x[0] = b0[0]; x[1] = b0[1]; x[2] = b0[2]; x[3] = b0[3]; x[4] = b1[0]; x[5] = b1[1]; x[6] = b1[2]; x[7] = b1[3]; }
#pragma unroll
    for (int r4 = 0; r4 < 4; ++r4) { const f32x4 av = ag[r4];
#pragma unroll
        for (int rr = 0; rr < 4; ++rr) { const f32x4 w0 = *(const LAS f32x4*)(gw + (4 * r4 + rr) * 32), w1 = *(const LAS f32x4*)(gw + (4 * r4 + rr) * 32 + 4);
            x[0] += av[rr] * w0[0]; x[1] += av[rr] * w0[1]; x[2] += av[rr] * w0[2]; x[3] += av[rr] * w0[3]; x[4] += av[rr] * w1[0]; x[5] += av[rr] * w1[1]; x[6] += av[rr] * w1[2]; x[7] += av[rr] * w1[3]; } }
#pragma unroll
    for (int j = 0; j < 8; ++j) x[j] = (fminf(x[j], 0.f) - __logf(1.f + __expf(-fabsf(x[j])))) * (1.f / 16.f);
#pragma unroll
    for (int dl = 1; dl < 16; dl <<= 1) { const int src = dir == 0 ? F.lane - dl : F.lane + dl; const bool ok = dir == 0 ? (tau >= dl) : (tau + dl <= 15);
#pragma unroll
        for (int j = 0; j < 8; ++j) { const float y = __shfl(x[j], src); x[j] += ok ? y : 0.f; } }
    float tot[8];
#pragma unroll
    for (int j = 0; j < 8; ++j) { tot[j] = __shfl(x[j], (lane_o & 48) + (dir == 0 ? 15 : 0)); ltot[j] += tot[j]; }
    const u32x4 kv = in.kv;
    const float kf[8] = {bflo(kv.x), bfhi(kv.x), bflo(kv.y), bfhi(kv.y), bflo(kv.z), bfhi(kv.z), bflo(kv.w), bfhi(kv.w)};
    float kt[8], kh[8];
#pragma unroll
    for (int j = 0; j < 8; ++j) { kt[j] = kf[j] * __expf(-x[j]); kh[j] = kf[j] * __expf(tot[j] - x[j]); }
    { u32x4 w; w.x = pk2(kt[0], kt[1]); w.y = pk2(kt[2], kt[3]); w.z = pk2(kt[4], kt[5]); w.w = pk2(kt[6], kt[7]); *(LAS u32x4*)(wl + GL_KT + (tau * 40 + dq * 8) * 2) = w; }
#pragma unroll
    for (int j = 0; j < 8; ++j) *(LAS unsigned short*)(wl + GL_KHT + ((dq * 8 + j) * 24 + tau) * 2) = (unsigned short)f2bf(kh[j]);
    if (NEEDQ) { const u32x4 qv = in.qv; const float sc = 0.17677669529663687f;
        const float qf[8] = {bflo(qv.x), bfhi(qv.x), bflo(qv.y), bfhi(qv.y), bflo(qv.z), bfhi(qv.z), bflo(qv.w), bfhi(qv.w)}; float qt[8];
#pragma unroll
        for (int j = 0; j < 8; ++j) qt[j] = qf[j] * sc * __expf(x[j]);
        u32x4 w; w.x = pk2(qt[0], qt[1]); w.y = pk2(qt[2], qt[3]); w.z = pk2(qt[4], qt[5]); w.w = pk2(qt[6], qt[7]); *(LAS u32x4*)(wl + GL_QT + (tau * 40 + dq * 8) * 2) = w; }
    if (tau == 0) {
#pragma unroll
        for (int j = 0; j < 8; ++j) ((LAS float*)(wl + GL_G))[dq * 8 + j] = __expf(tot[j]); }
    { const u32x4 v0 = in.v0, v1 = in.v1;
      const unsigned vw[8] = {v0.x, v0.y, v0.z, v0.w, v1.x, v1.y, v1.z, v1.w};
#pragma unroll
      for (int j = 0; j < 8; ++j) { *(LAS unsigned short*)(wl + GL_VT + ((dq * 16 + 2 * j) * 24 + tau) * 2) = (unsigned short)(vw[j] & 0xffffu); *(LAS unsigned short*)(wl + GL_VT + ((dq * 16 + 2 * j + 1) * 24 + tau) * 2) = (unsigned short)(vw[j] >> 16); } }
}
__device__ __forceinline__ void gla_state_update(Frame& F, LAS unsigned char* wl, f32x4 (&Sr)[2][4]) {
    int lane_o = F.lane; asm volatile("" : "+v"(lane_o));
    const int r16 = lane_o & 15, kg = lane_o >> 4; const bf16x8 zf = {0, 0, 0, 0, 0, 0, 0, 0};
    bf16x8 vb[4];
#pragma unroll
    for (int nb = 0; nb < 4; ++nb) { vb[nb] = *(const LAS bf16x8*)(wl + GL_VT + ((16 * nb + r16) * 24 + 8 * (kg & 1)) * 2); if (kg >= 2) vb[nb] = zf; }
#pragma unroll
    for (int db = 0; db < 2; ++db) { const f32x4 gv = *(const LAS f32x4*)(wl + GL_G + (16 * db + 4 * kg) * 4);
        bf16x8 ka = *(const LAS bf16x8*)(wl + GL_KHT + ((16 * db + r16) * 24 + 8 * (kg & 1)) * 2); if (kg >= 2) ka = zf;
#pragma unroll
        for (int nb = 0; nb < 4; ++nb) Sr[db][nb] = MFMA16(ka, vb[nb], Sr[db][nb] * gv); }
}
constexpr int GGRP = 6, NGRP = NCH / GGRP;
constexpr size_t WS_GGS = WS_GSS, WS_GGA = WS_GSS + 8 * MiB;
__device__ __forceinline__ void gla_pass_a(KP Pk, Frame& F, int l, int it, LAS unsigned char* wl) {
    unsigned char* ws = F.ws;
    const int seq = it / NGRP, g = it % NGRP, dir = seq & 1, h = (seq >> 1) & 7, b = seq >> 4, r16 = F.lane & 15, kg = F.lane >> 4;
    gla_load_gates(Pk, F, l, h, dir, wl);
    f32x4 Sr[2][4];
#pragma unroll
    for (int db = 0; db < 2; ++db)
#pragma unroll
        for (int nb = 0; nb < 4; ++nb) Sr[db][nb] = (f32x4){0.f, 0.f, 0.f, 0.f};
    float ltot[8] = {0.f, 0.f, 0.f, 0.f, 0.f, 0.f, 0.f, 0.f};
    GlaIn nin;
    { const int c0 = g * GGRP; gla_sub_load<false>(F, b, h, dir, (dir == 0 ? 64 * c0 : gla_kidx(1, 64 * c0) - 63) + 16 * (dir == 0 ? 0 : 3), nin); }
#pragma unroll 1
    for (int cg = 0; cg <= GGRP; ++cg) {
        const int c = g * GGRP + cg;
        float* sl = cg < GGRP ? (float*)(ws + WS_GSL) + ((size_t)seq * NCH + c) * 2048 : (float*)(ws + WS_GGS) + ((size_t)seq * NGRP + g) * 2048;
        float* al = cg < GGRP ? (float*)(ws + WS_GAE) + ((size_t)seq * NCH + c) * 32 : (float*)(ws + WS_GGA) + ((size_t)seq * NGRP + g) * 32;
#pragma unroll
        for (int db = 0; db < 2; ++db)
#pragma unroll
            for (int nb = 0; nb < 4; ++nb)
#pragma unroll
                for (int i = 0; i < 4; ++i) sl[(16 * db + 4 * kg + i) * 64 + 16 * nb + r16] = Sr[db][nb][i];
        if ((F.lane & 15) == 0) {
#pragma unroll
            for (int j = 0; j < 8; ++j) al[kg * 8 + j] = __expf(ltot[j]); }
        if (cg == GGRP) break;
#pragma unroll 1
        for (int st = 0; st < 4; ++st) {
            const GlaIn cur = nin;
            { const int q2 = cg * 4 + st + 1, c2 = g * GGRP + (q2 >> 2), st2 = q2 & 3, sb2 = dir == 0 ? st2 : 3 - st2;
              if (q2 < 4 * GGRP) gla_sub_load<false>(F, b, h, dir, (dir == 0 ? 64 * c2 : gla_kidx(1, 64 * c2) - 63) + 16 * sb2, nin); }
            gla_sub_prep<false>(F, dir, cur, wl, ltot);
            gla_state_update(F, wl, Sr); }
    }
}
__device__ __forceinline__ void gla_pass_b(KP Pk, Frame& F, int l, int b, int h, int c, LAS unsigned char* wl) {
    unsigned char* ws = F.ws;
    const int r16 = F.lane & 15, kg = F.lane >> 4, seq = (b * 8 + h) * 2; const bf16x8 zf = {0, 0, 0, 0, 0, 0, 0, 0};
    const bf16_t* U = (const bf16_t*)(ws + WS_U); unsigned char* MIX = ws + WS_H;
    u32x2 of[4][4];
#pragma unroll 1
    for (int dir = 0; dir < 2; ++dir) {
        gla_load_gates(Pk, F, l, h, dir, wl);
        const int cc = dir == 0 ? c : (c < 4 ? 3 - c : 39 - c);
        f32x4 Sr[2][4];
#pragma unroll
        for (int db = 0; db < 2; ++db)
#pragma unroll
            for (int nb = 0; nb < 4; ++nb) Sr[db][nb] = (f32x4){0.f, 0.f, 0.f, 0.f};
        { const int gsel = cc / GGRP;
#pragma unroll 1
          for (int gp = 0; gp <= gsel; ++gp) {
            const bool fin = gp == gsel;
            const float* sp = fin ? (const float*)(ws + WS_GSL) + ((size_t)(seq + dir) * NCH + cc) * 2048 : (const float*)(ws + WS_GGS) + ((size_t)(seq + dir) * NGRP + gp) * 2048;
            const float* apx = fin ? (const float*)(ws + WS_GAE) + ((size_t)(seq + dir) * NCH + cc) * 32 : (const float*)(ws + WS_GGA) + ((size_t)(seq + dir) * NGRP + gp) * 32;
#pragma unroll
            for (int db = 0; db < 2; ++db) { const f32x4 av = *(const f32x4*)(apx + 16 * db + 4 * kg);
#pragma unroll
                for (int nb = 0; nb < 4; ++nb)
#pragma unroll
                    for (int i = 0; i < 4; ++i) Sr[db][nb][i] = av[i] * Sr[db][nb][i] + sp[(16 * db + 4 * kg + i) * 64 + 16 * nb + r16]; } } }
        float ltot[8] = {0.f, 0.f, 0.f, 0.f, 0.f, 0.f, 0.f, 0.f};
#pragma unroll 1
        for (int st = 0; st < 4; ++st) { const int sb = dir == 0 ? st : 3 - st;
            int lane_o = F.lane; asm volatile("" : "+v"(lane_o)); const int r16 = lane_o & 15, kg = lane_o >> 4;
#pragma unroll
            for (int db = 0; db < 2; ++db)
#pragma unroll
                for (int nb = 0; nb < 4; ++nb) { u32x2 w; w.x = pk2(Sr[db][nb][0], Sr[db][nb][1]); w.y = pk2(Sr[db][nb][2], Sr[db][nb][3]); *(LAS u32x2*)(wl + GL_ST + ((16 * nb + r16) * 40 + 16 * db + 4 * kg) * 2) = w; }
            { GlaIn in; gla_sub_load<true>(F, b, h, dir, 64 * c + 16 * sb, in); gla_sub_prep<true>(F, dir, in, wl, ltot); }
            const bf16x8 bq = *(const LAS bf16x8*)(wl + GL_QT + (r16 * 40 + 8 * kg) * 2);
            { const bf16x8 ka = *(const LAS bf16x8*)(wl + GL_KT + (r16 * 40 + 8 * kg) * 2);
              f32x4 p = MFMA16(ka, bq, ((f32x4){0.f, 0.f, 0.f, 0.f}));
#pragma unroll
              for (int i = 0; i < 4; ++i) { const int sidx = 4 * kg + i; const bool keep = dir == 0 ? (sidx <= r16) : (sidx >= r16); p[i] = keep ? p[i] : 0.f; }
              u32x2 w; w.x = pk2(p[0], p[1]); w.y = pk2(p[2], p[3]); *(LAS u32x2*)(wl + GL_PT + (r16 * 24 + 4 * kg) * 2) = w; }
            bf16x8 pb = *(const LAS bf16x8*)(wl + GL_PT + (r16 * 24 + 8 * (kg & 1)) * 2); if (kg >= 2) pb = zf;
            f32x4 o[4];
#pragma unroll
            for (int nb = 0; nb < 4; ++nb) { const bf16x8 sa = *(const LAS bf16x8*)(wl + GL_ST + ((16 * nb + r16) * 40 + 8 * kg) * 2);
                bf16x8 va = *(const LAS bf16x8*)(wl + GL_VT + ((16 * nb + r16) * 24 + 8 * (kg & 1)) * 2); if (kg >= 2) va = zf;
                o[nb] = MFMA16(sa, bq, ((f32x4){0.f, 0.f, 0.f, 0.f})); o[nb] = MFMA16(va, pb, o[nb]); }
            if (dir == 0) { u32x2 t[4];
#pragma unroll
                for (int nb = 0; nb < 4; ++nb) { t[nb].x = pk2(o[nb][0], o[nb][1]); t[nb].y = pk2(o[nb][2], o[nb][3]); }
#define OF_PUT(k) { _Pragma("unroll") for (int nb = 0; nb < 4; ++nb) of[k][nb] = t[nb]; }
                if (sb == 0) OF_PUT(0) else if (sb == 1) OF_PUT(1) else if (sb == 2) OF_PUT(2) else OF_PUT(3)
#undef OF_PUT
            }
            else { float ss = 0.f; u32x2 t[4];
#define OF_GET(k) { _Pragma("unroll") for (int nb = 0; nb < 4; ++nb) t[nb] = of[k][nb]; }
                if (sb == 0) OF_GET(0) else if (sb == 1) OF_GET(1) else if (sb == 2) OF_GET(2) else OF_GET(3)
#undef OF_GET
#pragma unroll
                for (int nb = 0; nb < 4; ++nb) { o[nb][0] += bflo(t[nb].x); o[nb][1] += bfhi(t[nb].x); o[nb][2] += bflo(t[nb].y); o[nb][3] += bfhi(t[nb].y); ss += (o[nb][0] * o[nb][0] + o[nb][1] * o[nb][1]) + (o[nb][2] * o[nb][2] + o[nb][3] * o[nb][3]); }
                ss += __shfl_xor(ss, 16); ss += __shfl_xor(ss, 32);
                const float rstd = rsqrtf(ss * (1.f / 64.f) + NORM_EPS); const int row = keyrow(b, 64 * c + 16 * sb + r16);
#pragma unroll
                for (int nb = 0; nb < 4; ++nb) { const int dv0 = 16 * nb + 4 * kg; const u32x2 gg = *(const u32x2*)(U + (size_t)row * NU + UC_GG + h * 64 + dv0); const f32x4 nw = *(const f32x4*)(Pk->in[I_GNW] + l * 64 + dv0);
                    const float y0 = o[nb][0] * rstd * nw[0] * silu_f(bflo(gg.x)), y1 = o[nb][1] * rstd * nw[1] * silu_f(bfhi(gg.x)), y2 = o[nb][2] * rstd * nw[2] * silu_f(bflo(gg.y)), y3 = o[nb][3] * rstd * nw[3] * silu_f(bfhi(gg.y));
                    if (WOUT_F8) *(unsigned*)(MIX + ((size_t)row * D + h * 64 + dv0)) = pk4_f8(y0, y1, y2, y3);
                    else { u32x2 w; w.x = pk2(y0, y1); w.y = pk2(y2, y3); *(u32x2*)(MIX + ((size_t)row * D + h * 64 + dv0) * 2) = w; } } }
            if (st < 3) gla_state_update(F, wl, Sr);
        }
    }
}
__device__ __forceinline__ void prep_qk_row(KP Pk, Frame& F, int l, int row) {
    unsigned char* ws = F.ws;
    bf16_t* U = (bf16_t*)(ws + WS_U) + (size_t)row * NU;
    const bool lat = row < TL; const int t = row & (SEQ - 1), f = F.lane & 15;
    float cs = 1.f, sn = 0.f;
    if (lat) { const float* rp = (const float*)(ws + WS_ROPE) + (size_t)t * 64 + (F.lane < 32 ? 0 : 32); cs = rp[f]; sn = rp[16 + f]; if (!(F.lane & 16)) sn = -sn; }
    const float wsq = Pk->in[I_SQN][l * 64 + F.lane], wsk = Pk->in[I_SKN][l * 64 + F.lane], wdq = Pk->in[I_DQN][l * 64 + F.lane], wdk = Pk->in[I_DKN][l * 64 + F.lane];
    const float qs = 0.125f * LOG2E;
    float xs[26];
#pragma unroll
    for (int v = 0; v < 26; ++v) { const int c0 = v < 8 ? UC_SQ + 64 * v : v < 10 ? UC_SK + 64 * (v - 8) : v < 18 ? UC_DQ + 64 * (v - 10) : UC_DK + 64 * (v - 18); xs[v] = bf2f(U[c0 + F.lane]); }
#pragma unroll
    for (int v = 0; v < 26; ++v) {
        int c0; float w;
        if (v < 8) { c0 = UC_SQ + 64 * v; w = wsq * qs; } else if (v < 10) { c0 = UC_SK + 64 * (v - 8); w = wsk; } else if (v < 18) { c0 = UC_DQ + 64 * (v - 10); w = wdq * qs; } else { c0 = UC_DK + 64 * (v - 18); w = wdk; }
        const float x = xs[v];
        const float y = x * rsqrtf(wave_sum(x * x) * (1.f / 64.f) + NORM_EPS) * w;
        const float yp = __shfl_xor(y, 16);
        U[c0 + F.lane] = (bf16_t)f2bf(y * cs + yp * sn);
    }
}
template <bool PERMK, int NCOLS, class SRC>
__device__ __forceinline__ void tile_transpose(LAS unsigned char* wl, int lane, bf16_t* dst, size_t dst_stride, const SRC& src) {
    LAS unsigned* tl = (LAS unsigned*)wl;
    constexpr int ncols = NCOLS, cpr = NCOLS / 8;
    LDS_WAIT(); asm volatile("" ::: "memory");
#pragma unroll 1
    for (int k0 = 0; k0 < cpr; k0 += 4) { u32x4 v[4];
#pragma unroll
      for (int k = 0; k < 4; ++k) { const int id = lane + 64 * (k0 + k); v[k] = src(id / cpr, id % cpr); }
#pragma unroll
      for (int k = 0; k < 4; ++k) { const int id = lane + 64 * (k0 + k); LAS unsigned* p = tl + (id / cpr) * 65 + (id % cpr) * 4; p[0] = v[k].x; p[1] = v[k].y; p[2] = v[k].z; p[3] = v[k].w; } }
    LDS_WAIT(); asm volatile("" ::: "memory");
    const LAS unsigned short* ts = (const LAS unsigned short*)wl;
    const int cc = lane & 7;
    for (int dv = lane >> 3; dv < ncols; dv += 8) {
        unsigned short e[8];
#pragma unroll
        for (int i = 0; i < 8; ++i) { const int p = 8 * cc + i, srow = PERMK ? ((p & ~15) + perm16(p & 15)) : p; e[i] = ts[srow * 130 + dv]; }
        u32x4 o; o.x = e[0] | ((unsigned)e[1] << 16); o.y = e[2] | ((unsigned)e[3] << 16); o.z = e[4] | ((unsigned)e[5] << 16); o.w = e[6] | ((unsigned)e[7] << 16);
        *(u32x4*)(dst + (size_t)dv * dst_stride + 8 * cc) = o; }
}
__device__ __forceinline__ void ph_prep(KP Pk, Frame& F, int l, int rep) {
    unsigned char* ws = F.ws;
    const int gw = F.vcu * NWAVES + F.wave, NGW = F.G * NWAVES;
    LAS unsigned char* wl = F.lds + F.wave * WAVE_LDS;
    const bf16_t* U = (const bf16_t*)(ws + WS_U);
    const int n_gla = 128 * NGRP, n_hy = NB * (l == 0 ? 36 : 32) * 12, n_vd = NB * 4 * 36, n_vs = NB * 2 * 36, n_rows = rep ? 0 : TT / 4;
    if (gw < n_gla) { gla_pass_a(Pk, F, l, gw, wl); }
    const int total = n_hy + n_vd + n_vs + n_rows, nrest = NGW - n_gla;
    for (int it0 = gw - n_gla; it0 < total && gw >= n_gla; it0 += nrest) {
        int it = it0;
        if (it < n_hy) {
            const int ntile = l == 0 ? 36 : 32, b = it / (ntile * 12), r = it % (ntile * 12), tile = r / 12, cb = r % 12, c0 = cb * 128;
            const bool lat = tile < 32; const int p0 = lat ? 64 * tile : 64 * (tile - 32), Ls = lat ? SEQ : LC, rbase = lat ? b * SEQ : TL + b * LC;
            const float* cw = Pk->in[I_HCW] + (size_t)l * 3 * 1536 + c0 + (F.lane & 15) * 8; const float* cbias = Pk->in[I_HCB] + (size_t)l * 1536 + c0 + (F.lane & 15) * 8;
            float w0[8], w1[8], w2[8], wb[8];
#pragma unroll
            for (int k = 0; k < 8; ++k) { w0[k] = cw[k]; w1[k] = cw[1536 + k]; w2[k] = cw[3072 + k]; wb[k] = cbias[k]; }
            auto src = [&](int i, int ch) -> u32x4 { const int p = p0 + i; const bf16_t* up = U + (size_t)(rbase + p) * NU + UC_HY + c0 + ch * 8;
                const u32x4 m = *(const u32x4*)up; u32x4 a = {0u, 0u, 0u, 0u}, c = {0u, 0u, 0u, 0u};
                if (p > 0) a = *(const u32x4*)(up - NU); if (p + 1 < Ls) c = *(const u32x4*)(up + NU);
                const unsigned av[4] = {a.x, a.y, a.z, a.w}, mv[4] = {m.x, m.y, m.z, m.w}, cv[4] = {c.x, c.y, c.z, c.w}; unsigned o[4];
#pragma unroll
                for (int q = 0; q < 4; ++q) { const int k = 2 * q;
                    const float z0 = bflo(av[q]) * w0[k] + bflo(mv[q]) * w1[k] + bflo(cv[q]) * w2[k] + wb[k];
                    const float z1 = bfhi(av[q]) * w0[k + 1] + bfhi(mv[q]) * w1[k + 1] + bfhi(cv[q]) * w2[k + 1] + wb[k + 1];
                    o[q] = pk2(z0, z1); }
                return (u32x4){o[0], o[1], o[2], o[3]}; };
            tile_transpose<false, 128>(wl, F.lane, (bf16_t*)(ws + WS_ZT) + ((size_t)b * 1536 + c0) * KEYS + (lat ? p0 : SEQ + p0), KEYS, src);
            continue; } it -= n_hy;
        if (it < n_vd) {
            const int b = it / 144, r = it % 144, h = r / 36, tile = r % 36;
            auto src = [&](int i, int ch) -> u32x4 { return *(const u32x4*)(U + (size_t)keyrow(b, 64 * tile + i) * NU + UC_DV + h * 128 + ch * 8); };
            tile_transpose<true, 128>(wl, F.lane, (bf16_t*)(ws + WS_VTD) + ((size_t)(b * 4 + h) * 128) * KEYS + 64 * tile, KEYS, src);
            continue; } it -= n_vd;
        if (it < n_vs) {
            const int b = it / 72, r = it % 72, h = r / 36, tile = r % 36;
            auto src = [&](int i, int ch) -> u32x4 { return *(const u32x4*)(U + (size_t)keyrow(b, 64 * tile + i) * NU + UC_SV + h * 64 + ch * 8); };
            tile_transpose<true, 64>(wl, F.lane, (bf16_t*)(ws + WS_VTS) + ((size_t)(b * 2 + h) * 64) * KEYS + 64 * tile, KEYS, src);
            continue; } it -= n_vs;
        for (int q = 0; q < 4; ++q) prep_qk_row(Pk, F, l, it * 4 + q);
    }
}
__device__ __forceinline__ void ph_gla_scan(Frame& F) {
    unsigned char* ws = F.ws;
    const int gw = F.vcu * NWAVES + F.wave, NGW = F.G * NWAVES;
    for (int it = gw; it < 128 * 32; it += NGW) { const int seq = it >> 5, d = it & 31;
        const float* sl = (const float*)(ws + WS_GSL) + (size_t)seq * NCH * 2048 + d * 64 + F.lane; float* ss = (float*)(ws + WS_GSS) + (size_t)seq * NCH * 2048 + d * 64 + F.lane;
        const float* ae = (const float*)(ws + WS_GAE) + (size_t)seq * NCH * 32 + d;
        float x[NCH], a[NCH];
#pragma unroll
        for (int c = 0; c < NCH; ++c) { x[c] = sl[(size_t)c * 2048]; a[c] = ae[c * 32]; }
        float S = 0.f;
#pragma unroll
        for (int c = 0; c < NCH; ++c) { ss[(size_t)c * 2048] = S; S = a[c] * S + x[c]; }
    }
}

__device__ __forceinline__ int crow(int r, int hi) { return (r & 3) + 8 * (r >> 2) + 4 * hi; }
template <int KW, int DV, bool MASK>
__device__ __forceinline__ void attn_core(Frame& F, const bf16_t* U, int b, int kcol0, const bf16_t* VT, int nctx, int nloc, int loc0,
                                          const bf16x8 (&q)[4], int koff, int qpos0, float sh2, f32x16 (&O)[DV / 32], float& lsum) {
    constexpr int KRB = KW * 2, KB = 64 * KRB, VB = DV * 128, SLOT = KB + VB, NKC = KB / 8192, NVC = VB / 8192, NDMA = NKC + NVC;
    const int r32 = F.lane & 31, hi = F.lane >> 5, nt = nctx + nloc;
#define ATT_DMA(ti) do { const int _k0 = (ti) < nctx ? 64 * (ti) : loc0 + 64 * ((ti) - nctx); LAS unsigned char* _sl = F.lds + ((ti) & 3) * SLOT; \
        _Pragma("unroll") for (int _j = 0; _j < NKC; ++_j) { const int _ch = F.wave + 8 * _j; int _row, _c; \
            if (KW == 128) { _row = 4 * _ch + (F.lane >> 4); _c = (F.lane & 15) ^ (_row & 15); } else { _row = 8 * _ch + (F.lane >> 3); _c = (F.lane & 7) ^ ((_row >> 1) & 7); } \
            __builtin_amdgcn_global_load_lds((const unsigned*)(U + (size_t)keyrow(b, _k0 + _row) * NU + kcol0 + _c * 8), (LAS unsigned*)(_sl + _ch * 1024), 16, 0, 0); } \
        _Pragma("unroll") for (int _j = 0; _j < NVC; ++_j) { const int _ch = F.wave + 8 * _j, _row = 8 * _ch + (F.lane >> 3), _c = (F.lane & 7) ^ ((_row >> 1) & 7); \
            __builtin_amdgcn_global_load_lds((const unsigned*)(VT + (size_t)_row * KEYS + _k0 + _c * 8), (LAS unsigned*)(_sl + KB + _ch * 1024), 16, 0, 0); } } while (0)
    f32x16 s0, s1; bf16x8 pa[4];
#define DSR(dst, addr, off) asm volatile("ds_read_b128 %0, %1 offset:%2" : "=v"(dst) : "v"(addr), "n"(off))
#define LWAIT4(f) asm volatile("s_waitcnt lgkmcnt(0)" : "+v"(f[0]), "+v"(f[1]), "+v"(f[2]), "+v"(f[3]))
    unsigned kad[4], vad[4];
#pragma unroll
    for (int i = 0; i < 4; ++i) { const int c = 2 * i + hi;
        kad[i] = (unsigned)(uintptr_t)F.lds + (KW == 128 ? r32 * 256 + ((((koff >> 3) + c) ^ (r32 & 15)) << 4) : r32 * 128 + ((c ^ ((r32 >> 1) & 7)) << 4));
        vad[i] = (unsigned)(uintptr_t)F.lds + KB + r32 * 128 + ((c ^ ((r32 >> 1) & 7)) << 4); }
    __syncthreads();
    ATT_DMA(0);
    if (nt > 1) ATT_DMA(1);
    if (nt > 2) ATT_DMA(2);
    if (nt > 2) asm volatile("s_waitcnt vmcnt(%0)" :: "n"(NDMA) : "memory"); else asm volatile("s_waitcnt vmcnt(0)" ::: "memory");
    __syncthreads();
#define EXP1(ti, r) do { s0[r] = __builtin_amdgcn_exp2f(s0[r]); s1[r] = __builtin_amdgcn_exp2f(s1[r]); \
        if (MASK && (ti) >= nctx) { const int k0 = loc0 - LC + 64 * ((ti) - nctx) + crow(r, hi), k1 = k0 + 32, d0 = qpos0 + r32 - k0, d1 = d0 - 32; \
            if (k0 < 0 || k0 >= SEQ || d0 > 128 || d0 < -128) s0[r] = 0.f; if (k1 < 0 || k1 >= SEQ || d1 > 128 || d1 < -128) s1[r] = 0.f; } } while (0)
#define RD_K(f, h) do { DSR(f[0], ka[2 * (h)], 0); DSR(f[1], ka[2 * (h)], 32 * KRB); DSR(f[2], ka[2 * (h) + 1], 0); DSR(f[3], ka[2 * (h) + 1], 32 * KRB); } while (0)
#define RD_V(f, nb) do { DSR(f[0], va[0], (nb) * 4096); DSR(f[1], va[1], (nb) * 4096); DSR(f[2], va[2], (nb) * 4096); DSR(f[3], va[3], (nb) * 4096); } while (0)
#define SB() __builtin_amdgcn_sched_barrier(0)
#define PKW(S, B) pg8::cvt_pk_bf16(S[B], S[(B) + 1])
#define PV1(f, nb, kk, ti, R0, NE) do { O[nb] = MFMA32(pa[kk], f[kk], O[nb]); if (more) { _Pragma("unroll") for (int _r = 0; _r < (NE); ++_r) EXP1(ti, (R0) + _r); } SB(); } while (0)
    {
        bf16x8 fa[4], fb[4]; unsigned ka[4];
#pragma unroll
        for (int i = 0; i < 4; ++i) ka[i] = kad[i];
        RD_K(fa, 0); RD_K(fb, 1);
#pragma unroll
        for (int r = 0; r < 16; ++r) { s0[r] = -sh2; s1[r] = -sh2; }
        LWAIT4(fa); LWAIT4(fb);
        s0 = MFMA32(fa[0], q[0], s0); s1 = MFMA32(fa[1], q[0], s1); s0 = MFMA32(fa[2], q[1], s0); s1 = MFMA32(fa[3], q[1], s1);
        s0 = MFMA32(fb[0], q[2], s0); s1 = MFMA32(fb[1], q[2], s1); s0 = MFMA32(fb[2], q[3], s0); s1 = MFMA32(fb[3], q[3], s1);
#pragma unroll
        for (int r = 0; r < 16; ++r) EXP1(0, r);
    }
#define ATT_STEP(MORE) { \
        constexpr bool more = (MORE); \
        if (t + 3 < nt) ATT_DMA(t + 3); \
        unsigned ka[4], va[4]; \
        { int lo_ = F.lane; asm volatile("" : "+v"(lo_)); const int rr = lo_ & 31, hh = lo_ >> 5; \
        _Pragma("unroll") \
          for (int i = 0; i < 4; ++i) { const int c = 2 * i + hh; \
            ka[i] = (unsigned)(uintptr_t)F.lds + ((t + 1) & 3) * SLOT + (KW == 128 ? rr * 256 + ((((koff >> 3) + c) ^ (rr & 15)) << 4) : rr * 128 + ((c ^ ((rr >> 1) & 7)) << 4)); \
            va[i] = (unsigned)(uintptr_t)F.lds + (t & 3) * SLOT + KB + rr * 128 + ((c ^ ((rr >> 1) & 7)) << 4); } } \
        bf16x8 fa[4], fb[4]; \
        if (more) { RD_K(fa, 0); RD_K(fb, 1); } else { RD_V(fa, 0); } \
        SB(); \
 \
        { float ps = 0.f; \
        _Pragma("unroll") \
          for (int r = 0; r < 16; ++r) ps += s0[r] + s1[r]; \
          lsum += ps; \
          u32x4 w; \
          w.x = PKW(s0, 0); w.y = PKW(s0, 2); w.z = PKW(s0, 4); w.w = PKW(s0, 6); pa[0] = __builtin_bit_cast(bf16x8, w); \
          w.x = PKW(s0, 8); w.y = PKW(s0, 10); w.z = PKW(s0, 12); w.w = PKW(s0, 14); pa[1] = __builtin_bit_cast(bf16x8, w); \
          w.x = PKW(s1, 0); w.y = PKW(s1, 2); w.z = PKW(s1, 4); w.w = PKW(s1, 6); pa[2] = __builtin_bit_cast(bf16x8, w); \
          w.x = PKW(s1, 8); w.y = PKW(s1, 10); w.z = PKW(s1, 12); w.w = PKW(s1, 14); pa[3] = __builtin_bit_cast(bf16x8, w); } \
        if (more) { \
        _Pragma("unroll") \
            for (int r = 0; r < 16; ++r) { s0[r] = -sh2; s1[r] = -sh2; } \
        } \
        SB(); \
        if (more) { \
            LWAIT4(fa); LWAIT4(fb); \
            s0 = MFMA32(fa[0], q[0], s0); s1 = MFMA32(fa[1], q[0], s1); s0 = MFMA32(fa[2], q[1], s0); s1 = MFMA32(fa[3], q[1], s1); \
            SB(); RD_V(fa, 0); SB(); \
            s0 = MFMA32(fb[0], q[2], s0); s1 = MFMA32(fb[1], q[2], s1); s0 = MFMA32(fb[2], q[3], s0); s1 = MFMA32(fb[3], q[3], s1); \
            SB(); \
        } \
        LWAIT4(fa); RD_V(fb, 1); SB(); \
        if (DV == 128) { \
            PV1(fa, 0, 0, t + 1, 0, 1); PV1(fa, 0, 1, t + 1, 1, 1); PV1(fa, 0, 2, t + 1, 2, 1); PV1(fa, 0, 3, t + 1, 3, 1); \
            LWAIT4(fb); RD_V(fa, 2); SB(); \
            PV1(fb, 1, 0, t + 1, 4, 1); PV1(fb, 1, 1, t + 1, 5, 1); PV1(fb, 1, 2, t + 1, 6, 1); PV1(fb, 1, 3, t + 1, 7, 1); \
            LWAIT4(fa); RD_V(fb, 3); SB(); \
            PV1(fa, 2, 0, t + 1, 8, 1); PV1(fa, 2, 1, t + 1, 9, 1); PV1(fa, 2, 2, t + 1, 10, 1); PV1(fa, 2, 3, t + 1, 11, 1); \
            LWAIT4(fb); SB(); \
            PV1(fb, 3, 0, t + 1, 12, 1); PV1(fb, 3, 1, t + 1, 13, 1); PV1(fb, 3, 2, t + 1, 14, 1); PV1(fb, 3, 3, t + 1, 15, 1); \
        } else { \
            PV1(fa, 0, 0, t + 1, 0, 2); PV1(fa, 0, 1, t + 1, 2, 2); PV1(fa, 0, 2, t + 1, 4, 2); PV1(fa, 0, 3, t + 1, 6, 2); \
            LWAIT4(fb); SB(); \
            PV1(fb, 1, 0, t + 1, 8, 2); PV1(fb, 1, 1, t + 1, 10, 2); PV1(fb, 1, 2, t + 1, 12, 2); PV1(fb, 1, 3, t + 1, 14, 2); \
        } \
        if (t + 3 < nt) asm volatile("s_waitcnt vmcnt(%0)" :: "n"(NDMA) : "memory"); else asm volatile("s_waitcnt vmcnt(0)" ::: "memory"); \
        __syncthreads(); \
    }
    int t = 0;
#pragma unroll 1
    for (; t + 1 < nt; ++t) ATT_STEP(true)
    ATT_STEP(false)
#undef ATT_STEP
#undef EXP1
#undef SB
#undef PKW
#undef PV1
#undef RD_K
#undef RD_V
#undef DSR
#undef LWAIT4
#undef ATT_DMA
}
__device__ __forceinline__ float score_bound(const float* wq, const float* wk, int lane) {
    float a = fabsf(wq[lane]), c = fabsf(wk[lane]);
#pragma unroll
    for (int o = 1; o < 64; o <<= 1) { a = fmaxf(a, __shfl_xor(a, o)); c = fmaxf(c, __shfl_xor(c, o)); }
    return 64.f * a * c * 0.125f * LOG2E;
}
__device__ __forceinline__ void diff_unit(KP Pk, Frame& F, int l, int b, int h, int qrow0, int nkt) {
    unsigned char* ws = F.ws;
    const bf16_t* U = (const bf16_t*)(ws + WS_U);
    const int m = F.wave & 1, rb = F.wave >> 1;
    const float sh2 = score_bound(Pk->in[I_DQN] + l * 64, Pk->in[I_DKN] + l * 64, F.lane);
    bf16x8 q[4];
    { const bf16_t* qp = U + (size_t)(qrow0 + 32 * rb + (F.lane & 31)) * NU + UC_DQ + h * 128 + m * 64 + 8 * (F.lane >> 5);
#pragma unroll
      for (int ks = 0; ks < 4; ++ks) q[ks] = *(const bf16x8*)(qp + 16 * ks); }
    f32x16 O[4];
#pragma unroll
    for (int nb = 0; nb < 4; ++nb) O[nb] = (f32x16){};
    float lsum = 0.f;
    attn_core<128, 128, false>(F, U, b, UC_DK + h * 128, (const bf16_t*)(ws + WS_VTD) + ((size_t)(b * 4 + h) * 128) * KEYS, nkt, 0, 0, q, 64 * m, 0, sh2, O, lsum);
    int ln_; asm volatile("v_mbcnt_lo_u32_b32 %0, -1, 0\n\tv_mbcnt_hi_u32_b32 %0, -1, %0" : "=v"(ln_));
    const int r32 = ln_ & 31, hi = ln_ >> 5;
    { int lo_ = l; asm volatile("" : "+s"(lo_)); l = lo_; Pk = kp_opaque(Pk); }
    lsum += __shfl_xor(lsum, 32);
    const float rl = 1.f / lsum;
    LAS float* ex = (LAS float*)F.lds + rb * 4096;
    float rlr[16];
#pragma unroll
    for (int r = 0; r < 16; ++r) rlr[r] = __shfl(rl, crow(r, hi));
    if (m == 1) {
#pragma unroll
        for (int nb = 0; nb < 4; ++nb)
#pragma unroll
            for (int r = 0; r < 16; ++r) ex[crow(r, hi) * 128 + nb * 32 + r32] = O[nb][r] * rlr[r];
    }
    __syncthreads();
    if (m == 0) {
        const float* dl = Pk->in[I_DLAM] + l * 256; const float lam_init = __builtin_bit_cast(float, __builtin_amdgcn_readfirstlane(__builtin_bit_cast(int, l == 0 ? 0.2f : (0.8f - 0.6f * 0.74081822068f))));
        const float lam = expf(wave_sum(dl[ln_] * dl[64 + ln_])) - expf(wave_sum(dl[128 + ln_] * dl[192 + ln_])) + lam_init;
        float ssq[16];
#pragma unroll
        for (int r = 0; r < 16; ++r) { float a = 0.f;
#pragma unroll
            for (int nb = 0; nb < 4; ++nb) { const float v = O[nb][r] * rlr[r] - lam * ex[crow(r, hi) * 128 + nb * 32 + r32]; O[nb][r] = v; a += v * v; }
            a += __shfl_xor(a, 1); a += __shfl_xor(a, 2); a += __shfl_xor(a, 4); a += __shfl_xor(a, 8); a += __shfl_xor(a, 16);
            ssq[r] = rsqrtf(a * (1.f / 128.f) + NORM_EPS) * (1.f - lam_init); }
        unsigned char* mix = ws + WS_H + ((size_t)(qrow0 + 32 * rb) * D + 1536 + h * 128) * MIXB;
#pragma unroll
        for (int nb = 0; nb < 4; ++nb) { const float w = Pk->in[I_DSUB][l * 128 + nb * 32 + r32];
#pragma unroll
            for (int r = 0; r < 16; ++r) { const float y = O[nb][r] * ssq[r] * w; const size_t e = (size_t)crow(r, hi) * D + nb * 32 + r32; if (WOUT_F8) mix[e] = f8_1(y); else ((bf16_t*)mix)[e] = (bf16_t)f2bf(y); } }
    }
}
__device__ __forceinline__ void swa_unit(KP Pk, Frame& F, int l, int b, int kvh, int qrow0, int qpos0, bool latent) {
    unsigned char* ws = F.ws;
    const bf16_t* U = (const bf16_t*)(ws + WS_U);
    const int hq = kvh * 4 + (F.wave & 3), rb = F.wave >> 2;
    const float sh2 = score_bound(Pk->in[I_SQN] + l * 64, Pk->in[I_SKN] + l * 64, F.lane);
    bf16x8 q[4];
    { const bf16_t* qp = U + (size_t)(qrow0 + 32 * rb + (F.lane & 31)) * NU + UC_SQ + hq * 64 + 8 * (F.lane >> 5);
#pragma unroll
      for (int ks = 0; ks < 4; ++ks) q[ks] = *(const bf16x8*)(qp + 16 * ks); }
    f32x16 O[2]; O[0] = (f32x16){}; O[1] = (f32x16){};
    float lsum = 0.f;
    int nloc = 0, loc0 = 0;
    if (latent) { int kp0 = qpos0 - 128, kp1 = qpos0 + 64 + 128; if (kp0 < 0) kp0 = 0; if (kp1 > SEQ) kp1 = SEQ; nloc = (kp1 - kp0) / 64; loc0 = LC + kp0; }
    const bf16_t* VT = (const bf16_t*)(ws + WS_VTS) + ((size_t)(b * 2 + kvh) * 64) * KEYS;
    attn_core<64, 64, true>(F, U, b, UC_SK + kvh * 64, VT, 4, nloc, loc0, q, 0, qpos0 + 32 * rb, sh2, O, lsum);
    int ln_; asm volatile("v_mbcnt_lo_u32_b32 %0, -1, 0\n\tv_mbcnt_hi_u32_b32 %0, -1, %0" : "=v"(ln_));
    const int r32 = ln_ & 31, hi = ln_ >> 5;
    { int lo_ = l; asm volatile("" : "+s"(lo_)); l = lo_; Pk = kp_opaque(Pk); }
    lsum += __shfl_xor(lsum, 32);
    const float rl = 1.f / (lsum + exp2f(Pk->in[I_SINK][l * 8 + hq] * LOG2E - sh2));
    unsigned char* mix = ws + WS_H + ((size_t)(qrow0 + 32 * rb) * D + 512 + hq * 64) * MIXB;
#pragma unroll
    for (int r = 0; r < 16; ++r) { const float rr = __shfl(rl, crow(r, hi));
#pragma unroll
        for (int nb = 0; nb < 2; ++nb) { const float y = O[nb][r] * rr; const size_t e = (size_t)crow(r, hi) * D + nb * 32 + r32; if (WOUT_F8) mix[e] = f8_1(y); else ((bf16_t*)mix)[e] = (bf16_t)f2bf(y); } }
}
constexpr int HY_PAD = 224, YSTR = 2504, HY_YB = 8 * YSTR * 2, HY_CST = 8224, HY_COP = 2 * HY_YB;
__device__ __forceinline__ void hyena_unit(KP Pk, Frame& F, int l, int cg) {
    unsigned char* ws = F.ws;
    const int r32 = F.lane & 31, hi = F.lane >> 5, bb = r32 >> 2, ib = r32 & 3;
    const bf16_t* ZT = (const bf16_t*)(ws + WS_ZT); bf16_t* OT = (bf16_t*)(ws + WS_OT);
    LAS unsigned char* cop = F.lds + HY_COP;
    const int nseq = l == 0 ? 2 : 1;
#pragma unroll 1
    for (int cs = 0; cs < 4 * nseq; ++cs) {
        const int ci = cs >> (nseq - 1), st = cs & (nseq - 1), ch = cg * 4 + ci, L = st == 0 ? SEQ : LC, nblk = L / 32, pos0 = st == 0 ? 0 : SEQ;
        __syncthreads();
        for (int id = F.tid; id < 8 * (L / 8 + 56); id += NTHR) { const int b = id / (L / 8 + 56), c = id % (L / 8 + 56);
            if (c < L / 8) *(LAS u32x4*)(F.lds + (b * YSTR + HY_PAD + 8 * c) * 2) = *(const u32x4*)(ZT + ((size_t)b * 1536 + 1024 + ch) * KEYS + pos0 + 8 * c);
            else { const int pc = c - L / 8, off = pc < 28 ? 8 * pc : HY_PAD + L + 8 * (pc - 28); const u32x4 z = {0u, 0u, 0u, 0u};
                *(LAS u32x4*)(F.lds + (b * YSTR + off) * 2) = z; *(LAS u32x4*)(F.lds + HY_YB + (b * YSTR + off) * 2) = z; } }
#pragma unroll 1
        for (int o = 0; o < 2; ++o) {
            const bf16_t* R = (const bf16_t*)(ws + WS_HYF) + ((size_t)l * 1024 + o * 512 + ch) * 4608 + (st == 0 ? 0 : 4096);
            for (int xc = F.tid; xc < 2 * L / 8; xc += NTHR) { const u32x4 lo = *(const u32x4*)(R + 8 * xc); u32x4 hh = {0u, 0u, 0u, 0u}; if (8 * xc + 8 < 2 * L) hh = *(const u32x4*)(R + 8 * xc + 8);
                const unsigned w[9] = {lo.x, lo.y, lo.z, lo.w, hh.x, hh.y, hh.z, hh.w, 0u};
#pragma unroll
                for (int r = 0; r < 8; ++r) { u32x4 ov; unsigned t[4];
#pragma unroll
                    for (int k = 0; k < 4; ++k) t[k] = (r & 1) ? ((w[(r >> 1) + k] >> 16) | (w[(r >> 1) + k + 1] << 16)) : w[(r >> 1) + k];
                    ov.x = t[0]; ov.y = t[1]; ov.z = t[2]; ov.w = t[3]; *(LAS u32x4*)(cop + r * HY_CST + 16 * xc) = ov; } }
            __syncthreads();
            const LAS unsigned char* Yin = F.lds + (o == 0 ? 0 : HY_YB); LAS unsigned char* Yout = F.lds + (o == 0 ? HY_YB : 0);
            const float bias = Pk->in[I_HBIAS][(l * 2 + o) * 512 + ch];
            if (2 * F.wave < nblk / 4) {
                const int g0 = 2 * F.wave, dlo = 4 * g0 - nblk + 1, dhi = min(4 * g0 + 7, nblk - 1), nsteps = dhi - dlo + 1;
                const LAS unsigned char* ap = cop + ((-r32) & 7) * HY_CST + ((L - 32 * dlo - r32 + 8 * hi) & ~7) * 2;
                const LAS unsigned char* bp = Yin + (bb * YSTR + HY_PAD + 32 * (4 * g0 + ib - dlo) + 8 * hi) * 2;
                f32x16 acc0 = {}, acc1 = {};
#define HDSR(dst, addr, off) asm volatile("ds_read_b128 %0, %1 offset:%2" : "=v"(dst) : "v"(addr), "n"(off))
#define HWAIT(a, b, c, d) asm volatile("s_waitcnt lgkmcnt(0)" : "+v"(a), "+v"(b), "+v"(c), "+v"(d))
                bf16x8 R[6][2], A2[2][2];
                const unsigned apa = (unsigned)(uintptr_t)ap, bpa = (unsigned)(uintptr_t)bp;
                HDSR(R[2][0], bpa, 256); HDSR(R[2][1], bpa, 256 + 32); HDSR(R[3][0], bpa, 192); HDSR(R[3][1], bpa, 192 + 32);
                HDSR(R[4][0], bpa, 128); HDSR(R[4][1], bpa, 128 + 32); HDSR(R[5][0], bpa, 64); HDSR(R[5][1], bpa, 64 + 32);
                HDSR(R[0][0], bpa, 0); HDSR(R[0][1], bpa, 32); HDSR(A2[0][0], apa, 0); HDSR(A2[0][1], apa, 32);
                HWAIT(R[2][0], R[2][1], R[3][0], R[3][1]); HWAIT(R[4][0], R[4][1], R[5][0], R[5][1]); HWAIT(R[0][0], R[0][1], A2[0][0], A2[0][1]);
#pragma unroll 1
                for (int s0 = 0; s0 < nsteps; s0 += 6) {
                    const unsigned an = apa - (unsigned)(s0 + 6) * 64u, bn = bpa - (unsigned)(s0 + 6) * 64u;
#pragma unroll
                    for (int j = 0; j < 6; ++j) if (s0 + j < nsteps) {
                        if (s0 + j + 1 < nsteps) { HDSR(A2[(j + 1) & 1][0], an, (5 - j) * 64); HDSR(A2[(j + 1) & 1][1], an, (5 - j) * 64 + 32);
                            HDSR(R[(j + 1) % 6][0], bn, (5 - j) * 64); HDSR(R[(j + 1) % 6][1], bn, (5 - j) * 64 + 32); }
                        acc1 = MFMA32(A2[j & 1][0], R[(j + 2) % 6][0], acc1); acc0 = MFMA32(A2[j & 1][0], R[j][0], acc0);
                        acc1 = MFMA32(A2[j & 1][1], R[(j + 2) % 6][1], acc1); acc0 = MFMA32(A2[j & 1][1], R[j][1], acc0);
                        HWAIT(A2[(j + 1) & 1][0], A2[(j + 1) & 1][1], R[(j + 1) % 6][0], R[(j + 1) % 6][1]); }
                }
#undef HDSR
#undef HWAIT
#pragma unroll
                for (int gg = 0; gg < 2; ++gg) { const f32x16& acc = gg == 0 ? acc0 : acc1;
                    const int t0 = 32 * (4 * (g0 + gg) + ib) + 4 * hi;
                    const bf16_t* gp = ZT + ((size_t)bb * 1536 + o * 512 + ch) * KEYS + pos0 + t0;
#pragma unroll
                    for (int q = 0; q < 4; ++q) { const u32x2 yo = *(const LAS u32x2*)(Yin + (bb * YSTR + HY_PAD + t0 + 8 * q) * 2); const u32x2 gt = *(const u32x2*)(gp + 8 * q);
                        const float v0 = bflo(gt.x) * (acc[4 * q + 0] + bflo(yo.x) * bias), v1 = bfhi(gt.x) * (acc[4 * q + 1] + bfhi(yo.x) * bias);
                        const float v2 = bflo(gt.y) * (acc[4 * q + 2] + bflo(yo.y) * bias), v3 = bfhi(gt.y) * (acc[4 * q + 3] + bfhi(yo.y) * bias);
                        u32x2 ov; ov.x = pk2(v0, v1); ov.y = pk2(v2, v3);
                        if (o == 0) *(LAS u32x2*)(Yout + (bb * YSTR + HY_PAD + t0 + 8 * q) * 2) = ov;
                        else *(u32x2*)(OT + ((size_t)bb * 512 + ch) * KEYS + pos0 + t0 + 8 * q) = ov; } }
            }
            __syncthreads();
        }
    }
    VM_WAIT(); __syncthreads();
    const int npos = l == 0 ? KEYS : SEQ;
    for (int id = F.tid; id < 8 * npos; id += NTHR) { const int b = id / npos, pos = id % npos, row = pos < SEQ ? b * SEQ + pos : TL + b * LC + (pos - SEQ);
        const bf16_t* op = OT + ((size_t)b * 512 + cg * 4) * KEYS + pos;
        if (WOUT_F8) *(unsigned*)(ws + WS_H + (size_t)row * D + 1024 + cg * 4) = pk4_f8(bf2f(op[0]), bf2f(op[KEYS]), bf2f(op[2 * KEYS]), bf2f(op[3 * KEYS]));
        else { u32x2 ov; ov.x = (unsigned)op[0] | ((unsigned)op[KEYS] << 16); ov.y = (unsigned)op[2 * KEYS] | ((unsigned)op[3 * KEYS] << 16); *(u32x2*)((bf16_t*)(ws + WS_H) + (size_t)row * D + 1024 + cg * 4) = ov; } }
}
#ifndef MX_MASK
#define MX_MASK 15
#endif
#ifndef PROBE_MX
#define PROBE_MX 0
#endif
__device__ __forceinline__ void ph_mixers(KP Pk, Frame& F, int l, int qid) {
    const int n_diff = 512, n_hy = 128, n_dctx = l == 0 ? 64 : 0, n_swa = 512, n_sctx = l == 0 ? 64 : 0, gpb = l == 0 ? 5 : 4, n_gla = 64 * gpb;
    constexpr int R0 = 1 + ((PROBE_MX >> 0) & 1), R1 = 1 + ((PROBE_MX >> 1) & 1), R2 = 1 + ((PROBE_MX >> 2) & 1), R3 = 1 + ((PROBE_MX >> 3) & 1);
    const int n_mix = R0 * (n_diff + n_dctx) + R1 * n_hy + R2 * (n_swa + n_sctx) + R3 * n_gla + (l == 0 ? 96 + 128 : 0);
    const int n_titems = 16 * TI_GU + 16 * TI_DN + TI_WOUT + (l == 0 ? TI_WIN + TI_WA : 0), NTU = (n_titems + 127) / 128;
    const int total = n_mix + NTU, tplaced = min(NTU, total / 4);
    for (;;) {
        const int s_ = wg_grab(F, qid); if (s_ >= total) break;
        int u = s_ - min(NTU, s_ / 4), tu = -1;
        if ((s_ & 3) == 3 && (s_ >> 2) < NTU) tu = s_ >> 2; else if (u >= n_mix) tu = tplaced + (u - n_mix);
        if (tu >= 0) { LAS float* scr = (LAS float*)(F.lds + F.wave * 8704);
            for (int j = 0; j < 16; ++j) { int x = tu * 128 + F.wave * 16 + j; if (x >= n_titems) break;
                int it;
                if (x < 16 * TI_GU) it = 2 * TI_L + l * 16 * TI_GU + x;
                else if ((x -= 16 * TI_GU) < 16 * TI_DN) it = 2 * TI_L + 32 * TI_GU + l * 16 * TI_DN + x;
                else if ((x -= 16 * TI_DN) < TI_WOUT) it = l * TI_L + TI_WIN + TI_WA + x;
                else it = TI_L + (x - TI_WOUT);
                p0_item(Pk, F, it, scr); }
            goto mx_next; }
        if (l == 0) { if (u < 96) { ada_unit(Pk, F, 96 + u); goto mx_next; } u -= 96;
                      if (u < 128) { ph_hyena_filters(Pk, F, 128 + u); goto mx_next; } u -= 128; }
        if (u < R1 * n_hy) { u %= n_hy; if (MX_MASK & 2) hyena_unit(Pk, F, l, u); goto mx_next; } u -= R1 * n_hy;
        if (u < R0 * n_diff) { u %= n_diff; const int b = u >> 6, h = (u >> 4) & 3, qb = u & 15; if (MX_MASK & 1) diff_unit(Pk, F, l, b, h, b * SEQ + 128 * qb, 36); goto mx_next; } u -= R0 * n_diff;
        if (u < R0 * n_dctx) { u %= n_dctx; const int b = u >> 3, h = (u >> 1) & 3, qb = u & 1; if (MX_MASK & 1) diff_unit(Pk, F, l, b, h, TL + b * LC + 128 * qb, 4); goto mx_next; } u -= R0 * n_dctx;
        if (u < R2 * n_swa) { u %= n_swa; const int b = u >> 6, kvh = (u >> 5) & 1, qb = u & 31; if (MX_MASK & 4) swa_unit(Pk, F, l, b, kvh, b * SEQ + 64 * qb, 64 * qb, true); goto mx_next; } u -= R2 * n_swa;
        if (u < R2 * n_sctx) { u %= n_sctx; const int b = u >> 3, kvh = (u >> 2) & 1, qb = u & 3; if (MX_MASK & 4) swa_unit(Pk, F, l, b, kvh, TL + b * LC + 64 * qb, 64 * qb, false); goto mx_next; } u -= R2 * n_sctx;
        { u %= n_gla; const int bh = u / gpb, grp = u % gpb, c = (l == 0 ? 0 : 4) + grp * 8 + F.wave;
          __syncthreads();
          if ((MX_MASK & 8) && c < NCH) gla_pass_b(Pk, F, l, bh >> 3, bh & 7, c, F.lds + F.wave * WAVE_LDS);
        }
mx_next: ;
    }
}

constexpr int N_PHASES = 22;
#ifndef PH_MASK
#define PH_MASK 0xfffu
#endif
__global__ void __launch_bounds__(NTHR, 2) fwd_kernel(Params Parg) {
    extern __shared__ __attribute__((aligned(16))) unsigned char lds_raw[];
    const KP P0 = (KP)__builtin_amdgcn_kernarg_segment_ptr();
    Frame F;
    F.lds = (LAS unsigned char*)lds_raw; F.MISC = (volatile LAS unsigned*)(F.lds + LDS_MISC);
    const int wave_s = __builtin_amdgcn_readfirstlane((int)threadIdx.x >> 6);
#define TID_REFRESH() do { int t_; asm volatile("v_mbcnt_lo_u32_b32 %0, -1, 0\n\tv_mbcnt_hi_u32_b32 %0, -1, %0" : "=v"(t_)); F.lane = t_; F.wave = wave_s; F.tid = wave_s * 64 + t_; } while (0)
    TID_REFRESH();
    F.G = gridDim.x; { const int bx = blockIdx.x; F.vcu = (F.G % 8 == 0) ? (bx % 8) * (F.G / 8) + bx / 8 : bx; }
    F.ws = P0->ws; F.ctl = (unsigned*)(P0->ws + WS_CTL);
    for (int u = F.tid; u < 128; u += NTHR) F.MISC[u] = 0u;
    __syncthreads();
    const int lo = P0->ph_lo, hi = P0->ph_hi;
    const bool multi = hi - lo > 1;
    XcdBarrier bar; bar.bar = F.ctl + CW_BAR; bar.x = 0; bar.st = nullptr;
    if (multi) bar = xcd_barrier_post(F.ctl + CW_BAR, F.MISC + 8, F.tid);
#define INR(k) (lo <= (k) && (k) < hi)
#define IN(k, kind) (((PH_MASK >> (kind)) & 1u) && INR(k))
#define SEAM(k) do { if (INR(k) && INR((k) + 1)) { bar.bar = (unsigned*)(kp_opaque(P0)->ws + WS_CTL) + CW_BAR; TID_REFRESH(); xcd_barrier(bar, F.tid); } } while (0)
#ifndef PROBE_MASK
#define PROBE_MASK 0u
#endif
#define REP(kind) for (int rep_ = 0; rep_ < (((PROBE_MASK >> (kind)) & 1u) ? 2 : 1); ++rep_)
#define REP_SYNC(kind) do { if (((PROBE_MASK >> (kind)) & 1u) && rep_ == 0 && multi) { TID_REFRESH(); xcd_barrier(bar, F.tid); } } while (0)
#define PHASE_BEGIN() const KP Pk = kp_opaque(P0); unsigned char* ws = Pk->ws; F.ws = ws; F.ctl = (unsigned*)(ws + WS_CTL); \
    TID_REFRESH()
    if (IN(0, 0)) REP(0) { PHASE_BEGIN(); p0_prologue(Pk, F, rep_); REP_SYNC(0); } SEAM(0);
#pragma unroll 1
    for (int l = 0; l < DEPTH; ++l) {
        const int pb = 1 + 10 * l;
        if (IN(pb + 0, 1)) REP(1) { if (rep_ && l) break; PHASE_BEGIN(); if (l == 0) { for (int u = blockIdx.x; u < 128; u += F.G) ph_hyena_filters(Pk, F, u); } ph_norm1(Pk, F, l); REP_SYNC(1); } SEAM(pb + 0);
        if (IN(pb + 1, 2)) REP(2) { PHASE_BEGIN();
            pg8::Gemm g{(const bf16_t*)(ws + WS_H), (const bf16_t*)(ws + WS_WIN + (size_t)l * NU * D * 2), D, nullptr};
            pg8::RectOrder S; if (l == 0) S.init(72, 21, F.G, (int)blockIdx.x, 0, 0, 0ull); else S.init(64, 21, F.G, (int)blockIdx.x, 64, 64, 0x1413121108030201ull);
            pg8::EpiU E{(bf16_t*)(ws + WS_U), WIN_F8_L(l) ? 1.f / 32.f : 1.f};
            if (WIN_F8_L(l)) pg8::gemm_phase<pg8::EpiU, pg8::RectOrder, false, true>(F.lds, g, S, E, F.tid);
            else pg8::gemm_phase<pg8::EpiU, pg8::RectOrder, false, false>(F.lds, g, S, E, F.tid);
            if (WIN_F8_L(l)) ph_gate_cols8(F, l); else ph_gate_cols(F, l); REP_SYNC(2);
        } SEAM(pb + 1);
        if (IN(pb + 2, 3)) REP(3) { PHASE_BEGIN(); ph_prep(Pk, F, l, rep_); REP_SYNC(3); } SEAM(pb + 2);
        if (IN(pb + 4, 5)) REP(5) { PHASE_BEGIN(); ph_mixers(Pk, F, l, 1 + l + 2 * rep_); REP_SYNC(5); } SEAM(pb + 4);
        if (IN(pb + 5, 6)) REP(6) { if (rep_ && l) break; PHASE_BEGIN();
            pg8::Gemm g{(const bf16_t*)(ws + WS_H), (const bf16_t*)(ws + WS_WOUT + (size_t)l * D * D * MIXB), D, nullptr};
            pg8::RectOrder S; S.init(l == 0 ? 72 : 64, 8, F.G, (int)blockIdx.x, 0, 0, 0ull);
            pg8::EpiWout E{Pk->in[I_X], Pk->in[I_CTX], l == 0 ? (const bf16_t*)nullptr : (const bf16_t*)(ws + WS_X), (bf16_t*)(ws + WS_X), (const float*)(ws + WS_MOD) + (size_t)l * 9 * 12288};
            pg8::gemm_phase<pg8::EpiWout, pg8::RectOrder, false, WOUT_F8>(F.lds, g, S, E, F.tid); REP_SYNC(6);
        } SEAM(pb + 5);
        if (IN(pb + 6, 7)) REP(7) { PHASE_BEGIN(); ph_norm2_router(Pk, F, l, rep_); REP_SYNC(7); } SEAM(pb + 6);
        if (IN(pb + 7, 8)) { PHASE_BEGIN(); ph_slots(Pk, F, l); } SEAM(pb + 7);
        if (IN(pb + 8, 9)) REP(9) { PHASE_BEGIN();
            const int np = moe_table(F, l);
            pg8::Gemm g{(const bf16_t*)(ws + WS_H), (const bf16_t*)(ws + WS_WGU + (size_t)l * NE * 2048 * D), D, (const int*)(ws + WS_RT + RT_ROWTOK)};
            pg8::MoeOrder S{np, F.G, F.vcu, (const volatile LAS unsigned char*)(F.MISC + 64)};
            pg8::EpiMoe1 E{ws + WS_U};
            pg8::gemm_phase<pg8::EpiMoe1, pg8::MoeOrder, true, true>(F.lds, g, S, E, F.tid); REP_SYNC(9);
        } SEAM(pb + 8);
        if (IN(pb + 9, 10)) REP(10) { PHASE_BEGIN();
            const int np = moe_table(F, l);
            pg8::Gemm g{(const bf16_t*)(ws + WS_U), (const bf16_t*)(ws + WS_WD + (size_t)l * NE * D * DE), DE, nullptr};
            pg8::MoeOrder S{np, F.G, F.vcu, (const volatile LAS unsigned char*)(F.MISC + 64)};
            pg8::EpiMoe2 E{ws + WS_Y2, (const int*)(ws + WS_RT + RT_ROWTOK), (const float*)(ws + WS_RT + RT_ROWW)};
            pg8::gemm_phase<pg8::EpiMoe2, pg8::MoeOrder, false, true>(F.lds, g, S, E, F.tid); REP_SYNC(10);
        } SEAM(pb + 9);
    }
    if (IN(21, 11)) REP(11) { PHASE_BEGIN(); ph_final(Pk, F); REP_SYNC(11); }
#undef IN
#undef INR
#undef SEAM
#undef PHASE_BEGIN
#undef REP
#undef REP_SYNC
#undef TID_REFRESH
}

#ifndef MK_PER_PHASE
#define MK_PER_PHASE 0
#endif
extern "C" void kernel_launch(void* const* d_in, const int* in_sizes, int n_in, void* d_out, int out_size, void* d_ws, size_t ws_size, hipStream_t stream) {
    static int grid = 0;
    if (grid == 0) {
        if (n_in != 34 || in_sizes[0] != TL * D || out_size != TL * D || ws_size < WS_END) { fprintf(stderr, "kernel_launch: unexpected shapes (n_in %d, in0 %d, out %d, ws %zu < %zu)\n", n_in, n_in > 0 ? in_sizes[0] : -1, out_size, ws_size, (size_t)WS_END); grid = -1; return; }
        int dev = 0, cus = 0, per_cu = 0;
        if (hipGetDevice(&dev) != hipSuccess || hipDeviceGetAttribute(&cus, hipDeviceAttributeMultiprocessorCount, dev) != hipSuccess) { grid = -1; return; }
        if (hipFuncSetAttribute((const void*)fwd_kernel, hipFuncAttributeMaxDynamicSharedMemorySize, LDS_BYTES) != hipSuccess) { fprintf(stderr, "kernel_launch: hipFuncSetAttribute failed\n"); grid = -1; return; }
        if (hipOccupancyMaxActiveBlocksPerMultiprocessor(&per_cu, (const void*)fwd_kernel, NTHR, LDS_BYTES) != hipSuccess || per_cu < 1) fprintf(stderr, "kernel_launch: occupancy query reports %d\n", per_cu);
        (void)hipGetLastError();
        grid = cus;
    }
    if (grid < 0) return;
    (void)hipMemsetAsync((char*)d_ws + WS_CTL, 0, CTL_BYTES, stream);
    Params p{};
    for (int i = 0; i < 34; ++i) p.in[i] = (const float*)d_in[i];
    p.out = (float*)d_out; p.ws = (unsigned char*)d_ws;
#if MK_PER_PHASE
    for (int k = 0; k < N_PHASES; ++k) { p.ph_lo = k; p.ph_hi = k + 1; hipLaunchKernelGGL(fwd_kernel, dim3(grid), dim3(NTHR), LDS_BYTES, stream, p); }
#else
    p.ph_lo = 0; p.ph_hi = N_PHASES; hipLaunchKernelGGL(fwd_kernel, dim3(grid), dim3(NTHR), LDS_BYTES, stream, p);
#endif
    const hipError_t le = hipPeekAtLastError();
    if (le != hipSuccess) fprintf(stderr, "kernel_launch: launch failed: %s\n", hipGetErrorName(le));
}
```

```cpp
#include <hip/hip_runtime.h>
#include <cstdio>
#include <cstdint>

#define LAS __attribute__((address_space(3)))
#define GAS __attribute__((address_space(1)))
typedef unsigned short bf16_t;
typedef short bf16x8 __attribute__((ext_vector_type(8)));
typedef float f32x2 __attribute__((ext_vector_type(2)));
typedef float f32x4 __attribute__((ext_vector_type(4)));
typedef float f32x16 __attribute__((ext_vector_type(16)));
typedef unsigned u32x2 __attribute__((ext_vector_type(2)));
typedef unsigned u32x4 __attribute__((ext_vector_type(4)));
typedef int i32x4 __attribute__((ext_vector_type(4)));
typedef int i32x8 __attribute__((ext_vector_type(8)));

constexpr int D = 2048, NB = 8, SEQ = 2048, LC = 256, DEPTH = 2;
constexpr int TL = NB * SEQ, TCX = NB * LC, TT = TL + TCX;
constexpr int DIN = 5408, NU = 5376, NE = 16, DE = 1024;
constexpr int KEYS = LC + SEQ;
constexpr int UC_GQ = 0, UC_GK = 256, UC_GV = 512, UC_GG = 1024, UC_SQ = 1536, UC_SK = 2048, UC_SV = 2176, UC_HY = 2304, UC_DQ = 3840, UC_DK = 4352, UC_DV = 4864;
constexpr int MOE_ROWS = 2 * TT + NE * 256;
constexpr int MOE_PANELS = MOE_ROWS / 256;
constexpr int GCH = 64, NCH = KEYS / GCH;
constexpr float NORM_EPS = 1e-6f;
constexpr float LOG2E = 1.4426950408889634f;

constexpr size_t MiB = 1u << 20;
constexpr size_t WS_CTL = 0, CTL_BYTES = 1 * MiB;
constexpr size_t WS_MOD = 1 * MiB;
constexpr size_t WS_ROPE = 2 * MiB;
constexpr size_t WS_HYH2 = 3 * MiB;
constexpr size_t WS_WA = 5 * MiB;
constexpr size_t WS_RT = 6 * MiB;
constexpr size_t WS_AG = 7 * MiB;
constexpr size_t WS_HYF = 10 * MiB;
constexpr size_t WS_WIN = 28 * MiB;
constexpr size_t WS_WOUT = 70 * MiB;
constexpr size_t WS_WGU = 86 * MiB;
constexpr size_t WS_WD = 342 * MiB;
constexpr size_t WS_X = 470 * MiB;
constexpr size_t WS_H = 614 * MiB;
constexpr size_t WS_U = 686 * MiB;
constexpr size_t WS_B = 875 * MiB;
constexpr size_t WS_VTD = WS_B;
constexpr size_t WS_VTS = WS_B + 18 * MiB;
constexpr size_t WS_ZT = WS_B + 23 * MiB;
constexpr size_t WS_OT = WS_B + 77 * MiB;
constexpr size_t WS_GSL = WS_B + 95 * MiB;
constexpr size_t WS_GSS = WS_B + 131 * MiB;
constexpr size_t WS_GAE = WS_B + 167 * MiB;
constexpr size_t WS_Y2 = WS_B;
constexpr size_t WS_HB = 1043 * MiB;
constexpr size_t WS_END = 1115 * MiB;
constexpr int WIN_F8_MASK = 3;
#define WIN_F8_L(l) (((WIN_F8_MASK) >> (l)) & 1)
constexpr bool WOUT_F8 = true;
constexpr int MIXB = WOUT_F8 ? 1 : 2;
constexpr size_t RT_E = 0;
constexpr size_t RT_W = 128 * 1024;
constexpr size_t RT_ROWTOK = 320 * 1024;
constexpr size_t RT_ROWW = 512 * 1024;
constexpr int CW_BAR = 4096;
constexpr int CW_CNT = 16384;
constexpr int CW_CUR = 16384 + 256;
constexpr int CW_Q = 16384 + 1024;

constexpr int LDS_BYTES = 155648;
constexpr int LDS_MISC = LDS_BYTES - 512;
constexpr int NWAVES = 8, NTHR = 512;

__device__ __forceinline__ unsigned f2bf(float f) { unsigned u = __builtin_bit_cast(unsigned, f); return (u + 0x7fffu + ((u >> 16) & 1u)) >> 16; }
#ifndef EMU8
#define EMU8 0
#endif
__device__ __forceinline__ float q8(float f) { unsigned u = __builtin_bit_cast(unsigned, f); u = (u + 0x7ffffu + ((u >> 20) & 1u)) & 0xfff00000u; return __builtin_bit_cast(float, u); }
__device__ __forceinline__ unsigned pk2(float lo, float hi) { return f2bf(lo) | (f2bf(hi) << 16); }
__device__ __forceinline__ unsigned pk2q(float lo, float hi) { return f2bf(q8(lo)) | (f2bf(q8(hi)) << 16); }
__device__ __forceinline__ unsigned pk4_f8(float a, float b, float c, float d) {
    a = fminf(fmaxf(a, -448.f), 448.f); b = fminf(fmaxf(b, -448.f), 448.f); c = fminf(fmaxf(c, -448.f), 448.f); d = fminf(fmaxf(d, -448.f), 448.f);
    int r = 0; r = __builtin_amdgcn_cvt_pk_fp8_f32(a, b, r, false); r = __builtin_amdgcn_cvt_pk_fp8_f32(c, d, r, true); return (unsigned)r; }
__device__ __forceinline__ unsigned char f8_1(float a) { a = fminf(fmaxf(a, -448.f), 448.f); return (unsigned char)(__builtin_amdgcn_cvt_pk_fp8_f32(a, a, 0, false) & 0xff); }
__device__ __forceinline__ float bf2f(unsigned short b) { return __builtin_bit_cast(float, ((unsigned)b) << 16); }
__device__ __forceinline__ float bflo(unsigned w) { return __builtin_bit_cast(float, w << 16); }
__device__ __forceinline__ float bfhi(unsigned w) { return __builtin_bit_cast(float, w & 0xffff0000u); }
__device__ __forceinline__ float wave_sum(float v) {
#pragma unroll
    for (int o = 1; o < 64; o <<= 1) v += __shfl_xor(v, o);
    return v;
}
__device__ __forceinline__ float silu_f(float x) { return x / (1.f + __expf(-x)); }
#define LDS_WAIT() asm volatile("s_waitcnt lgkmcnt(0)" ::: "memory")
#define VM_WAIT() asm volatile("s_waitcnt vmcnt(0)" ::: "memory")

#define XB_TMO      128
#define XB_XCNT(j)  (256  + 64 * (j))
#define XB_XSUB(j)  (1280 + 64 * (j))
#define XB_XGEN(j)  (2304 + 64 * (j))
#define XB_TOP      3328
#define XB_TOPGEN   3392
#define XCD_BAR_WORDS 3456
#define XB_SPIN_CAP (1u << 18)
__device__ __forceinline__ unsigned xb_ld(unsigned* p)              { return __hip_atomic_load(p, __ATOMIC_RELAXED, __HIP_MEMORY_SCOPE_AGENT); }
__device__ __forceinline__ unsigned xb_add(unsigned* p, unsigned v) { return __hip_atomic_fetch_add(p, v, __ATOMIC_RELAXED, __HIP_MEMORY_SCOPE_AGENT); }
__device__ __forceinline__ unsigned xb_xcc_id() { return (unsigned)__builtin_amdgcn_s_getreg((3 << 11) | 20) & 0xFu; }
#define XB_SPIN(cond, bar) do { unsigned _sp = 0; while (cond) { __builtin_amdgcn_s_sleep(1); \
    if ((++_sp & 255u) == 0u) { if (xb_ld(&(bar)[XB_TMO])) break; if (_sp > XB_SPIN_CAP) { atomicAdd(&(bar)[XB_TMO], 1u); break; } } } } while (0)
struct XcdBarrier { unsigned* bar; unsigned x; volatile LAS unsigned* st; };
__device__ __forceinline__ XcdBarrier xcd_barrier_post(unsigned* bar, volatile LAS unsigned* st, int tid) {
    XcdBarrier b; b.bar = bar; b.x = xb_xcc_id(); b.st = st;
    if (tid == 0) (void)xb_add(&bar[XB_XCNT(b.x)], 1u);
    return b;
}
__device__ __forceinline__ void xcd_barrier_complete(unsigned* bar, unsigned x, unsigned& nloc, unsigned& nx) {
    const unsigned G = gridDim.x * gridDim.y * gridDim.z;
    unsigned sum, cnt, mine, sp = 0u;
    for (;;) {
        sum = 0u; cnt = 0u; mine = 0u;
#pragma unroll
        for (unsigned j = 0; j < 16; ++j) { const unsigned c = xb_ld(&bar[XB_XCNT(j)]); sum += c; cnt += (c > 0u) ? 1u : 0u; mine = (j == x) ? c : mine; }
        if (sum == G) break;
        __builtin_amdgcn_s_sleep(1);
        if ((++sp & 255u) == 0u) { if (xb_ld(&bar[XB_TMO])) break; if (sp > XB_SPIN_CAP) { atomicAdd(&bar[XB_TMO], 1u); break; } }
    }
    nloc = mine > 0u ? mine : 1u; nx = cnt > 0u ? cnt : 1u;
}
__device__ __forceinline__ void xcd_barrier(const XcdBarrier& b, int tid) {
    asm volatile("s_waitcnt vmcnt(0)" ::: "memory");
    __syncthreads();
    if (tid == 0) {
        unsigned* bar = b.bar;
        __builtin_amdgcn_s_waitcnt(0);
        unsigned nloc = b.st[0], nx = b.st[1];
        if (nloc == 0u) { xcd_barrier_complete(bar, b.x, nloc, nx); b.st[0] = nloc; b.st[1] = nx; }
        const unsigned old = xb_add(&bar[XB_XSUB(b.x)], 1u);
        const unsigned gen = old / nloc;
        if (old + 1u == (gen + 1u) * nloc) {
            __builtin_amdgcn_fence(__ATOMIC_RELEASE, "agent");
            asm volatile("s_waitcnt vmcnt(0)" ::: "memory");
            const unsigned og = xb_add(&bar[XB_TOP], 1u);
            const unsigned tg = og / nx;
            if (og + 1u == (tg + 1u) * nx) xb_add(&bar[XB_TOPGEN], 1u);
            else XB_SPIN(xb_ld(&bar[XB_TOPGEN]) == tg, bar);
            __builtin_amdgcn_fence(__ATOMIC_ACQUIRE, "agent");
            xb_add(&bar[XB_XGEN(b.x)], 1u);
            asm volatile("s_waitcnt vmcnt(0)" ::: "memory");
        } else {
            XB_SPIN(xb_ld(&bar[XB_XGEN(b.x)]) == gen, bar);
            __builtin_amdgcn_fence(__ATOMIC_ACQUIRE, "agent");
            asm volatile("s_waitcnt vmcnt(0)" ::: "memory");
        }
    }
    __syncthreads();
}

namespace pg8 {
constexpr int BM = 256, BK = 64, HALF = 128, HTB = HALF * BK * 2, STAGE_BYTES = 8 * HTB;
__host__ __device__ __forceinline__ int lds_byte(int r, int c) { const int st = (r >> 4) * 2 + (c >> 5), rr = r & 15, cc = c & 31, ob = rr * 64 + cc * 2; return st * 1024 + (ob ^ (((ob >> 9) & 1) << 5)); }
__host__ __device__ __forceinline__ void stage_rc(int b, int& R, int& C) { const int st = b / 1024, sb = b % 1024, swz = sb ^ (((sb >> 9) & 1) << 5); R = (st >> 1) * 16 + swz / 64; C = (st & 1) * 32 + (swz % 64) / 2; }
__host__ __device__ __forceinline__ int lds_byte8(int r, int cb) { const int st = (r >> 4) * 2 + (cb >> 6), rr = r & 15, ob = rr * 64 + (cb & 63); return st * 1024 + (ob ^ (((ob >> 9) & 1) << 4)); }
__host__ __device__ __forceinline__ void stage_rc8(int b, int& R, int& Cb) { const int st = b / 1024, sb = b % 1024, swz = sb ^ (((sb >> 9) & 1) << 4); R = (st >> 1) * 16 + swz / 64; Cb = (st & 1) * 64 + (swz % 64); }
__host__ __device__ __forceinline__ int perm32(int rho) { const int n = rho >> 4, i = rho & 15; return 8 * (i >> 2) + 4 * n + (i & 3); }
struct Unit { int pm, pn; };
struct Gemm { const bf16_t* A; const bf16_t* Bt; int K; const int* rowtab; };
__device__ __forceinline__ unsigned cvt_pk_bf16(float lo, float hi) { unsigned r; asm volatile("v_cvt_pk_bf16_f32 %0, %1, %2" : "=v"(r) : "v"(lo), "v"(hi)); return r; }

template <class Epi, class Sched, bool GATHER, bool F8 = false>
__device__ __forceinline__ void gemm_phase(LAS unsigned char* lds, const Gemm g, const Sched& S, const Epi& E, const int tid) {
    const int wid = __builtin_amdgcn_readfirstlane(tid >> 6), lane = tid & 63, wr = wid >> 2, wc = wid & 3, fr = lane & 15, fq = lane >> 4;
    const int K = g.K, RB = F8 ? K : 2 * K, nt = RB / 128;
    unsigned voffB[2], voffA[2];
#pragma unroll
    for (int i = 0; i < 2; ++i) { int R, Cb; if constexpr (F8) stage_rc8(tid * 16 + i * 8192, R, Cb); else { int C; stage_rc(tid * 16 + i * 8192, R, C); Cb = 2 * C; }
        const int Rb = Epi::PERM ? ((R & ~31) + perm32(R & 31)) : R;
        voffA[i] = (unsigned)(R * RB + Cb); voffB[i] = (unsigned)(Rb * RB + Cb); }
    const size_t kstep = 128;
    const size_t hstep = (size_t)HALF * RB;
    const size_t tstep = 2 * hstep;
    const unsigned ldsw = (unsigned)wid * 1024u;
    const int aoff = F8 ? lds_byte8(wr * 64 + fr, 32 * fq) : lds_byte(wr * 64 + fr, fq * 8), boff = F8 ? lds_byte8(wc * 32 + fr, 32 * fq) : lds_byte(wc * 32 + fr, fq * 8);
    const int aoff2 = aoff ^ 16, boff2 = boff ^ 16;
#define PG8_SA(b, h) (((b) * 2 + (h)) * HTB)
#define PG8_SB(b, h) ((4 + (b) * 2 + (h)) * HTB)
#define PG8_STAGE(bufoff, gbase, voff) do { _Pragma("unroll") for (int _i = 0; _i < 2; ++_i) \
        __builtin_amdgcn_global_load_lds((const unsigned*)((const char*)(gbase) + (voff)[_i]), (LAS unsigned*)(lds + (bufoff) + ldsw + _i * 8192), 16, 0, 0); } while (0)
#define PG8_LDA(dst, b, h) do { if constexpr (F8) { _Pragma("unroll") for (int m = 0; m < 4; ++m) { const i32x4 _lo = *(const LAS i32x4*)(lds + PG8_SA(b, h) + aoff + m * 2048), _hi = *(const LAS i32x4*)(lds + PG8_SA(b, h) + aoff2 + m * 2048); dst##8[m] = __builtin_shufflevector(_lo, _hi, 0, 1, 2, 3, 4, 5, 6, 7); } } \
        else { _Pragma("unroll") for (int m = 0; m < 4; ++m) _Pragma("unroll") for (int k = 0; k < 2; ++k) dst[m][k] = *(const LAS bf16x8*)(lds + PG8_SA(b, h) + aoff + m * 2048 + k * 1024); } } while (0)
#define PG8_LDB(dst, b, h) do { if constexpr (F8) { _Pragma("unroll") for (int n = 0; n < 2; ++n) { const i32x4 _lo = *(const LAS i32x4*)(lds + PG8_SB(b, h) + boff + n * 2048), _hi = *(const LAS i32x4*)(lds + PG8_SB(b, h) + boff2 + n * 2048); dst##8[n] = __builtin_shufflevector(_lo, _hi, 0, 1, 2, 3, 4, 5, 6, 7); } } \
        else { _Pragma("unroll") for (int n = 0; n < 2; ++n) _Pragma("unroll") for (int k = 0; k < 2; ++k) dst[n][k] = *(const LAS bf16x8*)(lds + PG8_SB(b, h) + boff + n * 2048 + k * 1024); } } while (0)
#define PG8_CAT(x) __builtin_shufflevector(x[0], x[1], 0, 1, 2, 3, 4, 5, 6, 7)
#define PG8_MMA(ai, bj, At, Bt) do { __builtin_amdgcn_s_setprio(1); if constexpr (F8) { _Pragma("unroll") for (int m = 0; m < 4; ++m) _Pragma("unroll") for (int n = 0; n < 2; ++n) \
            asm volatile("v_mfma_scale_f32_16x16x128_f8f6f4 %0, %1, %2, %0, %3, %3 op_sel_hi:[0,0,0]" : "+v"(acc[ai][bj][m][n]) : "v"(Bt##8[n]), "v"(At##8[m]), "v"(f8scale)); } \
        else { _Pragma("unroll") for (int m = 0; m < 4; ++m) _Pragma("unroll") for (int n = 0; n < 2; ++n) _Pragma("unroll") for (int k = 0; k < 2; ++k) \
            acc[ai][bj][m][n] = __builtin_amdgcn_mfma_f32_16x16x32_bf16(Bt[n][k], At[m][k], acc[ai][bj][m][n], 0, 0, 0); } __builtin_amdgcn_s_setprio(0); } while (0)
#define PG8_WAIT_V(n) asm volatile("s_waitcnt vmcnt(" #n ")" ::: "memory")
#define PG8_WAIT_L(n) asm volatile("s_waitcnt lgkmcnt(" #n ")" ::: "memory")
#define PG8_BAR __builtin_amdgcn_s_barrier()
#define PG8_SCHED __builtin_amdgcn_sched_barrier(0)
#define PG8_AOFF(o, u) do { int _t2 = tid; asm volatile("" : "+v"(_t2)); _Pragma("unroll") for (int _i = 0; _i < 2; ++_i) { int _R, _Cb; if constexpr (F8) stage_rc8(_t2 * 16 + _i * 8192, _R, _Cb); else { int _C; stage_rc(_t2 * 16 + _i * 8192, _R, _C); _Cb = 2 * _C; } \
        _Pragma("unroll") for (int _h = 0; _h < 2; ++_h) { int _r = (u).pm * BM + _h * HALF + _R; \
        { const int _t = g.rowtab[_r]; _r = _t < 0 ? 0 : (_t & 0x3fffffff); } o[_h][_i] = (unsigned)(_r * RB + _Cb); } } } while (0)
    Unit cur, nxt; int ui = 0;
    if (!S.next(0, cur)) return;
    f32x4 acc[2][2][4][2];
#pragma unroll
    for (int a = 0; a < 2; ++a)
#pragma unroll
        for (int b = 0; b < 2; ++b)
#pragma unroll
            for (int m = 0; m < 4; ++m)
#pragma unroll
                for (int n = 0; n < 2; ++n) acc[a][b][m][n] = (f32x4){0.f, 0.f, 0.f, 0.f};
    bf16x8 At[4][2], B0[2][2], B1[2][2];
    i32x8 At8[4], B08[2], B18[2];
    int f8scale = 0x7f7f7f7f; asm volatile("" : "+v"(f8scale));
    unsigned oc[2][2], on[2][2];
    const char* gA = (const char*)g.A;
    const char* cA = gA; const char* cB = (const char*)g.Bt + (size_t)cur.pn * tstep;
    if constexpr (GATHER) { PG8_AOFF(oc, cur); } else { cA = gA + (size_t)cur.pm * tstep; }
#define PG8_STA_CUR(buf, kb, h) do { if constexpr (GATHER) { PG8_STAGE(buf, gA + (kb), oc[h]); } else { PG8_STAGE(buf, cA + (kb) + (h) * hstep, voffA); } } while (0)
#define PG8_STA_SEL(buf, kb, h) do { if constexpr (GATHER) { if (last) { PG8_STAGE(buf, gA + (kb), on[h]); } else { PG8_STAGE(buf, gA + (kb), oc[h]); } } else { PG8_STAGE(buf, a2p + (kb) + (h) * hstep, voffA); } } while (0)
    PG8_STAGE(PG8_SB(0, 0), cB, voffB); PG8_STAGE(PG8_SB(0, 1), cB + hstep, voffB); PG8_STA_CUR(PG8_SA(0, 0), 0, 0); PG8_STA_CUR(PG8_SA(0, 1), 0, 1);
    if (wr == 1) PG8_BAR;
    PG8_WAIT_V(2); PG8_BAR;
    PG8_STAGE(PG8_SB(1, 0), cB + kstep, voffB); PG8_STA_CUR(PG8_SA(1, 0), kstep, 0); PG8_STAGE(PG8_SB(1, 1), cB + hstep + kstep, voffB);
    PG8_WAIT_V(6); PG8_BAR;
    for (;;) {
        const bool has_next = S.next(ui + 1, nxt);
        const char* nA = cA;
        if constexpr (!GATHER) { if (has_next) nA = gA + (size_t)nxt.pm * tstep; }
        const char* nB = has_next ? (const char*)g.Bt + (size_t)nxt.pn * tstep : cB;
#pragma unroll 1
        for (int t = 0; t < nt; t += 2) {
            const bool last = (t == nt - 2);
            int to = t; asm volatile("" : "+s"(to));
            const size_t k1 = (size_t)(to + 1) * kstep, k2 = last ? 0 : (size_t)(to + 2) * kstep, k3 = k2 + kstep;
            const char* b2 = last ? nB : cB + (size_t)(to + 2) * kstep; const char* b3 = b2 + kstep;
            const char* a2p = last ? nA : cA;
            if constexpr (GATHER) { if (last) { if (has_next) { PG8_AOFF(on, nxt); } else {
#pragma unroll
                for (int h = 0; h < 2; ++h)
#pragma unroll
                    for (int i = 0; i < 2; ++i) on[h][i] = oc[h][i]; } } }
            PG8_LDB(B0, 0, 0); PG8_LDB(B1, 0, 1); PG8_SCHED; PG8_LDA(At, 0, 0); PG8_STA_CUR(PG8_SA(1, 1), k1, 1);
            PG8_WAIT_V(8); PG8_WAIT_L(0); PG8_BAR; PG8_MMA(0, 0, At, B0); PG8_MMA(0, 1, At, B1); PG8_BAR; PG8_SCHED;
            PG8_LDA(At, 0, 1); PG8_STAGE(PG8_SB(0, 0), b2, voffB); PG8_STAGE(PG8_SB(0, 1), b2 + hstep, voffB); PG8_STA_SEL(PG8_SA(0, 0), k2, 0);
            PG8_WAIT_V(8); PG8_WAIT_L(0); PG8_BAR; PG8_MMA(1, 0, At, B0); PG8_MMA(1, 1, At, B1); PG8_BAR; PG8_SCHED;
            PG8_LDB(B0, 1, 0); PG8_LDB(B1, 1, 1); PG8_SCHED; PG8_LDA(At, 1, 0); PG8_STA_SEL(PG8_SA(0, 1), k2, 1);
            PG8_WAIT_V(8); PG8_WAIT_L(0); PG8_BAR; PG8_MMA(0, 0, At, B0); PG8_MMA(0, 1, At, B1); PG8_BAR; PG8_SCHED;
            PG8_LDA(At, 1, 1); PG8_STAGE(PG8_SB(1, 0), b3, voffB); PG8_STAGE(PG8_SB(1, 1), b3 + hstep, voffB); PG8_STA_SEL(PG8_SA(1, 0), k3, 0);
            PG8_WAIT_V(8); PG8_WAIT_L(0); PG8_BAR; PG8_MMA(1, 0, At, B0); PG8_MMA(1, 1, At, B1); PG8_BAR; PG8_SCHED;
        }
        if (wr == 0) PG8_BAR;
        if constexpr (F8) asm volatile("s_nop 15\n\ts_nop 15" : "+v"(acc[1][1][0][0]), "+v"(acc[1][1][0][1]), "+v"(acc[1][1][1][0]), "+v"(acc[1][1][1][1]), "+v"(acc[1][1][2][0]), "+v"(acc[1][1][2][1]), "+v"(acc[1][1][3][0]), "+v"(acc[1][1][3][1]) :: "memory");
        E(acc, cur, wr, wc, fr, fq);
        if (!has_next) break;
#pragma unroll
        for (int a = 0; a < 2; ++a)
#pragma unroll
            for (int b = 0; b < 2; ++b)
#pragma unroll
                for (int m = 0; m < 4; ++m)
#pragma unroll
                    for (int n = 0; n < 2; ++n) acc[a][b][m][n] = (f32x4){0.f, 0.f, 0.f, 0.f};
        cur = nxt; cB = nB; cA = nA; ++ui;
        if constexpr (GATHER) {
#pragma unroll
            for (int h = 0; h < 2; ++h)
#pragma unroll
                for (int i = 0; i < 2; ++i) oc[h][i] = on[h][i]; }
        if (wr == 1) PG8_BAR;
    }
#undef PG8_STA_CUR
#undef PG8_STA_SEL
    PG8_WAIT_V(0);
    PG8_BAR;
#undef PG8_SA
#undef PG8_SB
#undef PG8_STAGE
#undef PG8_LDA
#undef PG8_LDB
#undef PG8_CAT
#undef PG8_MMA
#undef PG8_WAIT_V
#undef PG8_WAIT_L
#undef PG8_BAR
#undef PG8_SCHED
#undef PG8_AOFF
}
}

struct Params { const float* in[34]; float* out; unsigned char* ws; int ph_lo, ph_hi; };
typedef const __attribute__((address_space(4))) Params* KP;
__device__ __forceinline__ KP kp_opaque(KP p) { asm volatile("" : "+s"(p)); return p; }
enum { I_X = 0, I_C, I_CTX, I_CCTX, I_N1W, I_N2W, I_ADAW, I_ADAB, I_WIN, I_WOUT, I_GGW, I_GGB, I_GNW, I_SQN, I_SKN, I_SINK, I_HCW, I_HCB, I_HW1, I_HB1, I_HW2, I_HB2, I_HW3, I_HFR, I_HBIAS,
       I_DQN, I_DKN, I_DLAM, I_DSUB, I_RW, I_RB, I_EG, I_EU, I_ED };
struct Frame {
    LAS unsigned char* lds; volatile LAS unsigned* MISC; unsigned* ctl;
    int tid, lane, wave, vcu, G;
    unsigned char* ws;
};
__device__ __forceinline__ int modrow_of(int row) { return row < TL ? (row >> 11) : 8; }
__device__ __forceinline__ int keyrow(int b, int kidx) { return kidx < LC ? TL + b * LC + kidx : b * SEQ + (kidx - LC); }
__device__ __forceinline__ int wg_grab(Frame& F, int q) {
    __syncthreads();
    if (F.tid == 0) F.MISC[0] = __hip_atomic_fetch_add(F.ctl + CW_Q + 64 * q, 1u, __ATOMIC_RELAXED, __HIP_MEMORY_SCOPE_AGENT);
    __syncthreads();
    { int t_; asm volatile("v_mbcnt_lo_u32_b32 %0, -1, 0\n\tv_mbcnt_hi_u32_b32 %0, -1, %0" : "=v"(t_)); F.lane = t_; F.tid = F.wave * 64 + t_; }
    return (int)F.MISC[0];
}

namespace pg8 {
constexpr int NXCD = 8, WGM = 8;
struct RectOrder {
    int nM, nN, nwg, G, c, nextra, xpm0; unsigned long long xt;
    __device__ void init(int nM_, int nN_, int G_, int c_, int nextra_, int xpm0_, unsigned long long xt_) { nM = nM_; nN = nN_; nwg = nM * nN; G = G_; c = c_; nextra = nextra_; xpm0 = xpm0_; xt = xt_; }
    __device__ bool next(int i, Unit& u) const {
        const int L = i * G + c; if (L >= nwg + nextra) return false;
        if (L >= nwg) { const int e = L - nwg; u.pm = xpm0 + (e >> 3); u.pn = (int)((xt >> (8 * (e & 7))) & 0xffull); return true; }
        int wgid = L; { const int q = nwg / NXCD, r = nwg % NXCD, xcd = wgid % NXCD, off = wgid / NXCD; wgid = (xcd < r ? xcd * (q + 1) : r * (q + 1) + (xcd - r) * q) + off; }
        const int nig = WGM * nN, gid = wgid / nig, fm = gid * WGM, gsz = (nM - fm) < WGM ? (nM - fm) : WGM;
        u.pm = fm + ((wgid % nig) % gsz); u.pn = (wgid % nig) / gsz; return true;
    }
};
struct MoeOrder {
    int npanels, G, vcu; const volatile LAS unsigned char* pexp;
    __device__ bool next(int i, Unit& u) const {
        const int L = i * G + vcu; if (L >= npanels * 8) return false;
        const int p = L >> 3; u.pm = p; u.pn = (int)pexp[p] * 8 + (L & 7); return true;
    }
};
struct EpiU {
    static constexpr bool PERM = true;
    bf16_t* O; float scale;
    __device__ __forceinline__ void operator()(const f32x4 (&acc)[2][2][4][2], const Unit& u, int wr, int wc, int fr, int fq) const {
        const int row0 = u.pm * BM + wr * 64 + fr, col0 = u.pn * BM + wc * 32 + 8 * fq;
#pragma unroll
        for (int ai = 0; ai < 2; ++ai)
#pragma unroll
            for (int m = 0; m < 4; ++m) { bf16_t* rowp = O + (size_t)(row0 + ai * HALF + m * 16) * NU + col0;
#pragma unroll
                for (int bj = 0; bj < 2; ++bj) { const f32x4 v0 = acc[ai][bj][m][0] * scale, v1 = acc[ai][bj][m][1] * scale;
                    u32x4 w; w.x = cvt_pk_bf16(v0[0], v0[1]); w.y = cvt_pk_bf16(v0[2], v0[3]); w.z = cvt_pk_bf16(v1[0], v1[1]); w.w = cvt_pk_bf16(v1[2], v1[3]);
                    *(u32x4*)(rowp + bj * HALF) = w; } }
    }
};
struct EpiWout {
    static constexpr bool PERM = true;
    const float* res_lat; const float* res_ctx; const bf16_t* resb; bf16_t* X; const float* mod;
    __device__ __forceinline__ void operator()(const f32x4 (&acc)[2][2][4][2], const Unit& u, int wr, int wc, int fr, int fq) const {
        const int row0 = u.pm * BM + wr * 64 + fr, col0 = u.pn * BM + wc * 32 + 8 * fq;
        const float* ga = mod + (size_t)modrow_of(u.pm * BM) * 12288 + 2 * D;
        constexpr float sc = WOUT_F8 ? 1.f / 32.f : 1.f;
        f32x4 gv[2][2];
#pragma unroll
        for (int bj = 0; bj < 2; ++bj)
#pragma unroll
            for (int n = 0; n < 2; ++n) gv[bj][n] = *(const f32x4*)(ga + col0 + bj * HALF + n * 4) * sc;
        if (resb) {
#pragma unroll
            for (int ai = 0; ai < 2; ++ai)
#pragma unroll
                for (int m = 0; m < 4; ++m) { const int row = row0 + ai * HALF + m * 16; const bf16_t* rp = resb + (size_t)row * D + col0; bf16_t* xp = X + (size_t)row * D + col0;
#pragma unroll
                    for (int bj = 0; bj < 2; ++bj) { const u32x4 r = *(const u32x4*)(rp + bj * HALF);
                        const f32x4 v0 = (f32x4){bflo(r.x), bfhi(r.x), bflo(r.y), bfhi(r.y)} + gv[bj][0] * acc[ai][bj][m][0], v1 = (f32x4){bflo(r.z), bfhi(r.z), bflo(r.w), bfhi(r.w)} + gv[bj][1] * acc[ai][bj][m][1];
                        u32x4 o; o.x = cvt_pk_bf16(v0[0], v0[1]); o.y = cvt_pk_bf16(v0[2], v0[3]); o.z = cvt_pk_bf16(v1[0], v1[1]); o.w = cvt_pk_bf16(v1[2], v1[3]);
                        *(u32x4*)(xp + bj * HALF) = o; } }
        } else {
#pragma unroll
            for (int ai = 0; ai < 2; ++ai)
#pragma unroll
                for (int m = 0; m < 4; ++m) { const int row = row0 + ai * HALF + m * 16;
                    const float* rp = (row < TL ? res_lat + (size_t)row * D : res_ctx + (size_t)(row - TL) * D) + col0; bf16_t* xp = X + (size_t)row * D + col0;
#pragma unroll
                    for (int bj = 0; bj < 2; ++bj) { const f32x4 r0 = *(const f32x4*)(rp + bj * HALF), r1 = *(const f32x4*)(rp + bj * HALF + 4);
                        const f32x4 v0 = r0 + gv[bj][0] * acc[ai][bj][m][0], v1 = r1 + gv[bj][1] * acc[ai][bj][m][1];
                        u32x4 o; o.x = cvt_pk_bf16(v0[0], v0[1]); o.y = cvt_pk_bf16(v0[2], v0[3]); o.z = cvt_pk_bf16(v1[0], v1[1]); o.w = cvt_pk_bf16(v1[2], v1[3]);
                        *(u32x4*)(xp + bj * HALF) = o; } }
        }
    }
};
struct EpiMoe1 {
    static constexpr bool PERM = true;
    unsigned char* O;
    __device__ __forceinline__ void operator()(const f32x4 (&acc)[2][2][4][2], const Unit& u, int wr, int wc, int fr, int fq) const {
        const int row0 = u.pm * BM + wr * 64 + fr, col0 = (u.pn & 7) * HALF + wc * 32 + 8 * fq;
#pragma unroll
        for (int ai = 0; ai < 2; ++ai)
#pragma unroll
            for (int m = 0; m < 4; ++m) { unsigned char* rowp = O + (size_t)(row0 + ai * HALF + m * 16) * DE + col0; float h[8];
#pragma unroll
                for (int n = 0; n < 2; ++n)
#pragma unroll
                    for (int j = 0; j < 4; ++j) { const float gt = acc[ai][0][m][n][j] * (1.f / 32.f), up = acc[ai][1][m][n][j] * (1.f / 32.f); h[4 * n + j] = gt * __builtin_amdgcn_rcpf(1.f + __expf(-gt)) * up; }
                u32x2 w; w.x = pk4_f8(h[0], h[1], h[2], h[3]); w.y = pk4_f8(h[4], h[5], h[6], h[7]);
                *(u32x2*)rowp = w; }
    }
};
struct EpiMoe2 {
    static constexpr bool PERM = true;
    unsigned char* Y2; const int* rowtok; const float* roww;
    __device__ __forceinline__ void operator()(const f32x4 (&acc)[2][2][4][2], const Unit& u, int wr, int wc, int fr, int fq) const {
        const int row0 = u.pm * BM + wr * 64 + fr, col0 = (u.pn & 7) * BM + wc * 32 + 8 * fq;
#pragma unroll
        for (int ai = 0; ai < 2; ++ai)
#pragma unroll
            for (int m = 0; m < 4; ++m) { asm volatile("" ::: "memory"); const int row = row0 + ai * HALF + m * 16; const int tk = rowtok[row]; const float w = roww[row];
                if (tk >= 0) { unsigned char* rowp = Y2 + ((size_t)(tk >> 30) * TT + (size_t)(tk & 0x3fffffff)) * D + col0;
#pragma unroll
                    for (int bj = 0; bj < 2; ++bj) { const f32x4 v0 = acc[ai][bj][m][0] * w, v1 = acc[ai][bj][m][1] * w;
                        u32x2 o; o.x = pk4_f8(v0[0], v0[1], v0[2], v0[3]); o.y = pk4_f8(v1[0], v1[1], v1[2], v1[3]);
                        *(u32x2*)(rowp + bj * HALF) = o; } } }
    }
};
}

__device__ __forceinline__ void p0_transpose_item(const float* W, int ldw, int srccol0, int k0, bf16_t* dst, int K, LAS float* scr, int lane, bool q = false) {
    { f32x4 v[8];
#pragma unroll
      for (int i = 0; i < 8; ++i) v[i] = *(const f32x4*)(W + (size_t)(k0 + 8 * i + (lane >> 3)) * ldw + srccol0 + 4 * (lane & 7));
#pragma unroll
      for (int i = 0; i < 8; ++i) { LAS float* p = scr + (8 * i + (lane >> 3)) * 33 + 4 * (lane & 7); p[0] = v[i][0]; p[1] = v[i][1]; p[2] = v[i][2]; p[3] = v[i][3]; } }
    LDS_WAIT(); asm volatile("" ::: "memory");
    const int c = lane & 7;
#pragma unroll
    for (int j = 0; j < 4; ++j) { const int n = (lane >> 3) + 8 * j; const LAS float* s = scr + (8 * c) * 33 + n;
        u32x4 o; if (q) { o.x = pk2q(s[0 * 33], s[1 * 33]); o.y = pk2q(s[2 * 33], s[3 * 33]); o.z = pk2q(s[4 * 33], s[5 * 33]); o.w = pk2q(s[6 * 33], s[7 * 33]); }
        else { o.x = pk2(s[0 * 33], s[1 * 33]); o.y = pk2(s[2 * 33], s[3 * 33]); o.z = pk2(s[4 * 33], s[5 * 33]); o.w = pk2(s[6 * 33], s[7 * 33]); }
        *(u32x4*)(dst + (size_t)n * K + k0 + 8 * c) = o; }
    LDS_WAIT(); asm volatile("" ::: "memory");
}
__device__ __forceinline__ void p0_transpose_item8(const float* W, int ldw, int srccol0, int k0, unsigned char* dst, int K, LAS float* scr, int lane) {
    { f32x4 v[8];
#pragma unroll
      for (int i = 0; i < 8; ++i) v[i] = *(const f32x4*)(W + (size_t)(k0 + 8 * i + (lane >> 3)) * ldw + srccol0 + 4 * (lane & 7));
#pragma unroll
      for (int i = 0; i < 8; ++i) { LAS float* p = scr + (8 * i + (lane >> 3)) * 33 + 4 * (lane & 7); p[0] = v[i][0]; p[1] = v[i][1]; p[2] = v[i][2]; p[3] = v[i][3]; } }
    LDS_WAIT(); asm volatile("" ::: "memory");
    const int c = lane & 7;
#pragma unroll
    for (int j = 0; j < 4; ++j) { const int n = (lane >> 3) + 8 * j; const LAS float* s = scr + (8 * c) * 33 + n;
        u32x2 o; o.x = pk4_f8(s[0 * 33] * 32.f, s[1 * 33] * 32.f, s[2 * 33] * 32.f, s[3 * 33] * 32.f); o.y = pk4_f8(s[4 * 33] * 32.f, s[5 * 33] * 32.f, s[6 * 33] * 32.f, s[7 * 33] * 32.f);
        *(u32x2*)(dst + (size_t)n * K + k0 + 8 * c) = o; }
    LDS_WAIT(); asm volatile("" ::: "memory");
}
constexpr int TI_WIN = 32 * 168, TI_WA = 32, TI_WOUT = 32 * 64, TI_GU = 32 * 64, TI_DN = 16 * 64;
constexpr int TI_L = TI_WIN + TI_WA + TI_WOUT;
constexpr int TI_TOTAL = 2 * TI_L + 32 * TI_GU + 32 * TI_DN;
__device__ __forceinline__ void p0_item(KP Pk, Frame& F, int it, LAS float* scr) {
    unsigned char* ws = F.ws;
    if (it < 2 * TI_L) { const int l = it / TI_L; int r = it % TI_L;
        if (r < TI_WIN) { const int kb = r / 168, nb = r % 168, n0 = 32 * nb;
            if (WIN_F8_L(l)) p0_transpose_item8(Pk->in[I_WIN] + (size_t)l * D * DIN, DIN, n0 < 1536 ? n0 : n0 + 32, 64 * kb, ws + WS_WIN + (size_t)l * NU * D * 2 + (size_t)n0 * D, D, scr, F.lane);
            else p0_transpose_item(Pk->in[I_WIN] + (size_t)l * D * DIN, DIN, n0 < 1536 ? n0 : n0 + 32, 64 * kb, (bf16_t*)(ws + WS_WIN) + ((size_t)l * NU + n0) * D, D, scr, F.lane); return; }
        r -= TI_WIN;
        if (r < TI_WA) { if (WIN_F8_L(l)) p0_transpose_item8(Pk->in[I_WIN] + (size_t)l * D * DIN, DIN, 1536, 64 * r, ws + WS_WA + (size_t)l * 32 * D * 2, D, scr, F.lane);
            else p0_transpose_item(Pk->in[I_WIN] + (size_t)l * D * DIN, DIN, 1536, 64 * r, (bf16_t*)(ws + WS_WA) + (size_t)l * 32 * D, D, scr, F.lane); return; }
        r -= TI_WA;
        { const int kb = r / 64, nb = r % 64;
          if (WOUT_F8) p0_transpose_item8(Pk->in[I_WOUT] + (size_t)l * D * D, D, 32 * nb, 64 * kb, ws + WS_WOUT + ((size_t)l * D + 32 * nb) * D, D, scr, F.lane);
          else p0_transpose_item(Pk->in[I_WOUT] + (size_t)l * D * D, D, 32 * nb, 64 * kb, (bf16_t*)(ws + WS_WOUT) + ((size_t)l * D + 32 * nb) * D, D, scr, F.lane); return; }
    }
    it -= 2 * TI_L;
    if (it < 32 * TI_GU) { const int le = it / TI_GU, r = it % TI_GU, kb = r / 64, nb = r % 64, n0 = 32 * nb, j = n0 >> 8, half = (n0 >> 7) & 1, c0 = 128 * j + (n0 & 127);
        p0_transpose_item8((half ? Pk->in[I_EU] : Pk->in[I_EG]) + (size_t)le * D * DE, DE, c0, 64 * kb, ws + WS_WGU + ((size_t)le * 2048 + n0) * D, D, scr, F.lane); return; }
    it -= 32 * TI_GU;
    { const int le = it / TI_DN, r = it % TI_DN, kb = r / 64, nb = r % 64;
        p0_transpose_item8(Pk->in[I_ED] + (size_t)le * DE * D, D, 32 * nb, 64 * kb, ws + WS_WD + ((size_t)le * D + 32 * nb) * DE, DE, scr, F.lane); }
}
__device__ __forceinline__ void ada_unit(KP Pk, Frame& F, int u) {
    unsigned char* ws = F.ws;
    __syncthreads();
        LAS float* sc = (LAS float*)F.lds;
        LAS float* red = (LAS float*)(F.lds + 9 * 2048 * 4);
        for (int i = F.tid; i < 9 * 2048; i += NTHR) { const int r = i >> 11, k = i & 2047; const float v = r < 8 ? Pk->in[I_C][r * 2048 + k] : Pk->in[I_CCTX][k]; sc[i] = silu_f(v); }
        __syncthreads();
        const int l = u / 96, cb = u % 96, col = cb * 128 + (F.tid & 127), kp = F.tid >> 7;
        const float* W = Pk->in[I_ADAW] + (size_t)l * D * 12288 + col;
        float a[9];
#pragma unroll
        for (int r = 0; r < 9; ++r) a[r] = 0.f;
        for (int k = kp * 512; k < kp * 512 + 512; k += 32) {
            float w[32];
#pragma unroll
            for (int q = 0; q < 32; ++q) w[q] = W[(size_t)(k + q) * 12288];
#pragma unroll
            for (int q = 0; q < 32; ++q) {
#pragma unroll
                for (int r = 0; r < 9; ++r) a[r] += sc[r * 2048 + k + q] * w[q];
                if ((q & 3) == 3) __builtin_amdgcn_sched_barrier(0); }
        }
#pragma unroll
        for (int r = 0; r < 9; ++r) red[(kp * 9 + r) * 128 + (F.tid & 127)] = a[r];
        __syncthreads();
        for (int i = F.tid; i < 9 * 128; i += NTHR) { const int r = i >> 7, c = i & 127;
            const float s = (red[(0 * 9 + r) * 128 + c] + red[(1 * 9 + r) * 128 + c]) + (red[(2 * 9 + r) * 128 + c] + red[(3 * 9 + r) * 128 + c]);
            ((float*)(ws + WS_MOD))[((size_t)l * 9 + r) * 12288 + cb * 128 + c] = s + Pk->in[I_ADAB][l * 12288 + cb * 128 + c]; }
        __syncthreads();
}
__device__ __forceinline__ void p0_prologue(KP Pk, Frame& F, int rep) {
    unsigned char* ws = F.ws;
    const int gw = F.vcu * NWAVES + F.wave, NGW = F.G * NWAVES;
    if (blockIdx.x < 96) ada_unit(Pk, F, (int)blockIdx.x);
    for (int i = blockIdx.x * NTHR + F.tid; i < SEQ * 64; i += F.G * NTHR) { const int t = i >> 6, j = i & 63, q = j >> 4, f = j & 15;
        const float inv = exp2f(-(float)f * (13.287712379549449f / 16.f)); const float pos = (float)(q < 2 ? (t >> 6) : (t & 63)); const float ang = pos * inv;
        ((float*)(ws + WS_ROPE))[i] = (q & 1) ? sinf(ang) : cosf(ang); }
    for (int it = gw; it < 2 * 2304; it += NGW) { const int l = it / 2304, tt = it % 2304, L = tt < 2048 ? 2048 : 256, t = tt < 2048 ? tt : tt - 2048;
        const float tn = (float)t / (float)(L - 1), wv = (6.283185307179586f / (float)L) * (float)t;
        const float* w1 = Pk->in[I_HW1] + l * 33 * 64; const float* w2 = Pk->in[I_HW2] + l * 64 * 64;
        float zv = 0.f;
        if (F.lane == 0) zv = tn; else if (F.lane < 33) { const int bi = (F.lane - 1) & 15; const float band = 1e-4f + (float)bi * ((15.f - 1e-4f) / 15.f); zv = F.lane < 17 ? cosf(wv * band) : -sinf(wv * band); }
        float s = Pk->in[I_HB1][l * 64 + F.lane];
#pragma unroll
        for (int i = 0; i < 33; ++i) s += __shfl(zv, i) * w1[i * 64 + F.lane];
        const float h1 = sinf(Pk->in[I_HFR][(l * 2 + 0) * 64 + F.lane] * s);
        float s2 = Pk->in[I_HB2][l * 64 + F.lane];
#pragma unroll 16
        for (int i = 0; i < 64; ++i) s2 += __shfl(h1, i) * w2[i * 64 + F.lane];
        ((float*)(ws + WS_HYH2))[(size_t)it * 64 + F.lane] = sinf(Pk->in[I_HFR][(l * 2 + 1) * 64 + F.lane] * s2);
    }
    { LAS float* scr = (LAS float*)(F.lds + F.wave * 8704);
      __syncthreads();
      for (;;) { int base = 0; if (F.lane == 0) base = (int)__hip_atomic_fetch_add(F.ctl + CW_Q + 64 * (rep ? 5 : 0), 16u, __ATOMIC_RELAXED, __HIP_MEMORY_SCOPE_AGENT);
          base = __builtin_amdgcn_readfirstlane(base); if (base >= TI_WIN + TI_WA) break;
          for (int it = base; it < base + 16 && it < TI_WIN + TI_WA; ++it) p0_item(Pk, F, it, scr); } }
}

#define MFMA16(a, b, c) __builtin_amdgcn_mfma_f32_16x16x32_bf16((a), (b), (c), 0, 0, 0)
#define MFMA32(a, b, c) __builtin_amdgcn_mfma_f32_32x32x16_bf16((a), (b), (c), 0, 0, 0)
__device__ __forceinline__ void load_row(const float* p, int lane, f32x4 (&v)[8]) {
#pragma unroll
    for (int j = 0; j < 8; ++j) v[j] = ((const f32x4*)p)[lane + 64 * j];
}
__device__ __forceinline__ void load_row_bf16(const bf16_t* p, int lane, f32x4 (&v)[8]) {
#pragma unroll
    for (int j = 0; j < 8; ++j) { const u32x2 a = ((const u32x2*)p)[lane + 64 * j]; v[j] = (f32x4){bflo(a.x), bfhi(a.x), bflo(a.y), bfhi(a.y)}; }
}
__device__ __forceinline__ void add_y2(const unsigned char* y0, const unsigned char* y1, const float* gf, int lane, f32x4 (&v)[8]) {
#pragma unroll
    for (int j = 0; j < 8; ++j) { const unsigned a = ((const unsigned*)y0)[lane + 64 * j], b = ((const unsigned*)y1)[lane + 64 * j]; const f32x4 g = ((const f32x4*)gf)[lane + 64 * j] * (1.f / 32.f);
        const f32x2 a0 = __builtin_amdgcn_cvt_pk_f32_fp8(a, false), a1 = __builtin_amdgcn_cvt_pk_f32_fp8(a, true), b0 = __builtin_amdgcn_cvt_pk_f32_fp8(b, false), b1 = __builtin_amdgcn_cvt_pk_f32_fp8(b, true);
        v[j][0] += g[0] * (a0[0] + b0[0]); v[j][1] += g[1] * (a0[1] + b0[1]); v[j][2] += g[2] * (a1[0] + b1[0]); v[j][3] += g[3] * (a1[1] + b1[1]); }
}
__device__ __forceinline__ float row_rstd(const f32x4 (&v)[8]) {
    float s = 0.f;
#pragma unroll
    for (int j = 0; j < 8; ++j) s += (v[j][0] * v[j][0] + v[j][1] * v[j][1]) + (v[j][2] * v[j][2] + v[j][3] * v[j][3]);
    return rsqrtf(wave_sum(s) * (1.f / D) + NORM_EPS);
}
__device__ __forceinline__ void modulate(f32x4 (&v)[8], float rstd, const float* nw, const float* sh, const float* sc, int lane) {
#pragma unroll
    for (int j = 0; j < 8; ++j) { const f32x4 w = ((const f32x4*)nw)[lane + 64 * j], a = ((const f32x4*)sc)[lane + 64 * j], b = ((const f32x4*)sh)[lane + 64 * j];
        v[j] = v[j] * rstd * w * (a + 1.f) + b; }
}
__device__ __forceinline__ void store_row_bf16(bf16_t* o, int lane, const f32x4 (&v)[8], bool q = false) {
#pragma unroll
    for (int j = 0; j < 8; ++j) { u32x2 w; if (q) { w.x = pk2q(v[j][0], v[j][1]); w.y = pk2q(v[j][2], v[j][3]); } else { w.x = pk2(v[j][0], v[j][1]); w.y = pk2(v[j][2], v[j][3]); } ((u32x2*)o)[lane + 64 * j] = w; }
}
__device__ __forceinline__ void store_row_f8(unsigned char* o, int lane, const f32x4 (&v)[8]) {
#pragma unroll
    for (int j = 0; j < 8; ++j) ((unsigned*)o)[lane + 64 * j] = pk4_f8(v[j][0], v[j][1], v[j][2], v[j][3]);
}
__device__ __forceinline__ void ph_norm1(KP Pk, Frame& F, int l) {
    unsigned char* ws = F.ws;
    const int gw = F.vcu * NWAVES + F.wave, NGW = F.G * NWAVES;
    const float* mod = (const float*)(ws + WS_MOD) + (size_t)l * 9 * 12288;
    bf16_t* X = (bf16_t*)(ws + WS_X); bf16_t* H = (bf16_t*)(ws + WS_H); const unsigned char* Y2 = ws + WS_Y2;
    for (int row = gw; row < TT; row += NGW) {
        const int r = modrow_of(row); f32x4 v[8];
        if (l == 0) load_row(row < TL ? Pk->in[I_X] + (size_t)row * D : Pk->in[I_CTX] + (size_t)(row - TL) * D, F.lane, v);
        else { load_row_bf16(X + (size_t)row * D, F.lane, v);
            add_y2(Y2 + (size_t)row * D, Y2 + ((size_t)TT + row) * D, (const float*)(ws + WS_MOD) + (size_t)r * 12288 + 5 * D, F.lane, v);
            if (row < TL) store_row_bf16(X + (size_t)row * D, F.lane, v); }
        const float rstd = row_rstd(v);
        modulate(v, rstd, Pk->in[I_N1W] + l * D, mod + (size_t)r * 12288, mod + (size_t)r * 12288 + D, F.lane);
        if (WIN_F8_L(l)) store_row_f8(ws + WS_H + (size_t)row * D, F.lane, v); else store_row_bf16(H + (size_t)row * D, F.lane, v);
    }
}
__device__ __forceinline__ void ph_hyena_filters(KP Pk, Frame& F, int u) {
    unsigned char* ws = F.ws;
    constexpr int HRS = 2052;
    LAS float* HR = (LAS float*)F.lds; LAS float* red = (LAS float*)(F.lds + 16 * HRS * 4);
    const int r16 = F.lane & 15, kg = F.lane >> 4;
    {
        const int lf = u >> 7, cg = u & 127, chl = r16 & 3, od = r16 >> 2, ch = cg * 4 + chl;
        const float* w3 = Pk->in[I_HW3] + (size_t)lf * 64 * 2048 + (od >> 1) * 1024 + (od & 1) * 512 + ch;
        bf16x8 wb[2];
#pragma unroll
        for (int ks = 0; ks < 2; ++ks) { float w[8];
#pragma unroll
            for (int j = 0; j < 8; ++j) w[j] = w3[(size_t)(32 * ks + 8 * kg + j) * 2048];
            u32x4 p; p.x = pk2(w[0], w[1]); p.y = pk2(w[2], w[3]); p.z = pk2(w[4], w[5]); p.w = pk2(w[6], w[7]); wb[ks] = __builtin_bit_cast(bf16x8, p); }
        const float dmin = 3.0701134573253940f, dmax = 15.350567286626972f, delta = dmin + (float)ch * ((dmax - dmin) / 511.f);
#pragma unroll 1
        for (int sel = 0; sel < 2; ++sel) {
            const int L = sel == 0 ? 2048 : 256; const float* h2 = (const float*)(ws + WS_HYH2) + ((size_t)lf * 2304 + (sel == 0 ? 0 : 2048)) * 64; const float rl = 1.f / (float)(L - 1);
            __syncthreads();
            float s = 0.f;
#pragma unroll 2
            for (int tile = F.wave; tile < L / 16; tile += NWAVES) {
                const f32x4* hp = (const f32x4*)(h2 + (size_t)(16 * tile + r16) * 64 + 8 * kg);
                const f32x4 a0 = hp[0], a1 = hp[1], a2 = hp[8], a3 = hp[9];
                u32x4 p0, p1; p0.x = pk2(a0[0], a0[1]); p0.y = pk2(a0[2], a0[3]); p0.z = pk2(a1[0], a1[1]); p0.w = pk2(a1[2], a1[3]); p1.x = pk2(a2[0], a2[1]); p1.y = pk2(a2[2], a2[3]); p1.z = pk2(a3[0], a3[1]); p1.w = pk2(a3[2], a3[3]);
                f32x4 d = MFMA16(__builtin_bit_cast(bf16x8, p0), wb[0], ((f32x4){0.f, 0.f, 0.f, 0.f})); d = MFMA16(__builtin_bit_cast(bf16x8, p1), wb[1], d);
                const int t0 = 16 * tile + 4 * kg;
#pragma unroll
                for (int i = 0; i < 4; ++i) { d[i] *= expf(-(float)(t0 + i) * rl * delta); s += fabsf(d[i]); }
                *(LAS f32x4*)(HR + r16 * HRS + t0) = d; }
            s += __shfl_xor(s, 16); s += __shfl_xor(s, 32);
            if (F.lane < 16) red[F.wave * 16 + F.lane] = s;
            __syncthreads();
            for (int e = F.tid; e < 16 * L; e += NTHR) { const int col = e / L, t = e % L, dir = (col >> 2) & 1, o = col >> 3, c = cg * 4 + (col & 3);
                float tot = 0.f;
#pragma unroll
                for (int w = 0; w < 8; ++w) tot += red[w * 16 + (col & ~4)] + red[w * 16 + (col | 4)];
                float hv = HR[col * HRS + t] / tot; int idx = dir == 0 ? L - t : L + t;
                if (dir == 1 && t == 0) { idx = 0; hv = 0.f; }
                ((bf16_t*)(ws + WS_HYF) + ((size_t)lf * 1024 + o * 512 + c) * 4608)[(sel == 0 ? 0 : 4096) + idx] = (bf16_t)f2bf(hv); }
        }
    }
}
__device__ __forceinline__ void ph_norm2_router(KP Pk, Frame& F, int l, int rep) {
    unsigned char* ws = F.ws;
    const int gw = F.vcu * NWAVES + F.wave, NGW = F.G * NWAVES, nrows = l == 0 ? TT : TL;
    const float* mod = (const float*)(ws + WS_MOD) + (size_t)l * 9 * 12288;
    const bf16_t* X = (const bf16_t*)(ws + WS_X); unsigned char* Fo = ws + WS_H;
    LAS float* rw = (LAS float*)F.lds;
    volatile LAS unsigned* lcnt = F.MISC + 16;
    if (F.tid < 16) lcnt[F.tid] = 0u;
    for (int i = F.tid; i < 2048 * 4; i += NTHR) { const f32x4 w = ((const f32x4*)Pk->in[I_RW])[i]; const int k = i >> 2, e0 = (i & 3) * 4;
        rw[(e0 + 0) * 2048 + k] = w[0]; rw[(e0 + 1) * 2048 + k] = w[1]; rw[(e0 + 2) * 2048 + k] = w[2]; rw[(e0 + 3) * 2048 + k] = w[3]; }
    __syncthreads();
    float rb[16];
#pragma unroll
    for (int e = 0; e < 16; ++e) rb[e] = Pk->in[I_RB][e];
    for (int rowA = gw; rowA < nrows; rowA += 2 * NGW) {
        const bool hasB = rowA + NGW < nrows; const int rowB = hasB ? rowA + NGW : rowA;
        f32x4 va[8], vb[8];
        load_row_bf16(X + (size_t)rowA * D, F.lane, va); load_row_bf16(X + (size_t)rowB * D, F.lane, vb);
        { const int r = modrow_of(rowA); const float rstd = row_rstd(va); modulate(va, rstd, Pk->in[I_N2W] + l * D, mod + (size_t)r * 12288 + 3 * D, mod + (size_t)r * 12288 + 4 * D, F.lane); store_row_f8(Fo + (size_t)rowA * D, F.lane, va); }
        { const int r = modrow_of(rowB); const float rstd = row_rstd(vb); modulate(vb, rstd, Pk->in[I_N2W] + l * D, mod + (size_t)r * 12288 + 3 * D, mod + (size_t)r * 12288 + 4 * D, F.lane); if (hasB) store_row_f8(Fo + (size_t)rowB * D, F.lane, vb); }
        float pa[32];
#pragma unroll
        for (int e = 0; e < 16; ++e) { f32x2 a = {0.f, 0.f}, b = {0.f, 0.f};
#pragma unroll
            for (int j = 0; j < 8; ++j) { const f32x4 w = ((const LAS f32x4*)(rw + e * 2048))[F.lane + 64 * j];
                const f32x2 wl = __builtin_shufflevector(w, w, 0, 1), wh = __builtin_shufflevector(w, w, 2, 3);
                a = __builtin_elementwise_fma(__builtin_shufflevector(va[j], va[j], 0, 1), wl, a); a = __builtin_elementwise_fma(__builtin_shufflevector(va[j], va[j], 2, 3), wh, a);
                b = __builtin_elementwise_fma(__builtin_shufflevector(vb[j], vb[j], 0, 1), wl, b); b = __builtin_elementwise_fma(__builtin_shufflevector(vb[j], vb[j], 2, 3), wh, b); }
            pa[e] = a[0] + a[1]; pa[16 + e] = b[0] + b[1]; }
#define RB_STEP(N, BIT) { const bool up = (F.lane & (BIT)) != 0; _Pragma("unroll") for (int k = 0; k < (N); ++k) { const float keep = up ? pa[(N) + k] : pa[k], send = up ? pa[k] : pa[(N) + k]; pa[k] = keep + __shfl_xor(send, (BIT)); } }
        RB_STEP(16, 32) RB_STEP(8, 16) RB_STEP(4, 8) RB_STEP(2, 4) RB_STEP(1, 2)
#undef RB_STEP
        const float red = pa[0] + __shfl_xor(pa[0], 1);
        float lg[16];
#pragma unroll
        for (int e = 0; e < 16; ++e) lg[e] = __shfl(red, (F.lane & 32) + 2 * e);
        float mx = lg[0];
#pragma unroll
        for (int e = 1; e < 16; ++e) mx = fmaxf(mx, lg[e]);
        float sum = 0.f;
#pragma unroll
        for (int e = 0; e < 16; ++e) { lg[e] = expf(lg[e] - mx); sum += lg[e]; }
        const float rs = 1.f / sum; float sel[16];
#pragma unroll
        for (int e = 0; e < 16; ++e) { lg[e] *= rs; sel[e] = lg[e] + rb[e]; }
        int grp = 0; float gbest = fmaxf(fmaxf(sel[0], sel[1]), fmaxf(sel[2], sel[3]));
#pragma unroll
        for (int g = 1; g < 4; ++g) { const float gm = fmaxf(fmaxf(sel[4 * g], sel[4 * g + 1]), fmaxf(sel[4 * g + 2], sel[4 * g + 3])); if (gm > gbest) { gbest = gm; grp = g; } }
        float s4[4], p4[4];
#pragma unroll
        for (int i = 0; i < 4; ++i) { s4[i] = grp == 0 ? sel[i] : grp == 1 ? sel[4 + i] : grp == 2 ? sel[8 + i] : sel[12 + i]; p4[i] = grp == 0 ? lg[i] : grp == 1 ? lg[4 + i] : grp == 2 ? lg[8 + i] : lg[12 + i]; }
        int i0 = 0; float b0 = s4[0];
#pragma unroll
        for (int i = 1; i < 4; ++i) if (s4[i] > b0) { b0 = s4[i]; i0 = i; }
        int i1 = -1; float b1 = 0.f;
#pragma unroll
        for (int i = 0; i < 4; ++i) if (i != i0 && (i1 < 0 || s4[i] > b1)) { b1 = s4[i]; i1 = i; }
        const float p0 = i0 == 0 ? p4[0] : i0 == 1 ? p4[1] : i0 == 2 ? p4[2] : p4[3], p1 = i1 == 0 ? p4[0] : i1 == 1 ? p4[1] : i1 == 2 ? p4[2] : p4[3];
        const int e0 = grp * 4 + i0, e1 = grp * 4 + i1; const float ws_ = 1.f / (p0 + p1);
        if (F.lane == 0 || (F.lane == 32 && hasB)) { const int row = F.lane == 0 ? rowA : rowB;
            ((int*)(ws + WS_RT + RT_E))[row] = e0 | (e1 << 8); ((f32x2*)(ws + WS_RT + RT_W))[row] = (f32x2){p0 * ws_, p1 * ws_};
            __hip_atomic_fetch_add((LAS unsigned*)&lcnt[e0], 1u, __ATOMIC_RELAXED, __HIP_MEMORY_SCOPE_WORKGROUP); __hip_atomic_fetch_add((LAS unsigned*)&lcnt[e1], 1u, __ATOMIC_RELAXED, __HIP_MEMORY_SCOPE_WORKGROUP); }
    }
    __syncthreads();
    { int t_; asm volatile("v_mbcnt_lo_u32_b32 %0, -1, 0\n\tv_mbcnt_hi_u32_b32 %0, -1, %0" : "=v"(t_)); t_ += F.wave * 64;
      if (t_ < 16 && lcnt[t_]) __hip_atomic_fetch_add(F.ctl + CW_CNT + 64 * (l + 2 * rep) + t_, lcnt[t_], __ATOMIC_RELAXED, __HIP_MEMORY_SCOPE_AGENT); }
}
__device__ __forceinline__ int moe_table(Frame& F, int l) {
    volatile LAS unsigned char* pexp = (volatile LAS unsigned char*)(F.MISC + 64);
    __syncthreads();
    if (F.tid < 64) {
        const int e = F.lane & 15; const int c = (int)__hip_atomic_load(F.ctl + CW_CNT + 64 * l + e, __ATOMIC_RELAXED, __HIP_MEMORY_SCOPE_AGENT);
        const int np = (c + 255) >> 8; int p0 = np;
#pragma unroll
        for (int d = 1; d < 16; d <<= 1) { const int y = __shfl(p0, F.lane - d); if (e >= d) p0 += y; }
        const int tot = __shfl(p0, 15); p0 -= np;
        if (F.lane < 16) { F.MISC[32 + e] = (unsigned)(p0 * 256); for (int j = 0; j < np; ++j) pexp[p0 + j] = (unsigned char)e; if (e == 0) F.MISC[2] = (unsigned)tot; }
    }
    __syncthreads();
    return (int)F.MISC[2];
}
__device__ __forceinline__ void ph_slots(KP Pk, Frame& F, int l) {
    unsigned char* ws = F.ws;
    const int nrows = l == 0 ? TT : TL, per = (nrows + F.G - 1) / F.G, t0 = blockIdx.x * per, t1 = min(nrows, t0 + per);
    (void)moe_table(F, l);
    volatile LAS unsigned* lcnt = F.MISC + 16; volatile LAS unsigned* lbase = F.MISC + 48;
    if (F.tid < 16) lcnt[F.tid] = 0u;
    __syncthreads();
    const int* RE = (const int*)(ws + WS_RT + RT_E); const f32x2* RW = (const f32x2*)(ws + WS_RT + RT_W);
    int* ROWTOK = (int*)(ws + WS_RT + RT_ROWTOK); float* ROWW = (float*)(ws + WS_RT + RT_ROWW);
    const int tok = t0 + F.tid; int e0 = 0, e1 = 0; unsigned q0 = 0, q1 = 0;
    if (tok < t1) { const int ee = RE[tok]; e0 = ee & 255; e1 = ee >> 8;
        q0 = __hip_atomic_fetch_add((LAS unsigned*)&lcnt[e0], 1u, __ATOMIC_RELAXED, __HIP_MEMORY_SCOPE_WORKGROUP); q1 = __hip_atomic_fetch_add((LAS unsigned*)&lcnt[e1], 1u, __ATOMIC_RELAXED, __HIP_MEMORY_SCOPE_WORKGROUP); }
    __syncthreads();
    if (F.tid < 16) lbase[F.tid] = lcnt[F.tid] ? __hip_atomic_fetch_add(F.ctl + CW_CUR + 64 * l + F.tid, lcnt[F.tid], __ATOMIC_RELAXED, __HIP_MEMORY_SCOPE_AGENT) : 0u;
    __syncthreads();
    if (tok < t1) { const f32x2 w = RW[tok]; const int r0 = (int)(F.MISC[32 + e0] + lbase[e0] + q0), r1 = (int)(F.MISC[32 + e1] + lbase[e1] + q1);
        ROWTOK[r0] = tok; ROWW[r0] = w.x; ROWTOK[r1] = tok | (1 << 30); ROWW[r1] = w.y; }
    if (blockIdx.x < NE) { const int e = blockIdx.x, c = (int)__hip_atomic_load(F.ctl + CW_CNT + 64 * l + e, __ATOMIC_RELAXED, __HIP_MEMORY_SCOPE_AGENT), base = (int)F.MISC[32 + e];
        for (int i = c + F.tid; i < ((c + 255) & ~255); i += NTHR) { ROWTOK[base + i] = -1; ROWW[base + i] = 0.f; } }
}
__device__ __forceinline__ void ph_final(KP Pk, Frame& F) {
    unsigned char* ws = F.ws;
    const int gw = F.vcu * NWAVES + F.wave, NGW = F.G * NWAVES;
    const bf16_t* X = (const bf16_t*)(ws + WS_X); const unsigned char* Y2 = ws + WS_Y2;
    for (int row = gw; row < TL; row += NGW) { f32x4 v[8];
        load_row_bf16(X + (size_t)row * D, F.lane, v);
        add_y2(Y2 + (size_t)row * D, Y2 + ((size_t)TT + row) * D, (const float*)(ws + WS_MOD) + ((size_t)9 + (row >> 11)) * 12288 + 5 * D, F.lane, v);
#pragma unroll
        for (int j = 0; j < 8; ++j) ((f32x4*)(Pk->out + (size_t)row * D))[F.lane + 64 * j] = v[j]; }
}

__device__ __forceinline__ void ph_gate_cols(Frame& F, int l) {
    unsigned char* ws = F.ws;
    const int r32 = F.lane & 31, hi = F.lane >> 5;
    const bf16_t* H = (const bf16_t*)(ws + WS_H); const bf16_t* Wa = (const bf16_t*)(ws + WS_WA) + (size_t)l * 32 * D; float* AG = (float*)(ws + WS_AG);
    LAS unsigned char* tile = F.lds + F.wave * 16896;
    LAS float* red = (LAS float*)F.lds;
    for (int it = blockIdx.x; it < TT / 32; it += F.G) {
        const int kb = F.wave * 256;
        u32x4 av[16]; bf16x8 bv[16];
#pragma unroll
        for (int i = 0; i < 16; ++i) { const int id = F.lane + 64 * i; av[i] = *(const u32x4*)(H + (size_t)(it * 32 + (id >> 5)) * D + kb + 8 * (id & 31)); }
#pragma unroll
        for (int ks = 0; ks < 16; ++ks) bv[ks] = *(const bf16x8*)(Wa + (size_t)r32 * D + kb + 16 * ks + 8 * hi);
        __syncthreads();
#pragma unroll
        for (int i = 0; i < 16; ++i) { const int id = F.lane + 64 * i; *(LAS u32x4*)(tile + ((id >> 5) * 264 + 8 * (id & 31)) * 2) = av[i]; }
        f32x16 acc = {};
#pragma unroll
        for (int ks = 0; ks < 16; ++ks) { const bf16x8 a = *(const LAS bf16x8*)(tile + (r32 * 264 + 16 * ks + 8 * hi) * 2); acc = MFMA32(a, bv[ks], acc); }
        __syncthreads();
#pragma unroll
        for (int r = 0; r < 16; ++r) red[(F.wave * 16 + r) * 64 + F.lane] = acc[r];
        __syncthreads();
        for (int e = F.tid; e < 1024; e += NTHR) { float sum = 0.f;
#pragma unroll
            for (int w = 0; w < 8; ++w) sum += red[w * 1024 + e];
            const int r = e >> 6, ln = e & 63; AG[(size_t)(it * 32 + (r & 3) + 8 * (r >> 2) + 4 * (ln >> 5)) * 32 + (ln & 31)] = sum; }
    }
}

__device__ __forceinline__ void ph_gate_cols8(Frame& F, int l) {
    unsigned char* ws = F.ws;
    const int fr = F.lane & 15, fq = F.lane >> 4, kb = F.wave * 256;
    const unsigned char* H8 = ws + WS_H; const unsigned char* Wa8 = ws + WS_WA + (size_t)l * 32 * D * 2; float* AG = (float*)(ws + WS_AG);
    LAS f32x4* red = (LAS f32x4*)F.lds;
    int f8scale = 0x7f7f7f7f; asm volatile("" : "+v"(f8scale));
    i32x8 b[2][2], a[2][2];
#pragma unroll
    for (int ch = 0; ch < 2; ++ch)
#pragma unroll
        for (int ks = 0; ks < 2; ++ks) b[ch][ks] = *(const i32x8*)(Wa8 + (size_t)(16 * ch + fr) * D + kb + 128 * ks + 32 * fq);
    int it = blockIdx.x;
    if (it < TT / 32) {
#pragma unroll
        for (int rh = 0; rh < 2; ++rh)
#pragma unroll
            for (int ks = 0; ks < 2; ++ks) a[rh][ks] = *(const i32x8*)(H8 + (size_t)(it * 32 + 16 * rh + fr) * D + kb + 128 * ks + 32 * fq); }
    for (; it < TT / 32; it += F.G) {
        f32x4 acc[2][2];
#pragma unroll
        for (int rh = 0; rh < 2; ++rh)
#pragma unroll
            for (int ch = 0; ch < 2; ++ch) acc[rh][ch] = (f32x4){0.f, 0.f, 0.f, 0.f};
#pragma unroll
        for (int ks = 0; ks < 2; ++ks)
#pragma unroll
            for (int rh = 0; rh < 2; ++rh)
#pragma unroll
                for (int ch = 0; ch < 2; ++ch)
                    asm volatile("v_mfma_scale_f32_16x16x128_f8f6f4 %0, %1, %2, %0, %3, %3 op_sel_hi:[0,0,0]" : "+v"(acc[rh][ch]) : "v"(b[ch][ks]), "v"(a[rh][ks]), "v"(f8scale));
        asm volatile("s_nop 15\n\ts_nop 15" : "+v"(acc[0][0]), "+v"(acc[0][1]), "+v"(acc[1][0]), "+v"(acc[1][1]) :: "memory");
        const int nx = it + F.G;
        if (nx < TT / 32) {
#pragma unroll
            for (int rh = 0; rh < 2; ++rh)
#pragma unroll
                for (int ks = 0; ks < 2; ++ks) a[rh][ks] = *(const i32x8*)(H8 + (size_t)(nx * 32 + 16 * rh + fr) * D + kb + 128 * ks + 32 * fq); }
        __syncthreads();
#pragma unroll
        for (int rh = 0; rh < 2; ++rh)
#pragma unroll
            for (int ch = 0; ch < 2; ++ch) red[(F.wave * 4 + rh * 2 + ch) * 64 + F.lane] = acc[rh][ch];
        __syncthreads();
        for (int e = F.tid; e < 1024; e += NTHR) { float sum = 0.f;
#pragma unroll
            for (int w = 0; w < 8; ++w) sum += ((const LAS float*)red)[w * 1024 + e];
            const int blk = e >> 8, ln = (e >> 2) & 63, k = e & 3;
            AG[(size_t)(it * 32 + 16 * (blk >> 1) + (ln & 15)) * 32 + 16 * (blk & 1) + 4 * (ln >> 4) + k] = sum * (1.f / 32.f); }
    }
}

constexpr int WAVE_LDS = 17408;
__device__ __forceinline__ int perm16(int k) { return (k & 3) + 4 * ((k >> 3) & 1) + 8 * ((k >> 2) & 1); }
__device__ __forceinline__ int gla_kidx(int dir, int s) { return dir == 0 ? s : (s < LC ? LC - 1 - s : LC + (SEQ - 1 - (s - LC))); }
constexpr int GL_QT = 0, GL_KT = 1280, GL_KHT = 2560, GL_VT = 4096, GL_PT = 7168, GL_ST = 7936, GL_G = 13056, GL_GW = 13312, GL_GB = 15360;
__device__ __forceinline__ void gla_load_gates(KP Pk, Frame& F, int l, int h, int dir, LAS unsigned char* wl) {
    LAS float* gw = (LAS float*)(wl + GL_GW); LAS float* gb = (LAS float*)(wl + GL_GB);
    const float* src = Pk->in[I_GGW] + ((size_t)(l * 2 + dir) * 16) * 256 + h * 32;
#pragma unroll
    for (int i = 0; i < 8; ++i) { const int e = F.lane + 64 * i; gw[e] = src[(e >> 5) * 256 + (e & 31)]; }
    if (F.lane < 32) gb[F.lane] = Pk->in[I_GGB][(l * 2 + dir) * 256 + h * 32 + F.lane];
}
struct GlaIn { f32x4 ag[4]; u32x4 kv, qv, v0, v1; };
template <bool NEEDQ>
__device__ __forceinline__ void gla_sub_load(Frame& F, int b, int h, int dir, int kidx0, GlaIn& in) {
    unsigned char* ws = F.ws;
    int lane_o = F.lane; asm volatile("" : "+v"(lane_o));
    const int tau = lane_o & 15, dq = lane_o >> 4, row = keyrow(b, kidx0 + tau);
    const f32x4* ag = (const f32x4*)((const float*)(ws + WS_AG) + (size_t)row * 32 + dir * 16);
#pragma unroll
    for (int r4 = 0; r4 < 4; ++r4) in.ag[r4] = ag[r4];
    const bf16_t* U = (const bf16_t*)(ws + WS_U) + (size_t)row * NU;
    in.kv = *(const u32x4*)(U + UC_GK + h * 32 + dq * 8);
    if (NEEDQ) in.qv = *(const u32x4*)(U + UC_GQ + h * 32 + dq * 8);
    in.v0 = *(const u32x4*)(U + UC_GV + h * 64 + dq * 16); in.v1 = *(const u32x4*)(U + UC_GV + h * 64 + dq * 16 + 8);
}
template <bool NEEDQ>
__device__ __forceinline__ void gla_sub_prep(Frame& F, int dir, const GlaIn& in, LAS unsigned char* wl, float (&ltot)[8]) {
    int lane_o = F.lane; asm volatile("" : "+v"(lane_o));
    const int tau = lane_o & 15, dq = lane_o >> 4;
    const LAS float* gw = (const LAS float*)(wl + GL_GW) + dq * 8; const LAS float* gb = (const LAS float*)(wl + GL_GB) + dq * 8;
    const f32x4* ag = in.ag;
    float x[8];
    { const f32x4 b0 = *(const LAS f32x4*)gb, b1 = *(const LAS f32x4*)(gb + 4); x[0] = b0[0]; x[1] = b0[1]; x[2] = b0[2]; x[3] = b0[3]; x[4] = b1[0]; x[5] = b1[1]; x[6] = b1[2]; x[7] = b1[3]; }
#pragma unroll
    for (int r4 = 0; r4 < 4; ++r4) { const f32x4 av = ag[r4];
#pragma unroll
        for (int rr = 0; rr < 4; ++rr) { const f32x4 w0 = *(const LAS f32x4*)(gw + (4 * r4 + rr) * 32), w1 = *(const LAS f32x4*)(gw + (4 * r4 + rr) * 32 + 4);
            x[0] += av[rr] * w0[0]; x[1] += av[rr] * w0[1]; x[2] += av[rr] * w0[2]; x[3] += av[rr] * w0[3]; x[4] += av[rr] * w1[0]; x[5] += av[rr] * w1[1]; x[6] += av[rr] * w1[2]; x[7] += av[rr] * w1[3]; } }
#pragma unroll
    for (int j = 0; j < 8; ++j) x[j] = (fminf(x[j], 0.f) - __logf(1.f + __expf(-fabsf(x[j])))) * (1.f / 16.f);
#pragma unroll
    for (int dl = 1; dl < 16; dl <<= 1) { const int src = dir == 0 ? F.lane - dl : F.lane + dl; const bool ok = dir == 0 ? (tau >= dl) : (tau + dl <= 15);
#pragma unroll
        for (int j = 0; j < 8; ++j) { const float y = __shfl(x[j], src); x[j] += ok ? y : 0.f; } }
    float tot[8];
#pragma unroll
    for (int j = 0; j < 8; ++j) { tot[j] = __shfl(x[j], (lane_o & 48) + (dir == 0 ? 15 : 0)); ltot[j] += tot[j]; }
    const u32x4 kv = in.kv;
    const float kf[8] = {bflo(kv.x), bfhi(kv.x), bflo(kv.y), bfhi(kv.y), bflo(kv.z), bfhi(kv.z), bflo(kv.w), bfhi(kv.w)};
    float kt[8], kh[8];
#pragma unroll
    for (int j = 0; j < 8; ++j) { kt[j] = kf[j] * __expf(-x[j]); kh[j] = kf[j] * __expf(tot[j] - x[j]); }
    { u32x4 w; w.x = pk2(kt[0], kt[1]); w.y = pk2(kt[2], kt[3]); w.z = pk2(kt[4], kt[5]); w.w = pk2(kt[6], kt[7]); *(LAS u32x4*)(wl + GL_KT + (tau * 40 + dq * 8) * 2) = w; }
#pragma unroll
    for (int j = 0; j < 8; ++j) *(LAS unsigned short*)(wl + GL_KHT + ((dq * 8 + j) * 24 + tau) * 2) = (unsigned short)f2bf(kh[j]);
    if (NEEDQ) { const u32x4 qv = in.qv; const float sc = 0.17677669529663687f;
        const float qf[8] = {bflo(qv.x), bfhi(qv.x), bflo(qv.y), bfhi(qv.y), bflo(qv.z), bfhi(qv.z), bflo(qv.w), bfhi(qv.w)}; float qt[8];
#pragma unroll
        for (int j = 0; j < 8; ++j) qt[j] = qf[j] * sc * __expf(x[j]);
        u32x4 w; w.x = pk2(qt[0], qt[1]); w.y = pk2(qt[2], qt[3]); w.z = pk2(qt[4], qt[5]); w.w = pk2(qt[6], qt[7]); *(LAS u32x4*)(wl + GL_QT + (tau * 40 + dq * 8) * 2) = w; }
    if (tau == 0) {
#pragma unroll
        for (int j = 0; j < 8; ++j) ((LAS float*)(wl + GL_G))[dq * 8 + j] = __expf(tot[j]); }
    { const u32x4 v0 = in.v0, v1 = in.v1;
      const unsigned vw[8] = {v0.x, v0.y, v0.z, v0.w, v1.x, v1.y, v1.z, v1.w};
#pragma unroll
      for (int j = 0; j < 8; ++j) { *(LAS unsigned short*)(wl + GL_VT + ((dq * 16 + 2 * j) * 24 + tau) * 2) = (unsigned short)(vw[j] & 0xffffu); *(LAS unsigned short*)(wl + GL_VT + ((dq * 16 + 2 * j + 1) * 24 + tau) * 2) = (unsigned short)(vw[j] >> 16); } }
}
__device__ __forceinline__ void gla_state_update(Frame& F, LAS unsigned char* wl, f32x4 (&Sr)[2][4]) {
    int lane_o = F.lane; asm volatile("" : "+v"(lane_o));
    const int r16 = lane_o & 15, kg = lane_o >> 4; const bf16x8 zf = {0, 0, 0, 0, 0, 0, 0, 0};
    bf16x8 vb[4];
#pragma unroll
    for (int nb = 0; nb < 4; ++nb) { vb[nb] = *(const LAS bf16x8*)(wl + GL_VT + ((16 * nb + r16) * 24 + 8 * (kg & 1)) * 2); if (kg >= 2) vb[nb] = zf; }
#pragma unroll
    for (int db = 0; db < 2; ++db) { const f32x4 gv = *(const LAS f32x4*)(wl + GL_G + (16 * db + 4 * kg) * 4);
        bf16x8 ka = *(const LAS bf16x8*)(wl + GL_KHT + ((16 * db + r16) * 24 + 8 * (kg & 1)) * 2); if (kg >= 2) ka = zf;
#pragma unroll
        for (int nb = 0; nb < 4; ++nb) Sr[db][nb] = MFMA16(ka, vb[nb], Sr[db][nb] * gv); }
}
constexpr int GGRP = 6, NGRP = NCH / GGRP;
constexpr size_t WS_GGS = WS_GSS, WS_GGA = WS_GSS + 8 * MiB;
__device__ __forceinline__ void gla_pass_a(KP Pk, Frame& F, int l, int it, LAS unsigned char* wl) {
    unsigned char* ws = F.ws;
    const int seq = it / NGRP, g = it % NGRP, dir = seq & 1, h = (seq >> 1) & 7, b = seq >> 4, r16 = F.lane & 15, kg = F.lane >> 4;
    gla_load_gates(Pk, F, l, h, dir, wl);
    f32x4 Sr[2][4];
#pragma unroll
    for (int db = 0; db < 2; ++db)
#pragma unroll
        for (int nb = 0; nb < 4; ++nb) Sr[db][nb] = (f32x4){0.f, 0.f, 0.f, 0.f};
    float ltot[8] = {0.f, 0.f, 0.f, 0.f, 0.f, 0.f, 0.f, 0.f};
    GlaIn nin;
    { const int c0 = g * GGRP; gla_sub_load<false>(F, b, h, dir, (dir == 0 ? 64 * c0 : gla_kidx(1, 64 * c0) - 63) + 16 * (dir == 0 ? 0 : 3), nin); }
#pragma unroll 1
    for (int cg = 0; cg <= GGRP; ++cg) {
        const int c = g * GGRP + cg;
        float* sl = cg < GGRP ? (float*)(ws + WS_GSL) + ((size_t)seq * NCH + c) * 2048 : (float*)(ws + WS_GGS) + ((size_t)seq * NGRP + g) * 2048;
        float* al = cg < GGRP ? (float*)(ws + WS_GAE) + ((size_t)seq * NCH + c) * 32 : (float*)(ws + WS_GGA) + ((size_t)seq * NGRP + g) * 32;
#pragma unroll
        for (int db = 0; db < 2; ++db)
#pragma unroll
            for (int nb = 0; nb < 4; ++nb)
#pragma unroll
                for (int i = 0; i < 4; ++i) sl[(16 * db + 4 * kg + i) * 64 + 16 * nb + r16] = Sr[db][nb][i];
        if ((F.lane & 15) == 0) {
#pragma unroll
            for (int j = 0; j < 8; ++j) al[kg * 8 + j] = __expf(ltot[j]); }
        if (cg == GGRP) break;
#pragma unroll 1
        for (int st = 0; st < 4; ++st) {
            const GlaIn cur = nin;
            { const int q2 = cg * 4 + st + 1, c2 = g * GGRP + (q2 >> 2), st2 = q2 & 3, sb2 = dir == 0 ? st2 : 3 - st2;
              if (q2 < 4 * GGRP) gla_sub_load<false>(F, b, h, dir, (dir == 0 ? 64 * c2 : gla_kidx(1, 64 * c2) - 63) + 16 * sb2, nin); }
            gla_sub_prep<false>(F, dir, cur, wl, ltot);
            gla_state_update(F, wl, Sr); }
    }
}
__device__ __forceinline__ void gla_pass_b(KP Pk, Frame& F, int l, int b, int h, int c, LAS unsigned char* wl) {
    unsigned char* ws = F.ws;
    const int r16 = F.lane & 15, kg = F.lane >> 4, seq = (b * 8 + h) * 2; const bf16x8 zf = {0, 0, 0, 0, 0, 0, 0, 0};
    const bf16_t* U = (const bf16_t*)(ws + WS_U); unsigned char* MIX = ws + WS_H;
    u32x2 of[4][4];
#pragma unroll 1
    for (int dir = 0; dir < 2; ++dir) {
        gla_load_gates(Pk, F, l, h, dir, wl);
        const int cc = dir == 0 ? c : (c < 4 ? 3 - c : 39 - c);
        f32x4 Sr[2][4];
#pragma unroll
        for (int db = 0; db < 2; ++db)
#pragma unroll
            for (int nb = 0; nb < 4; ++nb) Sr[db][nb] = (f32x4){0.f, 0.f, 0.f, 0.f};
        { const int gsel = cc / GGRP;
#pragma unroll 1
          for (int gp = 0; gp <= gsel; ++gp) {
            const bool fin = gp == gsel;
            const float* sp = fin ? (const float*)(ws + WS_GSL) + ((size_t)(seq + dir) * NCH + cc) * 2048 : (const float*)(ws + WS_GGS) + ((size_t)(seq + dir) * NGRP + gp) * 2048;
            const float* apx = fin ? (const float*)(ws + WS_GAE) + ((size_t)(seq + dir) * NCH + cc) * 32 : (const float*)(ws + WS_GGA) + ((size_t)(seq + dir) * NGRP + gp) * 32;
#pragma unroll
            for (int db = 0; db < 2; ++db) { const f32x4 av = *(const f32x4*)(apx + 16 * db + 4 * kg);
#pragma unroll
                for (int nb = 0; nb < 4; ++nb)
#pragma unroll
                    for (int i = 0; i < 4; ++i) Sr[db][nb][i] = av[i] * Sr[db][nb][i] + sp[(16 * db + 4 * kg + i) * 64 + 16 * nb + r16]; } } }
        float ltot[8] = {0.f, 0.f, 0.f, 0.f, 0.f, 0.f, 0.f, 0.f};
#pragma unroll 1
        for (int st = 0; st < 4; ++st) { const int sb = dir == 0 ? st : 3 - st;
            int lane_o = F.lane; asm volatile("" : "+v"(lane_o)); const int r16 = lane_o & 15, kg = lane_o >> 4;
#pragma unroll
            for (int db = 0; db < 2; ++db)
#pragma unroll
                for (int nb = 0; nb < 4; ++nb) { u32x2 w; w.x = pk2(Sr[db][nb][0], Sr[db][nb][1]); w.y = pk2(Sr[db][nb][2], Sr[db][nb][3]); *(LAS u32x2*)(wl + GL_ST + ((16 * nb + r16) * 40 + 16 * db + 4 * kg) * 2) = w; }
            { GlaIn in; gla_sub_load<true>(F, b, h, dir, 64 * c + 16 * sb, in); gla_sub_prep<true>(F, dir, in, wl, ltot); }
            const bf16x8 bq = *(const LAS bf16x8*)(wl + GL_QT + (r16 * 40 + 8 * kg) * 2);
            { const bf16x8 ka = *(const LAS bf16x8*)(wl + GL_KT + (r16 * 40 + 8 * kg) * 2);
              f32x4 p = MFMA16(ka, bq, ((f32x4){0.f, 0.f, 0.f, 0.f}));
#pragma unroll
              for (int i = 0; i < 4; ++i) { const int sidx = 4 * kg + i; const bool keep = dir == 0 ? (sidx <= r16) : (sidx >= r16); p[i] = keep ? p[i] : 0.f; }
              u32x2 w; w.x = pk2(p[0], p[1]); w.y = pk2(p[2], p[3]); *(LAS u32x2*)(wl + GL_PT + (r16 * 24 + 4 * kg) * 2) = w; }
            bf16x8 pb = *(const LAS bf16x8*)(wl + GL_PT + (r16 * 24 + 8 * (kg & 1)) * 2); if (kg >= 2) pb = zf;
            f32x4 o[4];
#pragma unroll
            for (int nb = 0; nb < 4; ++nb) { const bf16x8 sa = *(const LAS bf16x8*)(wl + GL_ST + ((16 * nb + r16) * 40 + 8 * kg) * 2);
                bf16x8 va = *(const LAS bf16x8*)(wl + GL_VT + ((16 * nb + r16) * 24 + 8 * (kg & 1)) * 2); if (kg >= 2) va = zf;
                o[nb] = MFMA16(sa, bq, ((f32x4){0.f, 0.f, 0.f, 0.f})); o[nb] = MFMA16(va, pb, o[nb]); }
            if (dir == 0) { u32x2 t[4];
#pragma unroll
                for (int nb = 0; nb < 4; ++nb) { t[nb].x = pk2(o[nb][0], o[nb][1]); t[nb].y = pk2(o[nb][2], o[nb][3]); }
#define OF_PUT(k) { _Pragma("unroll") for (int nb = 0; nb < 4; ++nb) of[k][nb] = t[nb]; }
                if (sb == 0) OF_PUT(0) else if (sb == 1) OF_PUT(1) else if (sb == 2) OF_PUT(2) else OF_PUT(3)
#undef OF_PUT
            }
            else { float ss = 0.f; u32x2 t[4];
#define OF_GET(k) { _Pragma("unroll") for (int nb = 0; nb < 4; ++nb) t[nb] = of[k][nb]; }
                if (sb == 0) OF_GET(0) else if (sb == 1) OF_GET(1) else if (sb == 2) OF_GET(2) else OF_GET(3)
#undef OF_GET
#pragma unroll
                for (int nb = 0; nb < 4; ++nb) { o[nb][0] += bflo(t[nb].x); o[nb][1] += bfhi(t[nb].x); o[nb][2] += bflo(t[nb].y); o[nb][3] += bfhi(t[nb].y); ss += (o[nb][0] * o[nb][0] + o[nb][1] * o[nb][1]) + (o[nb][2] * o[nb][2] + o[nb][3] * o[nb][3]); }
                ss += __shfl_xor(ss, 16); ss += __shfl_xor(ss, 32);
                const float rstd = rsqrtf(ss * (1.f / 64.f) + NORM_EPS); const int row = keyrow(b, 64 * c + 16 * sb + r16);
#pragma unroll
                for (int nb = 0; nb < 4; ++nb) { const int dv0 = 16 * nb + 4 * kg; const u32x2 gg = *(const u32x2*)(U + (size_t)row * NU + UC_GG + h * 64 + dv0); const f32x4 nw = *(const f32x4*)(Pk->in[I_GNW] + l * 64 + dv0);
                    const float y0 = o[nb][0] * rstd * nw[0] * silu_f(bflo(gg.x)), y1 = o[nb][1] * rstd * nw[1] * silu_f(bfhi(gg.x)), y2 = o[nb][2] * rstd * nw[2] * silu_f(bflo(gg.y)), y3 = o[nb][3] * rstd * nw[3] * silu_f(bfhi(gg.y));
                    if (WOUT_F8) *(unsigned*)(MIX + ((size_t)row * D + h * 64 + dv0)) = pk4_f8(y0, y1, y2, y3);
                    else { u32x2 w; w.x = pk2(y0, y1); w.y = pk2(y2, y3); *(u32x2*)(MIX + ((size_t)row * D + h * 64 + dv0) * 2) = w; } } }
            if (st < 3) gla_state_update(F, wl, Sr);
        }
    }
}
__device__ __forceinline__ void prep_qk_row(KP Pk, Frame& F, int l, int row) {
    unsigned char* ws = F.ws;
    bf16_t* U = (bf16_t*)(ws + WS_U) + (size_t)row * NU;
    const bool lat = row < TL; const int t = row & (SEQ - 1), f = F.lane & 15;
    float cs = 1.f, sn = 0.f;
    if (lat) { const float* rp = (const float*)(ws + WS_ROPE) + (size_t)t * 64 + (F.lane < 32 ? 0 : 32); cs = rp[f]; sn = rp[16 + f]; if (!(F.lane & 16)) sn = -sn; }
    const float wsq = Pk->in[I_SQN][l * 64 + F.lane], wsk = Pk->in[I_SKN][l * 64 + F.lane], wdq = Pk->in[I_DQN][l * 64 + F.lane], wdk = Pk->in[I_DKN][l * 64 + F.lane];
    const float qs = 0.125f * LOG2E;
    float xs[26];
#pragma unroll
    for (int v = 0; v < 26; ++v) { const int c0 = v < 8 ? UC_SQ + 64 * v : v < 10 ? UC_SK + 64 * (v - 8) : v < 18 ? UC_DQ + 64 * (v - 10) : UC_DK + 64 * (v - 18); xs[v] = bf2f(U[c0 + F.lane]); }
#pragma unroll
    for (int v = 0; v < 26; ++v) {
        int c0; float w;
        if (v < 8) { c0 = UC_SQ + 64 * v; w = wsq * qs; } else if (v < 10) { c0 = UC_SK + 64 * (v - 8); w = wsk; } else if (v < 18) { c0 = UC_DQ + 64 * (v - 10); w = wdq * qs; } else { c0 = UC_DK + 64 * (v - 18); w = wdk; }
        const float x = xs[v];
        const float y = x * rsqrtf(wave_sum(x * x) * (1.f / 64.f) + NORM_EPS) * w;
        const float yp = __shfl_xor(y, 16);
        U[c0 + F.lane] = (bf16_t)f2bf(y * cs + yp * sn);
    }
}
template <bool PERMK, int NCOLS, class SRC>
__device__ __forceinline__ void tile_transpose(LAS unsigned char* wl, int lane, bf16_t* dst, size_t dst_stride, const SRC& src) {
    LAS unsigned* tl = (LAS unsigned*)wl;
    constexpr int ncols = NCOLS, cpr = NCOLS / 8;
    LDS_WAIT(); asm volatile("" ::: "memory");
#pragma unroll 1
    for (int k0 = 0; k0 < cpr; k0 += 4) { u32x4 v[4];
#pragma unroll
      for (int k = 0; k < 4; ++k) { const int id = lane + 64 * (k0 + k); v[k] = src(id / cpr, id % cpr); }
#pragma unroll
      for (int k = 0; k < 4; ++k) { const int id = lane + 64 * (k0 + k); LAS unsigned* p = tl + (id / cpr) * 65 + (id % cpr) * 4; p[0] = v[k].x; p[1] = v[k].y; p[2] = v[k].z; p[3] = v[k].w; } }
    LDS_WAIT(); asm volatile("" ::: "memory");
    const LAS unsigned short* ts = (const LAS unsigned short*)wl;
    const int cc = lane & 7;
    for (int dv = lane >> 3; dv < ncols; dv += 8) {
        unsigned short e[8];
#pragma unroll
        for (int i = 0; i < 8; ++i) { const int p = 8 * cc + i, srow = PERMK ? ((p & ~15) + perm16(p & 15)) : p; e[i] = ts[srow * 130 + dv]; }
        u32x4 o; o.x = e[0] | ((unsigned)e[1] << 16); o.y = e[2] | ((unsigned)e[3] << 16); o.z = e[4] | ((unsigned)e[5] << 16); o.w = e[6] | ((unsigned)e[7] << 16);
        *(u32x4*)(dst + (size_t)dv * dst_stride + 8 * cc) = o; }
}
__device__ __forceinline__ void ph_prep(KP Pk, Frame& F, int l, int rep) {
    unsigned char* ws = F.ws;
    const int gw = F.vcu * NWAVES + F.wave, NGW = F.G * NWAVES;
    LAS unsigned char* wl = F.lds + F.wave * WAVE_LDS;
    const bf16_t* U = (const bf16_t*)(ws + WS_U);
    const int n_gla = 128 * NGRP, n_hy = NB * (l == 0 ? 36 : 32) * 12, n_vd = NB * 4 * 36, n_vs = NB * 2 * 36, n_rows = rep ? 0 : TT / 4;
    if (gw < n_gla) { gla_pass_a(Pk, F, l, gw, wl); }
    const int total = n_hy + n_vd + n_vs + n_rows, nrest = NGW - n_gla;
    for (int it0 = gw - n_gla; it0 < total && gw >= n_gla; it0 += nrest) {
        int it = it0;
        if (it < n_hy) {
            const int ntile = l == 0 ? 36 : 32, b = it / (ntile * 12), r = it % (ntile * 12), tile = r / 12, cb = r % 12, c0 = cb * 128;
            const bool lat = tile < 32; const int p0 = lat ? 64 * tile : 64 * (tile - 32), Ls = lat ? SEQ : LC, rbase = lat ? b * SEQ : TL + b * LC;
            const float* cw = Pk->in[I_HCW] + (size_t)l * 3 * 1536 + c0 + (F.lane & 15) * 8; const float* cbias = Pk->in[I_HCB] + (size_t)l * 1536 + c0 + (F.lane & 15) * 8;
            float w0[8], w1[8], w2[8], wb[8];
#pragma unroll
            for (int k = 0; k < 8; ++k) { w0[k] = cw[k]; w1[k] = cw[1536 + k]; w2[k] = cw[3072 + k]; wb[k] = cbias[k]; }
            auto src = [&](int i, int ch) -> u32x4 { const int p = p0 + i; const bf16_t* up = U + (size_t)(rbase + p) * NU + UC_HY + c0 + ch * 8;
                const u32x4 m = *(const u32x4*)up; u32x4 a = {0u, 0u, 0u, 0u}, c = {0u, 0u, 0u, 0u};
                if (p > 0) a = *(const u32x4*)(up - NU); if (p + 1 < Ls) c = *(const u32x4*)(up + NU);
                const unsigned av[4] = {a.x, a.y, a.z, a.w}, mv[4] = {m.x, m.y, m.z, m.w}, cv[4] = {c.x, c.y, c.z, c.w}; unsigned o[4];
#pragma unroll
                for (int q = 0; q < 4; ++q) { const int k = 2 * q;
                    const float z0 = bflo(av[q]) * w0[k] + bflo(mv[q]) * w1[k] + bflo(cv[q]) * w2[k] + wb[k];
                    const float z1 = bfhi(av[q]) * w0[k + 1] + bfhi(mv[q]) * w1[k + 1] + bfhi(cv[q]) * w2[k + 1] + wb[k + 1];
                    o[q] = pk2(z0, z1); }
                return (u32x4){o[0], o[1], o[2], o[3]}; };
            tile_transpose<false, 128>(wl, F.lane, (bf16_t*)(ws + WS_ZT) + ((size_t)b * 1536 + c0) * KEYS + (lat ? p0 : SEQ + p0), KEYS, src);
            continue; } it -= n_hy;
        if (it < n_vd) {
            const int b = it / 144, r = it % 144, h = r / 36, tile = r % 36;
            auto src = [&](int i, int ch) -> u32x4 { return *(const u32x4*)(U + (size_t)keyrow(b, 64 * tile + i) * NU + UC_DV + h * 128 + ch * 8); };
            tile_transpose<true, 128>(wl, F.lane, (bf16_t*)(ws + WS_VTD) + ((size_t)(b * 4 + h) * 128) * KEYS + 64 * tile, KEYS, src);
            continue; } it -= n_vd;
        if (it < n_vs) {
            const int b = it / 72, r = it % 72, h = r / 36, tile = r % 36;
            auto src = [&](int i, int ch) -> u32x4 { return *(const u32x4*)(U + (size_t)keyrow(b, 64 * tile + i) * NU + UC_SV + h * 64 + ch * 8); };
            tile_transpose<true, 64>(wl, F.lane, (bf16_t*)(ws + WS_VTS) + ((size_t)(b * 2 + h) * 64) * KEYS + 64 * tile, KEYS, src);
            continue; } it -= n_vs;
        for (int q = 0; q < 4; ++q) prep_qk_row(Pk, F, l, it * 4 + q);
    }
}
__device__ __forceinline__ void ph_gla_scan(Frame& F) {
    unsigned char* ws = F.ws;
    const int gw = F.vcu * NWAVES + F.wave, NGW = F.G * NWAVES;
    for (int it = gw; it < 128 * 32; it += NGW) { const int seq = it >> 5, d = it & 31;
        const float* sl = (const float*)(ws + WS_GSL) + (size_t)seq * NCH * 2048 + d * 64 + F.lane; float* ss = (float*)(ws + WS_GSS) + (size_t)seq * NCH * 2048 + d * 64 + F.lane;
        const float* ae = (const float*)(ws + WS_GAE) + (size_t)seq * NCH * 32 + d;
        float x[NCH], a[NCH];
#pragma unroll
        for (int c = 0; c < NCH; ++c) { x[c] = sl[(size_t)c * 2048]; a[c] = ae[c * 32]; }
        float S = 0.f;
#pragma unroll
        for (int c = 0; c < NCH; ++c) { ss[(size_t)c * 2048] = S; S = a[c] * S + x[c]; }
    }
}

__device__ __forceinline__ int crow(int r, int hi) { return (r & 3) + 8 * (r >> 2) + 4 * hi; }
template <int KW, int DV, bool MASK>
__device__ __forceinline__ void attn_core(Frame& F, const bf16_t* U, int b, int kcol0, const bf16_t* VT, int nctx, int nloc, int loc0,
                                          const bf16x8 (&q)[4], int koff, int qpos0, float sh2, f32x16 (&O)[DV / 32], float& lsum) {
    constexpr int KRB = KW * 2, KB = 64 * KRB, VB = DV * 128, SLOT = KB + VB, NKC = KB / 8192, NVC = VB / 8192, NDMA = NKC + NVC;
    const int r32 = F.lane & 31, hi = F.lane >> 5, nt = nctx + nloc;
#define ATT_DMA(ti) do { const int _k0 = (ti) < nctx ? 64 * (ti) : loc0 + 64 * ((ti) - nctx); LAS unsigned char* _sl = F.lds + ((ti) & 3) * SLOT; \
        _Pragma("unroll") for (int _j = 0; _j < NKC; ++_j) { const int _ch = F.wave + 8 * _j; int _row, _c; \
            if (KW == 128) { _row = 4 * _ch + (F.lane >> 4); _c = (F.lane & 15) ^ (_row & 15); } else { _row = 8 * _ch + (F.lane >> 3); _c = (F.lane & 7) ^ ((_row >> 1) & 7); } \
            __builtin_amdgcn_global_load_lds((const unsigned*)(U + (size_t)keyrow(b, _k0 + _row) * NU + kcol0 + _c * 8), (LAS unsigned*)(_sl + _ch * 1024), 16, 0, 0); } \
        _Pragma("unroll") for (int _j = 0; _j < NVC; ++_j) { const int _ch = F.wave + 8 * _j, _row = 8 * _ch + (F.lane >> 3), _c = (F.lane & 7) ^ ((_row >> 1) & 7); \
            __builtin_amdgcn_global_load_lds((const unsigned*)(VT + (size_t)_row * KEYS + _k0 + _c * 8), (LAS unsigned*)(_sl + KB + _ch * 1024), 16, 0, 0); } } while (0)
    f32x16 s0, s1; bf16x8 pa[4];
#define DSR(dst, addr, off) asm volatile("ds_read_b128 %0, %1 offset:%2" : "=v"(dst) : "v"(addr), "n"(off))
#define LWAIT4(f) asm volatile("s_waitcnt lgkmcnt(0)" : "+v"(f[0]), "+v"(f[1]), "+v"(f[2]), "+v"(f[3]))
    unsigned kad[4], vad[4];
#pragma unroll
    for (int i = 0; i < 4; ++i) { const int c = 2 * i + hi;
        kad[i] = (unsigned)(uintptr_t)F.lds + (KW == 128 ? r32 * 256 + ((((koff >> 3) + c) ^ (r32 & 15)) << 4) : r32 * 128 + ((c ^ ((r32 >> 1) & 7)) << 4));
        vad[i] = (unsigned)(uintptr_t)F.lds + KB + r32 * 128 + ((c ^ ((r32 >> 1) & 7)) << 4); }
    __syncthreads();
    ATT_DMA(0);
    if (nt > 1) ATT_DMA(1);
    if (nt > 2) ATT_DMA(2);
    if (nt > 2) asm volatile("s_waitcnt vmcnt(%0)" :: "n"(NDMA) : "memory"); else asm volatile("s_waitcnt vmcnt(0)" ::: "memory");
    __syncthreads();
#define EXP1(ti, r) do { s0[r] = __builtin_amdgcn_exp2f(s0[r]); s1[r] = __builtin_amdgcn_exp2f(s1[r]); \
        if (MASK && (ti) >= nctx) { const int k0 = loc0 - LC + 64 * ((ti) - nctx) + crow(r, hi), k1 = k0 + 32, d0 = qpos0 + r32 - k0, d1 = d0 - 32; \
            if (k0 < 0 || k0 >= SEQ || d0 > 128 || d0 < -128) s0[r] = 0.f; if (k1 < 0 || k1 >= SEQ || d1 > 128 || d1 < -128) s1[r] = 0.f; } } while (0)
#define RD_K(f, h) do { DSR(f[0], ka[2 * (h)], 0); DSR(f[1], ka[2 * (h)], 32 * KRB); DSR(f[2], ka[2 * (h) + 1], 0); DSR(f[3], ka[2 * (h) + 1], 32 * KRB); } while (0)
#define RD_V(f, nb) do { DSR(f[0], va[0], (nb) * 4096); DSR(f[1], va[1], (nb) * 4096); DSR(f[2], va[2], (nb) * 4096); DSR(f[3], va[3], (nb) * 4096); } while (0)
#define SB() __builtin_amdgcn_sched_barrier(0)
#define PKW(S, B) pg8::cvt_pk_bf16(S[B], S[(B) + 1])
#define PV1(f, nb, kk, ti, R0, NE) do { O[nb] = MFMA32(pa[kk], f[kk], O[nb]); if (more) { _Pragma("unroll") for (int _r = 0; _r < (NE); ++_r) EXP1(ti, (R0) + _r); } SB(); } while (0)
    {
        bf16x8 fa[4], fb[4]; unsigned ka[4];
#pragma unroll
        for (int i = 0; i < 4; ++i) ka[i] = kad[i];
        RD_K(fa, 0); RD_K(fb, 1);
#pragma unroll
        for (int r = 0; r < 16; ++r) { s0[r] = -sh2; s1[r] = -sh2; }
        LWAIT4(fa); LWAIT4(fb);
        s0 = MFMA32(fa[0], q[0], s0); s1 = MFMA32(fa[1], q[0], s1); s0 = MFMA32(fa[2], q[1], s0); s1 = MFMA32(fa[3], q[1], s1);
        s0 = MFMA32(fb[0], q[2], s0); s1 = MFMA32(fb[1], q[2], s1); s0 = MFMA32(fb[2], q[3], s0); s1 = MFMA32(fb[3], q[3], s1);
#pragma unroll
        for (int r = 0; r < 16; ++r) EXP1(0, r);
    }
#define ATT_STEP(MORE) { \
        constexpr bool more = (MORE); \
        if (t + 3 < nt) ATT_DMA(t + 3); \
        unsigned ka[4], va[4]; \
        { int lo_ = F.lane; asm volatile("" : "+v"(lo_)); const int rr = lo_ & 31, hh = lo_ >> 5; \
        _Pragma("unroll") \
          for (int i = 0; i < 4; ++i) { const int c = 2 * i + hh; \
            ka[i] = (unsigned)(uintptr_t)F.lds + ((t + 1) & 3) * SLOT + (KW == 128 ? rr * 256 + ((((koff >> 3) + c) ^ (rr & 15)) << 4) : rr * 128 + ((c ^ ((rr >> 1) & 7)) << 4)); \
            va[i] = (unsigned)(uintptr_t)F.lds + (t & 3) * SLOT + KB + rr * 128 + ((c ^ ((rr >> 1) & 7)) << 4); } } \
        bf16x8 fa[4], fb[4]; \
        if (more) { RD_K(fa, 0); RD_K(fb, 1); } else { RD_V(fa, 0); } \
        SB(); \
 \
        { float ps = 0.f; \
        _Pragma("unroll") \
          for (int r = 0; r < 16; ++r) ps += s0[r] + s1[r]; \
          lsum += ps; \
          u32x4 w; \
          w.x = PKW(s0, 0); w.y = PKW(s0, 2); w.z = PKW(s0, 4); w.w = PKW(s0, 6); pa[0] = __builtin_bit_cast(bf16x8, w); \
          w.x = PKW(s0, 8); w.y = PKW(s0, 10); w.z = PKW(s0, 12); w.w = PKW(s0, 14); pa[1] = __builtin_bit_cast(bf16x8, w); \
          w.x = PKW(s1, 0); w.y = PKW(s1, 2); w.z = PKW(s1, 4); w.w = PKW(s1, 6); pa[2] = __builtin_bit_cast(bf16x8, w); \
          w.x = PKW(s1, 8); w.y = PKW(s1, 10); w.z = PKW(s1, 12); w.w = PKW(s1, 14); pa[3] = __builtin_bit_cast(bf16x8, w); } \
        if (more) { \
        _Pragma("unroll") \
            for (int r = 0; r < 16; ++r) { s0[r] = -sh2; s1[r] = -sh2; } \
        } \
        SB(); \
        if (more) { \
            LWAIT4(fa); LWAIT4(fb); \
            s0 = MFMA32(fa[0], q[0], s0); s1 = MFMA32(fa[1], q[0], s1); s0 = MFMA32(fa[2], q[1], s0); s1 = MFMA32(fa[3], q[1], s1); \
            SB(); RD_V(fa, 0); SB(); \
            s0 = MFMA32(fb[0], q[2], s0); s1 = MFMA32(fb[1], q[2], s1); s0 = MFMA32(fb[2], q[3], s0); s1 = MFMA32(fb[3], q[3], s1); \
            SB(); \
        } \
        LWAIT4(fa); RD_V(fb, 1); SB(); \
        if (DV == 128) { \
            PV1(fa, 0, 0, t + 1, 0, 1); PV1(fa, 0, 1, t + 1, 1, 1); PV1(fa, 0, 2, t + 1, 2, 1); PV1(fa, 0, 3, t + 1, 3, 1); \
            LWAIT4(fb); RD_V(fa, 2); SB(); \
            PV1(fb, 1, 0, t + 1, 4, 1); PV1(fb, 1, 1, t + 1, 5, 1); PV1(fb, 1, 2, t + 1, 6, 1); PV1(fb, 1, 3, t + 1, 7, 1); \
            LWAIT4(fa); RD_V(fb, 3); SB(); \
            PV1(fa, 2, 0, t + 1, 8, 1); PV1(fa, 2, 1, t + 1, 9, 1); PV1(fa, 2, 2, t + 1, 10, 1); PV1(fa, 2, 3, t + 1, 11, 1); \
            LWAIT4(fb); SB(); \
            PV1(fb, 3, 0, t + 1, 12, 1); PV1(fb, 3, 1, t + 1, 13, 1); PV1(fb, 3, 2, t + 1, 14, 1); PV1(fb, 3, 3, t + 1, 15, 1); \
        } else { \
            PV1(fa, 0, 0, t + 1, 0, 2); PV1(fa, 0, 1, t + 1, 2, 2); PV1(fa, 0, 2, t + 1, 4, 2); PV1(fa, 0, 3, t + 1, 6, 2); \
            LWAIT4(fb); SB(); \
            PV1(fb, 1, 0, t + 1, 8, 2); PV1(fb, 1, 1, t + 1, 10, 2); PV1(fb, 1, 2, t + 1, 12, 2); PV1(fb, 1, 3, t + 1, 14, 2); \
        } \
        if (t + 3 < nt) asm volatile("s_waitcnt vmcnt(%0)" :: "n"(NDMA) : "memory"); else asm volatile("s_waitcnt vmcnt(0)" ::: "memory"); \
        __syncthreads(); \
    }
    int t = 0;
#pragma unroll 1
    for (; t + 1 < nt; ++t) ATT_STEP(true)
    ATT_STEP(false)
#undef ATT_STEP
#undef EXP1
#undef SB
#undef PKW
#undef PV1
#undef RD_K
#undef RD_V
#undef DSR
#undef LWAIT4
#undef ATT_DMA
}
__device__ __forceinline__ float score_bound(const float* wq, const float* wk, int lane) {
    float a = fabsf(wq[lane]), c = fabsf(wk[lane]);
#pragma unroll
    for (int o = 1; o < 64; o <<= 1) { a = fmaxf(a, __shfl_xor(a, o)); c = fmaxf(c, __shfl_xor(c, o)); }
    return 64.f * a * c * 0.125f * LOG2E;
}
__device__ __forceinline__ void diff_unit(KP Pk, Frame& F, int l, int b, int h, int qrow0, int nkt) {
    unsigned char* ws = F.ws;
    const bf16_t* U = (const bf16_t*)(ws + WS_U);
    const int m = F.wave & 1, rb = F.wave >> 1;
    const float sh2 = score_bound(Pk->in[I_DQN] + l * 64, Pk->in[I_DKN] + l * 64, F.lane);
    bf16x8 q[4];
    { const bf16_t* qp = U + (size_t)(qrow0 + 32 * rb + (F.lane & 31)) * NU + UC_DQ + h * 128 + m * 64 + 8 * (F.lane >> 5);
#pragma unroll
      for (int ks = 0; ks < 4; ++ks) q[ks] = *(const bf16x8*)(qp + 16 * ks); }
    f32x16 O[4];
#pragma unroll
    for (int nb = 0; nb < 4; ++nb) O[nb] = (f32x16){};
    float lsum = 0.f;
    attn_core<128, 128, false>(F, U, b, UC_DK + h * 128, (const bf16_t*)(ws + WS_VTD) + ((size_t)(b * 4 + h) * 128) * KEYS, nkt, 0, 0, q, 64 * m, 0, sh2, O, lsum);
    int ln_; asm volatile("v_mbcnt_lo_u32_b32 %0, -1, 0\n\tv_mbcnt_hi_u32_b32 %0, -1, %0" : "=v"(ln_));
    const int r32 = ln_ & 31, hi = ln_ >> 5;
    { int lo_ = l; asm volatile("" : "+s"(lo_)); l = lo_; Pk = kp_opaque(Pk); }
    lsum += __shfl_xor(lsum, 32);
    const float rl = 1.f / lsum;
    LAS float* ex = (LAS float*)F.lds + rb * 4096;
    float rlr[16];
#pragma unroll
    for (int r = 0; r < 16; ++r) rlr[r] = __shfl(rl, crow(r, hi));
    if (m == 1) {
#pragma unroll
        for (int nb = 0; nb < 4; ++nb)
#pragma unroll
            for (int r = 0; r < 16; ++r) ex[crow(r, hi) * 128 + nb * 32 + r32] = O[nb][r] * rlr[r];
    }
    __syncthreads();
    if (m == 0) {
        const float* dl = Pk->in[I_DLAM] + l * 256; const float lam_init = __builtin_bit_cast(float, __builtin_amdgcn_readfirstlane(__builtin_bit_cast(int, l == 0 ? 0.2f : (0.8f - 0.6f * 0.74081822068f))));
        const float lam = expf(wave_sum(dl[ln_] * dl[64 + ln_])) - expf(wave_sum(dl[128 + ln_] * dl[192 + ln_])) + lam_init;
        float ssq[16];
#pragma unroll
        for (int r = 0; r < 16; ++r) { float a = 0.f;
#pragma unroll
            for (int nb = 0; nb < 4; ++nb) { const float v = O[nb][r] * rlr[r] - lam * ex[crow(r, hi) * 128 + nb * 32 + r32]; O[nb][r] = v; a += v * v; }
            a += __shfl_xor(a, 1); a += __shfl_xor(a, 2); a += __shfl_xor(a, 4); a += __shfl_xor(a, 8); a += __shfl_xor(a, 16);
            ssq[r] = rsqrtf(a * (1.f / 128.f) + NORM_EPS) * (1.f - lam_init); }
        unsigned char* mix = ws + WS_H + ((size_t)(qrow0 + 32 * rb) * D + 1536 + h * 128) * MIXB;
#pragma unroll
        for (int nb = 0; nb < 4; ++nb) { const float w = Pk->in[I_DSUB][l * 128 + nb * 32 + r32];
#pragma unroll
            for (int r = 0; r < 16; ++r) { const float y = O[nb][r] * ssq[r] * w; const size_t e = (size_t)crow(r, hi) * D + nb * 32 + r32; if (WOUT_F8) mix[e] = f8_1(y); else ((bf16_t*)mix)[e] = (bf16_t)f2bf(y); } }
    }
}
__device__ __forceinline__ void swa_unit(KP Pk, Frame& F, int l, int b, int kvh, int qrow0, int qpos0, bool latent) {
    unsigned char* ws = F.ws;
    const bf16_t* U = (const bf16_t*)(ws + WS_U);
    const int hq = kvh * 4 + (F.wave & 3), rb = F.wave >> 2;
    const float sh2 = score_bound(Pk->in[I_SQN] + l * 64, Pk->in[I_SKN] + l * 64, F.lane);
    bf16x8 q[4];
    { const bf16_t* qp = U + (size_t)(qrow0 + 32 * rb + (F.lane & 31)) * NU + UC_SQ + hq * 64 + 8 * (F.lane >> 5);
#pragma unroll
      for (int ks = 0; ks < 4; ++ks) q[ks] = *(const bf16x8*)(qp + 16 * ks); }
    f32x16 O[2]; O[0] = (f32x16){}; O[1] = (f32x16){};
    float lsum = 0.f;
    int nloc = 0, loc0 = 0;
    if (latent) { int kp0 = qpos0 - 128, kp1 = qpos0 + 64 + 128; if (kp0 < 0) kp0 = 0; if (kp1 > SEQ) kp1 = SEQ; nloc = (kp1 - kp0) / 64; loc0 = LC + kp0; }
    const bf16_t* VT = (const bf16_t*)(ws + WS_VTS) + ((size_t)(b * 2 + kvh) * 64) * KEYS;
    attn_core<64, 64, true>(F, U, b, UC_SK + kvh * 64, VT, 4, nloc, loc0, q, 0, qpos0 + 32 * rb, sh2, O, lsum);
    int ln_; asm volatile("v_mbcnt_lo_u32_b32 %0, -1, 0\n\tv_mbcnt_hi_u32_b32 %0, -1, %0" : "=v"(ln_));
    const int r32 = ln_ & 31, hi = ln_ >> 5;
    { int lo_ = l; asm volatile("" : "+s"(lo_)); l = lo_; Pk = kp_opaque(Pk); }
    lsum += __shfl_xor(lsum, 32);
    const float rl = 1.f / (lsum + exp2f(Pk->in[I_SINK][l * 8 + hq] * LOG2E - sh2));
    unsigned char* mix = ws + WS_H + ((size_t)(qrow0 + 32 * rb) * D + 512 + hq * 64) * MIXB;
#pragma unroll
    for (int r = 0; r < 16; ++r) { const float rr = __shfl(rl, crow(r, hi));
#pragma unroll
        for (int nb = 0; nb < 2; ++nb) { const float y = O[nb][r] * rr; const size_t e = (size_t)crow(r, hi) * D + nb * 32 + r32; if (WOUT_F8) mix[e] = f8_1(y); else ((bf16_t*)mix)[e] = (bf16_t)f2bf(y); } }
}
constexpr int HY_PAD = 224, YSTR = 2504, HY_YB = 8 * YSTR * 2, HY_CST = 8224, HY_COP = 2 * HY_YB;
__device__ __forceinline__ void hyena_unit(KP Pk, Frame& F, int l, int cg) {
    unsigned char* ws = F.ws;
    const int r32 = F.lane & 31, hi = F.lane >> 5, bb = r32 >> 2, ib = r32 & 3;
    const bf16_t* ZT = (const bf16_t*)(ws + WS_ZT); bf16_t* OT = (bf16_t*)(ws + WS_OT);
    LAS unsigned char* cop = F.lds + HY_COP;
    const int nseq = l == 0 ? 2 : 1;
#pragma unroll 1
    for (int cs = 0; cs < 4 * nseq; ++cs) {
        const int ci = cs >> (nseq - 1), st = cs & (nseq - 1), ch = cg * 4 + ci, L = st == 0 ? SEQ : LC, nblk = L / 32, pos0 = st == 0 ? 0 : SEQ;
        __syncthreads();
        for (int id = F.tid; id < 8 * (L / 8 + 56); id += NTHR) { const int b = id / (L / 8 + 56), c = id % (L / 8 + 56);
            if (c < L / 8) *(LAS u32x4*)(F.lds + (b * YSTR + HY_PAD + 8 * c) * 2) = *(const u32x4*)(ZT + ((size_t)b * 1536 + 1024 + ch) * KEYS + pos0 + 8 * c);
            else { const int pc = c - L / 8, off = pc < 28 ? 8 * pc : HY_PAD + L + 8 * (pc - 28); const u32x4 z = {0u, 0u, 0u, 0u};
                *(LAS u32x4*)(F.lds + (b * YSTR + off) * 2) = z; *(LAS u32x4*)(F.lds + HY_YB + (b * YSTR + off) * 2) = z; } }
#pragma unroll 1
        for (int o = 0; o < 2; ++o) {
            const bf16_t* R = (const bf16_t*)(ws + WS_HYF) + ((size_t)l * 1024 + o * 512 + ch) * 4608 + (st == 0 ? 0 : 4096);
            for (int xc = F.tid; xc < 2 * L / 8; xc += NTHR) { const u32x4 lo = *(const u32x4*)(R + 8 * xc); u32x4 hh = {0u, 0u, 0u, 0u}; if (8 * xc + 8 < 2 * L) hh = *(const u32x4*)(R + 8 * xc + 8);
                const unsigned w[9] = {lo.x, lo.y, lo.z, lo.w, hh.x, hh.y, hh.z, hh.w, 0u};
#pragma unroll
                for (int r = 0; r < 8; ++r) { u32x4 ov; unsigned t[4];
#pragma unroll
                    for (int k = 0; k < 4; ++k) t[k] = (r & 1) ? ((w[(r >> 1) + k] >> 16) | (w[(r >> 1) + k + 1] << 16)) : w[(r >> 1) + k];
                    ov.x = t[0]; ov.y = t[1]; ov.z = t[2]; ov.w = t[3]; *(LAS u32x4*)(cop + r * HY_CST + 16 * xc) = ov; } }
            __syncthreads();
            const LAS unsigned char* Yin = F.lds + (o == 0 ? 0 : HY_YB); LAS unsigned char* Yout = F.lds + (o == 0 ? HY_YB : 0);
            const float bias = Pk->in[I_HBIAS][(l * 2 + o) * 512 + ch];
            if (2 * F.wave < nblk / 4) {
                const int g0 = 2 * F.wave, dlo = 4 * g0 - nblk + 1, dhi = min(4 * g0 + 7, nblk - 1), nsteps = dhi - dlo + 1;
                const LAS unsigned char* ap = cop + ((-r32) & 7) * HY_CST + ((L - 32 * dlo - r32 + 8 * hi) & ~7) * 2;
                const LAS unsigned char* bp = Yin + (bb * YSTR + HY_PAD + 32 * (4 * g0 + ib - dlo) + 8 * hi) * 2;
                f32x16 acc0 = {}, acc1 = {};
#define HDSR(dst, addr, off) asm volatile("ds_read_b128 %0, %1 offset:%2" : "=v"(dst) : "v"(addr), "n"(off))
#define HWAIT(a, b, c, d) asm volatile("s_waitcnt lgkmcnt(0)" : "+v"(a), "+v"(b), "+v"(c), "+v"(d))
                bf16x8 R[6][2], A2[2][2];
                const unsigned apa = (unsigned)(uintptr_t)ap, bpa = (unsigned)(uintptr_t)bp;
                HDSR(R[2][0], bpa, 256); HDSR(R[2][1], bpa, 256 + 32); HDSR(R[3][0], bpa, 192); HDSR(R[3][1], bpa, 192 + 32);
                HDSR(R[4][0], bpa, 128); HDSR(R[4][1], bpa, 128 + 32); HDSR(R[5][0], bpa, 64); HDSR(R[5][1], bpa, 64 + 32);
                HDSR(R[0][0], bpa, 0); HDSR(R[0][1], bpa, 32); HDSR(A2[0][0], apa, 0); HDSR(A2[0][1], apa, 32);
                HWAIT(R[2][0], R[2][1], R[3][0], R[3][1]); HWAIT(R[4][0], R[4][1], R[5][0], R[5][1]); HWAIT(R[0][0], R[0][1], A2[0][0], A2[0][1]);
#pragma unroll 1
                for (int s0 = 0; s0 < nsteps; s0 += 6) {
                    const unsigned an = apa - (unsigned)(s0 + 6) * 64u, bn = bpa - (unsigned)(s0 + 6) * 64u;
#pragma unroll
                    for (int j = 0; j < 6; ++j) if (s0 + j < nsteps) {
                        if (s0 + j + 1 < nsteps) { HDSR(A2[(j + 1) & 1][0], an, (5 - j) * 64); HDSR(A2[(j + 1) & 1][1], an, (5 - j) * 64 + 32);
                            HDSR(R[(j + 1) % 6][0], bn, (5 - j) * 64); HDSR(R[(j + 1) % 6][1], bn, (5 - j) * 64 + 32); }
                        acc1 = MFMA32(A2[j & 1][0], R[(j + 2) % 6][0], acc1); acc0 = MFMA32(A2[j & 1][0], R[j][0], acc0);
                        acc1 = MFMA32(A2[j & 1][1], R[(j + 2) % 6][1], acc1); acc0 = MFMA32(A2[j & 1][1], R[j][1], acc0);
                        HWAIT(A2[(j + 1) & 1][0], A2[(j + 1) & 1][1], R[(j + 1) % 6][0], R[(j + 1) % 6][1]); }
                }
#undef HDSR
#undef HWAIT
#pragma unroll
                for (int gg = 0; gg < 2; ++gg) { const f32x16& acc = gg == 0 ? acc0 : acc1;
                    const int t0 = 32 * (4 * (g0 + gg) + ib) + 4 * hi;
                    const bf16_t* gp = ZT + ((size_t)bb * 1536 + o * 512 + ch) * KEYS + pos0 + t0;
#pragma unroll
                    for (int q = 0; q < 4; ++q) { const u32x2 yo = *(const LAS u32x2*)(Yin + (bb * YSTR + HY_PAD + t0 + 8 * q) * 2); const u32x2 gt = *(const u32x2*)(gp + 8 * q);
                        const float v0 = bflo(gt.x) * (acc[4 * q + 0] + bflo(yo.x) * bias), v1 = bfhi(gt.x) * (acc[4 * q + 1] + bfhi(yo.x) * bias);
                        const float v2 = bflo(gt.y) * (acc[4 * q + 2] + bflo(yo.y) * bias), v3 = bfhi(gt.y) * (acc[4 * q + 3] + bfhi(yo.y) * bias);
                        u32x2 ov; ov.x = pk2(v0, v1); ov.y = pk2(v2, v3);
                        if (o == 0) *(LAS u32x2*)(Yout + (bb * YSTR + HY_PAD + t0 + 8 * q) * 2) = ov;
                        else *(u32x2*)(OT + ((size_t)bb * 512 + ch) * KEYS + pos0 + t0 + 8 * q) = ov; } }
            }
            __syncthreads();
        }
    }
    VM_WAIT(); __syncthreads();
    const int npos = l == 0 ? KEYS : SEQ;
    for (int id = F.tid; id < 8 * npos; id += NTHR) { const int b = id / npos, pos = id % npos, row = pos < SEQ ? b * SEQ + pos : TL + b * LC + (pos - SEQ);
        const bf16_t* op = OT + ((size_t)b * 512 + cg * 4) * KEYS + pos;
        if (WOUT_F8) *(unsigned*)(ws + WS_H + (size_t)row * D + 1024 + cg * 4) = pk4_f8(bf2f(op[0]), bf2f(op[KEYS]), bf2f(op[2 * KEYS]), bf2f(op[3 * KEYS]));
        else { u32x2 ov; ov.x = (unsigned)op[0] | ((unsigned)op[KEYS] << 16); ov.y = (unsigned)op[2 * KEYS] | ((unsigned)op[3 * KEYS] << 16); *(u32x2*)((bf16_t*)(ws + WS_H) + (size_t)row * D + 1024 + cg * 4) = ov; } }
}
#ifndef MX_MASK
#define MX_MASK 15
#endif
#ifndef PROBE_MX
#define PROBE_MX 0
#endif
__device__ __forceinline__ void ph_mixers(KP Pk, Frame& F, int l, int qid) {
    const int n_diff = 512, n_hy = 128, n_dctx = l == 0 ? 64 : 0, n_swa = 512, n_sctx = l == 0 ? 64 : 0, gpb = l == 0 ? 5 : 4, n_gla = 64 * gpb;
    constexpr int R0 = 1 + ((PROBE_MX >> 0) & 1), R1 = 1 + ((PROBE_MX >> 1) & 1), R2 = 1 + ((PROBE_MX >> 2) & 1), R3 = 1 + ((PROBE_MX >> 3) & 1);
    const int n_mix = R0 * (n_diff + n_dctx) + R1 * n_hy + R2 * (n_swa + n_sctx) + R3 * n_gla + (l == 0 ? 96 + 128 : 0);
    const int n_titems = 16 * TI_GU + 16 * TI_DN + TI_WOUT + (l == 0 ? TI_WIN + TI_WA : 0), NTU = (n_titems + 127) / 128;
    const int total = n_mix + NTU, tplaced = min(NTU, total / 4);
    for (;;) {
        const int s_ = wg_grab(F, qid); if (s_ >= total) break;
        int u = s_ - min(NTU, s_ / 4), tu = -1;
        if ((s_ & 3) == 3 && (s_ >> 2) < NTU) tu = s_ >> 2; else if (u >= n_mix) tu = tplaced + (u - n_mix);
        if (tu >= 0) { LAS float* scr = (LAS float*)(F.lds + F.wave * 8704);
            for (int j = 0; j < 16; ++j) { int x = tu * 128 + F.wave * 16 + j; if (x >= n_titems) break;
                int it;
                if (x < 16 * TI_GU) it = 2 * TI_L + l * 16 * TI_GU + x;
                else if ((x -= 16 * TI_GU) < 16 * TI_DN) it = 2 * TI_L + 32 * TI_GU + l * 16 * TI_DN + x;
                else if ((x -= 16 * TI_DN) < TI_WOUT) it = l * TI_L + TI_WIN + TI_WA + x;
                else it = TI_L + (x - TI_WOUT);
                p0_item(Pk, F, it, scr); }
            goto mx_next; }
        if (l == 0) { if (u < 96) { ada_unit(Pk, F, 96 + u); goto mx_next; } u -= 96;
                      if (u < 128) { ph_hyena_filters(Pk, F, 128 + u); goto mx_next; } u -= 128; }
        if (u < R1 * n_hy) { u %= n_hy; if (MX_MASK & 2) hyena_unit(Pk, F, l, u); goto mx_next; } u -= R1 * n_hy;
        if (u < R0 * n_diff) { u %= n_diff; const int b = u >> 6, h = (u >> 4) & 3, qb = u & 15; if (MX_MASK & 1) diff_unit(Pk, F, l, b, h, b * SEQ + 128 * qb, 36); goto mx_next; } u -= R0 * n_diff;
        if (u < R0 * n_dctx) { u %= n_dctx; const int b = u >> 3, h = (u >> 1) & 3, qb = u & 1; if (MX_MASK & 1) diff_unit(Pk, F, l, b, h, TL + b * LC + 128 * qb, 4); goto mx_next; } u -= R0 * n_dctx;
        if (u < R2 * n_swa) { u %= n_swa; const int b = u >> 6, kvh = (u >> 5) & 1, qb = u & 31; if (MX_MASK & 4) swa_unit(Pk, F, l, b, kvh, b * SEQ + 64 * qb, 64 * qb, true); goto mx_next; } u -= R2 * n_swa;
        if (u < R2 * n_sctx) { u %= n_sctx; const int b = u >> 3, kvh = (u >> 2) & 1, qb = u & 3; if (MX_MASK & 4) swa_unit(Pk, F, l, b, kvh, TL + b * LC + 64 * qb, 64 * qb, false); goto mx_next; } u -= R2 * n_sctx;
        { u %= n_gla; const int bh = u / gpb, grp = u % gpb, c = (l == 0 ? 0 : 4) + grp * 8 + F.wave;
          __syncthreads();
          if ((MX_MASK & 8) && c < NCH) gla_pass_b(Pk, F, l, bh >> 3, bh & 7, c, F.lds + F.wave * WAVE_LDS);
        }
mx_next: ;
    }
}

constexpr int N_PHASES = 22;
#ifndef PH_MASK
#define PH_MASK 0xfffu
#endif
__global__ void __launch_bounds__(NTHR, 2) fwd_kernel(Params Parg) {
    extern __shared__ __attribute__((aligned(16))) unsigned char lds_raw[];
    const KP P0 = (KP)__builtin_amdgcn_kernarg_segment_ptr();
    Frame F;
    F.lds = (LAS unsigned char*)lds_raw; F.MISC = (volatile LAS unsigned*)(F.lds + LDS_MISC);
    const int wave_s = __builtin_amdgcn_readfirstlane((int)threadIdx.x >> 6);
#define TID_REFRESH() do { int t_; asm volatile("v_mbcnt_lo_u32_b32 %0, -1, 0\n\tv_mbcnt_hi_u32_b32 %0, -1, %0" : "=v"(t_)); F.lane = t_; F.wave = wave_s; F.tid = wave_s * 64 + t_; } while (0)
    TID_REFRESH();
    F.G = gridDim.x; { const int bx = blockIdx.x; F.vcu = (F.G % 8 == 0) ? (bx % 8) * (F.G / 8) + bx / 8 : bx; }
    F.ws = P0->ws; F.ctl = (unsigned*)(P0->ws + WS_CTL);
    for (int u = F.tid; u < 128; u += NTHR) F.MISC[u] = 0u;
    __syncthreads();
    const int lo = P0->ph_lo, hi = P0->ph_hi;
    const bool multi = hi - lo > 1;
    XcdBarrier bar; bar.bar = F.ctl + CW_BAR; bar.x = 0; bar.st = nullptr;
    if (multi) bar = xcd_barrier_post(F.ctl + CW_BAR, F.MISC + 8, F.tid);
#define INR(k) (lo <= (k) && (k) < hi)
#define IN(k, kind) (((PH_MASK >> (kind)) & 1u) && INR(k))
#define SEAM(k) do { if (INR(k) && INR((k) + 1)) { bar.bar = (unsigned*)(kp_opaque(P0)->ws + WS_CTL) + CW_BAR; TID_REFRESH(); xcd_barrier(bar, F.tid); } } while (0)
#ifndef PROBE_MASK
#define PROBE_MASK 0u
#endif
#define REP(kind) for (int rep_ = 0; rep_ < (((PROBE_MASK >> (kind)) & 1u) ? 2 : 1); ++rep_)
#define REP_SYNC(kind) do { if (((PROBE_MASK >> (kind)) & 1u) && rep_ == 0 && multi) { TID_REFRESH(); xcd_barrier(bar, F.tid); } } while (0)
#define PHASE_BEGIN() const KP Pk = kp_opaque(P0); unsigned char* ws = Pk->ws; F.ws = ws; F.ctl = (unsigned*)(ws + WS_CTL); \
    TID_REFRESH()
    if (IN(0, 0)) REP(0) { PHASE_BEGIN(); p0_prologue(Pk, F, rep_); REP_SYNC(0); } SEAM(0);
#pragma unroll 1
    for (int l = 0; l < DEPTH; ++l) {
        const int pb = 1 + 10 * l;
        if (IN(pb + 0, 1)) REP(1) { if (rep_ && l) break; PHASE_BEGIN(); if (l == 0) { for (int u = blockIdx.x; u < 128; u += F.G) ph_hyena_filters(Pk, F, u); } ph_norm1(Pk, F, l); REP_SYNC(1); } SEAM(pb + 0);
        if (IN(pb + 1, 2)) REP(2) { PHASE_BEGIN();
            pg8::Gemm g{(const bf16_t*)(ws + WS_H), (const bf16_t*)(ws + WS_WIN + (size_t)l * NU * D * 2), D, nullptr};
            pg8::RectOrder S; if (l == 0) S.init(72, 21, F.G, (int)blockIdx.x, 0, 0, 0ull); else S.init(64, 21, F.G, (int)blockIdx.x, 64, 64, 0x1413121108030201ull);
            pg8::EpiU E{(bf16_t*)(ws + WS_U), WIN_F8_L(l) ? 1.f / 32.f : 1.f};
            if (WIN_F8_L(l)) pg8::gemm_phase<pg8::EpiU, pg8::RectOrder, false, true>(F.lds, g, S, E, F.tid);
            else pg8::gemm_phase<pg8::EpiU, pg8::RectOrder, false, false>(F.lds, g, S, E, F.tid);
            if (WIN_F8_L(l)) ph_gate_cols8(F, l); else ph_gate_cols(F, l); REP_SYNC(2);
        } SEAM(pb + 1);
        if (IN(pb + 2, 3)) REP(3) { PHASE_BEGIN(); ph_prep(Pk, F, l, rep_); REP_SYNC(3); } SEAM(pb + 2);
        if (IN(pb + 4, 5)) REP(5) { PHASE_BEGIN(); ph_mixers(Pk, F, l, 1 + l + 2 * rep_); REP_SYNC(5); } SEAM(pb + 4);
        if (IN(pb + 5, 6)) REP(6) { if (rep_ && l) break; PHASE_BEGIN();
            pg8::Gemm g{(const bf16_t*)(ws + WS_H), (const bf16_t*)(ws + WS_WOUT + (size_t)l * D * D * MIXB), D, nullptr};
            pg8::RectOrder S; S.init(l == 0 ? 72 : 64, 8, F.G, (int)blockIdx.x, 0, 0, 0ull);
            pg8::EpiWout E{Pk->in[I_X], Pk->in[I_CTX], l == 0 ? (const bf16_t*)nullptr : (const bf16_t*)(ws + WS_X), (bf16_t*)(ws + WS_X), (const float*)(ws + WS_MOD) + (size_t)l * 9 * 12288};
            pg8::gemm_phase<pg8::EpiWout, pg8::RectOrder, false, WOUT_F8>(F.lds, g, S, E, F.tid); REP_SYNC(6);
        } SEAM(pb + 5);
        if (IN(pb + 6, 7)) REP(7) { PHASE_BEGIN(); ph_norm2_router(Pk, F, l, rep_); REP_SYNC(7); } SEAM(pb + 6);
        if (IN(pb + 7, 8)) { PHASE_BEGIN(); ph_slots(Pk, F, l); } SEAM(pb + 7);
        if (IN(pb + 8, 9)) REP(9) { PHASE_BEGIN();
            const int np = moe_table(F, l);
            pg8::Gemm g{(const bf16_t*)(ws + WS_H), (const bf16_t*)(ws + WS_WGU + (size_t)l * NE * 2048 * D), D, (const int*)(ws + WS_RT + RT_ROWTOK)};
            pg8::MoeOrder S{np, F.G, F.vcu, (const volatile LAS unsigned char*)(F.MISC + 64)};
            pg8::EpiMoe1 E{ws + WS_U};
            pg8::gemm_phase<pg8::EpiMoe1, pg8::MoeOrder, true, true>(F.lds, g, S, E, F.tid); REP_SYNC(9);
        } SEAM(pb + 8);
        if (IN(pb + 9, 10)) REP(10) { PHASE_BEGIN();
            const int np = moe_table(F, l);
            pg8::Gemm g{(const bf16_t*)(ws + WS_U), (const bf16_t*)(ws + WS_WD + (size_t)l * NE * D * DE), DE, nullptr};
            pg8::MoeOrder S{np, F.G, F.vcu, (const volatile LAS unsigned char*)(F.MISC + 64)};
            pg8::EpiMoe2 E{ws + WS_Y2, (const int*)(ws + WS_RT + RT_ROWTOK), (const float*)(ws + WS_RT + RT_ROWW)};
            pg8::gemm_phase<pg8::EpiMoe2, pg8::MoeOrder, false, true>(F.lds, g, S, E, F.tid); REP_SYNC(10);
        } SEAM(pb + 9);
    }
    if (IN(21, 11)) REP(11) { PHASE_BEGIN(); ph_final(Pk, F); REP_SYNC(11); }
#undef IN
#undef INR
#undef SEAM
#undef PHASE_BEGIN
#undef REP
#undef REP_SYNC
#undef TID_REFRESH
}

#ifndef MK_PER_PHASE
#define MK_PER_PHASE 0
#endif
extern "C" void kernel_launch(void* const* d_in, const int* in_sizes, int n_in, void* d_out, int out_size, void* d_ws, size_t ws_size, hipStream_t stream) {
    static int grid = 0;
    if (grid == 0) {
        if (n_in != 34 || in_sizes[0] != TL * D || out_size != TL * D || ws_size < WS_END) { fprintf(stderr, "kernel_launch: unexpected shapes (n_in %d, in0 %d, out %d, ws %zu < %zu)\n", n_in, n_in > 0 ? in_sizes[0] : -1, out_size, ws_size, (size_t)WS_END); grid = -1; return; }
        int dev = 0, cus = 0, per_cu = 0;
        if (hipGetDevice(&dev) != hipSuccess || hipDeviceGetAttribute(&cus, hipDeviceAttributeMultiprocessorCount, dev) != hipSuccess) { grid = -1; return; }
        if (hipFuncSetAttribute((const void*)fwd_kernel, hipFuncAttributeMaxDynamicSharedMemorySize, LDS_BYTES) != hipSuccess) { fprintf(stderr, "kernel_launch: hipFuncSetAttribute failed\n"); grid = -1; return; }
        if (hipOccupancyMaxActiveBlocksPerMultiprocessor(&per_cu, (const void*)fwd_kernel, NTHR, LDS_BYTES) != hipSuccess || per_cu < 1) fprintf(stderr, "kernel_launch: occupancy query reports %d\n", per_cu);
        (void)hipGetLastError();
        grid = cus;
    }
    if (grid < 0) return;
    (void)hipMemsetAsync((char*)d_ws + WS_CTL, 0, CTL_BYTES, stream);
    Params p{};
    for (int i = 0; i < 34; ++i) p.in[i] = (const float*)d_in[i];
    p.out = (float*)d_out; p.ws = (unsigned char*)d_ws;
#if MK_PER_PHASE
    for (int k = 0; k < N_PHASES; ++k) { p.ph_lo = k; p.ph_hi = k + 1; hipLaunchKernelGGL(fwd_kernel, dim3(grid), dim3(NTHR), LDS_BYTES, stream, p); }
#else
    p.ph_lo = 0; p.ph_hi = N_PHASES; hipLaunchKernelGGL(fwd_kernel, dim3(grid), dim3(NTHR), LDS_BYTES, stream, p);
#endif
    const hipError_t le = hipPeekAtLastError();
    if (le != hipSuccess) fprintf(stderr, "kernel_launch: launch failed: %s\n", hipGetErrorName(le));
}
```

```cpp
#include <hip/hip_runtime.h>
#include <cstdio>
#include <cstdint>

#define LAS __attribute__((address_space(3)))
#define GAS __attribute__((address_space(1)))
typedef unsigned short bf16_t;
typedef short bf16x8 __attribute__((ext_vector_type(8)));
typedef float f32x2 __attribute__((ext_vector_type(2)));
typedef float f32x4 __attribute__((ext_vector_type(4)));
typedef float f32x16 __attribute__((ext_vector_type(16)));
typedef unsigned u32x2 __attribute__((ext_vector_type(2)));
typedef unsigned u32x4 __attribute__((ext_vector_type(4)));
typedef int i32x4 __attribute__((ext_vector_type(4)));
typedef int i32x8 __attribute__((ext_vector_type(8)));

constexpr int D = 2048, NB = 8, SEQ = 2048, LC = 256, DEPTH = 2;
constexpr int TL = NB * SEQ, TCX = NB * LC, TT = TL + TCX;
constexpr int DIN = 5408, NU = 5376, NE = 16, DE = 1024;
constexpr int KEYS = LC + SEQ;
constexpr int UC_GQ = 0, UC_GK = 256, UC_GV = 512, UC_GG = 1024, UC_SQ = 1536, UC_SK = 2048, UC_SV = 2176, UC_HY = 2304, UC_DQ = 3840, UC_DK = 4352, UC_DV = 4864;
constexpr int MOE_ROWS = 2 * TT + NE * 256;
constexpr int MOE_PANELS = MOE_ROWS / 256;
constexpr int GCH = 64, NCH = KEYS / GCH;
constexpr float NORM_EPS = 1e-6f;
constexpr float LOG2E = 1.4426950408889634f;

constexpr size_t MiB = 1u << 20;
constexpr size_t WS_CTL = 0, CTL_BYTES = 1 * MiB;
constexpr size_t WS_MOD = 1 * MiB;
constexpr size_t WS_ROPE = 2 * MiB;
constexpr size_t WS_HYH2 = 3 * MiB;
constexpr size_t WS_WA = 5 * MiB;
constexpr size_t WS_RT = 6 * MiB;
constexpr size_t WS_AG = 7 * MiB;
constexpr size_t WS_HYF = 10 * MiB;
constexpr size_t WS_WIN = 28 * MiB;
constexpr size_t WS_WOUT = 70 * MiB;
constexpr size_t WS_WGU = 86 * MiB;
constexpr size_t WS_WD = 342 * MiB;
constexpr size_t WS_X = 470 * MiB;
constexpr size_t WS_H = 614 * MiB;
constexpr size_t WS_U = 686 * MiB;
constexpr size_t WS_B = 875 * MiB;
constexpr size_t WS_VTD = WS_B;
constexpr size_t WS_VTS = WS_B + 18 * MiB;
constexpr size_t WS_ZT = WS_B + 23 * MiB;
constexpr size_t WS_OT = WS_B + 77 * MiB;
constexpr size_t WS_GSL = WS_B + 95 * MiB;
constexpr size_t WS_GSS = WS_B + 131 * MiB;
constexpr size_t WS_GAE = WS_B + 167 * MiB;
constexpr size_t WS_Y2 = WS_B;
constexpr size_t WS_HB = 1043 * MiB;
constexpr size_t WS_END = 1115 * MiB;
constexpr int WIN_F8_MASK = 3;
#define WIN_F8_L(l) (((WIN_F8_MASK) >> (l)) & 1)
constexpr bool WOUT_F8 = true;
constexpr int MIXB = WOUT_F8 ? 1 : 2;
constexpr size_t RT_E = 0;
constexpr size_t RT_W = 128 * 1024;
constexpr size_t RT_ROWTOK = 320 * 1024;
constexpr size_t RT_ROWW = 512 * 1024;
constexpr int CW_BAR = 4096;
constexpr int CW_CNT = 16384;
constexpr int CW_CUR = 16384 + 256;
constexpr int CW_Q = 16384 + 1024;

constexpr int LDS_BYTES = 155648;
constexpr int LDS_MISC = LDS_BYTES - 512;
constexpr int NWAVES = 8, NTHR = 512;

__device__ __forceinline__ unsigned f2bf(float f) { unsigned u = __builtin_bit_cast(unsigned, f); return (u + 0x7fffu + ((u >> 16) & 1u)) >> 16; }
#ifndef EMU8
#define EMU8 0
#endif
__device__ __forceinline__ float q8(float f) { unsigned u = __builtin_bit_cast(unsigned, f); u = (u + 0x7ffffu + ((u >> 20) & 1u)) & 0xfff00000u; return __builtin_bit_cast(float, u); }
__device__ __forceinline__ unsigned pk2(float lo, float hi) { return f2bf(lo) | (f2bf(hi) << 16); }
__device__ __forceinline__ unsigned pk2q(float lo, float hi) { return f2bf(q8(lo)) | (f2bf(q8(hi)) << 16); }
__device__ __forceinline__ unsigned pk4_f8(float a, float b, float c, float d) {
    a = fminf(fmaxf(a, -448.f), 448.f); b = fminf(fmaxf(b, -448.f), 448.f); c = fminf(fmaxf(c, -448.f), 448.f); d = fminf(fmaxf(d, -448.f), 448.f);
    int r = 0; r = __builtin_amdgcn_cvt_pk_fp8_f32(a, b, r, false); r = __builtin_amdgcn_cvt_pk_fp8_f32(c, d, r, true); return (unsigned)r; }
__device__ __forceinline__ unsigned char f8_1(float a) { a = fminf(fmaxf(a, -448.f), 448.f); return (unsigned char)(__builtin_amdgcn_cvt_pk_fp8_f32(a, a, 0, false) & 0xff); }
__device__ __forceinline__ float bf2f(unsigned short b) { return __builtin_bit_cast(float, ((unsigned)b) << 16); }
__device__ __forceinline__ float bflo(unsigned w) { return __builtin_bit_cast(float, w << 16); }
__device__ __forceinline__ float bfhi(unsigned w) { return __builtin_bit_cast(float, w & 0xffff0000u); }
__device__ __forceinline__ float wave_sum(float v) {
#pragma unroll
    for (int o = 1; o < 64; o <<= 1) v += __shfl_xor(v, o);
    return v;
}
__device__ __forceinline__ float silu_f(float x) { return x / (1.f + __expf(-x)); }
#define LDS_WAIT() asm volatile("s_waitcnt lgkmcnt(0)" ::: "memory")
#define VM_WAIT() asm volatile("s_waitcnt vmcnt(0)" ::: "memory")

#define XB_TMO      128
#define XB_XCNT(j)  (256  + 64 * (j))
#define XB_XSUB(j)  (1280 + 64 * (j))
#define XB_XGEN(j)  (2304 + 64 * (j))
#define XB_TOP      3328
#define XB_TOPGEN   3392
#define XCD_BAR_WORDS 3456
#define XB_SPIN_CAP (1u << 18)
__device__ __forceinline__ unsigned xb_ld(unsigned* p)              { return __hip_atomic_load(p, __ATOMIC_RELAXED, __HIP_MEMORY_SCOPE_AGENT); }
__device__ __forceinline__ unsigned xb_add(unsigned* p, unsigned v) { return __hip_atomic_fetch_add(p, v, __ATOMIC_RELAXED, __HIP_MEMORY_SCOPE_AGENT); }
__device__ __forceinline__ unsigned xb_xcc_id() { return (unsigned)__builtin_amdgcn_s_getreg((3 << 11) | 20) & 0xFu; }
#define XB_SPIN(cond, bar) do { unsigned _sp = 0; while (cond) { __builtin_amdgcn_s_sleep(1); \
    if ((++_sp & 255u) == 0u) { if (xb_ld(&(bar)[XB_TMO])) break; if (_sp > XB_SPIN_CAP) { atomicAdd(&(bar)[XB_TMO], 1u); break; } } } } while (0)
struct XcdBarrier { unsigned* bar; unsigned x; volatile LAS unsigned* st; };
__device__ __forceinline__ XcdBarrier xcd_barrier_post(unsigned* bar, volatile LAS unsigned* st, int tid) {
    XcdBarrier b; b.bar = bar; b.x = xb_xcc_id(); b.st = st;
    if (tid == 0) (void)xb_add(&bar[XB_XCNT(b.x)], 1u);
    return b;
}
__device__ __forceinline__ void xcd_barrier_complete(unsigned* bar, unsigned x, unsigned& nloc, unsigned& nx) {
    const unsigned G = gridDim.x * gridDim.y * gridDim.z;
    unsigned sum, cnt, mine, sp = 0u;
    for (;;) {
        sum = 0u; cnt = 0u; mine = 0u;
#pragma unroll
        for (unsigned j = 0; j < 16; ++j) { const unsigned c = xb_ld(&bar[XB_XCNT(j)]); sum += c; cnt += (c > 0u) ? 1u : 0u; mine = (j == x) ? c : mine; }
        if (sum == G) break;
        __builtin_amdgcn_s_sleep(1);
        if ((++sp & 255u) == 0u) { if (xb_ld(&bar[XB_TMO])) break; if (sp > XB_SPIN_CAP) { atomicAdd(&bar[XB_TMO], 1u); break; } }
    }
    nloc = mine > 0u ? mine : 1u; nx = cnt > 0u ? cnt : 1u;
}
__device__ __forceinline__ void xcd_barrier(const XcdBarrier& b, int tid) {
    asm volatile("s_waitcnt vmcnt(0)" ::: "memory");
    __syncthreads();
    if (tid == 0) {
        unsigned* bar = b.bar;
        __builtin_amdgcn_s_waitcnt(0);
        unsigned nloc = b.st[0], nx = b.st[1];
        if (nloc == 0u) { xcd_barrier_complete(bar, b.x, nloc, nx); b.st[0] = nloc; b.st[1] = nx; }
        const unsigned old = xb_add(&bar[XB_XSUB(b.x)], 1u);
        const unsigned gen = old / nloc;
        if (old + 1u == (gen + 1u) * nloc) {
            __builtin_amdgcn_fence(__ATOMIC_RELEASE, "agent");
            asm volatile("s_waitcnt vmcnt(0)" ::: "memory");
            const unsigned og = xb_add(&bar[XB_TOP], 1u);
            const unsigned tg = og / nx;
            if (og + 1u == (tg + 1u) * nx) xb_add(&bar[XB_TOPGEN], 1u);
            else XB_SPIN(xb_ld(&bar[XB_TOPGEN]) == tg, bar);
            __builtin_amdgcn_fence(__ATOMIC_ACQUIRE, "agent");
            xb_add(&bar[XB_XGEN(b.x)], 1u);
            asm volatile("s_waitcnt vmcnt(0)" ::: "memory");
        } else {
            XB_SPIN(xb_ld(&bar[XB_XGEN(b.x)]) == gen, bar);
            __builtin_amdgcn_fence(__ATOMIC_ACQUIRE, "agent");
            asm volatile("s_waitcnt vmcnt(0)" ::: "memory");
        }
    }
    __syncthreads();
}

namespace pg8 {
constexpr int BM = 256, BK = 64, HALF = 128, HTB = HALF * BK * 2, STAGE_BYTES = 8 * HTB;
__host__ __device__ __forceinline__ int lds_byte(int r, int c) { const int st = (r >> 4) * 2 + (c >> 5), rr = r & 15, cc = c & 31, ob = rr * 64 + cc * 2; return st * 1024 + (ob ^ (((ob >> 9) & 1) << 5)); }
__host__ __device__ __forceinline__ void stage_rc(int b, int& R, int& C) { const int st = b / 1024, sb = b % 1024, swz = sb ^ (((sb >> 9) & 1) << 5); R = (st >> 1) * 16 + swz / 64; C = (st & 1) * 32 + (swz % 64) / 2; }
__host__ __device__ __forceinline__ int lds_byte8(int r, int cb) { const int st = (r >> 4) * 2 + (cb >> 6), rr = r & 15, ob = rr * 64 + (cb & 63); return st * 1024 + (ob ^ (((ob >> 9) & 1) << 4)); }
__host__ __device__ __forceinline__ void stage_rc8(int b, int& R, int& Cb) { const int st = b / 1024, sb = b % 1024, swz = sb ^ (((sb >> 9) & 1) << 4); R = (st >> 1) * 16 + swz / 64; Cb = (st & 1) * 64 + (swz % 64); }
__host__ __device__ __forceinline__ int perm32(int rho) { const int n = rho >> 4, i = rho & 15; return 8 * (i >> 2) + 4 * n + (i & 3); }
struct Unit { int pm, pn; };
struct Gemm { const bf16_t* A; const bf16_t* Bt; int K; const int* rowtab; };
__device__ __forceinline__ unsigned cvt_pk_bf16(float lo, float hi) { unsigned r; asm volatile("v_cvt_pk_bf16_f32 %0, %1, %2" : "=v"(r) : "v"(lo), "v"(hi)); return r; }

template <class Epi, class Sched, bool GATHER, bool F8 = false>
__device__ __forceinline__ void gemm_phase(LAS unsigned char* lds, const Gemm g, const Sched& S, const Epi& E, const int tid) {
    const int wid = __builtin_amdgcn_readfirstlane(tid >> 6), lane = tid & 63, wr = wid >> 2, wc = wid & 3, fr = lane & 15, fq = lane >> 4;
    const int K = g.K, RB = F8 ? K : 2 * K, nt = RB / 128;
    unsigned voffB[2], voffA[2];
#pragma unroll
    for (int i = 0; i < 2; ++i) { int R, Cb; if constexpr (F8) stage_rc8(tid * 16 + i * 8192, R, Cb); else { int C; stage_rc(tid * 16 + i * 8192, R, C); Cb = 2 * C; }
        const int Rb = Epi::PERM ? ((R & ~31) + perm32(R & 31)) : R;
        voffA[i] = (unsigned)(R * RB + Cb); voffB[i] = (unsigned)(Rb * RB + Cb); }
    const size_t kstep = 128;
    const size_t hstep = (size_t)HALF * RB;
    const size_t tstep = 2 * hstep;
    const unsigned ldsw = (unsigned)wid * 1024u;
    const int aoff = F8 ? lds_byte8(wr * 64 + fr, 32 * fq) : lds_byte(wr * 64 + fr, fq * 8), boff = F8 ? lds_byte8(wc * 32 + fr, 32 * fq) : lds_byte(wc * 32 + fr, fq * 8);
    const int aoff2 = aoff ^ 16, boff2 = boff ^ 16;
#define PG8_SA(b, h) (((b) * 2 + (h)) * HTB)
#define PG8_SB(b, h) ((4 + (b) * 2 + (h)) * HTB)
#define PG8_STAGE(bufoff, gbase, voff) do { _Pragma("unroll") for (int _i = 0; _i < 2; ++_i) \
        __builtin_amdgcn_global_load_lds((const unsigned*)((const char*)(gbase) + (voff)[_i]), (LAS unsigned*)(lds + (bufoff) + ldsw + _i * 8192), 16, 0, 0); } while (0)
#define PG8_LDA(dst, b, h) do { if constexpr (F8) { _Pragma("unroll") for (int m = 0; m < 4; ++m) { const i32x4 _lo = *(const LAS i32x4*)(lds + PG8_SA(b, h) + aoff + m * 2048), _hi = *(const LAS i32x4*)(lds + PG8_SA(b, h) + aoff2 + m * 2048); dst##8[m] = __builtin_shufflevector(_lo, _hi, 0, 1, 2, 3, 4, 5, 6, 7); } } \
        else { _Pragma("unroll") for (int m = 0; m < 4; ++m) _Pragma("unroll") for (int k = 0; k < 2; ++k) dst[m][k] = *(const LAS bf16x8*)(lds + PG8_SA(b, h) + aoff + m * 2048 + k * 1024); } } while (0)
#define PG8_LDB(dst, b, h) do { if constexpr (F8) { _Pragma("unroll") for (int n = 0; n < 2; ++n) { const i32x4 _lo = *(const LAS i32x4*)(lds + PG8_SB(b, h) + boff + n * 2048), _hi = *(const LAS i32x4*)(lds + PG8_SB(b, h) + boff2 + n * 2048); dst##8[n] = __builtin_shufflevector(_lo, _hi, 0, 1, 2, 3, 4, 5, 6, 7); } } \
        else { _Pragma("unroll") for (int n = 0; n < 2; ++n) _Pragma("unroll") for (int k = 0; k < 2; ++k) dst[n][k] = *(const LAS bf16x8*)(lds + PG8_SB(b, h) + boff + n * 2048 + k * 1024); } } while (0)
#define PG8_CAT(x) __builtin_shufflevector(x[0], x[1], 0, 1, 2, 3, 4, 5, 6, 7)
#define PG8_MMA(ai, bj, At, Bt) do { __builtin_amdgcn_s_setprio(1); if constexpr (F8) { _Pragma("unroll") for (int m = 0; m < 4; ++m) _Pragma("unroll") for (int n = 0; n < 2; ++n) \
            asm volatile("v_mfma_scale_f32_16x16x128_f8f6f4 %0, %1, %2, %0, %3, %3 op_sel_hi:[0,0,0]" : "+v"(acc[ai][bj][m][n]) : "v"(Bt##8[n]), "v"(At##8[m]), "v"(f8scale)); } \
        else { _Pragma("unroll") for (int m = 0; m < 4; ++m) _Pragma("unroll") for (int n = 0; n < 2; ++n) _Pragma("unroll") for (int k = 0; k < 2; ++k) \
            acc[ai][bj][m][n] = __builtin_amdgcn_mfma_f32_16x16x32_bf16(Bt[n][k], At[m][k], acc[ai][bj][m][n], 0, 0, 0); } __builtin_amdgcn_s_setprio(0); } while (0)
#define PG8_WAIT_V(n) asm volatile("s_waitcnt vmcnt(" #n ")" ::: "memory")
#define PG8_WAIT_L(n) asm volatile("s_waitcnt lgkmcnt(" #n ")" ::: "memory")
#define PG8_BAR __builtin_amdgcn_s_barrier()
#define PG8_SCHED __builtin_amdgcn_sched_barrier(0)
#define PG8_AOFF(o, u) do { int _t2 = tid; asm volatile("" : "+v"(_t2)); _Pragma("unroll") for (int _i = 0; _i < 2; ++_i) { int _R, _Cb; if constexpr (F8) stage_rc8(_t2 * 16 + _i * 8192, _R, _Cb); else { int _C; stage_rc(_t2 * 16 + _i * 8192, _R, _C); _Cb = 2 * _C; } \
        _Pragma("unroll") for (int _h = 0; _h < 2; ++_h) { int _r = (u).pm * BM + _h * HALF + _R; \
        { const int _t = g.rowtab[_r]; _r = _t < 0 ? 0 : (_t & 0x3fffffff); } o[_h][_i] = (unsigned)(_r * RB + _Cb); } } } while (0)
    Unit cur, nxt; int ui = 0;
    if (!S.next(0, cur)) return;
    f32x4 acc[2][2][4][2];
#pragma unroll
    for (int a = 0; a < 2; ++a)
#pragma unroll
        for (int b = 0; b < 2; ++b)
#pragma unroll
            for (int m = 0; m < 4; ++m)
#pragma unroll
                for (int n = 0; n < 2; ++n) acc[a][b][m][n] = (f32x4){0.f, 0.f, 0.f, 0.f};
    bf16x8 At[4][2], B0[2][2], B1[2][2];
    i32x8 At8[4], B08[2], B18[2];
    int f8scale = 0x7f7f7f7f; asm volatile("" : "+v"(f8scale));
    unsigned oc[2][2], on[2][2];
    const char* gA = (const char*)g.A;
    const char* cA = gA; const char* cB = (const char*)g.Bt + (size_t)cur.pn * tstep;
    if constexpr (GATHER) { PG8_AOFF(oc, cur); } else { cA = gA + (size_t)cur.pm * tstep; }
#define PG8_STA_CUR(buf, kb, h) do { if constexpr (GATHER) { PG8_STAGE(buf, gA + (kb), oc[h]); } else { PG8_STAGE(buf, cA + (kb) + (h) * hstep, voffA); } } while (0)
#define PG8_STA_SEL(buf, kb, h) do { if constexpr (GATHER) { if (last) { PG8_STAGE(buf, gA + (kb), on[h]); } else { PG8_STAGE(buf, gA + (kb), oc[h]); } } else { PG8_STAGE(buf, a2p + (kb) + (h) * hstep, voffA); } } while (0)
    PG8_STAGE(PG8_SB(0, 0), cB, voffB); PG8_STAGE(PG8_SB(0, 1), cB + hstep, voffB); PG8_STA_CUR(PG8_SA(0, 0), 0, 0); PG8_STA_CUR(PG8_SA(0, 1), 0, 1);
    if (wr == 1) PG8_BAR;
    PG8_WAIT_V(2); PG8_BAR;
    PG8_STAGE(PG8_SB(1, 0), cB + kstep, voffB); PG8_STA_CUR(PG8_SA(1, 0), kstep, 0); PG8_STAGE(PG8_SB(1, 1), cB + hstep + kstep, voffB);
    PG8_WAIT_V(6); PG8_BAR;
    for (;;) {
        const bool has_next = S.next(ui + 1, nxt);
        const char* nA = cA;
        if constexpr (!GATHER) { if (has_next) nA = gA + (size_t)nxt.pm * tstep; }
        const char* nB = has_next ? (const char*)g.Bt + (size_t)nxt.pn * tstep : cB;
#pragma unroll 1
        for (int t = 0; t < nt; t += 2) {
            const bool last = (t == nt - 2);
            int to = t; asm volatile("" : "+s"(to));
            const size_t k1 = (size_t)(to + 1) * kstep, k2 = last ? 0 : (size_t)(to + 2) * kstep, k3 = k2 + kstep;
            const char* b2 = last ? nB : cB + (size_t)(to + 2) * kstep; const char* b3 = b2 + kstep;
            const char* a2p = last ? nA : cA;
            if constexpr (GATHER) { if (last) { if (has_next) { PG8_AOFF(on, nxt); } else {
#pragma unroll
                for (int h = 0; h < 2; ++h)
#pragma unroll
                    for (int i = 0; i < 2; ++i) on[h][i] = oc[h][i]; } } }
            PG8_LDB(B0, 0, 0); PG8_LDB(B1, 0, 1); PG8_SCHED; PG8_LDA(At, 0, 0); PG8_STA_CUR(PG8_SA(1, 1), k1, 1);
            PG8_WAIT_V(8); PG8_WAIT_L(0); PG8_BAR; PG8_MMA(0, 0, At, B0); PG8_MMA(0, 1, At, B1); PG8_BAR; PG8_SCHED;
            PG8_LDA(At, 0, 1); PG8_STAGE(PG8_SB(0, 0), b2, voffB); PG8_STAGE(PG8_SB(0, 1), b2 + hstep, voffB); PG8_STA_SEL(PG8_SA(0, 0), k2, 0);
            PG8_WAIT_V(8); PG8_WAIT_L(0); PG8_BAR; PG8_MMA(1, 0, At, B0); PG8_MMA(1, 1, At, B1); PG8_BAR; PG8_SCHED;
            PG8_LDB(B0, 1, 0); PG8_LDB(B1, 1, 1); PG8_SCHED; PG8_LDA(At, 1, 0); PG8_STA_SEL(PG8_SA(0, 1), k2, 1);
            PG8_WAIT_V(8); PG8_WAIT_L(0); PG8_BAR; PG8_MMA(0, 0, At, B0); PG8_MMA(0, 1, At, B1); PG8_BAR; PG8_SCHED;
            PG8_LDA(At, 1, 1); PG8_STAGE(PG8_SB(1, 0), b3, voffB); PG8_STAGE(PG8_SB(1, 1), b3 + hstep, voffB); PG8_STA_SEL(PG8_SA(1, 0), k3, 0);
            PG8_WAIT_V(8); PG8_WAIT_L(0); PG8_BAR; PG8_MMA(1, 0, At, B0); PG8_MMA(1, 1, At, B1); PG8_BAR; PG8_SCHED;
        }
        if (wr == 0) PG8_BAR;
        if constexpr (F8) asm volatile("s_nop 15\n\ts_nop 15" : "+v"(acc[1][1][0][0]), "+v"(acc[1][1][0][1]), "+v"(acc[1][1][1][0]), "+v"(acc[1][1][1][1]), "+v"(acc[1][1][2][0]), "+v"(acc[1][1][2][1]), "+v"(acc[1][1][3][0]), "+v"(acc[1][1][3][1]) :: "memory");
        E(acc, cur, wr, wc, fr, fq);
        if (!has_next) break;
#pragma unroll
        for (int a = 0; a < 2; ++a)
#pragma unroll
            for (int b = 0; b < 2; ++b)
#pragma unroll
                for (int m = 0; m < 4; ++m)
#pragma unroll
                    for (int n = 0; n < 2; ++n) acc[a][b][m][n] = (f32x4){0.f, 0.f, 0.f, 0.f};
        cur = nxt; cB = nB; cA = nA; ++ui;
        if constexpr (GATHER) {
#pragma unroll
            for (int h = 0; h < 2; ++h)
#pragma unroll
                for (int i = 0; i < 2; ++i) oc[h][i] = on[h][i]; }
        if (wr == 1) PG8_BAR;
    }
#undef PG8_STA_CUR
#undef PG8_STA_SEL
    PG8_WAIT_V(0);
    PG8_BAR;
#undef PG8_SA
#undef PG8_SB
#undef PG8_STAGE
#undef PG8_LDA
#undef PG8_LDB
#undef PG8_CAT
#undef PG8_MMA
#undef PG8_WAIT_V
#undef PG8_WAIT_L
#undef PG8_BAR
#undef PG8_SCHED
#undef PG8_AOFF
}
}

struct Params { const float* in[34]; float* out; unsigned char* ws; int ph_lo, ph_hi; };
typedef const __attribute__((address_space(4))) Params* KP;
__device__ __forceinline__ KP kp_opaque(KP p) { asm volatile("" : "+s"(p)); return p; }
enum { I_X = 0, I_C, I_CTX, I_CCTX, I_N1W, I_N2W, I_ADAW, I_ADAB, I_WIN, I_WOUT, I_GGW, I_GGB, I_GNW, I_SQN, I_SKN, I_SINK, I_HCW, I_HCB, I_HW1, I_HB1, I_HW2, I_HB2, I_HW3, I_HFR, I_HBIAS,
       I_DQN, I_DKN, I_DLAM, I_DSUB, I_RW, I_RB, I_EG, I_EU, I_ED };
struct Frame {
    LAS unsigned char* lds; volatile LAS unsigned* MISC; unsigned* ctl;
    int tid, lane, wave, vcu, G;
    unsigned char* ws;
};
__device__ __forceinline__ int modrow_of(int row) { return row < TL ? (row >> 11) : 8; }
__device__ __forceinline__ int keyrow(int b, int kidx) { return kidx < LC ? TL + b * LC + kidx : b * SEQ + (kidx - LC); }
__device__ __forceinline__ int wg_grab(Frame& F, int q) {
    __syncthreads();
    if (F.tid == 0) F.MISC[0] = __hip_atomic_fetch_add(F.ctl + CW_Q + 64 * q, 1u, __ATOMIC_RELAXED, __HIP_MEMORY_SCOPE_AGENT);
    __syncthreads();
    { int t_; asm volatile("v_mbcnt_lo_u32_b32 %0, -1, 0\n\tv_mbcnt_hi_u32_b32 %0, -1, %0" : "=v"(t_)); F.lane = t_; F.tid = F.wave * 64 + t_; }
    return (int)F.MISC[0];
}

namespace pg8 {
constexpr int NXCD = 8, WGM = 8;
struct RectOrder {
    int nM, nN, nwg, G, c, nextra, xpm0; unsigned long long xt;
    __device__ void init(int nM_, int nN_, int G_, int c_, int nextra_, int xpm0_, unsigned long long xt_) { nM = nM_; nN = nN_; nwg = nM * nN; G = G_; c = c_; nextra = nextra_; xpm0 = xpm0_; xt = xt_; }
    __device__ bool next(int i, Unit& u) const {
        const int L = i * G + c; if (L >= nwg + nextra) return false;
        if (L >= nwg) { const int e = L - nwg; u.pm = xpm0 + (e >> 3); u.pn = (int)((xt >> (8 * (e & 7))) & 0xffull); return true; }
        int wgid = L; { const int q = nwg / NXCD, r = nwg % NXCD, xcd = wgid % NXCD, off = wgid / NXCD; wgid = (xcd < r ? xcd * (q + 1) : r * (q + 1) + (xcd - r) * q) + off; }
        const int nig = WGM * nN, gid = wgid / nig, fm = gid * WGM, gsz = (nM - fm) < WGM ? (nM - fm) : WGM;
        u.pm = fm + ((wgid % nig) % gsz); u.pn = (wgid % nig) / gsz; return true;
    }
};
struct MoeOrder {
    int npanels, G, vcu; const volatile LAS unsigned char* pexp;
    __device__ bool next(int i, Unit& u) const {
        const int L = i * G + vcu; if (L >= npanels * 8) return false;
        const int p = L >> 3; u.pm = p; u.pn = (int)pexp[p] * 8 + (L & 7); return true;
    }
};
struct EpiU {
    static constexpr bool PERM = true;
    bf16_t* O; float scale;
    __device__ __forceinline__ void operator()(const f32x4 (&acc)[2][2][4][2], const Unit& u, int wr, int wc, int fr, int fq) const {
        const int row0 = u.pm * BM + wr * 64 + fr, col0 = u.pn * BM + wc * 32 + 8 * fq;
#pragma unroll
        for (int ai = 0; ai < 2; ++ai)
#pragma unroll
            for (int m = 0; m < 4; ++m) { bf16_t* rowp = O + (size_t)(row0 + ai * HALF + m * 16) * NU + col0;
#pragma unroll
                for (int bj = 0; bj < 2; ++bj) { const f32x4 v0 = acc[ai][bj][m][0] * scale, v1 = acc[ai][bj][m][1] * scale;
                    u32x4 w; w.x = cvt_pk_bf16(v0[0], v0[1]); w.y = cvt_pk_bf16(v0[2], v0[3]); w.z = cvt_pk_bf16(v1[0], v1[1]); w.w = cvt_pk_bf16(v1[2], v1[3]);
                    *(u32x4*)(rowp + bj * HALF) = w; } }
    }
};
struct EpiWout {
    static constexpr bool PERM = true;
    const float* res_lat; const float* res_ctx; const bf16_t* resb; bf16_t* X; const float* mod;
    __device__ __forceinline__ void operator()(const f32x4 (&acc)[2][2][4][2], const Unit& u, int wr, int wc, int fr, int fq) const {
        const int row0 = u.pm * BM + wr * 64 + fr, col0 = u.pn * BM + wc * 32 + 8 * fq;
        const float* ga = mod + (size_t)modrow_of(u.pm * BM) * 12288 + 2 * D;
        constexpr float sc = WOUT_F8 ? 1.f / 32.f : 1.f;
        f32x4 gv[2][2];
#pragma unroll
        for (int bj = 0; bj < 2; ++bj)
#pragma unroll
            for (int n = 0; n < 2; ++n) gv[bj][n] = *(const f32x4*)(ga + col0 + bj * HALF + n * 4) * sc;
        if (resb) {
#pragma unroll
            for (int ai = 0; ai < 2; ++ai)
#pragma unroll
                for (int m = 0; m < 4; ++m) { const int row = row0 + ai * HALF + m * 16; const bf16_t* rp = resb + (size_t)row * D + col0; bf16_t* xp = X + (size_t)row * D + col0;
#pragma unroll
                    for (int bj = 0; bj < 2; ++bj) { const u32x4 r = *(const u32x4*)(rp + bj * HALF);
                        const f32x4 v0 = (f32x4){bflo(r.x), bfhi(r.x), bflo(r.y), bfhi(r.y)} + gv[bj][0] * acc[ai][bj][m][0], v1 = (f32x4){bflo(r.z), bfhi(r.z), bflo(r.w), bfhi(r.w)} + gv[bj][1] * acc[ai][bj][m][1];
                        u32x4 o; o.x = cvt_pk_bf16(v0[0], v0[1]); o.y = cvt_pk_bf16(v0[2], v0[3]); o.z = cvt_pk_bf16(v1[0], v1[1]); o.w = cvt_pk_bf16(v1[2], v1[3]);
                        *(u32x4*)(xp + bj * HALF) = o; } }
        } else {
#pragma unroll
            for (int ai = 0; ai < 2; ++ai)
#pragma unroll
                for (int m = 0; m < 4; ++m) { const int row = row0 + ai * HALF + m * 16;
                    const float* rp = (row < TL ? res_lat + (size_t)row * D : res_ctx + (size_t)(row - TL) * D) + col0; bf16_t* xp = X + (size_t)row * D + col0;
#pragma unroll
                    for (int bj = 0; bj < 2; ++bj) { const f32x4 r0 = *(const f32x4*)(rp + bj * HALF), r1 = *(const f32x4*)(rp + bj * HALF + 4);
                        const f32x4 v0 = r0 + gv[bj][0] * acc[ai][bj][m][0], v1 = r1 + gv[bj][1] * acc[ai][bj][m][1];
                        u32x4 o; o.x = cvt_pk_bf16(v0[0], v0[1]); o.y = cvt_pk_bf16(v0[2], v0[3]); o.z = cvt_pk_bf16(v1[0], v1[1]); o.w = cvt_pk_bf16(v1[2], v1[3]);
                        *(u32x4*)(xp + bj * HALF) = o; } }
        }
    }
};
struct EpiMoe1 {
    static constexpr bool PERM = true;
    unsigned char* O;
    __device__ __forceinline__ void operator()(const f32x4 (&acc)[2][2][4][2], const Unit& u, int wr, int wc, int fr, int fq) const {
        const int row0 = u.pm * BM + wr * 64 + fr, col0 = (u.pn & 7) * HALF + wc * 32 + 8 * fq;
#pragma unroll
        for (int ai = 0; ai < 2; ++ai)
#pragma unroll
            for (int m = 0; m < 4; ++m) { unsigned char* rowp = O + (size_t)(row0 + ai * HALF + m * 16) * DE + col0; float h[8];
#pragma unroll
                for (int n = 0; n < 2; ++n)
#pragma unroll
                    for (int j = 0; j < 4; ++j) { const float gt = acc[ai][0][m][n][j] * (1.f / 32.f), up = acc[ai][1][m][n][j] * (1.f / 32.f); h[4 * n + j] = gt * __builtin_amdgcn_rcpf(1.f + __expf(-gt)) * up; }
                u32x2 w; w.x = pk4_f8(h[0], h[1], h[2], h[3]); w.y = pk4_f8(h[4], h[5], h[6], h[7]);
                *(u32x2*)rowp = w; }
    }
};
struct EpiMoe2 {
    static constexpr bool PERM = true;
    unsigned char* Y2; const int* rowtok; const float* roww;
    __device__ __forceinline__ void operator()(const f32x4 (&acc)[2][2][4][2], const Unit& u, int wr, int wc, int fr, int fq) const {
        const int row0 = u.pm * BM + wr * 64 + fr, col0 = (u.pn & 7) * BM + wc * 32 + 8 * fq;
#pragma unroll
        for (int ai = 0; ai < 2; ++ai)
#pragma unroll
            for (int m = 0; m < 4; ++m) { asm volatile("" ::: "memory"); const int row = row0 + ai * HALF + m * 16; const int tk = rowtok[row]; const float w = roww[row];
                if (tk >= 0) { unsigned char* rowp = Y2 + ((size_t)(tk >> 30) * TT + (size_t)(tk & 0x3fffffff)) * D + col0;
#pragma unroll
                    for (int bj = 0; bj < 2; ++bj) { const f32x4 v0 = acc[ai][bj][m][0] * w, v1 = acc[ai][bj][m][1] * w;
                        u32x2 o; o.x = pk4_f8(v0[0], v0[1], v0[2], v0[3]); o.y = pk4_f8(v1[0], v1[1], v1[2], v1[3]);
                        *(u32x2*)(rowp + bj * HALF) = o; } } }
    }
};
}

__device__ __forceinline__ void p0_transpose_item(const float* W, int ldw, int srccol0, int k0, bf16_t* dst, int K, LAS float* scr, int lane, bool q = false) {
    { f32x4 v[8];
#pragma unroll
      for (int i = 0; i < 8; ++i) v[i] = *(const f32x4*)(W + (size_t)(k0 + 8 * i + (lane >> 3)) * ldw + srccol0 + 4 * (lane & 7));
#pragma unroll
      for (int i = 0; i < 8; ++i) { LAS float* p = scr + (8 * i + (lane >> 3)) * 33 + 4 * (lane & 7); p[0] = v[i][0]; p[1] = v[i][1]; p[2] = v[i][2]; p[3] = v[i][3]; } }
    LDS_WAIT(); asm volatile("" ::: "memory");
    const int c = lane & 7;
#pragma unroll
    for (int j = 0; j < 4; ++j) { const int n = (lane >> 3) + 8 * j; const LAS float* s = scr + (8 * c) * 33 + n;
        u32x4 o; if (q) { o.x = pk2q(s[0 * 33], s[1 * 33]); o.y = pk2q(s[2 * 33], s[3 * 33]); o.z = pk2q(s[4 * 33], s[5 * 33]); o.w = pk2q(s[6 * 33], s[7 * 33]); }
        else { o.x = pk2(s[0 * 33], s[1 * 33]); o.y = pk2(s[2 * 33], s[3 * 33]); o.z = pk2(s[4 * 33], s[5 * 33]); o.w = pk2(s[6 * 33], s[7 * 33]); }
        *(u32x4*)(dst + (size_t)n * K + k0 + 8 * c) = o; }
    LDS_WAIT(); asm volatile("" ::: "memory");
}
__device__ __forceinline__ void p0_transpose_item8(const float* W, int ldw, int srccol0, int k0, unsigned char* dst, int K, LAS float* scr, int lane) {
    { f32x4 v[8];
#pragma unroll
      for (int i = 0; i < 8; ++i) v[i] = *(const f32x4*)(W + (size_t)(k0 + 8 * i + (lane >> 3)) * ldw + srccol0 + 4 * (lane & 7));
#pragma unroll
      for (int i = 0; i < 8; ++i) { LAS float* p = scr + (8 * i + (lane >> 3)) * 33 + 4 * (lane & 7); p[0] = v[i][0]; p[1] = v[i][1]; p[2] = v[i][2]; p[3] = v[i][3]; } }
    LDS_WAIT(); asm volatile("" ::: "memory");
    const int c = lane & 7;
#pragma unroll
    for (int j = 0; j < 4; ++j) { const int n = (lane >> 3) + 8 * j; const LAS float* s = scr + (8 * c) * 33 + n;
        u32x2 o; o.x = pk4_f8(s[0 * 33] * 32.f, s[1 * 33] * 32.f, s[2 * 33] * 32.f, s[3 * 33] * 32.f); o.y = pk4_f8(s[4 * 33] * 32.f, s[5 * 33] * 32.f, s[6 * 33] * 32.f, s[7 * 33] * 32.f);
        *(u32x2*)(dst + (size_t)n * K + k0 + 8 * c) = o; }
    LDS_WAIT(); asm volatile("" ::: "memory");
}
constexpr int TI_WIN = 32 * 168, TI_WA = 32, TI_WOUT = 32 * 64, TI_GU = 32 * 64, TI_DN = 16 * 64;
constexpr int TI_L = TI_WIN + TI_WA + TI_WOUT;
constexpr int TI_TOTAL = 2 * TI_L + 32 * TI_GU + 32 * TI_DN;
__device__ __forceinline__ void p0_item(KP Pk, Frame& F, int it, LAS float* scr) {
    unsigned char* ws = F.ws;
    if (it < 2 * TI_L) { const int l = it / TI_L; int r = it % TI_L;
        if (r < TI_WIN) { const int kb = r / 168, nb = r % 168, n0 = 32 * nb;
            if (WIN_F8_L(l)) p0_transpose_item8(Pk->in[I_WIN] + (size_t)l * D * DIN, DIN, n0 < 1536 ? n0 : n0 + 32, 64 * kb, ws + WS_WIN + (size_t)l * NU * D * 2 + (size_t)n0 * D, D, scr, F.lane);
            else p0_transpose_item(Pk->in[I_WIN] + (size_t)l * D * DIN, DIN, n0 < 1536 ? n0 : n0 + 32, 64 * kb, (bf16_t*)(ws + WS_WIN) + ((size_t)l * NU + n0) * D, D, scr, F.lane); return; }
        r -= TI_WIN;
        if (r < TI_WA) { if (WIN_F8_L(l)) p0_transpose_item8(Pk->in[I_WIN] + (size_t)l * D * DIN, DIN, 1536, 64 * r, ws + WS_WA + (size_t)l * 32 * D * 2, D, scr, F.lane);
            else p0_transpose_item(Pk->in[I_WIN] + (size_t)l * D * DIN, DIN, 1536, 64 * r, (bf16_t*)(ws + WS_WA) + (size_t)l * 32 * D, D, scr, F.lane); return; }
        r -= TI_WA;
        { const int kb = r / 64, nb = r % 64;
          if (WOUT_F8) p0_transpose_item8(Pk->in[I_WOUT] + (size_t)l * D * D, D, 32 * nb, 64 * kb, ws + WS_WOUT + ((size_t)l * D + 32 * nb) * D, D, scr, F.lane);
          else p0_transpose_item(Pk->in[I_WOUT] + (size_t)l * D * D, D, 32 * nb, 64 * kb, (bf16_t*)(ws + WS_WOUT) + ((size_t)l * D + 32 * nb) * D, D, scr, F.lane); return; }
    }
    it -= 2 * TI_L;
    if (it < 32 * TI_GU) { const int le = it / TI_GU, r = it % TI_GU, kb = r / 64, nb = r % 64, n0 = 32 * nb, j = n0 >> 8, half = (n0 >> 7) & 1, c0 = 128 * j + (n0 & 127);
        p0_transpose_item8((half ? Pk->in[I_EU] : Pk->in[I_EG]) + (size_t)le * D * DE, DE, c0, 64 * kb, ws + WS_WGU + ((size_t)le * 2048 + n0) * D, D, scr, F.lane); return; }
    it -= 32 * TI_GU;
    { const int le = it / TI_DN, r = it % TI_DN, kb = r / 64, nb = r % 64;
        p0_transpose_item8(Pk->in[I_ED] + (size_t)le * DE * D, D, 32 * nb, 64 * kb, ws + WS_WD + ((size_t)le * D + 32 * nb) * DE, DE, scr, F.lane); }
}
__device__ __forceinline__ void ada_unit(KP Pk, Frame& F, int u) {
    unsigned char* ws = F.ws;
    __syncthreads();
        LAS float* sc = (LAS float*)F.lds;
        LAS float* red = (LAS float*)(F.lds + 9 * 2048 * 4);
        for (int i = F.tid; i < 9 * 2048; i += NTHR) { const int r = i >> 11, k = i & 2047; const float v = r < 8 ? Pk->in[I_C][r * 2048 + k] : Pk->in[I_CCTX][k]; sc[i] = silu_f(v); }
        __syncthreads();
        const int l = u / 96, cb = u % 96, col = cb * 128 + (F.tid & 127), kp = F.tid >> 7;
        const float* W = Pk->in[I_ADAW] + (size_t)l * D * 12288 + col;
        float a[9];
#pragma unroll
        for (int r = 0; r < 9; ++r) a[r] = 0.f;
        for (int k = kp * 512; k < kp * 512 + 512; k += 32) {
            float w[32];
#pragma unroll
            for (int q = 0; q < 32; ++q) w[q] = W[(size_t)(k + q) * 12288];
#pragma unroll
            for (int q = 0; q < 32; ++q) {
#pragma unroll
                for (int r = 0; r < 9; ++r) a[r] += sc[r * 2048 + k + q] * w[q];
                if ((q & 3) == 3) __builtin_amdgcn_sched_barrier(0); }
        }
#pragma unroll
        for (int r = 0; r < 9; ++r) red[(kp * 9 + r) * 128 + (F.tid & 127)] = a[r];
        __syncthreads();
        for (int i = F.tid; i < 9 * 128; i += NTHR) { const int r = i >> 7, c = i & 127;
            const float s = (red[(0 * 9 + r) * 128 + c] + red[(1 * 9 + r) * 128 + c]) + (red[(2 * 9 + r) * 128 + c] + red[(3 * 9 + r) * 128 + c]);
            ((float*)(ws + WS_MOD))[((size_t)l * 9 + r) * 12288 + cb * 128 + c] = s + Pk->in[I_ADAB][l * 12288 + cb * 128 + c]; }
        __syncthreads();
}
__device__ __forceinline__ void p0_prologue(KP Pk, Frame& F, int rep) {
    unsigned char* ws = F.ws;
    const int gw = F.vcu * NWAVES + F.wave, NGW = F.G * NWAVES;
    if (blockIdx.x < 96) ada_unit(Pk, F, (int)blockIdx.x);
    for (int i = blockIdx.x * NTHR + F.tid; i < SEQ * 64; i += F.G * NTHR) { const int t = i >> 6, j = i & 63, q = j >> 4, f = j & 15;
        const float inv = exp2f(-(float)f * (13.287712379549449f / 16.f)); const float pos = (float)(q < 2 ? (t >> 6) : (t & 63)); const float ang = pos * inv;
        ((float*)(ws + WS_ROPE))[i] = (q & 1) ? sinf(ang) : cosf(ang); }
    for (int it = gw; it < 2 * 2304; it += NGW) { const int l = it / 2304, tt = it % 2304, L = tt < 2048 ? 2048 : 256, t = tt < 2048 ? tt : tt - 2048;
        const float tn = (float)t / (float)(L - 1), wv = (6.283185307179586f / (float)L) * (float)t;
        const float* w1 = Pk->in[I_HW1] + l * 33 * 64; const float* w2 = Pk->in[I_HW2] + l * 64 * 64;
        float zv = 0.f;
        if (F.lane == 0) zv = tn; else if (F.lane < 33) { const int bi = (F.lane - 1) & 15; const float band = 1e-4f + (float)bi * ((15.f - 1e-4f) / 15.f); zv = F.lane < 17 ? cosf(wv * band) : -sinf(wv * band); }
        float s = Pk->in[I_HB1][l * 64 + F.lane];
#pragma unroll
        for (int i = 0; i < 33; ++i) s += __shfl(zv, i) * w1[i * 64 + F.lane];
        const float h1 = sinf(Pk->in[I_HFR][(l * 2 + 0) * 64 + F.lane] * s);
        float s2 = Pk->in[I_HB2][l * 64 + F.lane];
#pragma unroll 16
        for (int i = 0; i < 64; ++i) s2 += __shfl(h1, i) * w2[i * 64 + F.lane];
        ((float*)(ws + WS_HYH2))[(size_t)it * 64 + F.lane] = sinf(Pk->in[I_HFR][(l * 2 + 1) * 64 + F.lane] * s2);
    }
    { LAS float* scr = (LAS float*)(F.lds + F.wave * 8704);
      __syncthreads();
      for (;;) { int base = 0; if (F.lane == 0) base = (int)__hip_atomic_fetch_add(F.ctl + CW_Q + 64 * (rep ? 5 : 0), 16u, __ATOMIC_RELAXED, __HIP_MEMORY_SCOPE_AGENT);
          base = __builtin_amdgcn_readfirstlane(base); if (base >= TI_WIN + TI_WA) break;
          for (int it = base; it < base + 16 && it < TI_WIN + TI_WA; ++it) p0_item(Pk, F, it, scr); } }
}

#define MFMA16(a, b, c) __builtin_amdgcn_mfma_f32_16x16x32_bf16((a), (b), (c), 0, 0, 0)
#define MFMA32(a, b, c) __builtin_amdgcn_mfma_f32_32x32x16_bf16((a), (b), (c), 0, 0, 0)
__device__ __forceinline__ void load_row(const float* p, int lane, f32x4 (&v)[8]) {
#pragma unroll
    for (int j = 0; j < 8; ++j) v[j] = ((const f32x4*)p)[lane + 64 * j];
}
__device__ __forceinline__ void load_row_bf16(const bf16_t* p, int lane, f32x4 (&v)[8]) {
#pragma unroll
    for (int j = 0; j < 8; ++j) { const u32x2 a = ((const u32x2*)p)[lane + 64 * j]; v[j] = (f32x4){bflo(a.x), bfhi(a.x), bflo(a.y), bfhi(a.y)}; }
}
__device__ __forceinline__ void add_y2(const unsigned char* y0, const unsigned char* y1, const float* gf, int lane, f32x4 (&v)[8]) {
#pragma unroll
    for (int j = 0; j < 8; ++j) { const unsigned a = ((const unsigned*)y0)[lane + 64 * j], b = ((const unsigned*)y1)[lane + 64 * j]; const f32x4 g = ((const f32x4*)gf)[lane + 64 * j] * (1.f / 32.f);
        const f32x2 a0 = __builtin_amdgcn_cvt_pk_f32_fp8(a, false), a1 = __builtin_amdgcn_cvt_pk_f32_fp8(a, true), b0 = __builtin_amdgcn_cvt_pk_f32_fp8(b, false), b1 = __builtin_amdgcn_cvt_pk_f32_fp8(b, true);
        v[j][0] += g[0] * (a0[0] + b0[0]); v[j][1] += g[1] * (a0[1] + b0[1]); v[j][2] += g[2] * (a1[0] + b1[0]); v[j][3] += g[3] * (a1[1] + b1[1]); }
}
__device__ __forceinline__ float row_rstd(const f32x4 (&v)[8]) {
    float s = 0.f;
#pragma unroll
    for (int j = 0; j < 8; ++j) s += (v[j][0] * v[j][0] + v[j][1] * v[j][1]) + (v[j][2] * v[j][2] + v[j][3] * v[j][3]);
    return rsqrtf(wave_sum(s) * (1.f / D) + NORM_EPS);
}
__device__ __forceinline__ void modulate(f32x4 (&v)[8], float rstd, const float* nw, const float* sh, const float* sc, int lane) {
#pragma unroll
    for (int j = 0; j < 8; ++j) { const f32x4 w = ((const f32x4*)nw)[lane + 64 * j], a = ((const f32x4*)sc)[lane + 64 * j], b = ((const f32x4*)sh)[lane + 64 * j];
        v[j] = v[j] * rstd * w * (a + 1.f) + b; }
}
__device__ __forceinline__ void store_row_bf16(bf16_t* o, int lane, const f32x4 (&v)[8], bool q = false) {
#pragma unroll
    for (int j = 0; j < 8; ++j) { u32x2 w; if (q) { w.x = pk2q(v[j][0], v[j][1]); w.y = pk2q(v[j][2], v[j][3]); } else { w.x = pk2(v[j][0], v[j][1]); w.y = pk2(v[j][2], v[j][3]); } ((u32x2*)o)[lane + 64 * j] = w; }
}
__device__ __forceinline__ void store_row_f8(unsigned char* o, int lane, const f32x4 (&v)[8]) {
#pragma unroll
    for (int j = 0; j < 8; ++j) ((unsigned*)o)[lane + 64 * j] = pk4_f8(v[j][0], v[j][1], v[j][2], v[j][3]);
}
__device__ __forceinline__ void ph_norm1(KP Pk, Frame& F, int l) {
    unsigned char* ws = F.ws;
    const int gw = F.vcu * NWAVES + F.wave, NGW = F.G * NWAVES;
    const float* mod = (const float*)(ws + WS_MOD) + (size_t)l * 9 * 12288;
    bf16_t* X = (bf16_t*)(ws + WS_X); bf16_t* H = (bf16_t*)(ws + WS_H); const unsigned char* Y2 = ws + WS_Y2;
    for (int row = gw; row < TT; row += NGW) {
        const int r = modrow_of(row); f32x4 v[8];
        if (l == 0) load_row(row < TL ? Pk->in[I_X] + (size_t)row * D : Pk->in[I_CTX] + (size_t)(row - TL) * D, F.lane, v);
        else { load_row_bf16(X + (size_t)row * D, F.lane, v);
            add_y2(Y2 + (size_t)row * D, Y2 + ((size_t)TT + row) * D, (const float*)(ws + WS_MOD) + (size_t)r * 12288 + 5 * D, F.lane, v);
            if (row < TL) store_row_bf16(X + (size_t)row * D, F.lane, v); }
        const float rstd = row_rstd(v);
        modulate(v, rstd, Pk->in[I_N1W] + l * D, mod + (size_t)r * 12288, mod + (size_t)r * 12288 + D, F.lane);
        if (WIN_F8_L(l)) store_row_f8(ws + WS_H + (size_t)row * D, F.lane, v); else store_row_bf16(H + (size_t)row * D, F.lane, v);
    }
}
__device__ __forceinline__ void ph_hyena_filters(KP Pk, Frame& F, int u) {
    unsigned char* ws = F.ws;
    constexpr int HRS = 2052;
    LAS float* HR = (LAS float*)F.lds; LAS float* red = (LAS float*)(F.lds + 16 * HRS * 4);
    const int r16 = F.lane & 15, kg = F.lane >> 4;
    {
        const int lf = u >> 7, cg = u & 127, chl = r16 & 3, od = r16 >> 2, ch = cg * 4 + chl;
        const float* w3 = Pk->in[I_HW3] + (size_t)lf * 64 * 2048 + (od >> 1) * 1024 + (od & 1) * 512 + ch;
        bf16x8 wb[2];
#pragma unroll
        for (int ks = 0; ks < 2; ++ks) { float w[8];
#pragma unroll
            for (int j = 0; j < 8; ++j) w[j] = w3[(size_t)(32 * ks + 8 * kg + j) * 2048];
            u32x4 p; p.x = pk2(w[0], w[1]); p.y = pk2(w[2], w[3]); p.z = pk2(w[4], w[5]); p.w = pk2(w[6], w[7]); wb[ks] = __builtin_bit_cast(bf16x8, p); }
        const float dmin = 3.0701134573253940f, dmax = 15.350567286626972f, delta = dmin + (float)ch * ((dmax - dmin) / 511.f);
#pragma unroll 1
        for (int sel = 0; sel < 2; ++sel) {
            const int L = sel == 0 ? 2048 : 256; const float* h2 = (const float*)(ws + WS_HYH2) + ((size_t)lf * 2304 + (sel == 0 ? 0 : 2048)) * 64; const float rl = 1.f / (float)(L - 1);
            __syncthreads();
            float s = 0.f;
#pragma unroll 2
            for (int tile = F.wave; tile < L / 16; tile += NWAVES) {
                const f32x4* hp = (const f32x4*)(h2 + (size_t)(16 * tile + r16) * 64 + 8 * kg);
                const f32x4 a0 = hp[0], a1 = hp[1], a2 = hp[8], a3 = hp[9];
                u32x4 p0, p1; p0.x = pk2(a0[0], a0[1]); p0.y = pk2(a0[2], a0[3]); p0.z = pk2(a1[0], a1[1]); p0.w = pk2(a1[2], a1[3]); p1.x = pk2(a2[0], a2[1]); p1.y = pk2(a2[2], a2[3]); p1.z = pk2(a3[0], a3[1]); p1.w = pk2(a3[2], a3[3]);
                f32x4 d = MFMA16(__builtin_bit_cast(bf16x8, p0), wb[0], ((f32x4){0.f, 0.f, 0.f, 0.f})); d = MFMA16(__builtin_bit_cast(bf16x8, p1), wb[1], d);
                const int t0 = 16 * tile + 4 * kg;
#pragma unroll
                for (int i = 0; i < 4; ++i) { d[i] *= expf(-(float)(t0 + i) * rl * delta); s += fabsf(d[i]); }
                *(LAS f32x4*)(HR + r16 * HRS + t0) = d; }
            s += __shfl_xor(s, 16); s += __shfl_xor(s, 32);
            if (F.lane < 16) red[F.wave * 16 + F.lane] = s;
            __syncthreads();
            for (int e = F.tid; e < 16 * L; e += NTHR) { const int col = e / L, t = e % L, dir = (col >> 2) & 1, o = col >> 3, c = cg * 4 + (col & 3);
                float tot = 0.f;
#pragma unroll
                for (int w = 0; w < 8; ++w) tot += red[w * 16 + (col & ~4)] + red[w * 16 + (col | 4)];
                float hv = HR[col * HRS + t] / tot; int idx = dir == 0 ? L - t : L + t;
                if (dir == 1 && t == 0) { idx = 0; hv = 0.f; }
                ((bf16_t*)(ws + WS_HYF) + ((size_t)lf * 1024 + o * 512 + c) * 4608)[(sel == 0 ? 0 : 4096) + idx] = (bf16_t)f2bf(hv); }
        }
    }
}
__device__ __forceinline__ void ph_norm2_router(KP Pk, Frame& F, int l, int rep) {
    unsigned char* ws = F.ws;
    const int gw = F.vcu * NWAVES + F.wave, NGW = F.G * NWAVES, nrows = l == 0 ? TT : TL;
    const float* mod = (const float*)(ws + WS_MOD) + (size_t)l * 9 * 12288;
    const bf16_t* X = (const bf16_t*)(ws + WS_X); unsigned char* Fo = ws + WS_H;
    LAS float* rw = (LAS float*)F.lds;
    volatile LAS unsigned* lcnt = F.MISC + 16;
    if (F.tid < 16) lcnt[F.tid] = 0u;
    for (int i = F.tid; i < 2048 * 4; i += NTHR) { const f32x4 w = ((const f32x4*)Pk->in[I_RW])[i]; const int k = i >> 2, e0 = (i & 3) * 4;
        rw[(e0 + 0) * 2048 + k] = w[0]; rw[(e0 + 1) * 2048 + k] = w[1]; rw[(e0 + 2) * 2048 + k] = w[2]; rw[(e0 + 3) * 2048 + k] = w[3]; }
    __syncthreads();
    float rb[16];
#pragma unroll
    for (int e = 0; e < 16; ++e) rb[e] = Pk->in[I_RB][e];
    for (int rowA = gw; rowA < nrows; rowA += 2 * NGW) {
        const bool hasB = rowA + NGW < nrows; const int rowB = hasB ? rowA + NGW : rowA;
        f32x4 va[8], vb[8];
        load_row_bf16(X + (size_t)rowA * D, F.lane, va); load_row_bf16(X + (size_t)rowB * D, F.lane, vb);
        { const int r = modrow_of(rowA); const float rstd = row_rstd(va); modulate(va, rstd, Pk->in[I_N2W] + l * D, mod + (size_t)r * 12288 + 3 * D, mod + (size_t)r * 12288 + 4 * D, F.lane); store_row_f8(Fo + (size_t)rowA * D, F.lane, va); }
        { const int r = modrow_of(rowB); const float rstd = row_rstd(vb); modulate(vb, rstd, Pk->in[I_N2W] + l * D, mod + (size_t)r * 12288 + 3 * D, mod + (size_t)r * 12288 + 4 * D, F.lane); if (hasB) store_row_f8(Fo + (size_t)rowB * D, F.lane, vb); }
        float pa[32];
#pragma unroll
        for (int e = 0; e < 16; ++e) { f32x2 a = {0.f, 0.f}, b = {0.f, 0.f};
#pragma unroll
            for (int j = 0; j < 8; ++j) { const f32x4 w = ((const LAS f32x4*)(rw + e * 2048))[F.lane + 64 * j];
                const f32x2 wl = __builtin_shufflevector(w, w, 0, 1), wh = __builtin_shufflevector(w, w, 2, 3);
                a = __builtin_elementwise_fma(__builtin_shufflevector(va[j], va[j], 0, 1), wl, a); a = __builtin_elementwise_fma(__builtin_shufflevector(va[j], va[j], 2, 3), wh, a);
                b = __builtin_elementwise_fma(__builtin_shufflevector(vb[j], vb[j], 0, 1), wl, b); b = __builtin_elementwise_fma(__builtin_shufflevector(vb[j], vb[j], 2, 3), wh, b); }
            pa[e] = a[0] + a[1]; pa[16 + e] = b[0] + b[1]; }
#define RB_STEP(N, BIT) { const bool up = (F.lane & (BIT)) != 0; _Pragma("unroll") for (int k = 0; k < (N); ++k) { const float keep = up ? pa[(N) + k] : pa[k], send = up ? pa[k] : pa[(N) + k]; pa[k] = keep + __shfl_xor(send, (BIT)); } }
        RB_STEP(16, 32) RB_STEP(8, 16) RB_STEP(4, 8) RB_STEP(2, 4) RB_STEP(1, 2)
#undef RB_STEP
        const float red = pa[0] + __shfl_xor(pa[0], 1);
        float lg[16];
#pragma unroll
        for (int e = 0; e < 16; ++e) lg[e] = __shfl(red, (F.lane & 32) + 2 * e);
        float mx = lg[0];
#pragma unroll
        for (int e = 1; e < 16; ++e) mx = fmaxf(mx, lg[e]);
        float sum = 0.f;
#pragma unroll
        for (int e = 0; e < 16; ++e) { lg[e] = expf(lg[e] - mx); sum += lg[e]; }
        const float rs = 1.f / sum; float sel[16];
#pragma unroll
        for (int e = 0; e < 16; ++e) { lg[e] *= rs; sel[e] = lg[e] + rb[e]; }
        int grp = 0; float gbest = fmaxf(fmaxf(sel[0], sel[1]), fmaxf(sel[2], sel[3]));
#pragma unroll
        for (int g = 1; g < 4; ++g) { const float gm = fmaxf(fmaxf(sel[4 * g], sel[4 * g + 1]), fmaxf(sel[4 * g + 2], sel[4 * g + 3])); if (gm > gbest) { gbest = gm; grp = g; } }
        float s4[4], p4[4];
#pragma unroll
        for (int i = 0; i < 4; ++i) { s4[i] = grp == 0 ? sel[i] : grp == 1 ? sel[4 + i] : grp == 2 ? sel[8 + i] : sel[12 + i]; p4[i] = grp == 0 ? lg[i] : grp == 1 ? lg[4 + i] : grp == 2 ? lg[8 + i] : lg[12 + i]; }
        int i0 = 0; float b0 = s4[0];
#pragma unroll
        for (int i = 1; i < 4; ++i) if (s4[i] > b0) { b0 = s4[i]; i0 = i; }
        int i1 = -1; float b1 = 0.f;
#pragma unroll
        for (int i = 0; i < 4; ++i) if (i != i0 && (i1 < 0 || s4[i] > b1)) { b1 = s4[i]; i1 = i; }
        const float p0 = i0 == 0 ? p4[0] : i0 == 1 ? p4[1] : i0 == 2 ? p4[2] : p4[3], p1 = i1 == 0 ? p4[0] : i1 == 1 ? p4[1] : i1 == 2 ? p4[2] : p4[3];
        const int e0 = grp * 4 + i0, e1 = grp * 4 + i1; const float ws_ = 1.f / (p0 + p1);
        if (F.lane == 0 || (F.lane == 32 && hasB)) { const int row = F.lane == 0 ? rowA : rowB;
            ((int*)(ws + WS_RT + RT_E))[row] = e0 | (e1 << 8); ((f32x2*)(ws + WS_RT + RT_W))[row] = (f32x2){p0 * ws_, p1 * ws_};
            __hip_atomic_fetch_add((LAS unsigned*)&lcnt[e0], 1u, __ATOMIC_RELAXED, __HIP_MEMORY_SCOPE_WORKGROUP); __hip_atomic_fetch_add((LAS unsigned*)&lcnt[e1], 1u, __ATOMIC_RELAXED, __HIP_MEMORY_SCOPE_WORKGROUP); }
    }
    __syncthreads();
    { int t_; asm volatile("v_mbcnt_lo_u32_b32 %0, -1, 0\n\tv_mbcnt_hi_u32_b32 %0, -1, %0" : "=v"(t_)); t_ += F.wave * 64;
      if (t_ < 16 && lcnt[t_]) __hip_atomic_fetch_add(F.ctl + CW_CNT + 64 * (l + 2 * rep) + t_, lcnt[t_], __ATOMIC_RELAXED, __HIP_MEMORY_SCOPE_AGENT); }
}
__device__ __forceinline__ int moe_table(Frame& F, int l) {
    volatile LAS unsigned char* pexp = (volatile LAS unsigned char*)(F.MISC + 64);
    __syncthreads();
    if (F.tid < 64) {
        const int e = F.lane & 15; const int c = (int)__hip_atomic_load(F.ctl + CW_CNT + 64 * l + e, __ATOMIC_RELAXED, __HIP_MEMORY_SCOPE_AGENT);
        const int np = (c + 255) >> 8; int p0 = np;
#pragma unroll
        for (int d = 1; d < 16; d <<= 1) { const int y = __shfl(p0, F.lane - d); if (e >= d) p0 += y; }
        const int tot = __shfl(p0, 15); p0 -= np;
        if (F.lane < 16) { F.MISC[32 + e] = (unsigned)(p0 * 256); for (int j = 0; j < np; ++j) pexp[p0 + j] = (unsigned char)e; if (e == 0) F.MISC[2] = (unsigned)tot; }
    }
    __syncthreads();
    return (int)F.MISC[2];
}
__device__ __forceinline__ void ph_slots(KP Pk, Frame& F, int l) {
    unsigned char* ws = F.ws;
    const int nrows = l == 0 ? TT : TL, per = (nrows + F.G - 1) / F.G, t0 = blockIdx.x * per, t1 = min(nrows, t0 + per);
    (void)moe_table(F, l);
    volatile LAS unsigned* lcnt = F.MISC + 16; volatile LAS unsigned* lbase = F.MISC + 48;
    if (F.tid < 16) lcnt[F.tid] = 0u;
    __syncthreads();
    const int* RE = (const int*)(ws + WS_RT + RT_E); const f32x2* RW = (const f32x2*)(ws + WS_RT + RT_W);
    int* ROWTOK = (int*)(ws + WS_RT + RT_ROWTOK); float* ROWW = (float*)(ws + WS_RT + RT_ROWW);
    const int tok = t0 + F.tid; int e0 = 0, e1 = 0; unsigned q0 = 0, q1 = 0;
    if (tok < t1) { const int ee = RE[tok]; e0 = ee & 255; e1 = ee >> 8;
        q0 = __hip_atomic_fetch_add((LAS unsigned*)&lcnt[e0], 1u, __ATOMIC_RELAXED, __HIP_MEMORY_SCOPE_WORKGROUP); q1 = __hip_atomic_fetch_add((LAS unsigned*)&lcnt[e1], 1u, __ATOMIC_RELAXED, __HIP_MEMORY_SCOPE_WORKGROUP); }
    __syncthreads();
    if (F.tid < 16) lbase[F.tid] = lcnt[F.tid] ? __hip_atomic_fetch_add(F.ctl + CW_CUR + 64 * l + F.tid, lcnt[F.tid], __ATOMIC_RELAXED, __HIP_MEMORY_SCOPE_AGENT) : 0u;
    __syncthreads();
    if (tok < t1) { const f32x2 w = RW[tok]; const int r0 = (int)(F.MISC[32 + e0] + lbase[e0] + q0), r1 = (int)(F.MISC[32 + e1] + lbase[e1] + q1);
        ROWTOK[r0] = tok; ROWW[r0] = w.x; ROWTOK[r1] = tok | (1 << 30); ROWW[r1] = w.y; }
    if (blockIdx.x < NE) { const int e = blockIdx.x, c = (int)__hip_atomic_load(F.ctl + CW_CNT + 64 * l + e, __ATOMIC_RELAXED, __HIP_MEMORY_SCOPE_AGENT), base = (int)F.MISC[32 + e];
        for (int i = c + F.tid; i < ((c + 255) & ~255); i += NTHR) { ROWTOK[base + i] = -1; ROWW[base + i] = 0.f; } }
}
__device__ __forceinline__ void ph_final(KP Pk, Frame& F) {
    unsigned char* ws = F.ws;
    const int gw = F.vcu * NWAVES + F.wave, NGW = F.G * NWAVES;
    const bf16_t* X = (const bf16_t*)(ws + WS_X); const unsigned char* Y2 = ws + WS_Y2;
    for (int row = gw; row < TL; row += NGW) { f32x4 v[8];
        load_row_bf16(X + (size_t)row * D, F.lane, v);
        add_y2(Y2 + (size_t)row * D, Y2 + ((size_t)TT + row) * D, (const float*)(ws + WS_MOD) + ((size_t)9 + (row >> 11)) * 12288 + 5 * D, F.lane, v);
#pragma unroll
        for (int j = 0; j < 8; ++j) ((f32x4*)(Pk->out + (size_t)row * D))[F.lane + 64 * j] = v[j]; }
}

__device__ __forceinline__ void ph_gate_cols(Frame& F, int l) {
    unsigned char* ws = F.ws;
    const int r32 = F.lane & 31, hi = F.lane >> 5;
    const bf16_t* H = (const bf16_t*)(ws + WS_H); const bf16_t* Wa = (const bf16_t*)(ws + WS_WA) + (size_t)l * 32 * D; float* AG = (float*)(ws + WS_AG);
    LAS unsigned char* tile = F.lds + F.wave * 16896;
    LAS float* red = (LAS float*)F.lds;
    for (int it = blockIdx.x; it < TT / 32; it += F.G) {
        const int kb = F.wave * 256;
        u32x4 av[16]; bf16x8 bv[16];
#pragma unroll
        for (int i = 0; i < 16; ++i) { const int id = F.lane + 64 * i; av[i] = *(const u32x4*)(H + (size_t)(it * 32 + (id >> 5)) * D + kb + 8 * (id & 31)); }
#pragma unroll
        for (int ks = 0; ks < 16; ++ks) bv[ks] = *(const bf16x8*)(Wa + (size_t)r32 * D + kb + 16 * ks + 8 * hi);
        __syncthreads();
#pragma unroll
        for (int i = 0; i < 16; ++i) { const int id = F.lane + 64 * i; *(LAS u32x4*)(tile + ((id >> 5) * 264 + 8 * (id & 31)) * 2) = av[i]; }
        f32x16 acc = {};
#pragma unroll
        for (int ks = 0; ks < 16; ++ks) { const bf16x8 a = *(const LAS bf16x8*)(tile + (r32 * 264 + 16 * ks + 8 * hi) * 2); acc = MFMA32(a, bv[ks], acc); }
        __syncthreads();
#pragma unroll
        for (int r = 0; r < 16; ++r) red[(F.wave * 16 + r) * 64 + F.lane] = acc[r];
        __syncthreads();
        for (int e = F.tid; e < 1024; e += NTHR) { float sum = 0.f;
#pragma unroll
            for (int w = 0; w < 8; ++w) sum += red[w * 1024 + e];
            const int r = e >> 6, ln = e & 63; AG[(size_t)(it * 32 + (r & 3) + 8 * (r >> 2) + 4 * (ln >> 5)) * 32 + (ln & 31)] = sum; }
    }
}

__device__ __forceinline__ void ph_gate_cols8(Frame& F, int l) {
    unsigned char* ws = F.ws;
    const int fr = F.lane & 15, fq = F.lane >> 4, kb = F.wave * 256;
    const unsigned char* H8 = ws + WS_H; const unsigned char* Wa8 = ws + WS_WA + (size_t)l * 32 * D * 2; float* AG = (float*)(ws + WS_AG);
    LAS f32x4* red = (LAS f32x4*)F.lds;
    int f8scale = 0x7f7f7f7f; asm volatile("" : "+v"(f8scale));
    i32x8 b[2][2], a[2][2];
#pragma unroll
    for (int ch = 0; ch < 2; ++ch)
#pragma unroll
        for (int ks = 0; ks < 2; ++ks) b[ch][ks] = *(const i32x8*)(Wa8 + (size_t)(16 * ch + fr) * D + kb + 128 * ks + 32 * fq);
    int it = blockIdx.x;
    if (it < TT / 32) {
#pragma unroll
        for (int rh = 0; rh < 2; ++rh)
#pragma unroll
            for (int ks = 0; ks < 2; ++ks) a[rh][ks] = *(const i32x8*)(H8 + (size_t)(it * 32 + 16 * rh + fr) * D + kb + 128 * ks + 32 * fq); }
    for (; it < TT / 32; it += F.G) {
        f32x4 acc[2][2];
#pragma unroll
        for (int rh = 0; rh < 2; ++rh)
#pragma unroll
            for (int ch = 0; ch < 2; ++ch) acc[rh][ch] = (f32x4){0.f, 0.f, 0.f, 0.f};
#pragma unroll
        for (int ks = 0; ks < 2; ++ks)
#pragma unroll
            for (int rh = 0; rh < 2; ++rh)
#pragma unroll
                for (int ch = 0; ch < 2; ++ch)
                    asm volatile("v_mfma_scale_f32_16x16x128_f8f6f4 %0, %1, %2, %0, %3, %3 op_sel_hi:[0,0,0]" : "+v"(acc[rh][ch]) : "v"(b[ch][ks]), "v"(a[rh][ks]), "v"(f8scale));
        asm volatile("s_nop 15\n\ts_nop 15" : "+v"(acc[0][0]), "+v"(acc[0][1]), "+v"(acc[1][0]), "+v"(acc[1][1]) :: "memory");
        const int nx = it + F.G;
        if (nx < TT / 32) {
#pragma unroll
            for (int rh = 0; rh < 2; ++rh)
#pragma unroll
                for (int ks = 0; ks < 2; ++ks) a[rh][ks] = *(const i32x8*)(H8 + (size_t)(nx * 32 + 16 * rh + fr) * D + kb + 128 * ks + 32 * fq); }
        __syncthreads();
#pragma unroll
        for (int rh = 0; rh < 2; ++rh)
#pragma unroll
            for (int ch = 0; ch < 2; ++ch) red[(F.wave * 4 + rh * 2 + ch) * 64 + F.lane] = acc[rh][ch];
        __syncthreads();
        for (int e = F.tid; e < 1024; e += NTHR) { float sum = 0.f;
#pragma unroll
            for (int w = 0; w < 8; ++w) sum += ((const LAS float*)red)[w * 1024 + e];
            const int blk = e >> 8, ln = (e >> 2) & 63, k = e & 3;
            AG[(size_t)(it * 32 + 16 * (blk >> 1) + (ln & 15)) * 32 + 16 * (blk & 1) + 4 * (ln >> 4) + k] = sum * (1.f / 32.f); }
    }
}

constexpr int WAVE_LDS = 17408;
__device__ __forceinline__ int perm16(int k) { return (k & 3) + 4 * ((k >> 3) & 1) + 8 * ((k >> 2) & 1); }
__device__ __forceinline__ int gla_kidx(int dir, int s) { return dir == 0 ? s : (s < LC ? LC - 1 - s : LC + (SEQ - 1 - (s - LC))); }
constexpr int GL_QT = 0, GL_KT = 1280, GL_KHT = 2560, GL_VT = 4096, GL_PT = 7168, GL_ST = 7936, GL_G = 13056, GL_GW = 13312, GL_GB = 15360;
__device__ __forceinline__ void gla_load_gates(KP Pk, Frame& F, int l, int h, int dir, LAS unsigned char* wl) {
    LAS float* gw = (LAS float*)(wl + GL_GW); LAS float* gb = (LAS float*)(wl + GL_GB);
    const float* src = Pk->in[I_GGW] + ((size_t)(l * 2 + dir) * 16) * 256 + h * 32;
#pragma unroll
    for (int i = 0; i < 8; ++i) { const int e = F.lane + 64 * i; gw[e] = src[(e >> 5) * 256 + (e & 31)]; }
    if (F.lane < 32) gb[F.lane] = Pk->in[I_GGB][(l * 2 + dir) * 256 + h * 32 + F.lane];
}
struct GlaIn { f32x4 ag[4]; u32x4 kv, qv, v0, v1; };
template <bool NEEDQ>
__device__ __forceinline__ void gla_sub_load(Frame& F, int b, int h, int dir, int kidx0, GlaIn& in) {
    unsigned char* ws = F.ws;
    int lane_o = F.lane; asm volatile("" : "+v"(lane_o));
    const int tau = lane_o & 15, dq = lane_o >> 4, row = keyrow(b, kidx0 + tau);
    const f32x4* ag = (const f32x4*)((const float*)(ws + WS_AG) + (size_t)row * 32 + dir * 16);
#pragma unroll
    for (int r4 = 0; r4 < 4; ++r4) in.ag[r4] = ag[r4];
    const bf16_t* U = (const bf16_t*)(ws + WS_U) + (size_t)row * NU;
    in.kv = *(const u32x4*)(U + UC_GK + h * 32 + dq * 8);
    if (NEEDQ) in.qv = *(const u32x4*)(U + UC_GQ + h * 32 + dq * 8);
    in.v0 = *(const u32x4*)(U + UC_GV + h * 64 + dq * 16); in.v1 = *(const u32x4*)(U + UC_GV + h * 64 + dq * 16 + 8);
}
template <bool NEEDQ>
__device__ __forceinline__ void gla_sub_prep(Frame& F, int dir, const GlaIn& in, LAS unsigned char* wl, float (&ltot)[8]) {
    int lane_o = F.lane; asm volatile("" : "+v"(lane_o));
    const int tau = lane_o & 15, dq = lane_o >> 4;
    const LAS float* gw = (const LAS float*)(wl + GL_GW) + dq * 8; const LAS float* gb = (const LAS float*)(wl + GL_GB) + dq * 8;
    const f32x4* ag = in.ag;
    float x[8];
    { const f32x4 b0 = *(const LAS f32x4*)gb, b1 = *(const LAS f32x4*)(gb + 4); x[0] = b0[0]; x[1] = b0[1]; x[2] = b0[2]; x[3] = b0[3]; x[4] = b1[0]; x[5] = b1[1]; x[6] = b1[2]; x[7] = b1[3]; }
#pragma unroll
    for (int r4 = 0; r4 < 4; ++r4) { const f32x4 av = ag[r4];
#pragma unroll
        for (int rr = 0; rr < 4; ++rr) { const f32x4 w0 = *(const LAS f32x4*)(gw + (4 * r4 + rr) * 32), w1 = *(const LAS f32x4*)(gw + (4 * r4 + rr) * 32 + 4);
            x[0] += av[rr] * w0[0]; x[1] += av[rr] * w0[1]; x[2] += av[rr] * w0[2]; x[3] += av[rr] * w0[3]; x[4] += av[rr] * w1[0]; x[5] += av[rr] * w1[1]; x[6] += av[rr] * w1[2]; x[7] += av[rr] * w1[3]; } }
#pragma unroll
    for (int j = 0; j < 8; ++j) x[j] = (fminf(x[j], 0.f) - __logf(1.f + __expf(-fabsf(x[j])))) * (1.f / 16.f);
#pragma unroll
    for (int dl = 1; dl < 16; dl <<= 1) { const int src = dir == 0 ? F.lane - dl : F.lane + dl; const bool ok = dir == 0 ? (tau >= dl) : (tau + dl <= 15);
#pragma unroll
        for (int j = 0; j < 8; ++j) { const float y = __shfl(x[j], src); x[j] += ok ? y : 0.f; } }
    float tot[8];
#pragma unroll
    for (int j = 0; j < 8; ++j) { tot[j] = __shfl(x[j], (lane_o & 48) + (dir == 0 ? 15 : 0)); ltot[j] += tot[j]; }
    const u32x4 kv = in.kv;
    const float kf[8] = {bflo(kv.x), bfhi(kv.x), bflo(kv.y), bfhi(kv.y), bflo(kv.z), bfhi(kv.z), bflo(kv.w), bfhi(kv.w)};
    float kt[8], kh[8];
#pragma unroll
    for (int j = 0; j < 8; ++j) { kt[j] = kf[j] * __expf(-x[j]); kh[j] = kf[j] * __expf(tot[j] - x[j]); }
    { u32x4 w; w.x = pk2(kt[0], kt[1]); w.y = pk2(kt[2], kt[3]); w.z = pk2(kt[4], kt[5]); w.w = pk2(kt[6], kt[7]); *(LAS u32x4*)(wl + GL_KT + (tau * 40 + dq * 8) * 2) = w; }
#pragma unroll
    for (int j = 0; j < 8; ++j) *(LAS unsigned short*)(wl + GL_KHT + ((dq * 8 + j) * 24 + tau) * 2) = (unsigned short)f2bf(kh[j]);
    if (NEEDQ) { const u32x4 qv = in.qv; const float sc = 0.17677669529663687f;
        const float qf[8] = {bflo(qv.x), bfhi(qv.x), bflo(qv.y), bfhi(qv.y), bflo(qv.z), bfhi(qv.z), bflo(qv.w), bfhi(qv.w)}; float qt[8];
#pragma unroll
        for (int j = 0; j < 8; ++j) qt[j] = qf[j] * sc * __expf(x[j]);
        u32x4 w; w.x = pk2(qt[0], qt[1]); w.y = pk2(qt[2], qt[3]); w.z = pk2(qt[4], qt[5]); w.w = pk2(qt[6], qt[7]); *(LAS u32x4*)(wl + GL_QT + (tau * 40 + dq * 8) * 2) = w; }
    if (tau == 0) {
#pragma unroll
        for (int j = 0; j < 8; ++j) ((LAS float*)(wl + GL_G))[dq * 8 + j] = __expf(tot[j]); }
    { const u32x4 v0 = in.v0, v1 = in.v1;
      const unsigned vw[8] = {v0.x, v0.y, v0.z, v0.w, v1.x, v1.y, v1.z, v1.w};
#pragma unroll
      for (int j = 0; j < 8; ++j) { *(LAS unsigned short*)(wl + GL_VT + ((dq * 16 + 2 * j) * 24 + tau) * 2) = (unsigned short)(vw[j] & 0xffffu); *(LAS unsigned short*)(wl + GL_VT + ((dq * 16 + 2 * j + 1) * 24 + tau) * 2) = (unsigned short)(vw[j] >> 16); } }
}
__device__ __forceinline__ void gla_state_update(Frame& F, LAS unsigned char* wl, f32x4 (&Sr)[2][4]) {
    int lane_o = F.lane; asm volatile("" : "+v"(lane_o));
    const int r16 = lane_o & 15, kg = lane_o >> 4; const bf16x8 zf = {0, 0, 0, 0, 0, 0, 0, 0};
    bf16x8 vb[4];
#pragma unroll
    for (int nb = 0; nb < 4; ++nb) { vb[nb] = *(const LAS bf16x8*)(wl + GL_VT + ((16 * nb + r16) * 24 + 8 * (kg & 1)) * 2); if (kg >= 2) vb[nb] = zf; }
#pragma unroll
    for (int db = 0; db < 2; ++db) { const f32x4 gv = *(const LAS f32x4*)(wl + GL_G + (16 * db + 4 * kg) * 4);
        bf16x8 ka = *(const LAS bf16x8*)(wl + GL_KHT + ((16 * db + r16) * 24 + 8 * (kg & 1)) * 2); if (kg >= 2) ka = zf;
#pragma unroll
        for (int nb = 0; nb < 4; ++nb) Sr[db][nb] = MFMA16(ka, vb[nb], Sr[db][nb] * gv); }
}
constexpr int GGRP = 6, NGRP = NCH / GGRP;
constexpr size_t WS_GGS = WS_GSS, WS_GGA = WS_GSS + 8 * MiB;
__device__ __forceinline__ void gla_pass_a(KP Pk, Frame& F, int l, int it, LAS unsigned char* wl) {
    unsigned char* ws = F.ws;
    const int seq = it / NGRP, g = it % NGRP, dir = seq & 1, h = (seq >> 1) & 7, b = seq >> 4, r16 = F.lane & 15, kg = F.lane >> 4;
    gla_load_gates(Pk, F, l, h, dir, wl);
    f32x4 Sr[2][4];
#pragma unroll
    for (int db = 0; db < 2; ++db)
#pragma unroll
        for (int nb = 0; nb < 4; ++nb) Sr[db][nb] = (f32x4){0.f, 0.f, 0.f, 0.f};
    float ltot[8] = {0.f, 0.f, 0.f, 0.f, 0.f, 0.f, 0.f, 0.f};
    GlaIn nin;
    { const int c0 = g * GGRP; gla_sub_load<false>(F, b, h, dir, (dir == 0 ? 64 * c0 : gla_kidx(1, 64 * c0) - 63) + 16 * (dir == 0 ? 0 : 3), nin); }
#pragma unroll 1
    for (int cg = 0; cg <= GGRP; ++cg) {
        const int c = g * GGRP + cg;
        float* sl = cg < GGRP ? (float*)(ws + WS_GSL) + ((size_t)seq * NCH + c) * 2048 : (float*)(ws + WS_GGS) + ((size_t)seq * NGRP + g) * 2048;
        float* al = cg < GGRP ? (float*)(ws + WS_GAE) + ((size_t)seq * NCH + c) * 32 : (float*)(ws + WS_GGA) + ((size_t)seq * NGRP + g) * 32;
#pragma unroll
        for (int db = 0; db < 2; ++db)
#pragma unroll
            for (int nb = 0; nb < 4; ++nb)
#pragma unroll
                for (int i = 0; i < 4; ++i) sl[(16 * db + 4 * kg + i) * 64 + 16 * nb + r16] = Sr[db][nb][i];
        if ((F.lane & 15) == 0) {
#pragma unroll
            for (int j = 0; j < 8; ++j) al[kg * 8 + j] = __expf(ltot[j]); }
        if (cg == GGRP) break;
#pragma unroll 1
        for (int st = 0; st < 4; ++st) {
            const GlaIn cur = nin;
            { const int q2 = cg * 4 + st + 1, c2 = g * GGRP + (q2 >> 2), st2 = q2 & 3, sb2 = dir == 0 ? st2 : 3 - st2;
              if (q2 < 4 * GGRP) gla_sub_load<false>(F, b, h, dir, (dir == 0 ? 64 * c2 : gla_kidx(1, 64 * c2) - 63) + 16 * sb2, nin); }
            gla_sub_prep<false>(F, dir, cur, wl, ltot);
            gla_state_update(F, wl, Sr); }
    }
}
__device__ __forceinline__ void gla_pass_b(KP Pk, Frame& F, int l, int b, int h, int c, LAS unsigned char* wl) {
    unsigned char* ws = F.ws;
    const int r16 = F.lane & 15, kg = F.lane >> 4, seq = (b * 8 + h) * 2; const bf16x8 zf = {0, 0, 0, 0, 0, 0, 0, 0};
    const bf16_t* U = (const bf16_t*)(ws + WS_U); unsigned char* MIX = ws + WS_H;
    u32x2 of[4][4];
#pragma unroll 1
    for (int dir = 0; dir < 2; ++dir) {
        gla_load_gates(Pk, F, l, h, dir, wl);
        const int cc = dir == 0 ? c : (c < 4 ? 3 - c : 39 - c);
        f32x4 Sr[2][4];
#pragma unroll
        for (int db = 0; db < 2; ++db)
#pragma unroll
            for (int nb = 0; nb < 4; ++nb) Sr[db][nb] = (f32x4){0.f, 0.f, 0.f, 0.f};
        { const int gsel = cc / GGRP;
#pragma unroll 1
          for (int gp = 0; gp <= gsel; ++gp) {
            const bool fin = gp == gsel;
            const float* sp = fin ? (const float*)(ws + WS_GSL) + ((size_t)(seq + dir) * NCH + cc) * 2048 : (const float*)(ws + WS_GGS) + ((size_t)(seq + dir) * NGRP + gp) * 2048;
            const float* apx = fin ? (const float*)(ws + WS_GAE) + ((size_t)(seq + dir) * NCH + cc) * 32 : (const float*)(ws + WS_GGA) + ((size_t)(seq + dir) * NGRP + gp) * 32;
#pragma unroll
            for (int db = 0; db < 2; ++db) { const f32x4 av = *(const f32x4*)(apx + 16 * db + 4 * kg);
#pragma unroll
                for (int nb = 0; nb < 4; ++nb)
#pragma unroll
                    for (int i = 0; i < 4; ++i) Sr[db][nb][i] = av[i] * Sr[db][nb][i] + sp[(16 * db + 4 * kg + i) * 64 + 16 * nb + r16]; } } }
        float ltot[8] = {0.f, 0.f, 0.f, 0.f, 0.f, 0.f, 0.f, 0.f};
#pragma unroll 1
        for (int st = 0; st < 4; ++st) { const int sb = dir == 0 ? st : 3 - st;
            int lane_o = F.lane; asm volatile("" : "+v"(lane_o)); const int r16 = lane_o & 15, kg = lane_o >> 4;
#pragma unroll
            for (int db = 0; db < 2; ++db)
#pragma unroll
                for (int nb = 0; nb < 4; ++nb) { u32x2 w; w.x = pk2(Sr[db][nb][0], Sr[db][nb][1]); w.y = pk2(Sr[db][nb][2], Sr[db][nb][3]); *(LAS u32x2*)(wl + GL_ST + ((16 * nb + r16) * 40 + 16 * db + 4 * kg) * 2) = w; }
            { GlaIn in; gla_sub_load<true>(F, b, h, dir, 64 * c + 16 * sb, in); gla_sub_prep<true>(F, dir, in, wl, ltot); }
            const bf16x8 bq = *(const LAS bf16x8*)(wl + GL_QT + (r16 * 40 + 8 * kg) * 2);
            { const bf16x8 ka = *(const LAS bf16x8*)(wl + GL_KT + (r16 * 40 + 8 * kg) * 2);
              f32x4 p = MFMA16(ka, bq, ((f32x4){0.f, 0.f, 0.f, 0.f}));
#pragma unroll
              for (int i = 0; i < 4; ++i) { const int sidx = 4 * kg + i; const bool keep = dir == 0 ? (sidx <= r16) : (sidx >= r16); p[i] = keep ? p[i] : 0.f; }
              u32x2 w; w.x = pk2(p[0], p[1]); w.y = pk2(p[2], p[3]); *(LAS u32x2*)(wl + GL_PT + (r16 * 24 + 4 * kg) * 2) = w; }
            bf16x8 pb = *(const LAS bf16x8*)(wl + GL_PT + (r16 * 24 + 8 * (kg & 1)) * 2); if (kg >= 2) pb = zf;
            f32x4 o[4];
#pragma unroll
            for (int nb = 0; nb < 4; ++nb) { const bf16x8 sa = *(const LAS bf16x8*)(wl + GL_ST + ((16 * nb + r16) * 40 + 8 * kg) * 2);
                bf16x8 va = *(const LAS bf16x8*)(wl + GL_VT + ((16 * nb + r16) * 24 + 8 * (kg & 1)) * 2); if (kg >= 2) va = zf;
                o[nb] = MFMA16(sa, bq, ((f32x4){0.f, 0.f, 0.f, 0.f})); o[nb] = MFMA16(va, pb, o[nb]); }
            if (dir == 0) { u32x2 t[4];
#pragma unroll
                for (int nb = 0; nb < 4; ++nb) { t[nb].x = pk2(o[nb][0], o[nb][1]); t[nb].y = pk2(o[nb][2], o[nb][3]); }
#define OF_PUT(k) { _Pragma("unroll") for (int nb = 0; nb < 4; ++nb) of[k][nb] = t[nb]; }
                if (sb == 0) OF_PUT(0) else if (sb == 1) OF_PUT(1) else if (sb == 2) OF_PUT(2) else OF_PUT(3)
#undef OF_PUT
            }
            else { float ss = 0.f; u32x2 t[4];
#define OF_GET(k) { _Pragma("unroll") for (int nb = 0; nb < 4; ++nb) t[nb] = of[k][nb]; }
                if (sb == 0) OF_GET(0) else if (sb == 1) OF_GET(1) else if (sb == 2) OF_GET(2) else OF_GET(3)
#undef OF_GET
#pragma unroll
                for (int nb = 0; nb < 4; ++nb) { o[nb][0] += bflo(t[nb].x); o[nb][1] += bfhi(t[nb].x); o[nb][2] += bflo(t[nb].y); o[nb][3] += bfhi(t[nb].y); ss += (o[nb][0] * o[nb][0] + o[nb][1] * o[nb][1]) + (o[nb][2] * o[nb][2] + o[nb][3] * o[nb][3]); }
                ss += __shfl_xor(ss, 16); ss += __shfl_xor(ss, 32);
                const float rstd = rsqrtf(ss * (1.f / 64.f) + NORM_EPS); const int row = keyrow(b, 64 * c + 16 * sb + r16);
#pragma unroll
                for (int nb = 0; nb < 4; ++nb) { const int dv0 = 16 * nb + 4 * kg; const u32x2 gg = *(const u32x2*)(U + (size_t)row * NU + UC_GG + h * 64 + dv0); const f32x4 nw = *(const f32x4*)(Pk->in[I_GNW] + l * 64 + dv0);
                    const float y0 = o[nb][0] * rstd * nw[0] * silu_f(bflo(gg.x)), y1 = o[nb][1] * rstd * nw[1] * silu_f(bfhi(gg.x)), y2 = o[nb][2] * rstd * nw[2] * silu_f(bflo(gg.y)), y3 = o[nb][3] * rstd * nw[3] * silu_f(bfhi(gg.y));
                    if (WOUT_F8) *(unsigned*)(MIX + ((size_t)row * D + h * 64 + dv0)) = pk4_f8(y0, y1, y2, y3);
                    else { u32x2 w; w.x = pk2(y0, y1); w.y = pk2(y2, y3); *(u32x2*)(MIX + ((size_t)row * D + h * 64 + dv0) * 2) = w; } } }
            if (st < 3) gla_state_update(F, wl, Sr);
        }
    }
}
__device__ __forceinline__ float dpp_x1(float v) { return __builtin_bit_cast(float, __builtin_amdgcn_update_dpp(0, __builtin_bit_cast(int, v), 0xB1, 0xF, 0xF, true)); }
__device__ __forceinline__ float dpp_x2(float v) { return __builtin_bit_cast(float, __builtin_amdgcn_update_dpp(0, __builtin_bit_cast(int, v), 0x4E, 0xF, 0xF, true)); }
__device__ __forceinline__ float dpp_hm(float v) { return __builtin_bit_cast(float, __builtin_amdgcn_update_dpp(0, __builtin_bit_cast(int, v), 0x141, 0xF, 0xF, true)); }
__device__ __forceinline__ void qk_vec(bf16_t* p, const float (&w)[8], const float (&cs)[8], const float (&sn)[8]) {
    const u32x4 r = *(const u32x4*)p;
    float x[8] = {bflo(r.x), bfhi(r.x), bflo(r.y), bfhi(r.y), bflo(r.z), bfhi(r.z), bflo(r.w), bfhi(r.w)};
    float ss = 0.f;
#pragma unroll
    for (int e = 0; e < 8; ++e) ss += x[e] * x[e];
    ss += dpp_x1(ss); ss += dpp_x2(ss); ss += dpp_hm(ss);
    const float rstd = rsqrtf(ss * (1.f / 64.f) + NORM_EPS);
    float o[8];
#pragma unroll
    for (int e = 0; e < 8; ++e) { const float y = x[e] * rstd * w[e]; o[e] = y * cs[e] + dpp_x2(y) * sn[e]; }
    u32x4 q; q.x = pk2(o[0], o[1]); q.y = pk2(o[2], o[3]); q.z = pk2(o[4], o[5]); q.w = pk2(o[6], o[7]);
    *(u32x4*)p = q;
}
__device__ __forceinline__ void qk_rope(const unsigned char* ws, int row, int j, float (&cs)[8], float (&sn)[8]) {
    if (row < TL) { const float* rp = (const float*)(ws + WS_ROPE) + (size_t)(row & (SEQ - 1)) * 64 + 32 * (j >> 2) + 8 * (j & 1);
        const f32x4 c0 = *(const f32x4*)rp, c1 = *(const f32x4*)(rp + 4), s0 = *(const f32x4*)(rp + 16), s1 = *(const f32x4*)(rp + 20); const float sg = (j & 2) ? 1.f : -1.f;
#pragma unroll
        for (int e = 0; e < 4; ++e) { cs[e] = c0[e]; cs[4 + e] = c1[e]; sn[e] = sg * s0[e]; sn[4 + e] = sg * s1[e]; } }
    else {
#pragma unroll
        for (int e = 0; e < 8; ++e) { cs[e] = 1.f; sn[e] = 0.f; } }
}
__device__ __forceinline__ void prep_qk_rows4(KP Pk, Frame& F, int l, int row0) {
    unsigned char* ws = F.ws;
    bf16_t* U = (bf16_t*)(ws + WS_U);
    const int j = F.lane & 7; const float qs = 0.125f * LOG2E;
    float wsq[8], wdq[8], wdk[8], wsk[8];
    { const float* a = Pk->in[I_SQN] + l * 64 + 8 * j; const float* b = Pk->in[I_DQN] + l * 64 + 8 * j; const float* c = Pk->in[I_DKN] + l * 64 + 8 * j; const float* d = Pk->in[I_SKN] + l * 64 + 8 * j;
#pragma unroll
      for (int e = 0; e < 8; ++e) { wsq[e] = a[e] * qs; wdq[e] = b[e] * qs; wdk[e] = c[e]; wsk[e] = d[e]; } }
#pragma unroll 1
    for (int r = 0; r < 4; ++r) { const int row = row0 + r; float cs[8], sn[8];
        qk_rope(ws, row, j, cs, sn);
        bf16_t* up = U + (size_t)row * NU + 8 * F.lane;
        qk_vec(up + UC_SQ, wsq, cs, sn); qk_vec(up + UC_DQ, wdq, cs, sn); qk_vec(up + UC_DK, wdk, cs, sn); }
    { const int row = row0 + (F.lane >> 4); float cs[8], sn[8];
      qk_rope(ws, row, j, cs, sn);
      qk_vec(U + (size_t)row * NU + UC_SK + 8 * (F.lane & 15), wsk, cs, sn); }
}
template <bool PERMK, int NCOLS, class SRC>
__device__ __forceinline__ void tile_transpose(LAS unsigned char* wl, int lane, bf16_t* dst, size_t dst_stride, const SRC& src) {
    LAS unsigned* tl = (LAS unsigned*)wl;
    constexpr int ncols = NCOLS, cpr = NCOLS / 8;
    LDS_WAIT(); asm volatile("" ::: "memory");
#pragma unroll 1
    for (int k0 = 0; k0 < cpr; k0 += 4) { u32x4 v[4];
#pragma unroll
      for (int k = 0; k < 4; ++k) { const int id = lane + 64 * (k0 + k); v[k] = src(id / cpr, id % cpr); }
#pragma unroll
      for (int k = 0; k < 4; ++k) { const int id = lane + 64 * (k0 + k); LAS unsigned* p = tl + (id / cpr) * 65 + (id % cpr) * 4; p[0] = v[k].x; p[1] = v[k].y; p[2] = v[k].z; p[3] = v[k].w; } }
    LDS_WAIT(); asm volatile("" ::: "memory");
    const LAS unsigned short* ts = (const LAS unsigned short*)wl;
    const int cc = lane & 7;
    for (int dv = lane >> 3; dv < ncols; dv += 8) {
        unsigned short e[8];
#pragma unroll
        for (int i = 0; i < 8; ++i) { const int p = 8 * cc + i, srow = PERMK ? ((p & ~15) + perm16(p & 15)) : p; e[i] = ts[srow * 130 + dv]; }
        u32x4 o; o.x = e[0] | ((unsigned)e[1] << 16); o.y = e[2] | ((unsigned)e[3] << 16); o.z = e[4] | ((unsigned)e[5] << 16); o.w = e[6] | ((unsigned)e[7] << 16);
        *(u32x4*)(dst + (size_t)dv * dst_stride + 8 * cc) = o; }
}
__device__ __forceinline__ void ph_prep(KP Pk, Frame& F, int l, int rep) {
    unsigned char* ws = F.ws;
    const int gw = F.vcu * NWAVES + F.wave, NGW = F.G * NWAVES;
    LAS unsigned char* wl = F.lds + F.wave * WAVE_LDS;
    const bf16_t* U = (const bf16_t*)(ws + WS_U);
    const int n_gla = 128 * NGRP, n_hy = NB * (l == 0 ? 36 : 32) * 12, n_vd = NB * 4 * 36, n_vs = NB * 2 * 36, n_rows = rep ? 0 : TT / 4;
    if (gw < n_gla) { gla_pass_a(Pk, F, l, gw, wl); }
    const int total = n_hy + n_vd + n_vs + n_rows, nrest = NGW - n_gla;
    for (int it0 = gw - n_gla; it0 < total && gw >= n_gla; it0 += nrest) {
        int it = it0;
        if (it < n_hy) {
            const int ntile = l == 0 ? 36 : 32, b = it / (ntile * 12), r = it % (ntile * 12), tile = r / 12, cb = r % 12, c0 = cb * 128;
            const bool lat = tile < 32; const int p0 = lat ? 64 * tile : 64 * (tile - 32), Ls = lat ? SEQ : LC, rbase = lat ? b * SEQ : TL + b * LC;
            const float* cw = Pk->in[I_HCW] + (size_t)l * 3 * 1536 + c0 + (F.lane & 15) * 8; const float* cbias = Pk->in[I_HCB] + (size_t)l * 1536 + c0 + (F.lane & 15) * 8;
            float w0[8], w1[8], w2[8], wb[8];
#pragma unroll
            for (int k = 0; k < 8; ++k) { w0[k] = cw[k]; w1[k] = cw[1536 + k]; w2[k] = cw[3072 + k]; wb[k] = cbias[k]; }
            auto src = [&](int i, int ch) -> u32x4 { const int p = p0 + i; const bf16_t* up = U + (size_t)(rbase + p) * NU + UC_HY + c0 + ch * 8;
                const u32x4 m = *(const u32x4*)up; u32x4 a = {0u, 0u, 0u, 0u}, c = {0u, 0u, 0u, 0u};
                if (p > 0) a = *(const u32x4*)(up - NU); if (p + 1 < Ls) c = *(const u32x4*)(up + NU);
                const unsigned av[4] = {a.x, a.y, a.z, a.w}, mv[4] = {m.x, m.y, m.z, m.w}, cv[4] = {c.x, c.y, c.z, c.w}; unsigned o[4];
#pragma unroll
                for (int q = 0; q < 4; ++q) { const int k = 2 * q;
                    const float z0 = bflo(av[q]) * w0[k] + bflo(mv[q]) * w1[k] + bflo(cv[q]) * w2[k] + wb[k];
                    const float z1 = bfhi(av[q]) * w0[k + 1] + bfhi(mv[q]) * w1[k + 1] + bfhi(cv[q]) * w2[k + 1] + wb[k + 1];
                    o[q] = pk2(z0, z1); }
                return (u32x4){o[0], o[1], o[2], o[3]}; };
            tile_transpose<false, 128>(wl, F.lane, (bf16_t*)(ws + WS_ZT) + ((size_t)b * 1536 + c0) * KEYS + (lat ? p0 : SEQ + p0), KEYS, src);
            continue; } it -= n_hy;
        if (it < n_vd) {
            const int b = it / 144, r = it % 144, h = r / 36, tile = r % 36;
            auto src = [&](int i, int ch) -> u32x4 { return *(const u32x4*)(U + (size_t)keyrow(b, 64 * tile + i) * NU + UC_DV + h * 128 + ch * 8); };
            tile_transpose<true, 128>(wl, F.lane, (bf16_t*)(ws + WS_VTD) + ((size_t)(b * 4 + h) * 128) * KEYS + 64 * tile, KEYS, src);
            continue; } it -= n_vd;
        if (it < n_vs) {
            const int b = it / 72, r = it % 72, h = r / 36, tile = r % 36;
            auto src = [&](int i, int ch) -> u32x4 { return *(const u32x4*)(U + (size_t)keyrow(b, 64 * tile + i) * NU + UC_SV + h * 64 + ch * 8); };
            tile_transpose<true, 64>(wl, F.lane, (bf16_t*)(ws + WS_VTS) + ((size_t)(b * 2 + h) * 64) * KEYS + 64 * tile, KEYS, src);
            continue; } it -= n_vs;
        prep_qk_rows4(Pk, F, l, it * 4);
    }
}
__device__ __forceinline__ void ph_gla_scan(Frame& F) {
    unsigned char* ws = F.ws;
    const int gw = F.vcu * NWAVES + F.wave, NGW = F.G * NWAVES;
    for (int it = gw; it < 128 * 32; it += NGW) { const int seq = it >> 5, d = it & 31;
        const float* sl = (const float*)(ws + WS_GSL) + (size_t)seq * NCH * 2048 + d * 64 + F.lane; float* ss = (float*)(ws + WS_GSS) + (size_t)seq * NCH * 2048 + d * 64 + F.lane;
        const float* ae = (const float*)(ws + WS_GAE) + (size_t)seq * NCH * 32 + d;
        float x[NCH], a[NCH];
#pragma unroll
        for (int c = 0; c < NCH; ++c) { x[c] = sl[(size_t)c * 2048]; a[c] = ae[c * 32]; }
        float S = 0.f;
#pragma unroll
        for (int c = 0; c < NCH; ++c) { ss[(size_t)c * 2048] = S; S = a[c] * S + x[c]; }
    }
}

__device__ __forceinline__ int crow(int r, int hi) { return (r & 3) + 8 * (r >> 2) + 4 * hi; }
template <int KW, int DV, bool MASK>
__device__ __forceinline__ void attn_core(Frame& F, const bf16_t* U, int b, int kcol0, const bf16_t* VT, int nctx, int nloc, int loc0,
                                          const bf16x8 (&q)[4], int koff, int qpos0, float sh2, f32x16 (&O)[DV / 32], float& lsum) {
    constexpr int KRB = KW * 2, KB = 64 * KRB, VB = DV * 128, SLOT = KB + VB, NKC = KB / 8192, NVC = VB / 8192, NDMA = NKC + NVC;
    const int r32 = F.lane & 31, hi = F.lane >> 5, nt = nctx + nloc;
#define ATT_DMA(ti) do { const int _k0 = (ti) < nctx ? 64 * (ti) : loc0 + 64 * ((ti) - nctx); LAS unsigned char* _sl = F.lds + ((ti) & 3) * SLOT; \
        _Pragma("unroll") for (int _j = 0; _j < NKC; ++_j) { const int _ch = F.wave + 8 * _j; int _row, _c; \
            if (KW == 128) { _row = 4 * _ch + (F.lane >> 4); _c = (F.lane & 15) ^ (_row & 15); } else { _row = 8 * _ch + (F.lane >> 3); _c = (F.lane & 7) ^ ((_row >> 1) & 7); } \
            __builtin_amdgcn_global_load_lds((const unsigned*)(U + (size_t)keyrow(b, _k0 + _row) * NU + kcol0 + _c * 8), (LAS unsigned*)(_sl + _ch * 1024), 16, 0, 0); } \
        _Pragma("unroll") for (int _j = 0; _j < NVC; ++_j) { const int _ch = F.wave + 8 * _j, _row = 8 * _ch + (F.lane >> 3), _c = (F.lane & 7) ^ ((_row >> 1) & 7); \
            __builtin_amdgcn_global_load_lds((const unsigned*)(VT + (size_t)_row * KEYS + _k0 + _c * 8), (LAS unsigned*)(_sl + KB + _ch * 1024), 16, 0, 0); } } while (0)
    f32x16 s0, s1; bf16x8 pa[4];
#define DSR(dst, addr, off) asm volatile("ds_read_b128 %0, %1 offset:%2" : "=v"(dst) : "v"(addr), "n"(off))
#define LWAIT4(f) asm volatile("s_waitcnt lgkmcnt(0)" : "+v"(f[0]), "+v"(f[1]), "+v"(f[2]), "+v"(f[3]))
    unsigned kad[4], vad[4];
#pragma unroll
    for (int i = 0; i < 4; ++i) { const int c = 2 * i + hi;
        kad[i] = (unsigned)(uintptr_t)F.lds + (KW == 128 ? r32 * 256 + ((((koff >> 3) + c) ^ (r32 & 15)) << 4) : r32 * 128 + ((c ^ ((r32 >> 1) & 7)) << 4));
        vad[i] = (unsigned)(uintptr_t)F.lds + KB + r32 * 128 + ((c ^ ((r32 >> 1) & 7)) << 4); }
    __syncthreads();
    ATT_DMA(0);
    if (nt > 1) ATT_DMA(1);
    if (nt > 2) ATT_DMA(2);
    if (nt > 2) asm volatile("s_waitcnt vmcnt(%0)" :: "n"(NDMA) : "memory"); else asm volatile("s_waitcnt vmcnt(0)" ::: "memory");
    __syncthreads();
#define EXP1(ti, r) do { s0[r] = __builtin_amdgcn_exp2f(s0[r]); s1[r] = __builtin_amdgcn_exp2f(s1[r]); \
        if (MASK && (ti) >= nctx) { const int k0 = loc0 - LC + 64 * ((ti) - nctx) + crow(r, hi), k1 = k0 + 32, d0 = qpos0 + r32 - k0, d1 = d0 - 32; \
            if (k0 < 0 || k0 >= SEQ || d0 > 128 || d0 < -128) s0[r] = 0.f; if (k1 < 0 || k1 >= SEQ || d1 > 128 || d1 < -128) s1[r] = 0.f; } } while (0)
#define RD_K(f, h) do { DSR(f[0], ka[2 * (h)], 0); DSR(f[1], ka[2 * (h)], 32 * KRB); DSR(f[2], ka[2 * (h) + 1], 0); DSR(f[3], ka[2 * (h) + 1], 32 * KRB); } while (0)
#define RD_V(f, nb) do { DSR(f[0], va[0], (nb) * 4096); DSR(f[1], va[1], (nb) * 4096); DSR(f[2], va[2], (nb) * 4096); DSR(f[3], va[3], (nb) * 4096); } while (0)
#define SB() __builtin_amdgcn_sched_barrier(0)
#define PKW(S, B) pg8::cvt_pk_bf16(S[B], S[(B) + 1])
#define PV1(f, nb, kk, ti, R0, NE) do { O[nb] = MFMA32(pa[kk], f[kk], O[nb]); if (more) { _Pragma("unroll") for (int _r = 0; _r < (NE); ++_r) EXP1(ti, (R0) + _r); } SB(); } while (0)
    {
        bf16x8 fa[4], fb[4]; unsigned ka[4];
#pragma unroll
        for (int i = 0; i < 4; ++i) ka[i] = kad[i];
        RD_K(fa, 0); RD_K(fb, 1);
#pragma unroll
        for (int r = 0; r < 16; ++r) { s0[r] = -sh2; s1[r] = -sh2; }
        LWAIT4(fa); LWAIT4(fb);
        s0 = MFMA32(fa[0], q[0], s0); s1 = MFMA32(fa[1], q[0], s1); s0 = MFMA32(fa[2], q[1], s0); s1 = MFMA32(fa[3], q[1], s1);
        s0 = MFMA32(fb[0], q[2], s0); s1 = MFMA32(fb[1], q[2], s1); s0 = MFMA32(fb[2], q[3], s0); s1 = MFMA32(fb[3], q[3], s1);
#pragma unroll
        for (int r = 0; r < 16; ++r) EXP1(0, r);
    }
#define ATT_STEP(MORE) { \
        constexpr bool more = (MORE); \
        if (t + 3 < nt) ATT_DMA(t + 3); \
        unsigned ka[4], va[4]; \
        { int lo_ = F.lane; asm volatile("" : "+v"(lo_)); const int rr = lo_ & 31, hh = lo_ >> 5; \
        _Pragma("unroll") \
          for (int i = 0; i < 4; ++i) { const int c = 2 * i + hh; \
            ka[i] = (unsigned)(uintptr_t)F.lds + ((t + 1) & 3) * SLOT + (KW == 128 ? rr * 256 + ((((koff >> 3) + c) ^ (rr & 15)) << 4) : rr * 128 + ((c ^ ((rr >> 1) & 7)) << 4)); \
            va[i] = (unsigned)(uintptr_t)F.lds + (t & 3) * SLOT + KB + rr * 128 + ((c ^ ((rr >> 1) & 7)) << 4); } } \
        bf16x8 fa[4], fb[4]; \
        if (more) { RD_K(fa, 0); RD_K(fb, 1); } else { RD_V(fa, 0); } \
        SB(); \
 \
        { float ps = 0.f; \
        _Pragma("unroll") \
          for (int r = 0; r < 16; ++r) ps += s0[r] + s1[r]; \
          lsum += ps; \
          u32x4 w; \
          w.x = PKW(s0, 0); w.y = PKW(s0, 2); w.z = PKW(s0, 4); w.w = PKW(s0, 6); pa[0] = __builtin_bit_cast(bf16x8, w); \
          w.x = PKW(s0, 8); w.y = PKW(s0, 10); w.z = PKW(s0, 12); w.w = PKW(s0, 14); pa[1] = __builtin_bit_cast(bf16x8, w); \
          w.x = PKW(s1, 0); w.y = PKW(s1, 2); w.z = PKW(s1, 4); w.w = PKW(s1, 6); pa[2] = __builtin_bit_cast(bf16x8, w); \
          w.x = PKW(s1, 8); w.y = PKW(s1, 10); w.z = PKW(s1, 12); w.w = PKW(s1, 14); pa[3] = __builtin_bit_cast(bf16x8, w); } \
        if (more) { \
        _Pragma("unroll") \
            for (int r = 0; r < 16; ++r) { s0[r] = -sh2; s1[r] = -sh2; } \
        } \
        SB(); \
        if (more) { \
            LWAIT4(fa); LWAIT4(fb); \
            s0 = MFMA32(fa[0], q[0], s0); s1 = MFMA32(fa[1], q[0], s1); s0 = MFMA32(fa[2], q[1], s0); s1 = MFMA32(fa[3], q[1], s1); \
            SB(); RD_V(fa, 0); SB(); \
            s0 = MFMA32(fb[0], q[2], s0); s1 = MFMA32(fb[1], q[2], s1); s0 = MFMA32(fb[2], q[3], s0); s1 = MFMA32(fb[3], q[3], s1); \
            SB(); \
        } \
        LWAIT4(fa); RD_V(fb, 1); SB(); \
        if (DV == 128) { \
            PV1(fa, 0, 0, t + 1, 0, 1); PV1(fa, 0, 1, t + 1, 1, 1); PV1(fa, 0, 2, t + 1, 2, 1); PV1(fa, 0, 3, t + 1, 3, 1); \
            LWAIT4(fb); RD_V(fa, 2); SB(); \
            PV1(fb, 1, 0, t + 1, 4, 1); PV1(fb, 1, 1, t + 1, 5, 1); PV1(fb, 1, 2, t + 1, 6, 1); PV1(fb, 1, 3, t + 1, 7, 1); \
            LWAIT4(fa); RD_V(fb, 3); SB(); \
            PV1(fa, 2, 0, t + 1, 8, 1); PV1(fa, 2, 1, t + 1, 9, 1); PV1(fa, 2, 2, t + 1, 10, 1); PV1(fa, 2, 3, t + 1, 11, 1); \
            LWAIT4(fb); SB(); \
            PV1(fb, 3, 0, t + 1, 12, 1); PV1(fb, 3, 1, t + 1, 13, 1); PV1(fb, 3, 2, t + 1, 14, 1); PV1(fb, 3, 3, t + 1, 15, 1); \
        } else { \
            PV1(fa, 0, 0, t + 1, 0, 2); PV1(fa, 0, 1, t + 1, 2, 2); PV1(fa, 0, 2, t + 1, 4, 2); PV1(fa, 0, 3, t + 1, 6, 2); \
            LWAIT4(fb); SB(); \
            PV1(fb, 1, 0, t + 1, 8, 2); PV1(fb, 1, 1, t + 1, 10, 2); PV1(fb, 1, 2, t + 1, 12, 2); PV1(fb, 1, 3, t + 1, 14, 2); \
        } \
        if (t + 3 < nt) asm volatile("s_waitcnt vmcnt(%0)" :: "n"(NDMA) : "memory"); else asm volatile("s_waitcnt vmcnt(0)" ::: "memory"); \
        __syncthreads(); \
    }
    int t = 0;
#pragma unroll 1
    for (; t + 1 < nt; ++t) ATT_STEP(true)
    ATT_STEP(false)
#undef ATT_STEP
#undef EXP1
#undef SB
#undef PKW
#undef PV1
#undef RD_K
#undef RD_V
#undef DSR
#undef LWAIT4
#undef ATT_DMA
}
__device__ __forceinline__ float score_bound(const float* wq, const float* wk, int lane) {
    float a = fabsf(wq[lane]), c = fabsf(wk[lane]);
#pragma unroll
    for (int o = 1; o < 64; o <<= 1) { a = fmaxf(a, __shfl_xor(a, o)); c = fmaxf(c, __shfl_xor(c, o)); }
    return 64.f * a * c * 0.125f * LOG2E;
}
__device__ __forceinline__ void diff_unit(KP Pk, Frame& F, int l, int b, int h, int qrow0, int nkt) {
    unsigned char* ws = F.ws;
    const bf16_t* U = (const bf16_t*)(ws + WS_U);
    const int m = F.wave & 1, rb = F.wave >> 1;
    const float sh2 = score_bound(Pk->in[I_DQN] + l * 64, Pk->in[I_DKN] + l * 64, F.lane);
    bf16x8 q[4];
    { const bf16_t* qp = U + (size_t)(qrow0 + 32 * rb + (F.lane & 31)) * NU + UC_DQ + h * 128 + m * 64 + 8 * (F.lane >> 5);
#pragma unroll
      for (int ks = 0; ks < 4; ++ks) q[ks] = *(const bf16x8*)(qp + 16 * ks); }
    f32x16 O[4];
#pragma unroll
    for (int nb = 0; nb < 4; ++nb) O[nb] = (f32x16){};
    float lsum = 0.f;
    attn_core<128, 128, false>(F, U, b, UC_DK + h * 128, (const bf16_t*)(ws + WS_VTD) + ((size_t)(b * 4 + h) * 128) * KEYS, nkt, 0, 0, q, 64 * m, 0, sh2, O, lsum);
    int ln_; asm volatile("v_mbcnt_lo_u32_b32 %0, -1, 0\n\tv_mbcnt_hi_u32_b32 %0, -1, %0" : "=v"(ln_));
    const int r32 = ln_ & 31, hi = ln_ >> 5;
    { int lo_ = l; asm volatile("" : "+s"(lo_)); l = lo_; Pk = kp_opaque(Pk); }
    lsum += __shfl_xor(lsum, 32);
    const float rl = 1.f / lsum;
    LAS float* ex = (LAS float*)F.lds + rb * 4096;
    float rlr[16];
#pragma unroll
    for (int r = 0; r < 16; ++r) rlr[r] = __shfl(rl, crow(r, hi));
    if (m == 1) {
#pragma unroll
        for (int nb = 0; nb < 4; ++nb)
#pragma unroll
            for (int r = 0; r < 16; ++r) ex[crow(r, hi) * 128 + nb * 32 + r32] = O[nb][r] * rlr[r];
    }
    __syncthreads();
    if (m == 0) {
        const float* dl = Pk->in[I_DLAM] + l * 256; const float lam_init = __builtin_bit_cast(float, __builtin_amdgcn_readfirstlane(__builtin_bit_cast(int, l == 0 ? 0.2f : (0.8f - 0.6f * 0.74081822068f))));
        const float lam = expf(wave_sum(dl[ln_] * dl[64 + ln_])) - expf(wave_sum(dl[128 + ln_] * dl[192 + ln_])) + lam_init;
        float ssq[16];
#pragma unroll
        for (int r = 0; r < 16; ++r) { float a = 0.f;
#pragma unroll
            for (int nb = 0; nb < 4; ++nb) { const float v = O[nb][r] * rlr[r] - lam * ex[crow(r, hi) * 128 + nb * 32 + r32]; O[nb][r] = v; a += v * v; }
            a += __shfl_xor(a, 1); a += __shfl_xor(a, 2); a += __shfl_xor(a, 4); a += __shfl_xor(a, 8); a += __shfl_xor(a, 16);
            ssq[r] = rsqrtf(a * (1.f / 128.f) + NORM_EPS) * (1.f - lam_init); }
        unsigned char* mix = ws + WS_H + ((size_t)(qrow0 + 32 * rb) * D + 1536 + h * 128) * MIXB;
#pragma unroll
        for (int nb = 0; nb < 4; ++nb) { const float w = Pk->in[I_DSUB][l * 128 + nb * 32 + r32];
#pragma unroll
            for (int r = 0; r < 16; ++r) { const float y = O[nb][r] * ssq[r] * w; const size_t e = (size_t)crow(r, hi) * D + nb * 32 + r32; if (WOUT_F8) mix[e] = f8_1(y); else ((bf16_t*)mix)[e] = (bf16_t)f2bf(y); } }
    }
}
__device__ __forceinline__ void swa_unit(KP Pk, Frame& F, int l, int b, int kvh, int qrow0, int qpos0, bool latent) {
    unsigned char* ws = F.ws;
    const bf16_t* U = (const bf16_t*)(ws + WS_U);
    const int hq = kvh * 4 + (F.wave & 3), rb = F.wave >> 2;
    const float sh2 = score_bound(Pk->in[I_SQN] + l * 64, Pk->in[I_SKN] + l * 64, F.lane);
    bf16x8 q[4];
    { const bf16_t* qp = U + (size_t)(qrow0 + 32 * rb + (F.lane & 31)) * NU + UC_SQ + hq * 64 + 8 * (F.lane >> 5);
#pragma unroll
      for (int ks = 0; ks < 4; ++ks) q[ks] = *(const bf16x8*)(qp + 16 * ks); }
    f32x16 O[2]; O[0] = (f32x16){}; O[1] = (f32x16){};
    float lsum = 0.f;
    int nloc = 0, loc0 = 0;
    if (latent) { int kp0 = qpos0 - 128, kp1 = qpos0 + 64 + 128; if (kp0 < 0) kp0 = 0; if (kp1 > SEQ) kp1 = SEQ; nloc = (kp1 - kp0) / 64; loc0 = LC + kp0; }
    const bf16_t* VT = (const bf16_t*)(ws + WS_VTS) + ((size_t)(b * 2 + kvh) * 64) * KEYS;
    attn_core<64, 64, true>(F, U, b, UC_SK + kvh * 64, VT, 4, nloc, loc0, q, 0, qpos0 + 32 * rb, sh2, O, lsum);
    int ln_; asm volatile("v_mbcnt_lo_u32_b32 %0, -1, 0\n\tv_mbcnt_hi_u32_b32 %0, -1, %0" : "=v"(ln_));
    const int r32 = ln_ & 31, hi = ln_ >> 5;
    { int lo_ = l; asm volatile("" : "+s"(lo_)); l = lo_; Pk = kp_opaque(Pk); }
    lsum += __shfl_xor(lsum, 32);
    const float rl = 1.f / (lsum + exp2f(Pk->in[I_SINK][l * 8 + hq] * LOG2E - sh2));
    unsigned char* mix = ws + WS_H + ((size_t)(qrow0 + 32 * rb) * D + 512 + hq * 64) * MIXB;
#pragma unroll
    for (int r = 0; r < 16; ++r) { const float rr = __shfl(rl, crow(r, hi));
#pragma unroll
        for (int nb = 0; nb < 2; ++nb) { const float y = O[nb][r] * rr; const size_t e = (size_t)crow(r, hi) * D + nb * 32 + r32; if (WOUT_F8) mix[e] = f8_1(y); else ((bf16_t*)mix)[e] = (bf16_t)f2bf(y); } }
}
constexpr int HY_PAD = 224, YSTR = 2504, HY_YB = 8 * YSTR * 2, HY_CST = 8224, HY_COP = 2 * HY_YB;
__device__ __forceinline__ void hyena_unit(KP Pk, Frame& F, int l, int cg) {
    unsigned char* ws = F.ws;
    const int r32 = F.lane & 31, hi = F.lane >> 5, bb = r32 >> 2, ib = r32 & 3;
    const bf16_t* ZT = (const bf16_t*)(ws + WS_ZT); bf16_t* OT = (bf16_t*)(ws + WS_OT);
    LAS unsigned char* cop = F.lds + HY_COP;
    const int nseq = l == 0 ? 2 : 1;
#pragma unroll 1
    for (int cs = 0; cs < 4 * nseq; ++cs) {
        const int ci = cs >> (nseq - 1), st = cs & (nseq - 1), ch = cg * 4 + ci, L = st == 0 ? SEQ : LC, nblk = L / 32, pos0 = st == 0 ? 0 : SEQ;
        __syncthreads();
        for (int id = F.tid; id < 8 * (L / 8 + 56); id += NTHR) { const int b = id / (L / 8 + 56), c = id % (L / 8 + 56);
            if (c < L / 8) *(LAS u32x4*)(F.lds + (b * YSTR + HY_PAD + 8 * c) * 2) = *(const u32x4*)(ZT + ((size_t)b * 1536 + 1024 + ch) * KEYS + pos0 + 8 * c);
            else { const int pc = c - L / 8, off = pc < 28 ? 8 * pc : HY_PAD + L + 8 * (pc - 28); const u32x4 z = {0u, 0u, 0u, 0u};
                *(LAS u32x4*)(F.lds + (b * YSTR + off) * 2) = z; *(LAS u32x4*)(F.lds + HY_YB + (b * YSTR + off) * 2) = z; } }
#pragma unroll 1
        for (int o = 0; o < 2; ++o) {
            const bf16_t* R = (const bf16_t*)(ws + WS_HYF) + ((size_t)l * 1024 + o * 512 + ch) * 4608 + (st == 0 ? 0 : 4096);
            for (int xc = F.tid; xc < 2 * L / 8; xc += NTHR) { const u32x4 lo = *(const u32x4*)(R + 8 * xc); u32x4 hh = {0u, 0u, 0u, 0u}; if (8 * xc + 8 < 2 * L) hh = *(const u32x4*)(R + 8 * xc + 8);
                const unsigned w[9] = {lo.x, lo.y, lo.z, lo.w, hh.x, hh.y, hh.z, hh.w, 0u};
#pragma unroll
                for (int r = 0; r < 8; ++r) { u32x4 ov; unsigned t[4];
#pragma unroll
                    for (int k = 0; k < 4; ++k) t[k] = (r & 1) ? ((w[(r >> 1) + k] >> 16) | (w[(r >> 1) + k + 1] << 16)) : w[(r >> 1) + k];
                    ov.x = t[0]; ov.y = t[1]; ov.z = t[2]; ov.w = t[3]; *(LAS u32x4*)(cop + r * HY_CST + 16 * xc) = ov; } }
            __syncthreads();
            const LAS unsigned char* Yin = F.lds + (o == 0 ? 0 : HY_YB); LAS unsigned char* Yout = F.lds + (o == 0 ? HY_YB : 0);
            const float bias = Pk->in[I_HBIAS][(l * 2 + o) * 512 + ch];
            if (2 * F.wave < nblk / 4) {
                const int g0 = 2 * F.wave, dlo = 4 * g0 - nblk + 1, dhi = min(4 * g0 + 7, nblk - 1), nsteps = dhi - dlo + 1;
                const LAS unsigned char* ap = cop + ((-r32) & 7) * HY_CST + ((L - 32 * dlo - r32 + 8 * hi) & ~7) * 2;
                const LAS unsigned char* bp = Yin + (bb * YSTR + HY_PAD + 32 * (4 * g0 + ib - dlo) + 8 * hi) * 2;
                f32x16 acc0 = {}, acc1 = {};
#define HDSR(dst, addr, off) asm volatile("ds_read_b128 %0, %1 offset:%2" : "=v"(dst) : "v"(addr), "n"(off))
#define HWAIT(a, b, c, d) asm volatile("s_waitcnt lgkmcnt(0)" : "+v"(a), "+v"(b), "+v"(c), "+v"(d))
                bf16x8 R[6][2], A2[2][2];
                const unsigned apa = (unsigned)(uintptr_t)ap, bpa = (unsigned)(uintptr_t)bp;
                HDSR(R[2][0], bpa, 256); HDSR(R[2][1], bpa, 256 + 32); HDSR(R[3][0], bpa, 192); HDSR(R[3][1], bpa, 192 + 32);
                HDSR(R[4][0], bpa, 128); HDSR(R[4][1], bpa, 128 + 32); HDSR(R[5][0], bpa, 64); HDSR(R[5][1], bpa, 64 + 32);
                HDSR(R[0][0], bpa, 0); HDSR(R[0][1], bpa, 32); HDSR(A2[0][0], apa, 0); HDSR(A2[0][1], apa, 32);
                HWAIT(R[2][0], R[2][1], R[3][0], R[3][1]); HWAIT(R[4][0], R[4][1], R[5][0], R[5][1]); HWAIT(R[0][0], R[0][1], A2[0][0], A2[0][1]);
#pragma unroll 1
                for (int s0 = 0; s0 < nsteps; s0 += 6) {
                    const unsigned an = apa - (unsigned)(s0 + 6) * 64u, bn = bpa - (unsigned)(s0 + 6) * 64u;
#pragma unroll
                    for (int j = 0; j < 6; ++j) if (s0 + j < nsteps) {
                        if (s0 + j + 1 < nsteps) { HDSR(A2[(j + 1) & 1][0], an, (5 - j) * 64); HDSR(A2[(j + 1) & 1][1], an, (5 - j) * 64 + 32);
                            HDSR(R[(j + 1) % 6][0], bn, (5 - j) * 64); HDSR(R[(j + 1) % 6][1], bn, (5 - j) * 64 + 32); }
                        acc1 = MFMA32(A2[j & 1][0], R[(j + 2) % 6][0], acc1); acc0 = MFMA32(A2[j & 1][0], R[j][0], acc0);
                        acc1 = MFMA32(A2[j & 1][1], R[(j + 2) % 6][1], acc1); acc0 = MFMA32(A2[j & 1][1], R[j][1], acc0);
                        HWAIT(A2[(j + 1) & 1][0], A2[(j + 1) & 1][1], R[(j + 1) % 6][0], R[(j + 1) % 6][1]); }
                }
#undef HDSR
#undef HWAIT
#pragma unroll
                for (int gg = 0; gg < 2; ++gg) { const f32x16& acc = gg == 0 ? acc0 : acc1;
                    const int t0 = 32 * (4 * (g0 + gg) + ib) + 4 * hi;
                    const bf16_t* gp = ZT + ((size_t)bb * 1536 + o * 512 + ch) * KEYS + pos0 + t0;
#pragma unroll
                    for (int q = 0; q < 4; ++q) { const u32x2 yo = *(const LAS u32x2*)(Yin + (bb * YSTR + HY_PAD + t0 + 8 * q) * 2); const u32x2 gt = *(const u32x2*)(gp + 8 * q);
                        const float v0 = bflo(gt.x) * (acc[4 * q + 0] + bflo(yo.x) * bias), v1 = bfhi(gt.x) * (acc[4 * q + 1] + bfhi(yo.x) * bias);
                        const float v2 = bflo(gt.y) * (acc[4 * q + 2] + bflo(yo.y) * bias), v3 = bfhi(gt.y) * (acc[4 * q + 3] + bfhi(yo.y) * bias);
                        u32x2 ov; ov.x = pk2(v0, v1); ov.y = pk2(v2, v3);
                        if (o == 0) *(LAS u32x2*)(Yout + (bb * YSTR + HY_PAD + t0 + 8 * q) * 2) = ov;
                        else *(u32x2*)(OT + ((size_t)bb * 512 + ch) * KEYS + pos0 + t0 + 8 * q) = ov; } }
            }
            __syncthreads();
        }
    }
    VM_WAIT(); __syncthreads();
    const int npos = l == 0 ? KEYS : SEQ;
    for (int id = F.tid; id < 8 * npos; id += NTHR) { const int b = id / npos, pos = id % npos, row = pos < SEQ ? b * SEQ + pos : TL + b * LC + (pos - SEQ);
        const bf16_t* op = OT + ((size_t)b * 512 + cg * 4) * KEYS + pos;
        if (WOUT_F8) *(unsigned*)(ws + WS_H + (size_t)row * D + 1024 + cg * 4) = pk4_f8(bf2f(op[0]), bf2f(op[KEYS]), bf2f(op[2 * KEYS]), bf2f(op[3 * KEYS]));
        else { u32x2 ov; ov.x = (unsigned)op[0] | ((unsigned)op[KEYS] << 16); ov.y = (unsigned)op[2 * KEYS] | ((unsigned)op[3 * KEYS] << 16); *(u32x2*)((bf16_t*)(ws + WS_H) + (size_t)row * D + 1024 + cg * 4) = ov; } }
}
#ifndef MX_MASK
#define MX_MASK 15
#endif
#ifndef PROBE_MX
#define PROBE_MX 0
#endif
__device__ __forceinline__ void ph_mixers(KP Pk, Frame& F, int l, int qid) {
    const int n_diff = 512, n_hy = 128, n_dctx = l == 0 ? 64 : 0, n_swa = 512, n_sctx = l == 0 ? 64 : 0, gpb = l == 0 ? 5 : 4, n_gla = 64 * gpb;
    constexpr int R0 = 1 + ((PROBE_MX >> 0) & 1), R1 = 1 + ((PROBE_MX >> 1) & 1), R2 = 1 + ((PROBE_MX >> 2) & 1), R3 = 1 + ((PROBE_MX >> 3) & 1);
    const int n_mix = R0 * (n_diff + n_dctx) + R1 * n_hy + R2 * (n_swa + n_sctx) + R3 * n_gla + (l == 0 ? 96 + 128 : 0);
    const int n_titems = 16 * TI_GU + 16 * TI_DN + TI_WOUT + (l == 0 ? TI_WIN + TI_WA : 0), NTU = (n_titems + 127) / 128;
    const int total = n_mix + NTU, tplaced = min(NTU, total / 4);
    for (;;) {
        const int s_ = wg_grab(F, qid); if (s_ >= total) break;
        int u = s_ - min(NTU, s_ / 4), tu = -1;
        if ((s_ & 3) == 3 && (s_ >> 2) < NTU) tu = s_ >> 2; else if (u >= n_mix) tu = tplaced + (u - n_mix);
        if (tu >= 0) { LAS float* scr = (LAS float*)(F.lds + F.wave * 8704);
            for (int j = 0; j < 16; ++j) { int x = tu * 128 + F.wave * 16 + j; if (x >= n_titems) break;
                int it;
                if (x < 16 * TI_GU) it = 2 * TI_L + l * 16 * TI_GU + x;
                else if ((x -= 16 * TI_GU) < 16 * TI_DN) it = 2 * TI_L + 32 * TI_GU + l * 16 * TI_DN + x;
                else if ((x -= 16 * TI_DN) < TI_WOUT) it = l * TI_L + TI_WIN + TI_WA + x;
                else it = TI_L + (x - TI_WOUT);
                p0_item(Pk, F, it, scr); }
            goto mx_next; }
        if (l == 0) { if (u < 96) { ada_unit(Pk, F, 96 + u); goto mx_next; } u -= 96;
                      if (u < 128) { ph_hyena_filters(Pk, F, 128 + u); goto mx_next; } u -= 128; }
        if (u < R1 * n_hy) { u %= n_hy; if (MX_MASK & 2) hyena_unit(Pk, F, l, u); goto mx_next; } u -= R1 * n_hy;
        if (u < R0 * n_diff) { u %= n_diff; const int b = u >> 6, h = (u >> 4) & 3, qb = u & 15; if (MX_MASK & 1) diff_unit(Pk, F, l, b, h, b * SEQ + 128 * qb, 36); goto mx_next; } u -= R0 * n_diff;
        if (u < R0 * n_dctx) { u %= n_dctx; const int b = u >> 3, h = (u >> 1) & 3, qb = u & 1; if (MX_MASK & 1) diff_unit(Pk, F, l, b, h, TL + b * LC + 128 * qb, 4); goto mx_next; } u -= R0 * n_dctx;
        if (u < R2 * n_swa) { u %= n_swa; const int b = u >> 6, kvh = (u >> 5) & 1, qb = u & 31; if (MX_MASK & 4) swa_unit(Pk, F, l, b, kvh, b * SEQ + 64 * qb, 64 * qb, true); goto mx_next; } u -= R2 * n_swa;
        if (u < R2 * n_sctx) { u %= n_sctx; const int b = u >> 3, kvh = (u >> 2) & 1, qb = u & 3; if (MX_MASK & 4) swa_unit(Pk, F, l, b, kvh, TL + b * LC + 64 * qb, 64 * qb, false); goto mx_next; } u -= R2 * n_sctx;
        { u %= n_gla; const int bh = u / gpb, grp = u % gpb, c = (l == 0 ? 0 : 4) + grp * 8 + F.wave;
          __syncthreads();
          if ((MX_MASK & 8) && c < NCH) gla_pass_b(Pk, F, l, bh >> 3, bh & 7, c, F.lds + F.wave * WAVE_LDS);
        }
mx_next: ;
    }
}

constexpr int N_PHASES = 22;
#ifndef PH_MASK
#define PH_MASK 0xfffu
#endif
__global__ void __launch_bounds__(NTHR, 2) fwd_kernel(Params Parg) {
    extern __shared__ __attribute__((aligned(16))) unsigned char lds_raw[];
    const KP P0 = (KP)__builtin_amdgcn_kernarg_segment_ptr();
    Frame F;
    F.lds = (LAS unsigned char*)lds_raw; F.MISC = (volatile LAS unsigned*)(F.lds + LDS_MISC);
    const int wave_s = __builtin_amdgcn_readfirstlane((int)threadIdx.x >> 6);
#define TID_REFRESH() do { int t_; asm volatile("v_mbcnt_lo_u32_b32 %0, -1, 0\n\tv_mbcnt_hi_u32_b32 %0, -1, %0" : "=v"(t_)); F.lane = t_; F.wave = wave_s; F.tid = wave_s * 64 + t_; } while (0)
    TID_REFRESH();
    F.G = gridDim.x; { const int bx = blockIdx.x; F.vcu = (F.G % 8 == 0) ? (bx % 8) * (F.G / 8) + bx / 8 : bx; }
    F.ws = P0->ws; F.ctl = (unsigned*)(P0->ws + WS_CTL);
    for (int u = F.tid; u < 128; u += NTHR) F.MISC[u] = 0u;
    __syncthreads();
    const int lo = P0->ph_lo, hi = P0->ph_hi;
    const bool multi = hi - lo > 1;
    XcdBarrier bar; bar.bar = F.ctl + CW_BAR; bar.x = 0; bar.st = nullptr;
    if (multi) bar = xcd_barrier_post(F.ctl + CW_BAR, F.MISC + 8, F.tid);
#define INR(k) (lo <= (k) && (k) < hi)
#define IN(k, kind) (((PH_MASK >> (kind)) & 1u) && INR(k))
#ifndef PROBE_T
#define PROBE_T 0u
#endif
#ifndef PROBE_WG
#define PROBE_WG 0
#endif
    unsigned long long pt_last = PROBE_T ? __builtin_amdgcn_s_memrealtime() : 0ull, pt_acc = 0ull;
#define PT_MARK(k) do { if (PROBE_T) { const unsigned long long now_ = __builtin_amdgcn_s_memrealtime(); if ((PROBE_T >> (k)) & 1u) pt_acc += now_ - pt_last; pt_last = now_; } } while (0)
#define SEAM(k) do { if (INR(k) && INR((k) + 1)) { bar.bar = (unsigned*)(kp_opaque(P0)->ws + WS_CTL) + CW_BAR; TID_REFRESH(); xcd_barrier(bar, F.tid); } PT_MARK(k); } while (0)
#ifndef PROBE_MASK
#define PROBE_MASK 0u
#endif
#define REP(kind) for (int rep_ = 0; rep_ < (((PROBE_MASK >> (kind)) & 1u) ? 2 : 1); ++rep_)
#define REP_SYNC(kind) do { if (((PROBE_MASK >> (kind)) & 1u) && rep_ == 0 && multi) { TID_REFRESH(); xcd_barrier(bar, F.tid); } } while (0)
#define PHASE_BEGIN() const KP Pk = kp_opaque(P0); unsigned char* ws = Pk->ws; F.ws = ws; F.ctl = (unsigned*)(ws + WS_CTL); \
    TID_REFRESH()
    if (IN(0, 0)) REP(0) { PHASE_BEGIN(); p0_prologue(Pk, F, rep_); REP_SYNC(0); } SEAM(0);
#pragma unroll 1
    for (int l = 0; l < DEPTH; ++l) {
        const int pb = 1 + 10 * l;
        if (IN(pb + 0, 1)) REP(1) { if (rep_ && l) break; PHASE_BEGIN(); if (l == 0) { for (int u = blockIdx.x; u < 128; u += F.G) ph_hyena_filters(Pk, F, u); } ph_norm1(Pk, F, l); REP_SYNC(1); } SEAM(pb + 0);
        if (IN(pb + 1, 2)) REP(2) { PHASE_BEGIN();
            pg8::Gemm g{(const bf16_t*)(ws + WS_H), (const bf16_t*)(ws + WS_WIN + (size_t)l * NU * D * 2), D, nullptr};
            pg8::RectOrder S; if (l == 0) S.init(72, 21, F.G, (int)blockIdx.x, 0, 0, 0ull); else S.init(64, 21, F.G, (int)blockIdx.x, 64, 64, 0x1413121108030201ull);
            pg8::EpiU E{(bf16_t*)(ws + WS_U), WIN_F8_L(l) ? 1.f / 32.f : 1.f};
            if (WIN_F8_L(l)) pg8::gemm_phase<pg8::EpiU, pg8::RectOrder, false, true>(F.lds, g, S, E, F.tid);
            else pg8::gemm_phase<pg8::EpiU, pg8::RectOrder, false, false>(F.lds, g, S, E, F.tid);
            if (WIN_F8_L(l)) ph_gate_cols8(F, l); else ph_gate_cols(F, l); REP_SYNC(2);
        } SEAM(pb + 1);
        if (IN(pb + 2, 3)) REP(3) { PHASE_BEGIN(); ph_prep(Pk, F, l, rep_); PT_MARK(pb + 3); REP_SYNC(3); } SEAM(pb + 2);
        if (IN(pb + 4, 5)) REP(5) { PHASE_BEGIN(); ph_mixers(Pk, F, l, 1 + l + 2 * rep_); REP_SYNC(5); } SEAM(pb + 4);
        if (IN(pb + 5, 6)) REP(6) { if (rep_ && l) break; PHASE_BEGIN();
            pg8::Gemm g{(const bf16_t*)(ws + WS_H), (const bf16_t*)(ws + WS_WOUT + (size_t)l * D * D * MIXB), D, nullptr};
            pg8::RectOrder S; S.init(l == 0 ? 72 : 64, 8, F.G, (int)blockIdx.x, 0, 0, 0ull);
            pg8::EpiWout E{Pk->in[I_X], Pk->in[I_CTX], l == 0 ? (const bf16_t*)nullptr : (const bf16_t*)(ws + WS_X), (bf16_t*)(ws + WS_X), (const float*)(ws + WS_MOD) + (size_t)l * 9 * 12288};
            pg8::gemm_phase<pg8::EpiWout, pg8::RectOrder, false, WOUT_F8>(F.lds, g, S, E, F.tid); REP_SYNC(6);
        } SEAM(pb + 5);
        if (IN(pb + 6, 7)) REP(7) { PHASE_BEGIN(); ph_norm2_router(Pk, F, l, rep_); REP_SYNC(7); } SEAM(pb + 6);
        if (IN(pb + 7, 8)) { PHASE_BEGIN(); ph_slots(Pk, F, l); } SEAM(pb + 7);
        if (IN(pb + 8, 9)) REP(9) { PHASE_BEGIN();
            const int np = moe_table(F, l);
            pg8::Gemm g{(const bf16_t*)(ws + WS_H), (const bf16_t*)(ws + WS_WGU + (size_t)l * NE * 2048 * D), D, (const int*)(ws + WS_RT + RT_ROWTOK)};
            pg8::MoeOrder S{np, F.G, F.vcu, (const volatile LAS unsigned char*)(F.MISC + 64)};
            pg8::EpiMoe1 E{ws + WS_U};
            pg8::gemm_phase<pg8::EpiMoe1, pg8::MoeOrder, true, true>(F.lds, g, S, E, F.tid); REP_SYNC(9);
        } SEAM(pb + 8);
        if (IN(pb + 9, 10)) REP(10) { PHASE_BEGIN();
            const int np = moe_table(F, l);
            pg8::Gemm g{(const bf16_t*)(ws + WS_U), (const bf16_t*)(ws + WS_WD + (size_t)l * NE * D * DE), DE, nullptr};
            pg8::MoeOrder S{np, F.G, F.vcu, (const volatile LAS unsigned char*)(F.MISC + 64)};
            pg8::EpiMoe2 E{ws + WS_Y2, (const int*)(ws + WS_RT + RT_ROWTOK), (const float*)(ws + WS_RT + RT_ROWW)};
            pg8::gemm_phase<pg8::EpiMoe2, pg8::MoeOrder, false, true>(F.lds, g, S, E, F.tid); REP_SYNC(10);
        } SEAM(pb + 9);
    }
    if (IN(21, 11)) REP(11) { PHASE_BEGIN(); ph_final(Pk, F); REP_SYNC(11); }
    if (PROBE_T) { PT_MARK(21); if (blockIdx.x == PROBE_WG) { const unsigned long long t0_ = __builtin_amdgcn_s_memrealtime(); while (__builtin_amdgcn_s_memrealtime() - t0_ < 8ull * pt_acc) __builtin_amdgcn_s_sleep(8); } }
#undef IN
#undef INR
#undef SEAM
#undef PT_MARK
#undef PHASE_BEGIN
#undef REP
#undef REP_SYNC
#undef TID_REFRESH
}

#ifndef MK_PER_PHASE
#define MK_PER_PHASE 0
#endif
extern "C" void kernel_launch(void* const* d_in, const int* in_sizes, int n_in, void* d_out, int out_size, void* d_ws, size_t ws_size, hipStream_t stream) {
    static int grid = 0;
    if (grid == 0) {
        if (n_in != 34 || in_sizes[0] != TL * D || out_size != TL * D || ws_size < WS_END) { fprintf(stderr, "kernel_launch: unexpected shapes (n_in %d, in0 %d, out %d, ws %zu < %zu)\n", n_in, n_in > 0 ? in_sizes[0] : -1, out_size, ws_size, (size_t)WS_END); grid = -1; return; }
        int dev = 0, cus = 0, per_cu = 0;
        if (hipGetDevice(&dev) != hipSuccess || hipDeviceGetAttribute(&cus, hipDeviceAttributeMultiprocessorCount, dev) != hipSuccess) { grid = -1; return; }
        if (hipFuncSetAttribute((const void*)fwd_kernel, hipFuncAttributeMaxDynamicSharedMemorySize, LDS_BYTES) != hipSuccess) { fprintf(stderr, "kernel_launch: hipFuncSetAttribute failed\n"); grid = -1; return; }
        if (hipOccupancyMaxActiveBlocksPerMultiprocessor(&per_cu, (const void*)fwd_kernel, NTHR, LDS_BYTES) != hipSuccess || per_cu < 1) fprintf(stderr, "kernel_launch: occupancy query reports %d\n", per_cu);
        (void)hipGetLastError();
        grid = cus;
    }
    if (grid < 0) return;
    (void)hipMemsetAsync((char*)d_ws + WS_CTL, 0, CTL_BYTES, stream);
    Params p{};
    for (int i = 0; i < 34; ++i) p.in[i] = (const float*)d_in[i];
    p.out = (float*)d_out; p.ws = (unsigned char*)d_ws;
#if MK_PER_PHASE
    for (int k = 0; k < N_PHASES; ++k) { p.ph_lo = k; p.ph_hi = k + 1; hipLaunchKernelGGL(fwd_kernel, dim3(grid), dim3(NTHR), LDS_BYTES, stream, p); }
#else
    p.ph_lo = 0; p.ph_hi = N_PHASES; hipLaunchKernelGGL(fwd_kernel, dim3(grid), dim3(NTHR), LDS_BYTES, stream, p);
#endif
    const hipError_t le = hipPeekAtLastError();
    if (le != hipSuccess) fprintf(stderr, "kernel_launch: launch failed: %s\n", hipGetErrorName(le));
}
```

```cpp
#include <hip/hip_runtime.h>
#include <cstdio>
#include <cstdint>

#define LAS __attribute__((address_space(3)))
#define GAS __attribute__((address_space(1)))
typedef unsigned short bf16_t;
typedef short bf16x8 __attribute__((ext_vector_type(8)));
typedef float f32x2 __attribute__((ext_vector_type(2)));
typedef float f32x4 __attribute__((ext_vector_type(4)));
typedef float f32x16 __attribute__((ext_vector_type(16)));
typedef unsigned u32x2 __attribute__((ext_vector_type(2)));
typedef unsigned u32x4 __attribute__((ext_vector_type(4)));
typedef int i32x4 __attribute__((ext_vector_type(4)));
typedef int i32x8 __attribute__((ext_vector_type(8)));

constexpr int D = 2048, NB = 8, SEQ = 2048, LC = 256, DEPTH = 2;
constexpr int TL = NB * SEQ, TCX = NB * LC, TT = TL + TCX;
constexpr int DIN = 5408, NU = 5376, NE = 16, DE = 1024;
constexpr int KEYS = LC + SEQ;
constexpr int UC_GQ = 0, UC_GK = 256, UC_GV = 512, UC_GG = 1024, UC_SQ = 1536, UC_SK = 2048, UC_SV = 2176, UC_HY = 2304, UC_DQ = 3840, UC_DK = 4352, UC_DV = 4864;
constexpr int MOE_ROWS = 2 * TT + NE * 256;
constexpr int MOE_PANELS = MOE_ROWS / 256;
constexpr int GCH = 64, NCH = KEYS / GCH;
constexpr float NORM_EPS = 1e-6f;
constexpr float LOG2E = 1.4426950408889634f;

constexpr size_t MiB = 1u << 20;
constexpr size_t WS_CTL = 0, CTL_BYTES = 1 * MiB;
constexpr size_t WS_MOD = 1 * MiB;
constexpr size_t WS_ROPE = 2 * MiB;
constexpr size_t WS_HYH2 = 3 * MiB;
constexpr size_t WS_WA = 5 * MiB;
constexpr size_t WS_RT = 6 * MiB;
constexpr size_t WS_AG = 7 * MiB;
constexpr size_t WS_HYF = 10 * MiB;
constexpr size_t WS_WIN = 28 * MiB;
constexpr size_t WS_WOUT = 70 * MiB;
constexpr size_t WS_WGU = 86 * MiB;
constexpr size_t WS_WD = 342 * MiB;
constexpr size_t WS_X = 470 * MiB;
constexpr size_t WS_H = 614 * MiB;
constexpr size_t WS_U = 686 * MiB;
constexpr size_t WS_B = 875 * MiB;
constexpr size_t WS_VTD = WS_B;
constexpr size_t WS_VTS = WS_B + 18 * MiB;
constexpr size_t WS_ZT = WS_B + 23 * MiB;
constexpr size_t WS_OT = WS_B + 77 * MiB;
constexpr size_t WS_GSL = WS_B + 95 * MiB;
constexpr size_t WS_GSS = WS_B + 131 * MiB;
constexpr size_t WS_GAE = WS_B + 167 * MiB;
constexpr size_t WS_Y2 = WS_B;
constexpr size_t WS_HB = 1043 * MiB;
constexpr size_t WS_END = 1115 * MiB;
constexpr int WIN_F8_MASK = 3;
#define WIN_F8_L(l) (((WIN_F8_MASK) >> (l)) & 1)
constexpr bool WOUT_F8 = true;
constexpr int MIXB = WOUT_F8 ? 1 : 2;
constexpr size_t RT_E = 0;
constexpr size_t RT_W = 128 * 1024;
constexpr size_t RT_ROWTOK = 320 * 1024;
constexpr size_t RT_ROWW = 512 * 1024;
constexpr int CW_BAR = 4096;
constexpr int CW_CNT = 16384;
constexpr int CW_CUR = 16384 + 256;
constexpr int CW_Q = 16384 + 1024;

constexpr int LDS_BYTES = 155648;
constexpr int LDS_MISC = LDS_BYTES - 512;
constexpr int NWAVES = 8, NTHR = 512;

__device__ __forceinline__ unsigned f2bf(float f) { unsigned u = __builtin_bit_cast(unsigned, f); return (u + 0x7fffu + ((u >> 16) & 1u)) >> 16; }
#ifndef EMU8
#define EMU8 0
#endif
__device__ __forceinline__ float q8(float f) { unsigned u = __builtin_bit_cast(unsigned, f); u = (u + 0x7ffffu + ((u >> 20) & 1u)) & 0xfff00000u; return __builtin_bit_cast(float, u); }
__device__ __forceinline__ unsigned pk2(float lo, float hi) { return f2bf(lo) | (f2bf(hi) << 16); }
__device__ __forceinline__ unsigned pk2q(float lo, float hi) { return f2bf(q8(lo)) | (f2bf(q8(hi)) << 16); }
__device__ __forceinline__ unsigned pk4_f8(float a, float b, float c, float d) {
    a = fminf(fmaxf(a, -448.f), 448.f); b = fminf(fmaxf(b, -448.f), 448.f); c = fminf(fmaxf(c, -448.f), 448.f); d = fminf(fmaxf(d, -448.f), 448.f);
    int r = 0; r = __builtin_amdgcn_cvt_pk_fp8_f32(a, b, r, false); r = __builtin_amdgcn_cvt_pk_fp8_f32(c, d, r, true); return (unsigned)r; }
__device__ __forceinline__ unsigned char f8_1(float a) { a = fminf(fmaxf(a, -448.f), 448.f); return (unsigned char)(__builtin_amdgcn_cvt_pk_fp8_f32(a, a, 0, false) & 0xff); }
__device__ __forceinline__ float bf2f(unsigned short b) { return __builtin_bit_cast(float, ((unsigned)b) << 16); }
__device__ __forceinline__ float bflo(unsigned w) { return __builtin_bit_cast(float, w << 16); }
__device__ __forceinline__ float bfhi(unsigned w) { return __builtin_bit_cast(float, w & 0xffff0000u); }
__device__ __forceinline__ float wave_sum(float v) {
#pragma unroll
    for (int o = 1; o < 64; o <<= 1) v += __shfl_xor(v, o);
    return v;
}
__device__ __forceinline__ float silu_f(float x) { return x / (1.f + __expf(-x)); }
#define LDS_WAIT() asm volatile("s_waitcnt lgkmcnt(0)" ::: "memory")
#define VM_WAIT() asm volatile("s_waitcnt vmcnt(0)" ::: "memory")

#define XB_TMO      128
#define XB_XCNT(j)  (256  + 64 * (j))
#define XB_XSUB(j)  (1280 + 64 * (j))
#define XB_XGEN(j)  (2304 + 64 * (j))
#define XB_TOP      3328
#define XB_TOPGEN   3392
#define XCD_BAR_WORDS 3456
#define XB_SPIN_CAP (1u << 18)
__device__ __forceinline__ unsigned xb_ld(unsigned* p)              { return __hip_atomic_load(p, __ATOMIC_RELAXED, __HIP_MEMORY_SCOPE_AGENT); }
__device__ __forceinline__ unsigned xb_add(unsigned* p, unsigned v) { return __hip_atomic_fetch_add(p, v, __ATOMIC_RELAXED, __HIP_MEMORY_SCOPE_AGENT); }
__device__ __forceinline__ unsigned xb_xcc_id() { return (unsigned)__builtin_amdgcn_s_getreg((3 << 11) | 20) & 0xFu; }
#define XB_SPIN(cond, bar) do { unsigned _sp = 0; while (cond) { __builtin_amdgcn_s_sleep(1); \
    if ((++_sp & 255u) == 0u) { if (xb_ld(&(bar)[XB_TMO])) break; if (_sp > XB_SPIN_CAP) { atomicAdd(&(bar)[XB_TMO], 1u); break; } } } } while (0)
struct XcdBarrier { unsigned* bar; unsigned x; volatile LAS unsigned* st; };
__device__ __forceinline__ XcdBarrier xcd_barrier_post(unsigned* bar, volatile LAS unsigned* st, int tid) {
    XcdBarrier b; b.bar = bar; b.x = xb_xcc_id(); b.st = st;
    if (tid == 0) (void)xb_add(&bar[XB_XCNT(b.x)], 1u);
    return b;
}
__device__ __forceinline__ void xcd_barrier_complete(unsigned* bar, unsigned x, unsigned& nloc, unsigned& nx) {
    const unsigned G = gridDim.x * gridDim.y * gridDim.z;
    unsigned sum, cnt, mine, sp = 0u;
    for (;;) {
        sum = 0u; cnt = 0u; mine = 0u;
#pragma unroll
        for (unsigned j = 0; j < 16; ++j) { const unsigned c = xb_ld(&bar[XB_XCNT(j)]); sum += c; cnt += (c > 0u) ? 1u : 0u; mine = (j == x) ? c : mine; }
        if (sum == G) break;
        __builtin_amdgcn_s_sleep(1);
        if ((++sp & 255u) == 0u) { if (xb_ld(&bar[XB_TMO])) break; if (sp > XB_SPIN_CAP) { atomicAdd(&bar[XB_TMO], 1u); break; } }
    }
    nloc = mine > 0u ? mine : 1u; nx = cnt > 0u ? cnt : 1u;
}
__device__ __forceinline__ void xcd_barrier(const XcdBarrier& b, int tid) {
    asm volatile("s_waitcnt vmcnt(0)" ::: "memory");
    __syncthreads();
    if (tid == 0) {
        unsigned* bar = b.bar;
        __builtin_amdgcn_s_waitcnt(0);
        unsigned nloc = b.st[0], nx = b.st[1];
        if (nloc == 0u) { xcd_barrier_complete(bar, b.x, nloc, nx); b.st[0] = nloc; b.st[1] = nx; }
        const unsigned old = xb_add(&bar[XB_XSUB(b.x)], 1u);
        const unsigned gen = old / nloc;
        if (old + 1u == (gen + 1u) * nloc) {
            __builtin_amdgcn_fence(__ATOMIC_RELEASE, "agent");
            asm volatile("s_waitcnt vmcnt(0)" ::: "memory");
            const unsigned og = xb_add(&bar[XB_TOP], 1u);
            const unsigned tg = og / nx;
            if (og + 1u == (tg + 1u) * nx) xb_add(&bar[XB_TOPGEN], 1u);
            else XB_SPIN(xb_ld(&bar[XB_TOPGEN]) == tg, bar);
            __builtin_amdgcn_fence(__ATOMIC_ACQUIRE, "agent");
            xb_add(&bar[XB_XGEN(b.x)], 1u);
            asm volatile("s_waitcnt vmcnt(0)" ::: "memory");
        } else {
            XB_SPIN(xb_ld(&bar[XB_XGEN(b.x)]) == gen, bar);
            __builtin_amdgcn_fence(__ATOMIC_ACQUIRE, "agent");
            asm volatile("s_waitcnt vmcnt(0)" ::: "memory");
        }
    }
    __syncthreads();
}

namespace pg8 {
constexpr int BM = 256, BK = 64, HALF = 128, HTB = HALF * BK * 2, STAGE_BYTES = 8 * HTB;
__host__ __device__ __forceinline__ int lds_byte(int r, int c) { const int st = (r >> 4) * 2 + (c >> 5), rr = r & 15, cc = c & 31, ob = rr * 64 + cc * 2; return st * 1024 + (ob ^ (((ob >> 9) & 1) << 5)); }
__host__ __device__ __forceinline__ void stage_rc(int b, int& R, int& C) { const int st = b / 1024, sb = b % 1024, swz = sb ^ (((sb >> 9) & 1) << 5); R = (st >> 1) * 16 + swz / 64; C = (st & 1) * 32 + (swz % 64) / 2; }
__host__ __device__ __forceinline__ int lds_byte8(int r, int cb) { const int st = (r >> 4) * 2 + (cb >> 6), rr = r & 15, ob = rr * 64 + (cb & 63); return st * 1024 + (ob ^ (((ob >> 9) & 1) << 4)); }
__host__ __device__ __forceinline__ void stage_rc8(int b, int& R, int& Cb) { const int st = b / 1024, sb = b % 1024, swz = sb ^ (((sb >> 9) & 1) << 4); R = (st >> 1) * 16 + swz / 64; Cb = (st & 1) * 64 + (swz % 64); }
__host__ __device__ __forceinline__ int perm32(int rho) { const int n = rho >> 4, i = rho & 15; return 8 * (i >> 2) + 4 * n + (i & 3); }
struct Unit { int pm, pn; };
struct Gemm { const bf16_t* A; const bf16_t* Bt; int K; const int* rowtab; };
__device__ __forceinline__ unsigned cvt_pk_bf16(float lo, float hi) { unsigned r; asm volatile("v_cvt_pk_bf16_f32 %0, %1, %2" : "=v"(r) : "v"(lo), "v"(hi)); return r; }

template <class Epi, class Sched, bool GATHER, bool F8 = false>
__device__ __forceinline__ void gemm_phase(LAS unsigned char* lds, const Gemm g, const Sched& S, const Epi& E, const int tid) {
    const int wid = __builtin_amdgcn_readfirstlane(tid >> 6), lane = tid & 63, wr = wid >> 2, wc = wid & 3, fr = lane & 15, fq = lane >> 4;
    const int K = g.K, RB = F8 ? K : 2 * K, nt = RB / 128;
    unsigned voffB[2], voffA[2];
#pragma unroll
    for (int i = 0; i < 2; ++i) { int R, Cb; if constexpr (F8) stage_rc8(tid * 16 + i * 8192, R, Cb); else { int C; stage_rc(tid * 16 + i * 8192, R, C); Cb = 2 * C; }
        const int Rb = Epi::PERM ? ((R & ~31) + perm32(R & 31)) : R;
        voffA[i] = (unsigned)(R * RB + Cb); voffB[i] = (unsigned)(Rb * RB + Cb); }
    const size_t kstep = 128;
    const size_t hstep = (size_t)HALF * RB;
    const size_t tstep = 2 * hstep;
    const unsigned ldsw = (unsigned)wid * 1024u;
    const int aoff = F8 ? lds_byte8(wr * 64 + fr, 32 * fq) : lds_byte(wr * 64 + fr, fq * 8), boff = F8 ? lds_byte8(wc * 32 + fr, 32 * fq) : lds_byte(wc * 32 + fr, fq * 8);
    const int aoff2 = aoff ^ 16, boff2 = boff ^ 16;
#define PG8_SA(b, h) (((b) * 2 + (h)) * HTB)
#define PG8_SB(b, h) ((4 + (b) * 2 + (h)) * HTB)
#define PG8_STAGE(bufoff, gbase, voff) do { _Pragma("unroll") for (int _i = 0; _i < 2; ++_i) \
        __builtin_amdgcn_global_load_lds((const unsigned*)((const char*)(gbase) + (voff)[_i]), (LAS unsigned*)(lds + (bufoff) + ldsw + _i * 8192), 16, 0, 0); } while (0)
#define PG8_LDA(dst, b, h) do { if constexpr (F8) { _Pragma("unroll") for (int m = 0; m < 4; ++m) { const i32x4 _lo = *(const LAS i32x4*)(lds + PG8_SA(b, h) + aoff + m * 2048), _hi = *(const LAS i32x4*)(lds + PG8_SA(b, h) + aoff2 + m * 2048); dst##8[m] = __builtin_shufflevector(_lo, _hi, 0, 1, 2, 3, 4, 5, 6, 7); } } \
        else { _Pragma("unroll") for (int m = 0; m < 4; ++m) _Pragma("unroll") for (int k = 0; k < 2; ++k) dst[m][k] = *(const LAS bf16x8*)(lds + PG8_SA(b, h) + aoff + m * 2048 + k * 1024); } } while (0)
#define PG8_LDB(dst, b, h) do { if constexpr (F8) { _Pragma("unroll") for (int n = 0; n < 2; ++n) { const i32x4 _lo = *(const LAS i32x4*)(lds + PG8_SB(b, h) + boff + n * 2048), _hi = *(const LAS i32x4*)(lds + PG8_SB(b, h) + boff2 + n * 2048); dst##8[n] = __builtin_shufflevector(_lo, _hi, 0, 1, 2, 3, 4, 5, 6, 7); } } \
        else { _Pragma("unroll") for (int n = 0; n < 2; ++n) _Pragma("unroll") for (int k = 0; k < 2; ++k) dst[n][k] = *(const LAS bf16x8*)(lds + PG8_SB(b, h) + boff + n * 2048 + k * 1024); } } while (0)
#define PG8_CAT(x) __builtin_shufflevector(x[0], x[1], 0, 1, 2, 3, 4, 5, 6, 7)
#define PG8_MMA(ai, bj, At, Bt) do { __builtin_amdgcn_s_setprio(1); if constexpr (F8) { _Pragma("unroll") for (int m = 0; m < 4; ++m) _Pragma("unroll") for (int n = 0; n < 2; ++n) \
            asm volatile("v_mfma_scale_f32_16x16x128_f8f6f4 %0, %1, %2, %0, %3, %3 op_sel_hi:[0,0,0]" : "+v"(acc[ai][bj][m][n]) : "v"(Bt##8[n]), "v"(At##8[m]), "v"(f8scale)); } \
        else { _Pragma("unroll") for (int m = 0; m < 4; ++m) _Pragma("unroll") for (int n = 0; n < 2; ++n) _Pragma("unroll") for (int k = 0; k < 2; ++k) \
            acc[ai][bj][m][n] = __builtin_amdgcn_mfma_f32_16x16x32_bf16(Bt[n][k], At[m][k], acc[ai][bj][m][n], 0, 0, 0); } __builtin_amdgcn_s_setprio(0); } while (0)
#define PG8_WAIT_V(n) asm volatile("s_waitcnt vmcnt(" #n ")" ::: "memory")
#define PG8_WAIT_L(n) asm volatile("s_waitcnt lgkmcnt(" #n ")" ::: "memory")
#define PG8_BAR __builtin_amdgcn_s_barrier()
#define PG8_SCHED __builtin_amdgcn_sched_barrier(0)
#define PG8_AOFF(o, u) do { int _t2 = tid; asm volatile("" : "+v"(_t2)); _Pragma("unroll") for (int _i = 0; _i < 2; ++_i) { int _R, _Cb; if constexpr (F8) stage_rc8(_t2 * 16 + _i * 8192, _R, _Cb); else { int _C; stage_rc(_t2 * 16 + _i * 8192, _R, _C); _Cb = 2 * _C; } \
        _Pragma("unroll") for (int _h = 0; _h < 2; ++_h) { int _r = (u).pm * BM + _h * HALF + _R; \
        { const int _t = g.rowtab[_r]; _r = _t < 0 ? 0 : (_t & 0x3fffffff); } o[_h][_i] = (unsigned)(_r * RB + _Cb); } } } while (0)
    Unit cur, nxt; int ui = 0;
    if (!S.next(0, cur)) return;
    f32x4 acc[2][2][4][2];
#pragma unroll
    for (int a = 0; a < 2; ++a)
#pragma unroll
        for (int b = 0; b < 2; ++b)
#pragma unroll
            for (int m = 0; m < 4; ++m)
#pragma unroll
                for (int n = 0; n < 2; ++n) acc[a][b][m][n] = (f32x4){0.f, 0.f, 0.f, 0.f};
    bf16x8 At[4][2], B0[2][2], B1[2][2];
    i32x8 At8[4], B08[2], B18[2];
    int f8scale = 0x7f7f7f7f; asm volatile("" : "+v"(f8scale));
    unsigned oc[2][2], on[2][2];
    const char* gA = (const char*)g.A;
    const char* cA = gA; const char* cB = (const char*)g.Bt + (size_t)cur.pn * tstep;
    if constexpr (GATHER) { PG8_AOFF(oc, cur); } else { cA = gA + (size_t)cur.pm * tstep; }
#define PG8_STA_CUR(buf, kb, h) do { if constexpr (GATHER) { PG8_STAGE(buf, gA + (kb), oc[h]); } else { PG8_STAGE(buf, cA + (kb) + (h) * hstep, voffA); } } while (0)
#define PG8_STA_SEL(buf, kb, h) do { if constexpr (GATHER) { if (last) { PG8_STAGE(buf, gA + (kb), on[h]); } else { PG8_STAGE(buf, gA + (kb), oc[h]); } } else { PG8_STAGE(buf, a2p + (kb) + (h) * hstep, voffA); } } while (0)
    PG8_STAGE(PG8_SB(0, 0), cB, voffB); PG8_STAGE(PG8_SB(0, 1), cB + hstep, voffB); PG8_STA_CUR(PG8_SA(0, 0), 0, 0); PG8_STA_CUR(PG8_SA(0, 1), 0, 1);
    if (wr == 1) PG8_BAR;
    PG8_WAIT_V(2); PG8_BAR;
    PG8_STAGE(PG8_SB(1, 0), cB + kstep, voffB); PG8_STA_CUR(PG8_SA(1, 0), kstep, 0); PG8_STAGE(PG8_SB(1, 1), cB + hstep + kstep, voffB);
    PG8_WAIT_V(6); PG8_BAR;
    for (;;) {
        const bool has_next = S.next(ui + 1, nxt);
        const char* nA = cA;
        if constexpr (!GATHER) { if (has_next) nA = gA + (size_t)nxt.pm * tstep; }
        const char* nB = has_next ? (const char*)g.Bt + (size_t)nxt.pn * tstep : cB;
#pragma unroll 1
        for (int t = 0; t < nt; t += 2) {
            const bool last = (t == nt - 2);
            int to = t; asm volatile("" : "+s"(to));
            const size_t k1 = (size_t)(to + 1) * kstep, k2 = last ? 0 : (size_t)(to + 2) * kstep, k3 = k2 + kstep;
            const char* b2 = last ? nB : cB + (size_t)(to + 2) * kstep; const char* b3 = b2 + kstep;
            const char* a2p = last ? nA : cA;
            if constexpr (GATHER) { if (last) { if (has_next) { PG8_AOFF(on, nxt); } else {
#pragma unroll
                for (int h = 0; h < 2; ++h)
#pragma unroll
                    for (int i = 0; i < 2; ++i) on[h][i] = oc[h][i]; } } }
            PG8_LDB(B0, 0, 0); PG8_LDB(B1, 0, 1); PG8_SCHED; PG8_LDA(At, 0, 0); PG8_STA_CUR(PG8_SA(1, 1), k1, 1);
            PG8_WAIT_V(8); PG8_WAIT_L(0); PG8_BAR; PG8_MMA(0, 0, At, B0); PG8_MMA(0, 1, At, B1); PG8_BAR; PG8_SCHED;
            PG8_LDA(At, 0, 1); PG8_STAGE(PG8_SB(0, 0), b2, voffB); PG8_STAGE(PG8_SB(0, 1), b2 + hstep, voffB); PG8_STA_SEL(PG8_SA(0, 0), k2, 0);
            PG8_WAIT_V(8); PG8_WAIT_L(0); PG8_BAR; PG8_MMA(1, 0, At, B0); PG8_MMA(1, 1, At, B1); PG8_BAR; PG8_SCHED;
            PG8_LDB(B0, 1, 0); PG8_LDB(B1, 1, 1); PG8_SCHED; PG8_LDA(At, 1, 0); PG8_STA_SEL(PG8_SA(0, 1), k2, 1);
            PG8_WAIT_V(8); PG8_WAIT_L(0); PG8_BAR; PG8_MMA(0, 0, At, B0); PG8_MMA(0, 1, At, B1); PG8_BAR; PG8_SCHED;
            PG8_LDA(At, 1, 1); PG8_STAGE(PG8_SB(1, 0), b3, voffB); PG8_STAGE(PG8_SB(1, 1), b3 + hstep, voffB); PG8_STA_SEL(PG8_SA(1, 0), k3, 0);
            PG8_WAIT_V(8); PG8_WAIT_L(0); PG8_BAR; PG8_MMA(1, 0, At, B0); PG8_MMA(1, 1, At, B1); PG8_BAR; PG8_SCHED;
        }
        if (wr == 0) PG8_BAR;
        if constexpr (F8) asm volatile("s_nop 15\n\ts_nop 15" : "+v"(acc[1][1][0][0]), "+v"(acc[1][1][0][1]), "+v"(acc[1][1][1][0]), "+v"(acc[1][1][1][1]), "+v"(acc[1][1][2][0]), "+v"(acc[1][1][2][1]), "+v"(acc[1][1][3][0]), "+v"(acc[1][1][3][1]) :: "memory");
        E(acc, cur, wr, wc, fr, fq);
        if (!has_next) break;
#pragma unroll
        for (int a = 0; a < 2; ++a)
#pragma unroll
            for (int b = 0; b < 2; ++b)
#pragma unroll
                for (int m = 0; m < 4; ++m)
#pragma unroll
                    for (int n = 0; n < 2; ++n) acc[a][b][m][n] = (f32x4){0.f, 0.f, 0.f, 0.f};
        cur = nxt; cB = nB; cA = nA; ++ui;
        if constexpr (GATHER) {
#pragma unroll
            for (int h = 0; h < 2; ++h)
#pragma unroll
                for (int i = 0; i < 2; ++i) oc[h][i] = on[h][i]; }
        if (wr == 1) PG8_BAR;
    }
#undef PG8_STA_CUR
#undef PG8_STA_SEL
    PG8_WAIT_V(0);
    PG8_BAR;
#undef PG8_SA
#undef PG8_SB
#undef PG8_STAGE
#undef PG8_LDA
#undef PG8_LDB
#undef PG8_CAT
#undef PG8_MMA
#undef PG8_WAIT_V
#undef PG8_WAIT_L
#undef PG8_BAR
#undef PG8_SCHED
#undef PG8_AOFF
}
}

struct Params { const float* in[34]; float* out; unsigned char* ws; int ph_lo, ph_hi; };
typedef const __attribute__((address_space(4))) Params* KP;
__device__ __forceinline__ KP kp_opaque(KP p) { asm volatile("" : "+s"(p)); return p; }
enum { I_X = 0, I_C, I_CTX, I_CCTX, I_N1W, I_N2W, I_ADAW, I_ADAB, I_WIN, I_WOUT, I_GGW, I_GGB, I_GNW, I_SQN, I_SKN, I_SINK, I_HCW, I_HCB, I_HW1, I_HB1, I_HW2, I_HB2, I_HW3, I_HFR, I_HBIAS,
       I_DQN, I_DKN, I_DLAM, I_DSUB, I_RW, I_RB, I_EG, I_EU, I_ED };
struct Frame {
    LAS unsigned char* lds; volatile LAS unsigned* MISC; unsigned* ctl;
    int tid, lane, wave, vcu, G;
    unsigned char* ws;
    unsigned long long pt; int pt_done;
};
__device__ __forceinline__ int modrow_of(int row) { return row < TL ? (row >> 11) : 8; }
__device__ __forceinline__ int keyrow(int b, int kidx) { return kidx < LC ? TL + b * LC + kidx : b * SEQ + (kidx - LC); }
__device__ __forceinline__ int wg_grab(Frame& F, int q) {
    __syncthreads();
    if (F.tid == 0) F.MISC[0] = __hip_atomic_fetch_add(F.ctl + CW_Q + 64 * q, 1u, __ATOMIC_RELAXED, __HIP_MEMORY_SCOPE_AGENT);
    __syncthreads();
    { int t_; asm volatile("v_mbcnt_lo_u32_b32 %0, -1, 0\n\tv_mbcnt_hi_u32_b32 %0, -1, %0" : "=v"(t_)); F.lane = t_; F.tid = F.wave * 64 + t_; }
    return (int)F.MISC[0];
}

namespace pg8 {
constexpr int NXCD = 8, WGM = 8;
struct RectOrder {
    int nM, nN, nwg, G, c, nextra, xpm0; unsigned long long xt;
    __device__ void init(int nM_, int nN_, int G_, int c_, int nextra_, int xpm0_, unsigned long long xt_) { nM = nM_; nN = nN_; nwg = nM * nN; G = G_; c = c_; nextra = nextra_; xpm0 = xpm0_; xt = xt_; }
    __device__ bool next(int i, Unit& u) const {
        const int L = i * G + c; if (L >= nwg + nextra) return false;
        if (L >= nwg) { const int e = L - nwg; u.pm = xpm0 + (e >> 3); u.pn = (int)((xt >> (8 * (e & 7))) & 0xffull); return true; }
        int wgid = L; { const int q = nwg / NXCD, r = nwg % NXCD, xcd = wgid % NXCD, off = wgid / NXCD; wgid = (xcd < r ? xcd * (q + 1) : r * (q + 1) + (xcd - r) * q) + off; }
        const int nig = WGM * nN, gid = wgid / nig, fm = gid * WGM, gsz = (nM - fm) < WGM ? (nM - fm) : WGM;
        u.pm = fm + ((wgid % nig) % gsz); u.pn = (wgid % nig) / gsz; return true;
    }
};
struct MoeOrder {
    int npanels, G, vcu; const volatile LAS unsigned char* pexp;
    __device__ bool next(int i, Unit& u) const {
        const int L = i * G + vcu; if (L >= npanels * 8) return false;
        const int p = L >> 3; u.pm = p; u.pn = (int)pexp[p] * 8 + (L & 7); return true;
    }
};
struct EpiU {
    static constexpr bool PERM = true;
    bf16_t* O; float scale;
    __device__ __forceinline__ void operator()(const f32x4 (&acc)[2][2][4][2], const Unit& u, int wr, int wc, int fr, int fq) const {
        const int row0 = u.pm * BM + wr * 64 + fr, col0 = u.pn * BM + wc * 32 + 8 * fq;
#pragma unroll
        for (int ai = 0; ai < 2; ++ai)
#pragma unroll
            for (int m = 0; m < 4; ++m) { bf16_t* rowp = O + (size_t)(row0 + ai * HALF + m * 16) * NU + col0;
#pragma unroll
                for (int bj = 0; bj < 2; ++bj) { const f32x4 v0 = acc[ai][bj][m][0] * scale, v1 = acc[ai][bj][m][1] * scale;
                    u32x4 w; w.x = cvt_pk_bf16(v0[0], v0[1]); w.y = cvt_pk_bf16(v0[2], v0[3]); w.z = cvt_pk_bf16(v1[0], v1[1]); w.w = cvt_pk_bf16(v1[2], v1[3]);
                    *(u32x4*)(rowp + bj * HALF) = w; } }
    }
};
struct EpiWout {
    static constexpr bool PERM = true;
    const float* res_lat; const float* res_ctx; const bf16_t* resb; bf16_t* X; const float* mod;
    __device__ __forceinline__ void operator()(const f32x4 (&acc)[2][2][4][2], const Unit& u, int wr, int wc, int fr, int fq) const {
        const int row0 = u.pm * BM + wr * 64 + fr, col0 = u.pn * BM + wc * 32 + 8 * fq;
        const float* ga = mod + (size_t)modrow_of(u.pm * BM) * 12288 + 2 * D;
        constexpr float sc = WOUT_F8 ? 1.f / 32.f : 1.f;
        f32x4 gv[2][2];
#pragma unroll
        for (int bj = 0; bj < 2; ++bj)
#pragma unroll
            for (int n = 0; n < 2; ++n) gv[bj][n] = *(const f32x4*)(ga + col0 + bj * HALF + n * 4) * sc;
        if (resb) {
#pragma unroll
            for (int ai = 0; ai < 2; ++ai)
#pragma unroll
                for (int m = 0; m < 4; ++m) { const int row = row0 + ai * HALF + m * 16; const bf16_t* rp = resb + (size_t)row * D + col0; bf16_t* xp = X + (size_t)row * D + col0;
#pragma unroll
                    for (int bj = 0; bj < 2; ++bj) { const u32x4 r = *(const u32x4*)(rp + bj * HALF);
                        const f32x4 v0 = (f32x4){bflo(r.x), bfhi(r.x), bflo(r.y), bfhi(r.y)} + gv[bj][0] * acc[ai][bj][m][0], v1 = (f32x4){bflo(r.z), bfhi(r.z), bflo(r.w), bfhi(r.w)} + gv[bj][1] * acc[ai][bj][m][1];
                        u32x4 o; o.x = cvt_pk_bf16(v0[0], v0[1]); o.y = cvt_pk_bf16(v0[2], v0[3]); o.z = cvt_pk_bf16(v1[0], v1[1]); o.w = cvt_pk_bf16(v1[2], v1[3]);
                        *(u32x4*)(xp + bj * HALF) = o; } }
        } else {
#pragma unroll
            for (int ai = 0; ai < 2; ++ai)
#pragma unroll
                for (int m = 0; m < 4; ++m) { const int row = row0 + ai * HALF + m * 16;
                    const float* rp = (row < TL ? res_lat + (size_t)row * D : res_ctx + (size_t)(row - TL) * D) + col0; bf16_t* xp = X + (size_t)row * D + col0;
#pragma unroll
                    for (int bj = 0; bj < 2; ++bj) { const f32x4 r0 = *(const f32x4*)(rp + bj * HALF), r1 = *(const f32x4*)(rp + bj * HALF + 4);
                        const f32x4 v0 = r0 + gv[bj][0] * acc[ai][bj][m][0], v1 = r1 + gv[bj][1] * acc[ai][bj][m][1];
                        u32x4 o; o.x = cvt_pk_bf16(v0[0], v0[1]); o.y = cvt_pk_bf16(v0[2], v0[3]); o.z = cvt_pk_bf16(v1[0], v1[1]); o.w = cvt_pk_bf16(v1[2], v1[3]);
                        *(u32x4*)(xp + bj * HALF) = o; } }
        }
    }
};
struct EpiMoe1 {
    static constexpr bool PERM = true;
    unsigned char* O;
    __device__ __forceinline__ void operator()(const f32x4 (&acc)[2][2][4][2], const Unit& u, int wr, int wc, int fr, int fq) const {
        const int row0 = u.pm * BM + wr * 64 + fr, col0 = (u.pn & 7) * HALF + wc * 32 + 8 * fq;
#pragma unroll
        for (int ai = 0; ai < 2; ++ai)
#pragma unroll
            for (int m = 0; m < 4; ++m) { unsigned char* rowp = O + (size_t)(row0 + ai * HALF + m * 16) * DE + col0; float h[8];
#pragma unroll
                for (int n = 0; n < 2; ++n)
#pragma unroll
                    for (int j = 0; j < 4; ++j) { const float gt = acc[ai][0][m][n][j] * (1.f / 32.f), up = acc[ai][1][m][n][j] * (1.f / 32.f); h[4 * n + j] = gt * __builtin_amdgcn_rcpf(1.f + __expf(-gt)) * up; }
                u32x2 w; w.x = pk4_f8(h[0], h[1], h[2], h[3]); w.y = pk4_f8(h[4], h[5], h[6], h[7]);
                *(u32x2*)rowp = w; }
    }
};
struct EpiMoe2 {
    static constexpr bool PERM = true;
    unsigned char* Y2; const int* rowtok; const float* roww;
    __device__ __forceinline__ void operator()(const f32x4 (&acc)[2][2][4][2], const Unit& u, int wr, int wc, int fr, int fq) const {
        const int row0 = u.pm * BM + wr * 64 + fr, col0 = (u.pn & 7) * BM + wc * 32 + 8 * fq;
#pragma unroll
        for (int ai = 0; ai < 2; ++ai)
#pragma unroll
            for (int m = 0; m < 4; ++m) { asm volatile("" ::: "memory"); const int row = row0 + ai * HALF + m * 16; const int tk = rowtok[row]; const float w = roww[row];
                if (tk >= 0) { unsigned char* rowp = Y2 + ((size_t)(tk >> 30) * TT + (size_t)(tk & 0x3fffffff)) * D + col0;
#pragma unroll
                    for (int bj = 0; bj < 2; ++bj) { const f32x4 v0 = acc[ai][bj][m][0] * w, v1 = acc[ai][bj][m][1] * w;
                        u32x2 o; o.x = pk4_f8(v0[0], v0[1], v0[2], v0[3]); o.y = pk4_f8(v1[0], v1[1], v1[2], v1[3]);
                        *(u32x2*)(rowp + bj * HALF) = o; } } }
    }
};
}

__device__ __forceinline__ void p0_transpose_item(const float* W, int ldw, int srccol0, int k0, bf16_t* dst, int K, LAS float* scr, int lane, bool q = false) {
    { f32x4 v[8];
#pragma unroll
      for (int i = 0; i < 8; ++i) v[i] = *(const f32x4*)(W + (size_t)(k0 + 8 * i + (lane >> 3)) * ldw + srccol0 + 4 * (lane & 7));
#pragma unroll
      for (int i = 0; i < 8; ++i) { LAS float* p = scr + (8 * i + (lane >> 3)) * 33 + 4 * (lane & 7); p[0] = v[i][0]; p[1] = v[i][1]; p[2] = v[i][2]; p[3] = v[i][3]; } }
    LDS_WAIT(); asm volatile("" ::: "memory");
    const int c = lane & 7;
#pragma unroll
    for (int j = 0; j < 4; ++j) { const int n = (lane >> 3) + 8 * j; const LAS float* s = scr + (8 * c) * 33 + n;
        u32x4 o; if (q) { o.x = pk2q(s[0 * 33], s[1 * 33]); o.y = pk2q(s[2 * 33], s[3 * 33]); o.z = pk2q(s[4 * 33], s[5 * 33]); o.w = pk2q(s[6 * 33], s[7 * 33]); }
        else { o.x = pk2(s[0 * 33], s[1 * 33]); o.y = pk2(s[2 * 33], s[3 * 33]); o.z = pk2(s[4 * 33], s[5 * 33]); o.w = pk2(s[6 * 33], s[7 * 33]); }
        *(u32x4*)(dst + (size_t)n * K + k0 + 8 * c) = o; }
    LDS_WAIT(); asm volatile("" ::: "memory");
}
__device__ __forceinline__ void p0_transpose_item8(const float* W, int ldw, int srccol0, int k0, unsigned char* dst, int K, LAS float* scr, int lane) {
    { f32x4 v[8];
#pragma unroll
      for (int i = 0; i < 8; ++i) v[i] = *(const f32x4*)(W + (size_t)(k0 + 8 * i + (lane >> 3)) * ldw + srccol0 + 4 * (lane & 7));
#pragma unroll
      for (int i = 0; i < 8; ++i) { LAS float* p = scr + (8 * i + (lane >> 3)) * 33 + 4 * (lane & 7); p[0] = v[i][0]; p[1] = v[i][1]; p[2] = v[i][2]; p[3] = v[i][3]; } }
    LDS_WAIT(); asm volatile("" ::: "memory");
    const int c = lane & 7;
#pragma unroll
    for (int j = 0; j < 4; ++j) { const int n = (lane >> 3) + 8 * j; const LAS float* s = scr + (8 * c) * 33 + n;
        u32x2 o; o.x = pk4_f8(s[0 * 33] * 32.f, s[1 * 33] * 32.f, s[2 * 33] * 32.f, s[3 * 33] * 32.f); o.y = pk4_f8(s[4 * 33] * 32.f, s[5 * 33] * 32.f, s[6 * 33] * 32.f, s[7 * 33] * 32.f);
        *(u32x2*)(dst + (size_t)n * K + k0 + 8 * c) = o; }
    LDS_WAIT(); asm volatile("" ::: "memory");
}
constexpr int TI_WIN = 32 * 168, TI_WA = 32, TI_WOUT = 32 * 64, TI_GU = 32 * 64, TI_DN = 16 * 64;
constexpr int TI_L = TI_WIN + TI_WA + TI_WOUT;
constexpr int TI_TOTAL = 2 * TI_L + 32 * TI_GU + 32 * TI_DN;
__device__ __forceinline__ void p0_item(KP Pk, Frame& F, int it, LAS float* scr) {
    unsigned char* ws = F.ws;
    if (it < 2 * TI_L) { const int l = it / TI_L; int r = it % TI_L;
        if (r < TI_WIN) { const int kb = r / 168, nb = r % 168, n0 = 32 * nb;
            if (WIN_F8_L(l)) p0_transpose_item8(Pk->in[I_WIN] + (size_t)l * D * DIN, DIN, n0 < 1536 ? n0 : n0 + 32, 64 * kb, ws + WS_WIN + (size_t)l * NU * D * 2 + (size_t)n0 * D, D, scr, F.lane);
            else p0_transpose_item(Pk->in[I_WIN] + (size_t)l * D * DIN, DIN, n0 < 1536 ? n0 : n0 + 32, 64 * kb, (bf16_t*)(ws + WS_WIN) + ((size_t)l * NU + n0) * D, D, scr, F.lane); return; }
        r -= TI_WIN;
        if (r < TI_WA) { if (WIN_F8_L(l)) p0_transpose_item8(Pk->in[I_WIN] + (size_t)l * D * DIN, DIN, 1536, 64 * r, ws + WS_WA + (size_t)l * 32 * D * 2, D, scr, F.lane);
            else p0_transpose_item(Pk->in[I_WIN] + (size_t)l * D * DIN, DIN, 1536, 64 * r, (bf16_t*)(ws + WS_WA) + (size_t)l * 32 * D, D, scr, F.lane); return; }
        r -= TI_WA;
        { const int kb = r / 64, nb = r % 64;
          if (WOUT_F8) p0_transpose_item8(Pk->in[I_WOUT] + (size_t)l * D * D, D, 32 * nb, 64 * kb, ws + WS_WOUT + ((size_t)l * D + 32 * nb) * D, D, scr, F.lane);
          else p0_transpose_item(Pk->in[I_WOUT] + (size_t)l * D * D, D, 32 * nb, 64 * kb, (bf16_t*)(ws + WS_WOUT) + ((size_t)l * D + 32 * nb) * D, D, scr, F.lane); return; }
    }
    it -= 2 * TI_L;
    if (it < 32 * TI_GU) { const int le = it / TI_GU, r = it % TI_GU, kb = r / 64, nb = r % 64, n0 = 32 * nb, j = n0 >> 8, half = (n0 >> 7) & 1, c0 = 128 * j + (n0 & 127);
        p0_transpose_item8((half ? Pk->in[I_EU] : Pk->in[I_EG]) + (size_t)le * D * DE, DE, c0, 64 * kb, ws + WS_WGU + ((size_t)le * 2048 + n0) * D, D, scr, F.lane); return; }
    it -= 32 * TI_GU;
    { const int le = it / TI_DN, r = it % TI_DN, kb = r / 64, nb = r % 64;
        p0_transpose_item8(Pk->in[I_ED] + (size_t)le * DE * D, D, 32 * nb, 64 * kb, ws + WS_WD + ((size_t)le * D + 32 * nb) * DE, DE, scr, F.lane); }
}
__device__ __forceinline__ void ada_unit(KP Pk, Frame& F, int u) {
    unsigned char* ws = F.ws;
    __syncthreads();
        LAS float* sc = (LAS float*)F.lds;
        LAS float* red = (LAS float*)(F.lds + 9 * 2048 * 4);
        for (int i = F.tid; i < 9 * 2048; i += NTHR) { const int r = i >> 11, k = i & 2047; const float v = r < 8 ? Pk->in[I_C][r * 2048 + k] : Pk->in[I_CCTX][k]; sc[i] = silu_f(v); }
        __syncthreads();
        const int l = u / 96, cb = u % 96, col = cb * 128 + (F.tid & 127), kp = F.tid >> 7;
        const float* W = Pk->in[I_ADAW] + (size_t)l * D * 12288 + col;
        float a[9];
#pragma unroll
        for (int r = 0; r < 9; ++r) a[r] = 0.f;
        for (int k = kp * 512; k < kp * 512 + 512; k += 32) {
            float w[32];
#pragma unroll
            for (int q = 0; q < 32; ++q) w[q] = W[(size_t)(k + q) * 12288];
#pragma unroll
            for (int q = 0; q < 32; ++q) {
#pragma unroll
                for (int r = 0; r < 9; ++r) a[r] += sc[r * 2048 + k + q] * w[q];
                if ((q & 3) == 3) __builtin_amdgcn_sched_barrier(0); }
        }
#pragma unroll
        for (int r = 0; r < 9; ++r) red[(kp * 9 + r) * 128 + (F.tid & 127)] = a[r];
        __syncthreads();
        for (int i = F.tid; i < 9 * 128; i += NTHR) { const int r = i >> 7, c = i & 127;
            const float s = (red[(0 * 9 + r) * 128 + c] + red[(1 * 9 + r) * 128 + c]) + (red[(2 * 9 + r) * 128 + c] + red[(3 * 9 + r) * 128 + c]);
            ((float*)(ws + WS_MOD))[((size_t)l * 9 + r) * 12288 + cb * 128 + c] = s + Pk->in[I_ADAB][l * 12288 + cb * 128 + c]; }
        __syncthreads();
}
__device__ __forceinline__ void p0_prologue(KP Pk, Frame& F, int rep) {
    unsigned char* ws = F.ws;
    const int gw = F.vcu * NWAVES + F.wave, NGW = F.G * NWAVES;
    if (blockIdx.x < 96) ada_unit(Pk, F, (int)blockIdx.x);
    for (int i = blockIdx.x * NTHR + F.tid; i < SEQ * 64; i += F.G * NTHR) { const int t = i >> 6, j = i & 63, q = j >> 4, f = j & 15;
        const float inv = exp2f(-(float)f * (13.287712379549449f / 16.f)); const float pos = (float)(q < 2 ? (t >> 6) : (t & 63)); const float ang = pos * inv;
        ((float*)(ws + WS_ROPE))[i] = (q & 1) ? sinf(ang) : cosf(ang); }
    for (int it = gw; it < 2 * 2304; it += NGW) { const int l = it / 2304, tt = it % 2304, L = tt < 2048 ? 2048 : 256, t = tt < 2048 ? tt : tt - 2048;
        const float tn = (float)t / (float)(L - 1), wv = (6.283185307179586f / (float)L) * (float)t;
        const float* w1 = Pk->in[I_HW1] + l * 33 * 64; const float* w2 = Pk->in[I_HW2] + l * 64 * 64;
        float zv = 0.f;
        if (F.lane == 0) zv = tn; else if (F.lane < 33) { const int bi = (F.lane - 1) & 15; const float band = 1e-4f + (float)bi * ((15.f - 1e-4f) / 15.f); zv = F.lane < 17 ? cosf(wv * band) : -sinf(wv * band); }
        float s = Pk->in[I_HB1][l * 64 + F.lane];
#pragma unroll
        for (int i = 0; i < 33; ++i) s += __shfl(zv, i) * w1[i * 64 + F.lane];
        const float h1 = sinf(Pk->in[I_HFR][(l * 2 + 0) * 64 + F.lane] * s);
        float s2 = Pk->in[I_HB2][l * 64 + F.lane];
#pragma unroll 16
        for (int i = 0; i < 64; ++i) s2 += __shfl(h1, i) * w2[i * 64 + F.lane];
        ((float*)(ws + WS_HYH2))[(size_t)it * 64 + F.lane] = sinf(Pk->in[I_HFR][(l * 2 + 1) * 64 + F.lane] * s2);
    }
    { LAS float* scr = (LAS float*)(F.lds + F.wave * 8704);
      __syncthreads();
      for (;;) { int base = 0; if (F.lane == 0) base = (int)__hip_atomic_fetch_add(F.ctl + CW_Q + 64 * (rep ? 5 : 0), 16u, __ATOMIC_RELAXED, __HIP_MEMORY_SCOPE_AGENT);
          base = __builtin_amdgcn_readfirstlane(base); if (base >= TI_WIN + TI_WA) break;
          for (int it = base; it < base + 16 && it < TI_WIN + TI_WA; ++it) p0_item(Pk, F, it, scr); } }
}

#define MFMA16(a, b, c) __builtin_amdgcn_mfma_f32_16x16x32_bf16((a), (b), (c), 0, 0, 0)
#define MFMA32(a, b, c) __builtin_amdgcn_mfma_f32_32x32x16_bf16((a), (b), (c), 0, 0, 0)
__device__ __forceinline__ void load_row(const float* p, int lane, f32x4 (&v)[8]) {
#pragma unroll
    for (int j = 0; j < 8; ++j) v[j] = ((const f32x4*)p)[lane + 64 * j];
}
__device__ __forceinline__ void load_row_bf16(const bf16_t* p, int lane, f32x4 (&v)[8]) {
#pragma unroll
    for (int j = 0; j < 8; ++j) { const u32x2 a = ((const u32x2*)p)[lane + 64 * j]; v[j] = (f32x4){bflo(a.x), bfhi(a.x), bflo(a.y), bfhi(a.y)}; }
}
__device__ __forceinline__ void add_y2(const unsigned char* y0, const unsigned char* y1, const float* gf, int lane, f32x4 (&v)[8]) {
#pragma unroll
    for (int j = 0; j < 8; ++j) { const unsigned a = ((const unsigned*)y0)[lane + 64 * j], b = ((const unsigned*)y1)[lane + 64 * j]; const f32x4 g = ((const f32x4*)gf)[lane + 64 * j] * (1.f / 32.f);
        const f32x2 a0 = __builtin_amdgcn_cvt_pk_f32_fp8(a, false), a1 = __builtin_amdgcn_cvt_pk_f32_fp8(a, true), b0 = __builtin_amdgcn_cvt_pk_f32_fp8(b, false), b1 = __builtin_amdgcn_cvt_pk_f32_fp8(b, true);
        v[j][0] += g[0] * (a0[0] + b0[0]); v[j][1] += g[1] * (a0[1] + b0[1]); v[j][2] += g[2] * (a1[0] + b1[0]); v[j][3] += g[3] * (a1[1] + b1[1]); }
}
__device__ __forceinline__ float row_rstd(const f32x4 (&v)[8]) {
    float s = 0.f;
#pragma unroll
    for (int j = 0; j < 8; ++j) s += (v[j][0] * v[j][0] + v[j][1] * v[j][1]) + (v[j][2] * v[j][2] + v[j][3] * v[j][3]);
    return rsqrtf(wave_sum(s) * (1.f / D) + NORM_EPS);
}
__device__ __forceinline__ void modulate(f32x4 (&v)[8], float rstd, const float* nw, const float* sh, const float* sc, int lane) {
#pragma unroll
    for (int j = 0; j < 8; ++j) { const f32x4 w = ((const f32x4*)nw)[lane + 64 * j], a = ((const f32x4*)sc)[lane + 64 * j], b = ((const f32x4*)sh)[lane + 64 * j];
        v[j] = v[j] * rstd * w * (a + 1.f) + b; }
}
__device__ __forceinline__ void store_row_bf16(bf16_t* o, int lane, const f32x4 (&v)[8], bool q = false) {
#pragma unroll
    for (int j = 0; j < 8; ++j) { u32x2 w; if (q) { w.x = pk2q(v[j][0], v[j][1]); w.y = pk2q(v[j][2], v[j][3]); } else { w.x = pk2(v[j][0], v[j][1]); w.y = pk2(v[j][2], v[j][3]); } ((u32x2*)o)[lane + 64 * j] = w; }
}
__device__ __forceinline__ void store_row_f8(unsigned char* o, int lane, const f32x4 (&v)[8]) {
#pragma unroll
    for (int j = 0; j < 8; ++j) ((unsigned*)o)[lane + 64 * j] = pk4_f8(v[j][0], v[j][1], v[j][2], v[j][3]);
}
__device__ __forceinline__ void ph_norm1(KP Pk, Frame& F, int l) {
    unsigned char* ws = F.ws;
    const int gw = F.vcu * NWAVES + F.wave, NGW = F.G * NWAVES;
    const float* mod = (const float*)(ws + WS_MOD) + (size_t)l * 9 * 12288;
    bf16_t* X = (bf16_t*)(ws + WS_X); bf16_t* H = (bf16_t*)(ws + WS_H); const unsigned char* Y2 = ws + WS_Y2;
    for (int row = gw; row < TT; row += NGW) {
        const int r = modrow_of(row); f32x4 v[8];
        if (l == 0) load_row(row < TL ? Pk->in[I_X] + (size_t)row * D : Pk->in[I_CTX] + (size_t)(row - TL) * D, F.lane, v);
        else { load_row_bf16(X + (size_t)row * D, F.lane, v);
            add_y2(Y2 + (size_t)row * D, Y2 + ((size_t)TT + row) * D, (const float*)(ws + WS_MOD) + (size_t)r * 12288 + 5 * D, F.lane, v);
            if (row < TL) store_row_bf16(X + (size_t)row * D, F.lane, v); }
        const float rstd = row_rstd(v);
        modulate(v, rstd, Pk->in[I_N1W] + l * D, mod + (size_t)r * 12288, mod + (size_t)r * 12288 + D, F.lane);
        if (WIN_F8_L(l)) store_row_f8(ws + WS_H + (size_t)row * D, F.lane, v); else store_row_bf16(H + (size_t)row * D, F.lane, v);
    }
}
__device__ __forceinline__ void ph_hyena_filters(KP Pk, Frame& F, int u) {
    unsigned char* ws = F.ws;
    constexpr int HRS = 2052;
    LAS float* HR = (LAS float*)F.lds; LAS float* red = (LAS float*)(F.lds + 16 * HRS * 4);
    const int r16 = F.lane & 15, kg = F.lane >> 4;
    {
        const int lf = u >> 7, cg = u & 127, chl = r16 & 3, od = r16 >> 2, ch = cg * 4 + chl;
        const float* w3 = Pk->in[I_HW3] + (size_t)lf * 64 * 2048 + (od >> 1) * 1024 + (od & 1) * 512 + ch;
        bf16x8 wb[2];
#pragma unroll
        for (int ks = 0; ks < 2; ++ks) { float w[8];
#pragma unroll
            for (int j = 0; j < 8; ++j) w[j] = w3[(size_t)(32 * ks + 8 * kg + j) * 2048];
            u32x4 p; p.x = pk2(w[0], w[1]); p.y = pk2(w[2], w[3]); p.z = pk2(w[4], w[5]); p.w = pk2(w[6], w[7]); wb[ks] = __builtin_bit_cast(bf16x8, p); }
        const float dmin = 3.0701134573253940f, dmax = 15.350567286626972f, delta = dmin + (float)ch * ((dmax - dmin) / 511.f);
#pragma unroll 1
        for (int sel = 0; sel < 2; ++sel) {
            const int L = sel == 0 ? 2048 : 256; const float* h2 = (const float*)(ws + WS_HYH2) + ((size_t)lf * 2304 + (sel == 0 ? 0 : 2048)) * 64; const float rl = 1.f / (float)(L - 1);
            __syncthreads();
            float s = 0.f;
#pragma unroll 2
            for (int tile = F.wave; tile < L / 16; tile += NWAVES) {
                const f32x4* hp = (const f32x4*)(h2 + (size_t)(16 * tile + r16) * 64 + 8 * kg);
                const f32x4 a0 = hp[0], a1 = hp[1], a2 = hp[8], a3 = hp[9];
                u32x4 p0, p1; p0.x = pk2(a0[0], a0[1]); p0.y = pk2(a0[2], a0[3]); p0.z = pk2(a1[0], a1[1]); p0.w = pk2(a1[2], a1[3]); p1.x = pk2(a2[0], a2[1]); p1.y = pk2(a2[2], a2[3]); p1.z = pk2(a3[0], a3[1]); p1.w = pk2(a3[2], a3[3]);
                f32x4 d = MFMA16(__builtin_bit_cast(bf16x8, p0), wb[0], ((f32x4){0.f, 0.f, 0.f, 0.f})); d = MFMA16(__builtin_bit_cast(bf16x8, p1), wb[1], d);
                const int t0 = 16 * tile + 4 * kg;
#pragma unroll
                for (int i = 0; i < 4; ++i) { d[i] *= expf(-(float)(t0 + i) * rl * delta); s += fabsf(d[i]); }
                *(LAS f32x4*)(HR + r16 * HRS + t0) = d; }
            s += __shfl_xor(s, 16); s += __shfl_xor(s, 32);
            if (F.lane < 16) red[F.wave * 16 + F.lane] = s;
            __syncthreads();
            for (int e = F.tid; e < 16 * L; e += NTHR) { const int col = e / L, t = e % L, dir = (col >> 2) & 1, o = col >> 3, c = cg * 4 + (col & 3);
                float tot = 0.f;
#pragma unroll
                for (int w = 0; w < 8; ++w) tot += red[w * 16 + (col & ~4)] + red[w * 16 + (col | 4)];
                float hv = HR[col * HRS + t] / tot; int idx = dir == 0 ? L - t : L + t;
                if (dir == 1 && t == 0) { idx = 0; hv = 0.f; }
                ((bf16_t*)(ws + WS_HYF) + ((size_t)lf * 1024 + o * 512 + c) * 4608)[(sel == 0 ? 0 : 4096) + idx] = (bf16_t)f2bf(hv); }
        }
    }
}
__device__ __forceinline__ void ph_norm2_router(KP Pk, Frame& F, int l, int rep) {
    unsigned char* ws = F.ws;
    const int gw = F.vcu * NWAVES + F.wave, NGW = F.G * NWAVES, nrows = l == 0 ? TT : TL;
    const float* mod = (const float*)(ws + WS_MOD) + (size_t)l * 9 * 12288;
    const bf16_t* X = (const bf16_t*)(ws + WS_X); unsigned char* Fo = ws + WS_H;
    LAS float* rw = (LAS float*)F.lds;
    volatile LAS unsigned* lcnt = F.MISC + 16;
    if (F.tid < 16) lcnt[F.tid] = 0u;
    for (int i = F.tid; i < 2048 * 4; i += NTHR) { const f32x4 w = ((const f32x4*)Pk->in[I_RW])[i]; const int k = i >> 2, e0 = (i & 3) * 4;
        rw[(e0 + 0) * 2048 + k] = w[0]; rw[(e0 + 1) * 2048 + k] = w[1]; rw[(e0 + 2) * 2048 + k] = w[2]; rw[(e0 + 3) * 2048 + k] = w[3]; }
    __syncthreads();
    float rb[16];
#pragma unroll
    for (int e = 0; e < 16; ++e) rb[e] = Pk->in[I_RB][e];
    for (int rowA = gw; rowA < nrows; rowA += 2 * NGW) {
        const bool hasB = rowA + NGW < nrows; const int rowB = hasB ? rowA + NGW : rowA;
        f32x4 va[8], vb[8];
        load_row_bf16(X + (size_t)rowA * D, F.lane, va); load_row_bf16(X + (size_t)rowB * D, F.lane, vb);
        { const int r = modrow_of(rowA); const float rstd = row_rstd(va); modulate(va, rstd, Pk->in[I_N2W] + l * D, mod + (size_t)r * 12288 + 3 * D, mod + (size_t)r * 12288 + 4 * D, F.lane); store_row_f8(Fo + (size_t)rowA * D, F.lane, va); }
        { const int r = modrow_of(rowB); const float rstd = row_rstd(vb); modulate(vb, rstd, Pk->in[I_N2W] + l * D, mod + (size_t)r * 12288 + 3 * D, mod + (size_t)r * 12288 + 4 * D, F.lane); if (hasB) store_row_f8(Fo + (size_t)rowB * D, F.lane, vb); }
        float pa[32];
#pragma unroll
        for (int e = 0; e < 16; ++e) { f32x2 a = {0.f, 0.f}, b = {0.f, 0.f};
#pragma unroll
            for (int j = 0; j < 8; ++j) { const f32x4 w = ((const LAS f32x4*)(rw + e * 2048))[F.lane + 64 * j];
                const f32x2 wl = __builtin_shufflevector(w, w, 0, 1), wh = __builtin_shufflevector(w, w, 2, 3);
                a = __builtin_elementwise_fma(__builtin_shufflevector(va[j], va[j], 0, 1), wl, a); a = __builtin_elementwise_fma(__builtin_shufflevector(va[j], va[j], 2, 3), wh, a);
                b = __builtin_elementwise_fma(__builtin_shufflevector(vb[j], vb[j], 0, 1), wl, b); b = __builtin_elementwise_fma(__builtin_shufflevector(vb[j], vb[j], 2, 3), wh, b); }
            pa[e] = a[0] + a[1]; pa[16 + e] = b[0] + b[1]; }
#define RB_STEP(N, BIT) { const bool up = (F.lane & (BIT)) != 0; _Pragma("unroll") for (int k = 0; k < (N); ++k) { const float keep = up ? pa[(N) + k] : pa[k], send = up ? pa[k] : pa[(N) + k]; pa[k] = keep + __shfl_xor(send, (BIT)); } }
        RB_STEP(16, 32) RB_STEP(8, 16) RB_STEP(4, 8) RB_STEP(2, 4) RB_STEP(1, 2)
#undef RB_STEP
        const float red = pa[0] + __shfl_xor(pa[0], 1);
        float lg[16];
#pragma unroll
        for (int e = 0; e < 16; ++e) lg[e] = __shfl(red, (F.lane & 32) + 2 * e);
        float mx = lg[0];
#pragma unroll
        for (int e = 1; e < 16; ++e) mx = fmaxf(mx, lg[e]);
        float sum = 0.f;
#pragma unroll
        for (int e = 0; e < 16; ++e) { lg[e] = expf(lg[e] - mx); sum += lg[e]; }
        const float rs = 1.f / sum; float sel[16];
#pragma unroll
        for (int e = 0; e < 16; ++e) { lg[e] *= rs; sel[e] = lg[e] + rb[e]; }
        int grp = 0; float gbest = fmaxf(fmaxf(sel[0], sel[1]), fmaxf(sel[2], sel[3]));
#pragma unroll
        for (int g = 1; g < 4; ++g) { const float gm = fmaxf(fmaxf(sel[4 * g], sel[4 * g + 1]), fmaxf(sel[4 * g + 2], sel[4 * g + 3])); if (gm > gbest) { gbest = gm; grp = g; } }
        float s4[4], p4[4];
#pragma unroll
        for (int i = 0; i < 4; ++i) { s4[i] = grp == 0 ? sel[i] : grp == 1 ? sel[4 + i] : grp == 2 ? sel[8 + i] : sel[12 + i]; p4[i] = grp == 0 ? lg[i] : grp == 1 ? lg[4 + i] : grp == 2 ? lg[8 + i] : lg[12 + i]; }
        int i0 = 0; float b0 = s4[0];
#pragma unroll
        for (int i = 1; i < 4; ++i) if (s4[i] > b0) { b0 = s4[i]; i0 = i; }
        int i1 = -1; float b1 = 0.f;
#pragma unroll
        for (int i = 0; i < 4; ++i) if (i != i0 && (i1 < 0 || s4[i] > b1)) { b1 = s4[i]; i1 = i; }
        const float p0 = i0 == 0 ? p4[0] : i0 == 1 ? p4[1] : i0 == 2 ? p4[2] : p4[3], p1 = i1 == 0 ? p4[0] : i1 == 1 ? p4[1] : i1 == 2 ? p4[2] : p4[3];
        const int e0 = grp * 4 + i0, e1 = grp * 4 + i1; const float ws_ = 1.f / (p0 + p1);
        if (F.lane == 0 || (F.lane == 32 && hasB)) { const int row = F.lane == 0 ? rowA : rowB;
            ((int*)(ws + WS_RT + RT_E))[row] = e0 | (e1 << 8); ((f32x2*)(ws + WS_RT + RT_W))[row] = (f32x2){p0 * ws_, p1 * ws_};
            __hip_atomic_fetch_add((LAS unsigned*)&lcnt[e0], 1u, __ATOMIC_RELAXED, __HIP_MEMORY_SCOPE_WORKGROUP); __hip_atomic_fetch_add((LAS unsigned*)&lcnt[e1], 1u, __ATOMIC_RELAXED, __HIP_MEMORY_SCOPE_WORKGROUP); }
    }
    __syncthreads();
    { int t_; asm volatile("v_mbcnt_lo_u32_b32 %0, -1, 0\n\tv_mbcnt_hi_u32_b32 %0, -1, %0" : "=v"(t_)); t_ += F.wave * 64;
      if (t_ < 16 && lcnt[t_]) __hip_atomic_fetch_add(F.ctl + CW_CNT + 64 * (l + 2 * rep) + t_, lcnt[t_], __ATOMIC_RELAXED, __HIP_MEMORY_SCOPE_AGENT); }
}
__device__ __forceinline__ int moe_table(Frame& F, int l) {
    volatile LAS unsigned char* pexp = (volatile LAS unsigned char*)(F.MISC + 64);
    __syncthreads();
    if (F.tid < 64) {
        const int e = F.lane & 15; const int c = (int)__hip_atomic_load(F.ctl + CW_CNT + 64 * l + e, __ATOMIC_RELAXED, __HIP_MEMORY_SCOPE_AGENT);
        const int np = (c + 255) >> 8; int p0 = np;
#pragma unroll
        for (int d = 1; d < 16; d <<= 1) { const int y = __shfl(p0, F.lane - d); if (e >= d) p0 += y; }
        const int tot = __shfl(p0, 15); p0 -= np;
        if (F.lane < 16) { F.MISC[32 + e] = (unsigned)(p0 * 256); for (int j = 0; j < np; ++j) pexp[p0 + j] = (unsigned char)e; if (e == 0) F.MISC[2] = (unsigned)tot; }
    }
    __syncthreads();
    return (int)F.MISC[2];
}
__device__ __forceinline__ void ph_slots(KP Pk, Frame& F, int l) {
    unsigned char* ws = F.ws;
    const int nrows = l == 0 ? TT : TL, per = (nrows + F.G - 1) / F.G, t0 = blockIdx.x * per, t1 = min(nrows, t0 + per);
    (void)moe_table(F, l);
    volatile LAS unsigned* lcnt = F.MISC + 16; volatile LAS unsigned* lbase = F.MISC + 48;
    if (F.tid < 16) lcnt[F.tid] = 0u;
    __syncthreads();
    const int* RE = (const int*)(ws + WS_RT + RT_E); const f32x2* RW = (const f32x2*)(ws + WS_RT + RT_W);
    int* ROWTOK = (int*)(ws + WS_RT + RT_ROWTOK); float* ROWW = (float*)(ws + WS_RT + RT_ROWW);
    const int tok = t0 + F.tid; int e0 = 0, e1 = 0; unsigned q0 = 0, q1 = 0;
    if (tok < t1) { const int ee = RE[tok]; e0 = ee & 255; e1 = ee >> 8;
        q0 = __hip_atomic_fetch_add((LAS unsigned*)&lcnt[e0], 1u, __ATOMIC_RELAXED, __HIP_MEMORY_SCOPE_WORKGROUP); q1 = __hip_atomic_fetch_add((LAS unsigned*)&lcnt[e1], 1u, __ATOMIC_RELAXED, __HIP_MEMORY_SCOPE_WORKGROUP); }
    __syncthreads();
    if (F.tid < 16) lbase[F.tid] = lcnt[F.tid] ? __hip_atomic_fetch_add(F.ctl + CW_CUR + 64 * l + F.tid, lcnt[F.tid], __ATOMIC_RELAXED, __HIP_MEMORY_SCOPE_AGENT) : 0u;
    __syncthreads();
    if (tok < t1) { const f32x2 w = RW[tok]; const int r0 = (int)(F.MISC[32 + e0] + lbase[e0] + q0), r1 = (int)(F.MISC[32 + e1] + lbase[e1] + q1);
        ROWTOK[r0] = tok; ROWW[r0] = w.x; ROWTOK[r1] = tok | (1 << 30); ROWW[r1] = w.y; }
    if (blockIdx.x < NE) { const int e = blockIdx.x, c = (int)__hip_atomic_load(F.ctl + CW_CNT + 64 * l + e, __ATOMIC_RELAXED, __HIP_MEMORY_SCOPE_AGENT), base = (int)F.MISC[32 + e];
        for (int i = c + F.tid; i < ((c + 255) & ~255); i += NTHR) { ROWTOK[base + i] = -1; ROWW[base + i] = 0.f; } }
}
__device__ __forceinline__ void ph_final(KP Pk, Frame& F) {
    unsigned char* ws = F.ws;
    const int gw = F.vcu * NWAVES + F.wave, NGW = F.G * NWAVES;
    const bf16_t* X = (const bf16_t*)(ws + WS_X); const unsigned char* Y2 = ws + WS_Y2;
    for (int row = gw; row < TL; row += NGW) { f32x4 v[8];
        load_row_bf16(X + (size_t)row * D, F.lane, v);
        add_y2(Y2 + (size_t)row * D, Y2 + ((size_t)TT + row) * D, (const float*)(ws + WS_MOD) + ((size_t)9 + (row >> 11)) * 12288 + 5 * D, F.lane, v);
#pragma unroll
        for (int j = 0; j < 8; ++j) ((f32x4*)(Pk->out + (size_t)row * D))[F.lane + 64 * j] = v[j]; }
}

__device__ __forceinline__ void ph_gate_cols(Frame& F, int l) {
    unsigned char* ws = F.ws;
    const int r32 = F.lane & 31, hi = F.lane >> 5;
    const bf16_t* H = (const bf16_t*)(ws + WS_H); const bf16_t* Wa = (const bf16_t*)(ws + WS_WA) + (size_t)l * 32 * D; float* AG = (float*)(ws + WS_AG);
    LAS unsigned char* tile = F.lds + F.wave * 16896;
    LAS float* red = (LAS float*)F.lds;
    for (int it = blockIdx.x; it < TT / 32; it += F.G) {
        const int kb = F.wave * 256;
        u32x4 av[16]; bf16x8 bv[16];
#pragma unroll
        for (int i = 0; i < 16; ++i) { const int id = F.lane + 64 * i; av[i] = *(const u32x4*)(H + (size_t)(it * 32 + (id >> 5)) * D + kb + 8 * (id & 31)); }
#pragma unroll
        for (int ks = 0; ks < 16; ++ks) bv[ks] = *(const bf16x8*)(Wa + (size_t)r32 * D + kb + 16 * ks + 8 * hi);
        __syncthreads();
#pragma unroll
        for (int i = 0; i < 16; ++i) { const int id = F.lane + 64 * i; *(LAS u32x4*)(tile + ((id >> 5) * 264 + 8 * (id & 31)) * 2) = av[i]; }
        f32x16 acc = {};
#pragma unroll
        for (int ks = 0; ks < 16; ++ks) { const bf16x8 a = *(const LAS bf16x8*)(tile + (r32 * 264 + 16 * ks + 8 * hi) * 2); acc = MFMA32(a, bv[ks], acc); }
        __syncthreads();
#pragma unroll
        for (int r = 0; r < 16; ++r) red[(F.wave * 16 + r) * 64 + F.lane] = acc[r];
        __syncthreads();
        for (int e = F.tid; e < 1024; e += NTHR) { float sum = 0.f;
#pragma unroll
            for (int w = 0; w < 8; ++w) sum += red[w * 1024 + e];
            const int r = e >> 6, ln = e & 63; AG[(size_t)(it * 32 + (r & 3) + 8 * (r >> 2) + 4 * (ln >> 5)) * 32 + (ln & 31)] = sum; }
    }
}

__device__ __forceinline__ void ph_gate_cols8(Frame& F, int l) {
    unsigned char* ws = F.ws;
    const int fr = F.lane & 15, fq = F.lane >> 4, kb = F.wave * 256;
    const unsigned char* H8 = ws + WS_H; const unsigned char* Wa8 = ws + WS_WA + (size_t)l * 32 * D * 2; float* AG = (float*)(ws + WS_AG);
    LAS f32x4* red = (LAS f32x4*)F.lds;
    int f8scale = 0x7f7f7f7f; asm volatile("" : "+v"(f8scale));
    i32x8 b[2][2], a[2][2];
#pragma unroll
    for (int ch = 0; ch < 2; ++ch)
#pragma unroll
        for (int ks = 0; ks < 2; ++ks) b[ch][ks] = *(const i32x8*)(Wa8 + (size_t)(16 * ch + fr) * D + kb + 128 * ks + 32 * fq);
    int it = blockIdx.x;
    if (it < TT / 32) {
#pragma unroll
        for (int rh = 0; rh < 2; ++rh)
#pragma unroll
            for (int ks = 0; ks < 2; ++ks) a[rh][ks] = *(const i32x8*)(H8 + (size_t)(it * 32 + 16 * rh + fr) * D + kb + 128 * ks + 32 * fq); }
    for (; it < TT / 32; it += F.G) {
        f32x4 acc[2][2];
#pragma unroll
        for (int rh = 0; rh < 2; ++rh)
#pragma unroll
            for (int ch = 0; ch < 2; ++ch) acc[rh][ch] = (f32x4){0.f, 0.f, 0.f, 0.f};
#pragma unroll
        for (int ks = 0; ks < 2; ++ks)
#pragma unroll
            for (int rh = 0; rh < 2; ++rh)
#pragma unroll
                for (int ch = 0; ch < 2; ++ch)
                    asm volatile("v_mfma_scale_f32_16x16x128_f8f6f4 %0, %1, %2, %0, %3, %3 op_sel_hi:[0,0,0]" : "+v"(acc[rh][ch]) : "v"(b[ch][ks]), "v"(a[rh][ks]), "v"(f8scale));
        asm volatile("s_nop 15\n\ts_nop 15" : "+v"(acc[0][0]), "+v"(acc[0][1]), "+v"(acc[1][0]), "+v"(acc[1][1]) :: "memory");
        const int nx = it + F.G;
        if (nx < TT / 32) {
#pragma unroll
            for (int rh = 0; rh < 2; ++rh)
#pragma unroll
                for (int ks = 0; ks < 2; ++ks) a[rh][ks] = *(const i32x8*)(H8 + (size_t)(nx * 32 + 16 * rh + fr) * D + kb + 128 * ks + 32 * fq); }
        __syncthreads();
#pragma unroll
        for (int rh = 0; rh < 2; ++rh)
#pragma unroll
            for (int ch = 0; ch < 2; ++ch) red[(F.wave * 4 + rh * 2 + ch) * 64 + F.lane] = acc[rh][ch];
        __syncthreads();
        for (int e = F.tid; e < 1024; e += NTHR) { float sum = 0.f;
#pragma unroll
            for (int w = 0; w < 8; ++w) sum += ((const LAS float*)red)[w * 1024 + e];
            const int blk = e >> 8, ln = (e >> 2) & 63, k = e & 3;
            AG[(size_t)(it * 32 + 16 * (blk >> 1) + (ln & 15)) * 32 + 16 * (blk & 1) + 4 * (ln >> 4) + k] = sum * (1.f / 32.f); }
    }
}

constexpr int WAVE_LDS = 17408;
__device__ __forceinline__ int perm16(int k) { return (k & 3) + 4 * ((k >> 3) & 1) + 8 * ((k >> 2) & 1); }
__device__ __forceinline__ int gla_kidx(int dir, int s) { return dir == 0 ? s : (s < LC ? LC - 1 - s : LC + (SEQ - 1 - (s - LC))); }
constexpr int GL_QT = 0, GL_KT = 1280, GL_KHT = 2560, GL_VT = 4096, GL_PT = 7168, GL_ST = 7936, GL_G = 13056, GL_GW = 13312, GL_GB = 15360;
__device__ __forceinline__ void gla_load_gates(KP Pk, Frame& F, int l, int h, int dir, LAS unsigned char* wl) {
    LAS float* gw = (LAS float*)(wl + GL_GW); LAS float* gb = (LAS float*)(wl + GL_GB);
    const float* src = Pk->in[I_GGW] + ((size_t)(l * 2 + dir) * 16) * 256 + h * 32;
#pragma unroll
    for (int i = 0; i < 8; ++i) { const int e = F.lane + 64 * i; gw[e] = src[(e >> 5) * 256 + (e & 31)]; }
    if (F.lane < 32) gb[F.lane] = Pk->in[I_GGB][(l * 2 + dir) * 256 + h * 32 + F.lane];
}
struct GlaIn { f32x4 ag[4]; u32x4 kv, qv, v0, v1; };
template <bool NEEDQ>
__device__ __forceinline__ void gla_sub_load(Frame& F, int b, int h, int dir, int kidx0, GlaIn& in) {
    unsigned char* ws = F.ws;
    int lane_o = F.lane; asm volatile("" : "+v"(lane_o));
    const int tau = lane_o & 15, dq = lane_o >> 4, row = keyrow(b, kidx0 + tau);
    const f32x4* ag = (const f32x4*)((const float*)(ws + WS_AG) + (size_t)row * 32 + dir * 16);
#pragma unroll
    for (int r4 = 0; r4 < 4; ++r4) in.ag[r4] = ag[r4];
    const bf16_t* U = (const bf16_t*)(ws + WS_U) + (size_t)row * NU;
    in.kv = *(const u32x4*)(U + UC_GK + h * 32 + dq * 8);
    if (NEEDQ) in.qv = *(const u32x4*)(U + UC_GQ + h * 32 + dq * 8);
    in.v0 = *(const u32x4*)(U + UC_GV + h * 64 + dq * 16); in.v1 = *(const u32x4*)(U + UC_GV + h * 64 + dq * 16 + 8);
}
template <bool NEEDQ>
__device__ __forceinline__ void gla_sub_prep(Frame& F, int dir, const GlaIn& in, LAS unsigned char* wl, float (&ltot)[8]) {
    int lane_o = F.lane; asm volatile("" : "+v"(lane_o));
    const int tau = lane_o & 15, dq = lane_o >> 4;
    const LAS float* gw = (const LAS float*)(wl + GL_GW) + dq * 8; const LAS float* gb = (const LAS float*)(wl + GL_GB) + dq * 8;
    const f32x4* ag = in.ag;
    float x[8];
    { const f32x4 b0 = *(const LAS f32x4*)gb, b1 = *(const LAS f32x4*)(gb + 4); x[0] = b0[0]; x[1] = b0[1]; x[2] = b0[2]; x[3] = b0[3]; x[4] = b1[0]; x[5] = b1[1]; x[6] = b1[2]; x[7] = b1[3]; }
#pragma unroll
    for (int r4 = 0; r4 < 4; ++r4) { const f32x4 av = ag[r4];
#pragma unroll
        for (int rr = 0; rr < 4; ++rr) { const f32x4 w0 = *(const LAS f32x4*)(gw + (4 * r4 + rr) * 32), w1 = *(const LAS f32x4*)(gw + (4 * r4 + rr) * 32 + 4);
            x[0] += av[rr] * w0[0]; x[1] += av[rr] * w0[1]; x[2] += av[rr] * w0[2]; x[3] += av[rr] * w0[3]; x[4] += av[rr] * w1[0]; x[5] += av[rr] * w1[1]; x[6] += av[rr] * w1[2]; x[7] += av[rr] * w1[3]; } }
#pragma unroll
    for (int j = 0; j < 8; ++j) x[j] = (fminf(x[j], 0.f) - __logf(1.f + __expf(-fabsf(x[j])))) * (1.f / 16.f);
#pragma unroll
    for (int dl = 1; dl < 16; dl <<= 1) { const int src = dir == 0 ? F.lane - dl : F.lane + dl; const bool ok = dir == 0 ? (tau >= dl) : (tau + dl <= 15);
#pragma unroll
        for (int j = 0; j < 8; ++j) { const float y = __shfl(x[j], src); x[j] += ok ? y : 0.f; } }
    float tot[8];
#pragma unroll
    for (int j = 0; j < 8; ++j) { tot[j] = __shfl(x[j], (lane_o & 48) + (dir == 0 ? 15 : 0)); ltot[j] += tot[j]; }
    const u32x4 kv = in.kv;
    const float kf[8] = {bflo(kv.x), bfhi(kv.x), bflo(kv.y), bfhi(kv.y), bflo(kv.z), bfhi(kv.z), bflo(kv.w), bfhi(kv.w)};
    float kt[8], kh[8];
#pragma unroll
    for (int j = 0; j < 8; ++j) { kt[j] = kf[j] * __expf(-x[j]); kh[j] = kf[j] * __expf(tot[j] - x[j]); }
    { u32x4 w; w.x = pk2(kt[0], kt[1]); w.y = pk2(kt[2], kt[3]); w.z = pk2(kt[4], kt[5]); w.w = pk2(kt[6], kt[7]); *(LAS u32x4*)(wl + GL_KT + (tau * 40 + dq * 8) * 2) = w; }
#pragma unroll
    for (int j = 0; j < 8; ++j) *(LAS unsigned short*)(wl + GL_KHT + ((dq * 8 + j) * 24 + tau) * 2) = (unsigned short)f2bf(kh[j]);
    if (NEEDQ) { const u32x4 qv = in.qv; const float sc = 0.17677669529663687f;
        const float qf[8] = {bflo(qv.x), bfhi(qv.x), bflo(qv.y), bfhi(qv.y), bflo(qv.z), bfhi(qv.z), bflo(qv.w), bfhi(qv.w)}; float qt[8];
#pragma unroll
        for (int j = 0; j < 8; ++j) qt[j] = qf[j] * sc * __expf(x[j]);
        u32x4 w; w.x = pk2(qt[0], qt[1]); w.y = pk2(qt[2], qt[3]); w.z = pk2(qt[4], qt[5]); w.w = pk2(qt[6], qt[7]); *(LAS u32x4*)(wl + GL_QT + (tau * 40 + dq * 8) * 2) = w; }
    if (tau == 0) {
#pragma unroll
        for (int j = 0; j < 8; ++j) ((LAS float*)(wl + GL_G))[dq * 8 + j] = __expf(tot[j]); }
    { const u32x4 v0 = in.v0, v1 = in.v1;
      const unsigned vw[8] = {v0.x, v0.y, v0.z, v0.w, v1.x, v1.y, v1.z, v1.w};
#pragma unroll
      for (int j = 0; j < 8; ++j) { *(LAS unsigned short*)(wl + GL_VT + ((dq * 16 + 2 * j) * 24 + tau) * 2) = (unsigned short)(vw[j] & 0xffffu); *(LAS unsigned short*)(wl + GL_VT + ((dq * 16 + 2 * j + 1) * 24 + tau) * 2) = (unsigned short)(vw[j] >> 16); } }
}
__device__ __forceinline__ void gla_state_update(Frame& F, LAS unsigned char* wl, f32x4 (&Sr)[2][4]) {
    int lane_o = F.lane; asm volatile("" : "+v"(lane_o));
    const int r16 = lane_o & 15, kg = lane_o >> 4; const bf16x8 zf = {0, 0, 0, 0, 0, 0, 0, 0};
    bf16x8 vb[4];
#pragma unroll
    for (int nb = 0; nb < 4; ++nb) { vb[nb] = *(const LAS bf16x8*)(wl + GL_VT + ((16 * nb + r16) * 24 + 8 * (kg & 1)) * 2); if (kg >= 2) vb[nb] = zf; }
#pragma unroll
    for (int db = 0; db < 2; ++db) { const f32x4 gv = *(const LAS f32x4*)(wl + GL_G + (16 * db + 4 * kg) * 4);
        bf16x8 ka = *(const LAS bf16x8*)(wl + GL_KHT + ((16 * db + r16) * 24 + 8 * (kg & 1)) * 2); if (kg >= 2) ka = zf;
#pragma unroll
        for (int nb = 0; nb < 4; ++nb) Sr[db][nb] = MFMA16(ka, vb[nb], Sr[db][nb] * gv); }
}
constexpr int GGRP = 6, NGRP = NCH / GGRP;
constexpr size_t WS_GGS = WS_GSS, WS_GGA = WS_GSS + 8 * MiB;
__device__ __forceinline__ void gla_pass_a(KP Pk, Frame& F, int l, int it, LAS unsigned char* wl) {
    unsigned char* ws = F.ws;
    const int seq = it / NGRP, g = it % NGRP, dir = seq & 1, h = (seq >> 1) & 7, b = seq >> 4, r16 = F.lane & 15, kg = F.lane >> 4;
    gla_load_gates(Pk, F, l, h, dir, wl);
    f32x4 Sr[2][4];
#pragma unroll
    for (int db = 0; db < 2; ++db)
#pragma unroll
        for (int nb = 0; nb < 4; ++nb) Sr[db][nb] = (f32x4){0.f, 0.f, 0.f, 0.f};
    float ltot[8] = {0.f, 0.f, 0.f, 0.f, 0.f, 0.f, 0.f, 0.f};
    GlaIn nin;
    { const int c0 = g * GGRP; gla_sub_load<false>(F, b, h, dir, (dir == 0 ? 64 * c0 : gla_kidx(1, 64 * c0) - 63) + 16 * (dir == 0 ? 0 : 3), nin); }
#pragma unroll 1
    for (int cg = 0; cg <= GGRP; ++cg) {
        const int c = g * GGRP + cg;
        float* sl = cg < GGRP ? (float*)(ws + WS_GSL) + ((size_t)seq * NCH + c) * 2048 : (float*)(ws + WS_GGS) + ((size_t)seq * NGRP + g) * 2048;
        float* al = cg < GGRP ? (float*)(ws + WS_GAE) + ((size_t)seq * NCH + c) * 32 : (float*)(ws + WS_GGA) + ((size_t)seq * NGRP + g) * 32;
#pragma unroll
        for (int db = 0; db < 2; ++db)
#pragma unroll
            for (int nb = 0; nb < 4; ++nb)
#pragma unroll
                for (int i = 0; i < 4; ++i) sl[(16 * db + 4 * kg + i) * 64 + 16 * nb + r16] = Sr[db][nb][i];
        if ((F.lane & 15) == 0) {
#pragma unroll
            for (int j = 0; j < 8; ++j) al[kg * 8 + j] = __expf(ltot[j]); }
        if (cg == GGRP) break;
#pragma unroll 1
        for (int st = 0; st < 4; ++st) {
            const GlaIn cur = nin;
            { const int q2 = cg * 4 + st + 1, c2 = g * GGRP + (q2 >> 2), st2 = q2 & 3, sb2 = dir == 0 ? st2 : 3 - st2;
              if (q2 < 4 * GGRP) gla_sub_load<false>(F, b, h, dir, (dir == 0 ? 64 * c2 : gla_kidx(1, 64 * c2) - 63) + 16 * sb2, nin); }
            gla_sub_prep<false>(F, dir, cur, wl, ltot);
            gla_state_update(F, wl, Sr); }
    }
}
__device__ __forceinline__ void gla_pass_b(KP Pk, Frame& F, int l, int b, int h, int c, LAS unsigned char* wl) {
    unsigned char* ws = F.ws;
    const int r16 = F.lane & 15, kg = F.lane >> 4, seq = (b * 8 + h) * 2; const bf16x8 zf = {0, 0, 0, 0, 0, 0, 0, 0};
    const bf16_t* U = (const bf16_t*)(ws + WS_U); unsigned char* MIX = ws + WS_H;
    u32x2 of[4][4];
#pragma unroll 1
    for (int dir = 0; dir < 2; ++dir) {
        gla_load_gates(Pk, F, l, h, dir, wl);
        const int cc = dir == 0 ? c : (c < 4 ? 3 - c : 39 - c);
        f32x4 Sr[2][4];
#pragma unroll
        for (int db = 0; db < 2; ++db)
#pragma unroll
            for (int nb = 0; nb < 4; ++nb) Sr[db][nb] = (f32x4){0.f, 0.f, 0.f, 0.f};
        { const int gsel = cc / GGRP;
#pragma unroll 1
          for (int gp = 0; gp <= gsel; ++gp) {
            const bool fin = gp == gsel;
            const float* sp = fin ? (const float*)(ws + WS_GSL) + ((size_t)(seq + dir) * NCH + cc) * 2048 : (const float*)(ws + WS_GGS) + ((size_t)(seq + dir) * NGRP + gp) * 2048;
            const float* apx = fin ? (const float*)(ws + WS_GAE) + ((size_t)(seq + dir) * NCH + cc) * 32 : (const float*)(ws + WS_GGA) + ((size_t)(seq + dir) * NGRP + gp) * 32;
#pragma unroll
            for (int db = 0; db < 2; ++db) { const f32x4 av = *(const f32x4*)(apx + 16 * db + 4 * kg);
#pragma unroll
                for (int nb = 0; nb < 4; ++nb)
#pragma unroll
                    for (int i = 0; i < 4; ++i) Sr[db][nb][i] = av[i] * Sr[db][nb][i] + sp[(16 * db + 4 * kg + i) * 64 + 16 * nb + r16]; } } }
        float ltot[8] = {0.f, 0.f, 0.f, 0.f, 0.f, 0.f, 0.f, 0.f};
#pragma unroll 1
        for (int st = 0; st < 4; ++st) { const int sb = dir == 0 ? st : 3 - st;
            int lane_o = F.lane; asm volatile("" : "+v"(lane_o)); const int r16 = lane_o & 15, kg = lane_o >> 4;
#pragma unroll
            for (int db = 0; db < 2; ++db)
#pragma unroll
                for (int nb = 0; nb < 4; ++nb) { u32x2 w; w.x = pk2(Sr[db][nb][0], Sr[db][nb][1]); w.y = pk2(Sr[db][nb][2], Sr[db][nb][3]); *(LAS u32x2*)(wl + GL_ST + ((16 * nb + r16) * 40 + 16 * db + 4 * kg) * 2) = w; }
            { GlaIn in; gla_sub_load<true>(F, b, h, dir, 64 * c + 16 * sb, in); gla_sub_prep<true>(F, dir, in, wl, ltot); }
            const bf16x8 bq = *(const LAS bf16x8*)(wl + GL_QT + (r16 * 40 + 8 * kg) * 2);
            { const bf16x8 ka = *(const LAS bf16x8*)(wl + GL_KT + (r16 * 40 + 8 * kg) * 2);
              f32x4 p = MFMA16(ka, bq, ((f32x4){0.f, 0.f, 0.f, 0.f}));
#pragma unroll
              for (int i = 0; i < 4; ++i) { const int sidx = 4 * kg + i; const bool keep = dir == 0 ? (sidx <= r16) : (sidx >= r16); p[i] = keep ? p[i] : 0.f; }
              u32x2 w; w.x = pk2(p[0], p[1]); w.y = pk2(p[2], p[3]); *(LAS u32x2*)(wl + GL_PT + (r16 * 24 + 4 * kg) * 2) = w; }
            bf16x8 pb = *(const LAS bf16x8*)(wl + GL_PT + (r16 * 24 + 8 * (kg & 1)) * 2); if (kg >= 2) pb = zf;
            f32x4 o[4];
#pragma unroll
            for (int nb = 0; nb < 4; ++nb) { const bf16x8 sa = *(const LAS bf16x8*)(wl + GL_ST + ((16 * nb + r16) * 40 + 8 * kg) * 2);
                bf16x8 va = *(const LAS bf16x8*)(wl + GL_VT + ((16 * nb + r16) * 24 + 8 * (kg & 1)) * 2); if (kg >= 2) va = zf;
                o[nb] = MFMA16(sa, bq, ((f32x4){0.f, 0.f, 0.f, 0.f})); o[nb] = MFMA16(va, pb, o[nb]); }
            if (dir == 0) { u32x2 t[4];
#pragma unroll
                for (int nb = 0; nb < 4; ++nb) { t[nb].x = pk2(o[nb][0], o[nb][1]); t[nb].y = pk2(o[nb][2], o[nb][3]); }
#define OF_PUT(k) { _Pragma("unroll") for (int nb = 0; nb < 4; ++nb) of[k][nb] = t[nb]; }
                if (sb == 0) OF_PUT(0) else if (sb == 1) OF_PUT(1) else if (sb == 2) OF_PUT(2) else OF_PUT(3)
#undef OF_PUT
            }
            else { float ss = 0.f; u32x2 t[4];
#define OF_GET(k) { _Pragma("unroll") for (int nb = 0; nb < 4; ++nb) t[nb] = of[k][nb]; }
                if (sb == 0) OF_GET(0) else if (sb == 1) OF_GET(1) else if (sb == 2) OF_GET(2) else OF_GET(3)
#undef OF_GET
#pragma unroll
                for (int nb = 0; nb < 4; ++nb) { o[nb][0] += bflo(t[nb].x); o[nb][1] += bfhi(t[nb].x); o[nb][2] += bflo(t[nb].y); o[nb][3] += bfhi(t[nb].y); ss += (o[nb][0] * o[nb][0] + o[nb][1] * o[nb][1]) + (o[nb][2] * o[nb][2] + o[nb][3] * o[nb][3]); }
                ss += __shfl_xor(ss, 16); ss += __shfl_xor(ss, 32);
                const float rstd = rsqrtf(ss * (1.f / 64.f) + NORM_EPS); const int row = keyrow(b, 64 * c + 16 * sb + r16);
#pragma unroll
                for (int nb = 0; nb < 4; ++nb) { const int dv0 = 16 * nb + 4 * kg; const u32x2 gg = *(const u32x2*)(U + (size_t)row * NU + UC_GG + h * 64 + dv0); const f32x4 nw = *(const f32x4*)(Pk->in[I_GNW] + l * 64 + dv0);
                    const float y0 = o[nb][0] * rstd * nw[0] * silu_f(bflo(gg.x)), y1 = o[nb][1] * rstd * nw[1] * silu_f(bfhi(gg.x)), y2 = o[nb][2] * rstd * nw[2] * silu_f(bflo(gg.y)), y3 = o[nb][3] * rstd * nw[3] * silu_f(bfhi(gg.y));
                    if (WOUT_F8) *(unsigned*)(MIX + ((size_t)row * D + h * 64 + dv0)) = pk4_f8(y0, y1, y2, y3);
                    else { u32x2 w; w.x = pk2(y0, y1); w.y = pk2(y2, y3); *(u32x2*)(MIX + ((size_t)row * D + h * 64 + dv0) * 2) = w; } } }
            if (st < 3) gla_state_update(F, wl, Sr);
        }
    }
}
__device__ __forceinline__ float dpp_x1(float v) { return __builtin_bit_cast(float, __builtin_amdgcn_update_dpp(0, __builtin_bit_cast(int, v), 0xB1, 0xF, 0xF, true)); }
__device__ __forceinline__ float dpp_x2(float v) { return __builtin_bit_cast(float, __builtin_amdgcn_update_dpp(0, __builtin_bit_cast(int, v), 0x4E, 0xF, 0xF, true)); }
__device__ __forceinline__ float dpp_hm(float v) { return __builtin_bit_cast(float, __builtin_amdgcn_update_dpp(0, __builtin_bit_cast(int, v), 0x141, 0xF, 0xF, true)); }
__device__ __forceinline__ void qk_vec(bf16_t* p, const float (&w)[8], const float (&cs)[8], const float (&sn)[8]) {
    const u32x4 r = *(const u32x4*)p;
    float x[8] = {bflo(r.x), bfhi(r.x), bflo(r.y), bfhi(r.y), bflo(r.z), bfhi(r.z), bflo(r.w), bfhi(r.w)};
    float ss = 0.f;
#pragma unroll
    for (int e = 0; e < 8; ++e) ss += x[e] * x[e];
    ss += dpp_x1(ss); ss += dpp_x2(ss); ss += dpp_hm(ss);
    const float rstd = rsqrtf(ss * (1.f / 64.f) + NORM_EPS);
    float o[8];
#pragma unroll
    for (int e = 0; e < 8; ++e) { const float y = x[e] * rstd * w[e]; o[e] = y * cs[e] + dpp_x2(y) * sn[e]; }
    u32x4 q; q.x = pk2(o[0], o[1]); q.y = pk2(o[2], o[3]); q.z = pk2(o[4], o[5]); q.w = pk2(o[6], o[7]);
    *(u32x4*)p = q;
}
__device__ __forceinline__ void qk_rope(const unsigned char* ws, int row, int j, float (&cs)[8], float (&sn)[8]) {
    if (row < TL) { const float* rp = (const float*)(ws + WS_ROPE) + (size_t)(row & (SEQ - 1)) * 64 + 32 * (j >> 2) + 8 * (j & 1);
        const f32x4 c0 = *(const f32x4*)rp, c1 = *(const f32x4*)(rp + 4), s0 = *(const f32x4*)(rp + 16), s1 = *(const f32x4*)(rp + 20); const float sg = (j & 2) ? 1.f : -1.f;
#pragma unroll
        for (int e = 0; e < 4; ++e) { cs[e] = c0[e]; cs[4 + e] = c1[e]; sn[e] = sg * s0[e]; sn[4 + e] = sg * s1[e]; } }
    else {
#pragma unroll
        for (int e = 0; e < 8; ++e) { cs[e] = 1.f; sn[e] = 0.f; } }
}
__device__ __forceinline__ void prep_qk_rows4(KP Pk, Frame& F, int l, int row0) {
    unsigned char* ws = F.ws;
    bf16_t* U = (bf16_t*)(ws + WS_U);
    const int j = F.lane & 7; const float qs = 0.125f * LOG2E;
    float wsq[8], wdq[8], wdk[8], wsk[8];
    { const float* a = Pk->in[I_SQN] + l * 64 + 8 * j; const float* b = Pk->in[I_DQN] + l * 64 + 8 * j; const float* c = Pk->in[I_DKN] + l * 64 + 8 * j; const float* d = Pk->in[I_SKN] + l * 64 + 8 * j;
#pragma unroll
      for (int e = 0; e < 8; ++e) { wsq[e] = a[e] * qs; wdq[e] = b[e] * qs; wdk[e] = c[e]; wsk[e] = d[e]; } }
#pragma unroll 1
    for (int r = 0; r < 4; ++r) { const int row = row0 + r; float cs[8], sn[8];
        qk_rope(ws, row, j, cs, sn);
        bf16_t* up = U + (size_t)row * NU + 8 * F.lane;
        qk_vec(up + UC_SQ, wsq, cs, sn); qk_vec(up + UC_DQ, wdq, cs, sn); qk_vec(up + UC_DK, wdk, cs, sn); }
    { const int row = row0 + (F.lane >> 4); float cs[8], sn[8];
      qk_rope(ws, row, j, cs, sn);
      qk_vec(U + (size_t)row * NU + UC_SK + 8 * (F.lane & 15), wsk, cs, sn); }
}
template <bool PERMK, int NCOLS, class SRC>
__device__ __forceinline__ void tile_transpose(LAS unsigned char* wl, int lane, bf16_t* dst, size_t dst_stride, const SRC& src) {
    LAS unsigned* tl = (LAS unsigned*)wl;
    constexpr int ncols = NCOLS, cpr = NCOLS / 8;
    LDS_WAIT(); asm volatile("" ::: "memory");
#pragma unroll 1
    for (int k0 = 0; k0 < cpr; k0 += 4) { u32x4 v[4];
#pragma unroll
      for (int k = 0; k < 4; ++k) { const int id = lane + 64 * (k0 + k); v[k] = src(id / cpr, id % cpr); }
#pragma unroll
      for (int k = 0; k < 4; ++k) { const int id = lane + 64 * (k0 + k); LAS unsigned* p = tl + (id / cpr) * 65 + (id % cpr) * 4; p[0] = v[k].x; p[1] = v[k].y; p[2] = v[k].z; p[3] = v[k].w; } }
    LDS_WAIT(); asm volatile("" ::: "memory");
    const LAS unsigned short* ts = (const LAS unsigned short*)wl;
    const int cc = lane & 7;
    for (int dv = lane >> 3; dv < ncols; dv += 8) {
        unsigned short e[8];
#pragma unroll
        for (int i = 0; i < 8; ++i) { const int p = 8 * cc + i, srow = PERMK ? ((p & ~15) + perm16(p & 15)) : p; e[i] = ts[srow * 130 + dv]; }
        u32x4 o; o.x = e[0] | ((unsigned)e[1] << 16); o.y = e[2] | ((unsigned)e[3] << 16); o.z = e[4] | ((unsigned)e[5] << 16); o.w = e[6] | ((unsigned)e[7] << 16);
        *(u32x4*)(dst + (size_t)dv * dst_stride + 8 * cc) = o; }
}
__device__ __forceinline__ void ph_prep(KP Pk, Frame& F, int l, int rep) {
    unsigned char* ws = F.ws;
    const int gw = F.vcu * NWAVES + F.wave, NGW = F.G * NWAVES;
    LAS unsigned char* wl = F.lds + F.wave * WAVE_LDS;
    const bf16_t* U = (const bf16_t*)(ws + WS_U);
    const int n_gla = 128 * NGRP, n_hy = NB * (l == 0 ? 36 : 32) * 12, n_vd = NB * 4 * 36, n_vs = NB * 2 * 36, n_rows = rep ? 0 : TT / 4;
    if (gw < n_gla) { gla_pass_a(Pk, F, l, gw, wl); }
    const int total = n_hy + n_vd + n_vs + n_rows, nrest = NGW - n_gla;
    for (int it0 = gw - n_gla; it0 < total && gw >= n_gla; it0 += nrest) {
        int it = it0;
        if (it < n_hy) {
            const int ntile = l == 0 ? 36 : 32, b = it / (ntile * 12), r = it % (ntile * 12), tile = r / 12, cb = r % 12, c0 = cb * 128;
            const bool lat = tile < 32; const int p0 = lat ? 64 * tile : 64 * (tile - 32), Ls = lat ? SEQ : LC, rbase = lat ? b * SEQ : TL + b * LC;
            const float* cw = Pk->in[I_HCW] + (size_t)l * 3 * 1536 + c0 + (F.lane & 15) * 8; const float* cbias = Pk->in[I_HCB] + (size_t)l * 1536 + c0 + (F.lane & 15) * 8;
            float w0[8], w1[8], w2[8], wb[8];
#pragma unroll
            for (int k = 0; k < 8; ++k) { w0[k] = cw[k]; w1[k] = cw[1536 + k]; w2[k] = cw[3072 + k]; wb[k] = cbias[k]; }
            auto src = [&](int i, int ch) -> u32x4 { const int p = p0 + i; const bf16_t* up = U + (size_t)(rbase + p) * NU + UC_HY + c0 + ch * 8;
                const u32x4 m = *(const u32x4*)up; u32x4 a = {0u, 0u, 0u, 0u}, c = {0u, 0u, 0u, 0u};
                if (p > 0) a = *(const u32x4*)(up - NU); if (p + 1 < Ls) c = *(const u32x4*)(up + NU);
                const unsigned av[4] = {a.x, a.y, a.z, a.w}, mv[4] = {m.x, m.y, m.z, m.w}, cv[4] = {c.x, c.y, c.z, c.w}; unsigned o[4];
#pragma unroll
                for (int q = 0; q < 4; ++q) { const int k = 2 * q;
                    const float z0 = bflo(av[q]) * w0[k] + bflo(mv[q]) * w1[k] + bflo(cv[q]) * w2[k] + wb[k];
                    const float z1 = bfhi(av[q]) * w0[k + 1] + bfhi(mv[q]) * w1[k + 1] + bfhi(cv[q]) * w2[k + 1] + wb[k + 1];
                    o[q] = pk2(z0, z1); }
                return (u32x4){o[0], o[1], o[2], o[3]}; };
            tile_transpose<false, 128>(wl, F.lane, (bf16_t*)(ws + WS_ZT) + ((size_t)b * 1536 + c0) * KEYS + (lat ? p0 : SEQ + p0), KEYS, src);
            continue; } it -= n_hy;
        if (it < n_vd) {
            const int b = it / 144, r = it % 144, h = r / 36, tile = r % 36;
            auto src = [&](int i, int ch) -> u32x4 { return *(const u32x4*)(U + (size_t)keyrow(b, 64 * tile + i) * NU + UC_DV + h * 128 + ch * 8); };
            tile_transpose<true, 128>(wl, F.lane, (bf16_t*)(ws + WS_VTD) + ((size_t)(b * 4 + h) * 128) * KEYS + 64 * tile, KEYS, src);
            continue; } it -= n_vd;
        if (it < n_vs) {
            const int b = it / 72, r = it % 72, h = r / 36, tile = r % 36;
            auto src = [&](int i, int ch) -> u32x4 { return *(const u32x4*)(U + (size_t)keyrow(b, 64 * tile + i) * NU + UC_SV + h * 64 + ch * 8); };
            tile_transpose<true, 64>(wl, F.lane, (bf16_t*)(ws + WS_VTS) + ((size_t)(b * 2 + h) * 64) * KEYS + 64 * tile, KEYS, src);
            continue; } it -= n_vs;
        prep_qk_rows4(Pk, F, l, it * 4);
    }
}
__device__ __forceinline__ void ph_gla_scan(Frame& F) {
    unsigned char* ws = F.ws;
    const int gw = F.vcu * NWAVES + F.wave, NGW = F.G * NWAVES;
    for (int it = gw; it < 128 * 32; it += NGW) { const int seq = it >> 5, d = it & 31;
        const float* sl = (const float*)(ws + WS_GSL) + (size_t)seq * NCH * 2048 + d * 64 + F.lane; float* ss = (float*)(ws + WS_GSS) + (size_t)seq * NCH * 2048 + d * 64 + F.lane;
        const float* ae = (const float*)(ws + WS_GAE) + (size_t)seq * NCH * 32 + d;
        float x[NCH], a[NCH];
#pragma unroll
        for (int c = 0; c < NCH; ++c) { x[c] = sl[(size_t)c * 2048]; a[c] = ae[c * 32]; }
        float S = 0.f;
#pragma unroll
        for (int c = 0; c < NCH; ++c) { ss[(size_t)c * 2048] = S; S = a[c] * S + x[c]; }
    }
}

__device__ __forceinline__ int crow(int r, int hi) { return (r & 3) + 8 * (r >> 2) + 4 * hi; }
template <int KW, int DV, bool MASK>
__device__ __forceinline__ void attn_core(Frame& F, const bf16_t* U, int b, int kcol0, const bf16_t* VT, int nctx, int nloc, int loc0,
                                          const bf16x8 (&q)[4], int koff, int qpos0, float sh2, f32x16 (&O)[DV / 32], float& lsum) {
    constexpr int KRB = KW * 2, KB = 64 * KRB, VB = DV * 128, SLOT = KB + VB, NKC = KB / 8192, NVC = VB / 8192, NDMA = NKC + NVC;
    const int r32 = F.lane & 31, hi = F.lane >> 5, nt = nctx + nloc;
#define ATT_DMA(ti) do { const int _k0 = (ti) < nctx ? 64 * (ti) : loc0 + 64 * ((ti) - nctx); LAS unsigned char* _sl = F.lds + ((ti) & 3) * SLOT; \
        _Pragma("unroll") for (int _j = 0; _j < NKC; ++_j) { const int _ch = F.wave + 8 * _j; int _row, _c; \
            if (KW == 128) { _row = 4 * _ch + (F.lane >> 4); _c = (F.lane & 15) ^ (_row & 15); } else { _row = 8 * _ch + (F.lane >> 3); _c = (F.lane & 7) ^ ((_row >> 1) & 7); } \
            __builtin_amdgcn_global_load_lds((const unsigned*)(U + (size_t)keyrow(b, _k0 + _row) * NU + kcol0 + _c * 8), (LAS unsigned*)(_sl + _ch * 1024), 16, 0, 0); } \
        _Pragma("unroll") for (int _j = 0; _j < NVC; ++_j) { const int _ch = F.wave + 8 * _j, _row = 8 * _ch + (F.lane >> 3), _c = (F.lane & 7) ^ ((_row >> 1) & 7); \
            __builtin_amdgcn_global_load_lds((const unsigned*)(VT + (size_t)_row * KEYS + _k0 + _c * 8), (LAS unsigned*)(_sl + KB + _ch * 1024), 16, 0, 0); } } while (0)
    f32x16 s0, s1; bf16x8 pa[4];
#define DSR(dst, addr, off) asm volatile("ds_read_b128 %0, %1 offset:%2" : "=v"(dst) : "v"(addr), "n"(off))
#define LWAIT4(f) asm volatile("s_waitcnt lgkmcnt(0)" : "+v"(f[0]), "+v"(f[1]), "+v"(f[2]), "+v"(f[3]))
    unsigned kad[4], vad[4];
#pragma unroll
    for (int i = 0; i < 4; ++i) { const int c = 2 * i + hi;
        kad[i] = (unsigned)(uintptr_t)F.lds + (KW == 128 ? r32 * 256 + ((((koff >> 3) + c) ^ (r32 & 15)) << 4) : r32 * 128 + ((c ^ ((r32 >> 1) & 7)) << 4));
        vad[i] = (unsigned)(uintptr_t)F.lds + KB + r32 * 128 + ((c ^ ((r32 >> 1) & 7)) << 4); }
    __syncthreads();
    ATT_DMA(0);
    if (nt > 1) ATT_DMA(1);
    if (nt > 2) ATT_DMA(2);
    if (nt > 2) asm volatile("s_waitcnt vmcnt(%0)" :: "n"(NDMA) : "memory"); else asm volatile("s_waitcnt vmcnt(0)" ::: "memory");
    __syncthreads();
#define EXP1(ti, r) do { s0[r] = __builtin_amdgcn_exp2f(s0[r]); s1[r] = __builtin_amdgcn_exp2f(s1[r]); \
        if (MASK && (ti) >= nctx) { const int k0 = loc0 - LC + 64 * ((ti) - nctx) + crow(r, hi), k1 = k0 + 32, d0 = qpos0 + r32 - k0, d1 = d0 - 32; \
            if (k0 < 0 || k0 >= SEQ || d0 > 128 || d0 < -128) s0[r] = 0.f; if (k1 < 0 || k1 >= SEQ || d1 > 128 || d1 < -128) s1[r] = 0.f; } } while (0)
#define RD_K(f, h) do { DSR(f[0], ka[2 * (h)], 0); DSR(f[1], ka[2 * (h)], 32 * KRB); DSR(f[2], ka[2 * (h) + 1], 0); DSR(f[3], ka[2 * (h) + 1], 32 * KRB); } while (0)
#define RD_V(f, nb) do { DSR(f[0], va[0], (nb) * 4096); DSR(f[1], va[1], (nb) * 4096); DSR(f[2], va[2], (nb) * 4096); DSR(f[3], va[3], (nb) * 4096); } while (0)
#define SB() __builtin_amdgcn_sched_barrier(0)
#define PKW(S, B) pg8::cvt_pk_bf16(S[B], S[(B) + 1])
#define PV1(f, nb, kk, ti, R0, NE) do { O[nb] = MFMA32(pa[kk], f[kk], O[nb]); if (more) { _Pragma("unroll") for (int _r = 0; _r < (NE); ++_r) EXP1(ti, (R0) + _r); } SB(); } while (0)
    {
        bf16x8 fa[4], fb[4]; unsigned ka[4];
#pragma unroll
        for (int i = 0; i < 4; ++i) ka[i] = kad[i];
        RD_K(fa, 0); RD_K(fb, 1);
#pragma unroll
        for (int r = 0; r < 16; ++r) { s0[r] = -sh2; s1[r] = -sh2; }
        LWAIT4(fa); LWAIT4(fb);
        s0 = MFMA32(fa[0], q[0], s0); s1 = MFMA32(fa[1], q[0], s1); s0 = MFMA32(fa[2], q[1], s0); s1 = MFMA32(fa[3], q[1], s1);
        s0 = MFMA32(fb[0], q[2], s0); s1 = MFMA32(fb[1], q[2], s1); s0 = MFMA32(fb[2], q[3], s0); s1 = MFMA32(fb[3], q[3], s1);
#pragma unroll
        for (int r = 0; r < 16; ++r) EXP1(0, r);
    }
#define ATT_STEP(MORE) { \
        constexpr bool more = (MORE); \
        if (t + 3 < nt) ATT_DMA(t + 3); \
        unsigned ka[4], va[4]; \
        { int lo_ = F.lane; asm volatile("" : "+v"(lo_)); const int rr = lo_ & 31, hh = lo_ >> 5; \
        _Pragma("unroll") \
          for (int i = 0; i < 4; ++i) { const int c = 2 * i + hh; \
            ka[i] = (unsigned)(uintptr_t)F.lds + ((t + 1) & 3) * SLOT + (KW == 128 ? rr * 256 + ((((koff >> 3) + c) ^ (rr & 15)) << 4) : rr * 128 + ((c ^ ((rr >> 1) & 7)) << 4)); \
            va[i] = (unsigned)(uintptr_t)F.lds + (t & 3) * SLOT + KB + rr * 128 + ((c ^ ((rr >> 1) & 7)) << 4); } } \
        bf16x8 fa[4], fb[4]; \
        if (more) { RD_K(fa, 0); RD_K(fb, 1); } else { RD_V(fa, 0); } \
        SB(); \
 \
        { float ps = 0.f; \
        _Pragma("unroll") \
          for (int r = 0; r < 16; ++r) ps += s0[r] + s1[r]; \
          lsum += ps; \
          u32x4 w; \
          w.x = PKW(s0, 0); w.y = PKW(s0, 2); w.z = PKW(s0, 4); w.w = PKW(s0, 6); pa[0] = __builtin_bit_cast(bf16x8, w); \
          w.x = PKW(s0, 8); w.y = PKW(s0, 10); w.z = PKW(s0, 12); w.w = PKW(s0, 14); pa[1] = __builtin_bit_cast(bf16x8, w); \
          w.x = PKW(s1, 0); w.y = PKW(s1, 2); w.z = PKW(s1, 4); w.w = PKW(s1, 6); pa[2] = __builtin_bit_cast(bf16x8, w); \
          w.x = PKW(s1, 8); w.y = PKW(s1, 10); w.z = PKW(s1, 12); w.w = PKW(s1, 14); pa[3] = __builtin_bit_cast(bf16x8, w); } \
        if (more) { \
        _Pragma("unroll") \
            for (int r = 0; r < 16; ++r) { s0[r] = -sh2; s1[r] = -sh2; } \
        } \
        SB(); \
        if (more) { \
            LWAIT4(fa); LWAIT4(fb); \
            s0 = MFMA32(fa[0], q[0], s0); s1 = MFMA32(fa[1], q[0], s1); s0 = MFMA32(fa[2], q[1], s0); s1 = MFMA32(fa[3], q[1], s1); \
            SB(); RD_V(fa, 0); SB(); \
            s0 = MFMA32(fb[0], q[2], s0); s1 = MFMA32(fb[1], q[2], s1); s0 = MFMA32(fb[2], q[3], s0); s1 = MFMA32(fb[3], q[3], s1); \
            SB(); \
        } \
        LWAIT4(fa); RD_V(fb, 1); SB(); \
        if (DV == 128) { \
            PV1(fa, 0, 0, t + 1, 0, 1); PV1(fa, 0, 1, t + 1, 1, 1); PV1(fa, 0, 2, t + 1, 2, 1); PV1(fa, 0, 3, t + 1, 3, 1); \
            LWAIT4(fb); RD_V(fa, 2); SB(); \
            PV1(fb, 1, 0, t + 1, 4, 1); PV1(fb, 1, 1, t + 1, 5, 1); PV1(fb, 1, 2, t + 1, 6, 1); PV1(fb, 1, 3, t + 1, 7, 1); \
            LWAIT4(fa); RD_V(fb, 3); SB(); \
            PV1(fa, 2, 0, t + 1, 8, 1); PV1(fa, 2, 1, t + 1, 9, 1); PV1(fa, 2, 2, t + 1, 10, 1); PV1(fa, 2, 3, t + 1, 11, 1); \
            LWAIT4(fb); SB(); \
            PV1(fb, 3, 0, t + 1, 12, 1); PV1(fb, 3, 1, t + 1, 13, 1); PV1(fb, 3, 2, t + 1, 14, 1); PV1(fb, 3, 3, t + 1, 15, 1); \
        } else { \
            PV1(fa, 0, 0, t + 1, 0, 2); PV1(fa, 0, 1, t + 1, 2, 2); PV1(fa, 0, 2, t + 1, 4, 2); PV1(fa, 0, 3, t + 1, 6, 2); \
            LWAIT4(fb); SB(); \
            PV1(fb, 1, 0, t + 1, 8, 2); PV1(fb, 1, 1, t + 1, 10, 2); PV1(fb, 1, 2, t + 1, 12, 2); PV1(fb, 1, 3, t + 1, 14, 2); \
        } \
        if (t + 3 < nt) asm volatile("s_waitcnt vmcnt(%0)" :: "n"(NDMA) : "memory"); else asm volatile("s_waitcnt vmcnt(0)" ::: "memory"); \
        __syncthreads(); \
    }
    int t = 0;
#pragma unroll 1
    for (; t + 1 < nt; ++t) ATT_STEP(true)
    ATT_STEP(false)
#undef ATT_STEP
#undef EXP1
#undef SB
#undef PKW
#undef PV1
#undef RD_K
#undef RD_V
#undef DSR
#undef LWAIT4
#undef ATT_DMA
}
__device__ __forceinline__ float score_bound(const float* wq, const float* wk, int lane) {
    float a = fabsf(wq[lane]), c = fabsf(wk[lane]);
#pragma unroll
    for (int o = 1; o < 64; o <<= 1) { a = fmaxf(a, __shfl_xor(a, o)); c = fmaxf(c, __shfl_xor(c, o)); }
    return 64.f * a * c * 0.125f * LOG2E;
}
__device__ __forceinline__ void diff_unit(KP Pk, Frame& F, int l, int b, int h, int qrow0, int nkt) {
    unsigned char* ws = F.ws;
    const bf16_t* U = (const bf16_t*)(ws + WS_U);
    const int m = F.wave & 1, rb = F.wave >> 1;
    const float sh2 = score_bound(Pk->in[I_DQN] + l * 64, Pk->in[I_DKN] + l * 64, F.lane);
    bf16x8 q[4];
    { const bf16_t* qp = U + (size_t)(qrow0 + 32 * rb + (F.lane & 31)) * NU + UC_DQ + h * 128 + m * 64 + 8 * (F.lane >> 5);
#pragma unroll
      for (int ks = 0; ks < 4; ++ks) q[ks] = *(const bf16x8*)(qp + 16 * ks); }
    f32x16 O[4];
#pragma unroll
    for (int nb = 0; nb < 4; ++nb) O[nb] = (f32x16){};
    float lsum = 0.f;
    attn_core<128, 128, false>(F, U, b, UC_DK + h * 128, (const bf16_t*)(ws + WS_VTD) + ((size_t)(b * 4 + h) * 128) * KEYS, nkt, 0, 0, q, 64 * m, 0, sh2, O, lsum);
    int ln_; asm volatile("v_mbcnt_lo_u32_b32 %0, -1, 0\n\tv_mbcnt_hi_u32_b32 %0, -1, %0" : "=v"(ln_));
    const int r32 = ln_ & 31, hi = ln_ >> 5;
    { int lo_ = l; asm volatile("" : "+s"(lo_)); l = lo_; Pk = kp_opaque(Pk); }
    lsum += __shfl_xor(lsum, 32);
    const float rl = 1.f / lsum;
    LAS float* ex = (LAS float*)F.lds + rb * 4096;
    float rlr[16];
#pragma unroll
    for (int r = 0; r < 16; ++r) rlr[r] = __shfl(rl, crow(r, hi));
    if (m == 1) {
#pragma unroll
        for (int nb = 0; nb < 4; ++nb)
#pragma unroll
            for (int r = 0; r < 16; ++r) ex[crow(r, hi) * 128 + nb * 32 + r32] = O[nb][r] * rlr[r];
    }
    __syncthreads();
    if (m == 0) {
        const float* dl = Pk->in[I_DLAM] + l * 256; const float lam_init = __builtin_bit_cast(float, __builtin_amdgcn_readfirstlane(__builtin_bit_cast(int, l == 0 ? 0.2f : (0.8f - 0.6f * 0.74081822068f))));
        const float lam = expf(wave_sum(dl[ln_] * dl[64 + ln_])) - expf(wave_sum(dl[128 + ln_] * dl[192 + ln_])) + lam_init;
        float ssq[16];
#pragma unroll
        for (int r = 0; r < 16; ++r) { float a = 0.f;
#pragma unroll
            for (int nb = 0; nb < 4; ++nb) { const float v = O[nb][r] * rlr[r] - lam * ex[crow(r, hi) * 128 + nb * 32 + r32]; O[nb][r] = v; a += v * v; }
            a += __shfl_xor(a, 1); a += __shfl_xor(a, 2); a += __shfl_xor(a, 4); a += __shfl_xor(a, 8); a += __shfl_xor(a, 16);
            ssq[r] = rsqrtf(a * (1.f / 128.f) + NORM_EPS) * (1.f - lam_init); }
        unsigned char* mix = ws + WS_H + ((size_t)(qrow0 + 32 * rb) * D + 1536 + h * 128) * MIXB;
#pragma unroll
        for (int nb = 0; nb < 4; ++nb) { const float w = Pk->in[I_DSUB][l * 128 + nb * 32 + r32];
#pragma unroll
            for (int r = 0; r < 16; ++r) { const float y = O[nb][r] * ssq[r] * w; const size_t e = (size_t)crow(r, hi) * D + nb * 32 + r32; if (WOUT_F8) mix[e] = f8_1(y); else ((bf16_t*)mix)[e] = (bf16_t)f2bf(y); } }
    }
}
__device__ __forceinline__ void swa_unit(KP Pk, Frame& F, int l, int b, int kvh, int qrow0, int qpos0, bool latent) {
    unsigned char* ws = F.ws;
    const bf16_t* U = (const bf16_t*)(ws + WS_U);
    const int hq = kvh * 4 + (F.wave & 3), rb = F.wave >> 2;
    const float sh2 = score_bound(Pk->in[I_SQN] + l * 64, Pk->in[I_SKN] + l * 64, F.lane);
    bf16x8 q[4];
    { const bf16_t* qp = U + (size_t)(qrow0 + 32 * rb + (F.lane & 31)) * NU + UC_SQ + hq * 64 + 8 * (F.lane >> 5);
#pragma unroll
      for (int ks = 0; ks < 4; ++ks) q[ks] = *(const bf16x8*)(qp + 16 * ks); }
    f32x16 O[2]; O[0] = (f32x16){}; O[1] = (f32x16){};
    float lsum = 0.f;
    int nloc = 0, loc0 = 0;
    if (latent) { int kp0 = qpos0 - 128, kp1 = qpos0 + 64 + 128; if (kp0 < 0) kp0 = 0; if (kp1 > SEQ) kp1 = SEQ; nloc = (kp1 - kp0) / 64; loc0 = LC + kp0; }
    const bf16_t* VT = (const bf16_t*)(ws + WS_VTS) + ((size_t)(b * 2 + kvh) * 64) * KEYS;
    attn_core<64, 64, true>(F, U, b, UC_SK + kvh * 64, VT, 4, nloc, loc0, q, 0, qpos0 + 32 * rb, sh2, O, lsum);
    int ln_; asm volatile("v_mbcnt_lo_u32_b32 %0, -1, 0\n\tv_mbcnt_hi_u32_b32 %0, -1, %0" : "=v"(ln_));
    const int r32 = ln_ & 31, hi = ln_ >> 5;
    { int lo_ = l; asm volatile("" : "+s"(lo_)); l = lo_; Pk = kp_opaque(Pk); }
    lsum += __shfl_xor(lsum, 32);
    const float rl = 1.f / (lsum + exp2f(Pk->in[I_SINK][l * 8 + hq] * LOG2E - sh2));
    unsigned char* mix = ws + WS_H + ((size_t)(qrow0 + 32 * rb) * D + 512 + hq * 64) * MIXB;
#pragma unroll
    for (int r = 0; r < 16; ++r) { const float rr = __shfl(rl, crow(r, hi));
#pragma unroll
        for (int nb = 0; nb < 2; ++nb) { const float y = O[nb][r] * rr; const size_t e = (size_t)crow(r, hi) * D + nb * 32 + r32; if (WOUT_F8) mix[e] = f8_1(y); else ((bf16_t*)mix)[e] = (bf16_t)f2bf(y); } }
}
constexpr int HY_PAD = 224, YSTR = 2504, HY_YB = 8 * YSTR * 2, HY_CST = 8224, HY_COP = 2 * HY_YB;
__device__ __forceinline__ void hyena_unit(KP Pk, Frame& F, int l, int cg) {
    unsigned char* ws = F.ws;
    const int r32 = F.lane & 31, hi = F.lane >> 5, bb = r32 >> 2, ib = r32 & 3;
    const bf16_t* ZT = (const bf16_t*)(ws + WS_ZT); bf16_t* OT = (bf16_t*)(ws + WS_OT);
    LAS unsigned char* cop = F.lds + HY_COP;
    const int nseq = l == 0 ? 2 : 1;
#pragma unroll 1
    for (int cs = 0; cs < 4 * nseq; ++cs) {
        const int ci = cs >> (nseq - 1), st = cs & (nseq - 1), ch = cg * 4 + ci, L = st == 0 ? SEQ : LC, nblk = L / 32, pos0 = st == 0 ? 0 : SEQ;
        __syncthreads();
        for (int id = F.tid; id < 8 * (L / 8 + 56); id += NTHR) { const int b = id / (L / 8 + 56), c = id % (L / 8 + 56);
            if (c < L / 8) *(LAS u32x4*)(F.lds + (b * YSTR + HY_PAD + 8 * c) * 2) = *(const u32x4*)(ZT + ((size_t)b * 1536 + 1024 + ch) * KEYS + pos0 + 8 * c);
            else { const int pc = c - L / 8, off = pc < 28 ? 8 * pc : HY_PAD + L + 8 * (pc - 28); const u32x4 z = {0u, 0u, 0u, 0u};
                *(LAS u32x4*)(F.lds + (b * YSTR + off) * 2) = z; *(LAS u32x4*)(F.lds + HY_YB + (b * YSTR + off) * 2) = z; } }
#pragma unroll 1
        for (int o = 0; o < 2; ++o) {
            const bf16_t* R = (const bf16_t*)(ws + WS_HYF) + ((size_t)l * 1024 + o * 512 + ch) * 4608 + (st == 0 ? 0 : 4096);
            for (int xc = F.tid; xc < 2 * L / 8; xc += NTHR) { const u32x4 lo = *(const u32x4*)(R + 8 * xc); u32x4 hh = {0u, 0u, 0u, 0u}; if (8 * xc + 8 < 2 * L) hh = *(const u32x4*)(R + 8 * xc + 8);
                const unsigned w[9] = {lo.x, lo.y, lo.z, lo.w, hh.x, hh.y, hh.z, hh.w, 0u};
#pragma unroll
                for (int r = 0; r < 8; ++r) { u32x4 ov; unsigned t[4];
#pragma unroll
                    for (int k = 0; k < 4; ++k) t[k] = (r & 1) ? ((w[(r >> 1) + k] >> 16) | (w[(r >> 1) + k + 1] << 16)) : w[(r >> 1) + k];
                    ov.x = t[0]; ov.y = t[1]; ov.z = t[2]; ov.w = t[3]; *(LAS u32x4*)(cop + r * HY_CST + 16 * xc) = ov; } }
            __syncthreads();
            const LAS unsigned char* Yin = F.lds + (o == 0 ? 0 : HY_YB); LAS unsigned char* Yout = F.lds + (o == 0 ? HY_YB : 0);
            const float bias = Pk->in[I_HBIAS][(l * 2 + o) * 512 + ch];
            if (2 * F.wave < nblk / 4) {
                const int g0 = 2 * F.wave, dlo = 4 * g0 - nblk + 1, dhi = min(4 * g0 + 7, nblk - 1), nsteps = dhi - dlo + 1;
                const LAS unsigned char* ap = cop + ((-r32) & 7) * HY_CST + ((L - 32 * dlo - r32 + 8 * hi) & ~7) * 2;
                const LAS unsigned char* bp = Yin + (bb * YSTR + HY_PAD + 32 * (4 * g0 + ib - dlo) + 8 * hi) * 2;
                f32x16 acc0 = {}, acc1 = {};
#define HDSR(dst, addr, off) asm volatile("ds_read_b128 %0, %1 offset:%2" : "=v"(dst) : "v"(addr), "n"(off))
#define HWAIT(a, b, c, d) asm volatile("s_waitcnt lgkmcnt(0)" : "+v"(a), "+v"(b), "+v"(c), "+v"(d))
                bf16x8 R[6][2], A2[2][2];
                const unsigned apa = (unsigned)(uintptr_t)ap, bpa = (unsigned)(uintptr_t)bp;
                HDSR(R[2][0], bpa, 256); HDSR(R[2][1], bpa, 256 + 32); HDSR(R[3][0], bpa, 192); HDSR(R[3][1], bpa, 192 + 32);
                HDSR(R[4][0], bpa, 128); HDSR(R[4][1], bpa, 128 + 32); HDSR(R[5][0], bpa, 64); HDSR(R[5][1], bpa, 64 + 32);
                HDSR(R[0][0], bpa, 0); HDSR(R[0][1], bpa, 32); HDSR(A2[0][0], apa, 0); HDSR(A2[0][1], apa, 32);
                HWAIT(R[2][0], R[2][1], R[3][0], R[3][1]); HWAIT(R[4][0], R[4][1], R[5][0], R[5][1]); HWAIT(R[0][0], R[0][1], A2[0][0], A2[0][1]);
#pragma unroll 1
                for (int s0 = 0; s0 < nsteps; s0 += 6) {
                    const unsigned an = apa - (unsigned)(s0 + 6) * 64u, bn = bpa - (unsigned)(s0 + 6) * 64u;
#pragma unroll
                    for (int j = 0; j < 6; ++j) if (s0 + j < nsteps) {
                        if (s0 + j + 1 < nsteps) { HDSR(A2[(j + 1) & 1][0], an, (5 - j) * 64); HDSR(A2[(j + 1) & 1][1], an, (5 - j) * 64 + 32);
                            HDSR(R[(j + 1) % 6][0], bn, (5 - j) * 64); HDSR(R[(j + 1) % 6][1], bn, (5 - j) * 64 + 32); }
                        acc1 = MFMA32(A2[j & 1][0], R[(j + 2) % 6][0], acc1); acc0 = MFMA32(A2[j & 1][0], R[j][0], acc0);
                        acc1 = MFMA32(A2[j & 1][1], R[(j + 2) % 6][1], acc1); acc0 = MFMA32(A2[j & 1][1], R[j][1], acc0);
                        HWAIT(A2[(j + 1) & 1][0], A2[(j + 1) & 1][1], R[(j + 1) % 6][0], R[(j + 1) % 6][1]); }
                }
#undef HDSR
#undef HWAIT
#pragma unroll
                for (int gg = 0; gg < 2; ++gg) { const f32x16& acc = gg == 0 ? acc0 : acc1;
                    const int t0 = 32 * (4 * (g0 + gg) + ib) + 4 * hi;
                    const bf16_t* gp = ZT + ((size_t)bb * 1536 + o * 512 + ch) * KEYS + pos0 + t0;
#pragma unroll
                    for (int q = 0; q < 4; ++q) { const u32x2 yo = *(const LAS u32x2*)(Yin + (bb * YSTR + HY_PAD + t0 + 8 * q) * 2); const u32x2 gt = *(const u32x2*)(gp + 8 * q);
                        const float v0 = bflo(gt.x) * (acc[4 * q + 0] + bflo(yo.x) * bias), v1 = bfhi(gt.x) * (acc[4 * q + 1] + bfhi(yo.x) * bias);
                        const float v2 = bflo(gt.y) * (acc[4 * q + 2] + bflo(yo.y) * bias), v3 = bfhi(gt.y) * (acc[4 * q + 3] + bfhi(yo.y) * bias);
                        u32x2 ov; ov.x = pk2(v0, v1); ov.y = pk2(v2, v3);
                        if (o == 0) *(LAS u32x2*)(Yout + (bb * YSTR + HY_PAD + t0 + 8 * q) * 2) = ov;
                        else *(u32x2*)(OT + ((size_t)bb * 512 + ch) * KEYS + pos0 + t0 + 8 * q) = ov; } }
            }
            __syncthreads();
        }
    }
    VM_WAIT(); __syncthreads();
    const int npos = l == 0 ? KEYS : SEQ;
    for (int id = F.tid; id < 8 * npos; id += NTHR) { const int b = id / npos, pos = id % npos, row = pos < SEQ ? b * SEQ + pos : TL + b * LC + (pos - SEQ);
        const bf16_t* op = OT + ((size_t)b * 512 + cg * 4) * KEYS + pos;
        if (WOUT_F8) *(unsigned*)(ws + WS_H + (size_t)row * D + 1024 + cg * 4) = pk4_f8(bf2f(op[0]), bf2f(op[KEYS]), bf2f(op[2 * KEYS]), bf2f(op[3 * KEYS]));
        else { u32x2 ov; ov.x = (unsigned)op[0] | ((unsigned)op[KEYS] << 16); ov.y = (unsigned)op[2 * KEYS] | ((unsigned)op[3 * KEYS] << 16); *(u32x2*)((bf16_t*)(ws + WS_H) + (size_t)row * D + 1024 + cg * 4) = ov; } }
}
#ifndef MX_MASK
#define MX_MASK 15
#endif
#ifndef PROBE_T
#define PROBE_T 0u
#endif
#ifndef PROBE_WG
#define PROBE_WG 0
#endif
#ifndef PROBE_UT
#define PROBE_UT -1
#endif
#ifndef PROBE_UL
#define PROBE_UL 0
#endif
#ifndef PROBE_MX
#define PROBE_MX 0
#endif
__device__ __forceinline__ void ph_mixers(KP Pk, Frame& F, int l, int qid) {
    const int n_diff = 512, n_hy = 128, n_dctx = l == 0 ? 64 : 0, n_swa = 512, n_sctx = l == 0 ? 64 : 0, gpb = l == 0 ? 5 : 4, n_gla = 64 * gpb;
    constexpr int R0 = 1 + ((PROBE_MX >> 0) & 1), R1 = 1 + ((PROBE_MX >> 1) & 1), R2 = 1 + ((PROBE_MX >> 2) & 1), R3 = 1 + ((PROBE_MX >> 3) & 1);
    const int n_mix = R0 * (n_diff + n_dctx) + R1 * n_hy + R2 * (n_swa + n_sctx) + R3 * n_gla + (l == 0 ? 96 + 128 : 0);
    const int n_titems = 16 * TI_GU + 16 * TI_DN + TI_WOUT + (l == 0 ? TI_WIN + TI_WA : 0), NTU = (n_titems + 127) / 128;
    const int total = n_mix + NTU, tplaced = min(NTU, total / 4);
    for (;;) {
        const int s_ = wg_grab(F, qid); if (s_ >= total) break;
        int ut_ = 8; const unsigned long long ut0_ = (PROBE_UT >= 0) ? __builtin_amdgcn_s_memrealtime() : 0ull;
        int u = s_ - min(NTU, s_ / 4), tu = -1;
        if ((s_ & 3) == 3 && (s_ >> 2) < NTU) tu = s_ >> 2; else if (u >= n_mix) tu = tplaced + (u - n_mix);
        if (tu >= 0) { ut_ = 0; LAS float* scr = (LAS float*)(F.lds + F.wave * 8704);
            for (int j = 0; j < 16; ++j) { int x = tu * 128 + F.wave * 16 + j; if (x >= n_titems) break;
                int it;
                if (x < 16 * TI_GU) it = 2 * TI_L + l * 16 * TI_GU + x;
                else if ((x -= 16 * TI_GU) < 16 * TI_DN) it = 2 * TI_L + 32 * TI_GU + l * 16 * TI_DN + x;
                else if ((x -= 16 * TI_DN) < TI_WOUT) it = l * TI_L + TI_WIN + TI_WA + x;
                else it = TI_L + (x - TI_WOUT);
                p0_item(Pk, F, it, scr); }
            goto mx_next; }
        if (l == 0) { if (u < 96) { ut_ = 1; ada_unit(Pk, F, 96 + u); goto mx_next; } u -= 96;
                      if (u < 128) { ut_ = 2; ph_hyena_filters(Pk, F, 128 + u); goto mx_next; } u -= 128; }
        if (u < R1 * n_hy) { ut_ = 3; u %= n_hy; if (MX_MASK & 2) hyena_unit(Pk, F, l, u); goto mx_next; } u -= R1 * n_hy;
        if (u < R3 * n_gla) { u %= n_gla; const int bh = u / gpb, grp = u % gpb, c = (l == 0 ? 0 : 4) + grp * 8 + F.wave;
          __syncthreads();
          if ((MX_MASK & 8) && c < NCH) gla_pass_b(Pk, F, l, bh >> 3, bh & 7, c, F.lds + F.wave * WAVE_LDS);
          goto mx_next; } u -= R3 * n_gla;
        if (u < R0 * n_diff) { ut_ = 4; u %= n_diff; const int b = u >> 6, h = (u >> 4) & 3, qb = u & 15; if (MX_MASK & 1) diff_unit(Pk, F, l, b, h, b * SEQ + 128 * qb, 36); goto mx_next; } u -= R0 * n_diff;
        if (u < R0 * n_dctx) { ut_ = 5; u %= n_dctx; const int b = u >> 3, h = (u >> 1) & 3, qb = u & 1; if (MX_MASK & 1) diff_unit(Pk, F, l, b, h, TL + b * LC + 128 * qb, 4); goto mx_next; } u -= R0 * n_dctx;
        if (u < R2 * n_swa) { ut_ = 6; u %= n_swa; const int b = u >> 6, kvh = (u >> 5) & 1, qb = u & 31; if (MX_MASK & 4) swa_unit(Pk, F, l, b, kvh, b * SEQ + 64 * qb, 64 * qb, true); goto mx_next; } u -= R2 * n_swa;
        if (u < R2 * n_sctx) { ut_ = 7; u %= n_sctx; const int b = u >> 3, kvh = (u >> 2) & 1, qb = u & 3; if (MX_MASK & 4) swa_unit(Pk, F, l, b, kvh, TL + b * LC + 64 * qb, 64 * qb, false); goto mx_next; } u -= R2 * n_sctx;
mx_next: ;
        if (PROBE_UT >= 0 && ut_ == PROBE_UT && l == PROBE_UL && !F.pt_done) { __syncthreads(); F.pt += __builtin_amdgcn_s_memrealtime() - ut0_; F.pt_done = 1; }
    }
}

constexpr int N_PHASES = 22;
#ifndef PH_MASK
#define PH_MASK 0xfffu
#endif
__global__ void __launch_bounds__(NTHR, 2) fwd_kernel(Params Parg) {
    extern __shared__ __attribute__((aligned(16))) unsigned char lds_raw[];
    const KP P0 = (KP)__builtin_amdgcn_kernarg_segment_ptr();
    Frame F;
    F.lds = (LAS unsigned char*)lds_raw; F.MISC = (volatile LAS unsigned*)(F.lds + LDS_MISC);
    const int wave_s = __builtin_amdgcn_readfirstlane((int)threadIdx.x >> 6);
#define TID_REFRESH() do { int t_; asm volatile("v_mbcnt_lo_u32_b32 %0, -1, 0\n\tv_mbcnt_hi_u32_b32 %0, -1, %0" : "=v"(t_)); F.lane = t_; F.wave = wave_s; F.tid = wave_s * 64 + t_; } while (0)
    TID_REFRESH();
    F.pt = 0ull; F.pt_done = 0;
    F.G = gridDim.x; { const int bx = blockIdx.x; F.vcu = (F.G % 8 == 0) ? (bx % 8) * (F.G / 8) + bx / 8 : bx; }
    F.ws = P0->ws; F.ctl = (unsigned*)(P0->ws + WS_CTL);
    for (int u = F.tid; u < 128; u += NTHR) F.MISC[u] = 0u;
    __syncthreads();
    const int lo = P0->ph_lo, hi = P0->ph_hi;
    const bool multi = hi - lo > 1;
    XcdBarrier bar; bar.bar = F.ctl + CW_BAR; bar.x = 0; bar.st = nullptr;
    if (multi) bar = xcd_barrier_post(F.ctl + CW_BAR, F.MISC + 8, F.tid);
#define INR(k) (lo <= (k) && (k) < hi)
#define IN(k, kind) (((PH_MASK >> (kind)) & 1u) && INR(k))
    unsigned long long pt_last = PROBE_T ? __builtin_amdgcn_s_memrealtime() : 0ull, pt_acc = 0ull;
#define PT_MARK(k) do { if (PROBE_T) { const unsigned long long now_ = __builtin_amdgcn_s_memrealtime(); if ((PROBE_T >> (k)) & 1u) pt_acc += now_ - pt_last; pt_last = now_; } } while (0)
#define SEAM(k) do { if (INR(k) && INR((k) + 1)) { bar.bar = (unsigned*)(kp_opaque(P0)->ws + WS_CTL) + CW_BAR; TID_REFRESH(); xcd_barrier(bar, F.tid); } PT_MARK(k); } while (0)
#ifndef PROBE_MASK
#define PROBE_MASK 0u
#endif
#define REP(kind) for (int rep_ = 0; rep_ < (((PROBE_MASK >> (kind)) & 1u) ? 2 : 1); ++rep_)
#define REP_SYNC(kind) do { if (((PROBE_MASK >> (kind)) & 1u) && rep_ == 0 && multi) { TID_REFRESH(); xcd_barrier(bar, F.tid); } } while (0)
#define PHASE_BEGIN() const KP Pk = kp_opaque(P0); unsigned char* ws = Pk->ws; F.ws = ws; F.ctl = (unsigned*)(ws + WS_CTL); \
    TID_REFRESH()
    if (IN(0, 0)) REP(0) { PHASE_BEGIN(); p0_prologue(Pk, F, rep_); REP_SYNC(0); } SEAM(0);
#pragma unroll 1
    for (int l = 0; l < DEPTH; ++l) {
        const int pb = 1 + 10 * l;
        if (IN(pb + 0, 1)) REP(1) { if (rep_ && l) break; PHASE_BEGIN(); if (l == 0) { for (int u = blockIdx.x; u < 128; u += F.G) ph_hyena_filters(Pk, F, u); } ph_norm1(Pk, F, l); REP_SYNC(1); } SEAM(pb + 0);
        if (IN(pb + 1, 2)) REP(2) { PHASE_BEGIN();
            pg8::Gemm g{(const bf16_t*)(ws + WS_H), (const bf16_t*)(ws + WS_WIN + (size_t)l * NU * D * 2), D, nullptr};
            pg8::RectOrder S; if (l == 0) S.init(72, 21, F.G, (int)blockIdx.x, 0, 0, 0ull); else S.init(64, 21, F.G, (int)blockIdx.x, 64, 64, 0x1413121108030201ull);
            pg8::EpiU E{(bf16_t*)(ws + WS_U), WIN_F8_L(l) ? 1.f / 32.f : 1.f};
            if (WIN_F8_L(l)) pg8::gemm_phase<pg8::EpiU, pg8::RectOrder, false, true>(F.lds, g, S, E, F.tid);
            else pg8::gemm_phase<pg8::EpiU, pg8::RectOrder, false, false>(F.lds, g, S, E, F.tid);
            if (WIN_F8_L(l)) ph_gate_cols8(F, l); else ph_gate_cols(F, l); REP_SYNC(2);
        } SEAM(pb + 1);
        if (IN(pb + 2, 3)) REP(3) { PHASE_BEGIN(); ph_prep(Pk, F, l, rep_); PT_MARK(pb + 3); REP_SYNC(3); } SEAM(pb + 2);
        if (IN(pb + 4, 5)) REP(5) { PHASE_BEGIN(); ph_mixers(Pk, F, l, 1 + l + 2 * rep_); REP_SYNC(5); } SEAM(pb + 4);
        if (IN(pb + 5, 6)) REP(6) { if (rep_ && l) break; PHASE_BEGIN();
            pg8::Gemm g{(const bf16_t*)(ws + WS_H), (const bf16_t*)(ws + WS_WOUT + (size_t)l * D * D * MIXB), D, nullptr};
            pg8::RectOrder S; S.init(l == 0 ? 72 : 64, 8, F.G, (int)blockIdx.x, 0, 0, 0ull);
            pg8::EpiWout E{Pk->in[I_X], Pk->in[I_CTX], l == 0 ? (const bf16_t*)nullptr : (const bf16_t*)(ws + WS_X), (bf16_t*)(ws + WS_X), (const float*)(ws + WS_MOD) + (size_t)l * 9 * 12288};
            pg8::gemm_phase<pg8::EpiWout, pg8::RectOrder, false, WOUT_F8>(F.lds, g, S, E, F.tid); REP_SYNC(6);
        } SEAM(pb + 5);
        if (IN(pb + 6, 7)) REP(7) { PHASE_BEGIN(); ph_norm2_router(Pk, F, l, rep_); REP_SYNC(7); } SEAM(pb + 6);
        if (IN(pb + 7, 8)) { PHASE_BEGIN(); ph_slots(Pk, F, l); } SEAM(pb + 7);
        if (IN(pb + 8, 9)) REP(9) { PHASE_BEGIN();
            const int np = moe_table(F, l);
            pg8::Gemm g{(const bf16_t*)(ws + WS_H), (const bf16_t*)(ws + WS_WGU + (size_t)l * NE * 2048 * D), D, (const int*)(ws + WS_RT + RT_ROWTOK)};
            pg8::MoeOrder S{np, F.G, F.vcu, (const volatile LAS unsigned char*)(F.MISC + 64)};
            pg8::EpiMoe1 E{ws + WS_U};
            pg8::gemm_phase<pg8::EpiMoe1, pg8::MoeOrder, true, true>(F.lds, g, S, E, F.tid); REP_SYNC(9);
        } SEAM(pb + 8);
        if (IN(pb + 9, 10)) REP(10) { PHASE_BEGIN();
            const int np = moe_table(F, l);
            pg8::Gemm g{(const bf16_t*)(ws + WS_U), (const bf16_t*)(ws + WS_WD + (size_t)l * NE * D * DE), DE, nullptr};
            pg8::MoeOrder S{np, F.G, F.vcu, (const volatile LAS unsigned char*)(F.MISC + 64)};
            pg8::EpiMoe2 E{ws + WS_Y2, (const int*)(ws + WS_RT + RT_ROWTOK), (const float*)(ws + WS_RT + RT_ROWW)};
            pg8::gemm_phase<pg8::EpiMoe2, pg8::MoeOrder, false, true>(F.lds, g, S, E, F.tid); REP_SYNC(10);
        } SEAM(pb + 9);
    }
    if (IN(21, 11)) REP(11) { PHASE_BEGIN(); ph_final(Pk, F); REP_SYNC(11); }
    if (PROBE_T || PROBE_UT >= 0) { PT_MARK(21); if (blockIdx.x == PROBE_WG) { const unsigned long long t0_ = __builtin_amdgcn_s_memrealtime(); while (__builtin_amdgcn_s_memrealtime() - t0_ < 8ull * (pt_acc + F.pt)) __builtin_amdgcn_s_sleep(8); } }
#undef IN
#undef INR
#undef SEAM
#undef PT_MARK
#undef PHASE_BEGIN
#undef REP
#undef REP_SYNC
#undef TID_REFRESH
}

#ifndef MK_PER_PHASE
#define MK_PER_PHASE 0
#endif
extern "C" void kernel_launch(void* const* d_in, const int* in_sizes, int n_in, void* d_out, int out_size, void* d_ws, size_t ws_size, hipStream_t stream) {
    static int grid = 0;
    if (grid == 0) {
        if (n_in != 34 || in_sizes[0] != TL * D || out_size != TL * D || ws_size < WS_END) { fprintf(stderr, "kernel_launch: unexpected shapes (n_in %d, in0 %d, out %d, ws %zu < %zu)\n", n_in, n_in > 0 ? in_sizes[0] : -1, out_size, ws_size, (size_t)WS_END); grid = -1; return; }
        int dev = 0, cus = 0, per_cu = 0;
        if (hipGetDevice(&dev) != hipSuccess || hipDeviceGetAttribute(&cus, hipDeviceAttributeMultiprocessorCount, dev) != hipSuccess) { grid = -1; return; }
        if (hipFuncSetAttribute((const void*)fwd_kernel, hipFuncAttributeMaxDynamicSharedMemorySize, LDS_BYTES) != hipSuccess) { fprintf(stderr, "kernel_launch: hipFuncSetAttribute failed\n"); grid = -1; return; }
        if (hipOccupancyMaxActiveBlocksPerMultiprocessor(&per_cu, (const void*)fwd_kernel, NTHR, LDS_BYTES) != hipSuccess || per_cu < 1) fprintf(stderr, "kernel_launch: occupancy query reports %d\n", per_cu);
        (void)hipGetLastError();
        grid = cus;
    }
    if (grid < 0) return;
    (void)hipMemsetAsync((char*)d_ws + WS_CTL, 0, CTL_BYTES, stream);
    Params p{};
    for (int i = 0; i < 34; ++i) p.in[i] = (const float*)d_in[i];
    p.out = (float*)d_out; p.ws = (unsigned char*)d_ws;
#if MK_PER_PHASE
    for (int k = 0; k < N_PHASES; ++k) { p.ph_lo = k; p.ph_hi = k + 1; hipLaunchKernelGGL(fwd_kernel, dim3(grid), dim3(NTHR), LDS_BYTES, stream, p); }
#else
    p.ph_lo = 0; p.ph_hi = N_PHASES; hipLaunchKernelGGL(fwd_kernel, dim3(grid), dim3(NTHR), LDS_BYTES, stream, p);
#endif
    const hipError_t le = hipPeekAtLastError();
    if (le != hipSuccess) fprintf(stderr, "kernel_launch: launch failed: %s\n", hipGetErrorName(le));
}
```

```cpp
#include <hip/hip_runtime.h>
#include <cstdio>
#include <cstdint>

#define LAS __attribute__((address_space(3)))
#define GAS __attribute__((address_space(1)))
typedef unsigned short bf16_t;
typedef short bf16x8 __attribute__((ext_vector_type(8)));
typedef float f32x2 __attribute__((ext_vector_type(2)));
typedef float f32x4 __attribute__((ext_vector_type(4)));
typedef float f32x16 __attribute__((ext_vector_type(16)));
typedef unsigned u32x2 __attribute__((ext_vector_type(2)));
typedef unsigned u32x4 __attribute__((ext_vector_type(4)));
typedef int i32x4 __attribute__((ext_vector_type(4)));
typedef int i32x8 __attribute__((ext_vector_type(8)));

#ifndef PROBE_T
#define PROBE_T 0u
#endif
#ifndef PROBE_WG
#define PROBE_WG 0
#endif
#ifndef PROBE_UT
#define PROBE_UT -1
#endif
#ifndef PROBE_UL
#define PROBE_UL 0
#endif
constexpr int D = 2048, NB = 8, SEQ = 2048, LC = 256, DEPTH = 2;
constexpr int TL = NB * SEQ, TCX = NB * LC, TT = TL + TCX;
constexpr int DIN = 5408, NU = 5376, NE = 16, DE = 1024;
constexpr int KEYS = LC + SEQ;
constexpr int UC_GQ = 0, UC_GK = 256, UC_GV = 512, UC_GG = 1024, UC_SQ = 1536, UC_SK = 2048, UC_SV = 2176, UC_HY = 2304, UC_DQ = 3840, UC_DK = 4352, UC_DV = 4864;
constexpr int MOE_ROWS = 2 * TT + NE * 256;
constexpr int MOE_PANELS = MOE_ROWS / 256;
constexpr int GCH = 64, NCH = KEYS / GCH;
constexpr float NORM_EPS = 1e-6f;
constexpr float LOG2E = 1.4426950408889634f;

constexpr size_t MiB = 1u << 20;
constexpr size_t WS_CTL = 0, CTL_BYTES = 1 * MiB;
constexpr size_t WS_MOD = 1 * MiB;
constexpr size_t WS_ROPE = 2 * MiB;
constexpr size_t WS_HYH2 = 3 * MiB;
constexpr size_t WS_WA = 5 * MiB;
constexpr size_t WS_RT = 6 * MiB;
constexpr size_t WS_AG = 7 * MiB;
constexpr size_t WS_HYF = 10 * MiB;
constexpr size_t WS_WIN = 28 * MiB;
constexpr size_t WS_WOUT = 70 * MiB;
constexpr size_t WS_WGU = 86 * MiB;
constexpr size_t WS_WD = 342 * MiB;
constexpr size_t WS_X = 470 * MiB;
constexpr size_t WS_H = 614 * MiB;
constexpr size_t WS_U = 686 * MiB;
constexpr size_t WS_B = 875 * MiB;
constexpr size_t WS_VTD = WS_B;
constexpr size_t WS_VTS = WS_B + 18 * MiB;
constexpr size_t WS_ZT = WS_B + 23 * MiB;
constexpr size_t WS_OT = WS_B + 77 * MiB;
constexpr size_t WS_GSL = WS_B + 95 * MiB;
constexpr size_t WS_GSS = WS_B + 131 * MiB;
constexpr size_t WS_GAE = WS_B + 167 * MiB;
constexpr size_t WS_Y2 = WS_B;
constexpr size_t WS_HB = 1043 * MiB;
constexpr size_t WS_END = 1115 * MiB;
constexpr int WIN_F8_MASK = 3;
#define WIN_F8_L(l) (((WIN_F8_MASK) >> (l)) & 1)
constexpr bool WOUT_F8 = true;
constexpr int MIXB = WOUT_F8 ? 1 : 2;
constexpr size_t RT_E = 0;
constexpr size_t RT_W = 128 * 1024;
constexpr size_t RT_ROWTOK = 320 * 1024;
constexpr size_t RT_ROWW = 512 * 1024;
constexpr int CW_BAR = 4096;
constexpr int CW_CNT = 16384;
constexpr int CW_CUR = 16384 + 256;
constexpr int CW_HYC = 16384 + 512, CW_ADAC = 16384 + 576;
constexpr int CW_Q = 16384 + 1024;

constexpr int LDS_BYTES = 155648;
constexpr int LDS_MISC = LDS_BYTES - 512;
constexpr int NWAVES = 8, NTHR = 512;

__device__ __forceinline__ unsigned f2bf(float f) { unsigned u = __builtin_bit_cast(unsigned, f); return (u + 0x7fffu + ((u >> 16) & 1u)) >> 16; }
#ifndef EMU8
#define EMU8 0
#endif
__device__ __forceinline__ float q8(float f) { unsigned u = __builtin_bit_cast(unsigned, f); u = (u + 0x7ffffu + ((u >> 20) & 1u)) & 0xfff00000u; return __builtin_bit_cast(float, u); }
__device__ __forceinline__ unsigned pk2(float lo, float hi) { return f2bf(lo) | (f2bf(hi) << 16); }
__device__ __forceinline__ unsigned pk2q(float lo, float hi) { return f2bf(q8(lo)) | (f2bf(q8(hi)) << 16); }
__device__ __forceinline__ unsigned pk4_f8(float a, float b, float c, float d) {
    a = fminf(fmaxf(a, -448.f), 448.f); b = fminf(fmaxf(b, -448.f), 448.f); c = fminf(fmaxf(c, -448.f), 448.f); d = fminf(fmaxf(d, -448.f), 448.f);
    int r = 0; r = __builtin_amdgcn_cvt_pk_fp8_f32(a, b, r, false); r = __builtin_amdgcn_cvt_pk_fp8_f32(c, d, r, true); return (unsigned)r; }
__device__ __forceinline__ unsigned char f8_1(float a) { a = fminf(fmaxf(a, -448.f), 448.f); return (unsigned char)(__builtin_amdgcn_cvt_pk_fp8_f32(a, a, 0, false) & 0xff); }
__device__ __forceinline__ float bf2f(unsigned short b) { return __builtin_bit_cast(float, ((unsigned)b) << 16); }
__device__ __forceinline__ float bflo(unsigned w) { return __builtin_bit_cast(float, w << 16); }
__device__ __forceinline__ float bfhi(unsigned w) { return __builtin_bit_cast(float, w & 0xffff0000u); }
__device__ __forceinline__ float wave_sum(float v) {
#pragma unroll
    for (int o = 1; o < 64; o <<= 1) v += __shfl_xor(v, o);
    return v;
}
__device__ __forceinline__ float silu_f(float x) { return x / (1.f + __expf(-x)); }
#define LDS_WAIT() asm volatile("s_waitcnt lgkmcnt(0)" ::: "memory")
#define VM_WAIT() asm volatile("s_waitcnt vmcnt(0)" ::: "memory")

#define XB_TMO      128
#define XB_XCNT(j)  (256  + 64 * (j))
#define XB_XSUB(j)  (1280 + 64 * (j))
#define XB_XGEN(j)  (2304 + 64 * (j))
#define XB_TOP      3328
#define XB_TOPGEN   3392
#define XCD_BAR_WORDS 3456
#define XB_SPIN_CAP (1u << 18)
__device__ __forceinline__ unsigned xb_ld(unsigned* p)              { return __hip_atomic_load(p, __ATOMIC_RELAXED, __HIP_MEMORY_SCOPE_AGENT); }
__device__ __forceinline__ unsigned xb_add(unsigned* p, unsigned v) { return __hip_atomic_fetch_add(p, v, __ATOMIC_RELAXED, __HIP_MEMORY_SCOPE_AGENT); }
__device__ __forceinline__ unsigned xb_xcc_id() { return (unsigned)__builtin_amdgcn_s_getreg((3 << 11) | 20) & 0xFu; }
#define XB_SPIN(cond, bar) do { unsigned _sp = 0; while (cond) { __builtin_amdgcn_s_sleep(1); \
    if ((++_sp & 255u) == 0u) { if (xb_ld(&(bar)[XB_TMO])) break; if (_sp > XB_SPIN_CAP) { atomicAdd(&(bar)[XB_TMO], 1u); break; } } } } while (0)
struct XcdBarrier { unsigned* bar; unsigned x; volatile LAS unsigned* st; };
__device__ __forceinline__ XcdBarrier xcd_barrier_post(unsigned* bar, volatile LAS unsigned* st, int tid) {
    XcdBarrier b; b.bar = bar; b.x = xb_xcc_id(); b.st = st;
    if (tid == 0) (void)xb_add(&bar[XB_XCNT(b.x)], 1u);
    return b;
}
__device__ __forceinline__ void xcd_barrier_complete(unsigned* bar, unsigned x, unsigned& nloc, unsigned& nx) {
    const unsigned G = gridDim.x * gridDim.y * gridDim.z;
    unsigned sum, cnt, mine, sp = 0u;
    for (;;) {
        sum = 0u; cnt = 0u; mine = 0u;
#pragma unroll
        for (unsigned j = 0; j < 16; ++j) { const unsigned c = xb_ld(&bar[XB_XCNT(j)]); sum += c; cnt += (c > 0u) ? 1u : 0u; mine = (j == x) ? c : mine; }
        if (sum == G) break;
        __builtin_amdgcn_s_sleep(1);
        if ((++sp & 255u) == 0u) { if (xb_ld(&bar[XB_TMO])) break; if (sp > XB_SPIN_CAP) { atomicAdd(&bar[XB_TMO], 1u); break; } }
    }
    nloc = mine > 0u ? mine : 1u; nx = cnt > 0u ? cnt : 1u;
}
__device__ __forceinline__ void xcd_barrier(const XcdBarrier& b, int tid) {
    asm volatile("s_waitcnt vmcnt(0)" ::: "memory");
    __syncthreads();
    if (tid == 0) {
        unsigned* bar = b.bar;
        __builtin_amdgcn_s_waitcnt(0);
        unsigned nloc = b.st[0], nx = b.st[1];
        if (nloc == 0u) { xcd_barrier_complete(bar, b.x, nloc, nx); b.st[0] = nloc; b.st[1] = nx; }
        const unsigned old = xb_add(&bar[XB_XSUB(b.x)], 1u);
        const unsigned gen = old / nloc;
        if (old + 1u == (gen + 1u) * nloc) {
            __builtin_amdgcn_fence(__ATOMIC_RELEASE, "agent");
            asm volatile("s_waitcnt vmcnt(0)" ::: "memory");
            const unsigned og = xb_add(&bar[XB_TOP], 1u);
            const unsigned tg = og / nx;
            if (og + 1u == (tg + 1u) * nx) xb_add(&bar[XB_TOPGEN], 1u);
            else XB_SPIN(xb_ld(&bar[XB_TOPGEN]) == tg, bar);
            __builtin_amdgcn_fence(__ATOMIC_ACQUIRE, "agent");
            xb_add(&bar[XB_XGEN(b.x)], 1u);
            asm volatile("s_waitcnt vmcnt(0)" ::: "memory");
        } else {
            XB_SPIN(xb_ld(&bar[XB_XGEN(b.x)]) == gen, bar);
            __builtin_amdgcn_fence(__ATOMIC_ACQUIRE, "agent");
            asm volatile("s_waitcnt vmcnt(0)" ::: "memory");
        }
    }
    __syncthreads();
}

namespace pg8 {
constexpr int BM = 256, BK = 64, HALF = 128, HTB = HALF * BK * 2, STAGE_BYTES = 8 * HTB;
__host__ __device__ __forceinline__ int lds_byte(int r, int c) { const int st = (r >> 4) * 2 + (c >> 5), rr = r & 15, cc = c & 31, ob = rr * 64 + cc * 2; return st * 1024 + (ob ^ (((ob >> 9) & 1) << 5)); }
__host__ __device__ __forceinline__ void stage_rc(int b, int& R, int& C) { const int st = b / 1024, sb = b % 1024, swz = sb ^ (((sb >> 9) & 1) << 5); R = (st >> 1) * 16 + swz / 64; C = (st & 1) * 32 + (swz % 64) / 2; }
__host__ __device__ __forceinline__ int lds_byte8(int r, int cb) { const int st = (r >> 4) * 2 + (cb >> 6), rr = r & 15, ob = rr * 64 + (cb & 63); return st * 1024 + (ob ^ (((ob >> 9) & 1) << 4)); }
__host__ __device__ __forceinline__ void stage_rc8(int b, int& R, int& Cb) { const int st = b / 1024, sb = b % 1024, swz = sb ^ (((sb >> 9) & 1) << 4); R = (st >> 1) * 16 + swz / 64; Cb = (st & 1) * 64 + (swz % 64); }
__host__ __device__ __forceinline__ int perm32(int rho) { const int n = rho >> 4, i = rho & 15; return 8 * (i >> 2) + 4 * n + (i & 3); }
struct Unit { int pm, pn; };
struct Gemm { const bf16_t* A; const bf16_t* Bt; int K; const int* rowtab; };
__device__ __forceinline__ unsigned cvt_pk_bf16(float lo, float hi) { unsigned r; asm volatile("v_cvt_pk_bf16_f32 %0, %1, %2" : "=v"(r) : "v"(lo), "v"(hi)); return r; }

template <class Epi, class Sched, bool GATHER, bool F8 = false>
__device__ __forceinline__ void gemm_phase(LAS unsigned char* lds, const Gemm g, const Sched& S, const Epi& E, const int tid) {
    const int wid = __builtin_amdgcn_readfirstlane(tid >> 6), lane = tid & 63, wr = wid >> 2, wc = wid & 3, fr = lane & 15, fq = lane >> 4;
    const int K = g.K, RB = F8 ? K : 2 * K, nt = RB / 128;
    unsigned voffB[2], voffA[2];
#pragma unroll
    for (int i = 0; i < 2; ++i) { int R, Cb; if constexpr (F8) stage_rc8(tid * 16 + i * 8192, R, Cb); else { int C; stage_rc(tid * 16 + i * 8192, R, C); Cb = 2 * C; }
        const int Rb = Epi::PERM ? ((R & ~31) + perm32(R & 31)) : R;
        voffA[i] = (unsigned)(R * RB + Cb); voffB[i] = (unsigned)(Rb * RB + Cb); }
    const size_t kstep = 128;
    const size_t hstep = (size_t)HALF * RB;
    const size_t tstep = 2 * hstep;
    const unsigned ldsw = (unsigned)wid * 1024u;
    const int aoff = F8 ? lds_byte8(wr * 64 + fr, 32 * fq) : lds_byte(wr * 64 + fr, fq * 8), boff = F8 ? lds_byte8(wc * 32 + fr, 32 * fq) : lds_byte(wc * 32 + fr, fq * 8);
    const int aoff2 = aoff ^ 16, boff2 = boff ^ 16;
#define PG8_SA(b, h) (((b) * 2 + (h)) * HTB)
#define PG8_SB(b, h) ((4 + (b) * 2 + (h)) * HTB)
#define PG8_STAGE(bufoff, gbase, voff) do { _Pragma("unroll") for (int _i = 0; _i < 2; ++_i) \
        __builtin_amdgcn_global_load_lds((const unsigned*)((const char*)(gbase) + (voff)[_i]), (LAS unsigned*)(lds + (bufoff) + ldsw + _i * 8192), 16, 0, 0); } while (0)
#define PG8_LDA(dst, b, h) do { if constexpr (F8) { _Pragma("unroll") for (int m = 0; m < 4; ++m) { const i32x4 _lo = *(const LAS i32x4*)(lds + PG8_SA(b, h) + aoff + m * 2048), _hi = *(const LAS i32x4*)(lds + PG8_SA(b, h) + aoff2 + m * 2048); dst##8[m] = __builtin_shufflevector(_lo, _hi, 0, 1, 2, 3, 4, 5, 6, 7); } } \
        else { _Pragma("unroll") for (int m = 0; m < 4; ++m) _Pragma("unroll") for (int k = 0; k < 2; ++k) dst[m][k] = *(const LAS bf16x8*)(lds + PG8_SA(b, h) + aoff + m * 2048 + k * 1024); } } while (0)
#define PG8_LDB(dst, b, h) do { if constexpr (F8) { _Pragma("unroll") for (int n = 0; n < 2; ++n) { const i32x4 _lo = *(const LAS i32x4*)(lds + PG8_SB(b, h) + boff + n * 2048), _hi = *(const LAS i32x4*)(lds + PG8_SB(b, h) + boff2 + n * 2048); dst##8[n] = __builtin_shufflevector(_lo, _hi, 0, 1, 2, 3, 4, 5, 6, 7); } } \
        else { _Pragma("unroll") for (int n = 0; n < 2; ++n) _Pragma("unroll") for (int k = 0; k < 2; ++k) dst[n][k] = *(const LAS bf16x8*)(lds + PG8_SB(b, h) + boff + n * 2048 + k * 1024); } } while (0)
#define PG8_CAT(x) __builtin_shufflevector(x[0], x[1], 0, 1, 2, 3, 4, 5, 6, 7)
#define PG8_MMA(ai, bj, At, Bt) do { __builtin_amdgcn_s_setprio(1); if constexpr (F8) { _Pragma("unroll") for (int m = 0; m < 4; ++m) _Pragma("unroll") for (int n = 0; n < 2; ++n) \
            asm volatile("v_mfma_scale_f32_16x16x128_f8f6f4 %0, %1, %2, %0, %3, %3 op_sel_hi:[0,0,0]" : "+v"(acc[ai][bj][m][n]) : "v"(Bt##8[n]), "v"(At##8[m]), "v"(f8scale)); } \
        else { _Pragma("unroll") for (int m = 0; m < 4; ++m) _Pragma("unroll") for (int n = 0; n < 2; ++n) _Pragma("unroll") for (int k = 0; k < 2; ++k) \
            acc[ai][bj][m][n] = __builtin_amdgcn_mfma_f32_16x16x32_bf16(Bt[n][k], At[m][k], acc[ai][bj][m][n], 0, 0, 0); } __builtin_amdgcn_s_setprio(0); } while (0)
#define PG8_WAIT_V(n) asm volatile("s_waitcnt vmcnt(" #n ")" ::: "memory")
#define PG8_WAIT_L(n) asm volatile("s_waitcnt lgkmcnt(" #n ")" ::: "memory")
#define PG8_BAR __builtin_amdgcn_s_barrier()
#define PG8_SCHED __builtin_amdgcn_sched_barrier(0)
#define PG8_AOFF(o, u) do { int _t2 = tid; asm volatile("" : "+v"(_t2)); _Pragma("unroll") for (int _i = 0; _i < 2; ++_i) { int _R, _Cb; if constexpr (F8) stage_rc8(_t2 * 16 + _i * 8192, _R, _Cb); else { int _C; stage_rc(_t2 * 16 + _i * 8192, _R, _C); _Cb = 2 * _C; } \
        _Pragma("unroll") for (int _h = 0; _h < 2; ++_h) { int _r = (u).pm * BM + _h * HALF + _R; \
        { const int _t = g.rowtab[_r]; _r = _t < 0 ? 0 : (_t & 0x3fffffff); } o[_h][_i] = (unsigned)(_r * RB + _Cb); } } } while (0)
    Unit cur, nxt; int ui = 0;
    if (!S.next(0, cur)) return;
    f32x4 acc[2][2][4][2];
#pragma unroll
    for (int a = 0; a < 2; ++a)
#pragma unroll
        for (int b = 0; b < 2; ++b)
#pragma unroll
            for (int m = 0; m < 4; ++m)
#pragma unroll
                for (int n = 0; n < 2; ++n) acc[a][b][m][n] = (f32x4){0.f, 0.f, 0.f, 0.f};
    bf16x8 At[4][2], B0[2][2], B1[2][2];
    i32x8 At8[4], B08[2], B18[2];
    int f8scale = 0x7f7f7f7f; asm volatile("" : "+v"(f8scale));
    unsigned oc[2][2], on[2][2];
    const char* gA = (const char*)g.A;
    const char* cA = gA; const char* cB = (const char*)g.Bt + (size_t)cur.pn * tstep;
    if constexpr (GATHER) { PG8_AOFF(oc, cur); } else { cA = gA + (size_t)cur.pm * tstep; }
#define PG8_STA_CUR(buf, kb, h) do { if constexpr (GATHER) { PG8_STAGE(buf, gA + (kb), oc[h]); } else { PG8_STAGE(buf, cA + (kb) + (h) * hstep, voffA); } } while (0)
#define PG8_STA_SEL(buf, kb, h) do { if constexpr (GATHER) { if (last) { PG8_STAGE(buf, gA + (kb), on[h]); } else { PG8_STAGE(buf, gA + (kb), oc[h]); } } else { PG8_STAGE(buf, a2p + (kb) + (h) * hstep, voffA); } } while (0)
    PG8_STAGE(PG8_SB(0, 0), cB, voffB); PG8_STAGE(PG8_SB(0, 1), cB + hstep, voffB); PG8_STA_CUR(PG8_SA(0, 0), 0, 0); PG8_STA_CUR(PG8_SA(0, 1), 0, 1);
    if (wr == 1) PG8_BAR;
    PG8_WAIT_V(2); PG8_BAR;
    PG8_STAGE(PG8_SB(1, 0), cB + kstep, voffB); PG8_STA_CUR(PG8_SA(1, 0), kstep, 0); PG8_STAGE(PG8_SB(1, 1), cB + hstep + kstep, voffB);
    PG8_WAIT_V(6); PG8_BAR;
    for (;;) {
        const bool has_next = S.next(ui + 1, nxt);
        const char* nA = cA;
        if constexpr (!GATHER) { if (has_next) nA = gA + (size_t)nxt.pm * tstep; }
        const char* nB = has_next ? (const char*)g.Bt + (size_t)nxt.pn * tstep : cB;
#pragma unroll 1
        for (int t = 0; t < nt; t += 2) {
            const bool last = (t == nt - 2);
            int to = t; asm volatile("" : "+s"(to));
            const size_t k1 = (size_t)(to + 1) * kstep, k2 = last ? 0 : (size_t)(to + 2) * kstep, k3 = k2 + kstep;
            const char* b2 = last ? nB : cB + (size_t)(to + 2) * kstep; const char* b3 = b2 + kstep;
            const char* a2p = last ? nA : cA;
            if constexpr (GATHER) { if (last) { if (has_next) { PG8_AOFF(on, nxt); } else {
#pragma unroll
                for (int h = 0; h < 2; ++h)
#pragma unroll
                    for (int i = 0; i < 2; ++i) on[h][i] = oc[h][i]; } } }
            PG8_LDB(B0, 0, 0); PG8_LDB(B1, 0, 1); PG8_SCHED; PG8_LDA(At, 0, 0); PG8_STA_CUR(PG8_SA(1, 1), k1, 1);
            PG8_WAIT_V(8); PG8_WAIT_L(0); PG8_BAR; PG8_MMA(0, 0, At, B0); PG8_MMA(0, 1, At, B1); PG8_BAR; PG8_SCHED;
            PG8_LDA(At, 0, 1); PG8_STAGE(PG8_SB(0, 0), b2, voffB); PG8_STAGE(PG8_SB(0, 1), b2 + hstep, voffB); PG8_STA_SEL(PG8_SA(0, 0), k2, 0);
            PG8_WAIT_V(8); PG8_WAIT_L(0); PG8_BAR; PG8_MMA(1, 0, At, B0); PG8_MMA(1, 1, At, B1); PG8_BAR; PG8_SCHED;
            PG8_LDB(B0, 1, 0); PG8_LDB(B1, 1, 1); PG8_SCHED; PG8_LDA(At, 1, 0); PG8_STA_SEL(PG8_SA(0, 1), k2, 1);
            PG8_WAIT_V(8); PG8_WAIT_L(0); PG8_BAR; PG8_MMA(0, 0, At, B0); PG8_MMA(0, 1, At, B1); PG8_BAR; PG8_SCHED;
            PG8_LDA(At, 1, 1); PG8_STAGE(PG8_SB(1, 0), b3, voffB); PG8_STAGE(PG8_SB(1, 1), b3 + hstep, voffB); PG8_STA_SEL(PG8_SA(1, 0), k3, 0);
            PG8_WAIT_V(8); PG8_WAIT_L(0); PG8_BAR; PG8_MMA(1, 0, At, B0); PG8_MMA(1, 1, At, B1); PG8_BAR; PG8_SCHED;
        }
        if (wr == 0) PG8_BAR;
        if constexpr (F8) asm volatile("s_nop 15\n\ts_nop 15" : "+v"(acc[1][1][0][0]), "+v"(acc[1][1][0][1]), "+v"(acc[1][1][1][0]), "+v"(acc[1][1][1][1]), "+v"(acc[1][1][2][0]), "+v"(acc[1][1][2][1]), "+v"(acc[1][1][3][0]), "+v"(acc[1][1][3][1]) :: "memory");
        E(acc, cur, wr, wc, fr, fq);
        if (!has_next) break;
#pragma unroll
        for (int a = 0; a < 2; ++a)
#pragma unroll
            for (int b = 0; b < 2; ++b)
#pragma unroll
                for (int m = 0; m < 4; ++m)
#pragma unroll
                    for (int n = 0; n < 2; ++n) acc[a][b][m][n] = (f32x4){0.f, 0.f, 0.f, 0.f};
        cur = nxt; cB = nB; cA = nA; ++ui;
        if constexpr (GATHER) {
#pragma unroll
            for (int h = 0; h < 2; ++h)
#pragma unroll
                for (int i = 0; i < 2; ++i) oc[h][i] = on[h][i]; }
        if (wr == 1) PG8_BAR;
    }
#undef PG8_STA_CUR
#undef PG8_STA_SEL
    PG8_WAIT_V(0);
    PG8_BAR;
#undef PG8_SA
#undef PG8_SB
#undef PG8_STAGE
#undef PG8_LDA
#undef PG8_LDB
#undef PG8_CAT
#undef PG8_MMA
#undef PG8_WAIT_V
#undef PG8_WAIT_L
#undef PG8_BAR
#undef PG8_SCHED
#undef PG8_AOFF
}
}

struct Params { const float* in[34]; float* out; unsigned char* ws; int ph_lo, ph_hi; };
typedef const __attribute__((address_space(4))) Params* KP;
__device__ __forceinline__ KP kp_opaque(KP p) { asm volatile("" : "+s"(p)); return p; }
enum { I_X = 0, I_C, I_CTX, I_CCTX, I_N1W, I_N2W, I_ADAW, I_ADAB, I_WIN, I_WOUT, I_GGW, I_GGB, I_GNW, I_SQN, I_SKN, I_SINK, I_HCW, I_HCB, I_HW1, I_HB1, I_HW2, I_HB2, I_HW3, I_HFR, I_HBIAS,
       I_DQN, I_DKN, I_DLAM, I_DSUB, I_RW, I_RB, I_EG, I_EU, I_ED };
struct Frame {
    LAS unsigned char* lds; volatile LAS unsigned* MISC; unsigned* ctl;
    int tid, lane, wave, vcu, G;
    unsigned char* ws;
    unsigned long long pt, pt0; int pt_done;
};
__device__ __forceinline__ int modrow_of(int row) { return row < TL ? (row >> 11) : 8; }
__device__ __forceinline__ int keyrow(int b, int kidx) { return kidx < LC ? TL + b * LC + kidx : b * SEQ + (kidx - LC); }
__device__ __forceinline__ int wg_grab(Frame& F, int q) {
    __syncthreads();
    if (F.tid == 0) F.MISC[0] = __hip_atomic_fetch_add(F.ctl + CW_Q + 64 * q, 1u, __ATOMIC_RELAXED, __HIP_MEMORY_SCOPE_AGENT);
    __syncthreads();
    { int t_; asm volatile("v_mbcnt_lo_u32_b32 %0, -1, 0\n\tv_mbcnt_hi_u32_b32 %0, -1, %0" : "=v"(t_)); F.lane = t_; F.tid = F.wave * 64 + t_; }
    return (int)F.MISC[0];
}

namespace pg8 {
constexpr int NXCD = 8, WGM = 8;
struct RectOrder {
    int nM, nN, nwg, G, c, nextra, xpm0; unsigned long long xt;
    __device__ void init(int nM_, int nN_, int G_, int c_, int nextra_, int xpm0_, unsigned long long xt_) { nM = nM_; nN = nN_; nwg = nM * nN; G = G_; c = c_; nextra = nextra_; xpm0 = xpm0_; xt = xt_; }
    __device__ bool next(int i, Unit& u) const {
        const int L = i * G + c; if (L >= nwg + nextra) return false;
        if (L >= nwg) { const int e = L - nwg; u.pm = xpm0 + (e >> 3); u.pn = (int)((xt >> (8 * (e & 7))) & 0xffull); return true; }
        int wgid = L; { const int q = nwg / NXCD, r = nwg % NXCD, xcd = wgid % NXCD, off = wgid / NXCD; wgid = (xcd < r ? xcd * (q + 1) : r * (q + 1) + (xcd - r) * q) + off; }
        const int nig = WGM * nN, gid = wgid / nig, fm = gid * WGM, gsz = (nM - fm) < WGM ? (nM - fm) : WGM;
        u.pm = fm + ((wgid % nig) % gsz); u.pn = (wgid % nig) / gsz; return true;
    }
};
struct MoeOrder {
    int npanels, G, vcu; const volatile LAS unsigned char* pexp;
    __device__ bool next(int i, Unit& u) const {
        const int L = i * G + vcu; if (L >= npanels * 8) return false;
        const int p = L >> 3; u.pm = p; u.pn = (int)pexp[p] * 8 + (L & 7); return true;
    }
};
struct EpiU {
    static constexpr bool PERM = true;
    bf16_t* O; float scale;
    __device__ __forceinline__ void operator()(const f32x4 (&acc)[2][2][4][2], const Unit& u, int wr, int wc, int fr, int fq) const {
        const int row0 = u.pm * BM + wr * 64 + fr, col0 = u.pn * BM + wc * 32 + 8 * fq;
#pragma unroll
        for (int ai = 0; ai < 2; ++ai)
#pragma unroll
            for (int m = 0; m < 4; ++m) { bf16_t* rowp = O + (size_t)(row0 + ai * HALF + m * 16) * NU + col0;
#pragma unroll
                for (int bj = 0; bj < 2; ++bj) { const f32x4 v0 = acc[ai][bj][m][0] * scale, v1 = acc[ai][bj][m][1] * scale;
                    u32x4 w; w.x = cvt_pk_bf16(v0[0], v0[1]); w.y = cvt_pk_bf16(v0[2], v0[3]); w.z = cvt_pk_bf16(v1[0], v1[1]); w.w = cvt_pk_bf16(v1[2], v1[3]);
                    *(u32x4*)(rowp + bj * HALF) = w; } }
    }
};
struct EpiWout {
    static constexpr bool PERM = true;
    const float* res_lat; const float* res_ctx; const bf16_t* resb; bf16_t* X; const float* mod;
    __device__ __forceinline__ void operator()(const f32x4 (&acc)[2][2][4][2], const Unit& u, int wr, int wc, int fr, int fq) const {
        const int row0 = u.pm * BM + wr * 64 + fr, col0 = u.pn * BM + wc * 32 + 8 * fq;
        const float* ga = mod + (size_t)modrow_of(u.pm * BM) * 12288 + 2 * D;
        constexpr float sc = WOUT_F8 ? 1.f / 32.f : 1.f;
        f32x4 gv[2][2];
#pragma unroll
        for (int bj = 0; bj < 2; ++bj)
#pragma unroll
            for (int n = 0; n < 2; ++n) gv[bj][n] = *(const f32x4*)(ga + col0 + bj * HALF + n * 4) * sc;
        if (resb) {
#pragma unroll
            for (int ai = 0; ai < 2; ++ai)
#pragma unroll
                for (int m = 0; m < 4; ++m) { const int row = row0 + ai * HALF + m * 16; const bf16_t* rp = resb + (size_t)row * D + col0; bf16_t* xp = X + (size_t)row * D + col0;
#pragma unroll
                    for (int bj = 0; bj < 2; ++bj) { const u32x4 r = *(const u32x4*)(rp + bj * HALF);
                        const f32x4 v0 = (f32x4){bflo(r.x), bfhi(r.x), bflo(r.y), bfhi(r.y)} + gv[bj][0] * acc[ai][bj][m][0], v1 = (f32x4){bflo(r.z), bfhi(r.z), bflo(r.w), bfhi(r.w)} + gv[bj][1] * acc[ai][bj][m][1];
                        u32x4 o; o.x = cvt_pk_bf16(v0[0], v0[1]); o.y = cvt_pk_bf16(v0[2], v0[3]); o.z = cvt_pk_bf16(v1[0], v1[1]); o.w = cvt_pk_bf16(v1[2], v1[3]);
                        *(u32x4*)(xp + bj * HALF) = o; } }
        } else {
#pragma unroll
            for (int ai = 0; ai < 2; ++ai)
#pragma unroll
                for (int m = 0; m < 4; ++m) { const int row = row0 + ai * HALF + m * 16;
                    const float* rp = (row < TL ? res_lat + (size_t)row * D : res_ctx + (size_t)(row - TL) * D) + col0; bf16_t* xp = X + (size_t)row * D + col0;
#pragma unroll
                    for (int bj = 0; bj < 2; ++bj) { const f32x4 r0 = *(const f32x4*)(rp + bj * HALF), r1 = *(const f32x4*)(rp + bj * HALF + 4);
                        const f32x4 v0 = r0 + gv[bj][0] * acc[ai][bj][m][0], v1 = r1 + gv[bj][1] * acc[ai][bj][m][1];
                        u32x4 o; o.x = cvt_pk_bf16(v0[0], v0[1]); o.y = cvt_pk_bf16(v0[2], v0[3]); o.z = cvt_pk_bf16(v1[0], v1[1]); o.w = cvt_pk_bf16(v1[2], v1[3]);
                        *(u32x4*)(xp + bj * HALF) = o; } }
        }
    }
};
struct EpiMoe1 {
    static constexpr bool PERM = true;
    unsigned char* O;
    __device__ __forceinline__ void operator()(const f32x4 (&acc)[2][2][4][2], const Unit& u, int wr, int wc, int fr, int fq) const {
        const int row0 = u.pm * BM + wr * 64 + fr, col0 = (u.pn & 7) * HALF + wc * 32 + 8 * fq;
#pragma unroll
        for (int ai = 0; ai < 2; ++ai)
#pragma unroll
            for (int m = 0; m < 4; ++m) { unsigned char* rowp = O + (size_t)(row0 + ai * HALF + m * 16) * DE + col0; float h[8];
#pragma unroll
                for (int n = 0; n < 2; ++n)
#pragma unroll
                    for (int j = 0; j < 4; ++j) { const float gt = acc[ai][0][m][n][j] * (1.f / 32.f), up = acc[ai][1][m][n][j] * (1.f / 32.f); h[4 * n + j] = gt * __builtin_amdgcn_rcpf(1.f + __expf(-gt)) * up; }
                u32x2 w; w.x = pk4_f8(h[0], h[1], h[2], h[3]); w.y = pk4_f8(h[4], h[5], h[6], h[7]);
                *(u32x2*)rowp = w; }
    }
};
struct EpiMoe2 {
    static constexpr bool PERM = true;
    unsigned char* Y2; const int* rowtok; const float* roww;
    __device__ __forceinline__ void operator()(const f32x4 (&acc)[2][2][4][2], const Unit& u, int wr, int wc, int fr, int fq) const {
        const int row0 = u.pm * BM + wr * 64 + fr, col0 = (u.pn & 7) * BM + wc * 32 + 8 * fq;
#pragma unroll
        for (int ai = 0; ai < 2; ++ai)
#pragma unroll
            for (int m = 0; m < 4; ++m) { asm volatile("" ::: "memory"); const int row = row0 + ai * HALF + m * 16; const int tk = rowtok[row]; const float w = roww[row];
                if (tk >= 0) { unsigned char* rowp = Y2 + ((size_t)(tk >> 30) * TT + (size_t)(tk & 0x3fffffff)) * D + col0;
#pragma unroll
                    for (int bj = 0; bj < 2; ++bj) { const f32x4 v0 = acc[ai][bj][m][0] * w, v1 = acc[ai][bj][m][1] * w;
                        u32x2 o; o.x = pk4_f8(v0[0], v0[1], v0[2], v0[3]); o.y = pk4_f8(v1[0], v1[1], v1[2], v1[3]);
                        *(u32x2*)(rowp + bj * HALF) = o; } } }
    }
};
}

__device__ __forceinline__ void p0_transpose_item(const float* W, int ldw, int srccol0, int k0, bf16_t* dst, int K, LAS float* scr, int lane, bool q = false) {
    { f32x4 v[8];
#pragma unroll
      for (int i = 0; i < 8; ++i) v[i] = *(const f32x4*)(W + (size_t)(k0 + 8 * i + (lane >> 3)) * ldw + srccol0 + 4 * (lane & 7));
#pragma unroll
      for (int i = 0; i < 8; ++i) { LAS float* p = scr + (8 * i + (lane >> 3)) * 33 + 4 * (lane & 7); p[0] = v[i][0]; p[1] = v[i][1]; p[2] = v[i][2]; p[3] = v[i][3]; } }
    LDS_WAIT(); asm volatile("" ::: "memory");
    const int c = lane & 7;
#pragma unroll
    for (int j = 0; j < 4; ++j) { const int n = (lane >> 3) + 8 * j; const LAS float* s = scr + (8 * c) * 33 + n;
        u32x4 o; if (q) { o.x = pk2q(s[0 * 33], s[1 * 33]); o.y = pk2q(s[2 * 33], s[3 * 33]); o.z = pk2q(s[4 * 33], s[5 * 33]); o.w = pk2q(s[6 * 33], s[7 * 33]); }
        else { o.x = pk2(s[0 * 33], s[1 * 33]); o.y = pk2(s[2 * 33], s[3 * 33]); o.z = pk2(s[4 * 33], s[5 * 33]); o.w = pk2(s[6 * 33], s[7 * 33]); }
        *(u32x4*)(dst + (size_t)n * K + k0 + 8 * c) = o; }
    LDS_WAIT(); asm volatile("" ::: "memory");
}
__device__ __forceinline__ void p0_transpose_item8(const float* W, int ldw, int srccol0, int k0, unsigned char* dst, int K, LAS float* scr, int lane) {
    { f32x4 v[8];
#pragma unroll
      for (int i = 0; i < 8; ++i) v[i] = *(const f32x4*)(W + (size_t)(k0 + 8 * i + (lane >> 3)) * ldw + srccol0 + 4 * (lane & 7));
#pragma unroll
      for (int i = 0; i < 8; ++i) { LAS float* p = scr + (8 * i + (lane >> 3)) * 33 + 4 * (lane & 7); p[0] = v[i][0]; p[1] = v[i][1]; p[2] = v[i][2]; p[3] = v[i][3]; } }
    LDS_WAIT(); asm volatile("" ::: "memory");
    const int c = lane & 7;
#pragma unroll
    for (int j = 0; j < 4; ++j) { const int n = (lane >> 3) + 8 * j; const LAS float* s = scr + (8 * c) * 33 + n;
        u32x2 o; o.x = pk4_f8(s[0 * 33] * 32.f, s[1 * 33] * 32.f, s[2 * 33] * 32.f, s[3 * 33] * 32.f); o.y = pk4_f8(s[4 * 33] * 32.f, s[5 * 33] * 32.f, s[6 * 33] * 32.f, s[7 * 33] * 32.f);
        *(u32x2*)(dst + (size_t)n * K + k0 + 8 * c) = o; }
    LDS_WAIT(); asm volatile("" ::: "memory");
}
constexpr int TI_WIN = 32 * 168, TI_WA = 32, TI_WOUT = 32 * 64, TI_GU = 32 * 64, TI_DN = 16 * 64;
constexpr int TI_L = TI_WIN + TI_WA + TI_WOUT;
constexpr int TI_TOTAL = 2 * TI_L + 32 * TI_GU + 32 * TI_DN;
__device__ __forceinline__ void p0_item(KP Pk, Frame& F, int it, LAS float* scr) {
    unsigned char* ws = F.ws;
    if (it < 2 * TI_L) { const int l = it / TI_L; int r = it % TI_L;
        if (r < TI_WIN) { const int kb = r / 168, nb = r % 168, n0 = 32 * nb;
            if (WIN_F8_L(l)) p0_transpose_item8(Pk->in[I_WIN] + (size_t)l * D * DIN, DIN, n0 < 1536 ? n0 : n0 + 32, 64 * kb, ws + WS_WIN + (size_t)l * NU * D * 2 + (size_t)n0 * D, D, scr, F.lane);
            else p0_transpose_item(Pk->in[I_WIN] + (size_t)l * D * DIN, DIN, n0 < 1536 ? n0 : n0 + 32, 64 * kb, (bf16_t*)(ws + WS_WIN) + ((size_t)l * NU + n0) * D, D, scr, F.lane); return; }
        r -= TI_WIN;
        if (r < TI_WA) { if (WIN_F8_L(l)) p0_transpose_item8(Pk->in[I_WIN] + (size_t)l * D * DIN, DIN, 1536, 64 * r, ws + WS_WA + (size_t)l * 32 * D * 2, D, scr, F.lane);
            else p0_transpose_item(Pk->in[I_WIN] + (size_t)l * D * DIN, DIN, 1536, 64 * r, (bf16_t*)(ws + WS_WA) + (size_t)l * 32 * D, D, scr, F.lane); return; }
        r -= TI_WA;
        { const int kb = r / 64, nb = r % 64;
          if (WOUT_F8) p0_transpose_item8(Pk->in[I_WOUT] + (size_t)l * D * D, D, 32 * nb, 64 * kb, ws + WS_WOUT + ((size_t)l * D + 32 * nb) * D, D, scr, F.lane);
          else p0_transpose_item(Pk->in[I_WOUT] + (size_t)l * D * D, D, 32 * nb, 64 * kb, (bf16_t*)(ws + WS_WOUT) + ((size_t)l * D + 32 * nb) * D, D, scr, F.lane); return; }
    }
    it -= 2 * TI_L;
    if (it < 32 * TI_GU) { const int le = it / TI_GU, r = it % TI_GU, kb = r / 64, nb = r % 64, n0 = 32 * nb, j = n0 >> 8, half = (n0 >> 7) & 1, c0 = 128 * j + (n0 & 127);
        p0_transpose_item8((half ? Pk->in[I_EU] : Pk->in[I_EG]) + (size_t)le * D * DE, DE, c0, 64 * kb, ws + WS_WGU + ((size_t)le * 2048 + n0) * D, D, scr, F.lane); return; }
    it -= 32 * TI_GU;
    { const int le = it / TI_DN, r = it % TI_DN, kb = r / 64, nb = r % 64;
        p0_transpose_item8(Pk->in[I_ED] + (size_t)le * DE * D, D, 32 * nb, 64 * kb, ws + WS_WD + ((size_t)le * D + 32 * nb) * DE, DE, scr, F.lane); }
}
constexpr size_t WS_APART = WS_HB;
__device__ __forceinline__ void ada_unit(KP Pk, Frame& F, int u) {
    unsigned char* ws = F.ws;
    __syncthreads();
    LAS float* sc = (LAS float*)F.lds;
    LAS f32x4* red = (LAS f32x4*)(F.lds + 9 * 128 * 4);
    const int l = u / 192, v = u % 192, cb = v % 12, kb = v / 12;
    for (int i = F.tid; i < 9 * 128; i += NTHR) { const int r = i >> 7, k = kb * 128 + (i & 127); const float x = r < 8 ? Pk->in[I_C][r * 2048 + k] : Pk->in[I_CCTX][k]; sc[i] = silu_f(x); }
    __syncthreads();
    const int c4 = F.tid & 255, kh = F.wave >> 2;
    const f32x4* W = (const f32x4*)(Pk->in[I_ADAW] + (size_t)l * D * 12288 + (size_t)(kb * 128 + kh * 64) * 12288 + cb * 1024) + c4;
    f32x4 a[9];
#pragma unroll
    for (int r = 0; r < 9; ++r) a[r] = (f32x4){0.f, 0.f, 0.f, 0.f};
#pragma unroll 1
    for (int k0 = 0; k0 < 64; k0 += 16) {
        f32x4 w[16];
#pragma unroll
        for (int q = 0; q < 16; ++q) w[q] = W[(size_t)(k0 + q) * 3072];
#pragma unroll
        for (int q = 0; q < 16; ++q) {
#pragma unroll
            for (int r = 0; r < 9; ++r) a[r] += w[q] * sc[r * 128 + kh * 64 + k0 + q];
            if ((q & 3) == 3) __builtin_amdgcn_sched_barrier(0); }
    }
    if (kh == 1) {
#pragma unroll
        for (int r = 0; r < 9; ++r) red[r * 256 + c4] = a[r]; }
    __syncthreads();
    float* part = (float*)(ws + WS_APART);
    if (kh == 0) {
#pragma unroll
        for (int r = 0; r < 9; ++r) *(f32x4*)(part + ((size_t)((l * 16 + kb) * 9 + r)) * 12288 + cb * 1024 + 4 * c4) = a[r] + red[r * 256 + c4]; }
    VM_WAIT();
    __syncthreads();
    if (F.tid == 0) { __builtin_amdgcn_fence(__ATOMIC_RELEASE, "agent"); F.MISC[1] = __hip_atomic_fetch_add(F.ctl + CW_ADAC + l * 12 + cb, 1u, __ATOMIC_RELAXED, __HIP_MEMORY_SCOPE_AGENT); }
    __syncthreads();
    if ((F.MISC[1] & 15u) == 15u) {
        __builtin_amdgcn_fence(__ATOMIC_ACQUIRE, "agent");
        for (int i = F.tid; i < 9 * 256; i += NTHR) { const int r = i >> 8, cc = i & 255;
            f32x4 sum = *(const f32x4*)(Pk->in[I_ADAB] + l * 12288 + cb * 1024 + 4 * cc), pv[16];
#pragma unroll
            for (int k2 = 0; k2 < 16; ++k2) pv[k2] = *(const f32x4*)(part + ((size_t)((l * 16 + k2) * 9 + r)) * 12288 + cb * 1024 + 4 * cc);
#pragma unroll
            for (int k2 = 0; k2 < 16; ++k2) sum += pv[k2];
            *(f32x4*)((float*)(ws + WS_MOD) + ((size_t)l * 9 + r) * 12288 + cb * 1024 + 4 * cc) = sum; } }
    __syncthreads();
}
__device__ __forceinline__ void wait_ctr(Frame& F, int word, unsigned target) {
    if (F.tid == 0) { while (__hip_atomic_load(F.ctl + word, __ATOMIC_RELAXED, __HIP_MEMORY_SCOPE_AGENT) < target) __builtin_amdgcn_s_sleep(2); }
    __syncthreads();
    __builtin_amdgcn_fence(__ATOMIC_ACQUIRE, "agent");
}
__device__ __forceinline__ void ph_hyena_filters(KP Pk, Frame& F, int u);
constexpr int P0_NCV = (TI_WIN + TI_WA + 31) / 32, P0_U_ADA = 0, P0_U_CV = P0_U_ADA + 192, P0_UNITS = P0_U_CV + P0_NCV;
__device__ __forceinline__ void p0_prologue(KP Pk, Frame& F, int rep) {
    unsigned char* ws = F.ws;
    const int gw = F.vcu * NWAVES + F.wave, NGW = F.G * NWAVES;
    for (int it = gw; it < 2 * 2304; it += NGW) { const int l = it / 2304, tt = it % 2304, L = tt < 2048 ? 2048 : 256, t = tt < 2048 ? tt : tt - 2048;
        const float tn = (float)t / (float)(L - 1), wv = (6.283185307179586f / (float)L) * (float)t;
        const float* w1 = Pk->in[I_HW1] + l * 33 * 64; const float* w2 = Pk->in[I_HW2] + l * 64 * 64;
        float zv = 0.f;
        if (F.lane == 0) zv = tn; else if (F.lane < 33) { const int bi = (F.lane - 1) & 15; const float band = 1e-4f + (float)bi * ((15.f - 1e-4f) / 15.f); zv = F.lane < 17 ? cosf(wv * band) : -sinf(wv * band); }
        float s = Pk->in[I_HB1][l * 64 + F.lane];
#pragma unroll
        for (int i = 0; i < 33; ++i) s += __shfl(zv, i) * w1[i * 64 + F.lane];
        const float h1 = sinf(Pk->in[I_HFR][(l * 2 + 0) * 64 + F.lane] * s);
        float s2 = Pk->in[I_HB2][l * 64 + F.lane];
#pragma unroll 16
        for (int i = 0; i < 64; ++i) s2 += __shfl(h1, i) * w2[i * 64 + F.lane];
        ((float*)(ws + WS_HYH2))[(size_t)it * 64 + F.lane] = sinf(Pk->in[I_HFR][(l * 2 + 1) * 64 + F.lane] * s2);
    }
    VM_WAIT();
    __syncthreads();
    if (F.tid == 0) { __builtin_amdgcn_fence(__ATOMIC_RELEASE, "agent"); __hip_atomic_fetch_add(F.ctl + CW_HYC, 1u, __ATOMIC_RELAXED, __HIP_MEMORY_SCOPE_AGENT); }
    for (int i = blockIdx.x * NTHR + F.tid; i < SEQ * 64; i += F.G * NTHR) { const int t = i >> 6, j = i & 63, q = j >> 4, f = j & 15;
        const float inv = exp2f(-(float)f * (13.287712379549449f / 16.f)); const float pos = (float)(q < 2 ? (t >> 6) : (t & 63)); const float ang = pos * inv;
        ((float*)(ws + WS_ROPE))[i] = (q & 1) ? sinf(ang) : cosf(ang); }
    if (PROBE_T & (1u << 24)) { F.pt += __builtin_amdgcn_s_memrealtime() - F.pt0; }
    for (;;) {
        const int u = wg_grab(F, rep ? 5 : 0); if (u >= P0_UNITS) break;
        const int ut_ = u < P0_U_ADA ? 10 : u < P0_U_CV ? 11 : 12; const unsigned long long ut0_ = (PROBE_UT >= 0) ? __builtin_amdgcn_s_memrealtime() : 0ull;
        if (u < P0_U_CV) ada_unit(Pk, F, u - P0_U_ADA);
        else { LAS float* scr = (LAS float*)(F.lds + F.wave * 8704);
            for (int j = 0; j < 4; ++j) { const int it = (u - P0_U_CV) * 32 + F.wave * 4 + j; if (it < TI_WIN + TI_WA) p0_item(Pk, F, it, scr); } }
        if (PROBE_UT >= 0 && ut_ == PROBE_UT && !F.pt_done) { __syncthreads(); F.pt += __builtin_amdgcn_s_memrealtime() - ut0_; F.pt_done = 1; }
    }
}

#define MFMA16(a, b, c) __builtin_amdgcn_mfma_f32_16x16x32_bf16((a), (b), (c), 0, 0, 0)
#define MFMA32(a, b, c) __builtin_amdgcn_mfma_f32_32x32x16_bf16((a), (b), (c), 0, 0, 0)
__device__ __forceinline__ void load_row(const float* p, int lane, f32x4 (&v)[8]) {
#pragma unroll
    for (int j = 0; j < 8; ++j) v[j] = ((const f32x4*)p)[lane + 64 * j];
}
__device__ __forceinline__ void load_row_bf16(const bf16_t* p, int lane, f32x4 (&v)[8]) {
#pragma unroll
    for (int j = 0; j < 8; ++j) { const u32x2 a = ((const u32x2*)p)[lane + 64 * j]; v[j] = (f32x4){bflo(a.x), bfhi(a.x), bflo(a.y), bfhi(a.y)}; }
}
__device__ __forceinline__ void add_y2(const unsigned char* y0, const unsigned char* y1, const float* gf, int lane, f32x4 (&v)[8]) {
#pragma unroll
    for (int j = 0; j < 8; ++j) { const unsigned a = ((const unsigned*)y0)[lane + 64 * j], b = ((const unsigned*)y1)[lane + 64 * j]; const f32x4 g = ((const f32x4*)gf)[lane + 64 * j] * (1.f / 32.f);
        const f32x2 a0 = __builtin_amdgcn_cvt_pk_f32_fp8(a, false), a1 = __builtin_amdgcn_cvt_pk_f32_fp8(a, true), b0 = __builtin_amdgcn_cvt_pk_f32_fp8(b, false), b1 = __builtin_amdgcn_cvt_pk_f32_fp8(b, true);
        v[j][0] += g[0] * (a0[0] + b0[0]); v[j][1] += g[1] * (a0[1] + b0[1]); v[j][2] += g[2] * (a1[0] + b1[0]); v[j][3] += g[3] * (a1[1] + b1[1]); }
}
__device__ __forceinline__ float row_rstd(const f32x4 (&v)[8]) {
    float s = 0.f;
#pragma unroll
    for (int j = 0; j < 8; ++j) s += (v[j][0] * v[j][0] + v[j][1] * v[j][1]) + (v[j][2] * v[j][2] + v[j][3] * v[j][3]);
    return rsqrtf(wave_sum(s) * (1.f / D) + NORM_EPS);
}
__device__ __forceinline__ void modulate(f32x4 (&v)[8], float rstd, const float* nw, const float* sh, const float* sc, int lane) {
#pragma unroll
    for (int j = 0; j < 8; ++j) { const f32x4 w = ((const f32x4*)nw)[lane + 64 * j], a = ((const f32x4*)sc)[lane + 64 * j], b = ((const f32x4*)sh)[lane + 64 * j];
        v[j] = v[j] * rstd * w * (a + 1.f) + b; }
}
__device__ __forceinline__ void store_row_bf16(bf16_t* o, int lane, const f32x4 (&v)[8], bool q = false) {
#pragma unroll
    for (int j = 0; j < 8; ++j) { u32x2 w; if (q) { w.x = pk2q(v[j][0], v[j][1]); w.y = pk2q(v[j][2], v[j][3]); } else { w.x = pk2(v[j][0], v[j][1]); w.y = pk2(v[j][2], v[j][3]); } ((u32x2*)o)[lane + 64 * j] = w; }
}
__device__ __forceinline__ void store_row_f8(unsigned char* o, int lane, const f32x4 (&v)[8]) {
#pragma unroll
    for (int j = 0; j < 8; ++j) ((unsigned*)o)[lane + 64 * j] = pk4_f8(v[j][0], v[j][1], v[j][2], v[j][3]);
}
__device__ __forceinline__ void ph_norm1(KP Pk, Frame& F, int l) {
    unsigned char* ws = F.ws;
    const int gw = F.vcu * NWAVES + F.wave, NGW = F.G * NWAVES;
    const float* mod = (const float*)(ws + WS_MOD) + (size_t)l * 9 * 12288;
    bf16_t* X = (bf16_t*)(ws + WS_X); bf16_t* H = (bf16_t*)(ws + WS_H); const unsigned char* Y2 = ws + WS_Y2;
    const bool uneven = l == 0 && F.G == 256; const int bx = (int)blockIdx.x;
    const int rfirst = uneven ? (bx < 128 ? bx * 36 : 4608 + (bx - 128) * 108) + F.wave : gw, rend = uneven ? (bx < 128 ? bx * 36 + 36 : 4608 + (bx - 128) * 108 + 108) : TT, rstep = uneven ? NWAVES : NGW;
    for (int row = rfirst; row < rend; row += rstep) {
        const int r = modrow_of(row); f32x4 v[8];
        if (l == 0) load_row(row < TL ? Pk->in[I_X] + (size_t)row * D : Pk->in[I_CTX] + (size_t)(row - TL) * D, F.lane, v);
        else { load_row_bf16(X + (size_t)row * D, F.lane, v);
            add_y2(Y2 + (size_t)row * D, Y2 + ((size_t)TT + row) * D, (const float*)(ws + WS_MOD) + (size_t)r * 12288 + 5 * D, F.lane, v);
            if (row < TL) store_row_bf16(X + (size_t)row * D, F.lane, v); }
        const float rstd = row_rstd(v);
        modulate(v, rstd, Pk->in[I_N1W] + l * D, mod + (size_t)r * 12288, mod + (size_t)r * 12288 + D, F.lane);
        if (WIN_F8_L(l)) store_row_f8(ws + WS_H + (size_t)row * D, F.lane, v); else store_row_bf16(H + (size_t)row * D, F.lane, v);
    }
}
__device__ __forceinline__ void ph_hyena_filters(KP Pk, Frame& F, int u) {
    unsigned char* ws = F.ws;
    constexpr int HRS = 2052;
    LAS float* HR = (LAS float*)F.lds; LAS float* red = (LAS float*)(F.lds + 16 * HRS * 4);
    const int r16 = F.lane & 15, kg = F.lane >> 4;
    {
        const int lf = u >> 7, cg = u & 127, chl = r16 & 3, od = r16 >> 2, ch = cg * 4 + chl;
        const float* w3 = Pk->in[I_HW3] + (size_t)lf * 64 * 2048 + (od >> 1) * 1024 + (od & 1) * 512 + ch;
        bf16x8 wb[2];
#pragma unroll
        for (int ks = 0; ks < 2; ++ks) { float w[8];
#pragma unroll
            for (int j = 0; j < 8; ++j) w[j] = w3[(size_t)(32 * ks + 8 * kg + j) * 2048];
            u32x4 p; p.x = pk2(w[0], w[1]); p.y = pk2(w[2], w[3]); p.z = pk2(w[4], w[5]); p.w = pk2(w[6], w[7]); wb[ks] = __builtin_bit_cast(bf16x8, p); }
        const float dmin = 3.0701134573253940f, dmax = 15.350567286626972f, delta = dmin + (float)ch * ((dmax - dmin) / 511.f);
#pragma unroll 1
        for (int sel = 0; sel < 2; ++sel) {
            const int L = sel == 0 ? 2048 : 256; const float* h2 = (const float*)(ws + WS_HYH2) + ((size_t)lf * 2304 + (sel == 0 ? 0 : 2048)) * 64; const float rl = 1.f / (float)(L - 1);
            __syncthreads();
            float s = 0.f;
#pragma unroll 2
            for (int tile = F.wave; tile < L / 16; tile += NWAVES) {
                const f32x4* hp = (const f32x4*)(h2 + (size_t)(16 * tile + r16) * 64 + 8 * kg);
                const f32x4 a0 = hp[0], a1 = hp[1], a2 = hp[8], a3 = hp[9];
                u32x4 p0, p1; p0.x = pk2(a0[0], a0[1]); p0.y = pk2(a0[2], a0[3]); p0.z = pk2(a1[0], a1[1]); p0.w = pk2(a1[2], a1[3]); p1.x = pk2(a2[0], a2[1]); p1.y = pk2(a2[2], a2[3]); p1.z = pk2(a3[0], a3[1]); p1.w = pk2(a3[2], a3[3]);
                f32x4 d = MFMA16(__builtin_bit_cast(bf16x8, p0), wb[0], ((f32x4){0.f, 0.f, 0.f, 0.f})); d = MFMA16(__builtin_bit_cast(bf16x8, p1), wb[1], d);
                const int t0 = 16 * tile + 4 * kg;
#pragma unroll
                for (int i = 0; i < 4; ++i) { d[i] *= expf(-(float)(t0 + i) * rl * delta); s += fabsf(d[i]); }
                *(LAS f32x4*)(HR + r16 * HRS + t0) = d; }
            s += __shfl_xor(s, 16); s += __shfl_xor(s, 32);
            if (F.lane < 16) red[F.wave * 16 + F.lane] = s;
            __syncthreads();
            for (int e = F.tid; e < 16 * L; e += NTHR) { const int col = e / L, t = e % L, dir = (col >> 2) & 1, o = col >> 3, c = cg * 4 + (col & 3);
                float tot = 0.f;
#pragma unroll
                for (int w = 0; w < 8; ++w) tot += red[w * 16 + (col & ~4)] + red[w * 16 + (col | 4)];
                float hv = HR[col * HRS + t] / tot; int idx = dir == 0 ? L - t : L + t;
                if (dir == 1 && t == 0) { idx = 0; hv = 0.f; }
                ((bf16_t*)(ws + WS_HYF) + ((size_t)lf * 1024 + o * 512 + c) * 4608)[(sel == 0 ? 0 : 4096) + idx] = (bf16_t)f2bf(hv); }
        }
    }
}
__device__ __forceinline__ void ph_norm2_router(KP Pk, Frame& F, int l, int rep) {
    unsigned char* ws = F.ws;
    const int gw = F.vcu * NWAVES + F.wave, NGW = F.G * NWAVES, nrows = l == 0 ? TT : TL;
    const float* mod = (const float*)(ws + WS_MOD) + (size_t)l * 9 * 12288;
    const bf16_t* X = (const bf16_t*)(ws + WS_X); unsigned char* Fo = ws + WS_H;
    LAS float* rw = (LAS float*)F.lds;
    volatile LAS unsigned* lcnt = F.MISC + 16;
    if (F.tid < 16) lcnt[F.tid] = 0u;
    for (int i = F.tid; i < 2048 * 4; i += NTHR) { const f32x4 w = ((const f32x4*)Pk->in[I_RW])[i]; const int k = i >> 2, e0 = (i & 3) * 4;
        rw[(e0 + 0) * 2048 + k] = w[0]; rw[(e0 + 1) * 2048 + k] = w[1]; rw[(e0 + 2) * 2048 + k] = w[2]; rw[(e0 + 3) * 2048 + k] = w[3]; }
    __syncthreads();
    float rb[16];
#pragma unroll
    for (int e = 0; e < 16; ++e) rb[e] = Pk->in[I_RB][e];
    for (int rowA = gw; rowA < nrows; rowA += 2 * NGW) {
        const bool hasB = rowA + NGW < nrows; const int rowB = hasB ? rowA + NGW : rowA;
        f32x4 va[8], vb[8];
        load_row_bf16(X + (size_t)rowA * D, F.lane, va); load_row_bf16(X + (size_t)rowB * D, F.lane, vb);
        { const int r = modrow_of(rowA); const float rstd = row_rstd(va); modulate(va, rstd, Pk->in[I_N2W] + l * D, mod + (size_t)r * 12288 + 3 * D, mod + (size_t)r * 12288 + 4 * D, F.lane); store_row_f8(Fo + (size_t)rowA * D, F.lane, va); }
        { const int r = modrow_of(rowB); const float rstd = row_rstd(vb); modulate(vb, rstd, Pk->in[I_N2W] + l * D, mod + (size_t)r * 12288 + 3 * D, mod + (size_t)r * 12288 + 4 * D, F.lane); if (hasB) store_row_f8(Fo + (size_t)rowB * D, F.lane, vb); }
        float pa[32];
#pragma unroll
        for (int e = 0; e < 16; ++e) { f32x2 a = {0.f, 0.f}, b = {0.f, 0.f};
#pragma unroll
            for (int j = 0; j < 8; ++j) { const f32x4 w = ((const LAS f32x4*)(rw + e * 2048))[F.lane + 64 * j];
                const f32x2 wl = __builtin_shufflevector(w, w, 0, 1), wh = __builtin_shufflevector(w, w, 2, 3);
                a = __builtin_elementwise_fma(__builtin_shufflevector(va[j], va[j], 0, 1), wl, a); a = __builtin_elementwise_fma(__builtin_shufflevector(va[j], va[j], 2, 3), wh, a);
                b = __builtin_elementwise_fma(__builtin_shufflevector(vb[j], vb[j], 0, 1), wl, b); b = __builtin_elementwise_fma(__builtin_shufflevector(vb[j], vb[j], 2, 3), wh, b); }
            pa[e] = a[0] + a[1]; pa[16 + e] = b[0] + b[1]; }
#define RB_STEP(N, BIT) { const bool up = (F.lane & (BIT)) != 0; _Pragma("unroll") for (int k = 0; k < (N); ++k) { const float keep = up ? pa[(N) + k] : pa[k], send = up ? pa[k] : pa[(N) + k]; pa[k] = keep + __shfl_xor(send, (BIT)); } }
        RB_STEP(16, 32) RB_STEP(8, 16) RB_STEP(4, 8) RB_STEP(2, 4) RB_STEP(1, 2)
#undef RB_STEP
        const float red = pa[0] + __shfl_xor(pa[0], 1);
        float lg[16];
#pragma unroll
        for (int e = 0; e < 16; ++e) lg[e] = __shfl(red, (F.lane & 32) + 2 * e);
        float mx = lg[0];
#pragma unroll
        for (int e = 1; e < 16; ++e) mx = fmaxf(mx, lg[e]);
        float sum = 0.f;
#pragma unroll
        for (int e = 0; e < 16; ++e) { lg[e] = expf(lg[e] - mx); sum += lg[e]; }
        const float rs = 1.f / sum; float sel[16];
#pragma unroll
        for (int e = 0; e < 16; ++e) { lg[e] *= rs; sel[e] = lg[e] + rb[e]; }
        int grp = 0; float gbest = fmaxf(fmaxf(sel[0], sel[1]), fmaxf(sel[2], sel[3]));
#pragma unroll
        for (int g = 1; g < 4; ++g) { const float gm = fmaxf(fmaxf(sel[4 * g], sel[4 * g + 1]), fmaxf(sel[4 * g + 2], sel[4 * g + 3])); if (gm > gbest) { gbest = gm; grp = g; } }
        float s4[4], p4[4];
#pragma unroll
        for (int i = 0; i < 4; ++i) { s4[i] = grp == 0 ? sel[i] : grp == 1 ? sel[4 + i] : grp == 2 ? sel[8 + i] : sel[12 + i]; p4[i] = grp == 0 ? lg[i] : grp == 1 ? lg[4 + i] : grp == 2 ? lg[8 + i] : lg[12 + i]; }
        int i0 = 0; float b0 = s4[0];
#pragma unroll
        for (int i = 1; i < 4; ++i) if (s4[i] > b0) { b0 = s4[i]; i0 = i; }
        int i1 = -1; float b1 = 0.f;
#pragma unroll
        for (int i = 0; i < 4; ++i) if (i != i0 && (i1 < 0 || s4[i] > b1)) { b1 = s4[i]; i1 = i; }
        const float p0 = i0 == 0 ? p4[0] : i0 == 1 ? p4[1] : i0 == 2 ? p4[2] : p4[3], p1 = i1 == 0 ? p4[0] : i1 == 1 ? p4[1] : i1 == 2 ? p4[2] : p4[3];
        const int e0 = grp * 4 + i0, e1 = grp * 4 + i1; const float ws_ = 1.f / (p0 + p1);
        if (F.lane == 0 || (F.lane == 32 && hasB)) { const int row = F.lane == 0 ? rowA : rowB;
            ((int*)(ws + WS_RT + RT_E))[row] = e0 | (e1 << 8); ((f32x2*)(ws + WS_RT + RT_W))[row] = (f32x2){p0 * ws_, p1 * ws_};
            __hip_atomic_fetch_add((LAS unsigned*)&lcnt[e0], 1u, __ATOMIC_RELAXED, __HIP_MEMORY_SCOPE_WORKGROUP); __hip_atomic_fetch_add((LAS unsigned*)&lcnt[e1], 1u, __ATOMIC_RELAXED, __HIP_MEMORY_SCOPE_WORKGROUP); }
    }
    __syncthreads();
    { int t_; asm volatile("v_mbcnt_lo_u32_b32 %0, -1, 0\n\tv_mbcnt_hi_u32_b32 %0, -1, %0" : "=v"(t_)); t_ += F.wave * 64;
      if (t_ < 16 && lcnt[t_]) __hip_atomic_fetch_add(F.ctl + CW_CNT + 64 * (l + 2 * rep) + t_, lcnt[t_], __ATOMIC_RELAXED, __HIP_MEMORY_SCOPE_AGENT); }
}
__device__ __forceinline__ int moe_table(Frame& F, int l) {
    volatile LAS unsigned char* pexp = (volatile LAS unsigned char*)(F.MISC + 64);
    __syncthreads();
    if (F.tid < 64) {
        const int e = F.lane & 15; const int c = (int)__hip_atomic_load(F.ctl + CW_CNT + 64 * l + e, __ATOMIC_RELAXED, __HIP_MEMORY_SCOPE_AGENT);
        const int np = (c + 255) >> 8; int p0 = np;
#pragma unroll
        for (int d = 1; d < 16; d <<= 1) { const int y = __shfl(p0, F.lane - d); if (e >= d) p0 += y; }
        const int tot = __shfl(p0, 15); p0 -= np;
        if (F.lane < 16) { F.MISC[32 + e] = (unsigned)(p0 * 256); for (int j = 0; j < np; ++j) pexp[p0 + j] = (unsigned char)e; if (e == 0) F.MISC[2] = (unsigned)tot; }
    }
    __syncthreads();
    return (int)F.MISC[2];
}
__device__ __forceinline__ void ph_slots(KP Pk, Frame& F, int l) {
    unsigned char* ws = F.ws;
    const int nrows = l == 0 ? TT : TL, per = (nrows + F.G - 1) / F.G, t0 = blockIdx.x * per, t1 = min(nrows, t0 + per);
    (void)moe_table(F, l);
    volatile LAS unsigned* lcnt = F.MISC + 16; volatile LAS unsigned* lbase = F.MISC + 48;
    if (F.tid < 16) lcnt[F.tid] = 0u;
    __syncthreads();
    const int* RE = (const int*)(ws + WS_RT + RT_E); const f32x2* RW = (const f32x2*)(ws + WS_RT + RT_W);
    int* ROWTOK = (int*)(ws + WS_RT + RT_ROWTOK); float* ROWW = (float*)(ws + WS_RT + RT_ROWW);
    const int tok = t0 + F.tid; int e0 = 0, e1 = 0; unsigned q0 = 0, q1 = 0;
    if (tok < t1) { const int ee = RE[tok]; e0 = ee & 255; e1 = ee >> 8;
        q0 = __hip_atomic_fetch_add((LAS unsigned*)&lcnt[e0], 1u, __ATOMIC_RELAXED, __HIP_MEMORY_SCOPE_WORKGROUP); q1 = __hip_atomic_fetch_add((LAS unsigned*)&lcnt[e1], 1u, __ATOMIC_RELAXED, __HIP_MEMORY_SCOPE_WORKGROUP); }
    __syncthreads();
    if (F.tid < 16) lbase[F.tid] = lcnt[F.tid] ? __hip_atomic_fetch_add(F.ctl + CW_CUR + 64 * l + F.tid, lcnt[F.tid], __ATOMIC_RELAXED, __HIP_MEMORY_SCOPE_AGENT) : 0u;
    __syncthreads();
    if (tok < t1) { const f32x2 w = RW[tok]; const int r0 = (int)(F.MISC[32 + e0] + lbase[e0] + q0), r1 = (int)(F.MISC[32 + e1] + lbase[e1] + q1);
        ROWTOK[r0] = tok; ROWW[r0] = w.x; ROWTOK[r1] = tok | (1 << 30); ROWW[r1] = w.y; }
    if (blockIdx.x < NE) { const int e = blockIdx.x, c = (int)__hip_atomic_load(F.ctl + CW_CNT + 64 * l + e, __ATOMIC_RELAXED, __HIP_MEMORY_SCOPE_AGENT), base = (int)F.MISC[32 + e];
        for (int i = c + F.tid; i < ((c + 255) & ~255); i += NTHR) { ROWTOK[base + i] = -1; ROWW[base + i] = 0.f; } }
}
__device__ __forceinline__ void ph_final(KP Pk, Frame& F) {
    unsigned char* ws = F.ws;
    const int gw = F.vcu * NWAVES + F.wave, NGW = F.G * NWAVES;
    const bf16_t* X = (const bf16_t*)(ws + WS_X); const unsigned char* Y2 = ws + WS_Y2;
    for (int row = gw; row < TL; row += NGW) { f32x4 v[8];
        load_row_bf16(X + (size_t)row * D, F.lane, v);
        add_y2(Y2 + (size_t)row * D, Y2 + ((size_t)TT + row) * D, (const float*)(ws + WS_MOD) + ((size_t)9 + (row >> 11)) * 12288 + 5 * D, F.lane, v);
#pragma unroll
        for (int j = 0; j < 8; ++j) ((f32x4*)(Pk->out + (size_t)row * D))[F.lane + 64 * j] = v[j]; }
}

__device__ __forceinline__ void ph_gate_cols(Frame& F, int l) {
    unsigned char* ws = F.ws;
    const int r32 = F.lane & 31, hi = F.lane >> 5;
    const bf16_t* H = (const bf16_t*)(ws + WS_H); const bf16_t* Wa = (const bf16_t*)(ws + WS_WA) + (size_t)l * 32 * D; float* AG = (float*)(ws + WS_AG);
    LAS unsigned char* tile = F.lds + F.wave * 16896;
    LAS float* red = (LAS float*)F.lds;
    for (int it = blockIdx.x; it < TT / 32; it += F.G) {
        const int kb = F.wave * 256;
        u32x4 av[16]; bf16x8 bv[16];
#pragma unroll
        for (int i = 0; i < 16; ++i) { const int id = F.lane + 64 * i; av[i] = *(const u32x4*)(H + (size_t)(it * 32 + (id >> 5)) * D + kb + 8 * (id & 31)); }
#pragma unroll
        for (int ks = 0; ks < 16; ++ks) bv[ks] = *(const bf16x8*)(Wa + (size_t)r32 * D + kb + 16 * ks + 8 * hi);
        __syncthreads();
#pragma unroll
        for (int i = 0; i < 16; ++i) { const int id = F.lane + 64 * i; *(LAS u32x4*)(tile + ((id >> 5) * 264 + 8 * (id & 31)) * 2) = av[i]; }
        f32x16 acc = {};
#pragma unroll
        for (int ks = 0; ks < 16; ++ks) { const bf16x8 a = *(const LAS bf16x8*)(tile + (r32 * 264 + 16 * ks + 8 * hi) * 2); acc = MFMA32(a, bv[ks], acc); }
        __syncthreads();
#pragma unroll
        for (int r = 0; r < 16; ++r) red[(F.wave * 16 + r) * 64 + F.lane] = acc[r];
        __syncthreads();
        for (int e = F.tid; e < 1024; e += NTHR) { float sum = 0.f;
#pragma unroll
            for (int w = 0; w < 8; ++w) sum += red[w * 1024 + e];
            const int r = e >> 6, ln = e & 63; AG[(size_t)(it * 32 + (r & 3) + 8 * (r >> 2) + 4 * (ln >> 5)) * 32 + (ln & 31)] = sum; }
    }
}

__device__ __forceinline__ void ph_gate_cols8(Frame& F, int l) {
    unsigned char* ws = F.ws;
    const int fr = F.lane & 15, fq = F.lane >> 4, kb = F.wave * 256;
    const unsigned char* H8 = ws + WS_H; const unsigned char* Wa8 = ws + WS_WA + (size_t)l * 32 * D * 2; float* AG = (float*)(ws + WS_AG);
    LAS f32x4* red = (LAS f32x4*)F.lds;
    int f8scale = 0x7f7f7f7f; asm volatile("" : "+v"(f8scale));
    i32x8 b[2][2], a[2][2];
#pragma unroll
    for (int ch = 0; ch < 2; ++ch)
#pragma unroll
        for (int ks = 0; ks < 2; ++ks) b[ch][ks] = *(const i32x8*)(Wa8 + (size_t)(16 * ch + fr) * D + kb + 128 * ks + 32 * fq);
    int it = blockIdx.x;
    if (it < TT / 32) {
#pragma unroll
        for (int rh = 0; rh < 2; ++rh)
#pragma unroll
            for (int ks = 0; ks < 2; ++ks) a[rh][ks] = *(const i32x8*)(H8 + (size_t)(it * 32 + 16 * rh + fr) * D + kb + 128 * ks + 32 * fq); }
    for (; it < TT / 32; it += F.G) {
        f32x4 acc[2][2];
#pragma unroll
        for (int rh = 0; rh < 2; ++rh)
#pragma unroll
            for (int ch = 0; ch < 2; ++ch) acc[rh][ch] = (f32x4){0.f, 0.f, 0.f, 0.f};
#pragma unroll
        for (int ks = 0; ks < 2; ++ks)
#pragma unroll
            for (int rh = 0; rh < 2; ++rh)
#pragma unroll
                for (int ch = 0; ch < 2; ++ch)
                    asm volatile("v_mfma_scale_f32_16x16x128_f8f6f4 %0, %1, %2, %0, %3, %3 op_sel_hi:[0,0,0]" : "+v"(acc[rh][ch]) : "v"(b[ch][ks]), "v"(a[rh][ks]), "v"(f8scale));
        asm volatile("s_nop 15\n\ts_nop 15" : "+v"(acc[0][0]), "+v"(acc[0][1]), "+v"(acc[1][0]), "+v"(acc[1][1]) :: "memory");
        const int nx = it + F.G;
        if (nx < TT / 32) {
#pragma unroll
            for (int rh = 0; rh < 2; ++rh)
#pragma unroll
                for (int ks = 0; ks < 2; ++ks) a[rh][ks] = *(const i32x8*)(H8 + (size_t)(nx * 32 + 16 * rh + fr) * D + kb + 128 * ks + 32 * fq); }
        __syncthreads();
#pragma unroll
        for (int rh = 0; rh < 2; ++rh)
#pragma unroll
            for (int ch = 0; ch < 2; ++ch) red[(F.wave * 4 + rh * 2 + ch) * 64 + F.lane] = acc[rh][ch];
        __syncthreads();
        for (int e = F.tid; e < 1024; e += NTHR) { float sum = 0.f;
#pragma unroll
            for (int w = 0; w < 8; ++w) sum += ((const LAS float*)red)[w * 1024 + e];
            const int blk = e >> 8, ln = (e >> 2) & 63, k = e & 3;
            AG[(size_t)(it * 32 + 16 * (blk >> 1) + (ln & 15)) * 32 + 16 * (blk & 1) + 4 * (ln >> 4) + k] = sum * (1.f / 32.f); }
    }
}

constexpr int WAVE_LDS = 17408;
__device__ __forceinline__ int perm16(int k) { return (k & 3) + 4 * ((k >> 3) & 1) + 8 * ((k >> 2) & 1); }
__device__ __forceinline__ int gla_kidx(int dir, int s) { return dir == 0 ? s : (s < LC ? LC - 1 - s : LC + (SEQ - 1 - (s - LC))); }
constexpr int GL_QT = 0, GL_KT = 1280, GL_KHT = 2560, GL_VT = 4096, GL_PT = 7168, GL_ST = 7936, GL_G = 13056, GL_GW = 13312, GL_GB = 15360;
__device__ __forceinline__ void gla_load_gates(KP Pk, Frame& F, int l, int h, int dir, LAS unsigned char* wl) {
    LAS float* gw = (LAS float*)(wl + GL_GW); LAS float* gb = (LAS float*)(wl + GL_GB);
    const float* src = Pk->in[I_GGW] + ((size_t)(l * 2 + dir) * 16) * 256 + h * 32;
#pragma unroll
    for (int i = 0; i < 8; ++i) { const int e = F.lane + 64 * i; gw[e] = src[(e >> 5) * 256 + (e & 31)]; }
    if (F.lane < 32) gb[F.lane] = Pk->in[I_GGB][(l * 2 + dir) * 256 + h * 32 + F.lane];
}
struct GlaIn { f32x4 ag[4]; u32x4 kv, qv, v0, v1; };
template <bool NEEDQ>
__device__ __forceinline__ void gla_sub_load(Frame& F, int b, int h, int dir, int kidx0, GlaIn& in) {
    unsigned char* ws = F.ws;
    int lane_o = F.lane; asm volatile("" : "+v"(lane_o));
    const int tau = lane_o & 15, dq = lane_o >> 4, row = keyrow(b, kidx0 + tau);
    const f32x4* ag = (const f32x4*)((const float*)(ws + WS_AG) + (size_t)row * 32 + dir * 16);
#pragma unroll
    for (int r4 = 0; r4 < 4; ++r4) in.ag[r4] = ag[r4];
    const bf16_t* U = (const bf16_t*)(ws + WS_U) + (size_t)row * NU;
    in.kv = *(const u32x4*)(U + UC_GK + h * 32 + dq * 8);
    if (NEEDQ) in.qv = *(const u32x4*)(U + UC_GQ + h * 32 + dq * 8);
    in.v0 = *(const u32x4*)(U + UC_GV + h * 64 + dq * 16); in.v1 = *(const u32x4*)(U + UC_GV + h * 64 + dq * 16 + 8);
}
template <bool NEEDQ>
__device__ __forceinline__ void gla_sub_prep(Frame& F, int dir, const GlaIn& in, LAS unsigned char* wl, float (&ltot)[8]) {
    int lane_o = F.lane; asm volatile("" : "+v"(lane_o));
    const int tau = lane_o & 15, dq = lane_o >> 4;
    const LAS float* gw = (const LAS float*)(wl + GL_GW) + dq * 8; const LAS float* gb = (const LAS float*)(wl + GL_GB) + dq * 8;
    const f32x4* ag = in.ag;
    float x[8];
    { const f32x4 b0 = *(const LAS f32x4*)gb, b1 = *(const LAS f32x4*)(gb + 4); x[0] = b0[0]; x[1] = b0[1]; x[2] = b0[2]; x[3] = b0[3]; x[4] = b1[0]; x[5] = b1[1]; x[6] = b1[2]; x[7] = b1[3]; }
#pragma unroll
    for (int r4 = 0; r4 < 4; ++r4) { const f32x4 av = ag[r4];
#pragma unroll
        for (int rr = 0; rr < 4; ++rr) { const f32x4 w0 = *(const LAS f32x4*)(gw + (4 * r4 + rr) * 32), w1 = *(const LAS f32x4*)(gw + (4 * r4 + rr) * 32 + 4);
            x[0] += av[rr] * w0[0]; x[1] += av[rr] * w0[1]; x[2] += av[rr] * w0[2]; x[3] += av[rr] * w0[3]; x[4] += av[rr] * w1[0]; x[5] += av[rr] * w1[1]; x[6] += av[rr] * w1[2]; x[7] += av[rr] * w1[3]; } }
#pragma unroll
    for (int j = 0; j < 8; ++j) x[j] = (fminf(x[j], 0.f) - __logf(1.f + __expf(-fabsf(x[j])))) * (1.f / 16.f);
#pragma unroll
    for (int dl = 1; dl < 16; dl <<= 1) { const int src = dir == 0 ? F.lane - dl : F.lane + dl; const bool ok = dir == 0 ? (tau >= dl) : (tau + dl <= 15);
#pragma unroll
        for (int j = 0; j < 8; ++j) { const float y = __shfl(x[j], src); x[j] += ok ? y : 0.f; } }
    float tot[8];
#pragma unroll
    for (int j = 0; j < 8; ++j) { tot[j] = __shfl(x[j], (lane_o & 48) + (dir == 0 ? 15 : 0)); ltot[j] += tot[j]; }
    const u32x4 kv = in.kv;
    const float kf[8] = {bflo(kv.x), bfhi(kv.x), bflo(kv.y), bfhi(kv.y), bflo(kv.z), bfhi(kv.z), bflo(kv.w), bfhi(kv.w)};
    float kt[8], kh[8];
#pragma unroll
    for (int j = 0; j < 8; ++j) { kt[j] = kf[j] * __expf(-x[j]); kh[j] = kf[j] * __expf(tot[j] - x[j]); }
    { u32x4 w; w.x = pk2(kt[0], kt[1]); w.y = pk2(kt[2], kt[3]); w.z = pk2(kt[4], kt[5]); w.w = pk2(kt[6], kt[7]); *(LAS u32x4*)(wl + GL_KT + (tau * 40 + dq * 8) * 2) = w; }
#pragma unroll
    for (int j = 0; j < 8; ++j) *(LAS unsigned short*)(wl + GL_KHT + ((dq * 8 + j) * 24 + tau) * 2) = (unsigned short)f2bf(kh[j]);
    if (NEEDQ) { const u32x4 qv = in.qv; const float sc = 0.17677669529663687f;
        const float qf[8] = {bflo(qv.x), bfhi(qv.x), bflo(qv.y), bfhi(qv.y), bflo(qv.z), bfhi(qv.z), bflo(qv.w), bfhi(qv.w)}; float qt[8];
#pragma unroll
        for (int j = 0; j < 8; ++j) qt[j] = qf[j] * sc * __expf(x[j]);
        u32x4 w; w.x = pk2(qt[0], qt[1]); w.y = pk2(qt[2], qt[3]); w.z = pk2(qt[4], qt[5]); w.w = pk2(qt[6], qt[7]); *(LAS u32x4*)(wl + GL_QT + (tau * 40 + dq * 8) * 2) = w; }
    if (tau == 0) {
#pragma unroll
        for (int j = 0; j < 8; ++j) ((LAS float*)(wl + GL_G))[dq * 8 + j] = __expf(tot[j]); }
    { const u32x4 v0 = in.v0, v1 = in.v1;
      const unsigned vw[8] = {v0.x, v0.y, v0.z, v0.w, v1.x, v1.y, v1.z, v1.w};
#pragma unroll
      for (int j = 0; j < 8; ++j) { *(LAS unsigned short*)(wl + GL_VT + ((dq * 16 + 2 * j) * 24 + tau) * 2) = (unsigned short)(vw[j] & 0xffffu); *(LAS unsigned short*)(wl + GL_VT + ((dq * 16 + 2 * j + 1) * 24 + tau) * 2) = (unsigned short)(vw[j] >> 16); } }
}
__device__ __forceinline__ void gla_state_update(Frame& F, LAS unsigned char* wl, f32x4 (&Sr)[2][4]) {
    int lane_o = F.lane; asm volatile("" : "+v"(lane_o));
    const int r16 = lane_o & 15, kg = lane_o >> 4; const bf16x8 zf = {0, 0, 0, 0, 0, 0, 0, 0};
    bf16x8 vb[4];
#pragma unroll
    for (int nb = 0; nb < 4; ++nb) { vb[nb] = *(const LAS bf16x8*)(wl + GL_VT + ((16 * nb + r16) * 24 + 8 * (kg & 1)) * 2); if (kg >= 2) vb[nb] = zf; }
#pragma unroll
    for (int db = 0; db < 2; ++db) { const f32x4 gv = *(const LAS f32x4*)(wl + GL_G + (16 * db + 4 * kg) * 4);
        bf16x8 ka = *(const LAS bf16x8*)(wl + GL_KHT + ((16 * db + r16) * 24 + 8 * (kg & 1)) * 2); if (kg >= 2) ka = zf;
#pragma unroll
        for (int nb = 0; nb < 4; ++nb) Sr[db][nb] = MFMA16(ka, vb[nb], Sr[db][nb] * gv); }
}
constexpr int GGRP = 6, NGRP = NCH / GGRP;
constexpr size_t WS_GGS = WS_GSS, WS_GGA = WS_GSS + 8 * MiB;
__device__ __forceinline__ void gla_pass_a(KP Pk, Frame& F, int l, int it, LAS unsigned char* wl) {
    unsigned char* ws = F.ws;
    const int seq = it / NGRP, g = it % NGRP, dir = seq & 1, h = (seq >> 1) & 7, b = seq >> 4, r16 = F.lane & 15, kg = F.lane >> 4;
    gla_load_gates(Pk, F, l, h, dir, wl);
    f32x4 Sr[2][4];
#pragma unroll
    for (int db = 0; db < 2; ++db)
#pragma unroll
        for (int nb = 0; nb < 4; ++nb) Sr[db][nb] = (f32x4){0.f, 0.f, 0.f, 0.f};
    float ltot[8] = {0.f, 0.f, 0.f, 0.f, 0.f, 0.f, 0.f, 0.f};
    GlaIn nin;
    { const int c0 = g * GGRP; gla_sub_load<false>(F, b, h, dir, (dir == 0 ? 64 * c0 : gla_kidx(1, 64 * c0) - 63) + 16 * (dir == 0 ? 0 : 3), nin); }
#pragma unroll 1
    for (int cg = 0; cg <= GGRP; ++cg) {
        const int c = g * GGRP + cg;
        float* sl = cg < GGRP ? (float*)(ws + WS_GSL) + ((size_t)seq * NCH + c) * 2048 : (float*)(ws + WS_GGS) + ((size_t)seq * NGRP + g) * 2048;
        float* al = cg < GGRP ? (float*)(ws + WS_GAE) + ((size_t)seq * NCH + c) * 32 : (float*)(ws + WS_GGA) + ((size_t)seq * NGRP + g) * 32;
#pragma unroll
        for (int db = 0; db < 2; ++db)
#pragma unroll
            for (int nb = 0; nb < 4; ++nb)
#pragma unroll
                for (int i = 0; i < 4; ++i) sl[(16 * db + 4 * kg + i) * 64 + 16 * nb + r16] = Sr[db][nb][i];
        if ((F.lane & 15) == 0) {
#pragma unroll
            for (int j = 0; j < 8; ++j) al[kg * 8 + j] = __expf(ltot[j]); }
        if (cg == GGRP) break;
#pragma unroll 1
        for (int st = 0; st < 4; ++st) {
            const GlaIn cur = nin;
            { const int q2 = cg * 4 + st + 1, c2 = g * GGRP + (q2 >> 2), st2 = q2 & 3, sb2 = dir == 0 ? st2 : 3 - st2;
              if (q2 < 4 * GGRP) gla_sub_load<false>(F, b, h, dir, (dir == 0 ? 64 * c2 : gla_kidx(1, 64 * c2) - 63) + 16 * sb2, nin); }
            gla_sub_prep<false>(F, dir, cur, wl, ltot);
            gla_state_update(F, wl, Sr); }
    }
}
__device__ __forceinline__ void gla_pass_b(KP Pk, Frame& F, int l, int b, int h, int c, LAS unsigned char* wl) {
    unsigned char* ws = F.ws;
    const int r16 = F.lane & 15, kg = F.lane >> 4, seq = (b * 8 + h) * 2; const bf16x8 zf = {0, 0, 0, 0, 0, 0, 0, 0};
    const bf16_t* U = (const bf16_t*)(ws + WS_U); unsigned char* MIX = ws + WS_H;
    u32x2 of[4][4];
#pragma unroll 1
    for (int dir = 0; dir < 2; ++dir) {
        gla_load_gates(Pk, F, l, h, dir, wl);
        const int cc = dir == 0 ? c : (c < 4 ? 3 - c : 39 - c);
        f32x4 Sr[2][4];
#pragma unroll
        for (int db = 0; db < 2; ++db)
#pragma unroll
            for (int nb = 0; nb < 4; ++nb) Sr[db][nb] = (f32x4){0.f, 0.f, 0.f, 0.f};
        { const int gsel = cc / GGRP;
#pragma unroll 1
          for (int gp = 0; gp <= gsel; ++gp) {
            const bool fin = gp == gsel;
            const float* sp = fin ? (const float*)(ws + WS_GSL) + ((size_t)(seq + dir) * NCH + cc) * 2048 : (const float*)(ws + WS_GGS) + ((size_t)(seq + dir) * NGRP + gp) * 2048;
            const float* apx = fin ? (const float*)(ws + WS_GAE) + ((size_t)(seq + dir) * NCH + cc) * 32 : (const float*)(ws + WS_GGA) + ((size_t)(seq + dir) * NGRP + gp) * 32;
#pragma unroll
            for (int db = 0; db < 2; ++db) { const f32x4 av = *(const f32x4*)(apx + 16 * db + 4 * kg);
#pragma unroll
                for (int nb = 0; nb < 4; ++nb)
#pragma unroll
                    for (int i = 0; i < 4; ++i) Sr[db][nb][i] = av[i] * Sr[db][nb][i] + sp[(16 * db + 4 * kg + i) * 64 + 16 * nb + r16]; } } }
        float ltot[8] = {0.f, 0.f, 0.f, 0.f, 0.f, 0.f, 0.f, 0.f};
#pragma unroll 1
        for (int st = 0; st < 4; ++st) { const int sb = dir == 0 ? st : 3 - st;
            int lane_o = F.lane; asm volatile("" : "+v"(lane_o)); const int r16 = lane_o & 15, kg = lane_o >> 4;
#pragma unroll
            for (int db = 0; db < 2; ++db)
#pragma unroll
                for (int nb = 0; nb < 4; ++nb) { u32x2 w; w.x = pk2(Sr[db][nb][0], Sr[db][nb][1]); w.y = pk2(Sr[db][nb][2], Sr[db][nb][3]); *(LAS u32x2*)(wl + GL_ST + ((16 * nb + r16) * 40 + 16 * db + 4 * kg) * 2) = w; }
            { GlaIn in; gla_sub_load<true>(F, b, h, dir, 64 * c + 16 * sb, in); gla_sub_prep<true>(F, dir, in, wl, ltot); }
            const bf16x8 bq = *(const LAS bf16x8*)(wl + GL_QT + (r16 * 40 + 8 * kg) * 2);
            { const bf16x8 ka = *(const LAS bf16x8*)(wl + GL_KT + (r16 * 40 + 8 * kg) * 2);
              f32x4 p = MFMA16(ka, bq, ((f32x4){0.f, 0.f, 0.f, 0.f}));
#pragma unroll
              for (int i = 0; i < 4; ++i) { const int sidx = 4 * kg + i; const bool keep = dir == 0 ? (sidx <= r16) : (sidx >= r16); p[i] = keep ? p[i] : 0.f; }
              u32x2 w; w.x = pk2(p[0], p[1]); w.y = pk2(p[2], p[3]); *(LAS u32x2*)(wl + GL_PT + (r16 * 24 + 4 * kg) * 2) = w; }
            bf16x8 pb = *(const LAS bf16x8*)(wl + GL_PT + (r16 * 24 + 8 * (kg & 1)) * 2); if (kg >= 2) pb = zf;
            f32x4 o[4];
#pragma unroll
            for (int nb = 0; nb < 4; ++nb) { const bf16x8 sa = *(const LAS bf16x8*)(wl + GL_ST + ((16 * nb + r16) * 40 + 8 * kg) * 2);
                bf16x8 va = *(const LAS bf16x8*)(wl + GL_VT + ((16 * nb + r16) * 24 + 8 * (kg & 1)) * 2); if (kg >= 2) va = zf;
                o[nb] = MFMA16(sa, bq, ((f32x4){0.f, 0.f, 0.f, 0.f})); o[nb] = MFMA16(va, pb, o[nb]); }
            if (dir == 0) { u32x2 t[4];
#pragma unroll
                for (int nb = 0; nb < 4; ++nb) { t[nb].x = pk2(o[nb][0], o[nb][1]); t[nb].y = pk2(o[nb][2], o[nb][3]); }
#define OF_PUT(k) { _Pragma("unroll") for (int nb = 0; nb < 4; ++nb) of[k][nb] = t[nb]; }
                if (sb == 0) OF_PUT(0) else if (sb == 1) OF_PUT(1) else if (sb == 2) OF_PUT(2) else OF_PUT(3)
#undef OF_PUT
            }
            else { float ss = 0.f; u32x2 t[4];
#define OF_GET(k) { _Pragma("unroll") for (int nb = 0; nb < 4; ++nb) t[nb] = of[k][nb]; }
                if (sb == 0) OF_GET(0) else if (sb == 1) OF_GET(1) else if (sb == 2) OF_GET(2) else OF_GET(3)
#undef OF_GET
#pragma unroll
                for (int nb = 0; nb < 4; ++nb) { o[nb][0] += bflo(t[nb].x); o[nb][1] += bfhi(t[nb].x); o[nb][2] += bflo(t[nb].y); o[nb][3] += bfhi(t[nb].y); ss += (o[nb][0] * o[nb][0] + o[nb][1] * o[nb][1]) + (o[nb][2] * o[nb][2] + o[nb][3] * o[nb][3]); }
                ss += __shfl_xor(ss, 16); ss += __shfl_xor(ss, 32);
                const float rstd = rsqrtf(ss * (1.f / 64.f) + NORM_EPS); const int row = keyrow(b, 64 * c + 16 * sb + r16);
#pragma unroll
                for (int nb = 0; nb < 4; ++nb) { const int dv0 = 16 * nb + 4 * kg; const u32x2 gg = *(const u32x2*)(U + (size_t)row * NU + UC_GG + h * 64 + dv0); const f32x4 nw = *(const f32x4*)(Pk->in[I_GNW] + l * 64 + dv0);
                    const float y0 = o[nb][0] * rstd * nw[0] * silu_f(bflo(gg.x)), y1 = o[nb][1] * rstd * nw[1] * silu_f(bfhi(gg.x)), y2 = o[nb][2] * rstd * nw[2] * silu_f(bflo(gg.y)), y3 = o[nb][3] * rstd * nw[3] * silu_f(bfhi(gg.y));
                    if (WOUT_F8) *(unsigned*)(MIX + ((size_t)row * D + h * 64 + dv0)) = pk4_f8(y0, y1, y2, y3);
                    else { u32x2 w; w.x = pk2(y0, y1); w.y = pk2(y2, y3); *(u32x2*)(MIX + ((size_t)row * D + h * 64 + dv0) * 2) = w; } } }
            if (st < 3) gla_state_update(F, wl, Sr);
        }
    }
}
__device__ __forceinline__ float dpp_x1(float v) { return __builtin_bit_cast(float, __builtin_amdgcn_update_dpp(0, __builtin_bit_cast(int, v), 0xB1, 0xF, 0xF, true)); }
__device__ __forceinline__ float dpp_x2(float v) { return __builtin_bit_cast(float, __builtin_amdgcn_update_dpp(0, __builtin_bit_cast(int, v), 0x4E, 0xF, 0xF, true)); }
__device__ __forceinline__ float dpp_hm(float v) { return __builtin_bit_cast(float, __builtin_amdgcn_update_dpp(0, __builtin_bit_cast(int, v), 0x141, 0xF, 0xF, true)); }
__device__ __forceinline__ void qk_vec(bf16_t* p, const float (&w)[8], const float (&cs)[8], const float (&sn)[8]) {
    const u32x4 r = *(const u32x4*)p;
    float x[8] = {bflo(r.x), bfhi(r.x), bflo(r.y), bfhi(r.y), bflo(r.z), bfhi(r.z), bflo(r.w), bfhi(r.w)};
    float ss = 0.f;
#pragma unroll
    for (int e = 0; e < 8; ++e) ss += x[e] * x[e];
    ss += dpp_x1(ss); ss += dpp_x2(ss); ss += dpp_hm(ss);
    const float rstd = rsqrtf(ss * (1.f / 64.f) + NORM_EPS);
    float o[8];
#pragma unroll
    for (int e = 0; e < 8; ++e) { const float y = x[e] * rstd * w[e]; o[e] = y * cs[e] + dpp_x2(y) * sn[e]; }
    u32x4 q; q.x = pk2(o[0], o[1]); q.y = pk2(o[2], o[3]); q.z = pk2(o[4], o[5]); q.w = pk2(o[6], o[7]);
    *(u32x4*)p = q;
}
__device__ __forceinline__ void qk_rope(const unsigned char* ws, int row, int j, float (&cs)[8], float (&sn)[8]) {
    if (row < TL) { const float* rp = (const float*)(ws + WS_ROPE) + (size_t)(row & (SEQ - 1)) * 64 + 32 * (j >> 2) + 8 * (j & 1);
        const f32x4 c0 = *(const f32x4*)rp, c1 = *(const f32x4*)(rp + 4), s0 = *(const f32x4*)(rp + 16), s1 = *(const f32x4*)(rp + 20); const float sg = (j & 2) ? 1.f : -1.f;
#pragma unroll
        for (int e = 0; e < 4; ++e) { cs[e] = c0[e]; cs[4 + e] = c1[e]; sn[e] = sg * s0[e]; sn[4 + e] = sg * s1[e]; } }
    else {
#pragma unroll
        for (int e = 0; e < 8; ++e) { cs[e] = 1.f; sn[e] = 0.f; } }
}
__device__ __forceinline__ void prep_qk_rows4(KP Pk, Frame& F, int l, int row0) {
    unsigned char* ws = F.ws;
    bf16_t* U = (bf16_t*)(ws + WS_U);
    const int j = F.lane & 7; const float qs = 0.125f * LOG2E;
    float wsq[8], wdq[8], wdk[8], wsk[8];
    { const float* a = Pk->in[I_SQN] + l * 64 + 8 * j; const float* b = Pk->in[I_DQN] + l * 64 + 8 * j; const float* c = Pk->in[I_DKN] + l * 64 + 8 * j; const float* d = Pk->in[I_SKN] + l * 64 + 8 * j;
#pragma unroll
      for (int e = 0; e < 8; ++e) { wsq[e] = a[e] * qs; wdq[e] = b[e] * qs; wdk[e] = c[e]; wsk[e] = d[e]; } }
#pragma unroll 1
    for (int r = 0; r < 4; ++r) { const int row = row0 + r; float cs[8], sn[8];
        qk_rope(ws, row, j, cs, sn);
        bf16_t* up = U + (size_t)row * NU + 8 * F.lane;
        qk_vec(up + UC_SQ, wsq, cs, sn); qk_vec(up + UC_DQ, wdq, cs, sn); qk_vec(up + UC_DK, wdk, cs, sn); }
    { const int row = row0 + (F.lane >> 4); float cs[8], sn[8];
      qk_rope(ws, row, j, cs, sn);
      qk_vec(U + (size_t)row * NU + UC_SK + 8 * (F.lane & 15), wsk, cs, sn); }
}
template <bool PERMK, int NCOLS, class SRC>
__device__ __forceinline__ void tile_transpose(LAS unsigned char* wl, int lane, bf16_t* dst, size_t dst_stride, const SRC& src) {
    LAS unsigned* tl = (LAS unsigned*)wl;
    constexpr int ncols = NCOLS, cpr = NCOLS / 8;
    LDS_WAIT(); asm volatile("" ::: "memory");
#pragma unroll 1
    for (int k0 = 0; k0 < cpr; k0 += 4) { u32x4 v[4];
#pragma unroll
      for (int k = 0; k < 4; ++k) { const int id = lane + 64 * (k0 + k); v[k] = src(id / cpr, id % cpr); }
#pragma unroll
      for (int k = 0; k < 4; ++k) { const int id = lane + 64 * (k0 + k); LAS unsigned* p = tl + (id / cpr) * 65 + (id % cpr) * 4; p[0] = v[k].x; p[1] = v[k].y; p[2] = v[k].z; p[3] = v[k].w; } }
    LDS_WAIT(); asm volatile("" ::: "memory");
    const LAS unsigned short* ts = (const LAS unsigned short*)wl;
    const int cc = lane & 7;
    for (int dv = lane >> 3; dv < ncols; dv += 8) {
        unsigned short e[8];
#pragma unroll
        for (int i = 0; i < 8; ++i) { const int p = 8 * cc + i, srow = PERMK ? ((p & ~15) + perm16(p & 15)) : p; e[i] = ts[srow * 130 + dv]; }
        u32x4 o; o.x = e[0] | ((unsigned)e[1] << 16); o.y = e[2] | ((unsigned)e[3] << 16); o.z = e[4] | ((unsigned)e[5] << 16); o.w = e[6] | ((unsigned)e[7] << 16);
        *(u32x4*)(dst + (size_t)dv * dst_stride + 8 * cc) = o; }
}
__device__ __forceinline__ void ph_prep(KP Pk, Frame& F, int l, int rep) {
    unsigned char* ws = F.ws;
    const int gw = F.vcu * NWAVES + F.wave, NGW = F.G * NWAVES;
    LAS unsigned char* wl = F.lds + F.wave * WAVE_LDS;
    const bf16_t* U = (const bf16_t*)(ws + WS_U);
    const int n_gla = 128 * NGRP, n_hy = NB * (l == 0 ? 36 : 32) * 12, n_vd = NB * 4 * 36, n_vs = NB * 2 * 36, n_rows = rep ? 0 : TT / 4;
    if (gw < n_gla) { gla_pass_a(Pk, F, l, gw, wl); }
    const int total = n_hy + n_vd + n_vs + n_rows, nrest = NGW - n_gla;
    for (int it0 = gw - n_gla; it0 < total && gw >= n_gla; it0 += nrest) {
        int it = it0;
        if (it < n_hy) {
            const int ntile = l == 0 ? 36 : 32, b = it / (ntile * 12), r = it % (ntile * 12), tile = r / 12, cb = r % 12, c0 = cb * 128;
            const bool lat = tile < 32; const int p0 = lat ? 64 * tile : 64 * (tile - 32), Ls = lat ? SEQ : LC, rbase = lat ? b * SEQ : TL + b * LC;
            const float* cw = Pk->in[I_HCW] + (size_t)l * 3 * 1536 + c0 + (F.lane & 15) * 8; const float* cbias = Pk->in[I_HCB] + (size_t)l * 1536 + c0 + (F.lane & 15) * 8;
            float w0[8], w1[8], w2[8], wb[8];
#pragma unroll
            for (int k = 0; k < 8; ++k) { w0[k] = cw[k]; w1[k] = cw[1536 + k]; w2[k] = cw[3072 + k]; wb[k] = cbias[k]; }
            auto src = [&](int i, int ch) -> u32x4 { const int p = p0 + i; const bf16_t* up = U + (size_t)(rbase + p) * NU + UC_HY + c0 + ch * 8;
                const u32x4 m = *(const u32x4*)up; u32x4 a = {0u, 0u, 0u, 0u}, c = {0u, 0u, 0u, 0u};
                if (p > 0) a = *(const u32x4*)(up - NU); if (p + 1 < Ls) c = *(const u32x4*)(up + NU);
                const unsigned av[4] = {a.x, a.y, a.z, a.w}, mv[4] = {m.x, m.y, m.z, m.w}, cv[4] = {c.x, c.y, c.z, c.w}; unsigned o[4];
#pragma unroll
                for (int q = 0; q < 4; ++q) { const int k = 2 * q;
                    const float z0 = bflo(av[q]) * w0[k] + bflo(mv[q]) * w1[k] + bflo(cv[q]) * w2[k] + wb[k];
                    const float z1 = bfhi(av[q]) * w0[k + 1] + bfhi(mv[q]) * w1[k + 1] + bfhi(cv[q]) * w2[k + 1] + wb[k + 1];
                    o[q] = pk2(z0, z1); }
                return (u32x4){o[0], o[1], o[2], o[3]}; };
            tile_transpose<false, 128>(wl, F.lane, (bf16_t*)(ws + WS_ZT) + ((size_t)b * 1536 + c0) * KEYS + (lat ? p0 : SEQ + p0), KEYS, src);
            continue; } it -= n_hy;
        if (it < n_vd) {
            const int b = it / 144, r = it % 144, h = r / 36, tile = r % 36;
            auto src = [&](int i, int ch) -> u32x4 { return *(const u32x4*)(U + (size_t)keyrow(b, 64 * tile + i) * NU + UC_DV + h * 128 + ch * 8); };
            tile_transpose<true, 128>(wl, F.lane, (bf16_t*)(ws + WS_VTD) + ((size_t)(b * 4 + h) * 128) * KEYS + 64 * tile, KEYS, src);
            continue; } it -= n_vd;
        if (it < n_vs) {
            const int b = it / 72, r = it % 72, h = r / 36, tile = r % 36;
            auto src = [&](int i, int ch) -> u32x4 { return *(const u32x4*)(U + (size_t)keyrow(b, 64 * tile + i) * NU + UC_SV + h * 64 + ch * 8); };
            tile_transpose<true, 64>(wl, F.lane, (bf16_t*)(ws + WS_VTS) + ((size_t)(b * 2 + h) * 64) * KEYS + 64 * tile, KEYS, src);
            continue; } it -= n_vs;
        prep_qk_rows4(Pk, F, l, it * 4);
    }
}
__device__ __forceinline__ void ph_gla_scan(Frame& F) {
    unsigned char* ws = F.ws;
    const int gw = F.vcu * NWAVES + F.wave, NGW = F.G * NWAVES;
    for (int it = gw; it < 128 * 32; it += NGW) { const int seq = it >> 5, d = it & 31;
        const float* sl = (const float*)(ws + WS_GSL) + (size_t)seq * NCH * 2048 + d * 64 + F.lane; float* ss = (float*)(ws + WS_GSS) + (size_t)seq * NCH * 2048 + d * 64 + F.lane;
        const float* ae = (const float*)(ws + WS_GAE) + (size_t)seq * NCH * 32 + d;
        float x[NCH], a[NCH];
#pragma unroll
        for (int c = 0; c < NCH; ++c) { x[c] = sl[(size_t)c * 2048]; a[c] = ae[c * 32]; }
        float S = 0.f;
#pragma unroll
        for (int c = 0; c < NCH; ++c) { ss[(size_t)c * 2048] = S; S = a[c] * S + x[c]; }
    }
}

__device__ __forceinline__ int crow(int r, int hi) { return (r & 3) + 8 * (r >> 2) + 4 * hi; }
template <int KW, int DV, bool MASK>
__device__ __forceinline__ void attn_core(Frame& F, const bf16_t* U, int b, int kcol0, const bf16_t* VT, int nctx, int nloc, int loc0,
                                          const bf16x8 (&q)[4], int koff, int qpos0, float sh2, f32x16 (&O)[DV / 32], float& lsum) {
    constexpr int KRB = KW * 2, KB = 64 * KRB, VB = DV * 128, SLOT = KB + VB, NKC = KB / 8192, NVC = VB / 8192, NDMA = NKC + NVC;
    const int r32 = F.lane & 31, hi = F.lane >> 5, nt = nctx + nloc;
#define ATT_DMA(ti) do { const int _k0 = (ti) < nctx ? 64 * (ti) : loc0 + 64 * ((ti) - nctx); LAS unsigned char* _sl = F.lds + ((ti) & 3) * SLOT; \
        _Pragma("unroll") for (int _j = 0; _j < NKC; ++_j) { const int _ch = F.wave + 8 * _j; int _row, _c; \
            if (KW == 128) { _row = 4 * _ch + (F.lane >> 4); _c = (F.lane & 15) ^ (_row & 15); } else { _row = 8 * _ch + (F.lane >> 3); _c = (F.lane & 7) ^ ((_row >> 1) & 7); } \
            __builtin_amdgcn_global_load_lds((const unsigned*)(U + (size_t)keyrow(b, _k0 + _row) * NU + kcol0 + _c * 8), (LAS unsigned*)(_sl + _ch * 1024), 16, 0, 0); } \
        _Pragma("unroll") for (int _j = 0; _j < NVC; ++_j) { const int _ch = F.wave + 8 * _j, _row = 8 * _ch + (F.lane >> 3), _c = (F.lane & 7) ^ ((_row >> 1) & 7); \
            __builtin_amdgcn_global_load_lds((const unsigned*)(VT + (size_t)_row * KEYS + _k0 + _c * 8), (LAS unsigned*)(_sl + KB + _ch * 1024), 16, 0, 0); } } while (0)
    f32x16 s0, s1; bf16x8 pa[4];
#define DSR(dst, addr, off) asm volatile("ds_read_b128 %0, %1 offset:%2" : "=v"(dst) : "v"(addr), "n"(off))
#define LWAIT4(f) asm volatile("s_waitcnt lgkmcnt(0)" : "+v"(f[0]), "+v"(f[1]), "+v"(f[2]), "+v"(f[3]))
    unsigned kad[4], vad[4];
#pragma unroll
    for (int i = 0; i < 4; ++i) { const int c = 2 * i + hi;
        kad[i] = (unsigned)(uintptr_t)F.lds + (KW == 128 ? r32 * 256 + ((((koff >> 3) + c) ^ (r32 & 15)) << 4) : r32 * 128 + ((c ^ ((r32 >> 1) & 7)) << 4));
        vad[i] = (unsigned)(uintptr_t)F.lds + KB + r32 * 128 + ((c ^ ((r32 >> 1) & 7)) << 4); }
    __syncthreads();
    ATT_DMA(0);
    if (nt > 1) ATT_DMA(1);
    if (nt > 2) ATT_DMA(2);
    if (nt > 2) asm volatile("s_waitcnt vmcnt(%0)" :: "n"(NDMA) : "memory"); else asm volatile("s_waitcnt vmcnt(0)" ::: "memory");
    __syncthreads();
#define EXP1(ti, r) do { s0[r] = __builtin_amdgcn_exp2f(s0[r]); s1[r] = __builtin_amdgcn_exp2f(s1[r]); \
        if (MASK && (ti) >= nctx) { const int k0 = loc0 - LC + 64 * ((ti) - nctx) + crow(r, hi), k1 = k0 + 32, d0 = qpos0 + r32 - k0, d1 = d0 - 32; \
            if (k0 < 0 || k0 >= SEQ || d0 > 128 || d0 < -128) s0[r] = 0.f; if (k1 < 0 || k1 >= SEQ || d1 > 128 || d1 < -128) s1[r] = 0.f; } } while (0)
#define RD_K(f, h) do { DSR(f[0], ka[2 * (h)], 0); DSR(f[1], ka[2 * (h)], 32 * KRB); DSR(f[2], ka[2 * (h) + 1], 0); DSR(f[3], ka[2 * (h) + 1], 32 * KRB); } while (0)
#define RD_V(f, nb) do { DSR(f[0], va[0], (nb) * 4096); DSR(f[1], va[1], (nb) * 4096); DSR(f[2], va[2], (nb) * 4096); DSR(f[3], va[3], (nb) * 4096); } while (0)
#define SB() __builtin_amdgcn_sched_barrier(0)
#define PKW(S, B) pg8::cvt_pk_bf16(S[B], S[(B) + 1])
#define PV1(f, nb, kk, ti, R0, NE) do { O[nb] = MFMA32(pa[kk], f[kk], O[nb]); if (more) { _Pragma("unroll") for (int _r = 0; _r < (NE); ++_r) EXP1(ti, (R0) + _r); } SB(); } while (0)
    {
        bf16x8 fa[4], fb[4]; unsigned ka[4];
#pragma unroll
        for (int i = 0; i < 4; ++i) ka[i] = kad[i];
        RD_K(fa, 0); RD_K(fb, 1);
#pragma unroll
        for (int r = 0; r < 16; ++r) { s0[r] = -sh2; s1[r] = -sh2; }
        LWAIT4(fa); LWAIT4(fb);
        s0 = MFMA32(fa[0], q[0], s0); s1 = MFMA32(fa[1], q[0], s1); s0 = MFMA32(fa[2], q[1], s0); s1 = MFMA32(fa[3], q[1], s1);
        s0 = MFMA32(fb[0], q[2], s0); s1 = MFMA32(fb[1], q[2], s1); s0 = MFMA32(fb[2], q[3], s0); s1 = MFMA32(fb[3], q[3], s1);
#pragma unroll
        for (int r = 0; r < 16; ++r) EXP1(0, r);
    }
#define ATT_STEP(MORE) { \
        constexpr bool more = (MORE); \
        if (t + 3 < nt) ATT_DMA(t + 3); \
        unsigned ka[4], va[4]; \
        { int lo_ = F.lane; asm volatile("" : "+v"(lo_)); const int rr = lo_ & 31, hh = lo_ >> 5; \
        _Pragma("unroll") \
          for (int i = 0; i < 4; ++i) { const int c = 2 * i + hh; \
            ka[i] = (unsigned)(uintptr_t)F.lds + ((t + 1) & 3) * SLOT + (KW == 128 ? rr * 256 + ((((koff >> 3) + c) ^ (rr & 15)) << 4) : rr * 128 + ((c ^ ((rr >> 1) & 7)) << 4)); \
            va[i] = (unsigned)(uintptr_t)F.lds + (t & 3) * SLOT + KB + rr * 128 + ((c ^ ((rr >> 1) & 7)) << 4); } } \
        bf16x8 fa[4], fb[4]; \
        if (more) { RD_K(fa, 0); RD_K(fb, 1); } else { RD_V(fa, 0); } \
        SB(); \
 \
        { float ps = 0.f; \
        _Pragma("unroll") \
          for (int r = 0; r < 16; ++r) ps += s0[r] + s1[r]; \
          lsum += ps; \
          u32x4 w; \
          w.x = PKW(s0, 0); w.y = PKW(s0, 2); w.z = PKW(s0, 4); w.w = PKW(s0, 6); pa[0] = __builtin_bit_cast(bf16x8, w); \
          w.x = PKW(s0, 8); w.y = PKW(s0, 10); w.z = PKW(s0, 12); w.w = PKW(s0, 14); pa[1] = __builtin_bit_cast(bf16x8, w); \
          w.x = PKW(s1, 0); w.y = PKW(s1, 2); w.z = PKW(s1, 4); w.w = PKW(s1, 6); pa[2] = __builtin_bit_cast(bf16x8, w); \
          w.x = PKW(s1, 8); w.y = PKW(s1, 10); w.z = PKW(s1, 12); w.w = PKW(s1, 14); pa[3] = __builtin_bit_cast(bf16x8, w); } \
        if (more) { \
        _Pragma("unroll") \
            for (int r = 0; r < 16; ++r) { s0[r] = -sh2; s1[r] = -sh2; } \
        } \
        SB(); \
        if (more) { \
            LWAIT4(fa); LWAIT4(fb); \
            s0 = MFMA32(fa[0], q[0], s0); s1 = MFMA32(fa[1], q[0], s1); s0 = MFMA32(fa[2], q[1], s0); s1 = MFMA32(fa[3], q[1], s1); \
            SB(); RD_V(fa, 0); SB(); \
            s0 = MFMA32(fb[0], q[2], s0); s1 = MFMA32(fb[1], q[2], s1); s0 = MFMA32(fb[2], q[3], s0); s1 = MFMA32(fb[3], q[3], s1); \
            SB(); \
        } \
        LWAIT4(fa); RD_V(fb, 1); SB(); \
        if (DV == 128) { \
            PV1(fa, 0, 0, t + 1, 0, 1); PV1(fa, 0, 1, t + 1, 1, 1); PV1(fa, 0, 2, t + 1, 2, 1); PV1(fa, 0, 3, t + 1, 3, 1); \
            LWAIT4(fb); RD_V(fa, 2); SB(); \
            PV1(fb, 1, 0, t + 1, 4, 1); PV1(fb, 1, 1, t + 1, 5, 1); PV1(fb, 1, 2, t + 1, 6, 1); PV1(fb, 1, 3, t + 1, 7, 1); \
            LWAIT4(fa); RD_V(fb, 3); SB(); \
            PV1(fa, 2, 0, t + 1, 8, 1); PV1(fa, 2, 1, t + 1, 9, 1); PV1(fa, 2, 2, t + 1, 10, 1); PV1(fa, 2, 3, t + 1, 11, 1); \
            LWAIT4(fb); SB(); \
            PV1(fb, 3, 0, t + 1, 12, 1); PV1(fb, 3, 1, t + 1, 13, 1); PV1(fb, 3, 2, t + 1, 14, 1); PV1(fb, 3, 3, t + 1, 15, 1); \
        } else { \
            PV1(fa, 0, 0, t + 1, 0, 2); PV1(fa, 0, 1, t + 1, 2, 2); PV1(fa, 0, 2, t + 1, 4, 2); PV1(fa, 0, 3, t + 1, 6, 2); \
            LWAIT4(fb); SB(); \
            PV1(fb, 1, 0, t + 1, 8, 2); PV1(fb, 1, 1, t + 1, 10, 2); PV1(fb, 1, 2, t + 1, 12, 2); PV1(fb, 1, 3, t + 1, 14, 2); \
        } \
        if (t + 3 < nt) asm volatile("s_waitcnt vmcnt(%0)" :: "n"(NDMA) : "memory"); else asm volatile("s_waitcnt vmcnt(0)" ::: "memory"); \
        __syncthreads(); \
    }
    int t = 0;
#pragma unroll 1
    for (; t + 1 < nt; ++t) ATT_STEP(true)
    ATT_STEP(false)
#undef ATT_STEP
#undef EXP1
#undef SB
#undef PKW
#undef PV1
#undef RD_K
#undef RD_V
#undef DSR
#undef LWAIT4
#undef ATT_DMA
}
__device__ __forceinline__ float score_bound(const float* wq, const float* wk, int lane) {
    float a = fabsf(wq[lane]), c = fabsf(wk[lane]);
#pragma unroll
    for (int o = 1; o < 64; o <<= 1) { a = fmaxf(a, __shfl_xor(a, o)); c = fmaxf(c, __shfl_xor(c, o)); }
    return 64.f * a * c * 0.125f * LOG2E;
}
__device__ __forceinline__ void diff_unit(KP Pk, Frame& F, int l, int b, int h, int qrow0, int nkt) {
    unsigned char* ws = F.ws;
    const bf16_t* U = (const bf16_t*)(ws + WS_U);
    const int m = F.wave & 1, rb = F.wave >> 1;
    const float sh2 = score_bound(Pk->in[I_DQN] + l * 64, Pk->in[I_DKN] + l * 64, F.lane);
    bf16x8 q[4];
    { const bf16_t* qp = U + (size_t)(qrow0 + 32 * rb + (F.lane & 31)) * NU + UC_DQ + h * 128 + m * 64 + 8 * (F.lane >> 5);
#pragma unroll
      for (int ks = 0; ks < 4; ++ks) q[ks] = *(const bf16x8*)(qp + 16 * ks); }
    f32x16 O[4];
#pragma unroll
    for (int nb = 0; nb < 4; ++nb) O[nb] = (f32x16){};
    float lsum = 0.f;
    attn_core<128, 128, false>(F, U, b, UC_DK + h * 128, (const bf16_t*)(ws + WS_VTD) + ((size_t)(b * 4 + h) * 128) * KEYS, nkt, 0, 0, q, 64 * m, 0, sh2, O, lsum);
    int ln_; asm volatile("v_mbcnt_lo_u32_b32 %0, -1, 0\n\tv_mbcnt_hi_u32_b32 %0, -1, %0" : "=v"(ln_));
    const int r32 = ln_ & 31, hi = ln_ >> 5;
    { int lo_ = l; asm volatile("" : "+s"(lo_)); l = lo_; Pk = kp_opaque(Pk); }
    lsum += __shfl_xor(lsum, 32);
    const float rl = 1.f / lsum;
    LAS float* ex = (LAS float*)F.lds + rb * 4096;
    float rlr[16];
#pragma unroll
    for (int r = 0; r < 16; ++r) rlr[r] = __shfl(rl, crow(r, hi));
    if (m == 1) {
#pragma unroll
        for (int nb = 0; nb < 4; ++nb)
#pragma unroll
            for (int r = 0; r < 16; ++r) ex[crow(r, hi) * 128 + nb * 32 + r32] = O[nb][r] * rlr[r];
    }
    __syncthreads();
    if (m == 0) {
        const float* dl = Pk->in[I_DLAM] + l * 256; const float lam_init = __builtin_bit_cast(float, __builtin_amdgcn_readfirstlane(__builtin_bit_cast(int, l == 0 ? 0.2f : (0.8f - 0.6f * 0.74081822068f))));
        const float lam = expf(wave_sum(dl[ln_] * dl[64 + ln_])) - expf(wave_sum(dl[128 + ln_] * dl[192 + ln_])) + lam_init;
        float ssq[16];
#pragma unroll
        for (int r = 0; r < 16; ++r) { float a = 0.f;
#pragma unroll
            for (int nb = 0; nb < 4; ++nb) { const float v = O[nb][r] * rlr[r] - lam * ex[crow(r, hi) * 128 + nb * 32 + r32]; O[nb][r] = v; a += v * v; }
            a += __shfl_xor(a, 1); a += __shfl_xor(a, 2); a += __shfl_xor(a, 4); a += __shfl_xor(a, 8); a += __shfl_xor(a, 16);
            ssq[r] = rsqrtf(a * (1.f / 128.f) + NORM_EPS) * (1.f - lam_init); }
        unsigned char* mix = ws + WS_H + ((size_t)(qrow0 + 32 * rb) * D + 1536 + h * 128) * MIXB;
#pragma unroll
        for (int nb = 0; nb < 4; ++nb) { const float w = Pk->in[I_DSUB][l * 128 + nb * 32 + r32];
#pragma unroll
            for (int r = 0; r < 16; ++r) { const float y = O[nb][r] * ssq[r] * w; const size_t e = (size_t)crow(r, hi) * D + nb * 32 + r32; if (WOUT_F8) mix[e] = f8_1(y); else ((bf16_t*)mix)[e] = (bf16_t)f2bf(y); } }
    }
}
__device__ __forceinline__ void swa_unit(KP Pk, Frame& F, int l, int b, int kvh, int qrow0, int qpos0, bool latent) {
    unsigned char* ws = F.ws;
    const bf16_t* U = (const bf16_t*)(ws + WS_U);
    const int hq = kvh * 4 + (F.wave & 3), rb = F.wave >> 2;
    const float sh2 = score_bound(Pk->in[I_SQN] + l * 64, Pk->in[I_SKN] + l * 64, F.lane);
    bf16x8 q[4];
    { const bf16_t* qp = U + (size_t)(qrow0 + 32 * rb + (F.lane & 31)) * NU + UC_SQ + hq * 64 + 8 * (F.lane >> 5);
#pragma unroll
      for (int ks = 0; ks < 4; ++ks) q[ks] = *(const bf16x8*)(qp + 16 * ks); }
    f32x16 O[2]; O[0] = (f32x16){}; O[1] = (f32x16){};
    float lsum = 0.f;
    int nloc = 0, loc0 = 0;
    if (latent) { int kp0 = qpos0 - 128, kp1 = qpos0 + 64 + 128; if (kp0 < 0) kp0 = 0; if (kp1 > SEQ) kp1 = SEQ; nloc = (kp1 - kp0) / 64; loc0 = LC + kp0; }
    const bf16_t* VT = (const bf16_t*)(ws + WS_VTS) + ((size_t)(b * 2 + kvh) * 64) * KEYS;
    attn_core<64, 64, true>(F, U, b, UC_SK + kvh * 64, VT, 4, nloc, loc0, q, 0, qpos0 + 32 * rb, sh2, O, lsum);
    int ln_; asm volatile("v_mbcnt_lo_u32_b32 %0, -1, 0\n\tv_mbcnt_hi_u32_b32 %0, -1, %0" : "=v"(ln_));
    const int r32 = ln_ & 31, hi = ln_ >> 5;
    { int lo_ = l; asm volatile("" : "+s"(lo_)); l = lo_; Pk = kp_opaque(Pk); }
    lsum += __shfl_xor(lsum, 32);
    const float rl = 1.f / (lsum + exp2f(Pk->in[I_SINK][l * 8 + hq] * LOG2E - sh2));
    unsigned char* mix = ws + WS_H + ((size_t)(qrow0 + 32 * rb) * D + 512 + hq * 64) * MIXB;
#pragma unroll
    for (int r = 0; r < 16; ++r) { const float rr = __shfl(rl, crow(r, hi));
#pragma unroll
        for (int nb = 0; nb < 2; ++nb) { const float y = O[nb][r] * rr; const size_t e = (size_t)crow(r, hi) * D + nb * 32 + r32; if (WOUT_F8) mix[e] = f8_1(y); else ((bf16_t*)mix)[e] = (bf16_t)f2bf(y); } }
}
constexpr int HY_PAD = 224, YSTR = 2504, HY_YB = 8 * YSTR * 2, HY_CST = 8224, HY_COP = 2 * HY_YB;
__device__ __forceinline__ void hyena_unit(KP Pk, Frame& F, int l, int cg) {
    unsigned char* ws = F.ws;
    const int r32 = F.lane & 31, hi = F.lane >> 5, bb = r32 >> 2, ib = r32 & 3;
    const bf16_t* ZT = (const bf16_t*)(ws + WS_ZT); bf16_t* OT = (bf16_t*)(ws + WS_OT);
    LAS unsigned char* cop = F.lds + HY_COP;
    const int nseq = l == 0 ? 2 : 1;
#pragma unroll 1
    for (int cs = 0; cs < 4 * nseq; ++cs) {
        const int ci = cs >> (nseq - 1), st = cs & (nseq - 1), ch = cg * 4 + ci, L = st == 0 ? SEQ : LC, nblk = L / 32, pos0 = st == 0 ? 0 : SEQ;
        __syncthreads();
        for (int id = F.tid; id < 8 * (L / 8 + 56); id += NTHR) { const int b = id / (L / 8 + 56), c = id % (L / 8 + 56);
            if (c < L / 8) *(LAS u32x4*)(F.lds + (b * YSTR + HY_PAD + 8 * c) * 2) = *(const u32x4*)(ZT + ((size_t)b * 1536 + 1024 + ch) * KEYS + pos0 + 8 * c);
            else { const int pc = c - L / 8, off = pc < 28 ? 8 * pc : HY_PAD + L + 8 * (pc - 28); const u32x4 z = {0u, 0u, 0u, 0u};
                *(LAS u32x4*)(F.lds + (b * YSTR + off) * 2) = z; *(LAS u32x4*)(F.lds + HY_YB + (b * YSTR + off) * 2) = z; } }
#pragma unroll 1
        for (int o = 0; o < 2; ++o) {
            const bf16_t* R = (const bf16_t*)(ws + WS_HYF) + ((size_t)l * 1024 + o * 512 + ch) * 4608 + (st == 0 ? 0 : 4096);
            for (int xc = F.tid; xc < 2 * L / 8; xc += NTHR) { const u32x4 lo = *(const u32x4*)(R + 8 * xc); u32x4 hh = {0u, 0u, 0u, 0u}; if (8 * xc + 8 < 2 * L) hh = *(const u32x4*)(R + 8 * xc + 8);
                const unsigned w[9] = {lo.x, lo.y, lo.z, lo.w, hh.x, hh.y, hh.z, hh.w, 0u};
#pragma unroll
                for (int r = 0; r < 8; ++r) { u32x4 ov; unsigned t[4];
#pragma unroll
                    for (int k = 0; k < 4; ++k) t[k] = (r & 1) ? ((w[(r >> 1) + k] >> 16) | (w[(r >> 1) + k + 1] << 16)) : w[(r >> 1) + k];
                    ov.x = t[0]; ov.y = t[1]; ov.z = t[2]; ov.w = t[3]; *(LAS u32x4*)(cop + r * HY_CST + 16 * xc) = ov; } }
            __syncthreads();
            const LAS unsigned char* Yin = F.lds + (o == 0 ? 0 : HY_YB); LAS unsigned char* Yout = F.lds + (o == 0 ? HY_YB : 0);
            const float bias = Pk->in[I_HBIAS][(l * 2 + o) * 512 + ch];
            if (2 * F.wave < nblk / 4) {
                const int g0 = 2 * F.wave, dlo = 4 * g0 - nblk + 1, dhi = min(4 * g0 + 7, nblk - 1), nsteps = dhi - dlo + 1;
                const LAS unsigned char* ap = cop + ((-r32) & 7) * HY_CST + ((L - 32 * dlo - r32 + 8 * hi) & ~7) * 2;
                const LAS unsigned char* bp = Yin + (bb * YSTR + HY_PAD + 32 * (4 * g0 + ib - dlo) + 8 * hi) * 2;
                f32x16 acc0 = {}, acc1 = {};
#define HDSR(dst, addr, off) asm volatile("ds_read_b128 %0, %1 offset:%2" : "=v"(dst) : "v"(addr), "n"(off))
#define HWAIT(a, b, c, d) asm volatile("s_waitcnt lgkmcnt(0)" : "+v"(a), "+v"(b), "+v"(c), "+v"(d))
                bf16x8 R[6][2], A2[2][2];
                const unsigned apa = (unsigned)(uintptr_t)ap, bpa = (unsigned)(uintptr_t)bp;
                HDSR(R[2][0], bpa, 256); HDSR(R[2][1], bpa, 256 + 32); HDSR(R[3][0], bpa, 192); HDSR(R[3][1], bpa, 192 + 32);
                HDSR(R[4][0], bpa, 128); HDSR(R[4][1], bpa, 128 + 32); HDSR(R[5][0], bpa, 64); HDSR(R[5][1], bpa, 64 + 32);
                HDSR(R[0][0], bpa, 0); HDSR(R[0][1], bpa, 32); HDSR(A2[0][0], apa, 0); HDSR(A2[0][1], apa, 32);
                HWAIT(R[2][0], R[2][1], R[3][0], R[3][1]); HWAIT(R[4][0], R[4][1], R[5][0], R[5][1]); HWAIT(R[0][0], R[0][1], A2[0][0], A2[0][1]);
#pragma unroll 1
                for (int s0 = 0; s0 < nsteps; s0 += 6) {
                    const unsigned an = apa - (unsigned)(s0 + 6) * 64u, bn = bpa - (unsigned)(s0 + 6) * 64u;
#pragma unroll
                    for (int j = 0; j < 6; ++j) if (s0 + j < nsteps) {
                        if (s0 + j + 1 < nsteps) { HDSR(A2[(j + 1) & 1][0], an, (5 - j) * 64); HDSR(A2[(j + 1) & 1][1], an, (5 - j) * 64 + 32);
                            HDSR(R[(j + 1) % 6][0], bn, (5 - j) * 64); HDSR(R[(j + 1) % 6][1], bn, (5 - j) * 64 + 32); }
                        acc1 = MFMA32(A2[j & 1][0], R[(j + 2) % 6][0], acc1); acc0 = MFMA32(A2[j & 1][0], R[j][0], acc0);
                        acc1 = MFMA32(A2[j & 1][1], R[(j + 2) % 6][1], acc1); acc0 = MFMA32(A2[j & 1][1], R[j][1], acc0);
                        HWAIT(A2[(j + 1) & 1][0], A2[(j + 1) & 1][1], R[(j + 1) % 6][0], R[(j + 1) % 6][1]); }
                }
#undef HDSR
#undef HWAIT
#pragma unroll
                for (int gg = 0; gg < 2; ++gg) { const f32x16& acc = gg == 0 ? acc0 : acc1;
                    const int t0 = 32 * (4 * (g0 + gg) + ib) + 4 * hi;
                    const bf16_t* gp = ZT + ((size_t)bb * 1536 + o * 512 + ch) * KEYS + pos0 + t0;
#pragma unroll
                    for (int q = 0; q < 4; ++q) { const u32x2 yo = *(const LAS u32x2*)(Yin + (bb * YSTR + HY_PAD + t0 + 8 * q) * 2); const u32x2 gt = *(const u32x2*)(gp + 8 * q);
                        const float v0 = bflo(gt.x) * (acc[4 * q + 0] + bflo(yo.x) * bias), v1 = bfhi(gt.x) * (acc[4 * q + 1] + bfhi(yo.x) * bias);
                        const float v2 = bflo(gt.y) * (acc[4 * q + 2] + bflo(yo.y) * bias), v3 = bfhi(gt.y) * (acc[4 * q + 3] + bfhi(yo.y) * bias);
                        u32x2 ov; ov.x = pk2(v0, v1); ov.y = pk2(v2, v3);
                        if (o == 0) *(LAS u32x2*)(Yout + (bb * YSTR + HY_PAD + t0 + 8 * q) * 2) = ov;
                        else *(u32x2*)(OT + ((size_t)bb * 512 + ch) * KEYS + pos0 + t0 + 8 * q) = ov; } }
            }
            __syncthreads();
        }
    }
    VM_WAIT(); __syncthreads();
    const int npos = l == 0 ? KEYS : SEQ;
    for (int id = F.tid; id < 8 * npos; id += NTHR) { const int b = id / npos, pos = id % npos, row = pos < SEQ ? b * SEQ + pos : TL + b * LC + (pos - SEQ);
        const bf16_t* op = OT + ((size_t)b * 512 + cg * 4) * KEYS + pos;
        if (WOUT_F8) *(unsigned*)(ws + WS_H + (size_t)row * D + 1024 + cg * 4) = pk4_f8(bf2f(op[0]), bf2f(op[KEYS]), bf2f(op[2 * KEYS]), bf2f(op[3 * KEYS]));
        else { u32x2 ov; ov.x = (unsigned)op[0] | ((unsigned)op[KEYS] << 16); ov.y = (unsigned)op[2 * KEYS] | ((unsigned)op[3 * KEYS] << 16); *(u32x2*)((bf16_t*)(ws + WS_H) + (size_t)row * D + 1024 + cg * 4) = ov; } }
}
#ifndef MX_MASK
#define MX_MASK 15
#endif
#ifndef PROBE_MX
#define PROBE_MX 0
#endif
__device__ __forceinline__ void ph_mixers(KP Pk, Frame& F, int l, int qid) {
    const int n_diff = 512, n_hy = 128, n_dctx = l == 0 ? 64 : 0, n_swa = 512, n_sctx = l == 0 ? 64 : 0, gpb = l == 0 ? 5 : 4, n_gla = 64 * gpb;
    constexpr int R0 = 1 + ((PROBE_MX >> 0) & 1), R1 = 1 + ((PROBE_MX >> 1) & 1), R2 = 1 + ((PROBE_MX >> 2) & 1), R3 = 1 + ((PROBE_MX >> 3) & 1);
    const int n_mix = R0 * (n_diff + n_dctx) + R1 * n_hy + R2 * (n_swa + n_sctx) + R3 * n_gla + (l == 0 ? 192 + 128 : 0);
    const int n_titems = 16 * TI_GU + 16 * TI_DN + TI_WOUT + (l == 0 ? TI_WIN + TI_WA : 0), NTU = (n_titems + 127) / 128;
    const int total = n_mix + NTU, tplaced = min(NTU, total / 4);
    for (;;) {
        const int s_ = wg_grab(F, qid); if (s_ >= total) break;
        int ut_ = 8; const unsigned long long ut0_ = (PROBE_UT >= 0) ? __builtin_amdgcn_s_memrealtime() : 0ull;
        int u = s_ - min(NTU, s_ / 4), tu = -1;
        if ((s_ & 3) == 3 && (s_ >> 2) < NTU) tu = s_ >> 2; else if (u >= n_mix) tu = tplaced + (u - n_mix);
        if (tu >= 0) { ut_ = 0; LAS float* scr = (LAS float*)(F.lds + F.wave * 8704);
            for (int j = 0; j < 16; ++j) { int x = tu * 128 + F.wave * 16 + j; if (x >= n_titems) break;
                int it;
                if (x < 16 * TI_GU) it = 2 * TI_L + l * 16 * TI_GU + x;
                else if ((x -= 16 * TI_GU) < 16 * TI_DN) it = 2 * TI_L + 32 * TI_GU + l * 16 * TI_DN + x;
                else if ((x -= 16 * TI_DN) < TI_WOUT) it = l * TI_L + TI_WIN + TI_WA + x;
                else it = TI_L + (x - TI_WOUT);
                p0_item(Pk, F, it, scr); }
            goto mx_next; }
        if (u < R1 * n_hy) { ut_ = 3; u %= n_hy; if (MX_MASK & 2) hyena_unit(Pk, F, l, u); goto mx_next; } u -= R1 * n_hy;
        if (u < R3 * n_gla) { u %= n_gla; const int bh = u / gpb, grp = u % gpb, c = (l == 0 ? 0 : 4) + grp * 8 + F.wave;
          __syncthreads();
          if ((MX_MASK & 8) && c < NCH) gla_pass_b(Pk, F, l, bh >> 3, bh & 7, c, F.lds + F.wave * WAVE_LDS);
          goto mx_next; } u -= R3 * n_gla;
        if (u < R0 * n_diff) { ut_ = 4; u %= n_diff; const int b = u >> 6, h = (u >> 4) & 3, qb = u & 15; if (MX_MASK & 1) diff_unit(Pk, F, l, b, h, b * SEQ + 128 * qb, 36); goto mx_next; } u -= R0 * n_diff;
        if (u < R0 * n_dctx) { ut_ = 5; u %= n_dctx; const int b = u >> 3, h = (u >> 1) & 3, qb = u & 1; if (MX_MASK & 1) diff_unit(Pk, F, l, b, h, TL + b * LC + 128 * qb, 4); goto mx_next; } u -= R0 * n_dctx;
        if (l == 0) { if (u < 128) { ut_ = 2; ph_hyena_filters(Pk, F, 128 + u); goto mx_next; } u -= 128;
                      if (u < 192) { ut_ = 1; ada_unit(Pk, F, 192 + u); goto mx_next; } u -= 192; }
        if (u < R2 * n_swa) { ut_ = 6; u %= n_swa; const int b = u >> 6, kvh = (u >> 5) & 1, qb = u & 31; if (MX_MASK & 4) swa_unit(Pk, F, l, b, kvh, b * SEQ + 64 * qb, 64 * qb, true); goto mx_next; } u -= R2 * n_swa;
        if (u < R2 * n_sctx) { ut_ = 7; u %= n_sctx; const int b = u >> 3, kvh = (u >> 2) & 1, qb = u & 3; if (MX_MASK & 4) swa_unit(Pk, F, l, b, kvh, TL + b * LC + 64 * qb, 64 * qb, false); goto mx_next; } u -= R2 * n_sctx;
mx_next: ;
        if (PROBE_UT >= 0 && ut_ == PROBE_UT && l == PROBE_UL && !F.pt_done) { __syncthreads(); F.pt += __builtin_amdgcn_s_memrealtime() - ut0_; F.pt_done = 1; }
    }
}

constexpr int N_PHASES = 22;
#ifndef PH_MASK
#define PH_MASK 0xfffu
#endif
__global__ void __launch_bounds__(NTHR, 2) fwd_kernel(Params Parg) {
    extern __shared__ __attribute__((aligned(16))) unsigned char lds_raw[];
    const KP P0 = (KP)__builtin_amdgcn_kernarg_segment_ptr();
    Frame F;
    F.lds = (LAS unsigned char*)lds_raw; F.MISC = (volatile LAS unsigned*)(F.lds + LDS_MISC);
    const int wave_s = __builtin_amdgcn_readfirstlane((int)threadIdx.x >> 6);
#define TID_REFRESH() do { int t_; asm volatile("v_mbcnt_lo_u32_b32 %0, -1, 0\n\tv_mbcnt_hi_u32_b32 %0, -1, %0" : "=v"(t_)); F.lane = t_; F.wave = wave_s; F.tid = wave_s * 64 + t_; } while (0)
    TID_REFRESH();
    F.pt = 0ull; F.pt_done = 0; F.pt0 = (PROBE_T || PROBE_UT >= 0) ? __builtin_amdgcn_s_memrealtime() : 0ull;
    F.G = gridDim.x; { const int bx = blockIdx.x; F.vcu = (F.G % 8 == 0) ? (bx % 8) * (F.G / 8) + bx / 8 : bx; }
    F.ws = P0->ws; F.ctl = (unsigned*)(P0->ws + WS_CTL);
    for (int u = F.tid; u < 128; u += NTHR) F.MISC[u] = 0u;
    __syncthreads();
    const int lo = P0->ph_lo, hi = P0->ph_hi;
    const bool multi = hi - lo > 1;
    XcdBarrier bar; bar.bar = F.ctl + CW_BAR; bar.x = 0; bar.st = nullptr;
    if (multi) bar = xcd_barrier_post(F.ctl + CW_BAR, F.MISC + 8, F.tid);
#define INR(k) (lo <= (k) && (k) < hi)
#define IN(k, kind) (((PH_MASK >> (kind)) & 1u) && INR(k))
    unsigned long long pt_last = PROBE_T ? __builtin_amdgcn_s_memrealtime() : 0ull, pt_acc = 0ull;
#define PT_MARK(k) do { if (PROBE_T) { const unsigned long long now_ = __builtin_amdgcn_s_memrealtime(); if ((PROBE_T >> (k)) & 1u) pt_acc += now_ - pt_last; pt_last = now_; } } while (0)
#define SEAM(k) do { if (INR(k) && INR((k) + 1)) { bar.bar = (unsigned*)(kp_opaque(P0)->ws + WS_CTL) + CW_BAR; TID_REFRESH(); xcd_barrier(bar, F.tid); } PT_MARK(k); } while (0)
#ifndef PROBE_MASK
#define PROBE_MASK 0u
#endif
#define REP(kind) for (int rep_ = 0; rep_ < (((PROBE_MASK >> (kind)) & 1u) ? 2 : 1); ++rep_)
#define REP_SYNC(kind) do { if (((PROBE_MASK >> (kind)) & 1u) && rep_ == 0 && multi) { TID_REFRESH(); xcd_barrier(bar, F.tid); } } while (0)
#define PHASE_BEGIN() const KP Pk = kp_opaque(P0); unsigned char* ws = Pk->ws; F.ws = ws; F.ctl = (unsigned*)(ws + WS_CTL); \
    TID_REFRESH()
    if (IN(0, 0)) REP(0) { PHASE_BEGIN(); p0_prologue(Pk, F, rep_); PT_MARK(22); REP_SYNC(0); } SEAM(0);
#pragma unroll 1
    for (int l = 0; l < DEPTH; ++l) {
        const int pb = 1 + 10 * l;
        if (IN(pb + 0, 1)) REP(1) { if (rep_ && l) break; PHASE_BEGIN(); if (l == 0) { for (int u = blockIdx.x; u < 128; u += F.G) ph_hyena_filters(Pk, F, u); } ph_norm1(Pk, F, l); if (l == 0) PT_MARK(23); REP_SYNC(1); } SEAM(pb + 0);
        if (IN(pb + 1, 2)) REP(2) { PHASE_BEGIN();
            pg8::Gemm g{(const bf16_t*)(ws + WS_H), (const bf16_t*)(ws + WS_WIN + (size_t)l * NU * D * 2), D, nullptr};
            pg8::RectOrder S; if (l == 0) S.init(72, 21, F.G, (int)blockIdx.x, 0, 0, 0ull); else S.init(64, 21, F.G, (int)blockIdx.x, 64, 64, 0x1413121108030201ull);
            pg8::EpiU E{(bf16_t*)(ws + WS_U), WIN_F8_L(l) ? 1.f / 32.f : 1.f};
            if (WIN_F8_L(l)) pg8::gemm_phase<pg8::EpiU, pg8::RectOrder, false, true>(F.lds, g, S, E, F.tid);
            else pg8::gemm_phase<pg8::EpiU, pg8::RectOrder, false, false>(F.lds, g, S, E, F.tid);
            if (WIN_F8_L(l)) ph_gate_cols8(F, l); else ph_gate_cols(F, l); REP_SYNC(2);
        } SEAM(pb + 1);
        if (IN(pb + 2, 3)) REP(3) { PHASE_BEGIN(); ph_prep(Pk, F, l, rep_); PT_MARK(pb + 3); REP_SYNC(3); } SEAM(pb + 2);
        if (IN(pb + 4, 5)) REP(5) { PHASE_BEGIN(); ph_mixers(Pk, F, l, 1 + l + 2 * rep_); REP_SYNC(5); } SEAM(pb + 4);
        if (IN(pb + 5, 6)) REP(6) { if (rep_ && l) break; PHASE_BEGIN();
            pg8::Gemm g{(const bf16_t*)(ws + WS_H), (const bf16_t*)(ws + WS_WOUT + (size_t)l * D * D * MIXB), D, nullptr};
            pg8::RectOrder S; S.init(l == 0 ? 72 : 64, 8, F.G, (int)blockIdx.x, 0, 0, 0ull);
            pg8::EpiWout E{Pk->in[I_X], Pk->in[I_CTX], l == 0 ? (const bf16_t*)nullptr : (const bf16_t*)(ws + WS_X), (bf16_t*)(ws + WS_X), (const float*)(ws + WS_MOD) + (size_t)l * 9 * 12288};
            pg8::gemm_phase<pg8::EpiWout, pg8::RectOrder, false, WOUT_F8>(F.lds, g, S, E, F.tid); REP_SYNC(6);
        } SEAM(pb + 5);
        if (IN(pb + 6, 7)) REP(7) { PHASE_BEGIN(); ph_norm2_router(Pk, F, l, rep_); REP_SYNC(7); } SEAM(pb + 6);
        if (IN(pb + 7, 8)) { PHASE_BEGIN(); ph_slots(Pk, F, l); } SEAM(pb + 7);
        if (IN(pb + 8, 9)) REP(9) { PHASE_BEGIN();
            const int np = moe_table(F, l);
            pg8::Gemm g{(const bf16_t*)(ws + WS_H), (const bf16_t*)(ws + WS_WGU + (size_t)l * NE * 2048 * D), D, (const int*)(ws + WS_RT + RT_ROWTOK)};
            pg8::MoeOrder S{np, F.G, F.vcu, (const volatile LAS unsigned char*)(F.MISC + 64)};
            pg8::EpiMoe1 E{ws + WS_U};
            pg8::gemm_phase<pg8::EpiMoe1, pg8::MoeOrder, true, true>(F.lds, g, S, E, F.tid); REP_SYNC(9);
        } SEAM(pb + 8);
        if (IN(pb + 9, 10)) REP(10) { PHASE_BEGIN();
            const int np = moe_table(F, l);
            pg8::Gemm g{(const bf16_t*)(ws + WS_U), (const bf16_t*)(ws + WS_WD + (size_t)l * NE * D * DE), DE, nullptr};
            pg8::MoeOrder S{np, F.G, F.vcu, (const volatile LAS unsigned char*)(F.MISC + 64)};
            pg8::EpiMoe2 E{ws + WS_Y2, (const int*)(ws + WS_RT + RT_ROWTOK), (const float*)(ws + WS_RT + RT_ROWW)};
            pg8::gemm_phase<pg8::EpiMoe2, pg8::MoeOrder, false, true>(F.lds, g, S, E, F.tid); REP_SYNC(10);
        } SEAM(pb + 9);
    }
    if (IN(21, 11)) REP(11) { PHASE_BEGIN(); ph_final(Pk, F); REP_SYNC(11); }
    if (PROBE_T || PROBE_UT >= 0) { PT_MARK(21); if (blockIdx.x == PROBE_WG) { const unsigned long long t0_ = __builtin_amdgcn_s_memrealtime(); while (__builtin_amdgcn_s_memrealtime() - t0_ < 8ull * (pt_acc + F.pt)) __builtin_amdgcn_s_sleep(8); } }
#undef IN
#undef INR
#undef SEAM
#undef PT_MARK
#undef PHASE_BEGIN
#undef REP
#undef REP_SYNC
#undef TID_REFRESH
}

#ifndef MK_PER_PHASE
#define MK_PER_PHASE 0
#endif
extern "C" void kernel_launch(void* const* d_in, const int* in_sizes, int n_in, void* d_out, int out_size, void* d_ws, size_t ws_size, hipStream_t stream) {
    static int grid = 0;
    if (grid == 0) {
        if (n_in != 34 || in_sizes[0] != TL * D || out_size != TL * D || ws_size < WS_END) { fprintf(stderr, "kernel_launch: unexpected shapes (n_in %d, in0 %d, out %d, ws %zu < %zu)\n", n_in, n_in > 0 ? in_sizes[0] : -1, out_size, ws_size, (size_t)WS_END); grid = -1; return; }
        int dev = 0, cus = 0, per_cu = 0;
        if (hipGetDevice(&dev) != hipSuccess || hipDeviceGetAttribute(&cus, hipDeviceAttributeMultiprocessorCount, dev) != hipSuccess) { grid = -1; return; }
        if (hipFuncSetAttribute((const void*)fwd_kernel, hipFuncAttributeMaxDynamicSharedMemorySize, LDS_BYTES) != hipSuccess) { fprintf(stderr, "kernel_launch: hipFuncSetAttribute failed\n"); grid = -1; return; }
        if (hipOccupancyMaxActiveBlocksPerMultiprocessor(&per_cu, (const void*)fwd_kernel, NTHR, LDS_BYTES) != hipSuccess || per_cu < 1) fprintf(stderr, "kernel_launch: occupancy query reports %d\n", per_cu);
        (void)hipGetLastError();
        grid = cus;
    }
    if (grid < 0) return;
    (void)hipMemsetAsync((char*)d_ws + WS_CTL, 0, CTL_BYTES, stream);
    Params p{};
    for (int i = 0; i < 34; ++i) p.in[i] = (const float*)d_in[i];
    p.out = (float*)d_out; p.ws = (unsigned char*)d_ws;
#if MK_PER_PHASE
    for (int k = 0; k < N_PHASES; ++k) { p.ph_lo = k; p.ph_hi = k + 1; hipLaunchKernelGGL(fwd_kernel, dim3(grid), dim3(NTHR), LDS_BYTES, stream, p); }
#else
    p.ph_lo = 0; p.ph_hi = N_PHASES; hipLaunchKernelGGL(fwd_kernel, dim3(grid), dim3(NTHR), LDS_BYTES, stream, p);
#endif
    const hipError_t le = hipPeekAtLastError();
    if (le != hipSuccess) fprintf(stderr, "kernel_launch: launch failed: %s\n", hipGetErrorName(le));
}
```

```cpp
#include <hip/hip_runtime.h>
#include <cstdio>
#include <cstdint>

#define LAS __attribute__((address_space(3)))
#define GAS __attribute__((address_space(1)))
typedef unsigned short bf16_t;
typedef short bf16x8 __attribute__((ext_vector_type(8)));
typedef float f32x2 __attribute__((ext_vector_type(2)));
typedef float f32x4 __attribute__((ext_vector_type(4)));
typedef float f32x16 __attribute__((ext_vector_type(16)));
typedef unsigned u32x2 __attribute__((ext_vector_type(2)));
typedef unsigned u32x4 __attribute__((ext_vector_type(4)));
typedef int i32x4 __attribute__((ext_vector_type(4)));
typedef int i32x8 __attribute__((ext_vector_type(8)));

#ifndef PROBE_T
#define PROBE_T 0u
#endif
#ifndef PROBE_WG
#define PROBE_WG 0
#endif
#ifndef PROBE_UT
#define PROBE_UT -1
#endif
#ifndef PROBE_UL
#define PROBE_UL 0
#endif
constexpr int D = 2048, NB = 8, SEQ = 2048, LC = 256, DEPTH = 2;
constexpr int TL = NB * SEQ, TCX = NB * LC, TT = TL + TCX;
constexpr int DIN = 5408, NU = 5376, NE = 16, DE = 1024;
constexpr int KEYS = LC + SEQ;
constexpr int UC_GQ = 0, UC_GK = 256, UC_GV = 512, UC_GG = 1024, UC_SQ = 1536, UC_SK = 2048, UC_SV = 2176, UC_HY = 2304, UC_DQ = 3840, UC_DK = 4352, UC_DV = 4864;
constexpr int MOE_ROWS = 2 * TT + NE * 256;
constexpr int MOE_PANELS = MOE_ROWS / 256;
constexpr int GCH = 64, NCH = KEYS / GCH;
constexpr float NORM_EPS = 1e-6f;
constexpr float LOG2E = 1.4426950408889634f;

constexpr size_t MiB = 1u << 20;
constexpr size_t WS_CTL = 0, CTL_BYTES = 1 * MiB;
constexpr size_t WS_MOD = 1 * MiB;
constexpr size_t WS_ROPE = 2 * MiB;
constexpr size_t WS_HYH2 = 3 * MiB;
constexpr size_t WS_WA = 5 * MiB;
constexpr size_t WS_RT = 6 * MiB;
constexpr size_t WS_AG = 7 * MiB;
constexpr size_t WS_HYF = 10 * MiB;
constexpr size_t WS_WIN = 28 * MiB;
constexpr size_t WS_WOUT = 70 * MiB;
constexpr size_t WS_WGU = 86 * MiB;
constexpr size_t WS_WD = 342 * MiB;
constexpr size_t WS_X = 470 * MiB;
constexpr size_t WS_H = 614 * MiB;
constexpr size_t WS_U = 686 * MiB;
constexpr size_t WS_B = 875 * MiB;
constexpr size_t WS_VTD = WS_B;
constexpr size_t WS_VTS = WS_B + 18 * MiB;
constexpr size_t WS_ZT = WS_B + 23 * MiB;
constexpr size_t WS_OT = WS_B + 77 * MiB;
constexpr size_t WS_GSL = WS_B + 95 * MiB;
constexpr size_t WS_GSS = WS_B + 131 * MiB;
constexpr size_t WS_GAE = WS_B + 167 * MiB;
constexpr size_t WS_Y2 = WS_B;
constexpr size_t WS_HB = 1043 * MiB;
constexpr size_t WS_END = 1115 * MiB;
constexpr int WIN_F8_MASK = 3;
#define WIN_F8_L(l) (((WIN_F8_MASK) >> (l)) & 1)
constexpr bool WOUT_F8 = true;
constexpr int MIXB = WOUT_F8 ? 1 : 2;
constexpr size_t RT_E = 0;
constexpr size_t RT_W = 128 * 1024;
constexpr size_t RT_ROWTOK = 320 * 1024;
constexpr size_t RT_ROWW = 512 * 1024;
constexpr int CW_BAR = 4096;
constexpr int CW_CNT = 16384;
constexpr int CW_CUR = 16384 + 256;
constexpr int CW_HYC = 16384 + 512, CW_ADAC = 16384 + 576;
constexpr int CW_Q = 16384 + 1024;

constexpr int LDS_BYTES = 155648;
constexpr int LDS_MISC = LDS_BYTES - 512;
constexpr int NWAVES = 8, NTHR = 512;

__device__ __forceinline__ unsigned f2bf(float f) { unsigned u = __builtin_bit_cast(unsigned, f); return (u + 0x7fffu + ((u >> 16) & 1u)) >> 16; }
#ifndef EMU8
#define EMU8 0
#endif
__device__ __forceinline__ float q8(float f) { unsigned u = __builtin_bit_cast(unsigned, f); u = (u + 0x7ffffu + ((u >> 20) & 1u)) & 0xfff00000u; return __builtin_bit_cast(float, u); }
__device__ __forceinline__ unsigned pk2(float lo, float hi) { return f2bf(lo) | (f2bf(hi) << 16); }
__device__ __forceinline__ unsigned pk2q(float lo, float hi) { return f2bf(q8(lo)) | (f2bf(q8(hi)) << 16); }
__device__ __forceinline__ unsigned pk4_f8(float a, float b, float c, float d) {
    a = fminf(fmaxf(a, -448.f), 448.f); b = fminf(fmaxf(b, -448.f), 448.f); c = fminf(fmaxf(c, -448.f), 448.f); d = fminf(fmaxf(d, -448.f), 448.f);
    int r = 0; r = __builtin_amdgcn_cvt_pk_fp8_f32(a, b, r, false); r = __builtin_amdgcn_cvt_pk_fp8_f32(c, d, r, true); return (unsigned)r; }
__device__ __forceinline__ unsigned char f8_1(float a) { a = fminf(fmaxf(a, -448.f), 448.f); return (unsigned char)(__builtin_amdgcn_cvt_pk_fp8_f32(a, a, 0, false) & 0xff); }
__device__ __forceinline__ float bf2f(unsigned short b) { return __builtin_bit_cast(float, ((unsigned)b) << 16); }
__device__ __forceinline__ float bflo(unsigned w) { return __builtin_bit_cast(float, w << 16); }
__device__ __forceinline__ float bfhi(unsigned w) { return __builtin_bit_cast(float, w & 0xffff0000u); }
__device__ __forceinline__ float wave_sum(float v) {
#pragma unroll
    for (int o = 1; o < 64; o <<= 1) v += __shfl_xor(v, o);
    return v;
}
__device__ __forceinline__ float silu_f(float x) { return x / (1.f + __expf(-x)); }
#define LDS_WAIT() asm volatile("s_waitcnt lgkmcnt(0)" ::: "memory")
#define VM_WAIT() asm volatile("s_waitcnt vmcnt(0)" ::: "memory")

#define XB_TMO      128
#define XB_XCNT(j)  (256  + 64 * (j))
#define XB_XSUB(j)  (1280 + 64 * (j))
#define XB_XGEN(j)  (2304 + 64 * (j))
#define XB_TOP      3328
#define XB_TOPGEN   3392
#define XCD_BAR_WORDS 3456
#define XB_SPIN_CAP (1u << 18)
__device__ __forceinline__ unsigned xb_ld(unsigned* p)              { return __hip_atomic_load(p, __ATOMIC_RELAXED, __HIP_MEMORY_SCOPE_AGENT); }
__device__ __forceinline__ unsigned xb_add(unsigned* p, unsigned v) { return __hip_atomic_fetch_add(p, v, __ATOMIC_RELAXED, __HIP_MEMORY_SCOPE_AGENT); }
__device__ __forceinline__ unsigned xb_xcc_id() { return (unsigned)__builtin_amdgcn_s_getreg((3 << 11) | 20) & 0xFu; }
#define XB_SPIN(cond, bar) do { unsigned _sp = 0; while (cond) { __builtin_amdgcn_s_sleep(1); \
    if ((++_sp & 255u) == 0u) { if (xb_ld(&(bar)[XB_TMO])) break; if (_sp > XB_SPIN_CAP) { atomicAdd(&(bar)[XB_TMO], 1u); break; } } } } while (0)
struct XcdBarrier { unsigned* bar; unsigned x; volatile LAS unsigned* st; };
__device__ __forceinline__ XcdBarrier xcd_barrier_post(unsigned* bar, volatile LAS unsigned* st, int tid) {
    XcdBarrier b; b.bar = bar; b.x = xb_xcc_id(); b.st = st;
    if (tid == 0) (void)xb_add(&bar[XB_XCNT(b.x)], 1u);
    return b;
}
__device__ __forceinline__ void xcd_barrier_complete(unsigned* bar, unsigned x, unsigned& nloc, unsigned& nx) {
    const unsigned G = gridDim.x * gridDim.y * gridDim.z;
    unsigned sum, cnt, mine, sp = 0u;
    for (;;) {
        sum = 0u; cnt = 0u; mine = 0u;
#pragma unroll
        for (unsigned j = 0; j < 16; ++j) { const unsigned c = xb_ld(&bar[XB_XCNT(j)]); sum += c; cnt += (c > 0u) ? 1u : 0u; mine = (j == x) ? c : mine; }
        if (sum == G) break;
        __builtin_amdgcn_s_sleep(1);
        if ((++sp & 255u) == 0u) { if (xb_ld(&bar[XB_TMO])) break; if (sp > XB_SPIN_CAP) { atomicAdd(&bar[XB_TMO], 1u); break; } }
    }
    nloc = mine > 0u ? mine : 1u; nx = cnt > 0u ? cnt : 1u;
}
__device__ __forceinline__ void xcd_barrier(const XcdBarrier& b, int tid) {
    asm volatile("s_waitcnt vmcnt(0)" ::: "memory");
    __syncthreads();
    if (tid == 0) {
        unsigned* bar = b.bar;
        __builtin_amdgcn_s_waitcnt(0);
        unsigned nloc = b.st[0], nx = b.st[1];
        if (nloc == 0u) { xcd_barrier_complete(bar, b.x, nloc, nx); b.st[0] = nloc; b.st[1] = nx; }
        const unsigned old = xb_add(&bar[XB_XSUB(b.x)], 1u);
        const unsigned gen = old / nloc;
        if (old + 1u == (gen + 1u) * nloc) {
            __builtin_amdgcn_fence(__ATOMIC_RELEASE, "agent");
            asm volatile("s_waitcnt vmcnt(0)" ::: "memory");
            const unsigned og = xb_add(&bar[XB_TOP], 1u);
            const unsigned tg = og / nx;
            if (og + 1u == (tg + 1u) * nx) xb_add(&bar[XB_TOPGEN], 1u);
            else XB_SPIN(xb_ld(&bar[XB_TOPGEN]) == tg, bar);
            __builtin_amdgcn_fence(__ATOMIC_ACQUIRE, "agent");
            xb_add(&bar[XB_XGEN(b.x)], 1u);
            asm volatile("s_waitcnt vmcnt(0)" ::: "memory");
        } else {
            XB_SPIN(xb_ld(&bar[XB_XGEN(b.x)]) == gen, bar);
            __builtin_amdgcn_fence(__ATOMIC_ACQUIRE, "agent");
            asm volatile("s_waitcnt vmcnt(0)" ::: "memory");
        }
    }
    __syncthreads();
}

namespace pg8 {
constexpr int BM = 256, BK = 64, HALF = 128, HTB = HALF * BK * 2, STAGE_BYTES = 8 * HTB;
__host__ __device__ __forceinline__ int lds_byte(int r, int c) { const int st = (r >> 4) * 2 + (c >> 5), rr = r & 15, cc = c & 31, ob = rr * 64 + cc * 2; return st * 1024 + (ob ^ (((ob >> 9) & 1) << 5)); }
__host__ __device__ __forceinline__ void stage_rc(int b, int& R, int& C) { const int st = b / 1024, sb = b % 1024, swz = sb ^ (((sb >> 9) & 1) << 5); R = (st >> 1) * 16 + swz / 64; C = (st & 1) * 32 + (swz % 64) / 2; }
__host__ __device__ __forceinline__ int lds_byte8(int r, int cb) { const int st = (r >> 4) * 2 + (cb >> 6), rr = r & 15, ob = rr * 64 + (cb & 63); return st * 1024 + (ob ^ (((ob >> 9) & 1) << 4)); }
__host__ __device__ __forceinline__ void stage_rc8(int b, int& R, int& Cb) { const int st = b / 1024, sb = b % 1024, swz = sb ^ (((sb >> 9) & 1) << 4); R = (st >> 1) * 16 + swz / 64; Cb = (st & 1) * 64 + (swz % 64); }
__host__ __device__ __forceinline__ int perm32(int rho) { const int n = rho >> 4, i = rho & 15; return 8 * (i >> 2) + 4 * n + (i & 3); }
struct Unit { int pm, pn; };
struct Gemm { const bf16_t* A; const bf16_t* Bt; int K; const int* rowtab; };
__device__ __forceinline__ unsigned cvt_pk_bf16(float lo, float hi) { unsigned r; asm volatile("v_cvt_pk_bf16_f32 %0, %1, %2" : "=v"(r) : "v"(lo), "v"(hi)); return r; }

template <class Epi, class Sched, bool GATHER, bool F8 = false>
__device__ __forceinline__ void gemm_phase(LAS unsigned char* lds, const Gemm g, const Sched& S, const Epi& E, const int tid) {
    const int wid = __builtin_amdgcn_readfirstlane(tid >> 6), lane = tid & 63, wr = wid >> 2, wc = wid & 3, fr = lane & 15, fq = lane >> 4;
    const int K = g.K, RB = F8 ? K : 2 * K, nt = RB / 128;
    unsigned voffB[2], voffA[2];
#pragma unroll
    for (int i = 0; i < 2; ++i) { int R, Cb; if constexpr (F8) stage_rc8(tid * 16 + i * 8192, R, Cb); else { int C; stage_rc(tid * 16 + i * 8192, R, C); Cb = 2 * C; }
        const int Rb = Epi::LINE64 ? (64 * (R >> 5) + perm32(R & 31)) : Epi::PERM ? ((R & ~31) + perm32(R & 31)) : R;
        voffA[i] = (unsigned)(R * RB + Cb); voffB[i] = (unsigned)(Rb * RB + Cb); }
    const size_t kstep = 128;
    const size_t hstep = (size_t)HALF * RB;
    const size_t hstepB = Epi::LINE64 ? (size_t)32 * RB : hstep;
    const size_t tstep = 2 * hstep;
    const unsigned ldsw = (unsigned)wid * 1024u;
    const int aoff = F8 ? lds_byte8(wr * 64 + fr, 32 * fq) : lds_byte(wr * 64 + fr, fq * 8), boff = F8 ? lds_byte8(wc * 32 + fr, 32 * fq) : lds_byte(wc * 32 + fr, fq * 8);
    const int aoff2 = aoff ^ 16, boff2 = boff ^ 16;
#define PG8_SA(b, h) (((b) * 2 + (h)) * HTB)
#define PG8_SB(b, h) ((4 + (b) * 2 + (h)) * HTB)
#define PG8_STAGE(bufoff, gbase, voff) do { _Pragma("unroll") for (int _i = 0; _i < 2; ++_i) \
        __builtin_amdgcn_global_load_lds((const unsigned*)((const char*)(gbase) + (voff)[_i]), (LAS unsigned*)(lds + (bufoff) + ldsw + _i * 8192), 16, 0, 0); } while (0)
#define PG8_LDA(dst, b, h) do { if constexpr (F8) { _Pragma("unroll") for (int m = 0; m < 4; ++m) { const i32x4 _lo = *(const LAS i32x4*)(lds + PG8_SA(b, h) + aoff + m * 2048), _hi = *(const LAS i32x4*)(lds + PG8_SA(b, h) + aoff2 + m * 2048); dst##8[m] = __builtin_shufflevector(_lo, _hi, 0, 1, 2, 3, 4, 5, 6, 7); } } \
        else { _Pragma("unroll") for (int m = 0; m < 4; ++m) _Pragma("unroll") for (int k = 0; k < 2; ++k) dst[m][k] = *(const LAS bf16x8*)(lds + PG8_SA(b, h) + aoff + m * 2048 + k * 1024); } } while (0)
#define PG8_LDB(dst, b, h) do { if constexpr (F8) { _Pragma("unroll") for (int n = 0; n < 2; ++n) { const i32x4 _lo = *(const LAS i32x4*)(lds + PG8_SB(b, h) + boff + n * 2048), _hi = *(const LAS i32x4*)(lds + PG8_SB(b, h) + boff2 + n * 2048); dst##8[n] = __builtin_shufflevector(_lo, _hi, 0, 1, 2, 3, 4, 5, 6, 7); } } \
        else { _Pragma("unroll") for (int n = 0; n < 2; ++n) _Pragma("unroll") for (int k = 0; k < 2; ++k) dst[n][k] = *(const LAS bf16x8*)(lds + PG8_SB(b, h) + boff + n * 2048 + k * 1024); } } while (0)
#define PG8_CAT(x) __builtin_shufflevector(x[0], x[1], 0, 1, 2, 3, 4, 5, 6, 7)
#define PG8_MMA(ai, bj, At, Bt) do { __builtin_amdgcn_s_setprio(1); if constexpr (F8) { _Pragma("unroll") for (int m = 0; m < 4; ++m) _Pragma("unroll") for (int n = 0; n < 2; ++n) \
            asm volatile("v_mfma_scale_f32_16x16x128_f8f6f4 %0, %1, %2, %0, %3, %3 op_sel_hi:[0,0,0]" : "+v"(acc[ai][bj][m][n]) : "v"(Bt##8[n]), "v"(At##8[m]), "v"(f8scale)); } \
        else { _Pragma("unroll") for (int m = 0; m < 4; ++m) _Pragma("unroll") for (int n = 0; n < 2; ++n) _Pragma("unroll") for (int k = 0; k < 2; ++k) \
            acc[ai][bj][m][n] = __builtin_amdgcn_mfma_f32_16x16x32_bf16(Bt[n][k], At[m][k], acc[ai][bj][m][n], 0, 0, 0); } __builtin_amdgcn_s_setprio(0); } while (0)
#define PG8_WAIT_V(n) asm volatile("s_waitcnt vmcnt(" #n ")" ::: "memory")
#define PG8_WAIT_L(n) asm volatile("s_waitcnt lgkmcnt(" #n ")" ::: "memory")
#define PG8_BAR __builtin_amdgcn_s_barrier()
#define PG8_SCHED __builtin_amdgcn_sched_barrier(0)
#define PG8_AOFF(o, u) do { int _t2 = tid; asm volatile("" : "+v"(_t2)); _Pragma("unroll") for (int _i = 0; _i < 2; ++_i) { int _R, _Cb; if constexpr (F8) stage_rc8(_t2 * 16 + _i * 8192, _R, _Cb); else { int _C; stage_rc(_t2 * 16 + _i * 8192, _R, _C); _Cb = 2 * _C; } \
        _Pragma("unroll") for (int _h = 0; _h < 2; ++_h) { int _r = (u).pm * BM + _h * HALF + _R; \
        { const int _t = g.rowtab[_r]; _r = _t < 0 ? 0 : (_t & 0x3fffffff); } o[_h][_i] = (unsigned)(_r * RB + _Cb); } } } while (0)
    Unit cur, nxt; int ui = 0;
    if (!S.next(0, cur)) return;
    f32x4 acc[2][2][4][2];
#pragma unroll
    for (int a = 0; a < 2; ++a)
#pragma unroll
        for (int b = 0; b < 2; ++b)
#pragma unroll
            for (int m = 0; m < 4; ++m)
#pragma unroll
                for (int n = 0; n < 2; ++n) acc[a][b][m][n] = (f32x4){0.f, 0.f, 0.f, 0.f};
    bf16x8 At[4][2], B0[2][2], B1[2][2];
    i32x8 At8[4], B08[2], B18[2];
    int f8scale = 0x7f7f7f7f; asm volatile("" : "+v"(f8scale));
    unsigned oc[2][2], on[2][2];
    const char* gA = (const char*)g.A;
    const char* cA = gA; const char* cB = (const char*)g.Bt + (size_t)cur.pn * tstep;
    if constexpr (GATHER) { PG8_AOFF(oc, cur); } else { cA = gA + (size_t)cur.pm * tstep; }
#define PG8_STA_CUR(buf, kb, h) do { if constexpr (GATHER) { PG8_STAGE(buf, gA + (kb), oc[h]); } else { PG8_STAGE(buf, cA + (kb) + (h) * hstep, voffA); } } while (0)
#define PG8_STA_SEL(buf, kb, h) do { if constexpr (GATHER) { if (last) { PG8_STAGE(buf, gA + (kb), on[h]); } else { PG8_STAGE(buf, gA + (kb), oc[h]); } } else { PG8_STAGE(buf, a2p + (kb) + (h) * hstep, voffA); } } while (0)
    PG8_STAGE(PG8_SB(0, 0), cB, voffB); PG8_STAGE(PG8_SB(0, 1), cB + hstepB, voffB); PG8_STA_CUR(PG8_SA(0, 0), 0, 0); PG8_STA_CUR(PG8_SA(0, 1), 0, 1);
    if (wr == 1) PG8_BAR;
    PG8_WAIT_V(2); PG8_BAR;
    PG8_STAGE(PG8_SB(1, 0), cB + kstep, voffB); PG8_STA_CUR(PG8_SA(1, 0), kstep, 0); PG8_STAGE(PG8_SB(1, 1), cB + hstepB + kstep, voffB);
    PG8_WAIT_V(6); PG8_BAR;
    for (;;) {
        const bool has_next = S.next(ui + 1, nxt);
        const char* nA = cA;
        if constexpr (!GATHER) { if (has_next) nA = gA + (size_t)nxt.pm * tstep; }
        const char* nB = has_next ? (const char*)g.Bt + (size_t)nxt.pn * tstep : cB;
#pragma unroll 1
        for (int t = 0; t < nt; t += 2) {
            const bool last = (t == nt - 2);
            int to = t; asm volatile("" : "+s"(to));
            const size_t k1 = (size_t)(to + 1) * kstep, k2 = last ? 0 : (size_t)(to + 2) * kstep, k3 = k2 + kstep;
            const char* b2 = last ? nB : cB + (size_t)(to + 2) * kstep; const char* b3 = b2 + kstep;
            const char* a2p = last ? nA : cA;
            if constexpr (GATHER) { if (last) { if (has_next) { PG8_AOFF(on, nxt); } else {
#pragma unroll
                for (int h = 0; h < 2; ++h)
#pragma unroll
                    for (int i = 0; i < 2; ++i) on[h][i] = oc[h][i]; } } }
            PG8_LDB(B0, 0, 0); PG8_LDB(B1, 0, 1); PG8_SCHED; PG8_LDA(At, 0, 0); PG8_STA_CUR(PG8_SA(1, 1), k1, 1);
            PG8_WAIT_V(8); PG8_WAIT_L(0); PG8_BAR; PG8_MMA(0, 0, At, B0); PG8_MMA(0, 1, At, B1); PG8_BAR; PG8_SCHED;
            PG8_LDA(At, 0, 1); PG8_STAGE(PG8_SB(0, 0), b2, voffB); PG8_STAGE(PG8_SB(0, 1), b2 + hstepB, voffB); PG8_STA_SEL(PG8_SA(0, 0), k2, 0);
            PG8_WAIT_V(8); PG8_WAIT_L(0); PG8_BAR; PG8_MMA(1, 0, At, B0); PG8_MMA(1, 1, At, B1); PG8_BAR; PG8_SCHED;
            PG8_LDB(B0, 1, 0); PG8_LDB(B1, 1, 1); PG8_SCHED; PG8_LDA(At, 1, 0); PG8_STA_SEL(PG8_SA(0, 1), k2, 1);
            PG8_WAIT_V(8); PG8_WAIT_L(0); PG8_BAR; PG8_MMA(0, 0, At, B0); PG8_MMA(0, 1, At, B1); PG8_BAR; PG8_SCHED;
            PG8_LDA(At, 1, 1); PG8_STAGE(PG8_SB(1, 0), b3, voffB); PG8_STAGE(PG8_SB(1, 1), b3 + hstepB, voffB); PG8_STA_SEL(PG8_SA(1, 0), k3, 0);
            PG8_WAIT_V(8); PG8_WAIT_L(0); PG8_BAR; PG8_MMA(1, 0, At, B0); PG8_MMA(1, 1, At, B1); PG8_BAR; PG8_SCHED;
        }
        if (wr == 0) PG8_BAR;
        if constexpr (F8) asm volatile("s_nop 15\n\ts_nop 15" : "+v"(acc[1][1][0][0]), "+v"(acc[1][1][0][1]), "+v"(acc[1][1][1][0]), "+v"(acc[1][1][1][1]), "+v"(acc[1][1][2][0]), "+v"(acc[1][1][2][1]), "+v"(acc[1][1][3][0]), "+v"(acc[1][1][3][1]) :: "memory");
        E(acc, cur, wr, wc, fr, fq);
        if (!has_next) break;
#pragma unroll
        for (int a = 0; a < 2; ++a)
#pragma unroll
            for (int b = 0; b < 2; ++b)
#pragma unroll
                for (int m = 0; m < 4; ++m)
#pragma unroll
                    for (int n = 0; n < 2; ++n) acc[a][b][m][n] = (f32x4){0.f, 0.f, 0.f, 0.f};
        cur = nxt; cB = nB; cA = nA; ++ui;
        if constexpr (GATHER) {
#pragma unroll
            for (int h = 0; h < 2; ++h)
#pragma unroll
                for (int i = 0; i < 2; ++i) oc[h][i] = on[h][i]; }
        if (wr == 1) PG8_BAR;
    }
#undef PG8_STA_CUR
#undef PG8_STA_SEL
    PG8_WAIT_V(0);
    PG8_BAR;
#undef PG8_SA
#undef PG8_SB
#undef PG8_STAGE
#undef PG8_LDA
#undef PG8_LDB
#undef PG8_CAT
#undef PG8_MMA
#undef PG8_WAIT_V
#undef PG8_WAIT_L
#undef PG8_BAR
#undef PG8_SCHED
#undef PG8_AOFF
}
}

struct Params { const float* in[34]; float* out; unsigned char* ws; int ph_lo, ph_hi; };
typedef const __attribute__((address_space(4))) Params* KP;
__device__ __forceinline__ KP kp_opaque(KP p) { asm volatile("" : "+s"(p)); return p; }
enum { I_X = 0, I_C, I_CTX, I_CCTX, I_N1W, I_N2W, I_ADAW, I_ADAB, I_WIN, I_WOUT, I_GGW, I_GGB, I_GNW, I_SQN, I_SKN, I_SINK, I_HCW, I_HCB, I_HW1, I_HB1, I_HW2, I_HB2, I_HW3, I_HFR, I_HBIAS,
       I_DQN, I_DKN, I_DLAM, I_DSUB, I_RW, I_RB, I_EG, I_EU, I_ED };
struct Frame {
    LAS unsigned char* lds; volatile LAS unsigned* MISC; unsigned* ctl;
    int tid, lane, wave, vcu, G;
    unsigned char* ws;
    unsigned long long pt, pt0; int pt_done;
};
__device__ __forceinline__ int modrow_of(int row) { return row < TL ? (row >> 11) : 8; }
__device__ __forceinline__ int keyrow(int b, int kidx) { return kidx < LC ? TL + b * LC + kidx : b * SEQ + (kidx - LC); }
__device__ __forceinline__ int wg_grab(Frame& F, int q) {
    __syncthreads();
    if (F.tid == 0) F.MISC[0] = __hip_atomic_fetch_add(F.ctl + CW_Q + 64 * q, 1u, __ATOMIC_RELAXED, __HIP_MEMORY_SCOPE_AGENT);
    __syncthreads();
    { int t_; asm volatile("v_mbcnt_lo_u32_b32 %0, -1, 0\n\tv_mbcnt_hi_u32_b32 %0, -1, %0" : "=v"(t_)); F.lane = t_; F.tid = F.wave * 64 + t_; }
    return (int)F.MISC[0];
}

namespace pg8 {
constexpr int NXCD = 8, WGM = 8;
struct RectOrder {
    int nM, nN, nwg, G, c, nextra, xpm0; unsigned long long xt;
    __device__ void init(int nM_, int nN_, int G_, int c_, int nextra_, int xpm0_, unsigned long long xt_) { nM = nM_; nN = nN_; nwg = nM * nN; G = G_; c = c_; nextra = nextra_; xpm0 = xpm0_; xt = xt_; }
    __device__ bool next(int i, Unit& u) const {
        const int L = i * G + c; if (L >= nwg + nextra) return false;
        if (L >= nwg) { const int e = L - nwg; u.pm = xpm0 + (e >> 3); u.pn = (int)((xt >> (8 * (e & 7))) & 0xffull); return true; }
        int wgid = L; { const int q = nwg / NXCD, r = nwg % NXCD, xcd = wgid % NXCD, off = wgid / NXCD; wgid = (xcd < r ? xcd * (q + 1) : r * (q + 1) + (xcd - r) * q) + off; }
        const int nig = WGM * nN, gid = wgid / nig, fm = gid * WGM, gsz = (nM - fm) < WGM ? (nM - fm) : WGM;
        u.pm = fm + ((wgid % nig) % gsz); u.pn = (wgid % nig) / gsz; return true;
    }
};
struct MoeOrder {
    int npanels, G, vcu; const volatile LAS unsigned char* pexp;
    __device__ bool next(int i, Unit& u) const {
        const int L = i * G + vcu; if (L >= npanels * 8) return false;
        const int p = L >> 3; u.pm = p; u.pn = (int)pexp[p] * 8 + (L & 7); return true;
    }
};
struct EpiU {
    static constexpr bool PERM = true, LINE64 = true;
    bf16_t* O; float scale;
    __device__ __forceinline__ void operator()(const f32x4 (&acc)[2][2][4][2], const Unit& u, int wr, int wc, int fr, int fq) const {
        const int row0 = u.pm * BM + wr * 64 + fr, col0 = u.pn * BM + wc * 64 + 8 * fq;
#pragma unroll
        for (int ai = 0; ai < 2; ++ai)
#pragma unroll
            for (int m = 0; m < 4; ++m) { bf16_t* rowp = O + (size_t)(row0 + ai * HALF + m * 16) * NU + col0;
#pragma unroll
                for (int bj = 0; bj < 2; ++bj) { const f32x4 v0 = acc[ai][bj][m][0] * scale, v1 = acc[ai][bj][m][1] * scale;
                    u32x4 w; w.x = cvt_pk_bf16(v0[0], v0[1]); w.y = cvt_pk_bf16(v0[2], v0[3]); w.z = cvt_pk_bf16(v1[0], v1[1]); w.w = cvt_pk_bf16(v1[2], v1[3]);
                    *(u32x4*)(rowp + bj * 32) = w; } }
    }
};
struct EpiWout {
    static constexpr bool PERM = true, LINE64 = false;
    const float* res_lat; const float* res_ctx; const bf16_t* resb; bf16_t* X; const float* mod;
    __device__ __forceinline__ void operator()(const f32x4 (&acc)[2][2][4][2], const Unit& u, int wr, int wc, int fr, int fq) const {
        const int row0 = u.pm * BM + wr * 64 + fr, col0 = u.pn * BM + wc * 32 + 8 * fq;
        const float* ga = mod + (size_t)modrow_of(u.pm * BM) * 12288 + 2 * D;
        constexpr float sc = WOUT_F8 ? 1.f / 32.f : 1.f;
        f32x4 gv[2][2];
#pragma unroll
        for (int bj = 0; bj < 2; ++bj)
#pragma unroll
            for (int n = 0; n < 2; ++n) gv[bj][n] = *(const f32x4*)(ga + col0 + bj * HALF + n * 4) * sc;
        if (resb) {
#pragma unroll
            for (int ai = 0; ai < 2; ++ai)
#pragma unroll
                for (int m = 0; m < 4; ++m) { const int row = row0 + ai * HALF + m * 16; const bf16_t* rp = resb + (size_t)row * D + col0; bf16_t* xp = X + (size_t)row * D + col0;
#pragma unroll
                    for (int bj = 0; bj < 2; ++bj) { const u32x4 r = *(const u32x4*)(rp + bj * HALF);
                        const f32x4 v0 = (f32x4){bflo(r.x), bfhi(r.x), bflo(r.y), bfhi(r.y)} + gv[bj][0] * acc[ai][bj][m][0], v1 = (f32x4){bflo(r.z), bfhi(r.z), bflo(r.w), bfhi(r.w)} + gv[bj][1] * acc[ai][bj][m][1];
                        u32x4 o; o.x = cvt_pk_bf16(v0[0], v0[1]); o.y = cvt_pk_bf16(v0[2], v0[3]); o.z = cvt_pk_bf16(v1[0], v1[1]); o.w = cvt_pk_bf16(v1[2], v1[3]);
                        *(u32x4*)(xp + bj * HALF) = o; } }
        } else {
#pragma unroll
            for (int ai = 0; ai < 2; ++ai)
#pragma unroll
                for (int m = 0; m < 4; ++m) { const int row = row0 + ai * HALF + m * 16;
                    const float* rp = (row < TL ? res_lat + (size_t)row * D : res_ctx + (size_t)(row - TL) * D) + col0; bf16_t* xp = X + (size_t)row * D + col0;
#pragma unroll
                    for (int bj = 0; bj < 2; ++bj) { const f32x4 r0 = *(const f32x4*)(rp + bj * HALF), r1 = *(const f32x4*)(rp + bj * HALF + 4);
                        const f32x4 v0 = r0 + gv[bj][0] * acc[ai][bj][m][0], v1 = r1 + gv[bj][1] * acc[ai][bj][m][1];
                        u32x4 o; o.x = cvt_pk_bf16(v0[0], v0[1]); o.y = cvt_pk_bf16(v0[2], v0[3]); o.z = cvt_pk_bf16(v1[0], v1[1]); o.w = cvt_pk_bf16(v1[2], v1[3]);
                        *(u32x4*)(xp + bj * HALF) = o; } }
        }
    }
};
struct EpiMoe1 {
    static constexpr bool PERM = true, LINE64 = false;
    unsigned char* O;
    __device__ __forceinline__ void operator()(const f32x4 (&acc)[2][2][4][2], const Unit& u, int wr, int wc, int fr, int fq) const {
        const int row0 = u.pm * BM + wr * 64 + fr, col0 = (u.pn & 7) * HALF + wc * 32 + 8 * fq;
#pragma unroll
        for (int ai = 0; ai < 2; ++ai)
#pragma unroll
            for (int m = 0; m < 4; ++m) { unsigned char* rowp = O + (size_t)(row0 + ai * HALF + m * 16) * DE + col0; float h[8];
#pragma unroll
                for (int n = 0; n < 2; ++n)
#pragma unroll
                    for (int j = 0; j < 4; ++j) { const float gt = acc[ai][0][m][n][j] * (1.f / 32.f), up = acc[ai][1][m][n][j] * (1.f / 32.f); h[4 * n + j] = gt * __builtin_amdgcn_rcpf(1.f + __expf(-gt)) * up; }
                u32x2 w; w.x = pk4_f8(h[0], h[1], h[2], h[3]); w.y = pk4_f8(h[4], h[5], h[6], h[7]);
                *(u32x2*)rowp = w; }
    }
};
struct EpiMoe2 {
    static constexpr bool PERM = true, LINE64 = false;
    unsigned char* Y2; const int* rowtok; const float* roww;
    __device__ __forceinline__ void operator()(const f32x4 (&acc)[2][2][4][2], const Unit& u, int wr, int wc, int fr, int fq) const {
        const int row0 = u.pm * BM + wr * 64 + fr, col0 = (u.pn & 7) * BM + wc * 32 + 8 * fq;
#pragma unroll
        for (int ai = 0; ai < 2; ++ai)
#pragma unroll
            for (int m = 0; m < 4; ++m) { asm volatile("" ::: "memory"); const int row = row0 + ai * HALF + m * 16; const int tk = rowtok[row]; const float w = roww[row];
                if (tk >= 0) { unsigned char* rowp = Y2 + ((size_t)(tk >> 30) * TT + (size_t)(tk & 0x3fffffff)) * D + col0;
#pragma unroll
                    for (int bj = 0; bj < 2; ++bj) { const f32x4 v0 = acc[ai][bj][m][0] * w, v1 = acc[ai][bj][m][1] * w;
                        u32x2 o; o.x = pk4_f8(v0[0], v0[1], v0[2], v0[3]); o.y = pk4_f8(v1[0], v1[1], v1[2], v1[3]);
                        *(u32x2*)(rowp + bj * HALF) = o; } } }
    }
};
}

__device__ __forceinline__ void p0_transpose_item(const float* W, int ldw, int srccol0, int k0, bf16_t* dst, int K, LAS float* scr, int lane, bool q = false) {
    { f32x4 v[8];
#pragma unroll
      for (int i = 0; i < 8; ++i) v[i] = *(const f32x4*)(W + (size_t)(k0 + 8 * i + (lane >> 3)) * ldw + srccol0 + 4 * (lane & 7));
#pragma unroll
      for (int i = 0; i < 8; ++i) { LAS float* p = scr + (8 * i + (lane >> 3)) * 33 + 4 * (lane & 7); p[0] = v[i][0]; p[1] = v[i][1]; p[2] = v[i][2]; p[3] = v[i][3]; } }
    LDS_WAIT(); asm volatile("" ::: "memory");
    const int c = lane & 7;
#pragma unroll
    for (int j = 0; j < 4; ++j) { const int n = (lane >> 3) + 8 * j; const LAS float* s = scr + (8 * c) * 33 + n;
        u32x4 o; if (q) { o.x = pk2q(s[0 * 33], s[1 * 33]); o.y = pk2q(s[2 * 33], s[3 * 33]); o.z = pk2q(s[4 * 33], s[5 * 33]); o.w = pk2q(s[6 * 33], s[7 * 33]); }
        else { o.x = pk2(s[0 * 33], s[1 * 33]); o.y = pk2(s[2 * 33], s[3 * 33]); o.z = pk2(s[4 * 33], s[5 * 33]); o.w = pk2(s[6 * 33], s[7 * 33]); }
        *(u32x4*)(dst + (size_t)n * K + k0 + 8 * c) = o; }
    LDS_WAIT(); asm volatile("" ::: "memory");
}
__device__ __forceinline__ void p0_transpose_item8(const float* W, int ldw, int srccol0, int k0, unsigned char* dst, int K, LAS float* scr, int lane) {
    { f32x4 v[8];
#pragma unroll
      for (int i = 0; i < 8; ++i) v[i] = *(const f32x4*)(W + (size_t)(k0 + 8 * i + (lane >> 3)) * ldw + srccol0 + 4 * (lane & 7));
#pragma unroll
      for (int i = 0; i < 8; ++i) { LAS float* p = scr + (8 * i + (lane >> 3)) * 33 + 4 * (lane & 7); p[0] = v[i][0]; p[1] = v[i][1]; p[2] = v[i][2]; p[3] = v[i][3]; } }
    LDS_WAIT(); asm volatile("" ::: "memory");
    const int c = lane & 7;
#pragma unroll
    for (int j = 0; j < 4; ++j) { const int n = (lane >> 3) + 8 * j; const LAS float* s = scr + (8 * c) * 33 + n;
        u32x2 o; o.x = pk4_f8(s[0 * 33] * 32.f, s[1 * 33] * 32.f, s[2 * 33] * 32.f, s[3 * 33] * 32.f); o.y = pk4_f8(s[4 * 33] * 32.f, s[5 * 33] * 32.f, s[6 * 33] * 32.f, s[7 * 33] * 32.f);
        *(u32x2*)(dst + (size_t)n * K + k0 + 8 * c) = o; }
    LDS_WAIT(); asm volatile("" ::: "memory");
}
constexpr int TI_WIN = 32 * 168, TI_WA = 32, TI_WOUT = 32 * 64, TI_GU = 32 * 64, TI_DN = 16 * 64;
constexpr int TI_L = TI_WIN + TI_WA + TI_WOUT;
constexpr int TI_TOTAL = 2 * TI_L + 32 * TI_GU + 32 * TI_DN;
__device__ __forceinline__ void p0_item(KP Pk, Frame& F, int it, LAS float* scr) {
    unsigned char* ws = F.ws;
    if (it < 2 * TI_L) { const int l = it / TI_L; int r = it % TI_L;
        if (r < TI_WIN) { const int kb = r / 168, nb = r % 168, n0 = 32 * nb;
            if (WIN_F8_L(l)) p0_transpose_item8(Pk->in[I_WIN] + (size_t)l * D * DIN, DIN, n0 < 1536 ? n0 : n0 + 32, 64 * kb, ws + WS_WIN + (size_t)l * NU * D * 2 + (size_t)n0 * D, D, scr, F.lane);
            else p0_transpose_item(Pk->in[I_WIN] + (size_t)l * D * DIN, DIN, n0 < 1536 ? n0 : n0 + 32, 64 * kb, (bf16_t*)(ws + WS_WIN) + ((size_t)l * NU + n0) * D, D, scr, F.lane); return; }
        r -= TI_WIN;
        if (r < TI_WA) { if (WIN_F8_L(l)) p0_transpose_item8(Pk->in[I_WIN] + (size_t)l * D * DIN, DIN, 1536, 64 * r, ws + WS_WA + (size_t)l * 32 * D * 2, D, scr, F.lane);
            else p0_transpose_item(Pk->in[I_WIN] + (size_t)l * D * DIN, DIN, 1536, 64 * r, (bf16_t*)(ws + WS_WA) + (size_t)l * 32 * D, D, scr, F.lane); return; }
        r -= TI_WA;
        { const int kb = r / 64, nb = r % 64;
          if (WOUT_F8) p0_transpose_item8(Pk->in[I_WOUT] + (size_t)l * D * D, D, 32 * nb, 64 * kb, ws + WS_WOUT + ((size_t)l * D + 32 * nb) * D, D, scr, F.lane);
          else p0_transpose_item(Pk->in[I_WOUT] + (size_t)l * D * D, D, 32 * nb, 64 * kb, (bf16_t*)(ws + WS_WOUT) + ((size_t)l * D + 32 * nb) * D, D, scr, F.lane); return; }
    }
    it -= 2 * TI_L;
    if (it < 32 * TI_GU) { const int le = it / TI_GU, r = it % TI_GU, kb = r / 64, nb = r % 64, n0 = 32 * nb, j = n0 >> 8, half = (n0 >> 7) & 1, c0 = 128 * j + (n0 & 127);
        p0_transpose_item8((half ? Pk->in[I_EU] : Pk->in[I_EG]) + (size_t)le * D * DE, DE, c0, 64 * kb, ws + WS_WGU + ((size_t)le * 2048 + n0) * D, D, scr, F.lane); return; }
    it -= 32 * TI_GU;
    { const int le = it / TI_DN, r = it % TI_DN, kb = r / 64, nb = r % 64;
        p0_transpose_item8(Pk->in[I_ED] + (size_t)le * DE * D, D, 32 * nb, 64 * kb, ws + WS_WD + ((size_t)le * D + 32 * nb) * DE, DE, scr, F.lane); }
}
constexpr size_t WS_APART = WS_HB;
__device__ __forceinline__ void ada_unit(KP Pk, Frame& F, int u) {
    unsigned char* ws = F.ws;
    __syncthreads();
    LAS float* sc = (LAS float*)F.lds;
    LAS f32x4* red = (LAS f32x4*)(F.lds + 9 * 128 * 4);
    const int l = u / 192, v = u % 192, cb = v % 12, kb = v / 12;
    for (int i = F.tid; i < 9 * 128; i += NTHR) { const int r = i >> 7, k = kb * 128 + (i & 127); const float x = r < 8 ? Pk->in[I_C][r * 2048 + k] : Pk->in[I_CCTX][k]; sc[i] = silu_f(x); }
    __syncthreads();
    const int c4 = F.tid & 255, kh = F.wave >> 2;
    const f32x4* W = (const f32x4*)(Pk->in[I_ADAW] + (size_t)l * D * 12288 + (size_t)(kb * 128 + kh * 64) * 12288 + cb * 1024) + c4;
    f32x4 a[9];
#pragma unroll
    for (int r = 0; r < 9; ++r) a[r] = (f32x4){0.f, 0.f, 0.f, 0.f};
#pragma unroll 1
    for (int k0 = 0; k0 < 64; k0 += 16) {
        f32x4 w[16];
#pragma unroll
        for (int q = 0; q < 16; ++q) w[q] = W[(size_t)(k0 + q) * 3072];
#pragma unroll
        for (int q = 0; q < 16; ++q) {
#pragma unroll
            for (int r = 0; r < 9; ++r) a[r] += w[q] * sc[r * 128 + kh * 64 + k0 + q];
            if ((q & 3) == 3) __builtin_amdgcn_sched_barrier(0); }
    }
    if (kh == 1) {
#pragma unroll
        for (int r = 0; r < 9; ++r) red[r * 256 + c4] = a[r]; }
    __syncthreads();
    float* part = (float*)(ws + WS_APART);
    if (kh == 0) {
#pragma unroll
        for (int r = 0; r < 9; ++r) *(f32x4*)(part + ((size_t)((l * 16 + kb) * 9 + r)) * 12288 + cb * 1024 + 4 * c4) = a[r] + red[r * 256 + c4]; }
    VM_WAIT();
    __syncthreads();
    if (F.tid == 0) { __builtin_amdgcn_fence(__ATOMIC_RELEASE, "agent"); F.MISC[1] = __hip_atomic_fetch_add(F.ctl + CW_ADAC + l * 12 + cb, 1u, __ATOMIC_RELAXED, __HIP_MEMORY_SCOPE_AGENT); }
    __syncthreads();
    if ((F.MISC[1] & 15u) == 15u) {
        __builtin_amdgcn_fence(__ATOMIC_ACQUIRE, "agent");
        for (int i = F.tid; i < 9 * 256; i += NTHR) { const int r = i >> 8, cc = i & 255;
            f32x4 sum = *(const f32x4*)(Pk->in[I_ADAB] + l * 12288 + cb * 1024 + 4 * cc), pv[16];
#pragma unroll
            for (int k2 = 0; k2 < 16; ++k2) pv[k2] = *(const f32x4*)(part + ((size_t)((l * 16 + k2) * 9 + r)) * 12288 + cb * 1024 + 4 * cc);
#pragma unroll
            for (int k2 = 0; k2 < 16; ++k2) sum += pv[k2];
            *(f32x4*)((float*)(ws + WS_MOD) + ((size_t)l * 9 + r) * 12288 + cb * 1024 + 4 * cc) = sum; } }
    __syncthreads();
}
__device__ __forceinline__ void wait_ctr(Frame& F, int word, unsigned target) {
    if (F.tid == 0) { while (__hip_atomic_load(F.ctl + word, __ATOMIC_RELAXED, __HIP_MEMORY_SCOPE_AGENT) < target) __builtin_amdgcn_s_sleep(2); }
    __syncthreads();
    __builtin_amdgcn_fence(__ATOMIC_ACQUIRE, "agent");
}
__device__ __forceinline__ void ph_hyena_filters(KP Pk, Frame& F, int u);
constexpr int P0_NCV = (TI_WIN + TI_WA + 31) / 32, P0_U_ADA = 0, P0_U_CV = P0_U_ADA + 192, P0_UNITS = P0_U_CV + P0_NCV;
__device__ __forceinline__ void p0_prologue(KP Pk, Frame& F, int rep) {
    unsigned char* ws = F.ws;
    const int gw = F.vcu * NWAVES + F.wave, NGW = F.G * NWAVES;
    for (int it = gw; it < 2 * 2304; it += NGW) { const int l = it / 2304, tt = it % 2304, L = tt < 2048 ? 2048 : 256, t = tt < 2048 ? tt : tt - 2048;
        const float tn = (float)t / (float)(L - 1), wv = (6.283185307179586f / (float)L) * (float)t;
        const float* w1 = Pk->in[I_HW1] + l * 33 * 64; const float* w2 = Pk->in[I_HW2] + l * 64 * 64;
        float zv = 0.f;
        if (F.lane == 0) zv = tn; else if (F.lane < 33) { const int bi = (F.lane - 1) & 15; const float band = 1e-4f + (float)bi * ((15.f - 1e-4f) / 15.f); zv = F.lane < 17 ? cosf(wv * band) : -sinf(wv * band); }
        float s = Pk->in[I_HB1][l * 64 + F.lane];
#pragma unroll
        for (int i = 0; i < 33; ++i) s += __shfl(zv, i) * w1[i * 64 + F.lane];
        const float h1 = sinf(Pk->in[I_HFR][(l * 2 + 0) * 64 + F.lane] * s);
        float s2 = Pk->in[I_HB2][l * 64 + F.lane];
#pragma unroll 16
        for (int i = 0; i < 64; ++i) s2 += __shfl(h1, i) * w2[i * 64 + F.lane];
        ((float*)(ws + WS_HYH2))[(size_t)it * 64 + F.lane] = sinf(Pk->in[I_HFR][(l * 2 + 1) * 64 + F.lane] * s2);
    }
    VM_WAIT();
    __syncthreads();
    if (F.tid == 0) { __builtin_amdgcn_fence(__ATOMIC_RELEASE, "agent"); __hip_atomic_fetch_add(F.ctl + CW_HYC, 1u, __ATOMIC_RELAXED, __HIP_MEMORY_SCOPE_AGENT); }
    for (int i = blockIdx.x * NTHR + F.tid; i < SEQ * 64; i += F.G * NTHR) { const int t = i >> 6, j = i & 63, q = j >> 4, f = j & 15;
        const float inv = exp2f(-(float)f * (13.287712379549449f / 16.f)); const float pos = (float)(q < 2 ? (t >> 6) : (t & 63)); const float ang = pos * inv;
        ((float*)(ws + WS_ROPE))[i] = (q & 1) ? sinf(ang) : cosf(ang); }
    if (PROBE_T & (1u << 24)) { F.pt += __builtin_amdgcn_s_memrealtime() - F.pt0; }
    for (;;) {
        const int u = wg_grab(F, rep ? 5 : 0); if (u >= P0_UNITS) break;
        const int ut_ = u < P0_U_ADA ? 10 : u < P0_U_CV ? 11 : 12; const unsigned long long ut0_ = (PROBE_UT >= 0) ? __builtin_amdgcn_s_memrealtime() : 0ull;
        if (u < P0_U_CV) ada_unit(Pk, F, u - P0_U_ADA);
        else { LAS float* scr = (LAS float*)(F.lds + F.wave * 8704);
            for (int j = 0; j < 4; ++j) { const int it = (u - P0_U_CV) * 32 + F.wave * 4 + j; if (it < TI_WIN + TI_WA) p0_item(Pk, F, it, scr); } }
        if (PROBE_UT >= 0 && ut_ == PROBE_UT && !F.pt_done) { __syncthreads(); F.pt += __builtin_amdgcn_s_memrealtime() - ut0_; F.pt_done = 1; }
    }
}

#define MFMA16(a, b, c) __builtin_amdgcn_mfma_f32_16x16x32_bf16((a), (b), (c), 0, 0, 0)
#define MFMA32(a, b, c) __builtin_amdgcn_mfma_f32_32x32x16_bf16((a), (b), (c), 0, 0, 0)
__device__ __forceinline__ void load_row(const float* p, int lane, f32x4 (&v)[8]) {
#pragma unroll
    for (int j = 0; j < 8; ++j) v[j] = ((const f32x4*)p)[lane + 64 * j];
}
__device__ __forceinline__ void load_row_bf16(const bf16_t* p, int lane, f32x4 (&v)[8]) {
#pragma unroll
    for (int j = 0; j < 8; ++j) { const u32x2 a = ((const u32x2*)p)[lane + 64 * j]; v[j] = (f32x4){bflo(a.x), bfhi(a.x), bflo(a.y), bfhi(a.y)}; }
}
__device__ __forceinline__ void add_y2(const unsigned char* y0, const unsigned char* y1, const float* gf, int lane, f32x4 (&v)[8]) {
#pragma unroll
    for (int j = 0; j < 8; ++j) { const unsigned a = ((const unsigned*)y0)[lane + 64 * j], b = ((const unsigned*)y1)[lane + 64 * j]; const f32x4 g = ((const f32x4*)gf)[lane + 64 * j] * (1.f / 32.f);
        const f32x2 a0 = __builtin_amdgcn_cvt_pk_f32_fp8(a, false), a1 = __builtin_amdgcn_cvt_pk_f32_fp8(a, true), b0 = __builtin_amdgcn_cvt_pk_f32_fp8(b, false), b1 = __builtin_amdgcn_cvt_pk_f32_fp8(b, true);
        v[j][0] += g[0] * (a0[0] + b0[0]); v[j][1] += g[1] * (a0[1] + b0[1]); v[j][2] += g[2] * (a1[0] + b1[0]); v[j][3] += g[3] * (a1[1] + b1[1]); }
}
__device__ __forceinline__ float row_rstd(const f32x4 (&v)[8]) {
    float s = 0.f;
#pragma unroll
    for (int j = 0; j < 8; ++j) s += (v[j][0] * v[j][0] + v[j][1] * v[j][1]) + (v[j][2] * v[j][2] + v[j][3] * v[j][3]);
    return rsqrtf(wave_sum(s) * (1.f / D) + NORM_EPS);
}
__device__ __forceinline__ void modulate(f32x4 (&v)[8], float rstd, const float* nw, const float* sh, const float* sc, int lane) {
#pragma unroll
    for (int j = 0; j < 8; ++j) { const f32x4 w = ((const f32x4*)nw)[lane + 64 * j], a = ((const f32x4*)sc)[lane + 64 * j], b = ((const f32x4*)sh)[lane + 64 * j];
        v[j] = v[j] * rstd * w * (a + 1.f) + b; }
}
__device__ __forceinline__ void store_row_bf16(bf16_t* o, int lane, const f32x4 (&v)[8], bool q = false) {
#pragma unroll
    for (int j = 0; j < 8; ++j) { u32x2 w; if (q) { w.x = pk2q(v[j][0], v[j][1]); w.y = pk2q(v[j][2], v[j][3]); } else { w.x = pk2(v[j][0], v[j][1]); w.y = pk2(v[j][2], v[j][3]); } ((u32x2*)o)[lane + 64 * j] = w; }
}
__device__ __forceinline__ void store_row_f8(unsigned char* o, int lane, const f32x4 (&v)[8]) {
#pragma unroll
    for (int j = 0; j < 8; ++j) ((unsigned*)o)[lane + 64 * j] = pk4_f8(v[j][0], v[j][1], v[j][2], v[j][3]);
}
__device__ __forceinline__ void ph_norm1(KP Pk, Frame& F, int l) {
    unsigned char* ws = F.ws;
    const int gw = F.vcu * NWAVES + F.wave, NGW = F.G * NWAVES;
    const float* mod = (const float*)(ws + WS_MOD) + (size_t)l * 9 * 12288;
    bf16_t* X = (bf16_t*)(ws + WS_X); bf16_t* H = (bf16_t*)(ws + WS_H); const unsigned char* Y2 = ws + WS_Y2;
    const bool uneven = l == 0 && F.G == 256; const int bx = (int)blockIdx.x;
    const int rfirst = uneven ? (bx < 128 ? bx * 44 : 5632 + (bx - 128) * 100) + F.wave : gw, rend = uneven ? (bx < 128 ? bx * 44 + 44 : 5632 + (bx - 128) * 100 + 100) : TT, rstep = uneven ? NWAVES : NGW;
    for (int row = rfirst; row < rend; row += rstep) {
        const int r = modrow_of(row); f32x4 v[8];
        if (l == 0) load_row(row < TL ? Pk->in[I_X] + (size_t)row * D : Pk->in[I_CTX] + (size_t)(row - TL) * D, F.lane, v);
        else { load_row_bf16(X + (size_t)row * D, F.lane, v);
            add_y2(Y2 + (size_t)row * D, Y2 + ((size_t)TT + row) * D, (const float*)(ws + WS_MOD) + (size_t)r * 12288 + 5 * D, F.lane, v);
            if (row < TL) store_row_bf16(X + (size_t)row * D, F.lane, v); }
        const float rstd = row_rstd(v);
        modulate(v, rstd, Pk->in[I_N1W] + l * D, mod + (size_t)r * 12288, mod + (size_t)r * 12288 + D, F.lane);
        if (WIN_F8_L(l)) store_row_f8(ws + WS_H + (size_t)row * D, F.lane, v); else store_row_bf16(H + (size_t)row * D, F.lane, v);
    }
}
__device__ __forceinline__ void ph_hyena_filters(KP Pk, Frame& F, int u) {
    unsigned char* ws = F.ws;
    constexpr int HRS = 2052;
    LAS float* HR = (LAS float*)F.lds; LAS float* red = (LAS float*)(F.lds + 16 * HRS * 4);
    const int r16 = F.lane & 15, kg = F.lane >> 4;
    {
        const int lf = u >> 7, cg = u & 127, chl = r16 & 3, od = r16 >> 2, ch = cg * 4 + chl;
        const float* w3 = Pk->in[I_HW3] + (size_t)lf * 64 * 2048 + (od >> 1) * 1024 + (od & 1) * 512 + ch;
        bf16x8 wb[2];
#pragma unroll
        for (int ks = 0; ks < 2; ++ks) { float w[8];
#pragma unroll
            for (int j = 0; j < 8; ++j) w[j] = w3[(size_t)(32 * ks + 8 * kg + j) * 2048];
            u32x4 p; p.x = pk2(w[0], w[1]); p.y = pk2(w[2], w[3]); p.z = pk2(w[4], w[5]); p.w = pk2(w[6], w[7]); wb[ks] = __builtin_bit_cast(bf16x8, p); }
        const float dmin = 3.0701134573253940f, dmax = 15.350567286626972f, delta = dmin + (float)ch * ((dmax - dmin) / 511.f);
#pragma unroll 1
        for (int sel = 0; sel < 2; ++sel) {
            const int L = sel == 0 ? 2048 : 256; const float* h2 = (const float*)(ws + WS_HYH2) + ((size_t)lf * 2304 + (sel == 0 ? 0 : 2048)) * 64; const float rl = 1.f / (float)(L - 1);
            __syncthreads();
            float s = 0.f;
#pragma unroll 2
            for (int tile = F.wave; tile < L / 16; tile += NWAVES) {
                const f32x4* hp = (const f32x4*)(h2 + (size_t)(16 * tile + r16) * 64 + 8 * kg);
                const f32x4 a0 = hp[0], a1 = hp[1], a2 = hp[8], a3 = hp[9];
                u32x4 p0, p1; p0.x = pk2(a0[0], a0[1]); p0.y = pk2(a0[2], a0[3]); p0.z = pk2(a1[0], a1[1]); p0.w = pk2(a1[2], a1[3]); p1.x = pk2(a2[0], a2[1]); p1.y = pk2(a2[2], a2[3]); p1.z = pk2(a3[0], a3[1]); p1.w = pk2(a3[2], a3[3]);
                f32x4 d = MFMA16(__builtin_bit_cast(bf16x8, p0), wb[0], ((f32x4){0.f, 0.f, 0.f, 0.f})); d = MFMA16(__builtin_bit_cast(bf16x8, p1), wb[1], d);
                const int t0 = 16 * tile + 4 * kg;
#pragma unroll
                for (int i = 0; i < 4; ++i) { d[i] *= expf(-(float)(t0 + i) * rl * delta); s += fabsf(d[i]); }
                *(LAS f32x4*)(HR + r16 * HRS + t0) = d; }
            s += __shfl_xor(s, 16); s += __shfl_xor(s, 32);
            if (F.lane < 16) red[F.wave * 16 + F.lane] = s;
            __syncthreads();
            if (F.tid < 16) { const int col = F.tid; float tot = 0.f;
#pragma unroll
                for (int w = 0; w < 8; ++w) tot += red[w * 16 + (col & ~4)] + red[w * 16 + (col | 4)];
                red[128 + col] = tot; }
            __syncthreads();
            for (int e = F.tid; e < 16 * L; e += NTHR) { const int col = e / L, t = e % L, dir = (col >> 2) & 1, o = col >> 3, c = cg * 4 + (col & 3);
                float hv = HR[col * HRS + t] / red[128 + col]; int idx = dir == 0 ? L - t : L + t;
                if (dir == 1 && t == 0) { idx = 0; hv = 0.f; }
                ((bf16_t*)(ws + WS_HYF) + ((size_t)lf * 1024 + o * 512 + c) * 4608)[(sel == 0 ? 0 : 4096) + idx] = (bf16_t)f2bf(hv); }
        }
    }
}
__device__ __forceinline__ void ph_norm2_router(KP Pk, Frame& F, int l, int rep) {
    unsigned char* ws = F.ws;
    const int gw = F.vcu * NWAVES + F.wave, NGW = F.G * NWAVES, nrows = l == 0 ? TT : TL;
    const float* mod = (const float*)(ws + WS_MOD) + (size_t)l * 9 * 12288;
    const bf16_t* X = (const bf16_t*)(ws + WS_X); unsigned char* Fo = ws + WS_H;
    LAS float* rw = (LAS float*)F.lds;
    volatile LAS unsigned* lcnt = F.MISC + 16;
    if (F.tid < 16) lcnt[F.tid] = 0u;
    for (int i = F.tid; i < 2048 * 4; i += NTHR) { const f32x4 w = ((const f32x4*)Pk->in[I_RW])[i]; const int k = i >> 2, e0 = (i & 3) * 4;
        rw[(e0 + 0) * 2048 + k] = w[0]; rw[(e0 + 1) * 2048 + k] = w[1]; rw[(e0 + 2) * 2048 + k] = w[2]; rw[(e0 + 3) * 2048 + k] = w[3]; }
    __syncthreads();
    if ((PROBE_T & (1u << 25)) && l == 0) F.pt += __builtin_amdgcn_s_memrealtime() - F.pt0;
    float rb[16];
#pragma unroll
    for (int e = 0; e < 16; ++e) rb[e] = Pk->in[I_RB][e];
    for (int rowA = gw; rowA < nrows; rowA += 2 * NGW) {
        const bool hasB = rowA + NGW < nrows; const int rowB = hasB ? rowA + NGW : rowA;
        f32x4 va[8], vb[8];
        load_row_bf16(X + (size_t)rowA * D, F.lane, va); load_row_bf16(X + (size_t)rowB * D, F.lane, vb);
        { const int r = modrow_of(rowA); const float rstd = row_rstd(va); modulate(va, rstd, Pk->in[I_N2W] + l * D, mod + (size_t)r * 12288 + 3 * D, mod + (size_t)r * 12288 + 4 * D, F.lane); store_row_f8(Fo + (size_t)rowA * D, F.lane, va); }
        { const int r = modrow_of(rowB); const float rstd = row_rstd(vb); modulate(vb, rstd, Pk->in[I_N2W] + l * D, mod + (size_t)r * 12288 + 3 * D, mod + (size_t)r * 12288 + 4 * D, F.lane); if (hasB) store_row_f8(Fo + (size_t)rowB * D, F.lane, vb); }
        float pa[32];
#pragma unroll
        for (int e = 0; e < 16; ++e) { f32x2 a = {0.f, 0.f}, b = {0.f, 0.f};
            f32x4 wq[8];
#pragma unroll
            for (int j = 0; j < 8; ++j) wq[j] = ((const LAS f32x4*)(rw + e * 2048))[F.lane + 64 * j];
            __builtin_amdgcn_sched_barrier(0);
#pragma unroll
            for (int j = 0; j < 8; ++j) { const f32x4 w = wq[j];
                const f32x2 wl = __builtin_shufflevector(w, w, 0, 1), wh = __builtin_shufflevector(w, w, 2, 3);
                a = __builtin_elementwise_fma(__builtin_shufflevector(va[j], va[j], 0, 1), wl, a); a = __builtin_elementwise_fma(__builtin_shufflevector(va[j], va[j], 2, 3), wh, a);
                b = __builtin_elementwise_fma(__builtin_shufflevector(vb[j], vb[j], 0, 1), wl, b); b = __builtin_elementwise_fma(__builtin_shufflevector(vb[j], vb[j], 2, 3), wh, b); }
            pa[e] = a[0] + a[1]; pa[16 + e] = b[0] + b[1]; }
#define RB_STEP(N, BIT) { const bool up = (F.lane & (BIT)) != 0; _Pragma("unroll") for (int k = 0; k < (N); ++k) { const float keep = up ? pa[(N) + k] : pa[k], send = up ? pa[k] : pa[(N) + k]; pa[k] = keep + __shfl_xor(send, (BIT)); } }
        RB_STEP(16, 32) RB_STEP(8, 16) RB_STEP(4, 8) RB_STEP(2, 4) RB_STEP(1, 2)
#undef RB_STEP
        const float red = pa[0] + __shfl_xor(pa[0], 1);
        float lg[16];
#pragma unroll
        for (int e = 0; e < 16; ++e) lg[e] = __shfl(red, (F.lane & 32) + 2 * e);
        float mx = lg[0];
#pragma unroll
        for (int e = 1; e < 16; ++e) mx = fmaxf(mx, lg[e]);
        float sum = 0.f;
#pragma unroll
        for (int e = 0; e < 16; ++e) { lg[e] = expf(lg[e] - mx); sum += lg[e]; }
        const float rs = 1.f / sum; float sel[16];
#pragma unroll
        for (int e = 0; e < 16; ++e) { lg[e] *= rs; sel[e] = lg[e] + rb[e]; }
        int grp = 0; float gbest = fmaxf(fmaxf(sel[0], sel[1]), fmaxf(sel[2], sel[3]));
#pragma unroll
        for (int g = 1; g < 4; ++g) { const float gm = fmaxf(fmaxf(sel[4 * g], sel[4 * g + 1]), fmaxf(sel[4 * g + 2], sel[4 * g + 3])); if (gm > gbest) { gbest = gm; grp = g; } }
        float s4[4], p4[4];
#pragma unroll
        for (int i = 0; i < 4; ++i) { s4[i] = grp == 0 ? sel[i] : grp == 1 ? sel[4 + i] : grp == 2 ? sel[8 + i] : sel[12 + i]; p4[i] = grp == 0 ? lg[i] : grp == 1 ? lg[4 + i] : grp == 2 ? lg[8 + i] : lg[12 + i]; }
        int i0 = 0; float b0 = s4[0];
#pragma unroll
        for (int i = 1; i < 4; ++i) if (s4[i] > b0) { b0 = s4[i]; i0 = i; }
        int i1 = -1; float b1 = 0.f;
#pragma unroll
        for (int i = 0; i < 4; ++i) if (i != i0 && (i1 < 0 || s4[i] > b1)) { b1 = s4[i]; i1 = i; }
        const float p0 = i0 == 0 ? p4[0] : i0 == 1 ? p4[1] : i0 == 2 ? p4[2] : p4[3], p1 = i1 == 0 ? p4[0] : i1 == 1 ? p4[1] : i1 == 2 ? p4[2] : p4[3];
        const int e0 = grp * 4 + i0, e1 = grp * 4 + i1; const float ws_ = 1.f / (p0 + p1);
        if (F.lane == 0 || (F.lane == 32 && hasB)) { const int row = F.lane == 0 ? rowA : rowB;
            ((int*)(ws + WS_RT + RT_E))[row] = e0 | (e1 << 8); ((f32x2*)(ws + WS_RT + RT_W))[row] = (f32x2){p0 * ws_, p1 * ws_};
            __hip_atomic_fetch_add((LAS unsigned*)&lcnt[e0], 1u, __ATOMIC_RELAXED, __HIP_MEMORY_SCOPE_WORKGROUP); __hip_atomic_fetch_add((LAS unsigned*)&lcnt[e1], 1u, __ATOMIC_RELAXED, __HIP_MEMORY_SCOPE_WORKGROUP); }
    }
    if ((PROBE_T & (1u << 26)) && l == 0) F.pt += __builtin_amdgcn_s_memrealtime() - F.pt0;
    __syncthreads();
    { int t_; asm volatile("v_mbcnt_lo_u32_b32 %0, -1, 0\n\tv_mbcnt_hi_u32_b32 %0, -1, %0" : "=v"(t_)); t_ += F.wave * 64;
      if (t_ < 16 && lcnt[t_]) __hip_atomic_fetch_add(F.ctl + CW_CNT + 64 * (l + 2 * rep) + t_, lcnt[t_], __ATOMIC_RELAXED, __HIP_MEMORY_SCOPE_AGENT); }
}
__device__ __forceinline__ int moe_table(Frame& F, int l) {
    volatile LAS unsigned char* pexp = (volatile LAS unsigned char*)(F.MISC + 64);
    __syncthreads();
    if (F.tid < 64) {
        const int e = F.lane & 15; const int c = (int)__hip_atomic_load(F.ctl + CW_CNT + 64 * l + e, __ATOMIC_RELAXED, __HIP_MEMORY_SCOPE_AGENT);
        const int np = (c + 255) >> 8; int p0 = np;
#pragma unroll
        for (int d = 1; d < 16; d <<= 1) { const int y = __shfl(p0, F.lane - d); if (e >= d) p0 += y; }
        const int tot = __shfl(p0, 15); p0 -= np;
        if (F.lane < 16) { F.MISC[32 + e] = (unsigned)(p0 * 256); for (int j = 0; j < np; ++j) pexp[p0 + j] = (unsigned char)e; if (e == 0) F.MISC[2] = (unsigned)tot; }
    }
    __syncthreads();
    return (int)F.MISC[2];
}
__device__ __forceinline__ void ph_slots(KP Pk, Frame& F, int l) {
    unsigned char* ws = F.ws;
    const int nrows = l == 0 ? TT : TL, per = (nrows + F.G - 1) / F.G, t0 = blockIdx.x * per, t1 = min(nrows, t0 + per);
    (void)moe_table(F, l);
    volatile LAS unsigned* lcnt = F.MISC + 16; volatile LAS unsigned* lbase = F.MISC + 48;
    if (F.tid < 16) lcnt[F.tid] = 0u;
    __syncthreads();
    const int* RE = (const int*)(ws + WS_RT + RT_E); const f32x2* RW = (const f32x2*)(ws + WS_RT + RT_W);
    int* ROWTOK = (int*)(ws + WS_RT + RT_ROWTOK); float* ROWW = (float*)(ws + WS_RT + RT_ROWW);
    const int tok = t0 + F.tid; int e0 = 0, e1 = 0; unsigned q0 = 0, q1 = 0;
    if (tok < t1) { const int ee = RE[tok]; e0 = ee & 255; e1 = ee >> 8;
        q0 = __hip_atomic_fetch_add((LAS unsigned*)&lcnt[e0], 1u, __ATOMIC_RELAXED, __HIP_MEMORY_SCOPE_WORKGROUP); q1 = __hip_atomic_fetch_add((LAS unsigned*)&lcnt[e1], 1u, __ATOMIC_RELAXED, __HIP_MEMORY_SCOPE_WORKGROUP); }
    __syncthreads();
    if (F.tid < 16) lbase[F.tid] = lcnt[F.tid] ? __hip_atomic_fetch_add(F.ctl + CW_CUR + 64 * l + F.tid, lcnt[F.tid], __ATOMIC_RELAXED, __HIP_MEMORY_SCOPE_AGENT) : 0u;
    __syncthreads();
    if (tok < t1) { const f32x2 w = RW[tok]; const int r0 = (int)(F.MISC[32 + e0] + lbase[e0] + q0), r1 = (int)(F.MISC[32 + e1] + lbase[e1] + q1);
        ROWTOK[r0] = tok; ROWW[r0] = w.x; ROWTOK[r1] = tok | (1 << 30); ROWW[r1] = w.y; }
    if (blockIdx.x < NE) { const int e = blockIdx.x, c = (int)__hip_atomic_load(F.ctl + CW_CNT + 64 * l + e, __ATOMIC_RELAXED, __HIP_MEMORY_SCOPE_AGENT), base = (int)F.MISC[32 + e];
        for (int i = c + F.tid; i < ((c + 255) & ~255); i += NTHR) { ROWTOK[base + i] = -1; ROWW[base + i] = 0.f; } }
}
__device__ __forceinline__ void ph_final(KP Pk, Frame& F) {
    unsigned char* ws = F.ws;
    const int gw = F.vcu * NWAVES + F.wave, NGW = F.G * NWAVES;
    const bf16_t* X = (const bf16_t*)(ws + WS_X); const unsigned char* Y2 = ws + WS_Y2;
    for (int row = gw; row < TL; row += NGW) { f32x4 v[8];
        load_row_bf16(X + (size_t)row * D, F.lane, v);
        add_y2(Y2 + (size_t)row * D, Y2 + ((size_t)TT + row) * D, (const float*)(ws + WS_MOD) + ((size_t)9 + (row >> 11)) * 12288 + 5 * D, F.lane, v);
#pragma unroll
        for (int j = 0; j < 8; ++j) ((f32x4*)(Pk->out + (size_t)row * D))[F.lane + 64 * j] = v[j]; }
}

__device__ __forceinline__ void ph_gate_cols(Frame& F, int l) {
    unsigned char* ws = F.ws;
    const int r32 = F.lane & 31, hi = F.lane >> 5;
    const bf16_t* H = (const bf16_t*)(ws + WS_H); const bf16_t* Wa = (const bf16_t*)(ws + WS_WA) + (size_t)l * 32 * D; float* AG = (float*)(ws + WS_AG);
    LAS unsigned char* tile = F.lds + F.wave * 16896;
    LAS float* red = (LAS float*)F.lds;
    for (int it = blockIdx.x; it < TT / 32; it += F.G) {
        const int kb = F.wave * 256;
        u32x4 av[16]; bf16x8 bv[16];
#pragma unroll
        for (int i = 0; i < 16; ++i) { const int id = F.lane + 64 * i; av[i] = *(const u32x4*)(H + (size_t)(it * 32 + (id >> 5)) * D + kb + 8 * (id & 31)); }
#pragma unroll
        for (int ks = 0; ks < 16; ++ks) bv[ks] = *(const bf16x8*)(Wa + (size_t)r32 * D + kb + 16 * ks + 8 * hi);
        __syncthreads();
#pragma unroll
        for (int i = 0; i < 16; ++i) { const int id = F.lane + 64 * i; *(LAS u32x4*)(tile + ((id >> 5) * 264 + 8 * (id & 31)) * 2) = av[i]; }
        f32x16 acc = {};
#pragma unroll
        for (int ks = 0; ks < 16; ++ks) { const bf16x8 a = *(const LAS bf16x8*)(tile + (r32 * 264 + 16 * ks + 8 * hi) * 2); acc = MFMA32(a, bv[ks], acc); }
        __syncthreads();
#pragma unroll
        for (int r = 0; r < 16; ++r) red[(F.wave * 16 + r) * 64 + F.lane] = acc[r];
        __syncthreads();
        for (int e = F.tid; e < 1024; e += NTHR) { float sum = 0.f;
#pragma unroll
            for (int w = 0; w < 8; ++w) sum += red[w * 1024 + e];
            const int r = e >> 6, ln = e & 63; AG[(size_t)(it * 32 + (r & 3) + 8 * (r >> 2) + 4 * (ln >> 5)) * 32 + (ln & 31)] = sum; }
    }
}

__device__ __forceinline__ void ph_gate_cols8(Frame& F, int l) {
    unsigned char* ws = F.ws;
    const int fr = F.lane & 15, fq = F.lane >> 4, kb = F.wave * 256;
    const unsigned char* H8 = ws + WS_H; const unsigned char* Wa8 = ws + WS_WA + (size_t)l * 32 * D * 2; float* AG = (float*)(ws + WS_AG);
    LAS f32x4* red = (LAS f32x4*)F.lds;
    int f8scale = 0x7f7f7f7f; asm volatile("" : "+v"(f8scale));
    i32x8 b[2][2], a[2][2];
#pragma unroll
    for (int ch = 0; ch < 2; ++ch)
#pragma unroll
        for (int ks = 0; ks < 2; ++ks) b[ch][ks] = *(const i32x8*)(Wa8 + (size_t)(16 * ch + fr) * D + kb + 128 * ks + 32 * fq);
    int it = blockIdx.x;
    if (it < TT / 32) {
#pragma unroll
        for (int rh = 0; rh < 2; ++rh)
#pragma unroll
            for (int ks = 0; ks < 2; ++ks) a[rh][ks] = *(const i32x8*)(H8 + (size_t)(it * 32 + 16 * rh + fr) * D + kb + 128 * ks + 32 * fq); }
    for (; it < TT / 32; it += F.G) {
        f32x4 acc[2][2];
#pragma unroll
        for (int rh = 0; rh < 2; ++rh)
#pragma unroll
            for (int ch = 0; ch < 2; ++ch) acc[rh][ch] = (f32x4){0.f, 0.f, 0.f, 0.f};
#pragma unroll
        for (int ks = 0; ks < 2; ++ks)
#pragma unroll
            for (int rh = 0; rh < 2; ++rh)
#pragma unroll
                for (int ch = 0; ch < 2; ++ch)
                    asm volatile("v_mfma_scale_f32_16x16x128_f8f6f4 %0, %1, %2, %0, %3, %3 op_sel_hi:[0,0,0]" : "+v"(acc[rh][ch]) : "v"(b[ch][ks]), "v"(a[rh][ks]), "v"(f8scale));
        asm volatile("s_nop 15\n\ts_nop 15" : "+v"(acc[0][0]), "+v"(acc[0][1]), "+v"(acc[1][0]), "+v"(acc[1][1]) :: "memory");
        const int nx = it + F.G;
        if (nx < TT / 32) {
#pragma unroll
            for (int rh = 0; rh < 2; ++rh)
#pragma unroll
                for (int ks = 0; ks < 2; ++ks) a[rh][ks] = *(const i32x8*)(H8 + (size_t)(nx * 32 + 16 * rh + fr) * D + kb + 128 * ks + 32 * fq); }
        __syncthreads();
#pragma unroll
        for (int rh = 0; rh < 2; ++rh)
#pragma unroll
            for (int ch = 0; ch < 2; ++ch) red[(F.wave * 4 + rh * 2 + ch) * 64 + F.lane] = acc[rh][ch];
        __syncthreads();
        for (int e = F.tid; e < 1024; e += NTHR) { float sum = 0.f;
#pragma unroll
            for (int w = 0; w < 8; ++w) sum += ((const LAS float*)red)[w * 1024 + e];
            const int blk = e >> 8, ln = (e >> 2) & 63, k = e & 3;
            AG[(size_t)(it * 32 + 16 * (blk >> 1) + (ln & 15)) * 32 + 16 * (blk & 1) + 4 * (ln >> 4) + k] = sum * (1.f / 32.f); }
    }
}

constexpr int WAVE_LDS = 17408;
__device__ __forceinline__ int perm16(int k) { return (k & 3) + 4 * ((k >> 3) & 1) + 8 * ((k >> 2) & 1); }
__device__ __forceinline__ int gla_kidx(int dir, int s) { return dir == 0 ? s : (s < LC ? LC - 1 - s : LC + (SEQ - 1 - (s - LC))); }
constexpr int GL_QT = 0, GL_KT = 1280, GL_KHT = 2560, GL_VT = 4096, GL_PT = 7168, GL_ST = 7936, GL_G = 13056, GL_GW = 13312, GL_GB = 15360;
__device__ __forceinline__ void gla_load_gates(KP Pk, Frame& F, int l, int h, int dir, LAS unsigned char* wl) {
    LAS float* gw = (LAS float*)(wl + GL_GW); LAS float* gb = (LAS float*)(wl + GL_GB);
    const float* src = Pk->in[I_GGW] + ((size_t)(l * 2 + dir) * 16) * 256 + h * 32;
#pragma unroll
    for (int i = 0; i < 8; ++i) { const int e = F.lane + 64 * i; gw[e] = src[(e >> 5) * 256 + (e & 31)]; }
    if (F.lane < 32) gb[F.lane] = Pk->in[I_GGB][(l * 2 + dir) * 256 + h * 32 + F.lane];
}
struct GlaIn { f32x4 ag[4]; u32x4 kv, qv, v0, v1; };
template <bool NEEDQ>
__device__ __forceinline__ void gla_sub_load(Frame& F, int b, int h, int dir, int kidx0, GlaIn& in) {
    unsigned char* ws = F.ws;
    int lane_o = F.lane; asm volatile("" : "+v"(lane_o));
    const int tau = lane_o & 15, dq = lane_o >> 4, row = keyrow(b, kidx0 + tau);
    const f32x4* ag = (const f32x4*)((const float*)(ws + WS_AG) + (size_t)row * 32 + dir * 16);
#pragma unroll
    for (int r4 = 0; r4 < 4; ++r4) in.ag[r4] = ag[r4];
    const bf16_t* U = (const bf16_t*)(ws + WS_U) + (size_t)row * NU;
    in.kv = *(const u32x4*)(U + UC_GK + h * 32 + dq * 8);
    if (NEEDQ) in.qv = *(const u32x4*)(U + UC_GQ + h * 32 + dq * 8);
    in.v0 = *(const u32x4*)(U + UC_GV + h * 64 + dq * 16); in.v1 = *(const u32x4*)(U + UC_GV + h * 64 + dq * 16 + 8);
}
template <bool NEEDQ>
__device__ __forceinline__ void gla_sub_prep(Frame& F, int dir, const GlaIn& in, LAS unsigned char* wl, float (&ltot)[8]) {
    int lane_o = F.lane; asm volatile("" : "+v"(lane_o));
    const int tau = lane_o & 15, dq = lane_o >> 4;
    const LAS float* gw = (const LAS float*)(wl + GL_GW) + dq * 8; const LAS float* gb = (const LAS float*)(wl + GL_GB) + dq * 8;
    const f32x4* ag = in.ag;
    float x[8];
    { const f32x4 b0 = *(const LAS f32x4*)gb, b1 = *(const LAS f32x4*)(gb + 4); x[0] = b0[0]; x[1] = b0[1]; x[2] = b0[2]; x[3] = b0[3]; x[4] = b1[0]; x[5] = b1[1]; x[6] = b1[2]; x[7] = b1[3]; }
#pragma unroll
    for (int r4 = 0; r4 < 4; ++r4) { const f32x4 av = ag[r4]; f32x4 wq[4][2];
#pragma unroll
        for (int rr = 0; rr < 4; ++rr) { wq[rr][0] = *(const LAS f32x4*)(gw + (4 * r4 + rr) * 32); wq[rr][1] = *(const LAS f32x4*)(gw + (4 * r4 + rr) * 32 + 4); }
        __builtin_amdgcn_sched_barrier(0);
#pragma unroll
        for (int rr = 0; rr < 4; ++rr) { const f32x4 w0 = wq[rr][0], w1 = wq[rr][1];
            x[0] += av[rr] * w0[0]; x[1] += av[rr] * w0[1]; x[2] += av[rr] * w0[2]; x[3] += av[rr] * w0[3]; x[4] += av[rr] * w1[0]; x[5] += av[rr] * w1[1]; x[6] += av[rr] * w1[2]; x[7] += av[rr] * w1[3]; }
        __builtin_amdgcn_sched_barrier(0); }
#pragma unroll
    for (int j = 0; j < 8; ++j) x[j] = (fminf(x[j], 0.f) - __logf(1.f + __expf(-fabsf(x[j])))) * (1.f / 16.f);
#define GLA_DPP(v, ctrl) __builtin_bit_cast(float, __builtin_amdgcn_update_dpp(0, __builtin_bit_cast(int, (v)), (ctrl), 0xF, 0xF, true))
    float tot[8];
#pragma unroll
    for (int j = 0; j < 8; ++j) { float t = x[j]; t += GLA_DPP(t, 0xB1); t += GLA_DPP(t, 0x4E); t += GLA_DPP(t, 0x141); t += GLA_DPP(t, 0x140); tot[j] = t; ltot[j] += t; }
    if (dir == 0) {
#pragma unroll
        for (int j = 0; j < 8; ++j) { x[j] += GLA_DPP(x[j], 0x111); x[j] += GLA_DPP(x[j], 0x112); x[j] += GLA_DPP(x[j], 0x114); x[j] += GLA_DPP(x[j], 0x118); } }
    else {
#pragma unroll
        for (int j = 0; j < 8; ++j) { x[j] += GLA_DPP(x[j], 0x101); x[j] += GLA_DPP(x[j], 0x102); x[j] += GLA_DPP(x[j], 0x104); x[j] += GLA_DPP(x[j], 0x108); } }
#undef GLA_DPP
    const u32x4 kv = in.kv;
    const float kf[8] = {bflo(kv.x), bfhi(kv.x), bflo(kv.y), bfhi(kv.y), bflo(kv.z), bfhi(kv.z), bflo(kv.w), bfhi(kv.w)};
    float kt[8], kh[8];
#pragma unroll
    for (int j = 0; j < 8; ++j) { kt[j] = kf[j] * __expf(-x[j]); kh[j] = kf[j] * __expf(tot[j] - x[j]); }
    { u32x4 w; w.x = pk2(kt[0], kt[1]); w.y = pk2(kt[2], kt[3]); w.z = pk2(kt[4], kt[5]); w.w = pk2(kt[6], kt[7]); *(LAS u32x4*)(wl + GL_KT + (tau * 40 + dq * 8) * 2) = w; }
#pragma unroll
    for (int j = 0; j < 8; ++j) *(LAS unsigned short*)(wl + GL_KHT + ((dq * 8 + j) * 24 + tau) * 2) = (unsigned short)f2bf(kh[j]);
    if (NEEDQ) { const u32x4 qv = in.qv; const float sc = 0.17677669529663687f;
        const float qf[8] = {bflo(qv.x), bfhi(qv.x), bflo(qv.y), bfhi(qv.y), bflo(qv.z), bfhi(qv.z), bflo(qv.w), bfhi(qv.w)}; float qt[8];
#pragma unroll
        for (int j = 0; j < 8; ++j) qt[j] = qf[j] * sc * __expf(x[j]);
        u32x4 w; w.x = pk2(qt[0], qt[1]); w.y = pk2(qt[2], qt[3]); w.z = pk2(qt[4], qt[5]); w.w = pk2(qt[6], qt[7]); *(LAS u32x4*)(wl + GL_QT + (tau * 40 + dq * 8) * 2) = w; }
    if (tau == 0) {
#pragma unroll
        for (int j = 0; j < 8; ++j) ((LAS float*)(wl + GL_G))[dq * 8 + j] = __expf(tot[j]); }
    { const u32x4 v0 = in.v0, v1 = in.v1;
      const unsigned vw[8] = {v0.x, v0.y, v0.z, v0.w, v1.x, v1.y, v1.z, v1.w};
#pragma unroll
      for (int j = 0; j < 8; ++j) { *(LAS unsigned short*)(wl + GL_VT + ((dq * 16 + 2 * j) * 24 + tau) * 2) = (unsigned short)(vw[j] & 0xffffu); *(LAS unsigned short*)(wl + GL_VT + ((dq * 16 + 2 * j + 1) * 24 + tau) * 2) = (unsigned short)(vw[j] >> 16); } }
}
__device__ __forceinline__ void gla_state_update(Frame& F, LAS unsigned char* wl, f32x4 (&Sr)[2][4]) {
    int lane_o = F.lane; asm volatile("" : "+v"(lane_o));
    const int r16 = lane_o & 15, kg = lane_o >> 4; const bf16x8 zf = {0, 0, 0, 0, 0, 0, 0, 0};
    bf16x8 vb[4];
#pragma unroll
    for (int nb = 0; nb < 4; ++nb) { vb[nb] = *(const LAS bf16x8*)(wl + GL_VT + ((16 * nb + r16) * 24 + 8 * (kg & 1)) * 2); if (kg >= 2) vb[nb] = zf; }
#pragma unroll
    for (int db = 0; db < 2; ++db) { const f32x4 gv = *(const LAS f32x4*)(wl + GL_G + (16 * db + 4 * kg) * 4);
        bf16x8 ka = *(const LAS bf16x8*)(wl + GL_KHT + ((16 * db + r16) * 24 + 8 * (kg & 1)) * 2); if (kg >= 2) ka = zf;
#pragma unroll
        for (int nb = 0; nb < 4; ++nb) Sr[db][nb] = MFMA16(ka, vb[nb], Sr[db][nb] * gv); }
}
constexpr int GGRP = 6, NGRP = NCH / GGRP;
constexpr size_t WS_GGS = WS_GSS, WS_GGA = WS_GSS + 8 * MiB;
__device__ __forceinline__ void gla_pass_a(KP Pk, Frame& F, int l, int it, LAS unsigned char* wl) {
    unsigned char* ws = F.ws;
    const int seq = it / NGRP, g = it % NGRP, dir = seq & 1, h = (seq >> 1) & 7, b = seq >> 4, r16 = F.lane & 15, kg = F.lane >> 4;
    gla_load_gates(Pk, F, l, h, dir, wl);
    f32x4 Sr[2][4];
#pragma unroll
    for (int db = 0; db < 2; ++db)
#pragma unroll
        for (int nb = 0; nb < 4; ++nb) Sr[db][nb] = (f32x4){0.f, 0.f, 0.f, 0.f};
    float ltot[8] = {0.f, 0.f, 0.f, 0.f, 0.f, 0.f, 0.f, 0.f};
    GlaIn nin;
    { const int c0 = g * GGRP; gla_sub_load<false>(F, b, h, dir, (dir == 0 ? 64 * c0 : gla_kidx(1, 64 * c0) - 63) + 16 * (dir == 0 ? 0 : 3), nin); }
#pragma unroll 1
    for (int cg = 0; cg <= GGRP; ++cg) {
        const int c = g * GGRP + cg;
        float* sl = cg < GGRP ? (float*)(ws + WS_GSL) + ((size_t)seq * NCH + c) * 2048 : (float*)(ws + WS_GGS) + ((size_t)seq * NGRP + g) * 2048;
        float* al = cg < GGRP ? (float*)(ws + WS_GAE) + ((size_t)seq * NCH + c) * 32 : (float*)(ws + WS_GGA) + ((size_t)seq * NGRP + g) * 32;
#pragma unroll
        for (int db = 0; db < 2; ++db)
#pragma unroll
            for (int nb = 0; nb < 4; ++nb)
#pragma unroll
                for (int i = 0; i < 4; ++i) sl[(16 * db + 4 * kg + i) * 64 + 16 * nb + r16] = Sr[db][nb][i];
        if ((F.lane & 15) == 0) {
#pragma unroll
            for (int j = 0; j < 8; ++j) al[kg * 8 + j] = __expf(ltot[j]); }
        if (cg == GGRP) break;
#pragma unroll 1
        for (int st = 0; st < 4; ++st) {
            const GlaIn cur = nin;
            { const int q2 = cg * 4 + st + 1, c2 = g * GGRP + (q2 >> 2), st2 = q2 & 3, sb2 = dir == 0 ? st2 : 3 - st2;
              if (q2 < 4 * GGRP) gla_sub_load<false>(F, b, h, dir, (dir == 0 ? 64 * c2 : gla_kidx(1, 64 * c2) - 63) + 16 * sb2, nin); }
            gla_sub_prep<false>(F, dir, cur, wl, ltot);
            gla_state_update(F, wl, Sr); }
    }
}
__device__ __forceinline__ void gla_pass_b(KP Pk, Frame& F, int l, int b, int h, int c, LAS unsigned char* wl) {
    unsigned char* ws = F.ws;
    const int r16 = F.lane & 15, kg = F.lane >> 4, seq = (b * 8 + h) * 2; const bf16x8 zf = {0, 0, 0, 0, 0, 0, 0, 0};
    const bf16_t* U = (const bf16_t*)(ws + WS_U); unsigned char* MIX = ws + WS_H;
    u32x2 of[4][4];
#pragma unroll 1
    for (int dir = 0; dir < 2; ++dir) {
        gla_load_gates(Pk, F, l, h, dir, wl);
        const int cc = dir == 0 ? c : (c < 4 ? 3 - c : 39 - c);
        f32x4 Sr[2][4];
#pragma unroll
        for (int db = 0; db < 2; ++db)
#pragma unroll
            for (int nb = 0; nb < 4; ++nb) Sr[db][nb] = (f32x4){0.f, 0.f, 0.f, 0.f};
        { const int gsel = cc / GGRP;
#pragma unroll 1
          for (int gp = 0; gp <= gsel; ++gp) {
            const bool fin = gp == gsel;
            const float* sp = fin ? (const float*)(ws + WS_GSL) + ((size_t)(seq + dir) * NCH + cc) * 2048 : (const float*)(ws + WS_GGS) + ((size_t)(seq + dir) * NGRP + gp) * 2048;
            const float* apx = fin ? (const float*)(ws + WS_GAE) + ((size_t)(seq + dir) * NCH + cc) * 32 : (const float*)(ws + WS_GGA) + ((size_t)(seq + dir) * NGRP + gp) * 32;
#pragma unroll
            for (int db = 0; db < 2; ++db) { const f32x4 av = *(const f32x4*)(apx + 16 * db + 4 * kg);
#pragma unroll
                for (int nb = 0; nb < 4; ++nb)
#pragma unroll
                    for (int i = 0; i < 4; ++i) Sr[db][nb][i] = av[i] * Sr[db][nb][i] + sp[(16 * db + 4 * kg + i) * 64 + 16 * nb + r16]; } } }
        float ltot[8] = {0.f, 0.f, 0.f, 0.f, 0.f, 0.f, 0.f, 0.f};
#pragma unroll 1
        for (int st = 0; st < 4; ++st) { const int sb = dir == 0 ? st : 3 - st;
            int lane_o = F.lane; asm volatile("" : "+v"(lane_o)); const int r16 = lane_o & 15, kg = lane_o >> 4;
#pragma unroll
            for (int db = 0; db < 2; ++db)
#pragma unroll
                for (int nb = 0; nb < 4; ++nb) { u32x2 w; w.x = pk2(Sr[db][nb][0], Sr[db][nb][1]); w.y = pk2(Sr[db][nb][2], Sr[db][nb][3]); *(LAS u32x2*)(wl + GL_ST + ((16 * nb + r16) * 40 + 16 * db + 4 * kg) * 2) = w; }
            { GlaIn in; gla_sub_load<true>(F, b, h, dir, 64 * c + 16 * sb, in); gla_sub_prep<true>(F, dir, in, wl, ltot); }
            const bf16x8 bq = *(const LAS bf16x8*)(wl + GL_QT + (r16 * 40 + 8 * kg) * 2);
            { const bf16x8 ka = *(const LAS bf16x8*)(wl + GL_KT + (r16 * 40 + 8 * kg) * 2);
              f32x4 p = MFMA16(ka, bq, ((f32x4){0.f, 0.f, 0.f, 0.f}));
#pragma unroll
              for (int i = 0; i < 4; ++i) { const int sidx = 4 * kg + i; const bool keep = dir == 0 ? (sidx <= r16) : (sidx >= r16); p[i] = keep ? p[i] : 0.f; }
              u32x2 w; w.x = pk2(p[0], p[1]); w.y = pk2(p[2], p[3]); *(LAS u32x2*)(wl + GL_PT + (r16 * 24 + 4 * kg) * 2) = w; }
            bf16x8 pb = *(const LAS bf16x8*)(wl + GL_PT + (r16 * 24 + 8 * (kg & 1)) * 2); if (kg >= 2) pb = zf;
            f32x4 o[4];
#pragma unroll
            for (int nb = 0; nb < 4; ++nb) { const bf16x8 sa = *(const LAS bf16x8*)(wl + GL_ST + ((16 * nb + r16) * 40 + 8 * kg) * 2);
                bf16x8 va = *(const LAS bf16x8*)(wl + GL_VT + ((16 * nb + r16) * 24 + 8 * (kg & 1)) * 2); if (kg >= 2) va = zf;
                o[nb] = MFMA16(sa, bq, ((f32x4){0.f, 0.f, 0.f, 0.f})); o[nb] = MFMA16(va, pb, o[nb]); }
            if (dir == 0) { u32x2 t[4];
#pragma unroll
                for (int nb = 0; nb < 4; ++nb) { t[nb].x = pk2(o[nb][0], o[nb][1]); t[nb].y = pk2(o[nb][2], o[nb][3]); }
#define OF_PUT(k) { _Pragma("unroll") for (int nb = 0; nb < 4; ++nb) of[k][nb] = t[nb]; }
                if (sb == 0) OF_PUT(0) else if (sb == 1) OF_PUT(1) else if (sb == 2) OF_PUT(2) else OF_PUT(3)
#undef OF_PUT
            }
            else { float ss = 0.f; u32x2 t[4];
#define OF_GET(k) { _Pragma("unroll") for (int nb = 0; nb < 4; ++nb) t[nb] = of[k][nb]; }
                if (sb == 0) OF_GET(0) else if (sb == 1) OF_GET(1) else if (sb == 2) OF_GET(2) else OF_GET(3)
#undef OF_GET
#pragma unroll
                for (int nb = 0; nb < 4; ++nb) { o[nb][0] += bflo(t[nb].x); o[nb][1] += bfhi(t[nb].x); o[nb][2] += bflo(t[nb].y); o[nb][3] += bfhi(t[nb].y); ss += (o[nb][0] * o[nb][0] + o[nb][1] * o[nb][1]) + (o[nb][2] * o[nb][2] + o[nb][3] * o[nb][3]); }
                ss += __shfl_xor(ss, 16); ss += __shfl_xor(ss, 32);
                const float rstd = rsqrtf(ss * (1.f / 64.f) + NORM_EPS); const int row = keyrow(b, 64 * c + 16 * sb + r16);
#pragma unroll
                for (int nb = 0; nb < 4; ++nb) { const int dv0 = 16 * nb + 4 * kg; const u32x2 gg = *(const u32x2*)(U + (size_t)row * NU + UC_GG + h * 64 + dv0); const f32x4 nw = *(const f32x4*)(Pk->in[I_GNW] + l * 64 + dv0);
                    const float y0 = o[nb][0] * rstd * nw[0] * silu_f(bflo(gg.x)), y1 = o[nb][1] * rstd * nw[1] * silu_f(bfhi(gg.x)), y2 = o[nb][2] * rstd * nw[2] * silu_f(bflo(gg.y)), y3 = o[nb][3] * rstd * nw[3] * silu_f(bfhi(gg.y));
                    if (WOUT_F8) *(unsigned*)(MIX + ((size_t)row * D + h * 64 + dv0)) = pk4_f8(y0, y1, y2, y3);
                    else { u32x2 w; w.x = pk2(y0, y1); w.y = pk2(y2, y3); *(u32x2*)(MIX + ((size_t)row * D + h * 64 + dv0) * 2) = w; } } }
            if (st < 3) gla_state_update(F, wl, Sr);
        }
    }
}
__device__ __forceinline__ float dpp_x1(float v) { return __builtin_bit_cast(float, __builtin_amdgcn_update_dpp(0, __builtin_bit_cast(int, v), 0xB1, 0xF, 0xF, true)); }
__device__ __forceinline__ float dpp_x2(float v) { return __builtin_bit_cast(float, __builtin_amdgcn_update_dpp(0, __builtin_bit_cast(int, v), 0x4E, 0xF, 0xF, true)); }
__device__ __forceinline__ float dpp_hm(float v) { return __builtin_bit_cast(float, __builtin_amdgcn_update_dpp(0, __builtin_bit_cast(int, v), 0x141, 0xF, 0xF, true)); }
__device__ __forceinline__ void qk_vec(bf16_t* p, const u32x4 r, const float (&w)[8], const float (&cs)[8], const float (&sn)[8]) {
    float x[8] = {bflo(r.x), bfhi(r.x), bflo(r.y), bfhi(r.y), bflo(r.z), bfhi(r.z), bflo(r.w), bfhi(r.w)};
    float ss = 0.f;
#pragma unroll
    for (int e = 0; e < 8; ++e) ss += x[e] * x[e];
    ss += dpp_x1(ss); ss += dpp_x2(ss); ss += dpp_hm(ss);
    const float rstd = rsqrtf(ss * (1.f / 64.f) + NORM_EPS);
    float o[8];
#pragma unroll
    for (int e = 0; e < 8; ++e) { const float y = x[e] * rstd * w[e]; o[e] = y * cs[e] + dpp_x2(y) * sn[e]; }
    u32x4 q; q.x = pk2(o[0], o[1]); q.y = pk2(o[2], o[3]); q.z = pk2(o[4], o[5]); q.w = pk2(o[6], o[7]);
    *(u32x4*)p = q;
}
__device__ __forceinline__ void qk_rope(const unsigned char* ws, int row, int j, float (&cs)[8], float (&sn)[8]) {
    if (row < TL) { const float* rp = (const float*)(ws + WS_ROPE) + (size_t)(row & (SEQ - 1)) * 64 + 32 * (j >> 2) + 8 * (j & 1);
        const f32x4 c0 = *(const f32x4*)rp, c1 = *(const f32x4*)(rp + 4), s0 = *(const f32x4*)(rp + 16), s1 = *(const f32x4*)(rp + 20); const float sg = (j & 2) ? 1.f : -1.f;
#pragma unroll
        for (int e = 0; e < 4; ++e) { cs[e] = c0[e]; cs[4 + e] = c1[e]; sn[e] = sg * s0[e]; sn[4 + e] = sg * s1[e]; } }
    else {
#pragma unroll
        for (int e = 0; e < 8; ++e) { cs[e] = 1.f; sn[e] = 0.f; } }
}
__device__ __forceinline__ void prep_qk_rows4(KP Pk, Frame& F, int l, int row0) {
    unsigned char* ws = F.ws;
    bf16_t* U = (bf16_t*)(ws + WS_U);
    const int j = F.lane & 7; const float qs = 0.125f * LOG2E;
    u32x4 raw[4][3], rawk;
#pragma unroll
    for (int r = 0; r < 4; ++r) { const bf16_t* up = U + (size_t)(row0 + r) * NU + 8 * F.lane; raw[r][0] = *(const u32x4*)(up + UC_SQ); raw[r][1] = *(const u32x4*)(up + UC_DQ); raw[r][2] = *(const u32x4*)(up + UC_DK); }
    const int rowk = row0 + (F.lane >> 4);
    rawk = *(const u32x4*)(U + (size_t)rowk * NU + UC_SK + 8 * (F.lane & 15));
    float wsq[8], wdq[8], wdk[8], wsk[8];
    { const float* a = Pk->in[I_SQN] + l * 64 + 8 * j; const float* b = Pk->in[I_DQN] + l * 64 + 8 * j; const float* c = Pk->in[I_DKN] + l * 64 + 8 * j; const float* d = Pk->in[I_SKN] + l * 64 + 8 * j;
#pragma unroll
      for (int e = 0; e < 8; ++e) { wsq[e] = a[e] * qs; wdq[e] = b[e] * qs; wdk[e] = c[e]; wsk[e] = d[e]; } }
    float cs[4][8], sn[4][8], csk[8], snk[8];
#pragma unroll
    for (int r = 0; r < 4; ++r) qk_rope(ws, row0 + r, j, cs[r], sn[r]);
    qk_rope(ws, rowk, j, csk, snk);
    asm volatile("" ::: "memory");
#pragma unroll
    for (int r = 0; r < 4; ++r) { bf16_t* up = U + (size_t)(row0 + r) * NU + 8 * F.lane;
        qk_vec(up + UC_SQ, raw[r][0], wsq, cs[r], sn[r]); qk_vec(up + UC_DQ, raw[r][1], wdq, cs[r], sn[r]); qk_vec(up + UC_DK, raw[r][2], wdk, cs[r], sn[r]); }
    qk_vec(U + (size_t)rowk * NU + UC_SK + 8 * (F.lane & 15), rawk, wsk, csk, snk);
}
template <bool PERMK, int NCOLS, class SRC>
__device__ __forceinline__ void tile_transpose(LAS unsigned char* wl, int lane, bf16_t* dst, size_t dst_stride, const SRC& src) {
    LAS unsigned* tl = (LAS unsigned*)wl;
    constexpr int ncols = NCOLS, cpr = NCOLS / 8;
    LDS_WAIT(); asm volatile("" ::: "memory");
#pragma unroll 1
    for (int k0 = 0; k0 < cpr; k0 += 4) { u32x4 v[4];
#pragma unroll
      for (int k = 0; k < 4; ++k) { const int id = lane + 64 * (k0 + k); v[k] = src(id / cpr, id % cpr); }
#pragma unroll
      for (int k = 0; k < 4; ++k) { const int id = lane + 64 * (k0 + k); LAS unsigned* p = tl + (id / cpr) * 65 + (id % cpr) * 4; p[0] = v[k].x; p[1] = v[k].y; p[2] = v[k].z; p[3] = v[k].w; } }
    LDS_WAIT(); asm volatile("" ::: "memory");
    const LAS unsigned short* ts = (const LAS unsigned short*)wl;
    const int cc = lane & 7;
    for (int dv = lane >> 3; dv < ncols; dv += 8) {
        unsigned short e[8];
#pragma unroll
        for (int i = 0; i < 8; ++i) { const int p = 8 * cc + i, srow = PERMK ? ((p & ~15) + perm16(p & 15)) : p; e[i] = ts[srow * 130 + dv]; }
        u32x4 o; o.x = e[0] | ((unsigned)e[1] << 16); o.y = e[2] | ((unsigned)e[3] << 16); o.z = e[4] | ((unsigned)e[5] << 16); o.w = e[6] | ((unsigned)e[7] << 16);
        *(u32x4*)(dst + (size_t)dv * dst_stride + 8 * cc) = o; }
}
__device__ __forceinline__ void ph_prep(KP Pk, Frame& F, int l, int rep) {
    unsigned char* ws = F.ws;
    const int gw = F.vcu * NWAVES + F.wave, NGW = F.G * NWAVES;
    LAS unsigned char* wl = F.lds + F.wave * WAVE_LDS;
    const bf16_t* U = (const bf16_t*)(ws + WS_U);
    const int n_gla = 128 * NGRP, n_hy = NB * (l == 0 ? 36 : 32) * 12, n_vd = NB * 4 * 36, n_vs = NB * 2 * 36, n_rows = rep ? 0 : TT / 4;
    if (gw < n_gla) { gla_pass_a(Pk, F, l, gw, wl); }
    const int total = n_hy + n_vd + n_vs + n_rows, nrest = NGW - n_gla;
    for (int it0 = gw - n_gla; it0 < total && gw >= n_gla; it0 += nrest) {
        int it = it0;
        if (it < n_hy) {
            const int ntile = l == 0 ? 36 : 32, b = it / (ntile * 12), r = it % (ntile * 12), tile = r / 12, cb = r % 12, c0 = cb * 128;
            const bool lat = tile < 32; const int p0 = lat ? 64 * tile : 64 * (tile - 32), Ls = lat ? SEQ : LC, rbase = lat ? b * SEQ : TL + b * LC;
            const float* cw = Pk->in[I_HCW] + (size_t)l * 3 * 1536 + c0 + (F.lane & 15) * 8; const float* cbias = Pk->in[I_HCB] + (size_t)l * 1536 + c0 + (F.lane & 15) * 8;
            float w0[8], w1[8], w2[8], wb[8];
#pragma unroll
            for (int k = 0; k < 8; ++k) { w0[k] = cw[k]; w1[k] = cw[1536 + k]; w2[k] = cw[3072 + k]; wb[k] = cbias[k]; }
            auto src = [&](int i, int ch) -> u32x4 { const int p = p0 + i; const bf16_t* up = U + (size_t)(rbase + p) * NU + UC_HY + c0 + ch * 8;
                const u32x4 m = *(const u32x4*)up; u32x4 a = {0u, 0u, 0u, 0u}, c = {0u, 0u, 0u, 0u};
                if (p > 0) a = *(const u32x4*)(up - NU); if (p + 1 < Ls) c = *(const u32x4*)(up + NU);
                const unsigned av[4] = {a.x, a.y, a.z, a.w}, mv[4] = {m.x, m.y, m.z, m.w}, cv[4] = {c.x, c.y, c.z, c.w}; unsigned o[4];
#pragma unroll
                for (int q = 0; q < 4; ++q) { const int k = 2 * q;
                    const float z0 = bflo(av[q]) * w0[k] + bflo(mv[q]) * w1[k] + bflo(cv[q]) * w2[k] + wb[k];
                    const float z1 = bfhi(av[q]) * w0[k + 1] + bfhi(mv[q]) * w1[k + 1] + bfhi(cv[q]) * w2[k + 1] + wb[k + 1];
                    o[q] = pk2(z0, z1); }
                return (u32x4){o[0], o[1], o[2], o[3]}; };
            tile_transpose<false, 128>(wl, F.lane, (bf16_t*)(ws + WS_ZT) + ((size_t)b * 1536 + c0) * KEYS + (lat ? p0 : SEQ + p0), KEYS, src);
            continue; } it -= n_hy;
        if (it < n_vd) {
            const int b = it / 144, r = it % 144, h = r / 36, tile = r % 36;
            auto src = [&](int i, int ch) -> u32x4 { return *(const u32x4*)(U + (size_t)keyrow(b, 64 * tile + i) * NU + UC_DV + h * 128 + ch * 8); };
            tile_transpose<true, 128>(wl, F.lane, (bf16_t*)(ws + WS_VTD) + ((size_t)(b * 4 + h) * 128) * KEYS + 64 * tile, KEYS, src);
            continue; } it -= n_vd;
        if (it < n_vs) {
            const int b = it / 72, r = it % 72, h = r / 36, tile = r % 36;
            auto src = [&](int i, int ch) -> u32x4 { return *(const u32x4*)(U + (size_t)keyrow(b, 64 * tile + i) * NU + UC_SV + h * 64 + ch * 8); };
            tile_transpose<true, 64>(wl, F.lane, (bf16_t*)(ws + WS_VTS) + ((size_t)(b * 2 + h) * 64) * KEYS + 64 * tile, KEYS, src);
            continue; } it -= n_vs;
        prep_qk_rows4(Pk, F, l, it * 4);
    }
}
__device__ __forceinline__ void ph_gla_scan(Frame& F) {
    unsigned char* ws = F.ws;
    const int gw = F.vcu * NWAVES + F.wave, NGW = F.G * NWAVES;
    for (int it = gw; it < 128 * 32; it += NGW) { const int seq = it >> 5, d = it & 31;
        const float* sl = (const float*)(ws + WS_GSL) + (size_t)seq * NCH * 2048 + d * 64 + F.lane; float* ss = (float*)(ws + WS_GSS) + (size_t)seq * NCH * 2048 + d * 64 + F.lane;
        const float* ae = (const float*)(ws + WS_GAE) + (size_t)seq * NCH * 32 + d;
        float x[NCH], a[NCH];
#pragma unroll
        for (int c = 0; c < NCH; ++c) { x[c] = sl[(size_t)c * 2048]; a[c] = ae[c * 32]; }
        float S = 0.f;
#pragma unroll
        for (int c = 0; c < NCH; ++c) { ss[(size_t)c * 2048] = S; S = a[c] * S + x[c]; }
    }
}

__device__ __forceinline__ int crow(int r, int hi) { return (r & 3) + 8 * (r >> 2) + 4 * hi; }
template <int KW, int DV, bool MASK>
__device__ __forceinline__ void attn_core(Frame& F, const bf16_t* U, int b, int kcol0, const bf16_t* VT, int nctx, int nloc, int loc0,
                                          const bf16x8 (&q)[4], int koff, int qpos0, float sh2, f32x16 (&O)[DV / 32], float& lsum) {
    constexpr int KRB = KW * 2, KB = 64 * KRB, VB = DV * 128, SLOT = KB + VB, NKC = KB / 8192, NVC = VB / 8192, NDMA = NKC + NVC;
    const int r32 = F.lane & 31, hi = F.lane >> 5, nt = nctx + nloc;
#define ATT_DMA(ti) do { const int _k0 = (ti) < nctx ? 64 * (ti) : loc0 + 64 * ((ti) - nctx); LAS unsigned char* _sl = F.lds + ((ti) & 3) * SLOT; \
        _Pragma("unroll") for (int _j = 0; _j < NKC; ++_j) { const int _ch = F.wave + 8 * _j; int _row, _c; \
            if (KW == 128) { _row = 4 * _ch + (F.lane >> 4); _c = (F.lane & 15) ^ (_row & 15); } else { _row = 8 * _ch + (F.lane >> 3); _c = (F.lane & 7) ^ ((_row >> 1) & 7); } \
            __builtin_amdgcn_global_load_lds((const unsigned*)(U + (size_t)keyrow(b, _k0 + _row) * NU + kcol0 + _c * 8), (LAS unsigned*)(_sl + _ch * 1024), 16, 0, 0); } \
        _Pragma("unroll") for (int _j = 0; _j < NVC; ++_j) { const int _ch = F.wave + 8 * _j, _row = 8 * _ch + (F.lane >> 3), _c = (F.lane & 7) ^ ((_row >> 1) & 7); \
            __builtin_amdgcn_global_load_lds((const unsigned*)(VT + (size_t)_row * KEYS + _k0 + _c * 8), (LAS unsigned*)(_sl + KB + _ch * 1024), 16, 0, 0); } } while (0)
    f32x16 s0, s1; bf16x8 pa[4];
#define DSR(dst, addr, off) asm volatile("ds_read_b128 %0, %1 offset:%2" : "=v"(dst) : "v"(addr), "n"(off))
#define LWAIT4(f) asm volatile("s_waitcnt lgkmcnt(0)" : "+v"(f[0]), "+v"(f[1]), "+v"(f[2]), "+v"(f[3]))
    unsigned kad[4], vad[4];
#pragma unroll
    for (int i = 0; i < 4; ++i) { const int c = 2 * i + hi;
        kad[i] = (unsigned)(uintptr_t)F.lds + (KW == 128 ? r32 * 256 + ((((koff >> 3) + c) ^ (r32 & 15)) << 4) : r32 * 128 + ((c ^ ((r32 >> 1) & 7)) << 4));
        vad[i] = (unsigned)(uintptr_t)F.lds + KB + r32 * 128 + ((c ^ ((r32 >> 1) & 7)) << 4); }
    __syncthreads();
    ATT_DMA(0);
    if (nt > 1) ATT_DMA(1);
    if (nt > 2) ATT_DMA(2);
    if (nt > 2) asm volatile("s_waitcnt vmcnt(%0)" :: "n"(NDMA) : "memory"); else asm volatile("s_waitcnt vmcnt(0)" ::: "memory");
    __syncthreads();
#define EXP1(ti, r) do { s0[r] = __builtin_amdgcn_exp2f(s0[r]); s1[r] = __builtin_amdgcn_exp2f(s1[r]); \
        if (MASK && (ti) >= nctx) { const int k0 = loc0 - LC + 64 * ((ti) - nctx) + crow(r, hi), k1 = k0 + 32, d0 = qpos0 + r32 - k0, d1 = d0 - 32; \
            if (k0 < 0 || k0 >= SEQ || d0 > 128 || d0 < -128) s0[r] = 0.f; if (k1 < 0 || k1 >= SEQ || d1 > 128 || d1 < -128) s1[r] = 0.f; } } while (0)
#define RD_K(f, h) do { DSR(f[0], ka[2 * (h)], 0); DSR(f[1], ka[2 * (h)], 32 * KRB); DSR(f[2], ka[2 * (h) + 1], 0); DSR(f[3], ka[2 * (h) + 1], 32 * KRB); } while (0)
#define RD_V(f, nb) do { DSR(f[0], va[0], (nb) * 4096); DSR(f[1], va[1], (nb) * 4096); DSR(f[2], va[2], (nb) * 4096); DSR(f[3], va[3], (nb) * 4096); } while (0)
#define SB() __builtin_amdgcn_sched_barrier(0)
#define PKW(S, B) pg8::cvt_pk_bf16(S[B], S[(B) + 1])
#define PV1(f, nb, kk, ti, R0, NE) do { O[nb] = MFMA32(pa[kk], f[kk], O[nb]); if (more) { _Pragma("unroll") for (int _r = 0; _r < (NE); ++_r) EXP1(ti, (R0) + _r); } SB(); } while (0)
    {
        bf16x8 fa[4], fb[4]; unsigned ka[4];
#pragma unroll
        for (int i = 0; i < 4; ++i) ka[i] = kad[i];
        RD_K(fa, 0); RD_K(fb, 1);
#pragma unroll
        for (int r = 0; r < 16; ++r) { s0[r] = -sh2; s1[r] = -sh2; }
        LWAIT4(fa); LWAIT4(fb);
        s0 = MFMA32(fa[0], q[0], s0); s1 = MFMA32(fa[1], q[0], s1); s0 = MFMA32(fa[2], q[1], s0); s1 = MFMA32(fa[3], q[1], s1);
        s0 = MFMA32(fb[0], q[2], s0); s1 = MFMA32(fb[1], q[2], s1); s0 = MFMA32(fb[2], q[3], s0); s1 = MFMA32(fb[3], q[3], s1);
#pragma unroll
        for (int r = 0; r < 16; ++r) EXP1(0, r);
    }
#define ATT_STEP(MORE) { \
        constexpr bool more = (MORE); \
        if (t + 3 < nt) ATT_DMA(t + 3); \
        unsigned ka[4], va[4]; \
        { int lo_ = F.lane; asm volatile("" : "+v"(lo_)); const int rr = lo_ & 31, hh = lo_ >> 5; \
        _Pragma("unroll") \
          for (int i = 0; i < 4; ++i) { const int c = 2 * i + hh; \
            ka[i] = (unsigned)(uintptr_t)F.lds + ((t + 1) & 3) * SLOT + (KW == 128 ? rr * 256 + ((((koff >> 3) + c) ^ (rr & 15)) << 4) : rr * 128 + ((c ^ ((rr >> 1) & 7)) << 4)); \
            va[i] = (unsigned)(uintptr_t)F.lds + (t & 3) * SLOT + KB + rr * 128 + ((c ^ ((rr >> 1) & 7)) << 4); } } \
        bf16x8 fa[4], fb[4]; \
        if (more) { RD_K(fa, 0); RD_K(fb, 1); } else { RD_V(fa, 0); } \
        SB(); \
 \
        { float ps = 0.f; \
        _Pragma("unroll") \
          for (int r = 0; r < 16; ++r) ps += s0[r] + s1[r]; \
          lsum += ps; \
          u32x4 w; \
          w.x = PKW(s0, 0); w.y = PKW(s0, 2); w.z = PKW(s0, 4); w.w = PKW(s0, 6); pa[0] = __builtin_bit_cast(bf16x8, w); \
          w.x = PKW(s0, 8); w.y = PKW(s0, 10); w.z = PKW(s0, 12); w.w = PKW(s0, 14); pa[1] = __builtin_bit_cast(bf16x8, w); \
          w.x = PKW(s1, 0); w.y = PKW(s1, 2); w.z = PKW(s1, 4); w.w = PKW(s1, 6); pa[2] = __builtin_bit_cast(bf16x8, w); \
          w.x = PKW(s1, 8); w.y = PKW(s1, 10); w.z = PKW(s1, 12); w.w = PKW(s1, 14); pa[3] = __builtin_bit_cast(bf16x8, w); } \
        if (more) { \
        _Pragma("unroll") \
            for (int r = 0; r < 16; ++r) { s0[r] = -sh2; s1[r] = -sh2; } \
        } \
        SB(); \
        if (more) { \
            LWAIT4(fa); LWAIT4(fb); \
            s0 = MFMA32(fa[0], q[0], s0); s1 = MFMA32(fa[1], q[0], s1); s0 = MFMA32(fa[2], q[1], s0); s1 = MFMA32(fa[3], q[1], s1); \
            SB(); RD_V(fa, 0); SB(); \
            s0 = MFMA32(fb[0], q[2], s0); s1 = MFMA32(fb[1], q[2], s1); s0 = MFMA32(fb[2], q[3], s0); s1 = MFMA32(fb[3], q[3], s1); \
            SB(); \
        } \
        LWAIT4(fa); RD_V(fb, 1); SB(); \
        if (DV == 128) { \
            PV1(fa, 0, 0, t + 1, 0, 1); PV1(fa, 0, 1, t + 1, 1, 1); PV1(fa, 0, 2, t + 1, 2, 1); PV1(fa, 0, 3, t + 1, 3, 1); \
            LWAIT4(fb); RD_V(fa, 2); SB(); \
            PV1(fb, 1, 0, t + 1, 4, 1); PV1(fb, 1, 1, t + 1, 5, 1); PV1(fb, 1, 2, t + 1, 6, 1); PV1(fb, 1, 3, t + 1, 7, 1); \
            LWAIT4(fa); RD_V(fb, 3); SB(); \
            PV1(fa, 2, 0, t + 1, 8, 1); PV1(fa, 2, 1, t + 1, 9, 1); PV1(fa, 2, 2, t + 1, 10, 1); PV1(fa, 2, 3, t + 1, 11, 1); \
            LWAIT4(fb); SB(); \
            PV1(fb, 3, 0, t + 1, 12, 1); PV1(fb, 3, 1, t + 1, 13, 1); PV1(fb, 3, 2, t + 1, 14, 1); PV1(fb, 3, 3, t + 1, 15, 1); \
        } else { \
            PV1(fa, 0, 0, t + 1, 0, 2); PV1(fa, 0, 1, t + 1, 2, 2); PV1(fa, 0, 2, t + 1, 4, 2); PV1(fa, 0, 3, t + 1, 6, 2); \
            LWAIT4(fb); SB(); \
            PV1(fb, 1, 0, t + 1, 8, 2); PV1(fb, 1, 1, t + 1, 10, 2); PV1(fb, 1, 2, t + 1, 12, 2); PV1(fb, 1, 3, t + 1, 14, 2); \
        } \
        if (t + 3 < nt) asm volatile("s_waitcnt vmcnt(%0)" :: "n"(NDMA) : "memory"); else asm volatile("s_waitcnt vmcnt(0)" ::: "memory"); \
        __syncthreads(); \
    }
    int t = 0;
#pragma unroll 1
    for (; t + 1 < nt; ++t) ATT_STEP(true)
    ATT_STEP(false)
#undef ATT_STEP
#undef EXP1
#undef SB
#undef PKW
#undef PV1
#undef RD_K
#undef RD_V
#undef DSR
#undef LWAIT4
#undef ATT_DMA
}
__device__ __forceinline__ float score_bound(const float* wq, const float* wk, int lane) {
    float a = fabsf(wq[lane]), c = fabsf(wk[lane]);
#pragma unroll
    for (int o = 1; o < 64; o <<= 1) { a = fmaxf(a, __shfl_xor(a, o)); c = fmaxf(c, __shfl_xor(c, o)); }
    return 64.f * a * c * 0.125f * LOG2E;
}
__device__ __forceinline__ void diff_unit(KP Pk, Frame& F, int l, int b, int h, int qrow0, int nkt) {
    unsigned char* ws = F.ws;
    const bf16_t* U = (const bf16_t*)(ws + WS_U);
    const int m = F.wave & 1, rb = F.wave >> 1;
    const float sh2 = score_bound(Pk->in[I_DQN] + l * 64, Pk->in[I_DKN] + l * 64, F.lane);
    bf16x8 q[4];
    { const bf16_t* qp = U + (size_t)(qrow0 + 32 * rb + (F.lane & 31)) * NU + UC_DQ + h * 128 + m * 64 + 8 * (F.lane >> 5);
#pragma unroll
      for (int ks = 0; ks < 4; ++ks) q[ks] = *(const bf16x8*)(qp + 16 * ks); }
    f32x16 O[4];
#pragma unroll
    for (int nb = 0; nb < 4; ++nb) O[nb] = (f32x16){};
    float lsum = 0.f;
    attn_core<128, 128, false>(F, U, b, UC_DK + h * 128, (const bf16_t*)(ws + WS_VTD) + ((size_t)(b * 4 + h) * 128) * KEYS, nkt, 0, 0, q, 64 * m, 0, sh2, O, lsum);
    int ln_; asm volatile("v_mbcnt_lo_u32_b32 %0, -1, 0\n\tv_mbcnt_hi_u32_b32 %0, -1, %0" : "=v"(ln_));
    const int r32 = ln_ & 31, hi = ln_ >> 5;
    { int lo_ = l; asm volatile("" : "+s"(lo_)); l = lo_; Pk = kp_opaque(Pk); }
    lsum += __shfl_xor(lsum, 32);
    const float rl = 1.f / lsum;
    LAS float* ex = (LAS float*)F.lds + rb * 4096;
    float rlr[16];
#pragma unroll
    for (int r = 0; r < 16; ++r) rlr[r] = __shfl(rl, crow(r, hi));
    if (m == 1) {
#pragma unroll
        for (int nb = 0; nb < 4; ++nb)
#pragma unroll
            for (int r = 0; r < 16; ++r) ex[crow(r, hi) * 128 + nb * 32 + r32] = O[nb][r] * rlr[r];
    }
    __syncthreads();
    if (m == 0) {
        const float* dl = Pk->in[I_DLAM] + l * 256; const float lam_init = __builtin_bit_cast(float, __builtin_amdgcn_readfirstlane(__builtin_bit_cast(int, l == 0 ? 0.2f : (0.8f - 0.6f * 0.74081822068f))));
        const float lam = expf(wave_sum(dl[ln_] * dl[64 + ln_])) - expf(wave_sum(dl[128 + ln_] * dl[192 + ln_])) + lam_init;
        float ssq[16];
#pragma unroll
        for (int r = 0; r < 16; ++r) { float a = 0.f;
#pragma unroll
            for (int nb = 0; nb < 4; ++nb) { const float v = O[nb][r] * rlr[r] - lam * ex[crow(r, hi) * 128 + nb * 32 + r32]; O[nb][r] = v; a += v * v; }
            a += __shfl_xor(a, 1); a += __shfl_xor(a, 2); a += __shfl_xor(a, 4); a += __shfl_xor(a, 8); a += __shfl_xor(a, 16);
            ssq[r] = rsqrtf(a * (1.f / 128.f) + NORM_EPS) * (1.f - lam_init); }
        unsigned char* mix = ws + WS_H + ((size_t)(qrow0 + 32 * rb) * D + 1536 + h * 128) * MIXB;
#pragma unroll
        for (int nb = 0; nb < 4; ++nb) { const float w = Pk->in[I_DSUB][l * 128 + nb * 32 + r32];
#pragma unroll
            for (int r = 0; r < 16; ++r) { const float y = O[nb][r] * ssq[r] * w; const size_t e = (size_t)crow(r, hi) * D + nb * 32 + r32; if (WOUT_F8) mix[e] = f8_1(y); else ((bf16_t*)mix)[e] = (bf16_t)f2bf(y); } }
    }
}
__device__ __forceinline__ void swa_unit(KP Pk, Frame& F, int l, int b, int kvh, int qrow0, int qpos0, bool latent) {
    unsigned char* ws = F.ws;
    const bf16_t* U = (const bf16_t*)(ws + WS_U);
    const int hq = kvh * 4 + (F.wave & 3), rb = F.wave >> 2;
    const float sh2 = score_bound(Pk->in[I_SQN] + l * 64, Pk->in[I_SKN] + l * 64, F.lane);
    bf16x8 q[4];
    { const bf16_t* qp = U + (size_t)(qrow0 + 32 * rb + (F.lane & 31)) * NU + UC_SQ + hq * 64 + 8 * (F.lane >> 5);
#pragma unroll
      for (int ks = 0; ks < 4; ++ks) q[ks] = *(const bf16x8*)(qp + 16 * ks); }
    f32x16 O[2]; O[0] = (f32x16){}; O[1] = (f32x16){};
    float lsum = 0.f;
    int nloc = 0, loc0 = 0;
    if (latent) { int kp0 = qpos0 - 128, kp1 = qpos0 + 64 + 128; if (kp0 < 0) kp0 = 0; if (kp1 > SEQ) kp1 = SEQ; nloc = (kp1 - kp0) / 64; loc0 = LC + kp0; }
    const bf16_t* VT = (const bf16_t*)(ws + WS_VTS) + ((size_t)(b * 2 + kvh) * 64) * KEYS;
    attn_core<64, 64, true>(F, U, b, UC_SK + kvh * 64, VT, 4, nloc, loc0, q, 0, qpos0 + 32 * rb, sh2, O, lsum);
    int ln_; asm volatile("v_mbcnt_lo_u32_b32 %0, -1, 0\n\tv_mbcnt_hi_u32_b32 %0, -1, %0" : "=v"(ln_));
    const int r32 = ln_ & 31, hi = ln_ >> 5;
    { int lo_ = l; asm volatile("" : "+s"(lo_)); l = lo_; Pk = kp_opaque(Pk); }
    lsum += __shfl_xor(lsum, 32);
    const float rl = 1.f / (lsum + exp2f(Pk->in[I_SINK][l * 8 + hq] * LOG2E - sh2));
    unsigned char* mix = ws + WS_H + ((size_t)(qrow0 + 32 * rb) * D + 512 + hq * 64) * MIXB;
#pragma unroll
    for (int r = 0; r < 16; ++r) { const float rr = __shfl(rl, crow(r, hi));
#pragma unroll
        for (int nb = 0; nb < 2; ++nb) { const float y = O[nb][r] * rr; const size_t e = (size_t)crow(r, hi) * D + nb * 32 + r32; if (WOUT_F8) mix[e] = f8_1(y); else ((bf16_t*)mix)[e] = (bf16_t)f2bf(y); } }
}
constexpr int HY_PAD = 224, YSTR = 2504, HY_YB = 8 * YSTR * 2, HY_CST = 8224, HY_COP = 2 * HY_YB;
__device__ __forceinline__ void hyena_unit(KP Pk, Frame& F, int l, int cg) {
    unsigned char* ws = F.ws;
    const int r32 = F.lane & 31, hi = F.lane >> 5, bb = r32 >> 2, ib = r32 & 3;
    const bf16_t* ZT = (const bf16_t*)(ws + WS_ZT); bf16_t* OT = (bf16_t*)(ws + WS_OT);
    LAS unsigned char* cop = F.lds + HY_COP;
    const int nseq = l == 0 ? 2 : 1;
    u32x4 plo = {0u, 0u, 0u, 0u}, phh = {0u, 0u, 0u, 0u};
#define HY_RLOAD(cs_, o_) do { const int ci_ = (cs_) >> (nseq - 1), st_ = (cs_) & (nseq - 1), L_ = st_ == 0 ? SEQ : LC; \
        const bf16_t* R_ = (const bf16_t*)(ws + WS_HYF) + ((size_t)l * 1024 + (o_) * 512 + cg * 4 + ci_) * 4608 + (st_ == 0 ? 0 : 4096); const int xc_ = F.tid; \
        if (xc_ < 2 * L_ / 8) { plo = *(const u32x4*)(R_ + 8 * xc_); phh = (u32x4){0u, 0u, 0u, 0u}; if (8 * xc_ + 8 < 2 * L_) phh = *(const u32x4*)(R_ + 8 * xc_ + 8); } } while (0)
    HY_RLOAD(0, 0);
#pragma unroll 1
    for (int cs = 0; cs < 4 * nseq; ++cs) {
        const int ci = cs >> (nseq - 1), st = cs & (nseq - 1), ch = cg * 4 + ci, L = st == 0 ? SEQ : LC, nblk = L / 32, pos0 = st == 0 ? 0 : SEQ;
        __syncthreads();
        for (int id = F.tid; id < 8 * (L / 8 + 56); id += NTHR) { const int b = id / (L / 8 + 56), c = id % (L / 8 + 56);
            if (c < L / 8) *(LAS u32x4*)(F.lds + (b * YSTR + HY_PAD + 8 * c) * 2) = *(const u32x4*)(ZT + ((size_t)b * 1536 + 1024 + ch) * KEYS + pos0 + 8 * c);
            else { const int pc = c - L / 8, off = pc < 28 ? 8 * pc : HY_PAD + L + 8 * (pc - 28); const u32x4 z = {0u, 0u, 0u, 0u};
                *(LAS u32x4*)(F.lds + (b * YSTR + off) * 2) = z; *(LAS u32x4*)(F.lds + HY_YB + (b * YSTR + off) * 2) = z; } }
#pragma unroll 1
        for (int o = 0; o < 2; ++o) {
            for (int xc = F.tid; xc < 2 * L / 8; xc += NTHR) { const u32x4 lo = plo, hh = phh;
                const unsigned w[9] = {lo.x, lo.y, lo.z, lo.w, hh.x, hh.y, hh.z, hh.w, 0u};
#pragma unroll
                for (int r = 0; r < 8; ++r) { u32x4 ov; unsigned t[4];
#pragma unroll
                    for (int k = 0; k < 4; ++k) t[k] = (r & 1) ? ((w[(r >> 1) + k] >> 16) | (w[(r >> 1) + k + 1] << 16)) : w[(r >> 1) + k];
                    ov.x = t[0]; ov.y = t[1]; ov.z = t[2]; ov.w = t[3]; *(LAS u32x4*)(cop + r * HY_CST + 16 * xc) = ov; } }
            { const int nq = 2 * cs + o + 1; if (nq < 8 * nseq) HY_RLOAD(nq >> 1, nq & 1); }
            __syncthreads();
            const LAS unsigned char* Yin = F.lds + (o == 0 ? 0 : HY_YB); LAS unsigned char* Yout = F.lds + (o == 0 ? HY_YB : 0);
            const float bias = Pk->in[I_HBIAS][(l * 2 + o) * 512 + ch];
            if (2 * F.wave < nblk / 4) {
                const int g0 = 2 * F.wave, dlo = 4 * g0 - nblk + 1, dhi = min(4 * g0 + 7, nblk - 1), nsteps = dhi - dlo + 1;
                const LAS unsigned char* ap = cop + ((-r32) & 7) * HY_CST + ((L - 32 * dlo - r32 + 8 * hi) & ~7) * 2;
                const LAS unsigned char* bp = Yin + (bb * YSTR + HY_PAD + 32 * (4 * g0 + ib - dlo) + 8 * hi) * 2;
                f32x16 acc0 = {}, acc1 = {};
                u32x2 gtv[4];
                { const bf16_t* gp = ZT + ((size_t)bb * 1536 + o * 512 + ch) * KEYS + pos0 + 32 * (4 * g0 + ib) + 4 * hi;
#pragma unroll
                  for (int q = 0; q < 4; ++q) gtv[q] = *(const u32x2*)(gp + 8 * q); }
#define HDSR(dst, addr, off) asm volatile("ds_read_b128 %0, %1 offset:%2" : "=v"(dst) : "v"(addr), "n"(off))
#define HWAIT(a, b, c, d) asm volatile("s_waitcnt lgkmcnt(0)" : "+v"(a), "+v"(b), "+v"(c), "+v"(d))
                bf16x8 R[6][2], A2[2][2];
                const unsigned apa = (unsigned)(uintptr_t)ap, bpa = (unsigned)(uintptr_t)bp;
                HDSR(R[2][0], bpa, 256); HDSR(R[2][1], bpa, 256 + 32); HDSR(R[3][0], bpa, 192); HDSR(R[3][1], bpa, 192 + 32);
                HDSR(R[4][0], bpa, 128); HDSR(R[4][1], bpa, 128 + 32); HDSR(R[5][0], bpa, 64); HDSR(R[5][1], bpa, 64 + 32);
                HDSR(R[0][0], bpa, 0); HDSR(R[0][1], bpa, 32); HDSR(A2[0][0], apa, 0); HDSR(A2[0][1], apa, 32);
                HWAIT(R[2][0], R[2][1], R[3][0], R[3][1]); HWAIT(R[4][0], R[4][1], R[5][0], R[5][1]); HWAIT(R[0][0], R[0][1], A2[0][0], A2[0][1]);
#pragma unroll 1
                for (int s0 = 0; s0 < nsteps; s0 += 6) {
                    const unsigned an = apa - (unsigned)(s0 + 6) * 64u, bn = bpa - (unsigned)(s0 + 6) * 64u;
#pragma unroll
                    for (int j = 0; j < 6; ++j) if (s0 + j < nsteps) {
                        if (s0 + j + 1 < nsteps) { HDSR(A2[(j + 1) & 1][0], an, (5 - j) * 64); HDSR(A2[(j + 1) & 1][1], an, (5 - j) * 64 + 32);
                            HDSR(R[(j + 1) % 6][0], bn, (5 - j) * 64); HDSR(R[(j + 1) % 6][1], bn, (5 - j) * 64 + 32); }
                        acc1 = MFMA32(A2[j & 1][0], R[(j + 2) % 6][0], acc1); acc0 = MFMA32(A2[j & 1][0], R[j][0], acc0);
                        acc1 = MFMA32(A2[j & 1][1], R[(j + 2) % 6][1], acc1); acc0 = MFMA32(A2[j & 1][1], R[j][1], acc0);
                        HWAIT(A2[(j + 1) & 1][0], A2[(j + 1) & 1][1], R[(j + 1) % 6][0], R[(j + 1) % 6][1]); }
                }
#undef HDSR
#undef HWAIT
#pragma unroll
                for (int gg = 0; gg < 2; ++gg) { const f32x16& acc = gg == 0 ? acc0 : acc1;
                    const int t0 = 32 * (4 * (g0 + gg) + ib) + 4 * hi;
#pragma unroll
                    for (int q = 0; q < 4; ++q) { const u32x2 yo = *(const LAS u32x2*)(Yin + (bb * YSTR + HY_PAD + t0 + 8 * q) * 2); const u32x2 gt = gg == 0 ? gtv[q] : *(const u32x2*)(ZT + ((size_t)bb * 1536 + o * 512 + ch) * KEYS + pos0 + t0 + 8 * q);
                        const float v0 = bflo(gt.x) * (acc[4 * q + 0] + bflo(yo.x) * bias), v1 = bfhi(gt.x) * (acc[4 * q + 1] + bfhi(yo.x) * bias);
                        const float v2 = bflo(gt.y) * (acc[4 * q + 2] + bflo(yo.y) * bias), v3 = bfhi(gt.y) * (acc[4 * q + 3] + bfhi(yo.y) * bias);
                        u32x2 ov; ov.x = pk2(v0, v1); ov.y = pk2(v2, v3);
                        if (o == 0) *(LAS u32x2*)(Yout + (bb * YSTR + HY_PAD + t0 + 8 * q) * 2) = ov;
                        else *(u32x2*)(OT + ((size_t)bb * 512 + ch) * KEYS + pos0 + t0 + 8 * q) = ov; } }
            }
            __syncthreads();
        }
    }
#undef HY_RLOAD
    VM_WAIT(); __syncthreads();
    const int npos = l == 0 ? KEYS : SEQ;
    { const int ng = npos / 8, tot = 8 * ng; u32x4 cv[5][4];
#pragma unroll
      for (int it = 0; it < 5; ++it) { const int id = F.tid + it * NTHR; if (id < tot) { const int b = id / ng, pos = 8 * (id % ng); const bf16_t* op = OT + ((size_t)b * 512 + cg * 4) * KEYS + pos;
#pragma unroll
          for (int c = 0; c < 4; ++c) cv[it][c] = *(const u32x4*)(op + (size_t)c * KEYS); } }
      asm volatile("" ::: "memory");
#pragma unroll
      for (int it = 0; it < 5; ++it) { const int id = F.tid + it * NTHR; if (id < tot) { const int b = id / ng, pos = 8 * (id % ng), row = pos < SEQ ? b * SEQ + pos : TL + b * LC + (pos - SEQ);
#pragma unroll
          for (int k = 0; k < 8; ++k) { unsigned short e[4];
#pragma unroll
              for (int c = 0; c < 4; ++c) { const unsigned w = k < 2 ? cv[it][c].x : k < 4 ? cv[it][c].y : k < 6 ? cv[it][c].z : cv[it][c].w; e[c] = (unsigned short)((k & 1) ? (w >> 16) : (w & 0xffffu)); }
              if (WOUT_F8) *(unsigned*)(ws + WS_H + (size_t)(row + k) * D + 1024 + cg * 4) = pk4_f8(bf2f(e[0]), bf2f(e[1]), bf2f(e[2]), bf2f(e[3]));
              else { u32x2 ov; ov.x = (unsigned)e[0] | ((unsigned)e[1] << 16); ov.y = (unsigned)e[2] | ((unsigned)e[3] << 16); *(u32x2*)((bf16_t*)(ws + WS_H) + (size_t)(row + k) * D + 1024 + cg * 4) = ov; } } } } }
}
#ifndef MX_MASK
#define MX_MASK 15
#endif
#ifndef PROBE_MX
#define PROBE_MX 0
#endif
__device__ __forceinline__ void ph_mixers(KP Pk, Frame& F, int l, int qid) {
    const int n_diff = 512, n_hy = 128, n_dctx = l == 0 ? 64 : 0, n_swa = 512, n_sctx = l == 0 ? 64 : 0, gpb = l == 0 ? 5 : 4, n_gla = 64 * gpb;
    constexpr int R0 = 1 + ((PROBE_MX >> 0) & 1), R1 = 1 + ((PROBE_MX >> 1) & 1), R2 = 1 + ((PROBE_MX >> 2) & 1), R3 = 1 + ((PROBE_MX >> 3) & 1);
    const int n_mix = R0 * (n_diff + n_dctx) + R1 * n_hy + R2 * (n_swa + n_sctx) + R3 * n_gla + (l == 0 ? 192 + 128 : 0);
    const int n_titems = 16 * TI_GU + 16 * TI_DN + TI_WOUT + (l == 0 ? TI_WIN + TI_WA : 0), NTU = (n_titems + 127) / 128;
    const int total = n_mix + NTU, tplaced = min(NTU, total / 4);
    for (;;) {
        const int s_ = wg_grab(F, qid); if (s_ >= total) break;
        int ut_ = 8; const unsigned long long ut0_ = (PROBE_UT >= 0) ? __builtin_amdgcn_s_memrealtime() : 0ull;
        int u = s_ - min(NTU, s_ / 4), tu = -1;
        if ((s_ & 3) == 3 && (s_ >> 2) < NTU) tu = s_ >> 2; else if (u >= n_mix) tu = tplaced + (u - n_mix);
        if (tu >= 0) { ut_ = 0; LAS float* scr = (LAS float*)(F.lds + F.wave * 8704);
            for (int j = 0; j < 16; ++j) { int x = tu * 128 + F.wave * 16 + j; if (x >= n_titems) break;
                int it;
                if (x < 16 * TI_GU) it = 2 * TI_L + l * 16 * TI_GU + x;
                else if ((x -= 16 * TI_GU) < 16 * TI_DN) it = 2 * TI_L + 32 * TI_GU + l * 16 * TI_DN + x;
                else if ((x -= 16 * TI_DN) < TI_WOUT) it = l * TI_L + TI_WIN + TI_WA + x;
                else it = TI_L + (x - TI_WOUT);
                p0_item(Pk, F, it, scr); }
            goto mx_next; }
        if (u < R1 * n_hy) { ut_ = 3; u %= n_hy; if (MX_MASK & 2) hyena_unit(Pk, F, l, u); goto mx_next; } u -= R1 * n_hy;
        if (u < R3 * n_gla) { u %= n_gla; const int bh = u / gpb, grp = u % gpb, c = (l == 0 ? 0 : 4) + grp * 8 + F.wave;
          __syncthreads();
          if ((MX_MASK & 8) && c < NCH) gla_pass_b(Pk, F, l, bh >> 3, bh & 7, c, F.lds + F.wave * WAVE_LDS);
          goto mx_next; } u -= R3 * n_gla;
        if (u < R0 * n_diff) { ut_ = 4; u %= n_diff; const int b = u >> 6, h = (u >> 4) & 3, qb = u & 15; if (MX_MASK & 1) diff_unit(Pk, F, l, b, h, b * SEQ + 128 * qb, 36); goto mx_next; } u -= R0 * n_diff;
        if (u < R0 * n_dctx) { ut_ = 5; u %= n_dctx; const int b = u >> 3, h = (u >> 1) & 3, qb = u & 1; if (MX_MASK & 1) diff_unit(Pk, F, l, b, h, TL + b * LC + 128 * qb, 4); goto mx_next; } u -= R0 * n_dctx;
        if (l == 0) { if (u < 128) { ut_ = 2; ph_hyena_filters(Pk, F, 128 + u); goto mx_next; } u -= 128;
                      if (u < 192) { ut_ = 1; ada_unit(Pk, F, 192 + u); goto mx_next; } u -= 192; }
        if (u < R2 * n_swa) { ut_ = 6; u %= n_swa; const int b = u >> 6, kvh = (u >> 5) & 1, qb = u & 31; if (MX_MASK & 4) swa_unit(Pk, F, l, b, kvh, b * SEQ + 64 * qb, 64 * qb, true); goto mx_next; } u -= R2 * n_swa;
        if (u < R2 * n_sctx) { ut_ = 7; u %= n_sctx; const int b = u >> 3, kvh = (u >> 2) & 1, qb = u & 3; if (MX_MASK & 4) swa_unit(Pk, F, l, b, kvh, TL + b * LC + 64 * qb, 64 * qb, false); goto mx_next; } u -= R2 * n_sctx;
mx_next: ;
        if (PROBE_UT >= 0 && ut_ == PROBE_UT && l == PROBE_UL && !F.pt_done) { __syncthreads(); F.pt += __builtin_amdgcn_s_memrealtime() - ut0_; F.pt_done = 1; }
    }
}

constexpr int N_PHASES = 22;
#ifndef PH_MASK
#define PH_MASK 0xfffu
#endif
__global__ void __launch_bounds__(NTHR, 2) fwd_kernel(Params Parg) {
    extern __shared__ __attribute__((aligned(16))) unsigned char lds_raw[];
    const KP P0 = (KP)__builtin_amdgcn_kernarg_segment_ptr();
    Frame F;
    F.lds = (LAS unsigned char*)lds_raw; F.MISC = (volatile LAS unsigned*)(F.lds + LDS_MISC);
    const int wave_s = __builtin_amdgcn_readfirstlane((int)threadIdx.x >> 6);
#define TID_REFRESH() do { int t_; asm volatile("v_mbcnt_lo_u32_b32 %0, -1, 0\n\tv_mbcnt_hi_u32_b32 %0, -1, %0" : "=v"(t_)); F.lane = t_; F.wave = wave_s; F.tid = wave_s * 64 + t_; } while (0)
    TID_REFRESH();
    F.pt = 0ull; F.pt_done = 0; F.pt0 = (PROBE_T || PROBE_UT >= 0) ? __builtin_amdgcn_s_memrealtime() : 0ull;
    F.G = gridDim.x; { const int bx = blockIdx.x; F.vcu = (F.G % 8 == 0) ? (bx % 8) * (F.G / 8) + bx / 8 : bx; }
    F.ws = P0->ws; F.ctl = (unsigned*)(P0->ws + WS_CTL);
    for (int u = F.tid; u < 128; u += NTHR) F.MISC[u] = 0u;
    __syncthreads();
    const int lo = P0->ph_lo, hi = P0->ph_hi;
    const bool multi = hi - lo > 1;
    XcdBarrier bar; bar.bar = F.ctl + CW_BAR; bar.x = 0; bar.st = nullptr;
    if (multi) bar = xcd_barrier_post(F.ctl + CW_BAR, F.MISC + 8, F.tid);
#define INR(k) (lo <= (k) && (k) < hi)
#define IN(k, kind) (((PH_MASK >> (kind)) & 1u) && INR(k))
    unsigned long long pt_last = PROBE_T ? __builtin_amdgcn_s_memrealtime() : 0ull, pt_acc = 0ull;
#define PT_MARK(k) do { if (PROBE_T) { const unsigned long long now_ = __builtin_amdgcn_s_memrealtime(); if ((PROBE_T >> (k)) & 1u) pt_acc += now_ - pt_last; pt_last = now_; F.pt0 = now_; } } while (0)
#define SEAM(k) do { if (INR(k) && INR((k) + 1)) { bar.bar = (unsigned*)(kp_opaque(P0)->ws + WS_CTL) + CW_BAR; TID_REFRESH(); xcd_barrier(bar, F.tid); } PT_MARK(k); } while (0)
#ifndef PROBE_MASK
#define PROBE_MASK 0u
#endif
#define REP(kind) for (int rep_ = 0; rep_ < (((PROBE_MASK >> (kind)) & 1u) ? 2 : 1); ++rep_)
#define REP_SYNC(kind) do { if (((PROBE_MASK >> (kind)) & 1u) && rep_ == 0 && multi) { TID_REFRESH(); xcd_barrier(bar, F.tid); } } while (0)
#define PHASE_BEGIN() const KP Pk = kp_opaque(P0); unsigned char* ws = Pk->ws; F.ws = ws; F.ctl = (unsigned*)(ws + WS_CTL); \
    TID_REFRESH()
    if (IN(0, 0)) REP(0) { PHASE_BEGIN(); p0_prologue(Pk, F, rep_); PT_MARK(22); REP_SYNC(0); } SEAM(0);
#pragma unroll 1
    for (int l = 0; l < DEPTH; ++l) {
        const int pb = 1 + 10 * l;
        if (IN(pb + 0, 1)) REP(1) { if (rep_ && l) break; PHASE_BEGIN(); if (l == 0) { for (int u = blockIdx.x; u < 128; u += F.G) ph_hyena_filters(Pk, F, u); } ph_norm1(Pk, F, l); if (l == 0) PT_MARK(23); REP_SYNC(1); } SEAM(pb + 0);
        if (IN(pb + 1, 2)) REP(2) { PHASE_BEGIN();
            pg8::Gemm g{(const bf16_t*)(ws + WS_H), (const bf16_t*)(ws + WS_WIN + (size_t)l * NU * D * 2), D, nullptr};
            pg8::RectOrder S; if (l == 0) S.init(72, 21, F.G, (int)blockIdx.x, 0, 0, 0ull); else S.init(64, 21, F.G, (int)blockIdx.x, 64, 64, 0x1413121108030201ull);
            pg8::EpiU E{(bf16_t*)(ws + WS_U), WIN_F8_L(l) ? 1.f / 32.f : 1.f};
            if (WIN_F8_L(l)) pg8::gemm_phase<pg8::EpiU, pg8::RectOrder, false, true>(F.lds, g, S, E, F.tid);
            else pg8::gemm_phase<pg8::EpiU, pg8::RectOrder, false, false>(F.lds, g, S, E, F.tid);
            if (WIN_F8_L(l)) ph_gate_cols8(F, l); else ph_gate_cols(F, l); REP_SYNC(2);
        } SEAM(pb + 1);
        if (IN(pb + 2, 3)) REP(3) { PHASE_BEGIN(); ph_prep(Pk, F, l, rep_); PT_MARK(pb + 3); REP_SYNC(3); } SEAM(pb + 2);
        if (IN(pb + 4, 5)) REP(5) { PHASE_BEGIN(); ph_mixers(Pk, F, l, 1 + l + 2 * rep_); REP_SYNC(5); } SEAM(pb + 4);
        if (IN(pb + 5, 6)) REP(6) { if (rep_ && l) break; PHASE_BEGIN();
            pg8::Gemm g{(const bf16_t*)(ws + WS_H), (const bf16_t*)(ws + WS_WOUT + (size_t)l * D * D * MIXB), D, nullptr};
            pg8::RectOrder S; S.init(l == 0 ? 72 : 64, 8, F.G, (int)blockIdx.x, 0, 0, 0ull);
            pg8::EpiWout E{Pk->in[I_X], Pk->in[I_CTX], l == 0 ? (const bf16_t*)nullptr : (const bf16_t*)(ws + WS_X), (bf16_t*)(ws + WS_X), (const float*)(ws + WS_MOD) + (size_t)l * 9 * 12288};
            pg8::gemm_phase<pg8::EpiWout, pg8::RectOrder, false, WOUT_F8>(F.lds, g, S, E, F.tid); REP_SYNC(6);
        } SEAM(pb + 5);
        if (IN(pb + 6, 7)) REP(7) { PHASE_BEGIN(); ph_norm2_router(Pk, F, l, rep_); REP_SYNC(7); } SEAM(pb + 6);
        if (IN(pb + 7, 8)) { PHASE_BEGIN(); ph_slots(Pk, F, l); } SEAM(pb + 7);
        if (IN(pb + 8, 9)) REP(9) { PHASE_BEGIN();
            const int np = moe_table(F, l);
            pg8::Gemm g{(const bf16_t*)(ws + WS_H), (const bf16_t*)(ws + WS_WGU + (size_t)l * NE * 2048 * D), D, (const int*)(ws + WS_RT + RT_ROWTOK)};
            pg8::MoeOrder S{np, F.G, F.vcu, (const volatile LAS unsigned char*)(F.MISC + 64)};
            pg8::EpiMoe1 E{ws + WS_U};
            pg8::gemm_phase<pg8::EpiMoe1, pg8::MoeOrder, true, true>(F.lds, g, S, E, F.tid); REP_SYNC(9);
        } SEAM(pb + 8);
        if (IN(pb + 9, 10)) REP(10) { PHASE_BEGIN();
            const int np = moe_table(F, l);
            pg8::Gemm g{(const bf16_t*)(ws + WS_U), (const bf16_t*)(ws + WS_WD + (size_t)l * NE * D * DE), DE, nullptr};
            pg8::MoeOrder S{np, F.G, F.vcu, (const volatile LAS unsigned char*)(F.MISC + 64)};
            pg8::EpiMoe2 E{ws + WS_Y2, (const int*)(ws + WS_RT + RT_ROWTOK), (const float*)(ws + WS_RT + RT_ROWW)};
            pg8::gemm_phase<pg8::EpiMoe2, pg8::MoeOrder, false, true>(F.lds, g, S, E, F.tid); REP_SYNC(10);
        } SEAM(pb + 9);
    }
    if (IN(21, 11)) REP(11) { PHASE_BEGIN(); ph_final(Pk, F); REP_SYNC(11); }
    if (PROBE_T || PROBE_UT >= 0) { PT_MARK(21); if (blockIdx.x == PROBE_WG) { const unsigned long long t0_ = __builtin_amdgcn_s_memrealtime(); while (__builtin_amdgcn_s_memrealtime() - t0_ < 8ull * (pt_acc + F.pt)) __builtin_amdgcn_s_sleep(8); } }
#undef IN
#undef INR
#undef SEAM
#undef PT_MARK
#undef PHASE_BEGIN
#undef REP
#undef REP_SYNC
#undef TID_REFRESH
}

#ifndef MK_PER_PHASE
#define MK_PER_PHASE 0
#endif
extern "C" void kernel_launch(void* const* d_in, const int* in_sizes, int n_in, void* d_out, int out_size, void* d_ws, size_t ws_size, hipStream_t stream) {
    static int grid = 0;
    if (grid == 0) {
        if (n_in != 34 || in_sizes[0] != TL * D || out_size != TL * D || ws_size < WS_END) { fprintf(stderr, "kernel_launch: unexpected shapes (n_in %d, in0 %d, out %d, ws %zu < %zu)\n", n_in, n_in > 0 ? in_sizes[0] : -1, out_size, ws_size, (size_t)WS_END); grid = -1; return; }
        int dev = 0, cus = 0, per_cu = 0;
        if (hipGetDevice(&dev) != hipSuccess || hipDeviceGetAttribute(&cus, hipDeviceAttributeMultiprocessorCount, dev) != hipSuccess) { grid = -1; return; }
        if (hipFuncSetAttribute((const void*)fwd_kernel, hipFuncAttributeMaxDynamicSharedMemorySize, LDS_BYTES) != hipSuccess) { fprintf(stderr, "kernel_launch: hipFuncSetAttribute failed\n"); grid = -1; return; }
        if (hipOccupancyMaxActiveBlocksPerMultiprocessor(&per_cu, (const void*)fwd_kernel, NTHR, LDS_BYTES) != hipSuccess || per_cu < 1) fprintf(stderr, "kernel_launch: occupancy query reports %d\n", per_cu);
        (void)hipGetLastError();
        grid = cus;
    }
    if (grid < 0) return;
    (void)hipMemsetAsync((char*)d_ws + WS_CTL, 0, CTL_BYTES, stream);
    Params p{};
    for (int i = 0; i < 34; ++i) p.in[i] = (const float*)d_in[i];
    p.out = (float*)d_out; p.ws = (unsigned char*)d_ws;
#if MK_PER_PHASE
    for (int k = 0; k < N_PHASES; ++k) { p.ph_lo = k; p.ph_hi = k + 1; hipLaunchKernelGGL(fwd_kernel, dim3(grid), dim3(NTHR), LDS_BYTES, stream, p); }
#else
    p.ph_lo = 0; p.ph_hi = N_PHASES; hipLaunchKernelGGL(fwd_kernel, dim3(grid), dim3(NTHR), LDS_BYTES, stream, p);
#endif
    const hipError_t le = hipPeekAtLastError();
    if (le != hipSuccess) fprintf(stderr, "kernel_launch: launch failed: %s\n", hipGetErrorName(le));
}
```
